# Optimizing an MI355X kernel written in HIP

```python
import math
import jax, jax.numpy as jnp
from jax import lax
import numpy as np

D_MODEL = 1024
BATCH = 4
SEQ = 4096
DEPTH = 2

PLE_DIM = 256
MOBA_HEADS = 8
MOBA_HEAD_DIM = 64
MOBA_WIDTH = MOBA_HEADS * MOBA_HEAD_DIM
MOBA_BLOCK = 256
MOBA_TOPK = 3
MOBA_QCHUNK = 32
MLSTM_HEADS = 4
MLSTM_QK_DIM = 128
MLSTM_V_DIM = 128
MLSTM_QK_WIDTH = MLSTM_HEADS * MLSTM_QK_DIM
MLSTM_V_WIDTH = MLSTM_HEADS * MLSTM_V_DIM
MLSTM_CHUNK = 64
CONV_WIDTH = 4
D_FF = 2816
N_EXPERTS = 8
TOP_K = 2
D_FF_EXPERT = 3584
MOE_BLOCK = 512
N_DENSE = (DEPTH + 1) // 2
N_MOE = DEPTH // 2
RMS_EPS = 1e-6

IN_SPLITS = (MOBA_WIDTH, MOBA_WIDTH, MOBA_WIDTH, 2 * MLSTM_QK_WIDTH, MLSTM_V_WIDTH,
             MLSTM_V_WIDTH, MLSTM_HEADS, MLSTM_HEADS, D_MODEL, D_MODEL)
N_IN = sum(IN_SPLITS)

kernel_name = "hybrid_moba_mlstm_moe_block"


def rms_norm(x, g):
    xf = x.astype(jnp.float32)
    y = xf * lax.rsqrt(jnp.mean(xf * xf, axis=-1, keepdims=True) + RMS_EPS)
    return (y * g.astype(jnp.float32)).astype(x.dtype)


def split_heads(t, n_heads):
    b, s, _ = t.shape
    return t.reshape(b, s, n_heads, -1).transpose(0, 2, 1, 3)


def merge_heads(t):
    b, h, s, d = t.shape
    return t.transpose(0, 2, 1, 3).reshape(b, s, h * d)


def causal_depthwise_conv(x, w):
    c = x.shape[-1]
    return lax.conv_general_dilated(
        x, w[:, None, :].astype(x.dtype), window_strides=(1,),
        padding=[(CONV_WIDTH - 1, 0)], dimension_numbers=("NWC", "WIO", "NWC"),
        feature_group_count=c)


def moba_attention(q, k, v):
    b, h, s, dh = q.shape
    nb = -(-s // MOBA_BLOCK)
    s_pad = nb * MOBA_BLOCK
    padw = ((0, 0), (0, 0), (0, s_pad - s), (0, 0))
    q, k, v = jnp.pad(q, padw), jnp.pad(k, padw), jnp.pad(v, padw)
    k_blocks = k.reshape(b, h, nb, MOBA_BLOCK, dh)
    v_blocks = v.reshape(b, h, nb, MOBA_BLOCK, dh)
    k_mean = jnp.mean(k_blocks.astype(jnp.float32), axis=3).astype(k.dtype)
    n_sel = min(MOBA_TOPK, nb)
    scale = dh ** -0.5
    bi = jnp.arange(b)[:, None, None, None]
    hi = jnp.arange(h)[None, :, None, None]

    def chunk_fn(c):
        q0 = c * MOBA_QCHUNK
        blk = q0 // MOBA_BLOCK
        qc = lax.dynamic_slice_in_dim(q, q0, MOBA_QCHUNK, axis=2)
        gate = jnp.einsum('bhqd,bhnd->bhqn', qc, k_mean).astype(jnp.float32)
        gate = jnp.where(jnp.arange(nb) < blk, gate, -jnp.inf)
        _, sel = lax.top_k(gate, n_sel)
        sel_ok = jnp.arange(n_sel) < blk
        kg = k_blocks[bi, hi, sel]
        vg = v_blocks[bi, hi, sel]
        s_sel = jnp.einsum('bhqd,bhqnkd->bhqnk', qc, kg).astype(jnp.float32) * scale
        s_sel = jnp.where(sel_ok[:, None], s_sel, -jnp.inf)
        k_own = lax.dynamic_slice_in_dim(k, blk * MOBA_BLOCK, MOBA_BLOCK, axis=2)
        v_own = lax.dynamic_slice_in_dim(v, blk * MOBA_BLOCK, MOBA_BLOCK, axis=2)
        s_own = jnp.einsum('bhqd,bhkd->bhqk', qc, k_own).astype(jnp.float32) * scale
        causal = (blk * MOBA_BLOCK + jnp.arange(MOBA_BLOCK))[None, :] <= (q0 + jnp.arange(MOBA_QCHUNK))[:, None]
        s_own = jnp.where(causal, s_own, -jnp.inf)
        n_g = n_sel * MOBA_BLOCK
        s_all = jnp.concatenate([s_sel.reshape(b, h, MOBA_QCHUNK, n_g), s_own], axis=-1)
        pr = jax.nn.softmax(s_all, axis=-1).astype(v.dtype)
        p_sel = pr[..., :n_g].reshape(b, h, MOBA_QCHUNK, n_sel, MOBA_BLOCK)
        return (jnp.einsum('bhqnk,bhqnkd->bhqd', p_sel, vg)
                + jnp.einsum('bhqk,bhkd->bhqd', pr[..., n_g:], v_own))

    outs = lax.map(chunk_fn, jnp.arange(s_pad // MOBA_QCHUNK))
    out = outs.transpose(1, 2, 0, 3, 4).reshape(b, h, s_pad, dh)
    return out[:, :, :s]


def mlstm_chunkwise(q, k, v, i_pre, f_pre):
    b, h, s, dk = q.shape
    dv = v.shape[-1]
    L = MLSTM_CHUNK
    nc = s // L
    f32 = jnp.float32
    q = q.astype(f32)
    k = k.astype(f32) * (dk ** -0.5)
    v = v.astype(f32)
    logf = jax.nn.log_sigmoid(f_pre.astype(f32))
    ig = i_pre.astype(f32)

    def to_chunks(t):
        return jnp.moveaxis(t.reshape(b, h, nc, L, *t.shape[3:]), 2, 0)

    xs = (to_chunks(q), to_chunks(k), to_chunks(v), to_chunks(ig), to_chunks(logf))
    tril = jnp.tril(jnp.ones((L, L), dtype=bool))

    def step(carry, inp):
        C, n, m = carry
        qc, kc, vc, ic, lfc = inp
        bcum = jnp.cumsum(lfc, axis=-1)
        D = bcum[..., :, None] - bcum[..., None, :] + ic[..., None, :]
        D = jnp.where(tril, D, -jnp.inf)
        a = bcum + m[..., None]
        m_t = jnp.maximum(a, jnp.max(D, axis=-1))
        Dw = jnp.exp(D - m_t[..., None])
        aw = jnp.exp(a - m_t)
        sqk = jnp.einsum('bhtd,bhsd->bhts', qc, kc) * Dw
        num = aw[..., None] * jnp.einsum('bhtd,bhde->bhte', qc, C) + jnp.einsum('bhts,bhse->bhte', sqk, vc)
        den = aw * jnp.einsum('bhtd,bhd->bht', qc, n) + jnp.sum(sqk, axis=-1)
        hc = num / jnp.maximum(jnp.abs(den), jnp.exp(-m_t))[..., None]
        bL = bcum[..., -1]
        g = bL[..., None] - bcum + ic
        m_new = jnp.maximum(bL + m, jnp.max(g, axis=-1))
        wC = jnp.exp(bL + m - m_new)
        ws = jnp.exp(g - m_new[..., None])
        C_new = wC[..., None, None] * C + jnp.einsum('bhs,bhsd,bhse->bhde', ws, kc, vc)
        n_new = wC[..., None] * n + jnp.einsum('bhs,bhsd->bhd', ws, kc)
        return (C_new, n_new, m_new), hc

    init = (jnp.zeros((b, h, dk, dv), f32), jnp.zeros((b, h, dk), f32), jnp.zeros((b, h), f32))
    _, hs = lax.scan(step, init, xs)
    return jnp.moveaxis(hs, 0, 2).reshape(b, h, s, dv)


def swiglu(x, w1, w3, w2):
    return (jax.nn.silu(x @ w1) * (x @ w3)) @ w2


def moe_swiglu(xt, w_router, w1, w3, w2):
    t = xt.shape[0]
    logits = (xt @ w_router).astype(jnp.float32)
    top_val, top_idx = lax.top_k(logits, TOP_K)
    gates = jax.nn.softmax(top_val, axis=-1)
    a = t * TOP_K
    e_flat = top_idx.reshape(a).astype(jnp.int32)
    g_flat = gates.reshape(a).astype(xt.dtype)
    t_flat = jnp.repeat(jnp.arange(t, dtype=jnp.int32), TOP_K)
    order = jnp.argsort(e_flat)
    e_s, t_s, g_s = e_flat[order], t_flat[order], g_flat[order]
    counts = jnp.bincount(e_flat, length=N_EXPERTS)
    start = jnp.cumsum(counts) - counts
    padded = ((counts + MOE_BLOCK - 1) // MOE_BLOCK) * MOE_BLOCK
    pad_end = jnp.cumsum(padded)
    pad_start = pad_end - padded
    dest = pad_start[e_s] + (jnp.arange(a, dtype=jnp.int32) - start[e_s])
    n_rows = (-(-a // MOE_BLOCK) + N_EXPERTS) * MOE_BLOCK
    n_blk = n_rows // MOE_BLOCK
    row_tok = jnp.zeros((n_rows,), jnp.int32).at[dest].set(t_s)
    row_w = jnp.zeros((n_rows,), xt.dtype).at[dest].set(g_s)
    blk_start = jnp.arange(n_blk) * MOE_BLOCK
    blk_exp = jnp.minimum(jnp.sum(blk_start[:, None] >= pad_end[None, :], axis=1), N_EXPERTS - 1)

    def blk_fn(args):
        tok, w, e = args
        xb = xt[tok]
        return swiglu(xb, w1[e], w3[e], w2[e]) * w[:, None]

    y_rows = lax.map(blk_fn, (row_tok.reshape(n_blk, MOE_BLOCK), row_w.reshape(n_blk, MOE_BLOCK), blk_exp))
    return jax.ops.segment_sum(y_rows.reshape(n_rows, -1), row_tok, num_segments=t)


def setup_inputs(seed: int = 0) -> dict:
    key = jax.random.key(seed)
    ks = jax.random.split(key, 26)
    f32 = jnp.float32

    def nrm(k, shape, fan_in):
        return jax.random.normal(k, shape, f32) * (fan_in ** -0.5)

    def gain(k, shape):
        return 1.0 + 0.05 * jax.random.normal(k, shape, f32)

    return {
        "x": jax.random.normal(ks[0], (BATCH, SEQ, D_MODEL), f32),
        "p": jax.random.normal(ks[1], (DEPTH, BATCH, SEQ, PLE_DIM), f32),
        "g_mix": gain(ks[2], (DEPTH, D_MODEL)),
        "w_in": nrm(ks[3], (DEPTH, D_MODEL, N_IN), D_MODEL),
        "g_q": gain(ks[4], (DEPTH, MOBA_HEAD_DIM)),
        "g_k": gain(ks[5], (DEPTH, MOBA_HEAD_DIM)),
        "conv_w": nrm(ks[6], (DEPTH, CONV_WIDTH, 2 * MLSTM_QK_WIDTH), CONV_WIDTH),
        "conv_b": 0.02 * jax.random.normal(ks[7], (DEPTH, 2 * MLSTM_QK_WIDTH), f32),
        "b_i": 0.1 * jax.random.normal(ks[8], (DEPTH, MLSTM_HEADS), f32),
        "b_f": 3.0 + 0.5 * jax.random.normal(ks[9], (DEPTH, MLSTM_HEADS), f32),
        "g_h": gain(ks[10], (DEPTH, MLSTM_V_DIM)),
        "w_oa": nrm(ks[11], (DEPTH, MOBA_WIDTH, D_MODEL), MOBA_WIDTH),
        "w_ob": nrm(ks[12], (DEPTH, MLSTM_V_WIDTH, D_MODEL), MLSTM_V_WIDTH),
        "w_out": nrm(ks[13], (DEPTH, D_MODEL, D_MODEL), D_MODEL),
        "g_ffn": gain(ks[14], (DEPTH, D_MODEL)),
        "w_d1": nrm(ks[15], (N_DENSE, D_MODEL, D_FF), D_MODEL),
        "w_d3": nrm(ks[16], (N_DENSE, D_MODEL, D_FF), D_MODEL),
        "w_d2": nrm(ks[17], (N_DENSE, D_FF, D_MODEL), D_FF),
        "w_router": nrm(ks[18], (N_MOE, D_MODEL, N_EXPERTS), D_MODEL),
        "w_e1": nrm(ks[19], (N_MOE, N_EXPERTS, D_MODEL, D_FF_EXPERT), D_MODEL),
        "w_e3": nrm(ks[20], (N_MOE, N_EXPERTS, D_MODEL, D_FF_EXPERT), D_MODEL),
        "w_e2": nrm(ks[21], (N_MOE, N_EXPERTS, D_FF_EXPERT, D_MODEL), D_FF_EXPERT),
        "g_ple": gain(ks[22], (DEPTH, D_MODEL)),
        "w_ple_gate": nrm(ks[23], (DEPTH, D_MODEL, D_MODEL), D_MODEL),
        "w_ple_proj": nrm(ks[24], (DEPTH, PLE_DIM, D_MODEL), PLE_DIM),
    }


def reference(x, p, g_mix, w_in, g_q, g_k, conv_w, conv_b, b_i, b_f, g_h, w_oa, w_ob, w_out,
              g_ffn, w_d1, w_d3, w_d2, w_router, w_e1, w_e3, w_e2, g_ple, w_ple_gate, w_ple_proj):
    b, s, d = x.shape
    cuts = np.cumsum(IN_SPLITS)[:-1].tolist()
    for l in range(DEPTH):
        h = rms_norm(x, g_mix[l])
        proj = h @ w_in[l]
        qa, ka, va, qk_m, v_m, o_m, i_m, f_m, ga, gb = jnp.split(proj, cuts, axis=-1)
        qa = rms_norm(split_heads(qa, MOBA_HEADS), g_q[l])
        ka = rms_norm(split_heads(ka, MOBA_HEADS), g_k[l])
        ya = merge_heads(moba_attention(qa, ka, split_heads(va, MOBA_HEADS)))
        qk_m = jax.nn.silu(causal_depthwise_conv(qk_m, conv_w[l]) + conv_b[l])
        q_m, k_m = jnp.split(qk_m, 2, axis=-1)
        i_pre = (i_m + b_i[l]).transpose(0, 2, 1)
        f_pre = (f_m + b_f[l]).transpose(0, 2, 1)
        hm = mlstm_chunkwise(split_heads(q_m, MLSTM_HEADS), split_heads(k_m, MLSTM_HEADS),
                             split_heads(v_m, MLSTM_HEADS), i_pre, f_pre).astype(x.dtype)
        hm = rms_norm(hm, g_h[l]) * jax.nn.sigmoid(split_heads(o_m, MLSTM_HEADS))
        yb = merge_heads(hm)
        mixed = jax.nn.sigmoid(ga) * (ya @ w_oa[l]) + jax.nn.sigmoid(gb) * (yb @ w_ob[l])
        x = x + mixed @ w_out[l]
        hf = rms_norm(x, g_ffn[l])
        j = l // 2
        if l % 2 == 0:
            ffn = swiglu(hf, w_d1[j], w_d3[j], w_d2[j])
        else:
            ffn = moe_swiglu(hf.reshape(b * s, d), w_router[j], w_e1[j], w_e3[j], w_e2[j]).reshape(b, s, d)
        x = x + ffn
        gate = jax.nn.sigmoid(rms_norm(x, g_ple[l]) @ w_ple_gate[l])
        x = x + gate * (p[l] @ w_ple_proj[l])
    return x
```

```cpp
#include <hip/hip_runtime.h>
#include <cstdio>
#include <cstdint>
#include <cmath>
namespace pg8 {
#define PG8_LAS __attribute__((address_space(3)))
typedef unsigned short bf16_t;
typedef short bf16x8 __attribute__((ext_vector_type(8)));
typedef float f32x4 __attribute__((ext_vector_type(4)));
typedef unsigned u32x4 __attribute__((ext_vector_type(4)));
constexpr int BM = 256, BK = 64, HALF = 128, HTB = HALF * BK * 2  , STAGE_BYTES = 8 * HTB, NXCD = 8, WGM = 8;

__host__ __device__ __forceinline__ int lds_byte(int r, int c) { const int st = (r >> 4) * 2 + (c >> 5), rr = r & 15, cc = c & 31, ob = rr * 64 + cc * 2; return st * 1024 + (ob ^ (((ob >> 9) & 1) << 5)); }
__host__ __device__ __forceinline__ void stage_rc(int b, int& R, int& C) { const int st = b / 1024, sb = b % 1024, swz = sb ^ (((sb >> 9) & 1) << 5); R = (st >> 1) * 16 + swz / 64; C = (st & 1) * 32 + (swz % 64) / 2; }
__host__ __device__ __forceinline__ int perm32(int rho) { const int n = rho >> 4, i = rho & 15; return 8 * (i >> 2) + 4 * n + (i & 3); }

struct Unit { int pm, pn, pb; };
struct Gemm { const bf16_t* A; const bf16_t* Bt; int M, N, K; };

struct StaticOrder {
    int nM, nN, nwg, G, c;
    __host__ __device__ void init(int M, int N, int G_, int c_) { nM = M / BM; nN = N / BM; nwg = nM * nN; G = G_; c = c_; }
    __host__ __device__ bool next(int i, Unit& u) const {
        const long L = (long)i * G + c; if (L >= nwg) return false;
        int wgid = (int)L; { const int q = nwg / NXCD, r = nwg % NXCD, xcd = wgid % NXCD, off = wgid / NXCD; wgid = (xcd < r ? xcd * (q + 1) : r * (q + 1) + (xcd - r) * q) + off; }
        const int nig = WGM * nN, gid = wgid / nig, fm = gid * WGM, gsz = (nM - fm) < WGM ? (nM - fm) : WGM;
        u.pm = fm + ((wgid % nig) % gsz); u.pn = (wgid % nig) / gsz; u.pb = u.pn; return true;
    }
    __device__ __forceinline__ void a_ready(const Unit&) const {}
    __device__ __forceinline__ void done(const Unit&) const {}
};

__device__ __forceinline__ unsigned cvt_pk_bf16(float lo, float hi) { unsigned r; asm volatile("v_cvt_pk_bf16_f32 %0, %1, %2" : "=v"(r) : "v"(lo), "v"(hi)); return r; }
template <class Epi, class Sched, bool ALIGN_EPI = false, bool SP2 = false>
__device__ __forceinline__ void gemm_phase(PG8_LAS unsigned char* lds, const Gemm g, const Sched& S, const Epi& E) {
    int tid_ = threadIdx.x; asm volatile("" : "+v"(tid_));
    const int tid = tid_, wid = __builtin_amdgcn_readfirstlane(tid >> 6), lane = tid & 63, wr = wid >> 2, wc = wid & 3, fr = lane & 15, fq = lane >> 4;
    const int K = g.K, nt = K / BK;
    unsigned voffA[2], voffB[2];
#pragma unroll
    for (int i = 0; i < 2; ++i) { int R, C; stage_rc(tid * 16 + i * 8192, R, C); const int Rb = Epi::PERM ? ((R & ~31) + perm32(R & 31)) : R;
        voffA[i] = (unsigned)(R * K + C) * 2u; voffB[i] = (unsigned)(Rb * K + C) * 2u; }
    const size_t kstep = (size_t)(BK * 2);
    const size_t hstep = (size_t)HALF * K * 2;
    const size_t tstep = 2 * hstep;
    const unsigned ldsw = (unsigned)wid * 1024u;
    const int aoff = lds_byte(wr * 64 + fr, fq * 8), boff = lds_byte(wc * 32 + fr, fq * 8);
#define PG8_SA(b, h) (((b) * 2 + (h)) * HTB)
#define PG8_SB(b, h) ((4 + (b) * 2 + (h)) * HTB)
#define PG8_STAGE(bufoff, gbase, voff) do { _Pragma("unroll") for (int _i = 0; _i < 2; ++_i) \
        __builtin_amdgcn_global_load_lds((const unsigned*)((const char*)(gbase) + (voff)[_i]), (PG8_LAS unsigned*)(lds + (bufoff) + ldsw + _i * 8192), 16, 0, 0); } while (0)
#define PG8_LDA(dst, b, h) do { _Pragma("unroll") for (int m = 0; m < 4; ++m) _Pragma("unroll") for (int k = 0; k < 2; ++k) dst[m][k] = *(const PG8_LAS bf16x8*)(lds + PG8_SA(b, h) + aoff + m * 2048 + k * 1024); } while (0)
#define PG8_LDB(dst, b, h) do { _Pragma("unroll") for (int n = 0; n < 2; ++n) _Pragma("unroll") for (int k = 0; k < 2; ++k) dst[n][k] = *(const PG8_LAS bf16x8*)(lds + PG8_SB(b, h) + boff + n * 2048 + k * 1024); } while (0)
#define PG8_MMA(ai, bj, At, Bt) do { __builtin_amdgcn_s_setprio(1); _Pragma("unroll") for (int m = 0; m < 4; ++m) _Pragma("unroll") for (int n = 0; n < 2; ++n) _Pragma("unroll") for (int k = 0; k < 2; ++k) \
        acc[ai][bj][m][n] = __builtin_amdgcn_mfma_f32_16x16x32_bf16(Bt[n][k], At[m][k], acc[ai][bj][m][n], 0, 0, 0); __builtin_amdgcn_s_setprio(0); } while (0)
#define PG8_WAIT_V(n) asm volatile("s_waitcnt vmcnt(" #n ")" ::: "memory")
#define PG8_WAIT_L(n) asm volatile("s_waitcnt lgkmcnt(" #n ")" ::: "memory")
#define PG8_BAR __builtin_amdgcn_s_barrier()
#define PG8_SCHED __builtin_amdgcn_sched_barrier(0)
    Unit cur, nxt; int ui = 0;
    if (!S.next(0, cur)) return;
    f32x4 acc[2][2][4][2];
#pragma unroll
    for (int a = 0; a < 2; ++a)
#pragma unroll
        for (int b = 0; b < 2; ++b)
#pragma unroll
            for (int m = 0; m < 4; ++m)
#pragma unroll
                for (int n = 0; n < 2; ++n) acc[a][b][m][n] = (f32x4){0.f, 0.f, 0.f, 0.f};
    bf16x8 At[4][2], B0[2][2], B1[2][2];
    const char* cA = (const char*)g.A + (size_t)cur.pm * tstep; const char* cB = (const char*)g.Bt + (size_t)cur.pb * tstep;
    S.a_ready(cur);
    if constexpr (SP2) {
        PG8_STAGE(PG8_SB(0, 0), cB, voffB); PG8_STAGE(PG8_SB(0, 1), cB + hstep, voffB); PG8_STAGE(PG8_SA(0, 0), cA, voffA); PG8_STAGE(PG8_SA(0, 1), cA + hstep, voffA);
        if (wr == 1) PG8_BAR;
        PG8_WAIT_V(2); PG8_BAR;
        PG8_STAGE(PG8_SB(1, 0), cB + kstep, voffB); PG8_STAGE(PG8_SA(1, 0), cA + kstep, voffA); PG8_STAGE(PG8_SB(1, 1), cB + hstep + kstep, voffB);
        PG8_WAIT_V(6); PG8_BAR;
    } else {
        PG8_STAGE(PG8_SB(0, 0), cB, voffB); PG8_STAGE(PG8_SA(0, 0), cA, voffA); PG8_STAGE(PG8_SB(0, 1), cB + hstep, voffB); PG8_STAGE(PG8_SA(0, 1), cA + hstep, voffA);
        if (wr == 1) PG8_BAR;
        PG8_WAIT_V(4); PG8_BAR;
        PG8_STAGE(PG8_SB(1, 0), cB + kstep, voffB); PG8_STAGE(PG8_SA(1, 0), cA + kstep, voffA); PG8_STAGE(PG8_SB(1, 1), cB + hstep + kstep, voffB);
        PG8_WAIT_V(6); PG8_BAR;
    }
    for (;;) {
        const bool has_next = S.next(ui + 1, nxt);
        const char* nA = has_next ? (const char*)g.A + (size_t)nxt.pm * tstep : cA; const char* nB = has_next ? (const char*)g.Bt + (size_t)nxt.pb * tstep : cB;
        for (int t = 0; t < nt; t += 2) {
            const bool last = (t == nt - 2);
            const char* a1 = cA + (size_t)(t + 1) * kstep;
            const char* a2 = last ? nA : cA + (size_t)(t + 2) * kstep; const char* b2 = last ? nB : cB + (size_t)(t + 2) * kstep;
            const char* a3 = a2 + kstep; const char* b3 = b2 + kstep;
            if (last && has_next) S.a_ready(nxt);
            if constexpr (SP2) {
            PG8_LDB(B0, 0, 0); PG8_LDB(B1, 0, 1); PG8_SCHED; PG8_LDA(At, 0, 0); PG8_STAGE(PG8_SA(1, 1), a1 + hstep, voffA);
            PG8_WAIT_V(8); PG8_WAIT_L(0); PG8_BAR; PG8_MMA(0, 0, At, B0); PG8_MMA(0, 1, At, B1); PG8_BAR; PG8_SCHED;
            PG8_LDA(At, 0, 1); PG8_STAGE(PG8_SB(0, 0), b2, voffB); PG8_STAGE(PG8_SB(0, 1), b2 + hstep, voffB); PG8_STAGE(PG8_SA(0, 0), a2, voffA);
            PG8_WAIT_V(8); PG8_WAIT_L(0); PG8_BAR; PG8_MMA(1, 0, At, B0); PG8_MMA(1, 1, At, B1); PG8_BAR; PG8_SCHED;
            PG8_LDB(B0, 1, 0); PG8_LDB(B1, 1, 1); PG8_SCHED; PG8_LDA(At, 1, 0); PG8_STAGE(PG8_SA(0, 1), a2 + hstep, voffA);
            PG8_WAIT_V(8); PG8_WAIT_L(0); PG8_BAR; PG8_MMA(0, 0, At, B0); PG8_MMA(0, 1, At, B1); PG8_BAR; PG8_SCHED;
            PG8_LDA(At, 1, 1); PG8_STAGE(PG8_SB(1, 0), b3, voffB); PG8_STAGE(PG8_SB(1, 1), b3 + hstep, voffB); PG8_STAGE(PG8_SA(1, 0), a3, voffA);
            PG8_WAIT_V(8); PG8_WAIT_L(0); PG8_BAR; PG8_MMA(1, 0, At, B0); PG8_MMA(1, 1, At, B1); PG8_BAR; PG8_SCHED;
            } else {
            PG8_LDB(B0, 0, 0); PG8_SCHED; PG8_LDA(At, 0, 0); PG8_STAGE(PG8_SA(1, 1), a1 + hstep, voffA);
            PG8_WAIT_L(8); PG8_BAR; PG8_WAIT_L(0); PG8_MMA(0, 0, At, B0); PG8_BAR; PG8_SCHED;
            PG8_LDB(B1, 0, 1); PG8_STAGE(PG8_SB(0, 0), b2, voffB);
            PG8_BAR; PG8_WAIT_L(0); PG8_MMA(0, 1, At, B1); PG8_BAR;
            PG8_LDA(At, 0, 1); PG8_STAGE(PG8_SA(0, 0), a2, voffA);
            PG8_BAR; PG8_WAIT_L(0); PG8_MMA(1, 0, At, B0); PG8_BAR; PG8_SCHED;
            PG8_STAGE(PG8_SB(0, 1), b2 + hstep, voffB);
            PG8_WAIT_V(6); PG8_BAR; PG8_MMA(1, 1, At, B1); PG8_BAR;
            PG8_LDB(B0, 1, 0); PG8_SCHED; PG8_LDA(At, 1, 0); PG8_STAGE(PG8_SA(0, 1), a2 + hstep, voffA);
            PG8_WAIT_L(8); PG8_BAR; PG8_WAIT_L(0); PG8_MMA(0, 0, At, B0); PG8_BAR; PG8_SCHED;
            PG8_LDB(B1, 1, 1); PG8_STAGE(PG8_SB(1, 0), b3, voffB);
            PG8_BAR; PG8_WAIT_L(0); PG8_MMA(0, 1, At, B1); PG8_BAR;
            PG8_LDA(At, 1, 1); PG8_STAGE(PG8_SA(1, 0), a3, voffA);
            PG8_BAR; PG8_WAIT_L(0); PG8_MMA(1, 0, At, B0); PG8_BAR; PG8_SCHED;
            PG8_STAGE(PG8_SB(1, 1), b3 + hstep, voffB);
            PG8_WAIT_V(6); PG8_BAR; PG8_MMA(1, 1, At, B1); PG8_BAR;
            }
        }
        if constexpr (ALIGN_EPI) { if (wr == 0) PG8_BAR; }
        if constexpr (!Epi::AFTER_DRAIN) { E(acc, cur, wr, wc, fr, fq); S.done(cur); }
        if (!has_next) break;
#pragma unroll
        for (int a = 0; a < 2; ++a)
#pragma unroll
            for (int b = 0; b < 2; ++b)
#pragma unroll
                for (int m = 0; m < 4; ++m)
#pragma unroll
                    for (int n = 0; n < 2; ++n) acc[a][b][m][n] = (f32x4){0.f, 0.f, 0.f, 0.f};
        cur = nxt; cA = nA; cB = nB; ++ui;
        if constexpr (ALIGN_EPI) { if (wr == 1) PG8_BAR; }
    }
    PG8_WAIT_V(0);
    if constexpr (!ALIGN_EPI) { if (wr == 0) PG8_BAR; }
    PG8_BAR;
    if constexpr (Epi::AFTER_DRAIN) { E.fused(acc, cur, wr, wc, fr, fq, lds, wid, lane); S.done(cur); }
#undef PG8_SA
#undef PG8_SB
#undef PG8_STAGE
#undef PG8_LDA
#undef PG8_LDB
#undef PG8_MMA
#undef PG8_WAIT_V
#undef PG8_WAIT_L
#undef PG8_BAR
#undef PG8_SCHED
}
}
namespace pg8 {
typedef unsigned u32x2 __attribute__((ext_vector_type(2)));
__device__ __forceinline__ float ex2(float x) { return __builtin_amdgcn_exp2f(x); }
__device__ __forceinline__ float sigm(float x) { return __builtin_amdgcn_rcpf(1.0f + ex2(-1.4426950408889634f * x)); }
__device__ __forceinline__ float bflo(unsigned w) { return __uint_as_float(w << 16); }
__device__ __forceinline__ float bfhi(unsigned w) { return __uint_as_float(w & 0xffff0000u); }

struct EpiProj {
    static constexpr bool PERM = true, AFTER_DRAIN = false;
    bf16_t* O; int ldc; int sig_from;
    __device__ __forceinline__ void operator()(const f32x4 (&acc)[2][2][4][2], const Unit& u, int wr, int wc, int fr, int fq) const {
        const int row0 = u.pm * BM + wr * 64 + fr, col0 = u.pn * BM + wc * 32 + 8 * fq; const bool sg = u.pn >= sig_from;
#pragma unroll
        for (int ai = 0; ai < 2; ++ai)
#pragma unroll
            for (int m = 0; m < 4; ++m) { bf16_t* rowp = O + (size_t)(row0 + ai * HALF + m * 16) * ldc + col0;
#pragma unroll
                for (int bj = 0; bj < 2; ++bj) { f32x4 v0 = acc[ai][bj][m][0], v1 = acc[ai][bj][m][1];
                    if (sg) {
#pragma unroll
                        for (int j = 0; j < 4; ++j) { v0[j] = sigm(v0[j]); v1[j] = sigm(v1[j]); } }
                    u32x4 w; w.x = cvt_pk_bf16(v0[0], v0[1]); w.y = cvt_pk_bf16(v0[2], v0[3]); w.z = cvt_pk_bf16(v1[0], v1[1]); w.w = cvt_pk_bf16(v1[2], v1[3]);
                    *(u32x4*)(rowp + bj * HALF) = w; } }
    }
};
struct EpiSwiglu {
    static constexpr bool PERM = true, AFTER_DRAIN = false;
    bf16_t* O; int ldc;
    __device__ __forceinline__ void operator()(const f32x4 (&acc)[2][2][4][2], const Unit& u, int wr, int wc, int fr, int fq) const {
        const int row0 = u.pm * BM + wr * 64 + fr, col0 = u.pn * HALF + wc * 32 + 8 * fq;
#pragma unroll
        for (int ai = 0; ai < 2; ++ai)
#pragma unroll
            for (int m = 0; m < 4; ++m) { bf16_t* rowp = O + (size_t)(row0 + ai * HALF + m * 16) * ldc + col0;
                f32x4 v0, v1;
#pragma unroll
                for (int j = 0; j < 4; ++j) { const float a0 = acc[ai][0][m][0][j], a1 = acc[ai][0][m][1][j];
                    v0[j] = a0 * sigm(a0) * acc[ai][1][m][0][j]; v1[j] = a1 * sigm(a1) * acc[ai][1][m][1][j]; }
                u32x4 w; w.x = cvt_pk_bf16(v0[0], v0[1]); w.y = cvt_pk_bf16(v0[2], v0[3]); w.z = cvt_pk_bf16(v1[0], v1[1]); w.w = cvt_pk_bf16(v1[2], v1[3]);
                *(u32x4*)rowp = w; }
    }
};
struct EpiResid {
    static constexpr bool PERM = false, AFTER_DRAIN = false;
    const float* base; float* out; int ldc; const float* rowscale; int rs_ld;
    __device__ __forceinline__ void operator()(const f32x4 (&acc)[2][2][4][2], const Unit& u, int wr, int wc, int fr, int fq) const {
        const int col0 = u.pn * BM + wc * 32 + 4 * fq;
#pragma unroll
        for (int ai = 0; ai < 2; ++ai)
#pragma unroll
            for (int m = 0; m < 4; ++m) { const int r = u.pm * BM + ai * HALF + wr * 64 + m * 16 + fr; const size_t off = (size_t)r * ldc + col0;
                const float s = rowscale ? rowscale[(size_t)r * rs_ld] : 1.0f;
#pragma unroll
                for (int bj = 0; bj < 2; ++bj)
#pragma unroll
                    for (int n = 0; n < 2; ++n) { const f32x4 bs = *(const f32x4*)(base + off + bj * HALF + n * 16);
                        *(f32x4*)(out + off + bj * HALF + n * 16) = bs + acc[ai][bj][m][n] * s; } }
    }
};
struct EpiGate1 {
    static constexpr bool PERM = true, AFTER_DRAIN = false;
    const bf16_t* G; int ldg; float* T; int ldc;
    __device__ __forceinline__ void operator()(const f32x4 (&acc)[2][2][4][2], const Unit& u, int wr, int wc, int fr, int fq) const {
        const int row0 = u.pm * BM + wr * 64 + fr, col0 = u.pn * BM + wc * 32 + 8 * fq;
#pragma unroll
        for (int ai = 0; ai < 2; ++ai)
#pragma unroll
            for (int m = 0; m < 4; ++m) { const size_t r = (size_t)(row0 + ai * HALF + m * 16);
#pragma unroll
                for (int bj = 0; bj < 2; ++bj) { const u32x4 g = *(const u32x4*)(G + r * ldg + col0 + bj * HALF);
                    f32x4 g0 = {bflo(g.x), bfhi(g.x), bflo(g.y), bfhi(g.y)}, g1 = {bflo(g.z), bfhi(g.z), bflo(g.w), bfhi(g.w)};
                    float* tp = T + r * ldc + col0 + bj * HALF;
                    *(f32x4*)tp = g0 * acc[ai][bj][m][0]; *(f32x4*)(tp + 4) = g1 * acc[ai][bj][m][1]; } }
    }
};
struct EpiGate2 {
    static constexpr bool PERM = true, AFTER_DRAIN = false;
    const bf16_t* G; int ldg; const float* T; bf16_t* O; int ldc;
    __device__ __forceinline__ void operator()(const f32x4 (&acc)[2][2][4][2], const Unit& u, int wr, int wc, int fr, int fq) const {
        const int row0 = u.pm * BM + wr * 64 + fr, col0 = u.pn * BM + wc * 32 + 8 * fq;
#pragma unroll
        for (int ai = 0; ai < 2; ++ai)
#pragma unroll
            for (int m = 0; m < 4; ++m) { const size_t r = (size_t)(row0 + ai * HALF + m * 16);
#pragma unroll
                for (int bj = 0; bj < 2; ++bj) { const u32x4 g = *(const u32x4*)(G + r * ldg + col0 + bj * HALF);
                    f32x4 g0 = {bflo(g.x), bfhi(g.x), bflo(g.y), bfhi(g.y)}, g1 = {bflo(g.z), bfhi(g.z), bflo(g.w), bfhi(g.w)};
                    const float* tp = T + r * ldc + col0 + bj * HALF;
                    const f32x4 v0 = *(const f32x4*)tp + g0 * acc[ai][bj][m][0], v1 = *(const f32x4*)(tp + 4) + g1 * acc[ai][bj][m][1];
                    u32x4 w; w.x = cvt_pk_bf16(v0[0], v0[1]); w.y = cvt_pk_bf16(v0[2], v0[3]); w.z = cvt_pk_bf16(v1[0], v1[1]); w.w = cvt_pk_bf16(v1[2], v1[3]);
                    *(u32x4*)(O + r * ldc + col0 + bj * HALF) = w; } }
    }
};
struct EpiF32 {
    static constexpr bool PERM = false, AFTER_DRAIN = false;
    float* O; int ldc;
    __device__ __forceinline__ void operator()(const f32x4 (&acc)[2][2][4][2], const Unit& u, int wr, int wc, int fr, int fq) const {
        const int col0 = u.pn * BM + wc * 32 + 4 * fq;
#pragma unroll
        for (int ai = 0; ai < 2; ++ai)
#pragma unroll
            for (int m = 0; m < 4; ++m) { const size_t off = (size_t)(u.pm * BM + ai * HALF + wr * 64 + m * 16 + fr) * ldc + col0;
#pragma unroll
                for (int bj = 0; bj < 2; ++bj)
#pragma unroll
                    for (int n = 0; n < 2; ++n) *(f32x4*)(O + off + bj * HALF + n * 16) = acc[ai][bj][m][n]; }
    }
};
struct EpiPle2 {
    static constexpr bool PERM = false, AFTER_DRAIN = false;
    const float* PP; float* x; int ldc;
    __device__ __forceinline__ void operator()(const f32x4 (&acc)[2][2][4][2], const Unit& u, int wr, int wc, int fr, int fq) const {
        const int col0 = u.pn * BM + wc * 32 + 4 * fq;
#pragma unroll
        for (int ai = 0; ai < 2; ++ai)
#pragma unroll
            for (int m = 0; m < 4; ++m) { const size_t off = (size_t)(u.pm * BM + ai * HALF + wr * 64 + m * 16 + fr) * ldc + col0;
#pragma unroll
                for (int bj = 0; bj < 2; ++bj)
#pragma unroll
                    for (int n = 0; n < 2; ++n) { const f32x4 pp = *(const f32x4*)(PP + off + bj * HALF + n * 16), xo = *(const f32x4*)(x + off + bj * HALF + n * 16);
                        f32x4 a = acc[ai][bj][m][n];
#pragma unroll
                        for (int j = 0; j < 4; ++j) a[j] = sigm(a[j]);
                        *(f32x4*)(x + off + bj * HALF + n * 16) = xo + a * pp; } }
    }
};
}
#define GAS __attribute__((address_space(1)))
#define LAS __attribute__((address_space(3)))
typedef unsigned short bf16;
typedef unsigned v4u __attribute__((ext_vector_type(4)));
typedef float f32x4 __attribute__((ext_vector_type(4)));
typedef short bf16x8 __attribute__((ext_vector_type(8)));
typedef GAS unsigned gu32;
typedef GAS unsigned long long gu64;
#define RLX_AGENT __ATOMIC_RELAXED, __HIP_MEMORY_SCOPE_AGENT
#define LDS_WAIT() asm volatile("s_waitcnt lgkmcnt(0)" ::: "memory")
#define VM_WAIT() asm volatile("s_waitcnt vmcnt(0)" ::: "memory")
__device__ __forceinline__ unsigned long long rt() { return __builtin_amdgcn_s_memrealtime(); }
__device__ __forceinline__ unsigned f2bf(float f) { unsigned u = __builtin_bit_cast(unsigned, f); return (u + 0x7fffu + ((u >> 16) & 1u)) >> 16; }
__device__ __forceinline__ unsigned pk2(float lo, float hi) { return f2bf(lo) | (f2bf(hi) << 16); }

#define XB_TMO      128
#define XB_XCNT(j)  (256  + 64 * (j))
#define XB_XSUB(j)  (1280 + 64 * (j))
#define XB_XGEN(j)  (2304 + 64 * (j))
#define XB_TOP      3328
#define XB_TOPGEN   3392
#define XCD_BAR_WORDS 3456
#define XB_SPIN_CAP (1u << 18)

__device__ __forceinline__ unsigned xb_ld(unsigned* p)              { return __hip_atomic_load(p, __ATOMIC_RELAXED, __HIP_MEMORY_SCOPE_AGENT); }
__device__ __forceinline__ unsigned xb_add(unsigned* p, unsigned v) { return __hip_atomic_fetch_add(p, v, __ATOMIC_RELAXED, __HIP_MEMORY_SCOPE_AGENT); }
__device__ __forceinline__ unsigned xb_xcc_id() { return (unsigned)__builtin_amdgcn_s_getreg((3 << 11) | 20) & 0xFu; }
#define XB_SPIN(cond, bar) do { unsigned _sp = 0; while (cond) { __builtin_amdgcn_s_sleep(1); \
    if ((++_sp & 255u) == 0u) { if (xb_ld(&(bar)[XB_TMO])) break; if (_sp > XB_SPIN_CAP) { atomicAdd(&(bar)[XB_TMO], 1u); break; } } } } while (0)

struct XcdBarrier {
    unsigned* bar; unsigned x;
    volatile LAS unsigned* st;
};

__device__ __forceinline__ XcdBarrier xcd_barrier_post(unsigned* bar, volatile LAS unsigned* st) {
    XcdBarrier b; b.bar = bar; b.x = xb_xcc_id(); b.st = st;
    if (threadIdx.x == 0) (void)xb_add(&bar[XB_XCNT(b.x)], 1u);
    return b;
}
__device__ __forceinline__ void xcd_barrier_complete(unsigned* bar, unsigned x, unsigned& nloc, unsigned& nx) {
    const unsigned G = gridDim.x * gridDim.y * gridDim.z;
    unsigned sum, cnt, mine, sp = 0u;
    for (;;) {
        sum = 0u; cnt = 0u; mine = 0u;
#pragma unroll
        for (unsigned j = 0; j < 16; ++j) { const unsigned c = xb_ld(&bar[XB_XCNT(j)]); sum += c; cnt += (c > 0u) ? 1u : 0u; mine = (j == x) ? c : mine; }
        if (sum == G) break;
        __builtin_amdgcn_s_sleep(1);
        if ((++sp & 255u) == 0u) { if (xb_ld(&bar[XB_TMO])) break; if (sp > XB_SPIN_CAP) { atomicAdd(&bar[XB_TMO], 1u); break; } }
    }
    nloc = mine > 0u ? mine : 1u; nx = cnt > 0u ? cnt : 1u;
}

__device__ __forceinline__ void xcd_barrier(const XcdBarrier& b) {
    asm volatile("s_waitcnt vmcnt(0)" ::: "memory");
    __syncthreads();
    if (threadIdx.x == 0) {
        unsigned* bar = b.bar;
        __builtin_amdgcn_s_waitcnt(0);
        unsigned nloc = b.st[0], nx = b.st[1];
        if (nloc == 0u) { xcd_barrier_complete(bar, b.x, nloc, nx); b.st[0] = nloc; b.st[1] = nx; }
        const unsigned old = xb_add(&bar[XB_XSUB(b.x)], 1u);
        const unsigned gen = old / nloc;
        if (old + 1u == (gen + 1u) * nloc) {
            __builtin_amdgcn_fence(__ATOMIC_RELEASE, "agent");
            asm volatile("s_waitcnt vmcnt(0)" ::: "memory");
            const unsigned og = xb_add(&bar[XB_TOP], 1u);
            const unsigned tg = og / nx;
            if (og + 1u == (tg + 1u) * nx) xb_add(&bar[XB_TOPGEN], 1u);
            else XB_SPIN(xb_ld(&bar[XB_TOPGEN]) == tg, bar);
            __builtin_amdgcn_fence(__ATOMIC_ACQUIRE, "agent");
            xb_add(&bar[XB_XGEN(b.x)], 1u);
            asm volatile("s_waitcnt vmcnt(0)" ::: "memory");
        } else {
            XB_SPIN(xb_ld(&bar[XB_XGEN(b.x)]) == gen, bar);
            __builtin_amdgcn_fence(__ATOMIC_ACQUIRE, "agent");
            asm volatile("s_waitcnt vmcnt(0)" ::: "memory");
        }
    }
    __syncthreads();
}
constexpr int NWAVES = 8, NTHR = NWAVES * 64;
constexpr int BATCH = 4, SEQ = 4096, D = 1024, M = BATCH * SEQ, NIN = 5640, NPROJ = 5632, PLE = 256;
constexpr int DFF = 2816, NEXP = 8, DFFE = 3584, NLAYER = 2;
constexpr int AH = 8, AHD = 64, ABLK = 256, ANB = SEQ / ABLK;
constexpr int MH = 4, MDK = 128;
constexpr float RMS_EPS = 1e-6f;
constexpr float C2 = 0.125f * 1.4426950408889634f;
constexpr int PC_Q = 0, PC_K = 512, PC_V = 1024, PC_QKM = 1536, PC_VM = 2560, PC_OM = 3072, PC_GA = 3584, PC_GB = 4608;

constexpr size_t MiB = 1u << 20;
constexpr size_t WS_CTL = 0, CTL_ZERO_BYTES = 1 * MiB;
constexpr size_t WS_WIN = 1 * MiB, WS_WOA = 23 * MiB, WS_WOB = 25 * MiB, WS_WOUT = 27 * MiB, WS_WD13 = 31 * MiB, WS_WD2 = 42 * MiB, WS_WPG = 48 * MiB, WS_WPP = 52 * MiB, WS_PB = 53 * MiB;
constexpr size_t WS_WE = 69 * MiB;
constexpr size_t WS_SMALL = 153 * MiB;
constexpr size_t WS_IFPRE = WS_SMALL, WS_KMEAN = WS_SMALL + 1 * MiB, WS_GSEL = WS_SMALL + 2 * MiB;
constexpr size_t WS_HB = 161 * MiB, WS_QKC = 193 * MiB, WS_YA = 225 * MiB, WS_YB = 241 * MiB, WS_MIXED = 257 * MiB, WS_ST = 289 * MiB, WS_PROJ = 309 * MiB, WS_END = 485 * MiB;
constexpr size_t WS_TMP = WS_HB;
constexpr size_t WS_GH = WS_PROJ, WS_PP = WS_PROJ;
constexpr int CW_TMO = 0, CW_CODE = 1, CW_BAR = 4096;

constexpr int RING_OFF = 0, RING_BYTES = 131072;
constexpr int LDSCTL_OFF = RING_BYTES, MISC_OFF = LDSCTL_OFF + 320;
constexpr int LDS_BYTES = 147456;
struct Frame {
    LAS unsigned char* lds;
    volatile LAS unsigned* MISC;
    gu32* ctl;
    int tid, lane, wave;
    int vcu, G;
    unsigned char* ws;
};
__device__ __forceinline__ int opaque(int v) { asm volatile("" : "+v"(v)); return v; }
#define PHASE_LOCALS() const int tid = opaque(F.tid), lane = tid & 63; (void)lane
__device__ __forceinline__ float shx(float v, int o, int lane) { return __int_as_float(__builtin_amdgcn_ds_bpermute((lane ^ o) << 2, __float_as_int(v))); }
__device__ __forceinline__ float wave_sum(float v, int lane) {
#pragma unroll
    for (int o = 1; o < 64; o <<= 1) v += shx(v, o, lane);
    return v;
}
__device__ __forceinline__ float wave_max(float v, int lane) {
#pragma unroll
    for (int o = 1; o < 64; o <<= 1) v = fmaxf(v, shx(v, o, lane));
    return v;
}
__device__ __forceinline__ float bf2f(bf16 u) { return __uint_as_float((unsigned)u << 16); }
__device__ __forceinline__ float bflo(unsigned w) { return __uint_as_float(w << 16); }
__device__ __forceinline__ float bfhi(unsigned w) { return __uint_as_float(w & 0xffff0000u); }
__device__ __forceinline__ float sigm(float x) { return pg8::sigm(x); }

__device__ __forceinline__ void tr_item(const float* W, int ld, int K, int N, bf16* WT, int rowstep, int row_off, LAS float* scr, int item, int lane) {
    const int nblk = N / 32, kb = item / nblk, nb = item % nblk, k0 = 64 * kb, n0 = 32 * nb;
#pragma unroll 8
    for (int i = 0; i < 32; ++i) { const int kk = 2 * i + (lane >> 5); scr[kk * 33 + (lane & 31)] = W[(size_t)(k0 + kk) * ld + n0 + (lane & 31)]; }
    LDS_WAIT(); asm volatile("" ::: "memory");
    const int c = lane & 7;
#pragma unroll
    for (int j = 0; j < 4; ++j) { const int n = (lane >> 3) + 8 * j; const LAS float* s = scr + (8 * c) * 33 + n;
        v4u o; o.x = pk2(s[0 * 33], s[1 * 33]); o.y = pk2(s[2 * 33], s[3 * 33]); o.z = pk2(s[4 * 33], s[5 * 33]); o.w = pk2(s[6 * 33], s[7 * 33]);
        const int nn = n0 + n, drow = (nn >> 7) * rowstep + (nn & 127) + row_off;
        *(GAS v4u*)(WT + (size_t)drow * K + k0 + 8 * c) = o; }
    LDS_WAIT(); asm volatile("" ::: "memory");
}
struct TrJob { const float* W; int ld, K, N; bf16* WT; int rowstep, row_off; };
#define TRJOB(W_, ld_, K_, N_, WT_, rs_, ro_) if (!found) { const int I_ = ((K_) / 64) * ((N_) / 32); if (r < I_) { jb.W = (W_); jb.ld = (ld_); jb.K = (K_); jb.N = (N_); jb.WT = (WT_); jb.rowstep = (rs_); jb.row_off = (ro_); found = true; } else r -= I_; }

struct Inputs { const float* p[25]; };
enum { I_X = 0, I_P, I_GMIX, I_WIN, I_GQ, I_GK, I_CONVW, I_CONVB, I_BI, I_BF, I_GH, I_WOA, I_WOB, I_WOUT, I_GFFN, I_WD1, I_WD3, I_WD2, I_WR, I_WE1, I_WE3, I_WE2, I_GPLE, I_WPG, I_WPP };

__device__ __forceinline__ void p0_prologue(Frame& F, const Inputs& in) {
    PHASE_LOCALS();
    LAS float* scr = (LAS float*)(F.lds + RING_OFF + F.wave * 16384);
    const int gw = F.vcu * NWAVES + F.wave, NGW = F.G * NWAVES;
    constexpr int PER_LAYER = 16 * 112 + 16 * 64 + 2 * (8 * 32) + 2 * (16 * 32) + 4 * 32;
    constexpr int NITEMS = 2 * PER_LAYER + 2 * (16 * 88) + 44 * 32;
    for (int it = gw; it < NITEMS; it += NGW) {
        int r = it; bool found = false; TrJob jb;
        jb.W = nullptr; jb.ld = 0; jb.K = 64; jb.N = 32; jb.WT = nullptr; jb.rowstep = 128; jb.row_off = 0;
#pragma unroll
        for (int l = 0; l < 2; ++l) {
            TRJOB(in.p[I_WIN] + (size_t)l * D * NIN, NIN, D, 3584, (bf16*)(F.ws + WS_WIN) + (size_t)l * NPROJ * D, 128, 0)
            TRJOB(in.p[I_WIN] + (size_t)l * D * NIN + 3592, NIN, D, 2048, (bf16*)(F.ws + WS_WIN) + (size_t)l * NPROJ * D, 128, 3584)
            TRJOB(in.p[I_WOA] + (size_t)l * 512 * D, D, 512, D, (bf16*)(F.ws + WS_WOA) + (size_t)l * D * 512, 128, 0)
            TRJOB(in.p[I_WOB] + (size_t)l * 512 * D, D, 512, D, (bf16*)(F.ws + WS_WOB) + (size_t)l * D * 512, 128, 0)
            TRJOB(in.p[I_WOUT] + (size_t)l * D * D, D, D, D, (bf16*)(F.ws + WS_WOUT) + (size_t)l * D * D, 128, 0)
            TRJOB(in.p[I_WPG] + (size_t)l * D * D, D, D, D, (bf16*)(F.ws + WS_WPG) + (size_t)l * D * D, 128, 0)
            TRJOB(in.p[I_WPP] + (size_t)l * PLE * D, D, PLE, D, (bf16*)(F.ws + WS_WPP) + (size_t)l * D * PLE, 128, 0)
        }
        TRJOB(in.p[I_WD1], DFF, D, DFF, (bf16*)(F.ws + WS_WD13), 256, 0)
        TRJOB(in.p[I_WD3], DFF, D, DFF, (bf16*)(F.ws + WS_WD13), 256, 128)
        TRJOB(in.p[I_WD2], D, DFF, D, (bf16*)(F.ws + WS_WD2), 128, 0)
        if (found) tr_item(jb.W, jb.ld, jb.K, jb.N, jb.WT, jb.rowstep, jb.row_off, scr, r, lane);
    }
    const size_t n8 = (size_t)2 * M * PLE / 8;
    for (size_t i = (size_t)F.vcu * NTHR + tid; i < n8; i += (size_t)F.G * NTHR) {
        const f32x4 a = *(const f32x4*)(in.p[I_P] + i * 8), b = *(const f32x4*)(in.p[I_P] + i * 8 + 4);
        v4u o; o.x = pk2(a[0], a[1]); o.y = pk2(a[2], a[3]); o.z = pk2(b[0], b[1]); o.w = pk2(b[2], b[3]);
        *(v4u*)((bf16*)(F.ws + WS_PB) + i * 8) = o;
    }
}
__device__ __forceinline__ void p_conv_expert(Frame& F, const Inputs& in, int e) {
    PHASE_LOCALS();
    LAS float* scr = (LAS float*)(F.lds + RING_OFF + F.wave * 16384);
    const int gw = F.vcu * NWAVES + F.wave, NGW = F.G * NWAVES;
    constexpr int NITEMS = 2 * (16 * 112) + 56 * 32;
    bf16* W13 = (bf16*)(F.ws + WS_WE); bf16* W2 = W13 + (size_t)2 * DFFE * D;
    for (int it = gw; it < NITEMS; it += NGW) {
        int r = it; bool found = false; TrJob jb;
        jb.W = nullptr; jb.ld = 0; jb.K = 64; jb.N = 32; jb.WT = nullptr; jb.rowstep = 128; jb.row_off = 0;
        TRJOB(in.p[I_WE1] + (size_t)e * D * DFFE, DFFE, D, DFFE, W13, 256, 0)
        TRJOB(in.p[I_WE3] + (size_t)e * D * DFFE, DFFE, D, DFFE, W13, 256, 128)
        TRJOB(in.p[I_WE2] + (size_t)e * DFFE * D, D, DFFE, D, W2, 128, 0)
        if (found) tr_item(jb.W, jb.ld, jb.K, jb.N, jb.WT, jb.rowstep, jb.row_off, scr, r, lane);
    }
}

template <int MODE>
__device__ __forceinline__ void phase_norm(Frame& F, const float* xsrc, const float* g, bf16* hb, const float* wx, int ldw, const float* b_i, const float* b_f, float* ifpre, float* gsel) {
    PHASE_LOCALS();
    LAS float* wl = (LAS float*)F.lds;
    if (MODE != 0) {
        for (int i = tid; i < 1024 * 2; i += NTHR) { const int c = i >> 1, hlf = i & 1; *(LAS f32x4*)(wl + c * 8 + 4 * hlf) = *(const f32x4*)(wx + (size_t)c * ldw + 4 * hlf); }
        __syncthreads();
    }
    const int gw = F.vcu * NWAVES + F.wave, NGW = F.G * NWAVES;
    for (int m = gw; m < M; m += NGW) {
        const f32x4* xr = (const f32x4*)(xsrc + (size_t)m * D) + lane;
        f32x4 v[4]; float s = 0.f;
#pragma unroll
        for (int j = 0; j < 4; ++j) { v[j] = xr[64 * j]; s += (v[j][0] * v[j][0] + v[j][1] * v[j][1]) + (v[j][2] * v[j][2] + v[j][3] * v[j][3]); }
        const float rstd = 1.0f / sqrtf(wave_sum(s, lane) * (1.0f / D) + RMS_EPS);
        unsigned long long* o8 = (unsigned long long*)(hb + (size_t)m * D) + lane;
#pragma unroll
        for (int j = 0; j < 4; ++j) { const f32x4 gj = ((const f32x4*)g)[lane + 64 * j]; v[j] = v[j] * rstd * gj;
            o8[64 * j] = (unsigned long long)pk2(v[j][0], v[j][1]) | ((unsigned long long)pk2(v[j][2], v[j][3]) << 32); }
        if (MODE != 0) {
            float a[8];
#pragma unroll
            for (int k = 0; k < 8; ++k) a[k] = 0.f;
#pragma unroll
            for (int j = 0; j < 4; ++j)
#pragma unroll
                for (int q = 0; q < 4; ++q) { const int c = 4 * lane + 256 * j + q; const f32x4 w0 = *(const LAS f32x4*)(wl + c * 8), w1 = *(const LAS f32x4*)(wl + c * 8 + 4); const float y = v[j][q];
                    a[0] += y * w0[0]; a[1] += y * w0[1]; a[2] += y * w0[2]; a[3] += y * w0[3]; a[4] += y * w1[0]; a[5] += y * w1[1]; a[6] += y * w1[2]; a[7] += y * w1[3]; }
#pragma unroll
            for (int k = 0; k < 8; ++k) a[k] = wave_sum(a[k], lane);
            if (MODE == 1) {
                if (lane == 0) {
                    f32x4 o0 = {a[0] + b_i[0], a[1] + b_i[1], a[2] + b_i[2], a[3] + b_i[3]}, o1 = {a[4] + b_f[0], a[5] + b_f[1], a[6] + b_f[2], a[7] + b_f[3]};
                    *(f32x4*)(ifpre + (size_t)m * 8) = o0; *(f32x4*)(ifpre + (size_t)m * 8 + 4) = o1; }
            } else {
                int i1 = 0; float v1 = a[0];
#pragma unroll
                for (int k = 1; k < 8; ++k) if (a[k] > v1) { v1 = a[k]; i1 = k; }
                int i2 = -1; float v2 = -INFINITY;
#pragma unroll
                for (int k = 0; k < 8; ++k) if (k != i1 && a[k] > v2) { v2 = a[k]; i2 = k; }
                const float g1 = 1.0f / (1.0f + expf(v2 - v1)), g2 = 1.0f - g1;
                if (lane < 8) gsel[(size_t)m * 8 + lane] = (lane == i1) ? g1 : (lane == i2) ? g2 : 0.f;
            }
        }
    }
    if (MODE != 0) __syncthreads();
}

__device__ __forceinline__ void phase_prep(Frame& F, const Inputs& in, int l) {
    PHASE_LOCALS();
    bf16* PROJ = (bf16*)(F.ws + WS_PROJ); float* kmean = (float*)(F.ws + WS_KMEAN); bf16* QKC = (bf16*)(F.ws + WS_QKC);
    const float* gq = in.p[I_GQ] + l * AHD; const float* gk = in.p[I_GK] + l * AHD;
    LAS float* kt = (LAS float*)F.lds; LAS float* part = kt + 256 * 65;
    for (int u = F.vcu; u < (M / 256) * AH; u += F.G) {
        const int pm = u >> 3, h = u & 7, row = tid >> 1, hf = tid & 1; const size_t grow = (size_t)pm * 256 + row;
#pragma unroll
        for (int which = 0; which < 2; ++which) {
            bf16* ptr = PROJ + grow * NPROJ + (which ? PC_K : PC_Q) + h * AHD + hf * 32; const float* gg = (which ? gk : gq) + hf * 32;
            float v[32]; float ss = 0.f;
#pragma unroll
            for (int i = 0; i < 4; ++i) { const v4u w = *(const v4u*)(ptr + 8 * i);
                v[8 * i + 0] = bflo(w.x); v[8 * i + 1] = bfhi(w.x); v[8 * i + 2] = bflo(w.y); v[8 * i + 3] = bfhi(w.y); v[8 * i + 4] = bflo(w.z); v[8 * i + 5] = bfhi(w.z); v[8 * i + 6] = bflo(w.w); v[8 * i + 7] = bfhi(w.w); }
#pragma unroll
            for (int i = 0; i < 32; ++i) ss += v[i] * v[i];
            ss += shx(ss, 1, lane);
            const float r = (1.0f / sqrtf(ss * (1.0f / AHD) + RMS_EPS)) * (which ? 1.0f : C2);
#pragma unroll
            for (int i = 0; i < 32; ++i) v[i] = v[i] * r * gg[i];
            if (which) {
#pragma unroll
                for (int i = 0; i < 32; ++i) kt[row * 65 + hf * 32 + i] = v[i]; }
#pragma unroll
            for (int i = 0; i < 4; ++i) { v4u o; o.x = pk2(v[8 * i], v[8 * i + 1]); o.y = pk2(v[8 * i + 2], v[8 * i + 3]); o.z = pk2(v[8 * i + 4], v[8 * i + 5]); o.w = pk2(v[8 * i + 6], v[8 * i + 7]); *(v4u*)(ptr + 8 * i) = o; }
        }
        __syncthreads();
        { const int c = tid & 63, pt = tid >> 6; float s = 0.f;
            for (int i = 0; i < 32; ++i) s += kt[(pt * 32 + i) * 65 + c];
            part[pt * 64 + c] = s; }
        __syncthreads();
        if (tid < 64) { float tot = 0.f;
#pragma unroll
            for (int pt = 0; pt < 8; ++pt) tot += part[pt * 64 + tid];
            const int b = pm >> 4, n = pm & 15;
            kmean[(((size_t)(b * AH + h)) * ANB + n) * AHD + tid] = tot * (1.0f / ABLK); }
        __syncthreads();
    }
    const float* cw = in.p[I_CONVW] + (size_t)l * 4 * 1024; const float* cb = in.p[I_CONVB] + (size_t)l * 1024;
    for (size_t idx = (size_t)F.vcu * NTHR + tid; idx < (size_t)M * 128; idx += (size_t)F.G * NTHR) {
        const int r = (int)(idx >> 7), ch = (int)(idx & 127), c0 = ch * 8, t = r & (SEQ - 1);
        float a[8];
        { const f32x4 b0 = *(const f32x4*)(cb + c0), b1 = *(const f32x4*)(cb + c0 + 4); a[0] = b0[0]; a[1] = b0[1]; a[2] = b0[2]; a[3] = b0[3]; a[4] = b1[0]; a[5] = b1[1]; a[6] = b1[2]; a[7] = b1[3]; }
#pragma unroll
        for (int j = 0; j < 4; ++j) { const int tt = t - 3 + j;
            if (tt >= 0) { const v4u w = *(const v4u*)(PROJ + (size_t)(r - 3 + j) * NPROJ + PC_QKM + c0); const f32x4 w0 = *(const f32x4*)(cw + j * 1024 + c0), w1 = *(const f32x4*)(cw + j * 1024 + c0 + 4);
                a[0] += w0[0] * bflo(w.x); a[1] += w0[1] * bfhi(w.x); a[2] += w0[2] * bflo(w.y); a[3] += w0[3] * bfhi(w.y); a[4] += w1[0] * bflo(w.z); a[5] += w1[1] * bfhi(w.z); a[6] += w1[2] * bflo(w.w); a[7] += w1[3] * bfhi(w.w); } }
        const float sc = (c0 >= 512) ? 0.08838834764831845f : 1.0f;
#pragma unroll
        for (int k = 0; k < 8; ++k) a[k] = a[k] * sigm(a[k]) * sc;
        v4u o; o.x = pk2(a[0], a[1]); o.y = pk2(a[2], a[3]); o.z = pk2(a[4], a[5]); o.w = pk2(a[6], a[7]);
        *(v4u*)(QKC + (size_t)r * 1024 + c0) = o;
    }
}

__device__ __forceinline__ float dot64(const bf16* kr, const float (&q)[64]) {
    float a = 0.f;
#pragma unroll
    for (int i = 0; i < 8; ++i) { const v4u w = *(const v4u*)(kr + 8 * i);
        a += q[8 * i] * bflo(w.x) + q[8 * i + 1] * bfhi(w.x) + q[8 * i + 2] * bflo(w.y) + q[8 * i + 3] * bfhi(w.y) + q[8 * i + 4] * bflo(w.z) + q[8 * i + 5] * bfhi(w.z) + q[8 * i + 6] * bflo(w.w) + q[8 * i + 7] * bfhi(w.w); }
    return a;
}
__device__ __forceinline__ void phase_attn_naive(Frame& F) {
    const bf16* PROJ = (const bf16*)(F.ws + WS_PROJ); const float* kmean = (const float*)(F.ws + WS_KMEAN); bf16* YA = (bf16*)(F.ws + WS_YA);
    LAS float* sc = (LAS float*)F.lds + F.wave * 1088; LAS float* qs = sc + 1024;
    const int gw = F.vcu * NWAVES + F.wave, NGW = F.G * NWAVES, lane = opaque(F.tid) & 63;
    for (int item = gw; item < BATCH * AH * SEQ; item += NGW) {
        const int q = item & (SEQ - 1), bh = item >> 12, b = bh >> 3, h = bh & 7, blk = q >> 8;
        const size_t rb = (size_t)b * SEQ;
        qs[lane] = bf2f(PROJ[(rb + q) * NPROJ + PC_Q + h * AHD + lane]);
        asm volatile("s_waitcnt lgkmcnt(0)" ::: "memory");
        float qr[64];
#pragma unroll
        for (int i = 0; i < 16; ++i) { const f32x4 t = *(const LAS f32x4*)(qs + 4 * i); qr[4 * i] = t[0]; qr[4 * i + 1] = t[1]; qr[4 * i + 2] = t[2]; qr[4 * i + 3] = t[3]; }
        float gv = -INFINITY;
        if (lane < blk) { const float* km = kmean + ((size_t)bh * ANB + lane) * AHD; float a = 0.f;
#pragma unroll
            for (int i = 0; i < 16; ++i) { const f32x4 t = *(const f32x4*)(km + 4 * i); a += qr[4 * i] * t[0] + qr[4 * i + 1] * t[1] + qr[4 * i + 2] * t[2] + qr[4 * i + 3] * t[3]; }
            gv = a; }
        unsigned selmask = 0u;
        for (int s = 0; s < 3 && s < blk; ++s) { const float mx = wave_max(gv, lane); const unsigned long long bal = __ballot(gv == mx && lane < blk); const int idx = __ffsll((long long)bal) - 1;
            selmask |= 1u << idx; if (lane == idx) gv = -INFINITY; }
        int slot = 0;
        for (int n = 0; n < blk; ++n) if ((selmask >> n) & 1u) {
#pragma unroll
            for (int jj = 0; jj < 4; ++jj) { const int key = n * ABLK + lane + 64 * jj; sc[slot * 256 + lane + 64 * jj] = dot64(PROJ + (rb + key) * NPROJ + PC_K + h * AHD, qr); }
            ++slot; }
#pragma unroll
        for (int jj = 0; jj < 4; ++jj) { const int key = blk * ABLK + lane + 64 * jj; const float a = dot64(PROJ + (rb + key) * NPROJ + PC_K + h * AHD, qr); sc[slot * 256 + lane + 64 * jj] = (key > q) ? -INFINITY : a; }
        const int ntot = (slot + 1) * 256;
        asm volatile("s_waitcnt lgkmcnt(0)" ::: "memory");
        float mx = -INFINITY; for (int i = lane; i < ntot; i += 64) mx = fmaxf(mx, sc[i]); mx = wave_max(mx, lane);
        float sum = 0.f; for (int i = lane; i < ntot; i += 64) { const float p = pg8::ex2(sc[i] - mx); sc[i] = p; sum += p; } sum = wave_sum(sum, lane);
        asm volatile("s_waitcnt lgkmcnt(0)" ::: "memory");
        float o = 0.f; slot = 0;
        for (int n = 0; n < blk; ++n) if ((selmask >> n) & 1u) { const bf16* vp = PROJ + (rb + n * ABLK) * NPROJ + PC_V + h * AHD + lane;
            for (int j = 0; j < 256; ++j) o += sc[slot * 256 + j] * bf2f(vp[(size_t)j * NPROJ]);
            ++slot; }
        { const bf16* vp = PROJ + (rb + blk * ABLK) * NPROJ + PC_V + h * AHD + lane; const int je = q - blk * ABLK;
            for (int j = 0; j <= je; ++j) o += sc[slot * 256 + j] * bf2f(vp[(size_t)j * NPROJ]); }
        YA[(rb + q) * 512 + h * AHD + lane] = (bf16)f2bf(o / sum);
        asm volatile("s_waitcnt lgkmcnt(0)" ::: "memory");
    }
}

__device__ __forceinline__ void phase_mlstm_naive(Frame& F, const Inputs& in, int l) {
    if (blockIdx.x >= BATCH * MH) return;
    const bf16* PROJ = (const bf16*)(F.ws + WS_PROJ); const bf16* QKC = (const bf16*)(F.ws + WS_QKC); const float* ifpre = (const float*)(F.ws + WS_IFPRE); bf16* YB = (bf16*)(F.ws + WS_YB);
    const float* gh = in.p[I_GH] + l * MDK;
    const int bh = blockIdx.x, b = bh >> 2, h = bh & 3, tid = opaque(F.tid), lane = tid & 63, e = tid & 127, g = tid >> 7;
    LAS float* qs = (LAS float*)F.lds; LAS float* ks = qs + 16 * 128; LAS float* vs = ks + 16 * 128; LAS float* red = vs + 16 * 128; LAS float* redd = red + 16 * 4 * 128;
    LAS float* gi = redd + 64; LAS float* gf = gi + 16; LAS float* ms = gf + 16;
    float C[32], nn[32];
#pragma unroll
    for (int i = 0; i < 32; ++i) { C[i] = 0.f; nn[i] = 0.f; }
    float m = 0.f;
    for (int t0 = 0; t0 < SEQ; t0 += 16) {
        for (int i = tid; i < 16 * 128; i += NTHR) { const int st = i >> 7, d = i & 127; const size_t r = (size_t)b * SEQ + t0 + st;
            qs[i] = bf2f(QKC[r * 1024 + h * MDK + d]); ks[i] = bf2f(QKC[r * 1024 + 512 + h * MDK + d]); vs[i] = bf2f(PROJ[r * NPROJ + PC_VM + h * MDK + d]); }
        if (tid < 16) { const size_t r = (size_t)b * SEQ + t0 + tid; gi[tid] = ifpre[r * 8 + h]; const float x = ifpre[r * 8 + 4 + h]; gf[tid] = fminf(x, 0.f) - log1pf(expf(-fabsf(x))); }
        __syncthreads();
        for (int st = 0; st < 16; ++st) {
            const float li = gi[st], lf = gf[st], mn = fmaxf(lf + m, li), wC = expf(lf + m - mn), wS = expf(li - mn); m = mn;
            const float ve = vs[st * 128 + e]; float pn = 0.f, pd = 0.f;
#pragma unroll
            for (int i4 = 0; i4 < 8; ++i4) { const f32x4 k4 = *(const LAS f32x4*)(ks + st * 128 + 32 * g + 4 * i4), q4 = *(const LAS f32x4*)(qs + st * 128 + 32 * g + 4 * i4);
#pragma unroll
                for (int j = 0; j < 4; ++j) { const int i = 4 * i4 + j; const float kd = wS * k4[j]; C[i] = wC * C[i] + kd * ve; nn[i] = wC * nn[i] + kd; pn += q4[j] * C[i]; pd += q4[j] * nn[i]; } }
            red[(st * 4 + g) * 128 + e] = pn; if (e == 0) redd[st * 4 + g] = pd; if (tid == 0) ms[st] = mn;
        }
        __syncthreads();
#pragma unroll
        for (int s2 = 0; s2 < 2; ++s2) { const int st = 2 * F.wave + s2; const float den = (redd[st * 4] + redd[st * 4 + 1]) + (redd[st * 4 + 2] + redd[st * 4 + 3]);
            const float dn = 1.0f / fmaxf(fabsf(den), expf(-ms[st]));
            const float h0 = ((red[(st * 4) * 128 + lane] + red[(st * 4 + 1) * 128 + lane]) + (red[(st * 4 + 2) * 128 + lane] + red[(st * 4 + 3) * 128 + lane])) * dn;
            const float h1 = ((red[(st * 4) * 128 + 64 + lane] + red[(st * 4 + 1) * 128 + 64 + lane]) + (red[(st * 4 + 2) * 128 + 64 + lane] + red[(st * 4 + 3) * 128 + 64 + lane])) * dn;
            const float rr = 1.0f / sqrtf(wave_sum(h0 * h0 + h1 * h1, lane) * (1.0f / MDK) + RMS_EPS);
            const size_t r = (size_t)b * SEQ + t0 + st;
            const float o0 = sigm(bf2f(PROJ[r * NPROJ + PC_OM + h * MDK + lane])), o1 = sigm(bf2f(PROJ[r * NPROJ + PC_OM + h * MDK + 64 + lane]));
            YB[r * 512 + h * MDK + lane] = (bf16)f2bf(h0 * rr * gh[lane] * o0); YB[r * 512 + h * MDK + 64 + lane] = (bf16)f2bf(h1 * rr * gh[64 + lane] * o1); }
        __syncthreads();
    }
}
struct Args { Inputs in; float* out; unsigned char* ws; int ph_lo, ph_hi, li, pad; };
#ifndef MK_PER_PHASE
#define MK_PER_PHASE 0
#endif
constexpr int MAX_LAUNCH = 64;

__global__ void __launch_bounds__(NTHR, 2) mega_fwd(Args args) {
    extern __shared__ __attribute__((aligned(16))) unsigned char lds[];
    Frame F;
    F.lds = (LAS unsigned char*)lds;
    F.MISC = (volatile LAS unsigned*)(F.lds + MISC_OFF);
    F.tid = threadIdx.x; F.lane = F.tid & 63; F.wave = __builtin_amdgcn_readfirstlane(F.tid >> 6);
    F.G = gridDim.x; { const int bx = blockIdx.x; F.vcu = (F.G % 8 == 0) ? (bx % 8) * (F.G / 8) + bx / 8 : bx; }
    F.ws = args.ws; F.ctl = (gu32*)(args.ws + WS_CTL);
    const Inputs& in = args.in;
    for (int u = F.tid; u < (LDS_BYTES - LDSCTL_OFF) / 4; u += NTHR) ((LAS unsigned*)(F.lds + LDSCTL_OFF))[u] = 0u;
    __syncthreads();
    XcdBarrier bar = xcd_barrier_post((unsigned*)(F.ctl + CW_BAR) + args.li * XCD_BAR_WORDS, F.MISC + 8);
    const int lo = args.ph_lo, hi = args.ph_hi;
    int ph = 0;
__attribute__((unused)) auto phq = [](int p) { asm volatile("" : "+s"(p)); return p; };
#define RUN() (lo <= phq(ph) && phq(ph) < hi)
#define SEAM() do { if (lo <= phq(ph) && phq(ph) + 1 < hi) xcd_barrier(bar); ++ph; } while (0)
    bf16* const HB = (bf16*)(F.ws + WS_HB); bf16* const PROJ = (bf16*)(F.ws + WS_PROJ); bf16* const YA = (bf16*)(F.ws + WS_YA); bf16* const YB = (bf16*)(F.ws + WS_YB);
    bf16* const MIXED = (bf16*)(F.ws + WS_MIXED); float* const TMP = (float*)(F.ws + WS_TMP); bf16* const GH = (bf16*)(F.ws + WS_GH); float* const PP = (float*)(F.ws + WS_PP);
    float* const IFPRE = (float*)(F.ws + WS_IFPRE); float* const GSEL = (float*)(F.ws + WS_GSEL);
    float* const X = args.out;


#ifndef SK_P0
        if (RUN()) p0_prologue(F, in);
#endif

    SEAM();
    { constexpr int l = 0;
        const float* xs = (l == 0) ? in.p[I_X] : X;

#ifndef SK_NORM
        if (RUN()) phase_norm<1>(F, xs, in.p[I_GMIX] + l * D, HB, in.p[I_WIN] + (size_t)l * D * NIN + 3584, NIN, in.p[I_BI] + l * MH, in.p[I_BF] + l * MH, IFPRE, nullptr);
#endif
        SEAM();
        if (RUN()) { pg8::Gemm g{HB, (const bf16*)(F.ws + WS_WIN) + (size_t)l * NPROJ * D, M, NPROJ, D}; pg8::StaticOrder S; S.init(M, NPROJ, F.G, (int)blockIdx.x);
            pg8::EpiProj E{PROJ, NPROJ, PC_GA / 256};
            pg8::gemm_phase<pg8::EpiProj, pg8::StaticOrder, true, true>(F.lds + RING_OFF, g, S, E); }
        SEAM();

#ifndef SK_PREP
        if (RUN()) phase_prep(F, in, l);
#endif

        SEAM();

#ifndef SK_ATTN
        if (RUN()) phase_attn_naive(F);
#endif

        SEAM();

#ifndef SK_MLSTM
        if (RUN()) phase_mlstm_naive(F, in, l);
#endif

        SEAM();
        if (RUN()) {
            { pg8::Gemm g{YA, (const bf16*)(F.ws + WS_WOA) + (size_t)l * D * 512, M, D, 512}; pg8::StaticOrder S; S.init(M, D, F.G, (int)blockIdx.x);
              pg8::EpiGate1 E{PROJ + PC_GA, NPROJ, TMP, D};
              pg8::gemm_phase<pg8::EpiGate1, pg8::StaticOrder, true, true>(F.lds + RING_OFF, g, S, E); }
            { pg8::Gemm g{YB, (const bf16*)(F.ws + WS_WOB) + (size_t)l * D * 512, M, D, 512}; pg8::StaticOrder S; S.init(M, D, F.G, (int)blockIdx.x);
              pg8::EpiGate2 E{PROJ + PC_GB, NPROJ, TMP, MIXED, D};
              pg8::gemm_phase<pg8::EpiGate2, pg8::StaticOrder, true, true>(F.lds + RING_OFF, g, S, E); }
        }
        SEAM();
        if (RUN()) { pg8::Gemm g{MIXED, (const bf16*)(F.ws + WS_WOUT) + (size_t)l * D * D, M, D, D}; pg8::StaticOrder S; S.init(M, D, F.G, (int)blockIdx.x);
            pg8::EpiResid E{xs, X, D, nullptr, 0};
            pg8::gemm_phase<pg8::EpiResid, pg8::StaticOrder, true, true>(F.lds + RING_OFF, g, S, E); }
        SEAM();
        if (l == 0) {
            if (RUN()) phase_norm<0>(F, X, in.p[I_GFFN] + l * D, HB, nullptr, 0, nullptr, nullptr, nullptr, nullptr);
            SEAM();
            if (RUN()) { pg8::Gemm g{HB, (const bf16*)(F.ws + WS_WD13), M, 2 * DFF, D}; pg8::StaticOrder S; S.init(M, 2 * DFF, F.G, (int)blockIdx.x);
                pg8::EpiSwiglu E{GH, DFF};
                pg8::gemm_phase<pg8::EpiSwiglu, pg8::StaticOrder, true, true>(F.lds + RING_OFF, g, S, E); }
            SEAM();
            if (RUN()) { pg8::Gemm g{GH, (const bf16*)(F.ws + WS_WD2), M, D, DFF}; pg8::StaticOrder S; S.init(M, D, F.G, (int)blockIdx.x);
                pg8::EpiResid E{X, X, D, nullptr, 0};
                pg8::gemm_phase<pg8::EpiResid, pg8::StaticOrder, true, true>(F.lds + RING_OFF, g, S, E); }
            SEAM();
        } else {
            if (RUN()) phase_norm<2>(F, X, in.p[I_GFFN] + l * D, HB, in.p[I_WR], NEXP, nullptr, nullptr, nullptr, GSEL);
            SEAM();
            for (int e = 0; e < NEXP; ++e) {

#ifndef SK_CONVE
        if (RUN()) p_conv_expert(F, in, e);
#endif

                SEAM();
                if (RUN()) { pg8::Gemm g{HB, (const bf16*)(F.ws + WS_WE), M, 2 * DFFE, D}; pg8::StaticOrder S; S.init(M, 2 * DFFE, F.G, (int)blockIdx.x);
                    pg8::EpiSwiglu E{GH, DFFE};
                    pg8::gemm_phase<pg8::EpiSwiglu, pg8::StaticOrder, true, true>(F.lds + RING_OFF, g, S, E); }
                SEAM();
                if (RUN()) { pg8::Gemm g{GH, (const bf16*)(F.ws + WS_WE) + (size_t)2 * DFFE * D, M, D, DFFE}; pg8::StaticOrder S; S.init(M, D, F.G, (int)blockIdx.x);
                    pg8::EpiResid E{X, X, D, GSEL + e, NEXP};
                    pg8::gemm_phase<pg8::EpiResid, pg8::StaticOrder, true, true>(F.lds + RING_OFF, g, S, E); }
                SEAM();
            }
        }
        if (RUN()) phase_norm<0>(F, X, in.p[I_GPLE] + l * D, HB, nullptr, 0, nullptr, nullptr, nullptr, nullptr);
        SEAM();
        if (RUN()) {
            { pg8::Gemm g{(const bf16*)(F.ws + WS_PB) + (size_t)l * M * PLE, (const bf16*)(F.ws + WS_WPP) + (size_t)l * D * PLE, M, D, PLE}; pg8::StaticOrder S; S.init(M, D, F.G, (int)blockIdx.x);
              pg8::EpiF32 E{PP, D};
              pg8::gemm_phase<pg8::EpiF32, pg8::StaticOrder, true, true>(F.lds + RING_OFF, g, S, E); }
            { pg8::Gemm g{HB, (const bf16*)(F.ws + WS_WPG) + (size_t)l * D * D, M, D, D}; pg8::StaticOrder S; S.init(M, D, F.G, (int)blockIdx.x);
              pg8::EpiPle2 E{PP, X, D};
              pg8::gemm_phase<pg8::EpiPle2, pg8::StaticOrder, true, true>(F.lds + RING_OFF, g, S, E); }
        }
        SEAM();
    }
    { constexpr int l = 1;
        const float* xs = (l == 0) ? in.p[I_X] : X;

#ifndef SK_NORM
        if (RUN()) phase_norm<1>(F, xs, in.p[I_GMIX] + l * D, HB, in.p[I_WIN] + (size_t)l * D * NIN + 3584, NIN, in.p[I_BI] + l * MH, in.p[I_BF] + l * MH, IFPRE, nullptr);
#endif
        SEAM();
        if (RUN()) { pg8::Gemm g{HB, (const bf16*)(F.ws + WS_WIN) + (size_t)l * NPROJ * D, M, NPROJ, D}; pg8::StaticOrder S; S.init(M, NPROJ, F.G, (int)blockIdx.x);
            pg8::EpiProj E{PROJ, NPROJ, PC_GA / 256};
            pg8::gemm_phase<pg8::EpiProj, pg8::StaticOrder, true, true>(F.lds + RING_OFF, g, S, E); }
        SEAM();

#ifndef SK_PREP
        if (RUN()) phase_prep(F, in, l);
#endif

        SEAM();

#ifndef SK_ATTN
        if (RUN()) phase_attn_naive(F);
#endif

        SEAM();

#ifndef SK_MLSTM
        if (RUN()) phase_mlstm_naive(F, in, l);
#endif

        SEAM();
        if (RUN()) {
            { pg8::Gemm g{YA, (const bf16*)(F.ws + WS_WOA) + (size_t)l * D * 512, M, D, 512}; pg8::StaticOrder S; S.init(M, D, F.G, (int)blockIdx.x);
              pg8::EpiGate1 E{PROJ + PC_GA, NPROJ, TMP, D};
              pg8::gemm_phase<pg8::EpiGate1, pg8::StaticOrder, true, true>(F.lds + RING_OFF, g, S, E); }
            { pg8::Gemm g{YB, (const bf16*)(F.ws + WS_WOB) + (size_t)l * D * 512, M, D, 512}; pg8::StaticOrder S; S.init(M, D, F.G, (int)blockIdx.x);
              pg8::EpiGate2 E{PROJ + PC_GB, NPROJ, TMP, MIXED, D};
              pg8::gemm_phase<pg8::EpiGate2, pg8::StaticOrder, true, true>(F.lds + RING_OFF, g, S, E); }
        }
        SEAM();
        if (RUN()) { pg8::Gemm g{MIXED, (const bf16*)(F.ws + WS_WOUT) + (size_t)l * D * D, M, D, D}; pg8::StaticOrder S; S.init(M, D, F.G, (int)blockIdx.x);
            pg8::EpiResid E{xs, X, D, nullptr, 0};
            pg8::gemm_phase<pg8::EpiResid, pg8::StaticOrder, true, true>(F.lds + RING_OFF, g, S, E); }
        SEAM();
        if (l == 0) {
            if (RUN()) phase_norm<0>(F, X, in.p[I_GFFN] + l * D, HB, nullptr, 0, nullptr, nullptr, nullptr, nullptr);
            SEAM();
            if (RUN()) { pg8::Gemm g{HB, (const bf16*)(F.ws + WS_WD13), M, 2 * DFF, D}; pg8::StaticOrder S; S.init(M, 2 * DFF, F.G, (int)blockIdx.x);
                pg8::EpiSwiglu E{GH, DFF};
                pg8::gemm_phase<pg8::EpiSwiglu, pg8::StaticOrder, true, true>(F.lds + RING_OFF, g, S, E); }
            SEAM();
            if (RUN()) { pg8::Gemm g{GH, (const bf16*)(F.ws + WS_WD2), M, D, DFF}; pg8::StaticOrder S; S.init(M, D, F.G, (int)blockIdx.x);
                pg8::EpiResid E{X, X, D, nullptr, 0};
                pg8::gemm_phase<pg8::EpiResid, pg8::StaticOrder, true, true>(F.lds + RING_OFF, g, S, E); }
            SEAM();
        } else {
            if (RUN()) phase_norm<2>(F, X, in.p[I_GFFN] + l * D, HB, in.p[I_WR], NEXP, nullptr, nullptr, nullptr, GSEL);
            SEAM();
            for (int e = 0; e < NEXP; ++e) {

#ifndef SK_CONVE
        if (RUN()) p_conv_expert(F, in, e);
#endif

                SEAM();
                if (RUN()) { pg8::Gemm g{HB, (const bf16*)(F.ws + WS_WE), M, 2 * DFFE, D}; pg8::StaticOrder S; S.init(M, 2 * DFFE, F.G, (int)blockIdx.x);
                    pg8::EpiSwiglu E{GH, DFFE};
                    pg8::gemm_phase<pg8::EpiSwiglu, pg8::StaticOrder, true, true>(F.lds + RING_OFF, g, S, E); }
                SEAM();
                if (RUN()) { pg8::Gemm g{GH, (const bf16*)(F.ws + WS_WE) + (size_t)2 * DFFE * D, M, D, DFFE}; pg8::StaticOrder S; S.init(M, D, F.G, (int)blockIdx.x);
                    pg8::EpiResid E{X, X, D, GSEL + e, NEXP};
                    pg8::gemm_phase<pg8::EpiResid, pg8::StaticOrder, true, true>(F.lds + RING_OFF, g, S, E); }
                SEAM();
            }
        }
        if (RUN()) phase_norm<0>(F, X, in.p[I_GPLE] + l * D, HB, nullptr, 0, nullptr, nullptr, nullptr, nullptr);
        SEAM();
        if (RUN()) {
            { pg8::Gemm g{(const bf16*)(F.ws + WS_PB) + (size_t)l * M * PLE, (const bf16*)(F.ws + WS_WPP) + (size_t)l * D * PLE, M, D, PLE}; pg8::StaticOrder S; S.init(M, D, F.G, (int)blockIdx.x);
              pg8::EpiF32 E{PP, D};
              pg8::gemm_phase<pg8::EpiF32, pg8::StaticOrder, true, true>(F.lds + RING_OFF, g, S, E); }
            { pg8::Gemm g{HB, (const bf16*)(F.ws + WS_WPG) + (size_t)l * D * D, M, D, D}; pg8::StaticOrder S; S.init(M, D, F.G, (int)blockIdx.x);
              pg8::EpiPle2 E{PP, X, D};
              pg8::gemm_phase<pg8::EpiPle2, pg8::StaticOrder, true, true>(F.lds + RING_OFF, g, S, E); }
        }
        SEAM();
    }
#undef RUN
#undef SEAM
}
constexpr int N_PHASES = 1 + (7 + 3 + 2) + (7 + 1 + 3 * NEXP + 2);

extern "C" void kernel_launch(void* const* d_in, const int* in_sizes, int n_in, void* d_out, int out_size, void* d_ws, size_t ws_size, hipStream_t stream) {
    static int grid = 0;
    if (grid == 0) {
        if (n_in != 25 || in_sizes[0] != M * D || out_size != M * D || ws_size < WS_END) { fprintf(stderr, "kernel_launch: unexpected shapes / workspace (n_in %d, ws %zu); nothing launched\n", n_in, ws_size); grid = -1; return; }
        int dev = 0, cus = 0, per_cu = 0;
        if (hipGetDevice(&dev) != hipSuccess || hipDeviceGetAttribute(&cus, hipDeviceAttributeMultiprocessorCount, dev) != hipSuccess) { grid = -1; return; }
        if (hipFuncSetAttribute((const void*)mega_fwd, hipFuncAttributeMaxDynamicSharedMemorySize, LDS_BYTES) != hipSuccess) { grid = -1; return; }
        if (hipOccupancyMaxActiveBlocksPerMultiprocessor(&per_cu, (const void*)mega_fwd, NTHR, LDS_BYTES) != hipSuccess || per_cu < 1) { fprintf(stderr, "kernel_launch: occupancy query reports %d\n", per_cu); }
        (void)hipGetLastError();
        grid = cus;
    }
    if (grid < 0) return;
    if (hipMemsetAsync((char*)d_ws + WS_CTL, 0, CTL_ZERO_BYTES, stream) != hipSuccess) return;
    Args a{};
    for (int i = 0; i < 25; ++i) a.in.p[i] = (const float*)d_in[i];
    a.out = (float*)d_out; a.ws = (unsigned char*)d_ws;
#if MK_PER_PHASE
    for (int li = 0; li < N_PHASES; ++li) { a.ph_lo = li; a.ph_hi = li + 1; a.li = 0; hipLaunchKernelGGL(mega_fwd, dim3(grid), dim3(NTHR), LDS_BYTES, stream, a); }
#else
    a.ph_lo = 0; a.ph_hi = N_PHASES; a.li = 0;
    hipLaunchKernelGGL(mega_fwd, dim3(grid), dim3(NTHR), LDS_BYTES, stream, a);
#endif
}
```

```cpp
#include <hip/hip_runtime.h>
#include <cstdio>
#include <cstdint>
#include <cmath>
namespace pg8 {
#define PG8_LAS __attribute__((address_space(3)))
typedef unsigned short bf16_t;
typedef short bf16x8 __attribute__((ext_vector_type(8)));
typedef float f32x4 __attribute__((ext_vector_type(4)));
typedef unsigned u32x4 __attribute__((ext_vector_type(4)));
typedef int v8i32 __attribute__((ext_vector_type(8)));
typedef int v4i32 __attribute__((ext_vector_type(4)));
constexpr int BM = 256, BK = 64, HALF = 128, HTB = HALF * BK * 2  , STAGE_BYTES = 8 * HTB, NXCD = 8, WGM = 8;

__host__ __device__ __forceinline__ int lds_byte(int r, int c) { const int st = (r >> 4) * 2 + (c >> 5), rr = r & 15, cc = c & 31, ob = rr * 64 + cc * 2; return st * 1024 + (ob ^ (((ob >> 9) & 1) << 5)); }
__host__ __device__ __forceinline__ void stage_rc(int b, int& R, int& C) { const int st = b / 1024, sb = b % 1024, swz = sb ^ (((sb >> 9) & 1) << 5); R = (st >> 1) * 16 + swz / 64; C = (st & 1) * 32 + (swz % 64) / 2; }
__host__ __device__ __forceinline__ int perm32(int rho) { const int n = rho >> 4, i = rho & 15; return 8 * (i >> 2) + 4 * n + (i & 3); }

struct Unit { int pm, pn, pb; };
struct Gemm { const bf16_t* A; const bf16_t* Bt; int M, N, K; };

struct StaticOrder {
    int nM, nN, nwg, G, c;
    __host__ __device__ void init(int M, int N, int G_, int c_) { nM = M / BM; nN = N / BM; nwg = nM * nN; G = G_; c = c_; }
    __host__ __device__ bool next(int i, Unit& u) const {
        const long L = (long)i * G + c; if (L >= nwg) return false;
        int wgid = (int)L; { const int q = nwg / NXCD, r = nwg % NXCD, xcd = wgid % NXCD, off = wgid / NXCD; wgid = (xcd < r ? xcd * (q + 1) : r * (q + 1) + (xcd - r) * q) + off; }
        const int nig = WGM * nN, gid = wgid / nig, fm = gid * WGM, gsz = (nM - fm) < WGM ? (nM - fm) : WGM;
        u.pm = fm + ((wgid % nig) % gsz); u.pn = (wgid % nig) / gsz; u.pb = u.pn; return true;
    }
    __device__ __forceinline__ void a_ready(const Unit&) const {}
    __device__ __forceinline__ void done(const Unit&) const {}
};

__device__ __forceinline__ unsigned cvt_pk_bf16(float lo, float hi) { unsigned r; asm volatile("v_cvt_pk_bf16_f32 %0, %1, %2" : "=v"(r) : "v"(lo), "v"(hi)); return r; }
template <class Epi, class Sched, bool ALIGN_EPI = false, bool SP2 = false, bool F8 = false>
__device__ __forceinline__ void gemm_phase(PG8_LAS unsigned char* lds, const Gemm g, const Sched& S, const Epi& E, int wave_in) {
    int tid_; asm volatile("v_mbcnt_lo_u32_b32 %0, -1, 0\n\tv_mbcnt_hi_u32_b32 %0, -1, %0" : "=v"(tid_)); tid_ += 64 * wave_in;
    const int tid = tid_, wid = __builtin_amdgcn_readfirstlane(tid >> 6), lane = tid & 63, wr = wid >> 2, wc = wid & 3, fr = lane & 15, fq = lane >> 4;
    const int K = g.K, nt = K / BK;
    unsigned voffA[2], voffB[2];
#pragma unroll
    for (int i = 0; i < 2; ++i) { int R, C; stage_rc(tid * 16 + i * 8192, R, C); const int Rb = Epi::PERM ? ((R & ~31) + perm32(R & 31)) : R;
        voffA[i] = (unsigned)(R * K + C) * 2u; voffB[i] = (unsigned)(Rb * K + C) * 2u; }
    const size_t kstep = (size_t)(BK * 2);
    const size_t hstep = (size_t)HALF * K * 2;
    const size_t tstep = 2 * hstep;
    const unsigned ldsw = (unsigned)wid * 1024u;
    const int aoff = lds_byte(wr * 64 + fr, fq * 8), boff = lds_byte(wc * 32 + fr, fq * 8);
    const int aofk0 = F8 ? lds_byte(wr * 64 + fr, 16 * fq) : aoff, aofk1 = F8 ? lds_byte(wr * 64 + fr, 16 * fq + 8) : aoff + 1024, bofk0 = F8 ? lds_byte(wc * 32 + fr, 16 * fq) : boff, bofk1 = F8 ? lds_byte(wc * 32 + fr, 16 * fq + 8) : boff + 1024;
#define PG8_SA(b, h) (((b) * 2 + (h)) * HTB)
#define PG8_SB(b, h) ((4 + (b) * 2 + (h)) * HTB)
#define PG8_STAGE(bufoff, gbase, voff) do { _Pragma("unroll") for (int _i = 0; _i < 2; ++_i) \
        __builtin_amdgcn_global_load_lds((const unsigned*)((const char*)(gbase) + (voff)[_i]), (PG8_LAS unsigned*)(lds + (bufoff) + ldsw + _i * 8192), 16, 0, 0); } while (0)
#define PG8_LDA(dst, b, h) do { if constexpr (F8) { _Pragma("unroll") for (int m = 0; m < 4; ++m) { dst##8[m].lo = *(const PG8_LAS v4i32*)(lds + PG8_SA(b, h) + aofk0 + m * 2048); dst##8[m].hi = *(const PG8_LAS v4i32*)(lds + PG8_SA(b, h) + aofk1 + m * 2048); } } \
        else { _Pragma("unroll") for (int m = 0; m < 4; ++m) _Pragma("unroll") for (int k = 0; k < 2; ++k) dst[m][k] = *(const PG8_LAS bf16x8*)(lds + PG8_SA(b, h) + (k ? aofk1 : aofk0) + m * 2048); } } while (0)
#define PG8_LDB(dst, b, h) do { if constexpr (F8) { _Pragma("unroll") for (int n = 0; n < 2; ++n) { dst##8[n].lo = *(const PG8_LAS v4i32*)(lds + PG8_SB(b, h) + bofk0 + n * 2048); dst##8[n].hi = *(const PG8_LAS v4i32*)(lds + PG8_SB(b, h) + bofk1 + n * 2048); } } \
        else { _Pragma("unroll") for (int n = 0; n < 2; ++n) _Pragma("unroll") for (int k = 0; k < 2; ++k) dst[n][k] = *(const PG8_LAS bf16x8*)(lds + PG8_SB(b, h) + (k ? bofk1 : bofk0) + n * 2048); } } while (0)
#define PG8_MMA(ai, bj, At, Bt) do { __builtin_amdgcn_s_setprio(1); \
        if constexpr (F8) { _Pragma("unroll") for (int m = 0; m < 4; ++m) _Pragma("unroll") for (int n = 0; n < 2; ++n) \
            asm volatile("v_mfma_scale_f32_16x16x128_f8f6f4 %0, %1, %2, %0, %3, %3 op_sel_hi:[0,0,0]" : "+v"(acc[ai][bj][m][n]) : "v"(Bt##8[n]), "v"(At##8[m]), "v"(f8one)); } \
        else { _Pragma("unroll") for (int m = 0; m < 4; ++m) _Pragma("unroll") for (int n = 0; n < 2; ++n) _Pragma("unroll") for (int k = 0; k < 2; ++k) \
            acc[ai][bj][m][n] = __builtin_amdgcn_mfma_f32_16x16x32_bf16(Bt[n][k], At[m][k], acc[ai][bj][m][n], 0, 0, 0); } \
        __builtin_amdgcn_s_setprio(0); } while (0)
#define PG8_WAIT_V(n) asm volatile("s_waitcnt vmcnt(" #n ")" ::: "memory")
#define PG8_WAIT_L(n) asm volatile("s_waitcnt lgkmcnt(" #n ")" ::: "memory")
#define PG8_BAR __builtin_amdgcn_s_barrier()
#define PG8_SCHED __builtin_amdgcn_sched_barrier(0)
    Unit cur, nxt; int ui = 0;
    if (!S.next(0, cur)) return;
    typename Epi::Pre pre = E.prefetch(cur, wr, fr);
    f32x4 acc[2][2][4][2];
#pragma unroll
    for (int a = 0; a < 2; ++a)
#pragma unroll
        for (int b = 0; b < 2; ++b)
#pragma unroll
            for (int m = 0; m < 4; ++m)
#pragma unroll
                for (int n = 0; n < 2; ++n) acc[a][b][m][n] = (f32x4){0.f, 0.f, 0.f, 0.f};
    bf16x8 At[4][2], B0[2][2], B1[2][2];
    int f8one = 0x7f7f7f7f; asm volatile("" : "+v"(f8one));
    v8i32 At8[4], B08[2], B18[2];
    const char* cA = (const char*)g.A + (size_t)cur.pm * tstep; const char* cB = (const char*)g.Bt + (size_t)cur.pb * tstep;
    S.a_ready(cur);
    if constexpr (SP2) {
        PG8_STAGE(PG8_SB(0, 0), cB, voffB); PG8_STAGE(PG8_SB(0, 1), cB + hstep, voffB); PG8_STAGE(PG8_SA(0, 0), cA, voffA); PG8_STAGE(PG8_SA(0, 1), cA + hstep, voffA);
        if (wr == 1) PG8_BAR;
        PG8_WAIT_V(2); PG8_BAR;
        PG8_STAGE(PG8_SB(1, 0), cB + kstep, voffB); PG8_STAGE(PG8_SA(1, 0), cA + kstep, voffA); PG8_STAGE(PG8_SB(1, 1), cB + hstep + kstep, voffB);
        PG8_WAIT_V(6); PG8_BAR;
    } else {
        PG8_STAGE(PG8_SB(0, 0), cB, voffB); PG8_STAGE(PG8_SA(0, 0), cA, voffA); PG8_STAGE(PG8_SB(0, 1), cB + hstep, voffB); PG8_STAGE(PG8_SA(0, 1), cA + hstep, voffA);
        if (wr == 1) PG8_BAR;
        PG8_WAIT_V(4); PG8_BAR;
        PG8_STAGE(PG8_SB(1, 0), cB + kstep, voffB); PG8_STAGE(PG8_SA(1, 0), cA + kstep, voffA); PG8_STAGE(PG8_SB(1, 1), cB + hstep + kstep, voffB);
        PG8_WAIT_V(6); PG8_BAR;
    }
    for (;;) {
        const bool has_next = S.next(ui + 1, nxt);
        const char* nA = has_next ? (const char*)g.A + (size_t)nxt.pm * tstep : cA; const char* nB = has_next ? (const char*)g.Bt + (size_t)nxt.pb * tstep : cB;
        _Pragma("nounroll") for (int t = 0; t < nt; t += 2) {
            const bool last = (t == nt - 2);
            const char* a1 = cA + (size_t)(t + 1) * kstep;
            const char* a2 = last ? nA : cA + (size_t)(t + 2) * kstep; const char* b2 = last ? nB : cB + (size_t)(t + 2) * kstep;
            const char* a3 = a2 + kstep; const char* b3 = b2 + kstep;
            if (last && has_next) S.a_ready(nxt);
            if constexpr (Epi::MIDK) { if (t == Epi::MID_T) E.mid(acc, cur, wr, wc, fr, fq); }
            if constexpr (SP2) {
            PG8_LDB(B0, 0, 0); PG8_LDB(B1, 0, 1); PG8_SCHED; PG8_LDA(At, 0, 0); PG8_STAGE(PG8_SA(1, 1), a1 + hstep, voffA);
            PG8_WAIT_V(8); PG8_WAIT_L(0); PG8_BAR; PG8_MMA(0, 0, At, B0); PG8_MMA(0, 1, At, B1); PG8_BAR; PG8_SCHED;
            PG8_LDA(At, 0, 1); PG8_STAGE(PG8_SB(0, 0), b2, voffB); PG8_STAGE(PG8_SB(0, 1), b2 + hstep, voffB); PG8_STAGE(PG8_SA(0, 0), a2, voffA);
            PG8_WAIT_V(8); PG8_WAIT_L(0); PG8_BAR; PG8_MMA(1, 0, At, B0); PG8_MMA(1, 1, At, B1); PG8_BAR; PG8_SCHED;
            PG8_LDB(B0, 1, 0); PG8_LDB(B1, 1, 1); PG8_SCHED; PG8_LDA(At, 1, 0); PG8_STAGE(PG8_SA(0, 1), a2 + hstep, voffA);
            PG8_WAIT_V(8); PG8_WAIT_L(0); PG8_BAR; PG8_MMA(0, 0, At, B0); PG8_MMA(0, 1, At, B1); PG8_BAR; PG8_SCHED;
            PG8_LDA(At, 1, 1); PG8_STAGE(PG8_SB(1, 0), b3, voffB); PG8_STAGE(PG8_SB(1, 1), b3 + hstep, voffB); PG8_STAGE(PG8_SA(1, 0), a3, voffA);
            PG8_WAIT_V(8); PG8_WAIT_L(0); PG8_BAR; PG8_MMA(1, 0, At, B0); PG8_MMA(1, 1, At, B1); PG8_BAR; PG8_SCHED;
            } else {
            PG8_LDB(B0, 0, 0); PG8_SCHED; PG8_LDA(At, 0, 0); PG8_STAGE(PG8_SA(1, 1), a1 + hstep, voffA);
            PG8_WAIT_L(8); PG8_BAR; PG8_WAIT_L(0); PG8_MMA(0, 0, At, B0); PG8_BAR; PG8_SCHED;
            PG8_LDB(B1, 0, 1); PG8_STAGE(PG8_SB(0, 0), b2, voffB);
            PG8_BAR; PG8_WAIT_L(0); PG8_MMA(0, 1, At, B1); PG8_BAR;
            PG8_LDA(At, 0, 1); PG8_STAGE(PG8_SA(0, 0), a2, voffA);
            PG8_BAR; PG8_WAIT_L(0); PG8_MMA(1, 0, At, B0); PG8_BAR; PG8_SCHED;
            PG8_STAGE(PG8_SB(0, 1), b2 + hstep, voffB);
            PG8_WAIT_V(6); PG8_BAR; PG8_MMA(1, 1, At, B1); PG8_BAR;
            PG8_LDB(B0, 1, 0); PG8_SCHED; PG8_LDA(At, 1, 0); PG8_STAGE(PG8_SA(0, 1), a2 + hstep, voffA);
            PG8_WAIT_L(8); PG8_BAR; PG8_WAIT_L(0); PG8_MMA(0, 0, At, B0); PG8_BAR; PG8_SCHED;
            PG8_LDB(B1, 1, 1); PG8_STAGE(PG8_SB(1, 0), b3, voffB);
            PG8_BAR; PG8_WAIT_L(0); PG8_MMA(0, 1, At, B1); PG8_BAR;
            PG8_LDA(At, 1, 1); PG8_STAGE(PG8_SA(1, 0), a3, voffA);
            PG8_BAR; PG8_WAIT_L(0); PG8_MMA(1, 0, At, B0); PG8_BAR; PG8_SCHED;
            PG8_STAGE(PG8_SB(1, 1), b3 + hstep, voffB);
            PG8_WAIT_V(6); PG8_BAR; PG8_MMA(1, 1, At, B1); PG8_BAR;
            }
        }
        if constexpr (ALIGN_EPI) { if (wr == 0) PG8_BAR; }
        if constexpr (F8) asm volatile("s_nop 15\n\ts_nop 15" ::: "memory");
        if constexpr (!Epi::AFTER_DRAIN) { E(acc, cur, wr, wc, fr, fq, pre); S.done(cur); }
        if (!has_next) break;
#pragma unroll
        for (int a = 0; a < 2; ++a)
#pragma unroll
            for (int b = 0; b < 2; ++b)
#pragma unroll
                for (int m = 0; m < 4; ++m)
#pragma unroll
                    for (int n = 0; n < 2; ++n) acc[a][b][m][n] = (f32x4){0.f, 0.f, 0.f, 0.f};
        cur = nxt; cA = nA; cB = nB; ++ui; pre = E.prefetch(cur, wr, fr);
        if constexpr (ALIGN_EPI) { if (wr == 1) PG8_BAR; }
    }
    PG8_WAIT_V(0);
    if constexpr (!ALIGN_EPI) { if (wr == 0) PG8_BAR; }
    PG8_BAR;
    if constexpr (Epi::AFTER_DRAIN) { E.fused(acc, cur, wr, wc, fr, fq, lds, wid, lane); S.done(cur); }
#undef PG8_SA
#undef PG8_SB
#undef PG8_STAGE
#undef PG8_LDA
#undef PG8_LDB
#undef PG8_MMA
#undef PG8_WAIT_V
#undef PG8_WAIT_L
#undef PG8_BAR
#undef PG8_SCHED
}
}
namespace pg8 {
#define PG8_GAS __attribute__((address_space(1)))
typedef unsigned u32x2 __attribute__((ext_vector_type(2)));
__device__ __forceinline__ float ex2(float x) { return __builtin_amdgcn_exp2f(x); }
__device__ __forceinline__ float sigm(float x) { return __builtin_amdgcn_rcpf(1.0f + ex2(-1.4426950408889634f * x)); }
__device__ __forceinline__ float bflo(unsigned w) { return __uint_as_float(w << 16); }
__device__ __forceinline__ float bfhi(unsigned w) { return __uint_as_float(w & 0xffff0000u); }

typedef unsigned ssq_t;
__device__ __forceinline__ ssq_t ss_fix(float v) { return (ssq_t)(v * 1024.0f); }
__device__ __forceinline__ float rstd_fix(ssq_t s) { return 1.0f / sqrtf((float)s * (1.0f / (1024.0f * 1024.0f)) + 1e-6f); }
struct NoPre { struct Pre {}; __device__ __forceinline__ Pre prefetch(const Unit&, int, int) const { return Pre{}; } };
struct SsPre { struct Pre { ssq_t s[8]; };
    __device__ __forceinline__ static Pre load(const ssq_t* ss, const Unit& u, int wr, int fr) { Pre p;
#pragma unroll
        for (int i = 0; i < 8; ++i) p.s[i] = ss ? ss[u.pm * BM + wr * 64 + fr + (i >> 2) * HALF + (i & 3) * 16] : 0u;
        return p; } };
__device__ __forceinline__ float quad_sum(float v, int fr, int fq) {
    const int lane = fr + 16 * fq;
    v += __int_as_float(__builtin_amdgcn_ds_bpermute((lane ^ 16) << 2, __float_as_int(v)));
    v += __int_as_float(__builtin_amdgcn_ds_bpermute((lane ^ 32) << 2, __float_as_int(v)));
    return v;
}
struct EpiQK {
    static constexpr bool PERM = true, AFTER_DRAIN = false, MIDK = false; typedef SsPre::Pre Pre;
    bf16_t* O; unsigned ldc; const ssq_t* ss; const float* g_q; const float* g_k; float* kmp; float qscale;
    __device__ __forceinline__ Pre prefetch(const Unit& u, int wr, int fr) const { return SsPre::load(ss, u, wr, fr); }
    __device__ __forceinline__ void operator()(const f32x4 (&acc)[2][2][4][2], const Unit& u, int wr, int wc, int fr_, int fq_, const Pre& pre) const {
        int fr = fr_, fq = fq_; asm volatile("" : "+v"(fr), "+v"(fq));
        const bool isq = u.pn < 2; const float* gg = (isq ? g_q : g_k) + 8 * fq; const float osc = isq ? qscale : 1.0f;
        f32x4 gn[2][2], cs[2][2];
#pragma unroll
        for (int bj = 0; bj < 2; ++bj)
#pragma unroll
            for (int n = 0; n < 2; ++n) { gn[bj][n] = *(const f32x4*)(gg + 32 * bj + 4 * n); cs[bj][n] = (f32x4){0.f, 0.f, 0.f, 0.f}; }
        const unsigned obase = (unsigned)(u.pm * BM + wr * 64 + fr) * ldc + (unsigned)(u.pn * BM + wc * 64 + 8 * fq);
#pragma unroll
        for (int ai = 0; ai < 2; ++ai)
#pragma unroll
            for (int m = 0; m < 4; ++m) { const float rs = rstd_fix(pre.s[ai * 4 + m]);
                float q2 = 0.f;
#pragma unroll
                for (int bj = 0; bj < 2; ++bj)
#pragma unroll
                    for (int n = 0; n < 2; ++n) { const f32x4 a = acc[ai][bj][m][n]; q2 += (a[0] * a[0] + a[1] * a[1]) + (a[2] * a[2] + a[3] * a[3]); }
                q2 = quad_sum(q2, fr, fq);
                const float rr = rs * __builtin_amdgcn_rsqf(rs * rs * q2 * (1.0f / 64.0f) + 1e-6f) * osc;
                const unsigned off = obase + (unsigned)(ai * HALF + m * 16) * ldc;
#pragma unroll
                for (int bj = 0; bj < 2; ++bj) { const f32x4 o0 = acc[ai][bj][m][0] * (gn[bj][0] * rr), o1 = acc[ai][bj][m][1] * (gn[bj][1] * rr); cs[bj][0] += o0; cs[bj][1] += o1;
                    u32x4 w; w.x = cvt_pk_bf16(o0[0], o0[1]); w.y = cvt_pk_bf16(o0[2], o0[3]); w.z = cvt_pk_bf16(o1[0], o1[1]); w.w = cvt_pk_bf16(o1[2], o1[3]);
                    *(u32x4*)(O + off + 32 * bj) = w; }
                asm volatile("" : "+v"(cs[0][0]), "+v"(cs[0][1]), "+v"(cs[1][0]), "+v"(cs[1][1]));
                __builtin_amdgcn_sched_barrier(0); }
        if (!isq) {
            const int lane = fr + 16 * fq;
#pragma unroll
            for (int o = 1; o < 16; o <<= 1)
#pragma unroll
                for (int bj = 0; bj < 2; ++bj)
#pragma unroll
                    for (int n = 0; n < 2; ++n)
#pragma unroll
                        for (int j = 0; j < 4; ++j) cs[bj][n][j] += __int_as_float(__builtin_amdgcn_ds_bpermute((lane ^ o) << 2, __float_as_int(cs[bj][n][j])));
            if (fr == 0) { float* kp = kmp + ((((unsigned)(u.pm >> 4) * 8 + (u.pn & 1) * 4 + wc) * 16 + (u.pm & 15)) * 2 + wr) * 64 + 8 * fq;
#pragma unroll
                for (int bj = 0; bj < 2; ++bj) { *(f32x4*)(kp + 32 * bj) = cs[bj][0]; *(f32x4*)(kp + 32 * bj + 4) = cs[bj][1]; } }
        }
    }
};
struct EpiProj {
    static constexpr bool PERM = true, AFTER_DRAIN = false, MIDK = false; typedef SsPre::Pre Pre;
    bf16_t* O; int ldc; int sig_from; const ssq_t* ss; int gate_tile; float* ifpre; const float* b_i; const float* b_f; bf16_t* GT; int pn0;
    __device__ __forceinline__ Pre prefetch(const Unit& u, int wr, int fr) const { return SsPre::load(ss, u, wr, fr); }
    __device__ __forceinline__ void operator()(const f32x4 (&acc)[2][2][4][2], const Unit& u_, int wr, int wc, int fr, int fq, const Pre& pre) const {
        Unit u = u_; u.pn += pn0;
        const int row0 = u.pm * BM + wr * 64 + fr, col0 = u.pn * BM + wc * 32 + 8 * fq; const bool sg = u.pn >= sig_from;
        if (u.pn == gate_tile) {
            if (wc == 0 && fq == 0) { const f32x4 bi = *(const f32x4*)b_i, bf = *(const f32x4*)b_f;
#pragma unroll
                for (int ai = 0; ai < 2; ++ai)
#pragma unroll
                    for (int m = 0; m < 4; ++m) { const int r = row0 + ai * HALF + m * 16; const float rs = rstd_fix(pre.s[ai * 4 + m]);
                        *(f32x4*)(ifpre + (size_t)r * 8) = acc[ai][0][m][0] * rs + bi; *(f32x4*)(ifpre + (size_t)r * 8 + 4) = acc[ai][0][m][1] * rs + bf; } }
            return; }
#pragma unroll
        for (int ai = 0; ai < 2; ++ai)
#pragma unroll
            for (int m = 0; m < 4; ++m) { const int r = row0 + ai * HALF + m * 16; bf16_t* rowp = O + (size_t)r * ldc + col0; const float rs = rstd_fix(pre.s[ai * 4 + m]);
#pragma unroll
                for (int bj = 0; bj < 2; ++bj) { f32x4 v0 = acc[ai][bj][m][0] * rs, v1 = acc[ai][bj][m][1] * rs;
                    if (sg) {
#pragma unroll
                        for (int j = 0; j < 4; ++j) { v0[j] = sigm(v0[j]); v1[j] = sigm(v1[j]); } }
                    u32x4 w; w.x = cvt_pk_bf16(v0[0], v0[1]); w.y = cvt_pk_bf16(v0[2], v0[3]); w.z = cvt_pk_bf16(v1[0], v1[1]); w.w = cvt_pk_bf16(v1[2], v1[3]);
                    if (sg) *(u32x4*)(GT + ((((size_t)u.pm * 8 + (u.pn - sig_from)) * 16 + (ai * 8 + m * 2 + bj)) * 8 + (wr * 4 + wc)) * 512 + (fr + 16 * fq) * 8) = w;
                    else *(u32x4*)(rowp + bj * HALF) = w; } }
    }
};
struct EpiSwiglu {
    static constexpr bool PERM = true, AFTER_DRAIN = false, MIDK = false; typedef SsPre::Pre Pre;
    bf16_t* O; int ldc; const ssq_t* ss; float osc; float f8out;
    __device__ __forceinline__ Pre prefetch(const Unit& u, int wr, int fr) const { return SsPre::load(ss, u, wr, fr); }
    __device__ __forceinline__ void operator()(const f32x4 (&acc)[2][2][4][2], const Unit& u, int wr, int wc, int fr_, int fq_, const Pre& pre) const {
        int fr = fr_, fq = fq_; asm volatile("" : "+v"(fr), "+v"(fq));
        const unsigned obase = (unsigned)(u.pm * BM + wr * 64 + fr) * (unsigned)ldc + (unsigned)(u.pn * HALF + wc * 32 + 8 * fq);
#pragma unroll
        for (int ai = 0; ai < 2; ++ai)
#pragma unroll
            for (int m = 0; m < 4; ++m) { bf16_t* rowp = O + (obase + (unsigned)(ai * HALF + m * 16) * (unsigned)ldc); const float rs = (ss ? rstd_fix(pre.s[ai * 4 + m]) : 1.0f) * osc;
                const float nl = -1.4426950408889634f * rs, ic = __builtin_amdgcn_rcpf(rs * rs * (f8out != 0.f ? f8out : 1.0f));
                f32x4 v0, v1;
#pragma unroll
                for (int j = 0; j < 4; ++j) { const float g0 = acc[ai][0][m][0][j], g1 = acc[ai][0][m][1][j];
                    v0[j] = (g0 * acc[ai][1][m][0][j]) * __builtin_amdgcn_rcpf(fmaf(ex2(g0 * nl), ic, ic)); v1[j] = (g1 * acc[ai][1][m][1][j]) * __builtin_amdgcn_rcpf(fmaf(ex2(g1 * nl), ic, ic)); }
                if (f8out != 0.f) {
#pragma unroll
                    for (int j = 0; j < 4; ++j) { v0[j] = __builtin_amdgcn_fmed3f(v0[j], -448.0f, 448.0f); v1[j] = __builtin_amdgcn_fmed3f(v1[j], -448.0f, 448.0f); }
                    int a_ = __builtin_amdgcn_cvt_pk_fp8_f32(v0[0], v0[1], 0, false); a_ = __builtin_amdgcn_cvt_pk_fp8_f32(v0[2], v0[3], a_, true);
                    int b_ = __builtin_amdgcn_cvt_pk_fp8_f32(v1[0], v1[1], 0, false); b_ = __builtin_amdgcn_cvt_pk_fp8_f32(v1[2], v1[3], b_, true);
                    u32x2 w8; w8.x = (unsigned)a_; w8.y = (unsigned)b_; *(u32x2*)((unsigned char*)O + (obase + (unsigned)(ai * HALF + m * 16) * (unsigned)ldc)) = w8; }
                else { u32x4 w; w.x = cvt_pk_bf16(v0[0], v0[1]); w.y = cvt_pk_bf16(v0[2], v0[3]); w.z = cvt_pk_bf16(v1[0], v1[1]); w.w = cvt_pk_bf16(v1[2], v1[3]);
                    *(u32x4*)rowp = w; } }
    }
};
struct EpiResid {
    static constexpr bool PERM = true, AFTER_DRAIN = false, MIDK = false; typedef NoPre::Pre Pre; __device__ __forceinline__ Pre prefetch(const Unit&, int, int) const { return Pre{}; }
    const float* base; float* out; int ldc; const float* rowscale; int rs_ld; bf16_t* xb; ssq_t* ssacc;
    __device__ __forceinline__ void operator()(const f32x4 (&acc)[2][2][4][2], const Unit& u, int wr, int wc, int fr_, int fq_, const Pre&) const {
        int fr = fr_, fq = fq_; asm volatile("" : "+v"(fr), "+v"(fq));
        const int row0 = u.pm * BM + wr * 64 + fr, col0 = u.pn * BM + wc * 32 + 8 * fq;
        const PG8_GAS float* gb_ = (const PG8_GAS float*)base;
        f32x4 bv[2][4][2][2];
#define PG8_RESID_LOAD(ai) do { _Pragma("unroll") for (int m = 0; m < 4; ++m) _Pragma("unroll") for (int bj = 0; bj < 2; ++bj) { const size_t off = (size_t)(row0 + (ai) * HALF + m * 16) * ldc + col0 + bj * HALF; \
            bv[ai][m][bj][0] = *(const PG8_GAS f32x4*)(gb_ + off); bv[ai][m][bj][1] = *(const PG8_GAS f32x4*)(gb_ + off + 4); } __builtin_amdgcn_sched_barrier(0); } while (0)
#define PG8_RESID_STEP(ai, m) do { const int r = row0 + (ai) * HALF + (m) * 16; const float s = rowscale ? rowscale[(size_t)r * rs_ld] : 1.0f; float part = 0.f; \
            _Pragma("unroll") for (int bj = 0; bj < 2; ++bj) { const size_t off = (size_t)r * ldc + col0 + bj * HALF; \
                const f32x4 v0 = bv[ai][m][bj][0] + acc[ai][bj][m][0] * s, v1 = bv[ai][m][bj][1] + acc[ai][bj][m][1] * s; \
                *(PG8_GAS f32x4*)((PG8_GAS float*)out + off) = v0; *(PG8_GAS f32x4*)((PG8_GAS float*)out + off + 4) = v1; \
                if (xb) { u32x4 w; w.x = cvt_pk_bf16(v0[0], v0[1]); w.y = cvt_pk_bf16(v0[2], v0[3]); w.z = cvt_pk_bf16(v1[0], v1[1]); w.w = cvt_pk_bf16(v1[2], v1[3]); *(PG8_GAS u32x4*)((PG8_GAS bf16_t*)xb + off) = w; } \
                part += (v0[0] * v0[0] + v0[1] * v0[1]) + (v0[2] * v0[2] + v0[3] * v0[3]) + (v1[0] * v1[0] + v1[1] * v1[1]) + (v1[2] * v1[2] + v1[3] * v1[3]); } \
            if (ssacc) { part = quad_sum(part, fr, fq); if (fq == 0) __hip_atomic_fetch_add((PG8_GAS ssq_t*)ssacc + r, ss_fix(part), __ATOMIC_RELAXED, __HIP_MEMORY_SCOPE_AGENT); } } while (0)
        PG8_RESID_LOAD(0);
        PG8_RESID_STEP(0, 0); PG8_RESID_STEP(0, 1); __builtin_amdgcn_sched_barrier(0);
        PG8_RESID_LOAD(1);
        PG8_RESID_STEP(0, 2); PG8_RESID_STEP(0, 3); PG8_RESID_STEP(1, 0); PG8_RESID_STEP(1, 1); PG8_RESID_STEP(1, 2); PG8_RESID_STEP(1, 3);
#undef PG8_RESID_LOAD
#undef PG8_RESID_STEP
    }
};
struct EpiMerge {
    static constexpr bool PERM = true, AFTER_DRAIN = false, MIDK = true; static constexpr int MID_T = 8; typedef NoPre::Pre Pre; __device__ __forceinline__ Pre prefetch(const Unit&, int, int) const { return Pre{}; }
    const bf16_t* GT; bf16_t* O; int ldc;
    __device__ __forceinline__ void mid(f32x4 (&acc)[2][2][4][2], const Unit& u, int wr, int wc, int fr_, int fq_) const {
        int fr = fr_, fq = fq_; asm volatile("" : "+v"(fr), "+v"(fq));
        const PG8_GAS bf16_t* ga_ = (const PG8_GAS bf16_t*)GT + ((size_t)u.pm * 8 + u.pn) * 65536 + (size_t)(wr * 4 + wc) * 512 + (fr + 16 * fq) * 8;
#pragma unroll
        for (int ai = 0; ai < 2; ++ai) { u32x4 ga[4][2], gb[4][2];
#pragma unroll
            for (int m = 0; m < 4; ++m)
#pragma unroll
                for (int bj = 0; bj < 2; ++bj) { const size_t fo = (size_t)(ai * 8 + m * 2 + bj) * 4096; ga[m][bj] = *(const PG8_GAS u32x4*)(ga_ + fo); gb[m][bj] = *(const PG8_GAS u32x4*)(ga_ + 4 * 65536 + fo); }
            __builtin_amdgcn_sched_barrier(0);
#pragma unroll
            for (int m = 0; m < 4; ++m)
#pragma unroll
                for (int bj = 0; bj < 2; ++bj) { const u32x4 a = ga[m][bj], b = gb[m][bj];
                    const f32x4 a0 = {bflo(a.x), bfhi(a.x), bflo(a.y), bfhi(a.y)}, a1 = {bflo(a.z), bfhi(a.z), bflo(a.w), bfhi(a.w)}, b0 = {bflo(b.x), bfhi(b.x), bflo(b.y), bfhi(b.y)}, b1 = {bflo(b.z), bfhi(b.z), bflo(b.w), bfhi(b.w)};
#pragma unroll
                    for (int j = 0; j < 4; ++j) { acc[ai][bj][m][0][j] *= a0[j] * __builtin_amdgcn_rcpf(fmaxf(b0[j], 1e-30f)); acc[ai][bj][m][1][j] *= a1[j] * __builtin_amdgcn_rcpf(fmaxf(b1[j], 1e-30f)); } }
            __builtin_amdgcn_sched_barrier(0); }
    }
    __device__ __forceinline__ void operator()(const f32x4 (&acc)[2][2][4][2], const Unit& u, int wr, int wc, int fr_, int fq_, const Pre&) const {
        int fr = fr_, fq = fq_; asm volatile("" : "+v"(fr), "+v"(fq));
        const int row0 = u.pm * BM + wr * 64 + fr, col0 = u.pn * BM + wc * 32 + 8 * fq;
        const PG8_GAS bf16_t* gb_ = (const PG8_GAS bf16_t*)GT + ((size_t)u.pm * 8 + 4 + u.pn) * 65536 + (size_t)(wr * 4 + wc) * 512 + (fr + 16 * fq) * 8;
        u32x4 gb[2][4][2];
#pragma unroll
        for (int ai = 0; ai < 2; ++ai)
#pragma unroll
            for (int m = 0; m < 4; ++m)
#pragma unroll
                for (int bj = 0; bj < 2; ++bj) gb[ai][m][bj] = *(const PG8_GAS u32x4*)(gb_ + (size_t)(ai * 8 + m * 2 + bj) * 4096);
        __builtin_amdgcn_sched_barrier(0);
#pragma unroll
        for (int ai = 0; ai < 2; ++ai)
#pragma unroll
            for (int m = 0; m < 4; ++m) { const size_t r = (size_t)(row0 + ai * HALF + m * 16);
#pragma unroll
                for (int bj = 0; bj < 2; ++bj) { const u32x4 b = gb[ai][m][bj];
                    const f32x4 b0 = {bflo(b.x), bfhi(b.x), bflo(b.y), bfhi(b.y)}, b1 = {bflo(b.z), bfhi(b.z), bflo(b.w), bfhi(b.w)};
                    const f32x4 v0 = acc[ai][bj][m][0] * b0, v1 = acc[ai][bj][m][1] * b1;
                    u32x4 w; w.x = cvt_pk_bf16(v0[0], v0[1]); w.y = cvt_pk_bf16(v0[2], v0[3]); w.z = cvt_pk_bf16(v1[0], v1[1]); w.w = cvt_pk_bf16(v1[2], v1[3]);
                    *(PG8_GAS u32x4*)((PG8_GAS bf16_t*)O + r * ldc + col0 + bj * HALF) = w; } }
    }
};
struct EpiGate1 {
    static constexpr bool PERM = true, AFTER_DRAIN = false, MIDK = false; typedef NoPre::Pre Pre; __device__ __forceinline__ Pre prefetch(const Unit&, int, int) const { return Pre{}; }
    const bf16_t* G; int ldg; bf16_t* T; int ldc;
    __device__ __forceinline__ void operator()(const f32x4 (&acc)[2][2][4][2], const Unit& u, int wr, int wc, int fr, int fq, const Pre&) const {
        const int row0 = u.pm * BM + wr * 64 + fr, col0 = u.pn * BM + wc * 32 + 8 * fq;
#pragma unroll
        for (int ai = 0; ai < 2; ++ai)
#pragma unroll
            for (int m = 0; m < 4; ++m) { const size_t r = (size_t)(row0 + ai * HALF + m * 16);
#pragma unroll
                for (int bj = 0; bj < 2; ++bj) { const u32x4 g = *(const u32x4*)(G + r * ldg + col0 + bj * HALF);
                    f32x4 g0 = {bflo(g.x), bfhi(g.x), bflo(g.y), bfhi(g.y)}, g1 = {bflo(g.z), bfhi(g.z), bflo(g.w), bfhi(g.w)};
                    const f32x4 t0 = g0 * acc[ai][bj][m][0], t1 = g1 * acc[ai][bj][m][1];
                    u32x4 w; w.x = cvt_pk_bf16(t0[0], t0[1]); w.y = cvt_pk_bf16(t0[2], t0[3]); w.z = cvt_pk_bf16(t1[0], t1[1]); w.w = cvt_pk_bf16(t1[2], t1[3]);
                    *(u32x4*)(T + r * ldc + col0 + bj * HALF) = w; } }
    }
};
struct EpiGate2 {
    static constexpr bool PERM = true, AFTER_DRAIN = false, MIDK = false; typedef NoPre::Pre Pre; __device__ __forceinline__ Pre prefetch(const Unit&, int, int) const { return Pre{}; }
    const bf16_t* G; int ldg; const bf16_t* T; bf16_t* O; int ldc;
    __device__ __forceinline__ void operator()(const f32x4 (&acc)[2][2][4][2], const Unit& u, int wr, int wc, int fr, int fq, const Pre&) const {
        const int row0 = u.pm * BM + wr * 64 + fr, col0 = u.pn * BM + wc * 32 + 8 * fq;
#pragma unroll
        for (int ai = 0; ai < 2; ++ai)
#pragma unroll
            for (int m = 0; m < 4; ++m) { const size_t r = (size_t)(row0 + ai * HALF + m * 16);
#pragma unroll
                for (int bj = 0; bj < 2; ++bj) { const u32x4 g = *(const u32x4*)(G + r * ldg + col0 + bj * HALF);
                    f32x4 g0 = {bflo(g.x), bfhi(g.x), bflo(g.y), bfhi(g.y)}, g1 = {bflo(g.z), bfhi(g.z), bflo(g.w), bfhi(g.w)};
                    const u32x4 tt = *(const u32x4*)(T + r * ldc + col0 + bj * HALF);
                    const f32x4 v0 = (f32x4){bflo(tt.x), bfhi(tt.x), bflo(tt.y), bfhi(tt.y)} + g0 * acc[ai][bj][m][0], v1 = (f32x4){bflo(tt.z), bfhi(tt.z), bflo(tt.w), bfhi(tt.w)} + g1 * acc[ai][bj][m][1];
                    u32x4 w; w.x = cvt_pk_bf16(v0[0], v0[1]); w.y = cvt_pk_bf16(v0[2], v0[3]); w.z = cvt_pk_bf16(v1[0], v1[1]); w.w = cvt_pk_bf16(v1[2], v1[3]);
                    *(u32x4*)(O + r * ldc + col0 + bj * HALF) = w; } }
    }
};
struct EpiF32 {
    static constexpr bool PERM = true, AFTER_DRAIN = false, MIDK = false; typedef NoPre::Pre Pre; __device__ __forceinline__ Pre prefetch(const Unit&, int, int) const { return Pre{}; }
    bf16_t* O; int ldc;
    __device__ __forceinline__ void operator()(const f32x4 (&acc)[2][2][4][2], const Unit& u, int wr, int wc, int fr, int fq, const Pre&) const {
        const int row0 = u.pm * BM + wr * 64 + fr, col0 = u.pn * BM + wc * 32 + 8 * fq;
#pragma unroll
        for (int ai = 0; ai < 2; ++ai)
#pragma unroll
            for (int m = 0; m < 4; ++m)
#pragma unroll
                for (int bj = 0; bj < 2; ++bj) { const f32x4 v0 = acc[ai][bj][m][0], v1 = acc[ai][bj][m][1]; u32x4 w; w.x = cvt_pk_bf16(v0[0], v0[1]); w.y = cvt_pk_bf16(v0[2], v0[3]); w.z = cvt_pk_bf16(v1[0], v1[1]); w.w = cvt_pk_bf16(v1[2], v1[3]);
                    *(u32x4*)(O + (size_t)(row0 + ai * HALF + m * 16) * ldc + col0 + bj * HALF) = w; }
    }
};
struct EpiPle2 {
    static constexpr bool PERM = true, AFTER_DRAIN = false, MIDK = false; typedef NoPre::Pre Pre; __device__ __forceinline__ Pre prefetch(const Unit&, int, int) const { return Pre{}; }
    const bf16_t* PP; float* x; int ldc; const ssq_t* ss_in; bf16_t* xb; ssq_t* ssacc;
    __device__ __forceinline__ void operator()(const f32x4 (&acc)[2][2][4][2], const Unit& u, int wr, int wc, int fr_, int fq_, const Pre&) const {
        int fr = fr_, fq = fq_; asm volatile("" : "+v"(fr), "+v"(fq));
        const int row0 = u.pm * BM + wr * 64 + fr, col0 = u.pn * BM + wc * 32 + 8 * fq;
        const PG8_GAS float* gx_ = (const PG8_GAS float*)x; const PG8_GAS bf16_t* gp_ = (const PG8_GAS bf16_t*)PP;
        f32x4 xv[4][2][2][2]; u32x4 pv[4][2][2]; ssq_t sv[4][2];
#define PG8_PLE_LOAD(q) do { _Pragma("unroll") for (int mm = 0; mm < 2; ++mm) { sv[q][mm] = ss_in ? ((const PG8_GAS ssq_t*)ss_in)[row0 + ((q) >> 1) * HALF + (((q) & 1) * 2 + mm) * 16] : 0u; _Pragma("unroll") for (int bj = 0; bj < 2; ++bj) { const size_t off = (size_t)(row0 + ((q) >> 1) * HALF + (((q) & 1) * 2 + mm) * 16) * ldc + col0 + bj * HALF; \
            pv[q][mm][bj] = *(const PG8_GAS u32x4*)(gp_ + off); xv[q][mm][bj][0] = *(const PG8_GAS f32x4*)(gx_ + off); xv[q][mm][bj][1] = *(const PG8_GAS f32x4*)(gx_ + off + 4); } } __builtin_amdgcn_sched_barrier(0); } while (0)
#define PG8_PLE_STEP(q, mm) do { constexpr int ai = (q) >> 1, m = ((q) & 1) * 2 + (mm); const int r = row0 + ai * HALF + m * 16; ssq_t sq_ = sv[q][mm]; asm volatile("" : "+v"(sq_));   const float rs = ss_in ? rstd_fix(sq_) : 1.0f; float part = 0.f; \
            _Pragma("unroll") for (int bj = 0; bj < 2; ++bj) { const size_t off = (size_t)r * ldc + col0 + bj * HALF; \
                f32x4 a0 = acc[ai][bj][m][0] * rs, a1 = acc[ai][bj][m][1] * rs; \
                _Pragma("unroll") for (int j = 0; j < 4; ++j) { a0[j] = sigm(a0[j]); a1[j] = sigm(a1[j]); } \
                const u32x4 pw = pv[q][mm][bj]; \
                const f32x4 v0 = xv[q][mm][bj][0] + a0 * (f32x4){bflo(pw.x), bfhi(pw.x), bflo(pw.y), bfhi(pw.y)}, v1 = xv[q][mm][bj][1] + a1 * (f32x4){bflo(pw.z), bfhi(pw.z), bflo(pw.w), bfhi(pw.w)}; \
                *(PG8_GAS f32x4*)((PG8_GAS float*)x + off) = v0; *(PG8_GAS f32x4*)((PG8_GAS float*)x + off + 4) = v1; \
                if (xb) { u32x4 w; w.x = cvt_pk_bf16(v0[0], v0[1]); w.y = cvt_pk_bf16(v0[2], v0[3]); w.z = cvt_pk_bf16(v1[0], v1[1]); w.w = cvt_pk_bf16(v1[2], v1[3]); *(PG8_GAS u32x4*)((PG8_GAS bf16_t*)xb + off) = w; } \
                part += (v0[0] * v0[0] + v0[1] * v0[1]) + (v0[2] * v0[2] + v0[3] * v0[3]) + (v1[0] * v1[0] + v1[1] * v1[1]) + (v1[2] * v1[2] + v1[3] * v1[3]); } \
            if (ssacc) { part = quad_sum(part, fr, fq); if (fq == 0) __hip_atomic_fetch_add((PG8_GAS ssq_t*)ssacc + r, ss_fix(part), __ATOMIC_RELAXED, __HIP_MEMORY_SCOPE_AGENT); } } while (0)
        PG8_PLE_LOAD(0);
        PG8_PLE_STEP(0, 0); __builtin_amdgcn_sched_barrier(0);
        PG8_PLE_LOAD(1);
        PG8_PLE_STEP(0, 1); PG8_PLE_STEP(1, 0); __builtin_amdgcn_sched_barrier(0);
        PG8_PLE_LOAD(2);
        PG8_PLE_STEP(1, 1); PG8_PLE_STEP(2, 0); __builtin_amdgcn_sched_barrier(0);
        PG8_PLE_LOAD(3);
        PG8_PLE_STEP(2, 1); PG8_PLE_STEP(3, 0); PG8_PLE_STEP(3, 1);
#undef PG8_PLE_LOAD
#undef PG8_PLE_STEP
    }
};
}
#define GAS __attribute__((address_space(1)))
#define LAS __attribute__((address_space(3)))
typedef unsigned short bf16;
typedef unsigned v4u __attribute__((ext_vector_type(4)));
typedef float f32x4 __attribute__((ext_vector_type(4)));
typedef short bf16x8 __attribute__((ext_vector_type(8)));
typedef GAS unsigned gu32;
typedef GAS unsigned long long gu64;
#define RLX_AGENT __ATOMIC_RELAXED, __HIP_MEMORY_SCOPE_AGENT
#define LDS_WAIT() asm volatile("s_waitcnt lgkmcnt(0)" ::: "memory")
#define VM_WAIT() asm volatile("s_waitcnt vmcnt(0)" ::: "memory")
__device__ __forceinline__ unsigned long long rt() { return __builtin_amdgcn_s_memrealtime(); }
__device__ __forceinline__ unsigned f2bf(float f) { unsigned u = __builtin_bit_cast(unsigned, f); return (u + 0x7fffu + ((u >> 16) & 1u)) >> 16; }
__device__ __forceinline__ unsigned pk2(float lo, float hi) { return f2bf(lo) | (f2bf(hi) << 16); }

#define XB_TMO      128
#define XB_XCNT(j)  (256  + 64 * (j))
#define XB_XSUB(j)  (1280 + 64 * (j))
#define XB_XGEN(j)  (2304 + 64 * (j))
#define XB_TOP      3328
#define XB_TOPGEN   3392
#define XCD_BAR_WORDS 3456
#define XB_SPIN_CAP (1u << 18)

__device__ __forceinline__ unsigned xb_ld(unsigned* p)              { return __hip_atomic_load(p, __ATOMIC_RELAXED, __HIP_MEMORY_SCOPE_AGENT); }
__device__ __forceinline__ unsigned xb_add(unsigned* p, unsigned v) { return __hip_atomic_fetch_add(p, v, __ATOMIC_RELAXED, __HIP_MEMORY_SCOPE_AGENT); }
__device__ __forceinline__ unsigned xb_xcc_id() { return (unsigned)__builtin_amdgcn_s_getreg((3 << 11) | 20) & 0xFu; }
#define XB_SPIN(cond, bar) do { unsigned _sp = 0; while (cond) { __builtin_amdgcn_s_sleep(1); \
    if ((++_sp & 255u) == 0u) { if (xb_ld(&(bar)[XB_TMO])) break; if (_sp > XB_SPIN_CAP) { atomicAdd(&(bar)[XB_TMO], 1u); break; } } } } while (0)

__device__ __forceinline__ int lane_now() { int l; asm volatile("v_mbcnt_lo_u32_b32 %0, -1, 0\n\tv_mbcnt_hi_u32_b32 %0, -1, %0" : "=v"(l)); return l; }
struct XcdBarrier {
    unsigned* bar; unsigned x; int wave;
    volatile LAS unsigned* st;
};

__device__ __forceinline__ XcdBarrier xcd_barrier_post(unsigned* bar, volatile LAS unsigned* st, int wave) {
    XcdBarrier b; b.bar = bar; b.x = xb_xcc_id(); b.st = st; b.wave = wave;
    if (wave == 0 && lane_now() == 0) (void)xb_add(&bar[XB_XCNT(b.x)], 1u);
    return b;
}
__device__ __forceinline__ void xcd_barrier_complete(unsigned* bar, unsigned x, unsigned& nloc, unsigned& nx) {
    const unsigned G = gridDim.x * gridDim.y * gridDim.z;
    unsigned sum, cnt, mine, sp = 0u;
    for (;;) {
        sum = 0u; cnt = 0u; mine = 0u;
#pragma unroll
        for (unsigned j = 0; j < 16; ++j) { const unsigned c = xb_ld(&bar[XB_XCNT(j)]); sum += c; cnt += (c > 0u) ? 1u : 0u; mine = (j == x) ? c : mine; }
        if (sum == G) break;
        __builtin_amdgcn_s_sleep(1);
        if ((++sp & 255u) == 0u) { if (xb_ld(&bar[XB_TMO])) break; if (sp > XB_SPIN_CAP) { atomicAdd(&bar[XB_TMO], 1u); break; } }
    }
    nloc = mine > 0u ? mine : 1u; nx = cnt > 0u ? cnt : 1u;
}

__device__ __forceinline__ void xcd_barrier(const XcdBarrier& b) {
    asm volatile("s_waitcnt vmcnt(0)" ::: "memory");
    __syncthreads();
    if (b.wave == 0 && lane_now() == 0) {
        unsigned* bar = b.bar;
        __builtin_amdgcn_s_waitcnt(0);
        unsigned nloc = b.st[0], nx = b.st[1];
        if (nloc == 0u) { xcd_barrier_complete(bar, b.x, nloc, nx); b.st[0] = nloc; b.st[1] = nx; }
        const unsigned old = xb_add(&bar[XB_XSUB(b.x)], 1u);
        const unsigned gen = old / nloc;
        if (old + 1u == (gen + 1u) * nloc) {
            __builtin_amdgcn_fence(__ATOMIC_RELEASE, "agent");
            asm volatile("s_waitcnt vmcnt(0)" ::: "memory");
            const unsigned og = xb_add(&bar[XB_TOP], 1u);
            const unsigned tg = og / nx;
            if (og + 1u == (tg + 1u) * nx) xb_add(&bar[XB_TOPGEN], 1u);
            else XB_SPIN(xb_ld(&bar[XB_TOPGEN]) == tg, bar);
            __builtin_amdgcn_fence(__ATOMIC_ACQUIRE, "agent");
            xb_add(&bar[XB_XGEN(b.x)], 1u);
            asm volatile("s_waitcnt vmcnt(0)" ::: "memory");
        } else {
            XB_SPIN(xb_ld(&bar[XB_XGEN(b.x)]) == gen, bar);
            __builtin_amdgcn_fence(__ATOMIC_ACQUIRE, "agent");
            asm volatile("s_waitcnt vmcnt(0)" ::: "memory");
        }
    }
    __syncthreads();
}
constexpr int NWAVES = 8, NTHR = NWAVES * 64;
constexpr int BATCH = 4, SEQ = 4096, D = 1024, M = BATCH * SEQ, NIN = 5640, NPROJ = 3584, PLE = 256;
constexpr int DFF = 2816, NEXP = 8, DFFE = 3584, NLAYER = 2;
constexpr int AH = 8, AHD = 64, ABLK = 256, ANB = SEQ / ABLK;
constexpr int MH = 4, MDK = 128;
constexpr float RMS_EPS = 1e-6f;
constexpr float C2 = 0.125f * 1.4426950408889634f;
constexpr int PC_Q = 0, PC_K = 512, PC_V = 1024, PC_QKM = 1536, PC_VM = 2560, PC_OM = 3072, PC_GA = 3584, PC_GB = 4608;

constexpr size_t MiB = 1u << 20;
constexpr size_t WS_CTL = 0, CTL_ZERO_BYTES = 1 * MiB;
constexpr int NPROJX = 5888;
constexpr size_t WS_WIN = 1 * MiB, WS_WOA = 24 * MiB, WS_WOB = 26 * MiB, WS_WOUT = 28 * MiB, WS_WD13 = 32 * MiB, WS_WD2 = 43 * MiB, WS_WPG = 49 * MiB, WS_WPP = 53 * MiB, WS_PB = 54 * MiB;
constexpr size_t WS_WE = 70 * MiB;
constexpr size_t WS_SMALL = 154 * MiB;
constexpr size_t WS_XB = 161 * MiB;
constexpr size_t WS_SS0 = WS_SMALL + 5 * MiB;
constexpr size_t WS_IFPRE = WS_SMALL, WS_KMEAN = WS_SMALL + 1 * MiB, WS_GSEL = WS_SMALL + 4 * MiB;
constexpr size_t WS_HB = 161 * MiB, WS_QKC = 193 * MiB, WS_YA = 225 * MiB, WS_YB = 225 * MiB + 1024  , WS_MIXED = 257 * MiB, WS_ST = 289 * MiB, WS_PROJ = 309 * MiB, WS_END = 485 * MiB;
constexpr size_t WS_TOPI = WS_SMALL + 2 * MiB, WS_TOPG = WS_TOPI + 256 * 1024, WS_DEST = WS_TOPG + 256 * 1024, WS_ROWTOK = WS_SMALL + 3 * MiB, WS_TILEE = WS_ROWTOK + 512 * 1024, WS_NTILES = WS_TILEE + 4096;
constexpr int MOE_MAXROWS = 2 * M + NEXP * 256;
constexpr size_t WS_WE2B = 448 * MiB;
constexpr size_t WS_XG = 193 * MiB, WS_Y = 261 * MiB, WS_GHH = 329 * MiB;
static_assert(WS_XG + (size_t)MOE_MAXROWS * D * 2 <= WS_Y && WS_Y + (size_t)MOE_MAXROWS * D * 2 <= WS_GHH && WS_GHH + (size_t)MOE_MAXROWS * DFFE <= WS_END, "MoE buffers");
constexpr size_t WS_GT = WS_PROJ + (size_t)M * NPROJ * 2;
static_assert(WS_GT + (size_t)64 * MiB <= WS_END, "gate tiles inside the old proj region");
constexpr size_t WS_TMP = WS_HB;
constexpr size_t WS_GH = WS_PROJ, WS_PP = WS_PROJ;
constexpr int CW_TMO = 0, CW_CODE = 1, CW_BAR = 4096;
constexpr int CW_SS = 65536;
static_assert((CW_SS + 3 * M) * 4 <= (int)CTL_ZERO_BYTES, "SS accumulators inside the zeroed region");

constexpr int RING_OFF = 0, RING_BYTES = 131072;
constexpr int LDSCTL_OFF = RING_BYTES, MISC_OFF = LDSCTL_OFF + 320;
constexpr int LDS_BYTES = 147456;
struct Frame {
    LAS unsigned char* lds;
    volatile LAS unsigned* MISC;
    gu32* ctl;
    int wave;
    int vcu, G;
    unsigned char* ws;
};
__device__ __forceinline__ int opaque(int v) { asm volatile("" : "+v"(v)); return v; }
#define PHASE_LOCALS() const int tid = F.wave * 64 + lane_now(), lane = tid & 63; (void)lane
__device__ __forceinline__ float shx(float v, int o, int lane) { return __int_as_float(__builtin_amdgcn_ds_bpermute((lane ^ o) << 2, __float_as_int(v))); }
__device__ __forceinline__ float wave_sum(float v, int lane) {
#pragma unroll
    for (int o = 1; o < 64; o <<= 1) v += shx(v, o, lane);
    return v;
}
__device__ __forceinline__ float wave_max(float v, int lane) {
#pragma unroll
    for (int o = 1; o < 64; o <<= 1) v = fmaxf(v, shx(v, o, lane));
    return v;
}
__device__ __forceinline__ float bf2f(bf16 u) { return __uint_as_float((unsigned)u << 16); }
__device__ __forceinline__ float bflo(unsigned w) { return __uint_as_float(w << 16); }
__device__ __forceinline__ float bfhi(unsigned w) { return __uint_as_float(w & 0xffff0000u); }
__device__ __forceinline__ float sigm(float x) { return pg8::sigm(x); }

__device__ __forceinline__ void tr_item(const float* W, int ld, int K, int N, bf16* WT, int rowstep, int row_off, LAS float* scr, int item, int lane, const float* gk = nullptr, int nrows = 32) {
    const int nblk = N / 32, kb = item / nblk, nb = item % nblk, k0 = 64 * kb, n0 = 32 * nb;
#pragma unroll 32
    for (int i = 0; i < 32; ++i) { const int kk = 2 * i + (lane >> 5); scr[kk * 33 + (lane & 31)] = W[(size_t)(k0 + kk) * ld + n0 + (lane & 31)] * (gk ? gk[k0 + kk] : 1.0f); }
    LDS_WAIT(); asm volatile("" ::: "memory");
    const int c = lane & 7;
#pragma unroll
    for (int j = 0; j < 4; ++j) { const int n = (lane >> 3) + 8 * j; const LAS float* s = scr + (8 * c) * 33 + n;
        v4u o; o.x = pk2(s[0 * 33], s[1 * 33]); o.y = pk2(s[2 * 33], s[3 * 33]); o.z = pk2(s[4 * 33], s[5 * 33]); o.w = pk2(s[6 * 33], s[7 * 33]);
        const int nn = n0 + n, drow = (nn >> 7) * rowstep + (nn & 127) + row_off;
        if (n < nrows) *(GAS v4u*)(WT + (size_t)drow * K + k0 + 8 * c) = o; }
    LDS_WAIT(); asm volatile("" ::: "memory");
}
__device__ __forceinline__ void tr_tile(const float* W, int ld, int K, int ntn, bf16* WT, int rowstep, int row_off, LAS float* scr, int tile, int wave, int lane, const float* gk, bool permqk, float f8scale = 0.f) {
    const int kb = tile / ntn, nb = tile % ntn, k0 = 64 * kb, n0 = 256 * nb;
    f32x4 v[8];
#pragma unroll
    for (int i = 0; i < 8; ++i) v[i] = *(const f32x4*)(W + (size_t)(k0 + wave + 8 * i) * ld + n0 + 4 * lane);
#pragma unroll
    for (int i = 0; i < 8; ++i) { const int k = wave + 8 * i; const float g = gk ? gk[k0 + k] : 1.0f; LAS float* d = scr + k * 257 + 4 * lane; d[0] = v[i][0] * g; d[1] = v[i][1] * g; d[2] = v[i][2] * g; d[3] = v[i][3] * g; }
    __syncthreads();
    const int tid = wave * 64 + lane, c = tid & 7;
#pragma unroll
    for (int j = 0; j < 4; ++j) { const int n = (tid >> 3) + 64 * j; const LAS float* p = scr + (8 * c) * 257 + n;
        v4u o; o.x = pk2(p[0], p[257]); o.y = pk2(p[2 * 257], p[3 * 257]); o.z = pk2(p[4 * 257], p[5 * 257]); o.w = pk2(p[6 * 257], p[7 * 257]);
        const int nn = n0 + n, drow = permqk ? (nn & ~255) + (((nn >> 5) & 1) << 7) + (((nn >> 6) & 3) << 5) + (nn & 31) + row_off : (nn >> 7) * rowstep + (nn & 127) + row_off;
        if (f8scale != 0.f) { uint2 o8; int a_ = __builtin_amdgcn_cvt_pk_fp8_f32(p[0] * f8scale, p[257] * f8scale, 0, false); a_ = __builtin_amdgcn_cvt_pk_fp8_f32(p[2 * 257] * f8scale, p[3 * 257] * f8scale, a_, true);
            int b_ = __builtin_amdgcn_cvt_pk_fp8_f32(p[4 * 257] * f8scale, p[5 * 257] * f8scale, 0, false); b_ = __builtin_amdgcn_cvt_pk_fp8_f32(p[6 * 257] * f8scale, p[7 * 257] * f8scale, b_, true);
            o8.x = (unsigned)a_; o8.y = (unsigned)b_; *(uint2*)((unsigned char*)WT + (size_t)drow * K + k0 + 8 * c) = o8; }
        else *(GAS v4u*)(WT + (size_t)drow * K + k0 + 8 * c) = o; }
    __syncthreads();
}
#define TTJOBG(W_, ld_, K_, N_, WT_, rs_, ro_, gk_) if (!found) { const int I_ = ((K_) / 64) * ((N_) / 256); if (r < I_) { jb.W = (W_); jb.ld = (ld_); jb.K = (K_); jb.N = (N_); jb.WT = (WT_); jb.rowstep = (rs_); jb.row_off = (ro_); jb.gk = (gk_); jb.nrows = 32; found = true; } else r -= I_; }
struct TrJob { const float* W; int ld, K, N; bf16* WT; int rowstep, row_off; const float* gk; int nrows; };
#define TRJOBG(W_, ld_, K_, N_, WT_, rs_, ro_, gk_, nr_) if (!found) { const int I_ = ((K_) / 64) * ((N_) / 32); if (r < I_) { jb.W = (W_); jb.ld = (ld_); jb.K = (K_); jb.N = (N_); jb.WT = (WT_); jb.rowstep = (rs_); jb.row_off = (ro_); jb.gk = (gk_); jb.nrows = (nr_); found = true; } else r -= I_; }
#define TRJOB(W_, ld_, K_, N_, WT_, rs_, ro_) TRJOBG(W_, ld_, K_, N_, WT_, rs_, ro_, nullptr, 32)

struct Inputs { const float* p[25]; };
enum { I_X = 0, I_P, I_GMIX, I_WIN, I_GQ, I_GK, I_CONVW, I_CONVB, I_BI, I_BF, I_GH, I_WOA, I_WOB, I_WOUT, I_GFFN, I_WD1, I_WD3, I_WD2, I_WR, I_WE1, I_WE3, I_WE2, I_GPLE, I_WPG, I_WPP };

constexpr int PER_LAYER_T = 16 * 4 + 16 * 10 + 16 * 8 + 2 * (8 * 4) + 2 * (16 * 4) + 4 * 4, NTILES_T = 2 * PER_LAYER_T + 2 * (16 * 11) + 44 * 4, P0_URGENT = 16 * 4 + 16 * 10 + 16 * 8;
__device__ __forceinline__ void p0_tile(Frame& F, const Inputs& in, int r_in, int lane) {
    int r = r_in; bool found = false; TrJob jb;
            jb.W = nullptr; jb.ld = 0; jb.K = 64; jb.N = 256; jb.WT = nullptr; jb.rowstep = 128; jb.row_off = 0; jb.gk = nullptr; jb.nrows = 32;
#pragma unroll
            for (int l = 0; l < 2; ++l) {
                if (!found) { const int I_ = 16 * 4; if (r < I_) { jb.W = in.p[I_WIN] + (size_t)l * D * NIN; jb.ld = NIN; jb.K = D; jb.N = 1024; jb.WT = (bf16*)(F.ws + WS_WIN) + (size_t)l * NPROJX * D; jb.rowstep = 128; jb.row_off = 0; jb.gk = in.p[I_GMIX] + l * D; jb.nrows = 33; found = true; } else r -= I_; }
                TTJOBG(in.p[I_WIN] + (size_t)l * D * NIN + 1024, NIN, D, 2560, (bf16*)(F.ws + WS_WIN) + (size_t)l * NPROJX * D, 128, 1024, in.p[I_GMIX] + l * D)
                TTJOBG(in.p[I_WIN] + (size_t)l * D * NIN + 3592, NIN, D, 2048, (bf16*)(F.ws + WS_WIN) + (size_t)l * NPROJX * D, 128, 3584, in.p[I_GMIX] + l * D)
                if (!found) { const int I_ = 8 * 4; if (r < I_) { jb.W = in.p[I_WOA] + (size_t)l * 512 * D; jb.ld = D; jb.K = D; jb.N = D; jb.WT = (bf16*)(F.ws + WS_WOA) + (size_t)l * D * D; jb.rowstep = 128; jb.row_off = 0; jb.gk = nullptr; found = true; } else r -= I_; }
                if (!found) { const int I_ = 8 * 4; if (r < I_) { jb.W = in.p[I_WOB] + (size_t)l * 512 * D; jb.ld = D; jb.K = D; jb.N = D; jb.WT = (bf16*)(F.ws + WS_WOA) + (size_t)l * D * D + 512; jb.rowstep = 128; jb.row_off = 0; jb.gk = nullptr; found = true; } else r -= I_; }
                TTJOBG(in.p[I_WOUT] + (size_t)l * D * D, D, D, D, (bf16*)(F.ws + WS_WOUT) + (size_t)l * D * D, 128, 0, nullptr)
                TTJOBG(in.p[I_WPG] + (size_t)l * D * D, D, D, D, (bf16*)(F.ws + WS_WPG) + (size_t)l * D * D, 128, 0, (l == 0) ? in.p[I_GPLE] : nullptr)
                TTJOBG(in.p[I_WPP] + (size_t)l * PLE * D, D, PLE, D, (bf16*)(F.ws + WS_WPP) + (size_t)l * D * PLE, 128, 0, nullptr)
            }
            TTJOBG(in.p[I_WD1], DFF, D, DFF, (bf16*)(F.ws + WS_WD13), 256, 0, in.p[I_GFFN])
            TTJOBG(in.p[I_WD3], DFF, D, DFF, (bf16*)(F.ws + WS_WD13), 256, 128, in.p[I_GFFN])
            TTJOBG(in.p[I_WD2], D, DFF, D, (bf16*)(F.ws + WS_WD2), 128, 0, nullptr)
    if (found) tr_tile(jb.W, jb.ld, jb.K, jb.N / 256, jb.WT, jb.rowstep, jb.row_off, (LAS float*)(F.lds + RING_OFF), r, F.wave, lane, jb.gk, jb.nrows == 33);
}
constexpr int P_CHUNKS = 64;
__device__ __forceinline__ void p_chunk(Frame& F, const Inputs& in, int c, int tid) {
    const size_t n8 = (size_t)2 * M * PLE / 8, per = n8 / P_CHUNKS;
    for (size_t i = (size_t)c * per + tid; i < (size_t)(c + 1) * per; i += NTHR) {
        const f32x4 a = *(const f32x4*)(in.p[I_P] + i * 8), b = *(const f32x4*)(in.p[I_P] + i * 8 + 4);
        v4u o; o.x = pk2(a[0], a[1]); o.y = pk2(a[2], a[3]); o.z = pk2(b[0], b[1]); o.w = pk2(b[2], b[3]);
        *(v4u*)((bf16*)(F.ws + WS_PB) + i * 8) = o; }
}
__device__ __forceinline__ void p0_prologue(Frame& F, const Inputs& in, int parts = 7) {
    PHASE_LOCALS();
    LAS float* scr = (LAS float*)(F.lds + RING_OFF + F.wave * 16384);
    const int gw = F.vcu * NWAVES + F.wave, NGW = F.G * NWAVES;
    if (parts & 1) {
        for (int it = F.vcu; it < P0_URGENT; it += F.G) p0_tile(F, in, it, lane);
        for (int it = gw; it < 32; it += NGW) { const int l = it >> 4;
            tr_item(in.p[I_WIN] + (size_t)l * D * NIN + 3584, NIN, D, 32, (bf16*)(F.ws + WS_WIN) + (size_t)l * NPROJX * D, 128, 5632, scr, it & 15, lane, in.p[I_GMIX] + l * D, 8); }
    }
    if (parts & 2) { pg8::ssq_t* SS0 = (pg8::ssq_t*)(F.ws + WS_SS0); bf16* XB = (bf16*)(F.ws + WS_XB);
      for (int m = gw; m < M; m += NGW) { const f32x4* xr = (const f32x4*)(in.p[I_X] + (size_t)m * D) + lane; unsigned long long* o8 = (unsigned long long*)(XB + (size_t)m * D) + lane; float ss = 0.f;
#pragma unroll
          for (int j = 0; j < 4; ++j) { const f32x4 v = xr[64 * j]; ss += (v[0] * v[0] + v[1] * v[1]) + (v[2] * v[2] + v[3] * v[3]); o8[64 * j] = (unsigned long long)pk2(v[0], v[1]) | ((unsigned long long)pk2(v[2], v[3]) << 32); }
          ss = wave_sum(ss, lane); if (lane == 0) SS0[m] = pg8::ss_fix(ss); } }
}
__device__ __forceinline__ void p_conv_expert(Frame& F, const Inputs& in, int e) {
    PHASE_LOCALS();
    LAS float* scr = (LAS float*)(F.lds + RING_OFF + F.wave * 16384);
    const int gw = F.vcu * NWAVES + F.wave, NGW = F.G * NWAVES;
    constexpr int NITEMS = 2 * (16 * 112) + 56 * 32;
    bf16* W13 = (bf16*)(F.ws + WS_WE); bf16* W2 = W13 + (size_t)2 * DFFE * D;
    for (int it = gw; it < NITEMS; it += NGW) {
        int r = it; bool found = false; TrJob jb;
        jb.W = nullptr; jb.ld = 0; jb.K = 64; jb.N = 32; jb.WT = nullptr; jb.rowstep = 128; jb.row_off = 0; jb.gk = nullptr; jb.nrows = 32;
        TRJOB(in.p[I_WE1] + (size_t)e * D * DFFE, DFFE, D, DFFE, W13, 256, 0)
        TRJOB(in.p[I_WE3] + (size_t)e * D * DFFE, DFFE, D, DFFE, W13, 256, 128)
        TRJOB(in.p[I_WE2] + (size_t)e * DFFE * D, D, DFFE, D, W2, 128, 0)
        if (found) tr_item(jb.W, jb.ld, jb.K, jb.N, jb.WT, jb.rowstep, jb.row_off, scr, r, lane, jb.gk, jb.nrows);
    }
}

template <int MODE>
__device__ __forceinline__ void phase_norm(Frame& F, const float* xsrc, const float* g, bf16* hb, const float* wx, int ldw, const float* b_i, const float* b_f, float* ifpre, float* gsel) {
    PHASE_LOCALS();
    LAS float* wl = (LAS float*)F.lds;
    if (MODE == 1 || MODE == 2) {
        for (int i = tid; i < 1024 * 2; i += NTHR) { const int c = i >> 1, hlf = i & 1; *(LAS f32x4*)(wl + c * 8 + 4 * hlf) = *(const f32x4*)(wx + (size_t)c * ldw + 4 * hlf); }
        __syncthreads();
    }
    const int gw = F.vcu * NWAVES + F.wave, NGW = F.G * NWAVES;
    f32x4 gv[4];
#pragma unroll
    for (int j = 0; j < 4; ++j) gv[j] = ((const f32x4*)g)[lane + 64 * j];
    f32x4 vn[4]; uint2 yan[4], ybn[4]; float2 tgn = make_float2(0.f, 0.f), tgc = tgn; int2 tdn = make_int2(0, 0);
#pragma unroll
    for (int j = 0; j < 4; ++j) { vn[j] = (f32x4){0.f, 0.f, 0.f, 0.f}; yan[j] = make_uint2(0u, 0u); ybn[j] = make_uint2(0u, 0u); }
    if (gw < M) {
        if (MODE == 3) { tgc = *(const float2*)((const float*)(F.ws + WS_TOPG) + (size_t)gw * 2); const int2 td0 = *(const int2*)((const int*)(F.ws + WS_DEST) + (size_t)gw * 2);
            const bf16* y1 = (const bf16*)(F.ws + WS_Y) + (size_t)td0.x * D; const bf16* y2 = (const bf16*)(F.ws + WS_Y) + (size_t)td0.y * D;
#pragma unroll
            for (int j = 0; j < 4; ++j) { yan[j] = *(const uint2*)(y1 + 4 * lane + 256 * j); ybn[j] = *(const uint2*)(y2 + 4 * lane + 256 * j); }
            if (gw + NGW < M) { tgn = *(const float2*)((const float*)(F.ws + WS_TOPG) + (size_t)(gw + NGW) * 2); tdn = *(const int2*)((const int*)(F.ws + WS_DEST) + (size_t)(gw + NGW) * 2); } }
#pragma unroll
        for (int j = 0; j < 4; ++j) vn[j] = ((const f32x4*)(xsrc + (size_t)gw * D) + lane)[64 * j];
    }
    for (int m = gw; m < M; m += NGW) {
        f32x4 v[4]; uint2 ya[4], yb[4]; float s = 0.f; const float2 tg = tgc;
#pragma unroll
        for (int j = 0; j < 4; ++j) { v[j] = vn[j]; ya[j] = yan[j]; yb[j] = ybn[j]; }
        if (m + NGW < M) {
            const int mn = m + NGW;
            if (MODE == 3) { tgc = tgn; const bf16* y1 = (const bf16*)(F.ws + WS_Y) + (size_t)tdn.x * D; const bf16* y2 = (const bf16*)(F.ws + WS_Y) + (size_t)tdn.y * D;
#pragma unroll
                for (int j = 0; j < 4; ++j) { yan[j] = *(const uint2*)(y1 + 4 * lane + 256 * j); ybn[j] = *(const uint2*)(y2 + 4 * lane + 256 * j); }
                if (mn + NGW < M) { tgn = *(const float2*)((const float*)(F.ws + WS_TOPG) + (size_t)(mn + NGW) * 2); tdn = *(const int2*)((const int*)(F.ws + WS_DEST) + (size_t)(mn + NGW) * 2); } }
#pragma unroll
            for (int j = 0; j < 4; ++j) vn[j] = ((const f32x4*)(xsrc + (size_t)mn * D) + lane)[64 * j];
        }
        if (MODE == 3) {
#pragma unroll
            for (int j = 0; j < 4; ++j) { const uint2 a = ya[j], b = yb[j];
                v[j][0] += tg.x * bflo(a.x) + tg.y * bflo(b.x); v[j][1] += tg.x * bfhi(a.x) + tg.y * bfhi(b.x); v[j][2] += tg.x * bflo(a.y) + tg.y * bflo(b.y); v[j][3] += tg.x * bfhi(a.y) + tg.y * bfhi(b.y);
                ((f32x4*)(const_cast<float*>(xsrc) + (size_t)m * D))[lane + 64 * j] = v[j]; }
        }
#pragma unroll
        for (int j = 0; j < 4; ++j) s += (v[j][0] * v[j][0] + v[j][1] * v[j][1]) + (v[j][2] * v[j][2] + v[j][3] * v[j][3]);
        const float rstd = 1.0f / sqrtf(wave_sum(s, lane) * (1.0f / D) + RMS_EPS);
        unsigned long long* o8 = (unsigned long long*)(hb + (size_t)m * D) + lane;
#pragma unroll
        for (int j = 0; j < 4; ++j) { v[j] = v[j] * rstd * gv[j];
            o8[64 * j] = (unsigned long long)pk2(v[j][0], v[j][1]) | ((unsigned long long)pk2(v[j][2], v[j][3]) << 32); }
        if (MODE == 1 || MODE == 2) {
            float a[8];
#pragma unroll
            for (int k = 0; k < 8; ++k) a[k] = 0.f;
#pragma unroll
            for (int j = 0; j < 4; ++j)
#pragma unroll
                for (int q = 0; q < 4; ++q) { const int c = 4 * lane + 256 * j + q; const f32x4 w0 = *(const LAS f32x4*)(wl + c * 8), w1 = *(const LAS f32x4*)(wl + c * 8 + 4); const float y = v[j][q];
                    a[0] += y * w0[0]; a[1] += y * w0[1]; a[2] += y * w0[2]; a[3] += y * w0[3]; a[4] += y * w1[0]; a[5] += y * w1[1]; a[6] += y * w1[2]; a[7] += y * w1[3]; }
#pragma unroll
            for (int k = 0; k < 8; ++k) a[k] = wave_sum(a[k], lane);
            if (MODE == 1) {
                if (lane == 0) {
                    f32x4 o0 = {a[0] + b_i[0], a[1] + b_i[1], a[2] + b_i[2], a[3] + b_i[3]}, o1 = {a[4] + b_f[0], a[5] + b_f[1], a[6] + b_f[2], a[7] + b_f[3]};
                    *(f32x4*)(ifpre + (size_t)m * 8) = o0; *(f32x4*)(ifpre + (size_t)m * 8 + 4) = o1; }
            } else {
                int i1 = 0; float v1 = a[0];
#pragma unroll
                for (int k = 1; k < 8; ++k) if (a[k] > v1) { v1 = a[k]; i1 = k; }
                int i2 = -1; float v2 = -INFINITY;
#pragma unroll
                for (int k = 0; k < 8; ++k) if (k != i1 && a[k] > v2) { v2 = a[k]; i2 = k; }
                const float g1 = 1.0f / (1.0f + expf(v2 - v1)), g2 = 1.0f - g1;
                if (lane < 8) gsel[(size_t)m * 8 + lane] = (lane == i1) ? g1 : (lane == i2) ? g2 : 0.f;
                if (lane == 0) { *(int2*)((int*)(F.ws + WS_TOPI) + (size_t)m * 2) = make_int2(i1, i2); *(float2*)((float*)(F.ws + WS_TOPG) + (size_t)m * 2) = make_float2(g1, g2); }
            }
        }
    }
    if (MODE == 1 || MODE == 2) __syncthreads();
}

__device__ __forceinline__ void phase_prep(Frame& F, const Inputs& in, int l, int parts = 3) {
    PHASE_LOCALS();
    bf16* PROJ = (bf16*)(F.ws + WS_PROJ); float* kmean = (float*)(F.ws + WS_KMEAN); bf16* QKC = (bf16*)(F.ws + WS_QKC);
    const float* gq = in.p[I_GQ] + l * AHD; const float* gk = in.p[I_GK] + l * AHD;
    LAS float* kt = (LAS float*)F.lds; LAS float* part = kt + 256 * 65;
    if (parts & 1) for (int u = F.vcu; u < (M / 256) * AH; u += F.G) {
        const int pm = u >> 3, h = u & 7, row = tid >> 1, hf = tid & 1; const size_t grow = (size_t)pm * 256 + row;
#pragma unroll
        for (int which = 0; which < 2; ++which) {
            bf16* ptr = PROJ + grow * NPROJ + (which ? PC_K : PC_Q) + h * AHD + hf * 32; const float* gg = (which ? gk : gq) + hf * 32;
            bf16* optr = (parts & 4) ? (bf16*)(F.ws + WS_MIXED) + (grow & 255) * NPROJ + (which ? PC_K : PC_Q) + h * AHD + hf * 32 : ptr;
            float v[32]; float ss = 0.f;
#pragma unroll
            for (int i = 0; i < 4; ++i) { const v4u w = *(const v4u*)(ptr + 8 * i);
                v[8 * i + 0] = bflo(w.x); v[8 * i + 1] = bfhi(w.x); v[8 * i + 2] = bflo(w.y); v[8 * i + 3] = bfhi(w.y); v[8 * i + 4] = bflo(w.z); v[8 * i + 5] = bfhi(w.z); v[8 * i + 6] = bflo(w.w); v[8 * i + 7] = bfhi(w.w); }
#pragma unroll
            for (int i = 0; i < 32; ++i) ss += v[i] * v[i];
            ss += shx(ss, 1, lane);
            const float r = (1.0f / sqrtf(ss * (1.0f / AHD) + RMS_EPS)) * (which ? 1.0f : C2);
#pragma unroll
            for (int i = 0; i < 32; ++i) v[i] = v[i] * r * gg[i];
            if (which) {
#pragma unroll
                for (int i = 0; i < 32; ++i) kt[row * 65 + hf * 32 + i] = v[i]; }
#pragma unroll
            for (int i = 0; i < 4; ++i) { v4u o; o.x = pk2(v[8 * i], v[8 * i + 1]); o.y = pk2(v[8 * i + 2], v[8 * i + 3]); o.z = pk2(v[8 * i + 4], v[8 * i + 5]); o.w = pk2(v[8 * i + 6], v[8 * i + 7]); *(v4u*)(optr + 8 * i) = o; }
        }
        __syncthreads();
        { const int c = tid & 63, pt = tid >> 6; float s = 0.f;
            for (int i = 0; i < 32; ++i) s += kt[(pt * 32 + i) * 65 + c];
            part[pt * 64 + c] = s; }
        __syncthreads();
        if (tid < 64) { float tot = 0.f;
#pragma unroll
            for (int pt = 0; pt < 8; ++pt) tot += part[pt * 64 + tid];
            const int b = pm >> 4, n = pm & 15;
            ((parts & 4) ? (float*)(F.ws + WS_MIXED) + 4 * 1024 * 1024 : kmean)[(((size_t)(b * AH + h)) * ANB + n) * AHD + tid] = tot * (1.0f / ABLK); }
        __syncthreads();
    }
    if (parts & 2) {
        const float* cw = in.p[I_CONVW] + (size_t)l * 4 * 1024; const float* cb = in.p[I_CONVB] + (size_t)l * 1024;
        const int ch = tid & 127, c0 = ch * 8; const float sc = (c0 >= 512) ? 0.08838834764831845f : 1.0f;
        float w[4][8], bia[8];
#pragma unroll
        for (int j = 0; j < 4; ++j) { const f32x4 w0 = *(const f32x4*)(cw + j * 1024 + c0), w1 = *(const f32x4*)(cw + j * 1024 + c0 + 4);
            w[j][0] = w0[0]; w[j][1] = w0[1]; w[j][2] = w0[2]; w[j][3] = w0[3]; w[j][4] = w1[0]; w[j][5] = w1[1]; w[j][6] = w1[2]; w[j][7] = w1[3]; }
        { const f32x4 b0 = *(const f32x4*)(cb + c0), b1 = *(const f32x4*)(cb + c0 + 4); bia[0] = b0[0]; bia[1] = b0[1]; bia[2] = b0[2]; bia[3] = b0[3]; bia[4] = b1[0]; bia[5] = b1[1]; bia[6] = b1[2]; bia[7] = b1[3]; }
        for (int run = F.vcu * 4 + (tid >> 7); run < M / 16; run += F.G * 4) {
            const int r0 = run * 16, t0 = r0 & (SEQ - 1);
            v4u xin[19];
#pragma unroll
            for (int i = 0; i < 19; ++i) { xin[i] = (v4u){0u, 0u, 0u, 0u}; if (i >= 3 || t0 > 0) xin[i] = *(const v4u*)(PROJ + (size_t)(r0 - 3 + i) * NPROJ + PC_QKM + c0); }
#pragma unroll
            for (int i = 0; i < 16; ++i) { float a[8];
#pragma unroll
                for (int k = 0; k < 8; ++k) a[k] = bia[k];
#pragma unroll
                for (int j = 0; j < 4; ++j) { const v4u x = xin[i + j];
                    a[0] += w[j][0] * bflo(x.x); a[1] += w[j][1] * bfhi(x.x); a[2] += w[j][2] * bflo(x.y); a[3] += w[j][3] * bfhi(x.y); a[4] += w[j][4] * bflo(x.z); a[5] += w[j][5] * bfhi(x.z); a[6] += w[j][6] * bflo(x.w); a[7] += w[j][7] * bfhi(x.w); }
#pragma unroll
                for (int k = 0; k < 8; ++k) a[k] = a[k] * sigm(a[k]) * sc;
                v4u o; o.x = pk2(a[0], a[1]); o.y = pk2(a[2], a[3]); o.z = pk2(a[4], a[5]); o.w = pk2(a[6], a[7]);
                *(v4u*)(QKC + (size_t)(r0 + i) * 1024 + c0) = o; }
        }
    }
}

__device__ __forceinline__ float dot64(const bf16* kr, const float (&q)[64]) {
    float a = 0.f;
#pragma unroll
    for (int i = 0; i < 8; ++i) { const v4u w = *(const v4u*)(kr + 8 * i);
        a += q[8 * i] * bflo(w.x) + q[8 * i + 1] * bfhi(w.x) + q[8 * i + 2] * bflo(w.y) + q[8 * i + 3] * bfhi(w.y) + q[8 * i + 4] * bflo(w.z) + q[8 * i + 5] * bfhi(w.z) + q[8 * i + 6] * bflo(w.w) + q[8 * i + 7] * bfhi(w.w); }
    return a;
}
__device__ __forceinline__ void phase_attn_naive(Frame& F) {
    const bf16* PROJ = (const bf16*)(F.ws + WS_PROJ); const float* kmean = (const float*)(F.ws + WS_KMEAN); bf16* YA = (bf16*)(F.ws + WS_YA);
    LAS float* sc = (LAS float*)F.lds + F.wave * 1088; LAS float* qs = sc + 1024;
    const int gw = F.vcu * NWAVES + F.wave, NGW = F.G * NWAVES, lane = lane_now();
    for (int item = gw; item < BATCH * AH * SEQ; item += NGW) {
        const int q = item & (SEQ - 1), bh = item >> 12, b = bh >> 3, h = bh & 7, blk = q >> 8;
        const size_t rb = (size_t)b * SEQ;
        qs[lane] = bf2f(PROJ[(rb + q) * NPROJ + PC_Q + h * AHD + lane]);
        asm volatile("s_waitcnt lgkmcnt(0)" ::: "memory");
        float qr[64];
#pragma unroll
        for (int i = 0; i < 16; ++i) { const f32x4 t = *(const LAS f32x4*)(qs + 4 * i); qr[4 * i] = t[0]; qr[4 * i + 1] = t[1]; qr[4 * i + 2] = t[2]; qr[4 * i + 3] = t[3]; }
        float gv = -INFINITY;
        if (lane < blk) { const float* km = kmean + ((size_t)bh * ANB + lane) * AHD; float a = 0.f;
#pragma unroll
            for (int i = 0; i < 16; ++i) { const f32x4 t = *(const f32x4*)(km + 4 * i); a += qr[4 * i] * t[0] + qr[4 * i + 1] * t[1] + qr[4 * i + 2] * t[2] + qr[4 * i + 3] * t[3]; }
            gv = a; }
        unsigned selmask = 0u;
        for (int s = 0; s < 3 && s < blk; ++s) { const float mx = wave_max(gv, lane); const unsigned long long bal = __ballot(gv == mx && lane < blk); const int idx = __ffsll((long long)bal) - 1;
            selmask |= 1u << idx; if (lane == idx) gv = -INFINITY; }
        int slot = 0;
        for (int n = 0; n < blk; ++n) if ((selmask >> n) & 1u) {
#pragma unroll
            for (int jj = 0; jj < 4; ++jj) { const int key = n * ABLK + lane + 64 * jj; sc[slot * 256 + lane + 64 * jj] = dot64(PROJ + (rb + key) * NPROJ + PC_K + h * AHD, qr); }
            ++slot; }
#pragma unroll
        for (int jj = 0; jj < 4; ++jj) { const int key = blk * ABLK + lane + 64 * jj; const float a = dot64(PROJ + (rb + key) * NPROJ + PC_K + h * AHD, qr); sc[slot * 256 + lane + 64 * jj] = (key > q) ? -INFINITY : a; }
        const int ntot = (slot + 1) * 256;
        asm volatile("s_waitcnt lgkmcnt(0)" ::: "memory");
        float mx = -INFINITY; for (int i = lane; i < ntot; i += 64) mx = fmaxf(mx, sc[i]); mx = wave_max(mx, lane);
        float sum = 0.f; for (int i = lane; i < ntot; i += 64) { const float p = pg8::ex2(sc[i] - mx); sc[i] = p; sum += p; } sum = wave_sum(sum, lane);
        asm volatile("s_waitcnt lgkmcnt(0)" ::: "memory");
        float o = 0.f; slot = 0;
        for (int n = 0; n < blk; ++n) if ((selmask >> n) & 1u) { const bf16* vp = PROJ + (rb + n * ABLK) * NPROJ + PC_V + h * AHD + lane;
            for (int j = 0; j < 256; ++j) o += sc[slot * 256 + j] * bf2f(vp[(size_t)j * NPROJ]);
            ++slot; }
        { const bf16* vp = PROJ + (rb + blk * ABLK) * NPROJ + PC_V + h * AHD + lane; const int je = q - blk * ABLK;
            for (int j = 0; j <= je; ++j) o += sc[slot * 256 + j] * bf2f(vp[(size_t)j * NPROJ]); }
        YA[(rb + q) * 1024 + h * AHD + lane] = (bf16)f2bf(o / sum);
        asm volatile("s_waitcnt lgkmcnt(0)" ::: "memory");
    }
}

__device__ __forceinline__ void phase_mlstm_naive(Frame& F, const Inputs& in, int l) {
    if (blockIdx.x >= BATCH * MH) return;
    const bf16* PROJ = (const bf16*)(F.ws + WS_PROJ); const bf16* QKC = (const bf16*)(F.ws + WS_QKC); const float* ifpre = (const float*)(F.ws + WS_IFPRE); bf16* YB = (bf16*)(F.ws + WS_YB);
    const float* gh = in.p[I_GH] + l * MDK;
    const int bh = blockIdx.x, b = bh >> 2, h = bh & 3, tid = F.wave * 64 + lane_now(), lane = tid & 63, e = tid & 127, g = tid >> 7;
    LAS float* qs = (LAS float*)F.lds; LAS float* ks = qs + 16 * 128; LAS float* vs = ks + 16 * 128; LAS float* red = vs + 16 * 128; LAS float* redd = red + 16 * 4 * 128;
    LAS float* gi = redd + 64; LAS float* gf = gi + 16; LAS float* ms = gf + 16;
    float C[32], nn[32];
#pragma unroll
    for (int i = 0; i < 32; ++i) { C[i] = 0.f; nn[i] = 0.f; }
    float m = 0.f;
    for (int t0 = 0; t0 < SEQ; t0 += 16) {
        for (int i = tid; i < 16 * 128; i += NTHR) { const int st = i >> 7, d = i & 127; const size_t r = (size_t)b * SEQ + t0 + st;
            qs[i] = bf2f(QKC[r * 1024 + h * MDK + d]); ks[i] = bf2f(QKC[r * 1024 + 512 + h * MDK + d]); vs[i] = bf2f(PROJ[r * NPROJ + PC_VM + h * MDK + d]); }
        if (tid < 16) { const size_t r = (size_t)b * SEQ + t0 + tid; gi[tid] = ifpre[r * 8 + h]; const float x = ifpre[r * 8 + 4 + h]; gf[tid] = fminf(x, 0.f) - log1pf(expf(-fabsf(x))); }
        __syncthreads();
        for (int st = 0; st < 16; ++st) {
            const float li = gi[st], lf = gf[st], mn = fmaxf(lf + m, li), wC = expf(lf + m - mn), wS = expf(li - mn); m = mn;
            const float ve = vs[st * 128 + e]; float pn = 0.f, pd = 0.f;
#pragma unroll
            for (int i4 = 0; i4 < 8; ++i4) { const f32x4 k4 = *(const LAS f32x4*)(ks + st * 128 + 32 * g + 4 * i4), q4 = *(const LAS f32x4*)(qs + st * 128 + 32 * g + 4 * i4);
#pragma unroll
                for (int j = 0; j < 4; ++j) { const int i = 4 * i4 + j; const float kd = wS * k4[j]; C[i] = wC * C[i] + kd * ve; nn[i] = wC * nn[i] + kd; pn += q4[j] * C[i]; pd += q4[j] * nn[i]; } }
            red[(st * 4 + g) * 128 + e] = pn; if (e == 0) redd[st * 4 + g] = pd; if (tid == 0) ms[st] = mn;
        }
        __syncthreads();
#pragma unroll
        for (int s2 = 0; s2 < 2; ++s2) { const int st = 2 * F.wave + s2; const float den = (redd[st * 4] + redd[st * 4 + 1]) + (redd[st * 4 + 2] + redd[st * 4 + 3]);
            const float dn = 1.0f / fmaxf(fabsf(den), expf(-ms[st]));
            const float h0 = ((red[(st * 4) * 128 + lane] + red[(st * 4 + 1) * 128 + lane]) + (red[(st * 4 + 2) * 128 + lane] + red[(st * 4 + 3) * 128 + lane])) * dn;
            const float h1 = ((red[(st * 4) * 128 + 64 + lane] + red[(st * 4 + 1) * 128 + 64 + lane]) + (red[(st * 4 + 2) * 128 + 64 + lane] + red[(st * 4 + 3) * 128 + 64 + lane])) * dn;
            const float rr = 1.0f / sqrtf(wave_sum(h0 * h0 + h1 * h1, lane) * (1.0f / MDK) + RMS_EPS);
            const size_t r = (size_t)b * SEQ + t0 + st;
            const float o0 = sigm(bf2f(PROJ[r * NPROJ + PC_OM + h * MDK + lane])), o1 = sigm(bf2f(PROJ[r * NPROJ + PC_OM + h * MDK + 64 + lane]));
            YB[r * 1024 + h * MDK + lane] = (bf16)f2bf(h0 * rr * gh[lane] * o0); YB[r * 1024 + h * MDK + 64 + lane] = (bf16)f2bf(h1 * rr * gh[64 + lane] * o1); }
        __syncthreads();
    }
}
typedef short bf16x8s __attribute__((ext_vector_type(8)));
typedef short s16x4 __attribute__((ext_vector_type(4)));
typedef float f32x16 __attribute__((ext_vector_type(16)));
constexpr size_t ST_DCT = WS_ST, ST_DN = WS_ST + 16 * MiB, ST_NIN = ST_DN + 128 * 1024, ST_MLOC = ST_NIN + 128 * 1024, ST_BL = ST_MLOC + 4096, ST_MIN = ST_BL + 4096;
constexpr size_t ST_CINT = WS_MIXED;
constexpr int SM_OFF = LDSCTL_OFF + 1024;
__device__ __forceinline__ unsigned off_b(unsigned row, unsigned ch) { return 256u * row + 16u * (ch ^ (((row & 3u) << 2) | ((row >> 2) & 3u))); }
__device__ __forceinline__ s16x4 vtr(const LAS unsigned char* p) { return __builtin_bit_cast(s16x4, __builtin_amdgcn_ds_read_tr16_b64_v4i16((LAS s16x4*)p)); }
__device__ __forceinline__ int crow(int r, int hi) { return (r & 3) + 8 * (r >> 2) + 4 * hi; }
__device__ __forceinline__ float shu(float v, int o, int lane) { return __int_as_float(__builtin_amdgcn_ds_bpermute((lane - o) << 2, __float_as_int(v))); }
__device__ __forceinline__ float shl(float v, int src) { return __int_as_float(__builtin_amdgcn_ds_bpermute(src << 2, __float_as_int(v))); }
__device__ __forceinline__ float logsig(float x) { return fminf(x, 0.f) - log1pf(expf(-fabsf(x))); }
__device__ __forceinline__ bf16x8s tr_frag(const LAS unsigned char* img, int lane, int row0, int c) {
    const unsigned h = lane >> 5, blk = (lane >> 4) & 1, q = (lane & 15) >> 2, p = lane & 3;
    const s16x4 lo = vtr(img + off_b(row0 + 8 * h + q, 4 * c + 2 * blk + (p >> 1)) + 8 * (p & 1)), hi = vtr(img + off_b(row0 + 8 * h + 4 + q, 4 * c + 2 * blk + (p >> 1)) + 8 * (p & 1));
    return (bf16x8s){lo[0], lo[1], lo[2], lo[3], hi[0], hi[1], hi[2], hi[3]};
}
__device__ __forceinline__ bf16x8s tr_frag_perm(const LAS unsigned char* img, int lane, int row0, int c) {
    const unsigned h = lane >> 5, blk = (lane >> 4) & 1, q = (lane & 15) >> 2, p = lane & 3;
    const s16x4 lo = vtr(img + off_b(row0 + 4 * h + q, 4 * c + 2 * blk + (p >> 1)) + 8 * (p & 1)), hi = vtr(img + off_b(row0 + 8 + 4 * h + q, 4 * c + 2 * blk + (p >> 1)) + 8 * (p & 1));
    return (bf16x8s){lo[0], lo[1], lo[2], lo[3], hi[0], hi[1], hi[2], hi[3]};
}
__device__ __forceinline__ void chunk_gates(const float* ifpre, size_t row0, int h, int lane, float (&bc)[4], float (&ii)[4], float& bL) {
#pragma unroll
    for (int k = 0; k < 4; ++k) { const size_t r = row0 + 4 * lane + k; ii[k] = ifpre[r * 8 + h]; bc[k] = logsig(ifpre[r * 8 + 4 + h]); }
    bc[1] += bc[0]; bc[2] += bc[1]; bc[3] += bc[2];
    float inc = bc[3];
#pragma unroll
    for (int o = 1; o < 64; o <<= 1) { const float t = shu(inc, o, lane); if (lane >= o) inc += t; }
    const float excl = inc - bc[3];
#pragma unroll
    for (int k = 0; k < 4; ++k) bc[k] += excl;
    bL = shl(inc, 63);
}

__device__ __forceinline__ void phase_mlstm_m1(Frame& F, const Inputs& in, int l) {
    PHASE_LOCALS();
    const bf16* PROJ = (const bf16*)(F.ws + WS_PROJ); bf16* QKC = (bf16*)(F.ws + WS_QKC); const float* ifpre = (const float*)(F.ws + WS_IFPRE);
    float* dCT = (float*)(F.ws + ST_DCT); float* DN = (float*)(F.ws + ST_DN); float* MLOC = (float*)(F.ws + ST_MLOC); float* BL = (float*)(F.ws + ST_BL);
    LAS unsigned char* Kimg = F.lds; LAS unsigned char* Vimg = F.lds + 65536; LAS float* sw = (LAS float*)(F.lds + SM_OFF);
    const int r32 = lane & 31, hi = lane >> 5;
    for (int unit = F.vcu; unit < BATCH * MH * 16; unit += F.G) {
        const int bh = unit >> 4, c = unit & 15, b = bh >> 2, h = bh & 3; const size_t row0 = (size_t)b * SEQ + c * 256;
        { const float* cw = in.p[I_CONVW] + (size_t)l * 4 * 1024; const float* cb = in.p[I_CONVB] + (size_t)l * 1024;
          const int cc = tid & 31, c0 = (cc < 16 ? 0 : 512) + h * MDK + 8 * (cc & 15), run = tid >> 5; const float sc = (cc >= 16) ? 0.08838834764831845f : 1.0f;
          float w[4][8], bia[8];
#pragma unroll
          for (int j = 0; j < 4; ++j) { const f32x4 w0 = *(const f32x4*)(cw + j * 1024 + c0), w1 = *(const f32x4*)(cw + j * 1024 + c0 + 4);
              w[j][0] = w0[0]; w[j][1] = w0[1]; w[j][2] = w0[2]; w[j][3] = w0[3]; w[j][4] = w1[0]; w[j][5] = w1[1]; w[j][6] = w1[2]; w[j][7] = w1[3]; }
          { const f32x4 b0 = *(const f32x4*)(cb + c0), b1 = *(const f32x4*)(cb + c0 + 4); bia[0] = b0[0]; bia[1] = b0[1]; bia[2] = b0[2]; bia[3] = b0[3]; bia[4] = b1[0]; bia[5] = b1[1]; bia[6] = b1[2]; bia[7] = b1[3]; }
          const size_t r0 = row0 + 16 * run; const bool first = (c == 0 && run == 0);
          v4u xin[19];
#pragma unroll
          for (int i = 0; i < 19; ++i) { xin[i] = (v4u){0u, 0u, 0u, 0u}; if (i >= 3 || !first) xin[i] = *(const v4u*)(PROJ + (r0 - 3 + i) * NPROJ + PC_QKM + c0); }
#pragma unroll
          for (int i = 0; i < 16; ++i) { float a[8];
#pragma unroll
              for (int k = 0; k < 8; ++k) a[k] = bia[k];
#pragma unroll
              for (int j = 0; j < 4; ++j) { const v4u x = xin[i + j];
                  a[0] += w[j][0] * bflo(x.x); a[1] += w[j][1] * bfhi(x.x); a[2] += w[j][2] * bflo(x.y); a[3] += w[j][3] * bfhi(x.y); a[4] += w[j][4] * bflo(x.z); a[5] += w[j][5] * bfhi(x.z); a[6] += w[j][6] * bflo(x.w); a[7] += w[j][7] * bfhi(x.w); }
#pragma unroll
              for (int k = 0; k < 8; ++k) a[k] = a[k] * sigm(a[k]) * sc;
              v4u o; o.x = pk2(a[0], a[1]); o.y = pk2(a[2], a[3]); o.z = pk2(a[4], a[5]); o.w = pk2(a[6], a[7]);
              *(v4u*)(QKC + (r0 + i) * 1024 + c0) = o; } }
        if (F.wave == 0) {
            float bc[4], ii[4], bL; chunk_gates(ifpre, row0, h, lane, bc, ii, bL);
            float g[4]; float mx = -INFINITY;
#pragma unroll
            for (int k = 0; k < 4; ++k) { g[k] = bL - bc[k] + ii[k]; mx = fmaxf(mx, g[k]); }
            mx = wave_max(mx, lane);
#pragma unroll
            for (int k = 0; k < 4; ++k) sw[4 * lane + k] = pg8::ex2((g[k] - mx) * 1.4426950408889634f);
            if (lane == 0) { MLOC[unit] = mx; BL[unit] = bL; }
        }
        asm volatile("s_waitcnt vmcnt(0)" ::: "memory");
        __syncthreads();
        for (int i = tid; i < 4096; i += NTHR) { const int s = i >> 4, ch = i & 15; const float w = sw[s];
            const v4u kv = *(const v4u*)(QKC + (row0 + s) * 1024 + 512 + h * MDK + 8 * ch);
            v4u ko; ko.x = pk2(bflo(kv.x) * w, bfhi(kv.x) * w); ko.y = pk2(bflo(kv.y) * w, bfhi(kv.y) * w); ko.z = pk2(bflo(kv.z) * w, bfhi(kv.z) * w); ko.w = pk2(bflo(kv.w) * w, bfhi(kv.w) * w);
            *(LAS v4u*)(Kimg + off_b(s, ch)) = ko;
            *(LAS v4u*)(Vimg + off_b(s, ch)) = *(const v4u*)(PROJ + (row0 + s) * NPROJ + PC_VM + h * MDK + 8 * ch); }
        __syncthreads();
        const int dt = F.wave >> 1, c0 = 2 * (F.wave & 1);
        f32x16 acc0, acc1;
#pragma unroll
        for (int i = 0; i < 16; ++i) { acc0[i] = 0.f; acc1[i] = 0.f; }
#pragma unroll 4
        for (int ks = 0; ks < 16; ++ks) {
            const bf16x8s a = tr_frag(Kimg, lane, 16 * ks, dt), b0 = tr_frag(Vimg, lane, 16 * ks, c0), b1 = tr_frag(Vimg, lane, 16 * ks, c0 + 1);
            acc0 = __builtin_amdgcn_mfma_f32_32x32x16_bf16(a, b0, acc0, 0, 0, 0);
            acc1 = __builtin_amdgcn_mfma_f32_32x32x16_bf16(a, b1, acc1, 0, 0, 0);
        }
#pragma unroll
        for (int g = 0; g < 4; ++g) { const int d = 32 * dt + 8 * g + 4 * hi;
            *(f32x4*)(dCT + ((size_t)unit * 128 + 32 * c0 + r32) * 128 + d) = (f32x4){acc0[4 * g], acc0[4 * g + 1], acc0[4 * g + 2], acc0[4 * g + 3]};
            *(f32x4*)(dCT + ((size_t)unit * 128 + 32 * (c0 + 1) + r32) * 128 + d) = (f32x4){acc1[4 * g], acc1[4 * g + 1], acc1[4 * g + 2], acc1[4 * g + 3]}; }
        { const int d = tid & 127, part = tid >> 7; float s0 = 0.f, s1 = 0.f;
#pragma unroll 8
            for (int t = 0; t < 64; t += 2) { s0 += bf2f(*(const LAS bf16*)(Kimg + off_b(64 * part + t, d >> 3) + 2 * (d & 7))); s1 += bf2f(*(const LAS bf16*)(Kimg + off_b(64 * part + t + 1, d >> 3) + 2 * (d & 7))); }
            sw[256 + tid] = s0 + s1; }
        __syncthreads();
        if (tid < 128) DN[(size_t)unit * 128 + tid] = (sw[256 + tid] + sw[256 + 128 + tid]) + (sw[256 + 256 + tid] + sw[256 + 384 + tid]);
        __syncthreads();
    }
}

__device__ __forceinline__ void phase_mlstm_m2(Frame& F) {
    PHASE_LOCALS();
    const float* dCT = (const float*)(F.ws + ST_DCT); const float* DN = (const float*)(F.ws + ST_DN); const float* MLOC = (const float*)(F.ws + ST_MLOC); const float* BL = (const float*)(F.ws + ST_BL);
    bf16* CinT = (bf16*)(F.ws + ST_CINT); float* NIN = (float*)(F.ws + ST_NIN); float* MIN = (float*)(F.ws + ST_MIN);
    LAS float* al = (LAS float*)(F.lds + SM_OFF); LAS float* be = al + 16;
    for (int item = F.vcu; item < 256; item += F.G) {
        const int bh = item >> 4, sl = item & 15;
        if (tid == 0) { float m = 0.f;
            for (int c = 0; c < 16; ++c) { const int u = bh * 16 + c; const float bl = BL[u], ml = MLOC[u]; if (sl == 0) MIN[u] = m;
                const float mo = fmaxf(bl + m, ml); al[c] = expf(bl + m - mo); be[c] = expf(ml - mo); m = mo; } }
        __syncthreads();
        { const size_t idx = (size_t)sl * 1024 + 2 * tid; float s0 = 0.f, s1 = 0.f;
#pragma unroll
            for (int c = 0; c < 16; ++c) { const size_t u = (size_t)bh * 16 + c; const float2 dc = *(const float2*)(dCT + u * 16384 + idx);
                *(unsigned*)(CinT + u * 16384 + idx) = pk2(s0, s1); s0 = al[c] * s0 + be[c] * dc.x; s1 = al[c] * s1 + be[c] * dc.y; } }
        if (sl == 0 && tid < 128) { float s = 0.f;
#pragma unroll
            for (int c = 0; c < 16; ++c) { const size_t u = (size_t)bh * 16 + c; NIN[u * 128 + tid] = s; s = al[c] * s + be[c] * DN[u * 128 + tid]; } }
        __syncthreads();
    }
}

__device__ __forceinline__ void phase_mlstm_m3(Frame& F, const Inputs& in, int l, int reps = 1) {
    PHASE_LOCALS();
    const bf16* PROJ = (const bf16*)(F.ws + WS_PROJ); const bf16* QKC = (const bf16*)(F.ws + WS_QKC); const float* ifpre = (const float*)(F.ws + WS_IFPRE);
    const float* dCT = (const float*)(F.ws + ST_DCT); const float* DN = (const float*)(F.ws + ST_DN); const float* MLOC = (const float*)(F.ws + ST_MLOC); const float* BLV = (const float*)(F.ws + ST_BL); bf16* YB = (bf16*)(F.ws + WS_YB);
    const float* gh = in.p[I_GH] + l * MDK;
    LAS unsigned char* Vimg = F.lds; LAS unsigned char* Cimg = F.lds + 65536; LAS unsigned char* Kimg = F.lds + 65536;
    LAS float* us = (LAS float*)(F.lds + SM_OFF); LAS float* Mt = us + 256; LAS float* aw = Mt + 256; LAS float* em = aw + 256; LAS float* inv = em + 256; LAS float* nin_s = inv + 256; LAS float* coef = nin_s + 128;
    const int r32 = lane & 31, hi = lane >> 5, wave = F.wave;
    for (int unit = F.vcu; unit < reps * BATCH * MH * 16; unit += F.G) {
        const int unit_ = unit; { const int unit = unit_ & (BATCH * MH * 16 - 1);
        const int bh = unit >> 4, c = unit & 15, b = bh >> 2, h = bh & 3; const size_t row0 = (size_t)b * SEQ + c * 256;
        if (tid < 32) coef[tid] = (tid < 16) ? BLV[bh * 16 + tid] : MLOC[bh * 16 + tid - 16];
        for (int i = tid; i < 4096; i += NTHR) { const int s = i >> 4, ch = i & 15;
            *(LAS v4u*)(Vimg + off_b(s, ch)) = *(const v4u*)(PROJ + (row0 + s) * NPROJ + PC_VM + h * MDK + 8 * ch); }
        __syncthreads();
        if (tid == 0) { float mm = 0.f;
            for (int cc = 0; cc < c; ++cc) { const float bl = coef[cc], ml = coef[16 + cc], mo = fmaxf(bl + mm, ml); coef[cc] = pg8::ex2((bl + mm - mo) * 1.4426950408889634f); coef[16 + cc] = pg8::ex2((ml - mo) * 1.4426950408889634f); mm = mo; }
            coef[32] = mm; }
        __syncthreads();
        { float st[32];
#pragma unroll
            for (int i = 0; i < 32; ++i) st[i] = 0.f;
            f32x4 sa[8], sb[8], sc[8];
            const float* sbase = dCT + ((size_t)(bh * 16)) * 16384 + 32 * tid;
#define M3_LD(buf, cc_) do { const int ci_ = ((cc_) < 15) ? (cc_) : 15;   \
                const f32x4* src_ = (const f32x4*)(sbase + (size_t)ci_ * 16384); _Pragma("unroll") for (int i = 0; i < 8; ++i) buf[i] = src_[i]; __builtin_amdgcn_sched_barrier(0); } while (0)
#define M3_FM(buf, cc_) do { if ((cc_) < c) { const float al = coef[(cc_)], be = coef[16 + (cc_)]; \
                _Pragma("unroll") for (int i = 0; i < 8; ++i) { const f32x4 v = buf[i]; st[4 * i] = al * st[4 * i] + be * v[0]; st[4 * i + 1] = al * st[4 * i + 1] + be * v[1]; st[4 * i + 2] = al * st[4 * i + 2] + be * v[2]; st[4 * i + 3] = al * st[4 * i + 3] + be * v[3]; } } \
                __builtin_amdgcn_sched_barrier(0); } while (0)
            if (c > 0) { M3_LD(sa, 0); M3_LD(sb, 1);
                for (int cc = 0; cc < c; cc += 3) { M3_LD(sc, cc + 2); M3_FM(sa, cc); M3_LD(sa, cc + 3); M3_FM(sb, cc + 1); M3_LD(sb, cc + 4); M3_FM(sc, cc + 2); } }
#undef M3_LD
#undef M3_FM
            LAS unsigned char* dst = Cimg + (tid >> 2) * 272 + (tid & 3) * 64;
#pragma unroll
            for (int i = 0; i < 4; ++i) { v4u o; o.x = pk2(st[8 * i], st[8 * i + 1]); o.y = pk2(st[8 * i + 2], st[8 * i + 3]); o.z = pk2(st[8 * i + 4], st[8 * i + 5]); o.w = pk2(st[8 * i + 6], st[8 * i + 7]); *(LAS v4u*)(dst + 16 * i) = o; }
            if (tid < 128) { float dnv[16];
#pragma unroll
                for (int cc = 0; cc < 16; ++cc) dnv[cc] = DN[((size_t)(bh * 16 + cc)) * 128 + tid];
                float sn = 0.f;
#pragma unroll
                for (int cc = 0; cc < 16; ++cc) if (cc < c) sn = coef[cc] * sn + coef[16 + cc] * dnv[cc];
                nin_s[tid] = sn; } }
        if (wave == 0) {
            float bc[4], ii[4], bL; chunk_gates(ifpre, row0, h, lane, bc, ii, bL);
            float u[4], pm[4];
#pragma unroll
            for (int k = 0; k < 4; ++k) u[k] = ii[k] - bc[k];
            pm[0] = u[0]; pm[1] = fmaxf(pm[0], u[1]); pm[2] = fmaxf(pm[1], u[2]); pm[3] = fmaxf(pm[2], u[3]);
            float inc = pm[3];
#pragma unroll
            for (int o = 1; o < 64; o <<= 1) { const float t = shu(inc, o, lane); if (lane >= o) inc = fmaxf(inc, t); }
            float excl = shu(inc, 1, lane); if (lane == 0) excl = -INFINITY;
            const float m_in = coef[32];
#pragma unroll
            for (int k = 0; k < 4; ++k) { const float Mx = fmaxf(m_in, fmaxf(pm[k], excl)); const int s = 4 * lane + k; us[s] = u[k]; Mt[s] = Mx; aw[s] = pg8::ex2((m_in - Mx) * 1.4426950408889634f); em[s] = pg8::ex2(-(bc[k] + Mx) * 1.4426950408889634f); }
        }
        __syncthreads();
        const int t = 32 * wave + r32;
        bf16x8s qf[8];
#pragma unroll
        for (int ks = 0; ks < 8; ++ks) qf[ks] = *(const bf16x8s*)(QKC + (row0 + t) * 1024 + h * MDK + 16 * ks + 8 * hi);
        float qn = 0.f;
#pragma unroll
        for (int ks = 0; ks < 8; ++ks)
#pragma unroll
            for (int j = 0; j < 8; ++j) qn += bf2f((bf16)qf[ks][j]) * nin_s[16 * ks + 8 * hi + j];
        qn += shx(qn, 32, lane);
        f32x16 acc[4];
#pragma unroll
        for (int cc = 0; cc < 4; ++cc)
#pragma unroll
            for (int i = 0; i < 16; ++i) acc[cc][i] = 0.f;
#pragma unroll
        for (int cc = 0; cc < 4; ++cc)
#pragma unroll
            for (int ks = 0; ks < 8; ++ks) { const bf16x8s bq = *(const LAS bf16x8s*)(Cimg + (32 * cc + r32) * 272 + 2 * (16 * ks + 8 * hi));
                acc[cc] = __builtin_amdgcn_mfma_f32_32x32x16_bf16(qf[ks], bq, acc[cc], 0, 0, 0); }
#pragma unroll
        for (int rg = 0; rg < 16; ++rg) { const float a = aw[32 * wave + crow(rg, hi)];
#pragma unroll
            for (int cc = 0; cc < 4; ++cc) acc[cc][rg] *= a; }
        { v4u kst[8];
#pragma unroll
          for (int i = 0; i < 8; ++i) { const int idx = tid + NTHR * i, s_ = idx >> 4, ch = idx & 15; kst[i] = *(const v4u*)(QKC + (row0 + s_) * 1024 + 512 + h * MDK + 8 * ch); }
          __syncthreads();
#pragma unroll
          for (int i = 0; i < 8; ++i) { const int idx = tid + NTHR * i, s_ = idx >> 4, ch = idx & 15; *(LAS v4u*)(Kimg + off_b(s_, ch)) = kst[i]; }
          __syncthreads(); }
        const float Ml = Mt[t]; float den = 0.f;
        for (int j = 0; j <= wave; ++j) {
            f32x16 X;
#pragma unroll
            for (int i = 0; i < 16; ++i) X[i] = 0.f;
#pragma unroll
            for (int ks = 0; ks < 8; ++ks) { const bf16x8s ka = *(const LAS bf16x8s*)(Kimg + off_b(32 * j + r32, 2 * ks + hi));
                X = __builtin_amdgcn_mfma_f32_32x32x16_bf16(ka, qf[ks], X, 0, 0, 0); }
#pragma unroll
            for (int rg = 0; rg < 16; ++rg) { const int s = 32 * j + crow(rg, hi); float w = pg8::ex2((us[s] - Ml) * 1.4426950408889634f); if (s > t) w = 0.f;     const float pv = X[rg] * w; X[rg] = pv; den += pv; }
            v4u p0, p1;
            p0.x = pk2(X[0], X[1]); p0.y = pk2(X[2], X[3]); p0.z = pk2(X[4], X[5]); p0.w = pk2(X[6], X[7]);
            p1.x = pk2(X[8], X[9]); p1.y = pk2(X[10], X[11]); p1.z = pk2(X[12], X[13]); p1.w = pk2(X[14], X[15]);
            const bf16x8s pa0 = __builtin_bit_cast(bf16x8s, p0), pa1 = __builtin_bit_cast(bf16x8s, p1);
#pragma unroll
            for (int cc = 0; cc < 4; ++cc) {
                acc[cc] = __builtin_amdgcn_mfma_f32_32x32x16_bf16(pa0, tr_frag_perm(Vimg, lane, 32 * j, cc), acc[cc], 0, 0, 0);
                acc[cc] = __builtin_amdgcn_mfma_f32_32x32x16_bf16(pa1, tr_frag_perm(Vimg, lane, 32 * j + 16, cc), acc[cc], 0, 0, 0); }
        }
        den += shx(den, 32, lane);
        { const float dt = aw[t] * qn + den; inv[t] = 1.0f / fmaxf(fabsf(dt), em[t]); }
        asm volatile("s_waitcnt lgkmcnt(0)" ::: "memory");
        float rr[16];
#pragma unroll
        for (int rg = 0; rg < 16; ++rg) { const float f = inv[32 * wave + crow(rg, hi)]; float sq = 0.f;
#pragma unroll
            for (int cc = 0; cc < 4; ++cc) { acc[cc][rg] *= f; sq += acc[cc][rg] * acc[cc][rg]; }
#pragma unroll
            for (int o = 1; o < 32; o <<= 1) sq += shx(sq, o, lane);
            rr[rg] = 1.0f / sqrtf(sq * (1.0f / MDK) + RMS_EPS); }
#pragma unroll
        for (int cc = 0; cc < 4; ++cc) { const int e = 32 * cc + r32; const float ge = gh[e];
#pragma unroll
            for (int rg = 0; rg < 16; ++rg) { const size_t r = row0 + 32 * wave + crow(rg, hi);
                const float o = sigm(bf2f(PROJ[r * NPROJ + PC_OM + h * MDK + e]));
                YB[r * 1024 + h * MDK + e] = (bf16)f2bf(acc[cc][rg] * rr[rg] * ge * o); } }
        __syncthreads();
        }
    }
}
#include <hip/hip_bf16.h>
namespace attn_body {
using bf16=__hip_bfloat16;
using bf16x8=__attribute__((ext_vector_type(8)))short;
using s16x4=__attribute__((ext_vector_type(4)))short;
using f32x16=__attribute__((ext_vector_type(16)))float;
using u32x4=__attribute__((ext_vector_type(4)))unsigned;
using f32x4_t=__attribute__((ext_vector_type(4)))float;
constexpr int BATCH=4,NHEAD=8,SEQ=4096,D=64,DM=3584,DMO=1024;
constexpr float NEGBIG=-200.f;
constexpr int NW=8,QBLK=32,QB=QBLK*NW,KVBLK=64,NQB=SEQ/QB;
constexpr int ATTN_PITCH=DM, ATTN_UNIT_ROWS=QB;
__device__ __forceinline__ int crow(int r,int hi){return (r&3)+8*(r>>2)+4*hi;}
#define SBAR() __builtin_amdgcn_sched_barrier(0)
__device__ __forceinline__ void cmask(f32x16&p0,f32x16&p1,int jb,int qrel,int hi){
  const float NEG=-INFINITY; int kb=64*jb+4*hi;
  #pragma unroll
  for(int r=0;r<16;++r){int kv=kb+(r&3)+8*(r>>2); if(kv>qrel)p0[r]=NEG; if(kv+32>qrel)p1[r]=NEG;}
}

constexpr int NSLOT=3, SLOTB=8192;
constexpr int LDS_K=0, LDS_V=NSLOT*SLOTB, LDS_WS=2*NSLOT*SLOTB, LDS_OST=LDS_WS+NW*64*4, LDS_KMS=LDS_OST+NW*4096  , LDS_BYTES=LDS_KMS+4096;
constexpr float C2=0.125f*1.4426950408889634f;
__device__ __forceinline__ void glds16(const void*gsrc,unsigned lds_dst){unsigned keep;
  asm volatile("s_mov_b32 %0, m0\n\ts_mov_b32 m0, %2\n\ts_nop 0\n\tglobal_load_lds_dwordx4 %1, off\n\ts_mov_b32 m0, %0":"=&s"(keep):"v"(gsrc),"s"(lds_dst):"memory");}
__device__ __forceinline__ float max3f(float a,float b,float c){float r;asm("v_max3_f32 %0, %1, %2, %3":"=v"(r):"v"(a),"v"(b),"v"(c));return r;}
__device__ __forceinline__ float max2f(float a,float b){float r;asm("v_max_f32_e32 %0, %1, %2":"=v"(r):"v"(a),"v"(b));return r;}
__device__ __forceinline__ float fadd_s(float a,float b){float r;asm("v_add_f32_e32 %0, %1, %2":"=v"(r):"v"(a),"v"(b));return r;}
__device__ __forceinline__ float fsub_s(float a,float b){float r;asm("v_sub_f32_e32 %0, %1, %2":"=v"(r):"v"(a),"v"(b));return r;}
typedef float f32x2_t __attribute__((ext_vector_type(2))); typedef __bf16 bf16x2_t __attribute__((ext_vector_type(2)));
__device__ __forceinline__ unsigned cvtpk_s(float lo,float hi){f32x2_t v={lo,hi};bf16x2_t b=__builtin_convertvector(v,bf16x2_t);return __builtin_bit_cast(unsigned,b);}
#define WAIT_BAR(N) asm volatile("s_waitcnt vmcnt(" #N ") lgkmcnt(0)\n\ts_barrier":::"memory")

__device__ __forceinline__ void qkt(f32x16&p0,f32x16&p1,const char*Kslot,const bf16x8*qr,const f32x16&negm,int r32,int hi){
  const char*kb=Kslot+hi*1024+r32*16;
  #pragma unroll
  for(int d0=0;d0<4;++d0){
    const bf16x8 b0=*reinterpret_cast<const bf16x8*>(kb+d0*2048);
    const bf16x8 b1=*reinterpret_cast<const bf16x8*>(kb+d0*2048+512);
    if(d0==0){p0=__builtin_amdgcn_mfma_f32_32x32x16_bf16(b0,qr[0],negm,0,0,0);p1=__builtin_amdgcn_mfma_f32_32x32x16_bf16(b1,qr[0],negm,0,0,0);}
    else{p0=__builtin_amdgcn_mfma_f32_32x32x16_bf16(b0,qr[d0],p0,0,0,0);p1=__builtin_amdgcn_mfma_f32_32x32x16_bf16(b1,qr[d0],p1,0,0,0);}}
}
typedef __attribute__((address_space(3))) const char* lds_cptr;
typedef short v4i16_t __attribute__((ext_vector_type(4)));
__device__ __forceinline__ void kload8(bf16x8*kf,lds_cptr kp){
  kf[0]=*(const __attribute__((address_space(3))) bf16x8*)(kp);      kf[1]=*(const __attribute__((address_space(3))) bf16x8*)(kp+512);
  kf[2]=*(const __attribute__((address_space(3))) bf16x8*)(kp+2048); kf[3]=*(const __attribute__((address_space(3))) bf16x8*)(kp+2560);
  kf[4]=*(const __attribute__((address_space(3))) bf16x8*)(kp+4096); kf[5]=*(const __attribute__((address_space(3))) bf16x8*)(kp+4608);
  kf[6]=*(const __attribute__((address_space(3))) bf16x8*)(kp+6144); kf[7]=*(const __attribute__((address_space(3))) bf16x8*)(kp+6656);
}
__device__ __forceinline__ void kload2(bf16x8*kf,lds_cptr kp,int j){ kf[2*j]=*(const __attribute__((address_space(3))) bf16x8*)(kp+j*2048); kf[2*j+1]=*(const __attribute__((address_space(3))) bf16x8*)(kp+j*2048+512); }
__device__ __forceinline__ s16x4 vtr(lds_cptr p){ return __builtin_bit_cast(s16x4,__builtin_amdgcn_ds_read_tr16_b64_v4i16((__attribute__((address_space(3))) v4i16_t*)p)); }
__device__ __forceinline__ float rowmax(const f32x16&p0,const f32x16&p1){
  float a=max3f(p0[0],p0[1],p1[0]),b=max3f(p0[2],p0[3],p1[1]);a=max3f(a,p1[2],p1[3]);
  #pragma unroll
  for(int r=4;r<16;r+=4){a=max3f(a,p0[r],p0[r+1]);b=max3f(b,p0[r+2],p0[r+3]);a=max3f(a,p1[r],p1[r+1]);b=max3f(b,p1[r+2],p1[r+3]);}
  const float m=max2f(a,b);
  auto rr=__builtin_amdgcn_permlane32_swap(__float_as_uint(m),__float_as_uint(m),false,false);
  return max2f(__uint_as_float(rr[0]),__uint_as_float(rr[1]));
}
__device__ __forceinline__ void pv(f32x16*o,int vb,bf16x8 pa0,bf16x8 pa1,bf16x8 pa2,bf16x8 pa3){
  #pragma unroll
  for(int d0=0;d0<2;++d0){s16x4 lo[4],hi[4];
    #pragma unroll
    for(int ks=0;ks<4;++ks){
      asm volatile("ds_read_b64_tr_b16 %0,%1 offset:%c2":"=&v"(lo[ks]):"v"(vb),"i"(d0*4096+ks*1024):"memory");
      asm volatile("ds_read_b64_tr_b16 %0,%1 offset:%c2":"=&v"(hi[ks]):"v"(vb),"i"(d0*4096+ks*1024+512):"memory");}
    asm volatile("s_waitcnt lgkmcnt(0)":::"memory");SBAR();
    #define PK(k) (bf16x8){lo[k][0],lo[k][1],lo[k][2],lo[k][3],hi[k][0],hi[k][1],hi[k][2],hi[k][3]}
    o[d0]=__builtin_amdgcn_mfma_f32_32x32x16_bf16(pa0,PK(0),o[d0],0,0,0);
    o[d0]=__builtin_amdgcn_mfma_f32_32x32x16_bf16(pa1,PK(1),o[d0],0,0,0);
    o[d0]=__builtin_amdgcn_mfma_f32_32x32x16_bf16(pa2,PK(2),o[d0],0,0,0);
    o[d0]=__builtin_amdgcn_mfma_f32_32x32x16_bf16(pa3,PK(3),o[d0],0,0,0);
    #undef PK
  }
}

#ifndef ATTN_STORE16
#define ATTN_STORE16(p,v) (*(u32x4*)(p)=(v))
#endif
template<int THRL> __device__ __forceinline__ void attn_unit(int b,int h,int qb,const bf16*Q,const bf16*__restrict__ K,const bf16*__restrict__ V,bf16*O,const float*__restrict__ kmean,char*shm,int wave_in){
  int tid_; asm volatile("v_mbcnt_lo_u32_b32 %0, -1, 0\n\tv_mbcnt_hi_u32_b32 %0, -1, %0":"=v"(tid_)); tid_+=64*wave_in; const int tid=tid_,lane=tid&63,r32=lane&31,hi=lane>>5; const int wid=__builtin_amdgcn_readfirstlane(tid>>6);
  const long rowbase=(long)b*SEQ; const int q0=qb*QB;
  const bf16*Qw=Q+(rowbase+q0+wid*QBLK)*DM+h*D;
  const bf16*Kh=K+rowbase*DM+h*D,*Vh=V+rowbase*DM+h*D;
  const unsigned lds0=(unsigned)(uintptr_t)shm;
  float*wsf=(float*)(shm+LDS_WS)+wid*64;
  const bf16*ksrc=Kh+(long)lane*DM+wid*8;
  const bf16*vsrc=Vh+(long)(16*(wid&3)+(lane>>2))*DM+(wid>>2)*32+(lane&3)*8;
  const unsigned kdst=lds0+LDS_K+wid*1024, vdst=lds0+LDS_V+wid*1024;
  #define DMA_K(t,slot) glds16(ksrc+(long)(t)*KVBLK*DM,(unsigned)__builtin_amdgcn_readfirstlane(kdst+(slot)))
  #define DMA_V(t,slot) glds16(vsrc+(long)(t)*KVBLK*DM,(unsigned)__builtin_amdgcn_readfirstlane(vdst+(slot)))
  const int vb0=(int)(lds0+LDS_V)+((lane>>4)&1)*32+(lane&3)*8+(4*hi+((lane&15)>>2))*64;
  const char*Kbase=shm+LDS_K; bf16x8 kf[8];
  const lds_cptr shm3=(lds_cptr)shm; const lds_cptr kp0=shm3+LDS_K+hi*1024+r32*16; const lds_cptr vp0=shm3+LDS_V+((lane>>4)&1)*32+(lane&3)*8+(4*hi+((lane&15)>>2))*64;
  const int NT=(q0+QB)/KVBLK;
  DMA_K(0,0);DMA_V(0,0);DMA_K(1,SLOTB);
  bf16x8 qr[4];
  #pragma unroll
  for(int d0=0;d0<4;++d0)qr[d0]=*reinterpret_cast<const bf16x8*>(&Qw[(long)r32*DM+d0*16+hi*8]);

  unsigned selm=0u;
  if(qb>0){
    typedef __attribute__((address_space(3))) f32x4_t lds_f4;
    if(wid<4){ const int n_=tid>>4,d4_=(tid&15)*4; const f32x4_t s_=*reinterpret_cast<const f32x4_t*>(kmean+n_*128+d4_)+*reinterpret_cast<const f32x4_t*>(kmean+n_*128+64+d4_);
      *(lds_f4*)((lds_cptr)shm+LDS_KMS+(n_*64+d4_)*4)=s_; }
    asm volatile("s_waitcnt lgkmcnt(0)\n\ts_barrier":::"memory");
    float g[16];
    #pragma unroll
    for(int n=0;n<16;++n)g[n]=-INFINITY;
    #pragma unroll
    for(int n=0;n<15;++n) if(n<qb){
      const lds_cptr km=(lds_cptr)shm+LDS_KMS+(n*64+8*hi)*4; float a=0.f;
      #pragma unroll
      for(int d0=0;d0<4;++d0){ const f32x4_t k0=*(const lds_f4*)(km+64*d0),k1=*(const lds_f4*)(km+64*d0+16);
        #pragma unroll
        for(int j=0;j<4;++j){ a+=__uint_as_float((unsigned)(unsigned short)qr[d0][j]<<16)*k0[j]; a+=__uint_as_float((unsigned)(unsigned short)qr[d0][4+j]<<16)*k1[j]; } }
      auto rr=__builtin_amdgcn_permlane32_swap(__float_as_uint(a),__float_as_uint(a),false,false); g[n]=__uint_as_float(rr[0])+__uint_as_float(rr[1]);
    }
    #pragma unroll
    for(int s=0;s<3;++s) if(s<qb){ float best=-INFINITY; int bi=0;
      #pragma unroll
      for(int n=0;n<15;++n) if(g[n]>best){best=g[n];bi=n;}
      selm|=1u<<bi;
      #pragma unroll
      for(int n=0;n<15;++n) if(n==bi)g[n]=-INFINITY; }
  }
  selm|=1u<<qb;
  float mhat=0.f,l_reg=0.f;f32x16 o[2];f32x16 negm; { float z_=0.f; asm volatile("":"+v"(z_));
    _Pragma("unroll") for(int r_=0;r_<16;++r_){o[0][r_]=z_;o[1][r_]=z_;negm[r_]=z_;} } asm volatile("":"+v"(negm));
  const int qrel=wid*QBLK+r32;
  #define NEGSET(blk) do{ const float nv_=((selm>>(blk))&1u)?-mhat:NEGBIG; _Pragma("unroll") for(int r_=0;r_<16;++r_)negm[r_]=nv_; asm volatile("":"+v"(negm)); }while(0)
  NEGSET(0);
  #define CMASK(P0,P1,t) do{int jb_=(t)-(NT-4); if(jb_>=0)cmask(P0,P1,jb_,qrel,hi); }while(0)
  bool resc=false;
  #define START(P0,P1) do{ const float rm=rowmax(P0,P1); resc=false; \
    { const float dl=rm; mhat=fadd_s(mhat,dl); \
      _Pragma("unroll") for(int r=0;r<16;++r){P0[r]=fsub_s(P0[r],dl);P1[r]=fsub_s(P1[r],dl);} \
      NEGSET(0); } \
    _Pragma("unroll") for(int r=0;r<16;++r)P0[r]=__builtin_amdgcn_exp2f(P0[r]); }while(0)
  #define RESC() do{ if(resc){ asm volatile("s_waitcnt lgkmcnt(0)":::"memory"); \
      _Pragma("unroll") for(int d_=0;d_<2;++d_) _Pragma("unroll") for(int r=0;r<16;++r)o[d_][r]*=wsf[crow(r,hi)]; } }while(0)
  f32x16 pA0,pA1,pB0,pB1;
  int sl_prev=0,sl_cur=0,sl_next=SLOTB;
  #define ROT() do{sl_prev=sl_cur;sl_cur=sl_next;sl_next=(sl_next==(NSLOT-1)*SLOTB)?0:sl_next+SLOTB;}while(0)
  DMA_K(2,2*SLOTB);
  WAIT_BAR(3);
  qkt(pA0,pA1,Kbase,qr,negm,r32,hi);asm volatile("s_nop 15\n\ts_nop 7":"+v"(pA0),"+v"(pA1));CMASK(pA0,pA1,0);
  START(pA0,pA1);
  _Pragma("unroll") for(int r=0;r<16;++r)pA1[r]=__builtin_amdgcn_exp2f(pA1[r]);
  WAIT_BAR(0);
  DMA_K(3,0);DMA_V(1,SLOTB);
  ROT();
  kload8(kf,kp0+sl_cur);
  WAIT_BAR(2);
  s16x4 vlo[8],vhi[8]; u32x4 pw0,pw1,pw2,pw3;
  #define PKW(P,B) cvtpk_s(P[B],P[B+1])
  #define PAF(k) __builtin_bit_cast(bf16x8,pw##k)
  #define VFR(i) (bf16x8){vlo[i][0],vlo[i][1],vlo[i][2],vlo[i][3],vhi[i][0],vhi[i][1],vhi[i][2],vhi[i][3]}
  #define PIN(x) asm volatile("":"+v"(x))
  #define MX3(a,b,c) __builtin_fmaxf(__builtin_fmaxf((a),(b)),(c))
  #define GAPA(MF,A0,A1,A2,A3,W0,W1,PW) do{ MF; sacc+=A0; sacc+=A1; sacc+=A2; sacc+=A3; PIN(sacc); W0; W1; PIN(PW); SBAR(); }while(0)
  #define EX(v) __builtin_amdgcn_exp2f(v)
  #define GAPB(MF,X,B) do{ MF; X[B]=EX(X[B]); X[B+1]=EX(X[B+1]); X[B+2]=EX(X[B+2]); X[B+3]=EX(X[B+3]); PIN(X); SBAR(); }while(0)
  #define VRD(i) do{ vlo[i]=vtr(vp_+(((i)>>2)*4096+((i)&3)*1024)); vhi[i]=vtr(vp_+(((i)>>2)*4096+((i)&3)*1024+512)); }while(0)
  #define KRD(G,j) do{ if(G){ kload2(kf,kp0+sl_next,j); SBAR(); } }while(0)
  #define STEP(C0,C1,P0,P1,t,GK,GV,GL) do{ SBAR(); \
    const lds_cptr vp_=vp0+sl_prev; \
    VRD(0); SBAR(); float sacc=(P0[0]+P0[1]); \
    GAPA(C0=__builtin_amdgcn_mfma_f32_32x32x16_bf16(kf[0],qr[0],negm,0,0,0), P0[2],P0[3],P0[4],P0[5],     pw0[0]=PKW(P0,0), pw0[1]=PKW(P0,2), pw0); \
    VRD(4); SBAR(); GAPA(C1=__builtin_amdgcn_mfma_f32_32x32x16_bf16(kf[1],qr[0],negm,0,0,0), P0[6],P0[7],P0[8],P0[9],     pw0[2]=PKW(P0,4), pw0[3]=PKW(P0,6), pw0); \
    VRD(1); SBAR(); GAPA(C0=__builtin_amdgcn_mfma_f32_32x32x16_bf16(kf[2],qr[1],C0,0,0,0),   P0[10],P0[11],P0[12],P0[13], pw1[0]=PKW(P0,8), pw1[1]=PKW(P0,10), pw1); \
    VRD(5); SBAR(); GAPA(C1=__builtin_amdgcn_mfma_f32_32x32x16_bf16(kf[3],qr[1],C1,0,0,0),   P0[14],P0[15],P1[0],P1[1],   pw1[2]=PKW(P0,12),pw1[3]=PKW(P0,14), pw1); \
    VRD(2); SBAR(); GAPA(C0=__builtin_amdgcn_mfma_f32_32x32x16_bf16(kf[4],qr[2],C0,0,0,0),   P1[2],P1[3],P1[4],P1[5],     pw2[0]=PKW(P1,0), pw2[1]=PKW(P1,2), pw2); \
    VRD(6); SBAR(); GAPA(C1=__builtin_amdgcn_mfma_f32_32x32x16_bf16(kf[5],qr[2],C1,0,0,0),   P1[6],P1[7],P1[8],P1[9],     pw2[2]=PKW(P1,4), pw2[3]=PKW(P1,6), pw2); \
    VRD(3); SBAR(); GAPA(C0=__builtin_amdgcn_mfma_f32_32x32x16_bf16(kf[6],qr[3],C0,0,0,0),   P1[10],P1[11],P1[12],P1[13], pw3[0]=PKW(P1,8), pw3[1]=PKW(P1,10), pw3); \
    VRD(7); SBAR(); GAPA(C1=__builtin_amdgcn_mfma_f32_32x32x16_bf16(kf[7],qr[3],C1,0,0,0),   P1[14],P1[15],0.f,0.f,       pw3[2]=PKW(P1,12),pw3[3]=PKW(P1,14), pw3); \
    l_reg+=sacc; \
    if(GK){DMA_K((t)+3,sl_cur);} if(GV){DMA_V((t)+1,sl_next);} \
    CMASK(C0,C1,t); \
    { float a=MX3(C0[0],C0[1],C1[0]),b=MX3(C0[2],C0[3],C1[1]); a=MX3(a,C1[2],C1[3]); \
      _Pragma("unroll") for(int r=4;r<16;r+=4){a=MX3(a,C0[r],C0[r+1]);b=MX3(b,C0[r+2],C0[r+3]);a=MX3(a,C1[r],C1[r+1]);b=MX3(b,C1[r+2],C1[r+3]);} \
      float rm=__builtin_fmaxf(a,b); { auto rr=__builtin_amdgcn_permlane32_swap(__float_as_uint(rm),__float_as_uint(rm),false,false); rm=__builtin_fmaxf(__uint_as_float(rr[0]),__uint_as_float(rr[1])); } \
      resc=false; \
      if(__builtin_expect(__any(rm>(float)THRL),0)){ const float dl=__builtin_fmaxf(rm,0.f); mhat+=dl; \
        _Pragma("unroll") for(int r=0;r<16;++r){C0[r]-=dl;C1[r]-=dl;} \
        NEGSET((t)>>2); \
        const float f=__builtin_amdgcn_exp2f(-dl); l_reg*=f; if(hi==0)wsf[r32]=f; resc=true; } } \
    SBAR(); \
    GAPB(o[0]=__builtin_amdgcn_mfma_f32_32x32x16_bf16(PAF(0),VFR(0),o[0],0,0,0), C0,0); \
    GAPB(o[1]=__builtin_amdgcn_mfma_f32_32x32x16_bf16(PAF(0),VFR(4),o[1],0,0,0), C0,4); \
    KRD(GL,0); GAPB(o[0]=__builtin_amdgcn_mfma_f32_32x32x16_bf16(PAF(1),VFR(1),o[0],0,0,0), C0,8); \
    KRD(GL,1); GAPB(o[1]=__builtin_amdgcn_mfma_f32_32x32x16_bf16(PAF(1),VFR(5),o[1],0,0,0), C0,12); \
    KRD(GL,2); GAPB(o[0]=__builtin_amdgcn_mfma_f32_32x32x16_bf16(PAF(2),VFR(2),o[0],0,0,0), C1,0); \
    KRD(GL,3); GAPB(o[1]=__builtin_amdgcn_mfma_f32_32x32x16_bf16(PAF(2),VFR(6),o[1],0,0,0), C1,4); \
    GAPB(o[0]=__builtin_amdgcn_mfma_f32_32x32x16_bf16(PAF(3),VFR(3),o[0],0,0,0), C1,8); \
    GAPB(o[1]=__builtin_amdgcn_mfma_f32_32x32x16_bf16(PAF(3),VFR(7),o[1],0,0,0), C1,12); \
    }while(0)
  int t=1;
  #undef CMASK
  #define CMASK(P0,P1,t) do{}while(0)
  for(;t+5<NT;t+=2){
    STEP(pB0,pB1,pA0,pA1,t,true,true,true);     WAIT_BAR(2); RESC(); ROT();
    if(((t+1)&3)==0)NEGSET((t+1)>>2);
    STEP(pA0,pA1,pB0,pB1,t+1,true,true,true);   WAIT_BAR(2); RESC(); ROT();
  }
  #undef CMASK
  #define CMASK(P0,P1,t) do{int jb_=(t)-(NT-4); if(jb_>=0)cmask(P0,P1,jb_,qrel,hi); }while(0)
  #define ENDW(tt) do{ if((tt)+3<NT){WAIT_BAR(2);} else if((tt)+2<NT){WAIT_BAR(1);} else {WAIT_BAR(0);} }while(0)
  for(;t+1<NT;t+=2){
    STEP(pB0,pB1,pA0,pA1,t,(t+3<NT),(t+1<NT),(t+1<NT));       ENDW(t);   RESC(); ROT();
    if(((t+1)&3)==0)NEGSET((t+1)>>2);
    STEP(pA0,pA1,pB0,pB1,t+1,(t+4<NT),(t+2<NT),(t+2<NT));     ENDW(t+1); RESC(); ROT();
  }
  STEP(pB0,pB1,pA0,pA1,NT-1,false,false,false); RESC();
  { float sacc=pB0[0]+pB0[1]; _Pragma("unroll") for(int r=2;r<16;++r)sacc+=pB0[r]; _Pragma("unroll") for(int r=0;r<16;++r)sacc+=pB1[r]; l_reg+=sacc;
    pw0=(u32x4){PKW(pB0,0),PKW(pB0,2),PKW(pB0,4),PKW(pB0,6)};pw1=(u32x4){PKW(pB0,8),PKW(pB0,10),PKW(pB0,12),PKW(pB0,14)};pw2=(u32x4){PKW(pB1,0),PKW(pB1,2),PKW(pB1,4),PKW(pB1,6)};pw3=(u32x4){PKW(pB1,8),PKW(pB1,10),PKW(pB1,12),PKW(pB1,14)};
    SBAR(); pv(o,vb0+sl_cur,PAF(0),PAF(1),PAF(2),PAF(3)); }
  #undef PKW
  #undef PAF
  #undef VFR
  #undef PIN
  #undef MX3
  #undef GAPA
  #undef GAPB
  #undef EX
  #undef VRD
  #undef KRD
  #undef STEP
  #undef ENDW
  {auto rr=__builtin_amdgcn_permlane32_swap(__float_as_uint(l_reg),__float_as_uint(l_reg),false,false);l_reg=__uint_as_float(rr[0])+__uint_as_float(rr[1]);}
  if(hi==0)wsf[32+r32]=l_reg;asm volatile("s_waitcnt lgkmcnt(0)":::"memory");
  float rli[16];
  #pragma unroll
  for(int r=0;r<16;++r)rli[r]=__builtin_amdgcn_rcpf(wsf[32+crow(r,hi)]);
  bf16*Ow=O+(rowbase+q0+wid*QBLK)*DMO+h*D;
  { bf16*stg=(bf16*)(shm+LDS_OST)+wid*2048;
    #pragma unroll
    for(int r=0;r<16;++r){const int orow=crow(r,hi);
      #pragma unroll
      for(int d0=0;d0<2;++d0)stg[orow*64+d0*32+r32]=__float2bfloat16(o[d0][r]*rli[r]);}
    asm volatile("s_waitcnt lgkmcnt(0)":::"memory");
    #pragma unroll
    for(int i=0;i<4;++i){const int row=i*8+(lane>>3),ch=lane&7; const u32x4 v=*(const u32x4*)(stg+row*64+ch*8); ATTN_STORE16(Ow+(long)row*DMO+ch*8,v);} }
  asm volatile("s_waitcnt lgkmcnt(0)\n\ts_barrier":::"memory");
  #undef DMA_K
  #undef DMA_V
  #undef CMASK
  #undef NEGSET
  #undef START
  #undef RESC
  #undef ROT
}
constexpr int ATTN_LDS_BYTES=LDS_BYTES;
struct AttnTensors { const bf16* Q; const bf16* K; const bf16* V; bf16* O; const float* kmean; };
struct AttnUnit { int bh; int qb; };
struct StaticOrder {
  int vcu,G;
  __device__ __forceinline__ explicit StaticOrder(int grid,int block):vcu((grid%8==0)?(block%8)*(grid/8)+block/8:block),G(grid){}
  __device__ __forceinline__ bool next(int i,AttnUnit&u)const{ const int idx=(i>>1)*G+vcu; if(idx>=BATCH*NHEAD*8)return false; const int s=idx&7; u.bh=idx>>3; u.qb=(i&1)?15-s:s; return true; }
  __device__ __forceinline__ void a_ready(const AttnUnit&)const{}
  __device__ __forceinline__ void done(const AttnUnit&)const{}
};
template<class Sched,int THRL=8> __device__ __forceinline__ void attn_phase(char*lds,const AttnTensors&T,const Sched&S,int wave_in){
  AttnUnit u;
  for(int i=0;S.next(i,u);++i){ S.a_ready(u); attn_unit<THRL>(u.bh/NHEAD,u.bh%NHEAD,u.qb,T.Q,T.K,T.V,T.O,T.kmean+(size_t)u.bh*16*128,lds,wave_in); S.done(u); }
}
#undef SBAR
#undef WAIT_BAR
}
__device__ __forceinline__ void phase_moe_route(Frame& F) {
    PHASE_LOCALS();
    if ((int)blockIdx.x >= 4 * (M / 256)) return;
    const int j = blockIdx.x >> 2, quarter = blockIdx.x & 3;
    const int* TOPI = (const int*)(F.ws + WS_TOPI); int* DEST = (int*)(F.ws + WS_DEST); int* ROWTOK = (int*)(F.ws + WS_ROWTOK); int* TILEE = (int*)(F.ws + WS_TILEE); int* NTILES = (int*)(F.ws + WS_NTILES);
    LAS int* cnt = (LAS int*)F.lds; LAS int* tot = cnt + 64 * 8; LAS int* basej = tot + 8; LAS int* pstart = basej + 8; LAS int* wcnt = pstart + 16; LAS int* dsts = wcnt + 32;
    for (int i = tid; i < 64 * 8; i += NTHR) cnt[i] = 0;
    __syncthreads();
    for (int m0 = tid; m0 < M; m0 += 8 * NTHR) { int2 e[8];
#pragma unroll
        for (int k = 0; k < 8; ++k) e[k] = *(const int2*)(TOPI + (size_t)(m0 + k * NTHR) * 2);
#pragma unroll
        for (int k = 0; k < 8; ++k) { const int m = m0 + k * NTHR; __hip_atomic_fetch_add(cnt + (m >> 8) * 8 + e[k].x, 1, __ATOMIC_RELAXED, __HIP_MEMORY_SCOPE_WORKGROUP); __hip_atomic_fetch_add(cnt + (m >> 8) * 8 + e[k].y, 1, __ATOMIC_RELAXED, __HIP_MEMORY_SCOPE_WORKGROUP); } }
    __syncthreads();
    if (tid < 8) { int s = 0, bj = 0; for (int jj = 0; jj < 64; ++jj) { if (jj == j) bj = s; s += cnt[jj * 8 + tid]; } tot[tid] = s; basej[tid] = bj; }
    __syncthreads();
    if (tid == 0) { int ps = 0; for (int e = 0; e < 8; ++e) { pstart[e] = ps; ps += (tot[e] + 255) & ~255; } pstart[8] = ps; }
    __syncthreads();
    const int m = 256 * j + tid; int e1 = -1, e2 = -1, rk1 = 0, rk2 = 0;
    if (tid < 256) { const int2 e = *(const int2*)(TOPI + (size_t)m * 2); e1 = e.x; e2 = e.y; }
    if (tid < 256) {
#pragma unroll
        for (int e = 0; e < 8; ++e) { const bool has = (e1 == e) || (e2 == e); const unsigned long long mask = __ballot(has); const int rk = __popcll(mask & ((1ull << lane) - 1ull));
            if (e1 == e) rk1 = rk; if (e2 == e) rk2 = rk; if (lane == 0) wcnt[F.wave * 8 + e] = __popcll(mask); }
    }
    __syncthreads();
    if (tid < 256) {
        int o1 = 0, o2 = 0;
        for (int w = 0; w < F.wave; ++w) { o1 += wcnt[w * 8 + e1]; o2 += wcnt[w * 8 + e2]; }
        const int d1 = pstart[e1] + basej[e1] + o1 + rk1, d2 = pstart[e2] + basej[e2] + o2 + rk2;
        if (quarter == 0) *(int2*)(DEST + (size_t)m * 2) = make_int2(d1, d2);
        dsts[2 * tid] = d1; dsts[2 * tid + 1] = d2;
    }
    __syncthreads();
    { const bf16* __restrict__ HB = (const bf16*)(F.ws + WS_HB); bf16* __restrict__ XG = (bf16*)(F.ws + WS_XG);
      for (int i0 = quarter * 64 * 128 + tid; i0 < (quarter + 1) * 64 * 128; i0 += 8 * NTHR) { v4u val[8];
#pragma unroll
          for (int k = 0; k < 8; ++k) { const int i = i0 + k * NTHR; val[k] = *(const v4u*)(HB + (size_t)(256 * j + (i >> 7)) * D + 8 * (i & 127)); }
#pragma unroll
          for (int k = 0; k < 8; ++k) { const int i = i0 + k * NTHR, t = i >> 7; const v4u w = val[k];
#define C8_(v) __builtin_amdgcn_fmed3f((v), -448.0f, 448.0f)
              int a_ = __builtin_amdgcn_cvt_pk_fp8_f32(C8_(bflo(w.x)), C8_(bfhi(w.x)), 0, false); a_ = __builtin_amdgcn_cvt_pk_fp8_f32(C8_(bflo(w.y)), C8_(bfhi(w.y)), a_, true);
              int b_ = __builtin_amdgcn_cvt_pk_fp8_f32(C8_(bflo(w.z)), C8_(bfhi(w.z)), 0, false); b_ = __builtin_amdgcn_cvt_pk_fp8_f32(C8_(bflo(w.w)), C8_(bfhi(w.w)), b_, true);
#undef C8_
              uint2 o8; o8.x = (unsigned)a_; o8.y = (unsigned)b_;
              *(uint2*)((unsigned char*)XG + (size_t)dsts[2 * t] * D + 8 * (i & 127)) = o8; *(uint2*)((unsigned char*)XG + (size_t)dsts[2 * t + 1] * D + 8 * (i & 127)) = o8; } } }
    if (j == 0 && quarter == 0) {
        const int nt = pstart[8] >> 8;
        for (int i = tid; i < nt; i += NTHR) { int e = 0; for (int k = 1; k < 8; ++k) if (256 * i >= pstart[k]) e = k; TILEE[i] = e; }
        if (tid == 0) NTILES[0] = nt;
    }
    __syncthreads();
}
__device__ __forceinline__ int moe_ntiles(Frame& F) { return __builtin_amdgcn_readfirstlane((int)__hip_atomic_load((const unsigned*)(F.ws + WS_NTILES), RLX_AGENT)); }
__device__ __forceinline__ void phase_moe_gather(Frame& F) {
    PHASE_LOCALS();
    const int nrows = moe_ntiles(F) * 256; const int* __restrict__ ROWTOK = (const int*)(F.ws + WS_ROWTOK); const bf16* __restrict__ HB = (const bf16*)(F.ws + WS_HB); bf16* __restrict__ XG = (bf16*)(F.ws + WS_XG);
    const int total = nrows * 128, stride = F.G * NTHR;
    for (int idx0 = F.vcu * NTHR + tid; idx0 < total; idx0 += 8 * stride) {
        int tok[8]; v4u val[8];
#pragma unroll
        for (int k = 0; k < 8; ++k) { const int idx = idx0 + k * stride; tok[k] = (idx < total) ? ROWTOK[idx >> 7] : 0; }
#pragma unroll
        for (int k = 0; k < 8; ++k) { const int idx = idx0 + k * stride; val[k] = *(const v4u*)(HB + (size_t)tok[k] * D + 8 * (idx & 127)); }
#pragma unroll
        for (int k = 0; k < 8; ++k) { const int idx = idx0 + k * stride; if (idx < total) *(v4u*)(XG + (size_t)(idx >> 7) * D + 8 * (idx & 127)) = val[k]; }
    }
}
constexpr float W2_F8SCALE = 64.0f, GH_F8SCALE = 4.0f;
constexpr float W13_F8SCALE = 32.0f;
constexpr int CW_Q = 2048, CW_DONE = 3072;
constexpr int QN_E13 = 2 * (16 * 14), QN_E2 = 56 * 4;
constexpr int QN0 = NEXP * (QN_E13 + QN_E2), QN3 = (NTILES_T - P0_URGENT) + P_CHUNKS;
__device__ __forceinline__ void conv_item(Frame& F, const Inputs& in, int q, int it, int lane) {
    if (q == 3) { if (it < NTILES_T - P0_URGENT) p0_tile(F, in, P0_URGENT + it, lane); else p_chunk(F, in, it - (NTILES_T - P0_URGENT), F.wave * 64 + lane); return; }
    unsigned char* W13 = F.ws + WS_WE; unsigned char* W2 = W13 + (size_t)NEXP * 2 * DFFE * D;
    const int per = QN_E13 + QN_E2, e = it / per; int r = it % per;
    bool found = false; TrJob jb;
    jb.W = nullptr; jb.ld = 0; jb.K = 64; jb.N = 256; jb.WT = nullptr; jb.rowstep = 128; jb.row_off = 0; jb.gk = nullptr; jb.nrows = 32;
    bf16* W13e = (bf16*)(W13 + (size_t)e * 2 * DFFE * D);
    TTJOBG(in.p[I_WE1] + (size_t)e * D * DFFE, DFFE, D, DFFE, W13e, 256, 0, nullptr)
    TTJOBG(in.p[I_WE3] + (size_t)e * D * DFFE, DFFE, D, DFFE, W13e, 256, 128, nullptr)
    const bool is13 = found;
    TTJOBG(in.p[I_WE2] + (size_t)e * DFFE * D, D, DFFE, D, (bf16*)(W2 + (size_t)e * D * DFFE), 128, 0, nullptr)
    if (found) tr_tile(jb.W, jb.ld, jb.K, jb.N / 256, jb.WT, jb.rowstep, jb.row_off, (LAS float*)(F.lds + RING_OFF), r, F.wave, lane, jb.gk, false, is13 ? W13_F8SCALE : W2_F8SCALE);
}
__device__ __forceinline__ void conv_queue(Frame& F, const Inputs& in, int q, int nitems, int stop_site, unsigned n_long) {
    PHASE_LOCALS();
    gu32* head = F.ctl + CW_Q + 64 * q; gu32* done = F.ctl + CW_DONE + 64 * (stop_site < 0 ? 0 : stop_site);
    volatile LAS unsigned* slot = F.MISC + 16;
    for (;;) {
        if (tid == 0) { unsigned base = 0xffffffffu;
            if (!(stop_site >= 0 && __hip_atomic_load(done, RLX_AGENT) >= n_long)) base = __hip_atomic_fetch_add(head, 1u, RLX_AGENT);
            slot[0] = base; }
        __syncthreads();
        const unsigned base = slot[0];
        __syncthreads();
        if (base >= (unsigned)nitems) break;
        conv_item(F, in, q, (int)base, lane);
    }
}
__device__ __forceinline__ void conv_fill_tail(Frame& F, const Inputs& in, int q, int nitems, int site, int mine, int maxc, int nlong) {
    if (nlong >= F.G) return;
    if (mine == maxc) { if (F.wave == 0 && lane_now() == 0) __hip_atomic_fetch_add(F.ctl + CW_DONE + 64 * site, 1u, RLX_AGENT); }
    else conv_queue(F, in, q, nitems, site, (unsigned)nlong);
}
__device__ __forceinline__ void conv_fill_all(Frame& F, const Inputs& in, int q, int nitems, int site) {
    __syncthreads();
    if (F.wave == 0 && lane_now() == 0) __hip_atomic_fetch_add(F.ctl + CW_DONE + 64 * site, 1u, RLX_AGENT);
    conv_queue(F, in, q, nitems, site, (unsigned)F.G);
}
__device__ __forceinline__ void conv_fill_tail_rr(Frame& F, const Inputs& in, int q, int nitems, int site, int nunits, int c) {
    const int maxu = (nunits + F.G - 1) / F.G, n_long = nunits - (maxu - 1) * F.G;
    conv_fill_tail(F, in, q, nitems, site, c < n_long ? maxu : maxu - 1, maxu, n_long);
}
__device__ __forceinline__ const LAS unsigned* moe_tile_table(Frame& F, int ntr) {
    LAS unsigned* tab = (LAS unsigned*)(F.lds + SM_OFF); const int tid = F.wave * 64 + lane_now();
    __syncthreads();
    if (tid < ntr) tab[tid] = __hip_atomic_load((const unsigned*)(F.ws + WS_TILEE) + tid, RLX_AGENT);
    __syncthreads();
    return tab;
}
namespace pg8 {
struct MoeOrder {
    static constexpr bool SEGMENTED = true;
    const PG8_LAS unsigned* tile_e; int ntr, nct, bpe, G, c;
    __device__ __forceinline__ bool next(int i, Unit& u) const {
        const int T = ntr * nct; long p;
        if (SEGMENTED && G % 8 == 0) { const int per = G / 8, x = c % 8, s = c / 8, seg = (T + 7) / 8; const long q = (long)i * per + s; if (q >= seg) return false; p = (long)x * seg + q; }
        else p = (long)i * G + c;
        if (p >= T) return false;
        u.pm = (int)(p / nct); u.pn = (int)(p % nct);
        const int e = __builtin_amdgcn_readfirstlane((int)tile_e[u.pm]);
        u.pb = e * bpe + u.pn; return true;
    }
    __device__ __forceinline__ int count_of(int cc) const { const int T = ntr * nct;
        if (SEGMENTED && G % 8 == 0) { const int per = G / 8, x = cc % 8, s = cc / 8, seg = (T + 7) / 8; int sx = T - x * seg; sx = sx < 0 ? 0 : (sx > seg ? seg : sx); return s < sx ? (sx - s + per - 1) / per : 0; }
        return cc < T ? (T - cc + G - 1) / G : 0; }
    __device__ __forceinline__ void tails(int& mine, int& maxc, int& nlong) const { mine = count_of(c); const int T = ntr * nct;
        if (!(SEGMENTED && G % 8 == 0)) { maxc = (T + G - 1) / G; nlong = T - (maxc - 1) * G; return; }
        const int per = G / 8, seg = (T + 7) / 8; maxc = (seg + per - 1) / per; nlong = 0;
        for (int x = 0; x < 8; ++x) { int sx = T - x * seg; sx = sx < 0 ? 0 : (sx > seg ? seg : sx); int k = sx - (maxc - 1) * per; k = k < 0 ? 0 : (k > per ? per : k); nlong += k; } }
    __device__ __forceinline__ void a_ready(const Unit&) const {}
    __device__ __forceinline__ void done(const Unit&) const {}
};
template <bool ACCUM> struct EpiY {
    static constexpr bool PERM = true, AFTER_DRAIN = false, MIDK = false; typedef NoPre::Pre Pre; __device__ __forceinline__ Pre prefetch(const Unit&, int, int) const { return Pre{}; }
    bf16_t* Y; int ldc; float osc;
    __device__ __forceinline__ void operator()(const f32x4 (&acc)[2][2][4][2], const Unit& u, int wr, int wc, int fr, int fq, const Pre&) const {
        const int row0 = u.pm * BM + wr * 64 + fr, col0 = u.pn * BM + wc * 32 + 8 * fq;
#pragma unroll
        for (int ai = 0; ai < 2; ++ai)
#pragma unroll
            for (int m = 0; m < 4; ++m) { bf16_t* rowp = Y + (size_t)(row0 + ai * HALF + m * 16) * ldc + col0;
#pragma unroll
                for (int bj = 0; bj < 2; ++bj) { f32x4 v0 = acc[ai][bj][m][0] * osc, v1 = acc[ai][bj][m][1] * osc;
                    if (ACCUM) { const u32x4 y = *(const u32x4*)(rowp + bj * HALF);
                        v0 += (f32x4){bflo(y.x), bfhi(y.x), bflo(y.y), bfhi(y.y)}; v1 += (f32x4){bflo(y.z), bfhi(y.z), bflo(y.w), bfhi(y.w)}; }
                    u32x4 w; w.x = cvt_pk_bf16(v0[0], v0[1]); w.y = cvt_pk_bf16(v0[2], v0[3]); w.z = cvt_pk_bf16(v1[0], v1[1]); w.w = cvt_pk_bf16(v1[2], v1[3]);
                    *(u32x4*)(rowp + bj * HALF) = w; } }
    }
};
}
struct Args { Inputs in; float* out; unsigned char* ws; int ph_lo, ph_hi, li, pad; };
#ifndef MLSTM_NAIVE
#define MLSTM_NAIVE 0
#endif
#ifndef ATTN_NAIVE
#define ATTN_NAIVE 0
#endif
#ifndef MOE_NAIVE
#define MOE_NAIVE 0
#endif
#ifndef MK_PER_PHASE
#define MK_PER_PHASE 0
#endif
constexpr int MAX_LAUNCH = 64;

__global__ void __launch_bounds__(NTHR, 2) mega_fwd(Args args) {
    extern __shared__ __attribute__((aligned(16))) unsigned char lds[];
    Frame F;
    F.lds = (LAS unsigned char*)lds;
    F.MISC = (volatile LAS unsigned*)(F.lds + MISC_OFF);
    F.wave = __builtin_amdgcn_readfirstlane((int)(threadIdx.x >> 6));
    F.G = gridDim.x; { const int bx = blockIdx.x; F.vcu = (F.G % 8 == 0) ? (bx % 8) * (F.G / 8) + bx / 8 : bx; }
    F.ws = args.ws; F.ctl = (gu32*)(args.ws + WS_CTL);
    const Inputs& in = args.in;
    for (int u = threadIdx.x; u < (LDS_BYTES - LDSCTL_OFF) / 4; u += NTHR) ((LAS unsigned*)(F.lds + LDSCTL_OFF))[u] = 0u;
    __syncthreads();
    XcdBarrier bar = xcd_barrier_post((unsigned*)(F.ctl + CW_BAR) + args.li * XCD_BAR_WORDS, F.MISC + 8, F.wave);
    const int lo = args.ph_lo, hi = args.ph_hi;
    int ph = 0;
__attribute__((unused)) auto phq = [](int p) { asm volatile("" : "+s"(p)); return p; };
#define RUN() (lo <= phq(ph) && phq(ph) < hi)
#define SEAM() do { if (lo <= phq(ph) && phq(ph) + 1 < hi) xcd_barrier(bar); ++ph; } while (0)
    auto wsp = [&]() { unsigned char* p_ = args.ws; asm volatile("" : "+s"(p_)); return p_; };
#define HB ((bf16*)(wsp() + WS_HB))
#define PROJ ((bf16*)(wsp() + WS_PROJ))
#define YA ((bf16*)(wsp() + WS_YA))
#define YB ((bf16*)(wsp() + WS_YB))
#define MIXED ((bf16*)(wsp() + WS_MIXED))
#define TMP ((bf16*)(wsp() + WS_TMP))
#define GH ((bf16*)(wsp() + WS_GH))
#define PP ((bf16*)(wsp() + WS_PP))
#define IFPRE ((float*)(wsp() + WS_IFPRE))
#define GSEL ((float*)(wsp() + WS_GSEL))
#define XB ((bf16*)(wsp() + WS_XB))
#define XB2 ((bf16*)(wsp() + WS_QKC))
#define SSACC ((pg8::ssq_t*)((unsigned*)(wsp() + WS_CTL) + CW_SS))
    float* const X = args.out;


#ifndef SK_P0
        if (RUN()) p0_prologue(F, in);
#endif

    SEAM();
    { constexpr int l = 0;
        const float* xs = (l == 0) ? in.p[I_X] : X;
        if (RUN()) {
            const bf16* A_ = (l == 0) ? XB : XB2; const bf16* W_ = (const bf16*)(F.ws + WS_WIN) + (size_t)l * NPROJX * D; const pg8::ssq_t* ss_ = (l == 0) ? (const pg8::ssq_t*)(F.ws + WS_SS0) : (const pg8::ssq_t*)(SSACC + 2 * M);
            { pg8::Gemm g{A_, W_, M, 1024, D}; pg8::StaticOrder S; S.init(M, 1024, F.G, (int)blockIdx.x);
              pg8::EpiQK E{PROJ, (unsigned)NPROJ, ss_, in.p[I_GQ] + l * AHD, in.p[I_GK] + l * AHD, (float*)(wsp() + WS_KMEAN), C2};
              pg8::gemm_phase<pg8::EpiQK, pg8::StaticOrder, true, true>(F.lds + RING_OFF, g, S, E, F.wave); }
            { pg8::Gemm g{A_, W_ + (size_t)1024 * D, M, NPROJX - 1024, D}; pg8::StaticOrder S; S.init(M, NPROJX - 1024, F.G, (int)blockIdx.x);
              pg8::EpiProj E{PROJ, NPROJ, PC_GA / 256, ss_, NPROJX / 256 - 1, IFPRE, in.p[I_BI] + l * MH, in.p[I_BF] + l * MH, (bf16*)(wsp() + WS_GT), 4};
              pg8::gemm_phase<pg8::EpiProj, pg8::StaticOrder, true, true>(F.lds + RING_OFF, g, S, E, F.wave);
              if (l == 0) conv_fill_tail_rr(F, in, 3, QN3, 0, (M / 256) * ((NPROJX - 1024) / 256), (int)blockIdx.x);
              else conv_fill_tail_rr(F, in, 0, QN0, 2, (M / 256) * ((NPROJX - 1024) / 256), (int)blockIdx.x); }
        }
        SEAM();
        if (RUN()) {
#if !MLSTM_NAIVE
            phase_mlstm_m1(F, in, l);
#endif
#if ATTN_NAIVE
            phase_attn_naive(F);
#else
            { const attn_body::AttnTensors AT{(const attn_body::bf16*)(PROJ + PC_Q), (const attn_body::bf16*)(PROJ + PC_K), (const attn_body::bf16*)(PROJ + PC_V), (attn_body::bf16*)YA, (const float*)(F.ws + WS_KMEAN)};
              const attn_body::StaticOrder S((int)F.G, (int)blockIdx.x);
              attn_body::attn_phase<attn_body::StaticOrder>((char*)lds + RING_OFF, AT, S, F.wave); }
#endif
        }

        SEAM();

#if MLSTM_NAIVE
        if (RUN()) phase_mlstm_naive(F, in, l);
        SEAM();
#else
        if (RUN()) { phase_mlstm_m3(F, in, l);
            if (l == 0) { conv_queue(F, in, 3, QN3, -1, 0u); conv_fill_all(F, in, 0, QN0, 5); } else conv_fill_all(F, in, 0, QN0, 4); }
        SEAM();
#endif


        if (RUN()) { pg8::Gemm g{YA, (const bf16*)(F.ws + WS_WOA) + (size_t)l * D * D, M, D, D}; pg8::StaticOrder S; S.init(M, D, F.G, (int)blockIdx.x);
            pg8::EpiMerge E{(const bf16*)(wsp() + WS_GT), MIXED, D};
            pg8::gemm_phase<pg8::EpiMerge, pg8::StaticOrder, true, true>(F.lds + RING_OFF, g, S, E, F.wave); }
        SEAM();
        if (RUN()) { pg8::Gemm g{MIXED, (const bf16*)(F.ws + WS_WOUT) + (size_t)l * D * D, M, D, D}; pg8::StaticOrder S; S.init(M, D, F.G, (int)blockIdx.x);
            pg8::EpiResid E{xs, X, D, nullptr, 0, (l == 0) ? XB : nullptr, (l == 0) ? SSACC : nullptr};
            pg8::gemm_phase<pg8::EpiResid, pg8::StaticOrder, true, true>(F.lds + RING_OFF, g, S, E, F.wave); }
        SEAM();
        if (l == 0) {
            if (RUN()) { pg8::Gemm g{XB, (const bf16*)(F.ws + WS_WD13), M, 2 * DFF, D}; pg8::StaticOrder S; S.init(M, 2 * DFF, F.G, (int)blockIdx.x);
                pg8::EpiSwiglu E{GH, DFF, SSACC, 1.0f, 0.f};
                pg8::gemm_phase<pg8::EpiSwiglu, pg8::StaticOrder, true, true>(F.lds + RING_OFF, g, S, E, F.wave);
                conv_fill_tail_rr(F, in, 0, QN0, 1, (M / 256) * (2 * DFF / 256), (int)blockIdx.x); }
            SEAM();
            if (RUN()) { pg8::Gemm g{GH, (const bf16*)(F.ws + WS_WD2), M, D, DFF}; pg8::StaticOrder S; S.init(M, D, F.G, (int)blockIdx.x);
                pg8::EpiResid E{X, X, D, nullptr, 0, XB, SSACC + M};
                pg8::gemm_phase<pg8::EpiResid, pg8::StaticOrder, true, true>(F.lds + RING_OFF, g, S, E, F.wave); }
            SEAM();
        } else {
            if (RUN()) phase_norm<2>(F, X, in.p[I_GFFN] + l * D, HB, in.p[I_WR], NEXP, nullptr, nullptr, nullptr, GSEL);
            SEAM();
#if MOE_NAIVE
            for (int e = 0; e < NEXP; ++e) {

#ifndef SK_CONVE
        if (RUN()) p_conv_expert(F, in, e);
#endif

                SEAM();
                if (RUN()) { pg8::Gemm g{HB, (const bf16*)(F.ws + WS_WE), M, 2 * DFFE, D}; pg8::StaticOrder S; S.init(M, 2 * DFFE, F.G, (int)blockIdx.x);
                    pg8::EpiSwiglu E{GH, DFFE, nullptr, 1.0f, 0.f};
                    pg8::gemm_phase<pg8::EpiSwiglu, pg8::StaticOrder, true, true>(F.lds + RING_OFF, g, S, E, F.wave); }
                SEAM();
                if (RUN()) { pg8::Gemm g{GH, (const bf16*)(F.ws + WS_WE) + (size_t)2 * DFFE * D, M, D, DFFE}; pg8::StaticOrder S; S.init(M, D, F.G, (int)blockIdx.x);
                    pg8::EpiResid E{X, X, D, GSEL + e, NEXP, nullptr, nullptr};
                    pg8::gemm_phase<pg8::EpiResid, pg8::StaticOrder, true, true>(F.lds + RING_OFF, g, S, E, F.wave); }
                SEAM();
            }
#else
            if (RUN()) { phase_moe_route(F); conv_queue(F, in, 0, QN0, -1, 0u); }
            SEAM();
            if (RUN()) { pg8::Gemm g{(const bf16*)(F.ws + WS_XG), (const bf16*)(F.ws + WS_WE), MOE_MAXROWS, 2 * DFFE, D / 2};
                const int ntr_ = moe_ntiles(F); pg8::MoeOrder S{moe_tile_table(F, ntr_), ntr_, 2 * DFFE / 256, 2 * DFFE / 256, F.G, (int)blockIdx.x};
                pg8::EpiSwiglu E{(bf16*)(F.ws + WS_GHH), DFFE, nullptr, 1.0f / W13_F8SCALE, GH_F8SCALE};
                pg8::gemm_phase<pg8::EpiSwiglu, pg8::MoeOrder, true, true, true>(F.lds + RING_OFF, g, S, E, F.wave); }
            SEAM();
            if (RUN()) { pg8::Gemm g{(const bf16*)(F.ws + WS_GHH), (const bf16*)(F.ws + WS_WE + (size_t)NEXP * 2 * DFFE * D), MOE_MAXROWS, D, DFFE / 2};
                const int ntr_ = moe_ntiles(F); pg8::MoeOrder S{moe_tile_table(F, ntr_), ntr_, D / 256, D / 256, F.G, (int)blockIdx.x};
                pg8::EpiY<false> E{(bf16*)(F.ws + WS_Y), D, 1.0f / (W2_F8SCALE * GH_F8SCALE)}; pg8::gemm_phase<pg8::EpiY<false>, pg8::MoeOrder, true, true, true>(F.lds + RING_OFF, g, S, E, F.wave); }
            SEAM();
#endif
        }
        if (l == 1) {
            if (RUN()) { if (!MOE_NAIVE) phase_norm<3>(F, X, in.p[I_GPLE] + l * D, HB, nullptr, 0, nullptr, nullptr, nullptr, nullptr);
                else phase_norm<0>(F, X, in.p[I_GPLE] + l * D, HB, nullptr, 0, nullptr, nullptr, nullptr, nullptr); }
            SEAM();
        }
        if (RUN()) {
            { pg8::Gemm g{(const bf16*)(F.ws + WS_PB) + (size_t)l * M * PLE, (const bf16*)(F.ws + WS_WPP) + (size_t)l * D * PLE, M, D, PLE}; pg8::StaticOrder S; S.init(M, D, F.G, (int)blockIdx.x);
              pg8::EpiF32 E{PP, D};
              pg8::gemm_phase<pg8::EpiF32, pg8::StaticOrder, true, true>(F.lds + RING_OFF, g, S, E, F.wave); }
            { pg8::Gemm g{(l == 0) ? XB : HB, (const bf16*)(F.ws + WS_WPG) + (size_t)l * D * D, M, D, D}; pg8::StaticOrder S; S.init(M, D, F.G, (int)blockIdx.x);
              pg8::EpiPle2 E{PP, X, D, (l == 0) ? (const pg8::ssq_t*)(SSACC + M) : nullptr, (l == 0) ? XB2 : nullptr, (l == 0) ? SSACC + 2 * M : nullptr};
              pg8::gemm_phase<pg8::EpiPle2, pg8::StaticOrder, true, true>(F.lds + RING_OFF, g, S, E, F.wave); }
        }
        SEAM();
    }
    { constexpr int l = 1;
        const float* xs = (l == 0) ? in.p[I_X] : X;
        if (RUN()) {
            const bf16* A_ = (l == 0) ? XB : XB2; const bf16* W_ = (const bf16*)(F.ws + WS_WIN) + (size_t)l * NPROJX * D; const pg8::ssq_t* ss_ = (l == 0) ? (const pg8::ssq_t*)(F.ws + WS_SS0) : (const pg8::ssq_t*)(SSACC + 2 * M);
            { pg8::Gemm g{A_, W_, M, 1024, D}; pg8::StaticOrder S; S.init(M, 1024, F.G, (int)blockIdx.x);
              pg8::EpiQK E{PROJ, (unsigned)NPROJ, ss_, in.p[I_GQ] + l * AHD, in.p[I_GK] + l * AHD, (float*)(wsp() + WS_KMEAN), C2};
              pg8::gemm_phase<pg8::EpiQK, pg8::StaticOrder, true, true>(F.lds + RING_OFF, g, S, E, F.wave); }
            { pg8::Gemm g{A_, W_ + (size_t)1024 * D, M, NPROJX - 1024, D}; pg8::StaticOrder S; S.init(M, NPROJX - 1024, F.G, (int)blockIdx.x);
              pg8::EpiProj E{PROJ, NPROJ, PC_GA / 256, ss_, NPROJX / 256 - 1, IFPRE, in.p[I_BI] + l * MH, in.p[I_BF] + l * MH, (bf16*)(wsp() + WS_GT), 4};
              pg8::gemm_phase<pg8::EpiProj, pg8::StaticOrder, true, true>(F.lds + RING_OFF, g, S, E, F.wave);
              if (l == 0) conv_fill_tail_rr(F, in, 3, QN3, 0, (M / 256) * ((NPROJX - 1024) / 256), (int)blockIdx.x);
              else conv_fill_tail_rr(F, in, 0, QN0, 2, (M / 256) * ((NPROJX - 1024) / 256), (int)blockIdx.x); }
        }
        SEAM();
        if (RUN()) {
#if !MLSTM_NAIVE
            phase_mlstm_m1(F, in, l);
#endif
#if ATTN_NAIVE
            phase_attn_naive(F);
#else
            { const attn_body::AttnTensors AT{(const attn_body::bf16*)(PROJ + PC_Q), (const attn_body::bf16*)(PROJ + PC_K), (const attn_body::bf16*)(PROJ + PC_V), (attn_body::bf16*)YA, (const float*)(F.ws + WS_KMEAN)};
              const attn_body::StaticOrder S((int)F.G, (int)blockIdx.x);
              attn_body::attn_phase<attn_body::StaticOrder>((char*)lds + RING_OFF, AT, S, F.wave); }
#endif
        }

        SEAM();

#if MLSTM_NAIVE
        if (RUN()) phase_mlstm_naive(F, in, l);
        SEAM();
#else
        if (RUN()) { phase_mlstm_m3(F, in, l);
            if (l == 0) { conv_queue(F, in, 3, QN3, -1, 0u); conv_fill_all(F, in, 0, QN0, 5); } else conv_fill_all(F, in, 0, QN0, 4); }
        SEAM();
#endif


        if (RUN()) { pg8::Gemm g{YA, (const bf16*)(F.ws + WS_WOA) + (size_t)l * D * D, M, D, D}; pg8::StaticOrder S; S.init(M, D, F.G, (int)blockIdx.x);
            pg8::EpiMerge E{(const bf16*)(wsp() + WS_GT), MIXED, D};
            pg8::gemm_phase<pg8::EpiMerge, pg8::StaticOrder, true, true>(F.lds + RING_OFF, g, S, E, F.wave); }
        SEAM();
        if (RUN()) { pg8::Gemm g{MIXED, (const bf16*)(F.ws + WS_WOUT) + (size_t)l * D * D, M, D, D}; pg8::StaticOrder S; S.init(M, D, F.G, (int)blockIdx.x);
            pg8::EpiResid E{xs, X, D, nullptr, 0, (l == 0) ? XB : nullptr, (l == 0) ? SSACC : nullptr};
            pg8::gemm_phase<pg8::EpiResid, pg8::StaticOrder, true, true>(F.lds + RING_OFF, g, S, E, F.wave); }
        SEAM();
        if (l == 0) {
            if (RUN()) { pg8::Gemm g{XB, (const bf16*)(F.ws + WS_WD13), M, 2 * DFF, D}; pg8::StaticOrder S; S.init(M, 2 * DFF, F.G, (int)blockIdx.x);
                pg8::EpiSwiglu E{GH, DFF, SSACC, 1.0f, 0.f};
                pg8::gemm_phase<pg8::EpiSwiglu, pg8::StaticOrder, true, true>(F.lds + RING_OFF, g, S, E, F.wave);
                conv_fill_tail_rr(F, in, 0, QN0, 1, (M / 256) * (2 * DFF / 256), (int)blockIdx.x); }
            SEAM();
            if (RUN()) { pg8::Gemm g{GH, (const bf16*)(F.ws + WS_WD2), M, D, DFF}; pg8::StaticOrder S; S.init(M, D, F.G, (int)blockIdx.x);
                pg8::EpiResid E{X, X, D, nullptr, 0, XB, SSACC + M};
                pg8::gemm_phase<pg8::EpiResid, pg8::StaticOrder, true, true>(F.lds + RING_OFF, g, S, E, F.wave); }
            SEAM();
        } else {
            if (RUN()) phase_norm<2>(F, X, in.p[I_GFFN] + l * D, HB, in.p[I_WR], NEXP, nullptr, nullptr, nullptr, GSEL);
            SEAM();
#if MOE_NAIVE
            for (int e = 0; e < NEXP; ++e) {

#ifndef SK_CONVE
        if (RUN()) p_conv_expert(F, in, e);
#endif

                SEAM();
                if (RUN()) { pg8::Gemm g{HB, (const bf16*)(F.ws + WS_WE), M, 2 * DFFE, D}; pg8::StaticOrder S; S.init(M, 2 * DFFE, F.G, (int)blockIdx.x);
                    pg8::EpiSwiglu E{GH, DFFE, nullptr, 1.0f, 0.f};
                    pg8::gemm_phase<pg8::EpiSwiglu, pg8::StaticOrder, true, true>(F.lds + RING_OFF, g, S, E, F.wave); }
                SEAM();
                if (RUN()) { pg8::Gemm g{GH, (const bf16*)(F.ws + WS_WE) + (size_t)2 * DFFE * D, M, D, DFFE}; pg8::StaticOrder S; S.init(M, D, F.G, (int)blockIdx.x);
                    pg8::EpiResid E{X, X, D, GSEL + e, NEXP, nullptr, nullptr};
                    pg8::gemm_phase<pg8::EpiResid, pg8::StaticOrder, true, true>(F.lds + RING_OFF, g, S, E, F.wave); }
                SEAM();
            }
#else
            if (RUN()) { phase_moe_route(F); conv_queue(F, in, 0, QN0, -1, 0u); }
            SEAM();
            if (RUN()) { pg8::Gemm g{(const bf16*)(F.ws + WS_XG), (const bf16*)(F.ws + WS_WE), MOE_MAXROWS, 2 * DFFE, D / 2};
                const int ntr_ = moe_ntiles(F); pg8::MoeOrder S{moe_tile_table(F, ntr_), ntr_, 2 * DFFE / 256, 2 * DFFE / 256, F.G, (int)blockIdx.x};
                pg8::EpiSwiglu E{(bf16*)(F.ws + WS_GHH), DFFE, nullptr, 1.0f / W13_F8SCALE, GH_F8SCALE};
                pg8::gemm_phase<pg8::EpiSwiglu, pg8::MoeOrder, true, true, true>(F.lds + RING_OFF, g, S, E, F.wave); }
            SEAM();
            if (RUN()) { pg8::Gemm g{(const bf16*)(F.ws + WS_GHH), (const bf16*)(F.ws + WS_WE + (size_t)NEXP * 2 * DFFE * D), MOE_MAXROWS, D, DFFE / 2};
                const int ntr_ = moe_ntiles(F); pg8::MoeOrder S{moe_tile_table(F, ntr_), ntr_, D / 256, D / 256, F.G, (int)blockIdx.x};
                pg8::EpiY<false> E{(bf16*)(F.ws + WS_Y), D, 1.0f / (W2_F8SCALE * GH_F8SCALE)}; pg8::gemm_phase<pg8::EpiY<false>, pg8::MoeOrder, true, true, true>(F.lds + RING_OFF, g, S, E, F.wave); }
            SEAM();
#endif
        }
        if (l == 1) {
            if (RUN()) { if (!MOE_NAIVE) phase_norm<3>(F, X, in.p[I_GPLE] + l * D, HB, nullptr, 0, nullptr, nullptr, nullptr, nullptr);
                else phase_norm<0>(F, X, in.p[I_GPLE] + l * D, HB, nullptr, 0, nullptr, nullptr, nullptr, nullptr); }
            SEAM();
        }
        if (RUN()) {
            { pg8::Gemm g{(const bf16*)(F.ws + WS_PB) + (size_t)l * M * PLE, (const bf16*)(F.ws + WS_WPP) + (size_t)l * D * PLE, M, D, PLE}; pg8::StaticOrder S; S.init(M, D, F.G, (int)blockIdx.x);
              pg8::EpiF32 E{PP, D};
              pg8::gemm_phase<pg8::EpiF32, pg8::StaticOrder, true, true>(F.lds + RING_OFF, g, S, E, F.wave); }
            { pg8::Gemm g{(l == 0) ? XB : HB, (const bf16*)(F.ws + WS_WPG) + (size_t)l * D * D, M, D, D}; pg8::StaticOrder S; S.init(M, D, F.G, (int)blockIdx.x);
              pg8::EpiPle2 E{PP, X, D, (l == 0) ? (const pg8::ssq_t*)(SSACC + M) : nullptr, (l == 0) ? XB2 : nullptr, (l == 0) ? SSACC + 2 * M : nullptr};
              pg8::gemm_phase<pg8::EpiPle2, pg8::StaticOrder, true, true>(F.lds + RING_OFF, g, S, E, F.wave); }
        }
        SEAM();
    }
#undef RUN
#undef HB
#undef PROJ
#undef YA
#undef YB
#undef MIXED
#undef TMP
#undef GH
#undef PP
#undef IFPRE
#undef GSEL
#undef XB
#undef XB2
#undef SSACC
#undef SEAM
}
constexpr int N_PHASES = 1 + (5 + 2 + 1) + (5 + 1 + (MOE_NAIVE ? 3 * NEXP : 3) + 2);

extern "C" void kernel_launch(void* const* d_in, const int* in_sizes, int n_in, void* d_out, int out_size, void* d_ws, size_t ws_size, hipStream_t stream) {
    static int grid = 0;
    if (grid == 0) {
        if (n_in != 25 || in_sizes[0] != M * D || out_size != M * D || ws_size < WS_END) { fprintf(stderr, "kernel_launch: unexpected shapes / workspace (n_in %d, ws %zu); nothing launched\n", n_in, ws_size); grid = -1; return; }
        int dev = 0, cus = 0, per_cu = 0;
        if (hipGetDevice(&dev) != hipSuccess || hipDeviceGetAttribute(&cus, hipDeviceAttributeMultiprocessorCount, dev) != hipSuccess) { grid = -1; return; }
        if (hipFuncSetAttribute((const void*)mega_fwd, hipFuncAttributeMaxDynamicSharedMemorySize, LDS_BYTES) != hipSuccess) { grid = -1; return; }
        if (hipOccupancyMaxActiveBlocksPerMultiprocessor(&per_cu, (const void*)mega_fwd, NTHR, LDS_BYTES) != hipSuccess || per_cu < 1) { fprintf(stderr, "kernel_launch: occupancy query reports %d\n", per_cu); }
        (void)hipGetLastError();
        grid = cus;
    }
    if (grid < 0) return;
    if (hipMemsetAsync((char*)d_ws + WS_CTL, 0, CTL_ZERO_BYTES, stream) != hipSuccess) return;
    Args a{};
    for (int i = 0; i < 25; ++i) a.in.p[i] = (const float*)d_in[i];
    a.out = (float*)d_out; a.ws = (unsigned char*)d_ws;
#if MK_PER_PHASE
    for (int li = 0; li < N_PHASES; ++li) { a.ph_lo = li; a.ph_hi = li + 1; a.li = 0; hipLaunchKernelGGL(mega_fwd, dim3(grid), dim3(NTHR), LDS_BYTES, stream, a); }
#else
    a.ph_lo = 0; a.ph_hi = N_PHASES; a.li = 0;
    hipLaunchKernelGGL(mega_fwd, dim3(grid), dim3(NTHR), LDS_BYTES, stream, a);
#endif
}
```

```cpp
#include <hip/hip_runtime.h>
#include <cstdio>
#include <cstdint>
#include <cmath>
namespace pg8 {
#define PG8_LAS __attribute__((address_space(3)))
typedef unsigned short bf16_t;
typedef short bf16x8 __attribute__((ext_vector_type(8)));
typedef float f32x4 __attribute__((ext_vector_type(4)));
typedef unsigned u32x4 __attribute__((ext_vector_type(4)));
typedef int v8i32 __attribute__((ext_vector_type(8)));
typedef int v4i32 __attribute__((ext_vector_type(4)));
constexpr int BM = 256, BK = 64, HALF = 128, HTB = HALF * BK * 2  , STAGE_BYTES = 8 * HTB, NXCD = 8, WGM = 8;

__host__ __device__ __forceinline__ int lds_byte(int r, int c) { const int st = (r >> 4) * 2 + (c >> 5), rr = r & 15, cc = c & 31, ob = rr * 64 + cc * 2; return st * 1024 + (ob ^ (((ob >> 9) & 1) << 5)); }
__host__ __device__ __forceinline__ void stage_rc(int b, int& R, int& C) { const int st = b / 1024, sb = b % 1024, swz = sb ^ (((sb >> 9) & 1) << 5); R = (st >> 1) * 16 + swz / 64; C = (st & 1) * 32 + (swz % 64) / 2; }
__host__ __device__ __forceinline__ int perm32(int rho) { const int n = rho >> 4, i = rho & 15; return 8 * (i >> 2) + 4 * n + (i & 3); }

struct Unit { int pm, pn, pb; };
struct Gemm { const bf16_t* A; const bf16_t* Bt; int M, N, K; };

struct StaticOrder {
    int nM, nN, nwg, G, c;
    __host__ __device__ void init(int M, int N, int G_, int c_) { nM = M / BM; nN = N / BM; nwg = nM * nN; G = G_; c = c_; }
    __host__ __device__ bool next(int i, Unit& u) const {
        const long L = (long)i * G + c; if (L >= nwg) return false;
        int wgid = (int)L; { const int q = nwg / NXCD, r = nwg % NXCD, xcd = wgid % NXCD, off = wgid / NXCD; wgid = (xcd < r ? xcd * (q + 1) : r * (q + 1) + (xcd - r) * q) + off; }
        const int nig = WGM * nN, gid = wgid / nig, fm = gid * WGM, gsz = (nM - fm) < WGM ? (nM - fm) : WGM;
        u.pm = fm + ((wgid % nig) % gsz); u.pn = (wgid % nig) / gsz; u.pb = u.pn; return true;
    }
    __device__ __forceinline__ void a_ready(const Unit&) const {}
    __device__ __forceinline__ void done(const Unit&) const {}
};

__device__ __forceinline__ unsigned cvt_pk_bf16(float lo, float hi) { unsigned r; asm volatile("v_cvt_pk_bf16_f32 %0, %1, %2" : "=v"(r) : "v"(lo), "v"(hi)); return r; }
template <class Epi, class Sched, bool ALIGN_EPI = false, bool SP2 = false, bool F8 = false>
__device__ __forceinline__ void gemm_phase(PG8_LAS unsigned char* lds, const Gemm g, const Sched& S, const Epi& E, int wave_in) {
    int tid_; asm volatile("v_mbcnt_lo_u32_b32 %0, -1, 0\n\tv_mbcnt_hi_u32_b32 %0, -1, %0" : "=v"(tid_)); tid_ += 64 * wave_in;
    const int tid = tid_, wid = __builtin_amdgcn_readfirstlane(tid >> 6), lane = tid & 63, wr = wid >> 2, wc = wid & 3, fr = lane & 15, fq = lane >> 4;
    const int K = g.K, nt = K / BK;
    unsigned voffA[2], voffB[2];
#pragma unroll
    for (int i = 0; i < 2; ++i) { int R, C; stage_rc(tid * 16 + i * 8192, R, C); const int Rb = Epi::PERM ? ((R & ~31) + perm32(R & 31)) : R;
        voffA[i] = (unsigned)(R * K + C) * 2u; voffB[i] = (unsigned)(Rb * K + C) * 2u; }
    const size_t kstep = (size_t)(BK * 2);
    const size_t hstep = (size_t)HALF * K * 2;
    const size_t tstep = 2 * hstep;
    const unsigned ldsw = (unsigned)wid * 1024u;
    const int aoff = lds_byte(wr * 64 + fr, fq * 8), boff = lds_byte(wc * 32 + fr, fq * 8);
    const int aofk0 = F8 ? lds_byte(wr * 64 + fr, 16 * fq) : aoff, aofk1 = F8 ? lds_byte(wr * 64 + fr, 16 * fq + 8) : aoff + 1024, bofk0 = F8 ? lds_byte(wc * 32 + fr, 16 * fq) : boff, bofk1 = F8 ? lds_byte(wc * 32 + fr, 16 * fq + 8) : boff + 1024;
#define PG8_SA(b, h) (((b) * 2 + (h)) * HTB)
#define PG8_SB(b, h) ((4 + (b) * 2 + (h)) * HTB)
#define PG8_STAGE(bufoff, gbase, voff) do { _Pragma("unroll") for (int _i = 0; _i < 2; ++_i) \
        __builtin_amdgcn_global_load_lds((const unsigned*)((const char*)(gbase) + (voff)[_i]), (PG8_LAS unsigned*)(lds + (bufoff) + ldsw + _i * 8192), 16, 0, 0); } while (0)
#define PG8_LDA(dst, b, h) do { if constexpr (F8) { _Pragma("unroll") for (int m = 0; m < 4; ++m) { dst##8[m].lo = *(const PG8_LAS v4i32*)(lds + PG8_SA(b, h) + aofk0 + m * 2048); dst##8[m].hi = *(const PG8_LAS v4i32*)(lds + PG8_SA(b, h) + aofk1 + m * 2048); } } \
        else { _Pragma("unroll") for (int m = 0; m < 4; ++m) _Pragma("unroll") for (int k = 0; k < 2; ++k) dst[m][k] = *(const PG8_LAS bf16x8*)(lds + PG8_SA(b, h) + (k ? aofk1 : aofk0) + m * 2048); } } while (0)
#define PG8_LDB(dst, b, h) do { if constexpr (F8) { _Pragma("unroll") for (int n = 0; n < 2; ++n) { dst##8[n].lo = *(const PG8_LAS v4i32*)(lds + PG8_SB(b, h) + bofk0 + n * 2048); dst##8[n].hi = *(const PG8_LAS v4i32*)(lds + PG8_SB(b, h) + bofk1 + n * 2048); } } \
        else { _Pragma("unroll") for (int n = 0; n < 2; ++n) _Pragma("unroll") for (int k = 0; k < 2; ++k) dst[n][k] = *(const PG8_LAS bf16x8*)(lds + PG8_SB(b, h) + (k ? bofk1 : bofk0) + n * 2048); } } while (0)
#define PG8_MMA(ai, bj, At, Bt) do { __builtin_amdgcn_s_setprio(1); \
        if constexpr (F8) { _Pragma("unroll") for (int m = 0; m < 4; ++m) _Pragma("unroll") for (int n = 0; n < 2; ++n) \
            asm volatile("v_mfma_scale_f32_16x16x128_f8f6f4 %0, %1, %2, %0, %3, %3 op_sel_hi:[0,0,0]" : "+v"(acc[ai][bj][m][n]) : "v"(Bt##8[n]), "v"(At##8[m]), "v"(f8one)); } \
        else { _Pragma("unroll") for (int m = 0; m < 4; ++m) _Pragma("unroll") for (int n = 0; n < 2; ++n) _Pragma("unroll") for (int k = 0; k < 2; ++k) \
            acc[ai][bj][m][n] = __builtin_amdgcn_mfma_f32_16x16x32_bf16(Bt[n][k], At[m][k], acc[ai][bj][m][n], 0, 0, 0); } \
        __builtin_amdgcn_s_setprio(0); } while (0)
#define PG8_WAIT_V(n) asm volatile("s_waitcnt vmcnt(" #n ")" ::: "memory")
#define PG8_WAIT_L(n) asm volatile("s_waitcnt lgkmcnt(" #n ")" ::: "memory")
#define PG8_BAR __builtin_amdgcn_s_barrier()
#define PG8_SCHED __builtin_amdgcn_sched_barrier(0)
    Unit cur, nxt; int ui = 0;
    if (!S.next(0, cur)) return;
    typename Epi::Pre pre = E.prefetch(cur, wr, fr);
    f32x4 acc[2][2][4][2];
#pragma unroll
    for (int a = 0; a < 2; ++a)
#pragma unroll
        for (int b = 0; b < 2; ++b)
#pragma unroll
            for (int m = 0; m < 4; ++m)
#pragma unroll
                for (int n = 0; n < 2; ++n) acc[a][b][m][n] = (f32x4){0.f, 0.f, 0.f, 0.f};
    bf16x8 At[4][2], B0[2][2], B1[2][2];
    int f8one = 0x7f7f7f7f; asm volatile("" : "+v"(f8one));
    v8i32 At8[4], B08[2], B18[2];
    const char* cA = (const char*)g.A + (size_t)cur.pm * tstep; const char* cB = (const char*)g.Bt + (size_t)cur.pb * tstep;
    S.a_ready(cur);
    if constexpr (SP2) {
        PG8_STAGE(PG8_SB(0, 0), cB, voffB); PG8_STAGE(PG8_SB(0, 1), cB + hstep, voffB); PG8_STAGE(PG8_SA(0, 0), cA, voffA); PG8_STAGE(PG8_SA(0, 1), cA + hstep, voffA);
        if (wr == 1) PG8_BAR;
        PG8_WAIT_V(2); PG8_BAR;
        PG8_STAGE(PG8_SB(1, 0), cB + kstep, voffB); PG8_STAGE(PG8_SA(1, 0), cA + kstep, voffA); PG8_STAGE(PG8_SB(1, 1), cB + hstep + kstep, voffB);
        PG8_WAIT_V(6); PG8_BAR;
    } else {
        PG8_STAGE(PG8_SB(0, 0), cB, voffB); PG8_STAGE(PG8_SA(0, 0), cA, voffA); PG8_STAGE(PG8_SB(0, 1), cB + hstep, voffB); PG8_STAGE(PG8_SA(0, 1), cA + hstep, voffA);
        if (wr == 1) PG8_BAR;
        PG8_WAIT_V(4); PG8_BAR;
        PG8_STAGE(PG8_SB(1, 0), cB + kstep, voffB); PG8_STAGE(PG8_SA(1, 0), cA + kstep, voffA); PG8_STAGE(PG8_SB(1, 1), cB + hstep + kstep, voffB);
        PG8_WAIT_V(6); PG8_BAR;
    }
    for (;;) {
        const bool has_next = S.next(ui + 1, nxt);
        const char* nA = has_next ? (const char*)g.A + (size_t)nxt.pm * tstep : cA; const char* nB = has_next ? (const char*)g.Bt + (size_t)nxt.pb * tstep : cB;
        _Pragma("nounroll") for (int t = 0; t < nt; t += 2) {
            const bool last = (t == nt - 2);
            const char* a1 = cA + (size_t)(t + 1) * kstep;
            const char* a2 = last ? nA : cA + (size_t)(t + 2) * kstep; const char* b2 = last ? nB : cB + (size_t)(t + 2) * kstep;
            const char* a3 = a2 + kstep; const char* b3 = b2 + kstep;
            if (last && has_next) S.a_ready(nxt);
            if constexpr (Epi::MIDK) { if (t == Epi::MID_T) E.mid(acc, cur, wr, wc, fr, fq); }
            if constexpr (SP2) {
            PG8_LDB(B0, 0, 0); PG8_LDB(B1, 0, 1); PG8_SCHED; PG8_LDA(At, 0, 0); PG8_STAGE(PG8_SA(1, 1), a1 + hstep, voffA);
            PG8_WAIT_V(8); PG8_WAIT_L(0); PG8_BAR; PG8_MMA(0, 0, At, B0); PG8_MMA(0, 1, At, B1); PG8_BAR; PG8_SCHED;
            PG8_LDA(At, 0, 1); PG8_STAGE(PG8_SB(0, 0), b2, voffB); PG8_STAGE(PG8_SB(0, 1), b2 + hstep, voffB); PG8_STAGE(PG8_SA(0, 0), a2, voffA);
            PG8_WAIT_V(8); PG8_WAIT_L(0); PG8_BAR; PG8_MMA(1, 0, At, B0); PG8_MMA(1, 1, At, B1); PG8_BAR; PG8_SCHED;
            PG8_LDB(B0, 1, 0); PG8_LDB(B1, 1, 1); PG8_SCHED; PG8_LDA(At, 1, 0); PG8_STAGE(PG8_SA(0, 1), a2 + hstep, voffA);
            PG8_WAIT_V(8); PG8_WAIT_L(0); PG8_BAR; PG8_MMA(0, 0, At, B0); PG8_MMA(0, 1, At, B1); PG8_BAR; PG8_SCHED;
            PG8_LDA(At, 1, 1); PG8_STAGE(PG8_SB(1, 0), b3, voffB); PG8_STAGE(PG8_SB(1, 1), b3 + hstep, voffB); PG8_STAGE(PG8_SA(1, 0), a3, voffA);
            PG8_WAIT_V(8); PG8_WAIT_L(0); PG8_BAR; PG8_MMA(1, 0, At, B0); PG8_MMA(1, 1, At, B1); PG8_BAR; PG8_SCHED;
            } else {
            PG8_LDB(B0, 0, 0); PG8_SCHED; PG8_LDA(At, 0, 0); PG8_STAGE(PG8_SA(1, 1), a1 + hstep, voffA);
            PG8_WAIT_L(8); PG8_BAR; PG8_WAIT_L(0); PG8_MMA(0, 0, At, B0); PG8_BAR; PG8_SCHED;
            PG8_LDB(B1, 0, 1); PG8_STAGE(PG8_SB(0, 0), b2, voffB);
            PG8_BAR; PG8_WAIT_L(0); PG8_MMA(0, 1, At, B1); PG8_BAR;
            PG8_LDA(At, 0, 1); PG8_STAGE(PG8_SA(0, 0), a2, voffA);
            PG8_BAR; PG8_WAIT_L(0); PG8_MMA(1, 0, At, B0); PG8_BAR; PG8_SCHED;
            PG8_STAGE(PG8_SB(0, 1), b2 + hstep, voffB);
            PG8_WAIT_V(6); PG8_BAR; PG8_MMA(1, 1, At, B1); PG8_BAR;
            PG8_LDB(B0, 1, 0); PG8_SCHED; PG8_LDA(At, 1, 0); PG8_STAGE(PG8_SA(0, 1), a2 + hstep, voffA);
            PG8_WAIT_L(8); PG8_BAR; PG8_WAIT_L(0); PG8_MMA(0, 0, At, B0); PG8_BAR; PG8_SCHED;
            PG8_LDB(B1, 1, 1); PG8_STAGE(PG8_SB(1, 0), b3, voffB);
            PG8_BAR; PG8_WAIT_L(0); PG8_MMA(0, 1, At, B1); PG8_BAR;
            PG8_LDA(At, 1, 1); PG8_STAGE(PG8_SA(1, 0), a3, voffA);
            PG8_BAR; PG8_WAIT_L(0); PG8_MMA(1, 0, At, B0); PG8_BAR; PG8_SCHED;
            PG8_STAGE(PG8_SB(1, 1), b3 + hstep, voffB);
            PG8_WAIT_V(6); PG8_BAR; PG8_MMA(1, 1, At, B1); PG8_BAR;
            }
        }
        if constexpr (ALIGN_EPI) { if (wr == 0) PG8_BAR; }
        if constexpr (F8) asm volatile("s_nop 15\n\ts_nop 15" ::: "memory");
        if constexpr (!Epi::AFTER_DRAIN) { E(acc, cur, wr, wc, fr, fq, pre); S.done(cur); }
        if (!has_next) break;
#pragma unroll
        for (int a = 0; a < 2; ++a)
#pragma unroll
            for (int b = 0; b < 2; ++b)
#pragma unroll
                for (int m = 0; m < 4; ++m)
#pragma unroll
                    for (int n = 0; n < 2; ++n) acc[a][b][m][n] = (f32x4){0.f, 0.f, 0.f, 0.f};
        cur = nxt; cA = nA; cB = nB; ++ui; pre = E.prefetch(cur, wr, fr);
        if constexpr (ALIGN_EPI) { if (wr == 1) PG8_BAR; }
    }
    PG8_WAIT_V(0);
    if constexpr (!ALIGN_EPI) { if (wr == 0) PG8_BAR; }
    PG8_BAR;
    if constexpr (Epi::AFTER_DRAIN) { E.fused(acc, cur, wr, wc, fr, fq, lds, wid, lane); S.done(cur); }
#undef PG8_SA
#undef PG8_SB
#undef PG8_STAGE
#undef PG8_LDA
#undef PG8_LDB
#undef PG8_MMA
#undef PG8_WAIT_V
#undef PG8_WAIT_L
#undef PG8_BAR
#undef PG8_SCHED
}
}
namespace pg8 {
#define PG8_GAS __attribute__((address_space(1)))
typedef unsigned u32x2 __attribute__((ext_vector_type(2)));
__device__ __forceinline__ float ex2(float x) { return __builtin_amdgcn_exp2f(x); }
__device__ __forceinline__ float sigm(float x) { return __builtin_amdgcn_rcpf(1.0f + ex2(-1.4426950408889634f * x)); }
__device__ __forceinline__ float bflo(unsigned w) { return __uint_as_float(w << 16); }
__device__ __forceinline__ float bfhi(unsigned w) { return __uint_as_float(w & 0xffff0000u); }

typedef unsigned ssq_t;
__device__ __forceinline__ ssq_t ss_fix(float v) { return (ssq_t)(v * 1024.0f); }
__device__ __forceinline__ float rstd_fix(ssq_t s) { return 1.0f / sqrtf((float)s * (1.0f / (1024.0f * 1024.0f)) + 1e-6f); }
struct NoPre { struct Pre {}; __device__ __forceinline__ Pre prefetch(const Unit&, int, int) const { return Pre{}; } };
struct SsPre { struct Pre { ssq_t s[8]; };
    __device__ __forceinline__ static Pre load(const ssq_t* ss, const Unit& u, int wr, int fr) { Pre p;
#pragma unroll
        for (int i = 0; i < 8; ++i) p.s[i] = ss ? ss[u.pm * BM + wr * 64 + fr + (i >> 2) * HALF + (i & 3) * 16] : 0u;
        return p; } };
__device__ __forceinline__ float quad_sum(float v, int fr, int fq) {
    const int lane = fr + 16 * fq;
    v += __int_as_float(__builtin_amdgcn_ds_bpermute((lane ^ 16) << 2, __float_as_int(v)));
    v += __int_as_float(__builtin_amdgcn_ds_bpermute((lane ^ 32) << 2, __float_as_int(v)));
    return v;
}
struct EpiQK {
    static constexpr bool PERM = true, AFTER_DRAIN = false, MIDK = false; typedef SsPre::Pre Pre;
    bf16_t* O; unsigned ldc; const ssq_t* ss; const float* g_q; const float* g_k; float* kmp; float qscale;
    __device__ __forceinline__ Pre prefetch(const Unit& u, int wr, int fr) const { return SsPre::load(ss, u, wr, fr); }
    __device__ __forceinline__ void operator()(const f32x4 (&acc)[2][2][4][2], const Unit& u, int wr, int wc, int fr_, int fq_, const Pre& pre) const {
        int fr = fr_, fq = fq_; asm volatile("" : "+v"(fr), "+v"(fq));
        const bool isq = u.pn < 2; const float* gg = (isq ? g_q : g_k) + 8 * fq; const float osc = isq ? qscale : 1.0f;
        f32x4 gn[2][2], cs[2][2];
#pragma unroll
        for (int bj = 0; bj < 2; ++bj)
#pragma unroll
            for (int n = 0; n < 2; ++n) { gn[bj][n] = *(const f32x4*)(gg + 32 * bj + 4 * n); cs[bj][n] = (f32x4){0.f, 0.f, 0.f, 0.f}; }
        const unsigned obase = (unsigned)(u.pm * BM + wr * 64 + fr) * ldc + (unsigned)(u.pn * BM + wc * 64 + 8 * fq);
#pragma unroll
        for (int ai = 0; ai < 2; ++ai)
#pragma unroll
            for (int m = 0; m < 4; ++m) { const float rs = rstd_fix(pre.s[ai * 4 + m]);
                float q2 = 0.f;
#pragma unroll
                for (int bj = 0; bj < 2; ++bj)
#pragma unroll
                    for (int n = 0; n < 2; ++n) { const f32x4 a = acc[ai][bj][m][n]; q2 += (a[0] * a[0] + a[1] * a[1]) + (a[2] * a[2] + a[3] * a[3]); }
                q2 = quad_sum(q2, fr, fq);
                const float rr = rs * __builtin_amdgcn_rsqf(rs * rs * q2 * (1.0f / 64.0f) + 1e-6f) * osc;
                const unsigned off = obase + (unsigned)(ai * HALF + m * 16) * ldc;
#pragma unroll
                for (int bj = 0; bj < 2; ++bj) { const f32x4 o0 = acc[ai][bj][m][0] * (gn[bj][0] * rr), o1 = acc[ai][bj][m][1] * (gn[bj][1] * rr); cs[bj][0] += o0; cs[bj][1] += o1;
                    u32x4 w; w.x = cvt_pk_bf16(o0[0], o0[1]); w.y = cvt_pk_bf16(o0[2], o0[3]); w.z = cvt_pk_bf16(o1[0], o1[1]); w.w = cvt_pk_bf16(o1[2], o1[3]);
                    *(u32x4*)(O + off + 32 * bj) = w; }
                asm volatile("" : "+v"(cs[0][0]), "+v"(cs[0][1]), "+v"(cs[1][0]), "+v"(cs[1][1]));
                __builtin_amdgcn_sched_barrier(0); }
        if (!isq) {
            const int lane = fr + 16 * fq;
#pragma unroll
            for (int o = 1; o < 16; o <<= 1)
#pragma unroll
                for (int bj = 0; bj < 2; ++bj)
#pragma unroll
                    for (int n = 0; n < 2; ++n)
#pragma unroll
                        for (int j = 0; j < 4; ++j) cs[bj][n][j] += __int_as_float(__builtin_amdgcn_ds_bpermute((lane ^ o) << 2, __float_as_int(cs[bj][n][j])));
            if (fr == 0) { float* kp = kmp + ((((unsigned)(u.pm >> 4) * 8 + (u.pn & 1) * 4 + wc) * 16 + (u.pm & 15)) * 2 + wr) * 64 + 8 * fq;
#pragma unroll
                for (int bj = 0; bj < 2; ++bj) { *(f32x4*)(kp + 32 * bj) = cs[bj][0]; *(f32x4*)(kp + 32 * bj + 4) = cs[bj][1]; } }
        }
    }
};
struct EpiProj {
    static constexpr bool PERM = true, AFTER_DRAIN = false, MIDK = false; typedef SsPre::Pre Pre;
    bf16_t* O; int ldc; int sig_from; const ssq_t* ss; int gate_tile; float* ifpre; const float* b_i; const float* b_f; bf16_t* GT; int pn0;
    __device__ __forceinline__ Pre prefetch(const Unit& u, int wr, int fr) const { return SsPre::load(ss, u, wr, fr); }
    __device__ __forceinline__ void operator()(const f32x4 (&acc)[2][2][4][2], const Unit& u_, int wr, int wc, int fr, int fq, const Pre& pre) const {
        Unit u = u_; u.pn += pn0;
        const int row0 = u.pm * BM + wr * 64 + fr, col0 = u.pn * BM + wc * 32 + 8 * fq; const bool sg = u.pn >= sig_from;
        if (u.pn == gate_tile) {
            if (wc == 0 && fq == 0) { const f32x4 bi = *(const f32x4*)b_i, bf = *(const f32x4*)b_f;
#pragma unroll
                for (int ai = 0; ai < 2; ++ai)
#pragma unroll
                    for (int m = 0; m < 4; ++m) { const int r = row0 + ai * HALF + m * 16; const float rs = rstd_fix(pre.s[ai * 4 + m]);
                        *(f32x4*)(ifpre + (size_t)r * 8) = acc[ai][0][m][0] * rs + bi; *(f32x4*)(ifpre + (size_t)r * 8 + 4) = acc[ai][0][m][1] * rs + bf; } }
            return; }
#pragma unroll
        for (int ai = 0; ai < 2; ++ai)
#pragma unroll
            for (int m = 0; m < 4; ++m) { const int r = row0 + ai * HALF + m * 16; bf16_t* rowp = O + (size_t)r * ldc + col0; const float rs = rstd_fix(pre.s[ai * 4 + m]);
#pragma unroll
                for (int bj = 0; bj < 2; ++bj) { f32x4 v0 = acc[ai][bj][m][0] * rs, v1 = acc[ai][bj][m][1] * rs;
                    if (sg) {
#pragma unroll
                        for (int j = 0; j < 4; ++j) { v0[j] = sigm(v0[j]); v1[j] = sigm(v1[j]); } }
                    u32x4 w; w.x = cvt_pk_bf16(v0[0], v0[1]); w.y = cvt_pk_bf16(v0[2], v0[3]); w.z = cvt_pk_bf16(v1[0], v1[1]); w.w = cvt_pk_bf16(v1[2], v1[3]);
                    if (sg) *(u32x4*)(GT + ((((size_t)u.pm * 8 + (u.pn - sig_from)) * 16 + (ai * 8 + m * 2 + bj)) * 8 + (wr * 4 + wc)) * 512 + (fr + 16 * fq) * 8) = w;
                    else *(u32x4*)(rowp + bj * HALF) = w; } }
    }
};
struct EpiSwiglu {
    static constexpr bool PERM = true, AFTER_DRAIN = false, MIDK = false; typedef SsPre::Pre Pre;
    bf16_t* O; int ldc; const ssq_t* ss; float osc; float f8out;
    __device__ __forceinline__ Pre prefetch(const Unit& u, int wr, int fr) const { return SsPre::load(ss, u, wr, fr); }
    __device__ __forceinline__ void operator()(const f32x4 (&acc)[2][2][4][2], const Unit& u, int wr, int wc, int fr_, int fq_, const Pre& pre) const {
        int fr = fr_, fq = fq_; asm volatile("" : "+v"(fr), "+v"(fq));
        const unsigned obase = (unsigned)(u.pm * BM + wr * 64 + fr) * (unsigned)ldc + (unsigned)(u.pn * HALF + wc * 32 + 8 * fq);
#pragma unroll
        for (int ai = 0; ai < 2; ++ai)
#pragma unroll
            for (int m = 0; m < 4; ++m) { bf16_t* rowp = O + (obase + (unsigned)(ai * HALF + m * 16) * (unsigned)ldc); const float rs = (ss ? rstd_fix(pre.s[ai * 4 + m]) : 1.0f) * osc;
                const float nl = -1.4426950408889634f * rs, ic = __builtin_amdgcn_rcpf(rs * rs * (f8out != 0.f ? f8out : 1.0f));
                f32x4 v0, v1;
#pragma unroll
                for (int j = 0; j < 4; ++j) { const float g0 = acc[ai][0][m][0][j], g1 = acc[ai][0][m][1][j];
                    v0[j] = (g0 * acc[ai][1][m][0][j]) * __builtin_amdgcn_rcpf(fmaf(ex2(g0 * nl), ic, ic)); v1[j] = (g1 * acc[ai][1][m][1][j]) * __builtin_amdgcn_rcpf(fmaf(ex2(g1 * nl), ic, ic)); }
                if (f8out != 0.f) {
#pragma unroll
                    for (int j = 0; j < 4; ++j) { v0[j] = __builtin_amdgcn_fmed3f(v0[j], -448.0f, 448.0f); v1[j] = __builtin_amdgcn_fmed3f(v1[j], -448.0f, 448.0f); }
                    int a_ = __builtin_amdgcn_cvt_pk_fp8_f32(v0[0], v0[1], 0, false); a_ = __builtin_amdgcn_cvt_pk_fp8_f32(v0[2], v0[3], a_, true);
                    int b_ = __builtin_amdgcn_cvt_pk_fp8_f32(v1[0], v1[1], 0, false); b_ = __builtin_amdgcn_cvt_pk_fp8_f32(v1[2], v1[3], b_, true);
                    u32x2 w8; w8.x = (unsigned)a_; w8.y = (unsigned)b_; *(u32x2*)((unsigned char*)O + (obase + (unsigned)(ai * HALF + m * 16) * (unsigned)ldc)) = w8; }
                else { u32x4 w; w.x = cvt_pk_bf16(v0[0], v0[1]); w.y = cvt_pk_bf16(v0[2], v0[3]); w.z = cvt_pk_bf16(v1[0], v1[1]); w.w = cvt_pk_bf16(v1[2], v1[3]);
                    *(u32x4*)rowp = w; } }
    }
};
struct EpiResid {
    static constexpr bool PERM = true, AFTER_DRAIN = false, MIDK = false; typedef NoPre::Pre Pre; __device__ __forceinline__ Pre prefetch(const Unit&, int, int) const { return Pre{}; }
    const float* base; float* out; int ldc; const float* rowscale; int rs_ld; bf16_t* xb; ssq_t* ssacc;
    __device__ __forceinline__ void operator()(const f32x4 (&acc)[2][2][4][2], const Unit& u, int wr, int wc, int fr_, int fq_, const Pre&) const {
        int fr = fr_, fq = fq_; asm volatile("" : "+v"(fr), "+v"(fq));
        const int row0 = u.pm * BM + wr * 64 + fr, col0 = u.pn * BM + wc * 32 + 8 * fq;
        const PG8_GAS float* gb_ = (const PG8_GAS float*)base;
        f32x4 bv[2][4][2][2];
#define PG8_RESID_LOAD(ai) do { _Pragma("unroll") for (int m = 0; m < 4; ++m) _Pragma("unroll") for (int bj = 0; bj < 2; ++bj) { const size_t off = (size_t)(row0 + (ai) * HALF + m * 16) * ldc + col0 + bj * HALF; \
            bv[ai][m][bj][0] = *(const PG8_GAS f32x4*)(gb_ + off); bv[ai][m][bj][1] = *(const PG8_GAS f32x4*)(gb_ + off + 4); } __builtin_amdgcn_sched_barrier(0); } while (0)
#define PG8_RESID_STEP(ai, m) do { const int r = row0 + (ai) * HALF + (m) * 16; const float s = rowscale ? rowscale[(size_t)r * rs_ld] : 1.0f; float part = 0.f; \
            _Pragma("unroll") for (int bj = 0; bj < 2; ++bj) { const size_t off = (size_t)r * ldc + col0 + bj * HALF; \
                const f32x4 v0 = bv[ai][m][bj][0] + acc[ai][bj][m][0] * s, v1 = bv[ai][m][bj][1] + acc[ai][bj][m][1] * s; \
                *(PG8_GAS f32x4*)((PG8_GAS float*)out + off) = v0; *(PG8_GAS f32x4*)((PG8_GAS float*)out + off + 4) = v1; \
                if (xb) { u32x4 w; w.x = cvt_pk_bf16(v0[0], v0[1]); w.y = cvt_pk_bf16(v0[2], v0[3]); w.z = cvt_pk_bf16(v1[0], v1[1]); w.w = cvt_pk_bf16(v1[2], v1[3]); *(PG8_GAS u32x4*)((PG8_GAS bf16_t*)xb + off) = w; } \
                part += (v0[0] * v0[0] + v0[1] * v0[1]) + (v0[2] * v0[2] + v0[3] * v0[3]) + (v1[0] * v1[0] + v1[1] * v1[1]) + (v1[2] * v1[2] + v1[3] * v1[3]); } \
            if (ssacc) { part = quad_sum(part, fr, fq); if (fq == 0) __hip_atomic_fetch_add((PG8_GAS ssq_t*)ssacc + r, ss_fix(part), __ATOMIC_RELAXED, __HIP_MEMORY_SCOPE_AGENT); } } while (0)
        PG8_RESID_LOAD(0);
        PG8_RESID_STEP(0, 0); PG8_RESID_STEP(0, 1); __builtin_amdgcn_sched_barrier(0);
        PG8_RESID_LOAD(1);
        PG8_RESID_STEP(0, 2); PG8_RESID_STEP(0, 3); PG8_RESID_STEP(1, 0); PG8_RESID_STEP(1, 1); PG8_RESID_STEP(1, 2); PG8_RESID_STEP(1, 3);
#undef PG8_RESID_LOAD
#undef PG8_RESID_STEP
    }
};
struct EpiMerge {
    static constexpr bool PERM = true, AFTER_DRAIN = false, MIDK = true; static constexpr int MID_T = 8; typedef NoPre::Pre Pre; __device__ __forceinline__ Pre prefetch(const Unit&, int, int) const { return Pre{}; }
    const bf16_t* GT; bf16_t* O; int ldc;
    __device__ __forceinline__ void mid(f32x4 (&acc)[2][2][4][2], const Unit& u, int wr, int wc, int fr_, int fq_) const {
        int fr = fr_, fq = fq_; asm volatile("" : "+v"(fr), "+v"(fq));
        const PG8_GAS bf16_t* ga_ = (const PG8_GAS bf16_t*)GT + ((size_t)u.pm * 8 + u.pn) * 65536 + (size_t)(wr * 4 + wc) * 512 + (fr + 16 * fq) * 8;
#pragma unroll
        for (int ai = 0; ai < 2; ++ai) { u32x4 ga[4][2], gb[4][2];
#pragma unroll
            for (int m = 0; m < 4; ++m)
#pragma unroll
                for (int bj = 0; bj < 2; ++bj) { const size_t fo = (size_t)(ai * 8 + m * 2 + bj) * 4096; ga[m][bj] = *(const PG8_GAS u32x4*)(ga_ + fo); gb[m][bj] = *(const PG8_GAS u32x4*)(ga_ + 4 * 65536 + fo); }
            __builtin_amdgcn_sched_barrier(0);
#pragma unroll
            for (int m = 0; m < 4; ++m)
#pragma unroll
                for (int bj = 0; bj < 2; ++bj) { const u32x4 a = ga[m][bj], b = gb[m][bj];
                    const f32x4 a0 = {bflo(a.x), bfhi(a.x), bflo(a.y), bfhi(a.y)}, a1 = {bflo(a.z), bfhi(a.z), bflo(a.w), bfhi(a.w)}, b0 = {bflo(b.x), bfhi(b.x), bflo(b.y), bfhi(b.y)}, b1 = {bflo(b.z), bfhi(b.z), bflo(b.w), bfhi(b.w)};
#pragma unroll
                    for (int j = 0; j < 4; ++j) { acc[ai][bj][m][0][j] *= a0[j] * __builtin_amdgcn_rcpf(fmaxf(b0[j], 1e-30f)); acc[ai][bj][m][1][j] *= a1[j] * __builtin_amdgcn_rcpf(fmaxf(b1[j], 1e-30f)); } }
            __builtin_amdgcn_sched_barrier(0); }
    }
    __device__ __forceinline__ void operator()(const f32x4 (&acc)[2][2][4][2], const Unit& u, int wr, int wc, int fr_, int fq_, const Pre&) const {
        int fr = fr_, fq = fq_; asm volatile("" : "+v"(fr), "+v"(fq));
        const int row0 = u.pm * BM + wr * 64 + fr, col0 = u.pn * BM + wc * 32 + 8 * fq;
        const PG8_GAS bf16_t* gb_ = (const PG8_GAS bf16_t*)GT + ((size_t)u.pm * 8 + 4 + u.pn) * 65536 + (size_t)(wr * 4 + wc) * 512 + (fr + 16 * fq) * 8;
        u32x4 gb[2][4][2];
#pragma unroll
        for (int ai = 0; ai < 2; ++ai)
#pragma unroll
            for (int m = 0; m < 4; ++m)
#pragma unroll
                for (int bj = 0; bj < 2; ++bj) gb[ai][m][bj] = *(const PG8_GAS u32x4*)(gb_ + (size_t)(ai * 8 + m * 2 + bj) * 4096);
        __builtin_amdgcn_sched_barrier(0);
#pragma unroll
        for (int ai = 0; ai < 2; ++ai)
#pragma unroll
            for (int m = 0; m < 4; ++m) { const size_t r = (size_t)(row0 + ai * HALF + m * 16);
#pragma unroll
                for (int bj = 0; bj < 2; ++bj) { const u32x4 b = gb[ai][m][bj];
                    const f32x4 b0 = {bflo(b.x), bfhi(b.x), bflo(b.y), bfhi(b.y)}, b1 = {bflo(b.z), bfhi(b.z), bflo(b.w), bfhi(b.w)};
                    const f32x4 v0 = acc[ai][bj][m][0] * b0, v1 = acc[ai][bj][m][1] * b1;
                    u32x4 w; w.x = cvt_pk_bf16(v0[0], v0[1]); w.y = cvt_pk_bf16(v0[2], v0[3]); w.z = cvt_pk_bf16(v1[0], v1[1]); w.w = cvt_pk_bf16(v1[2], v1[3]);
                    *(PG8_GAS u32x4*)((PG8_GAS bf16_t*)O + r * ldc + col0 + bj * HALF) = w; } }
    }
};
struct EpiGate1 {
    static constexpr bool PERM = true, AFTER_DRAIN = false, MIDK = false; typedef NoPre::Pre Pre; __device__ __forceinline__ Pre prefetch(const Unit&, int, int) const { return Pre{}; }
    const bf16_t* G; int ldg; bf16_t* T; int ldc;
    __device__ __forceinline__ void operator()(const f32x4 (&acc)[2][2][4][2], const Unit& u, int wr, int wc, int fr, int fq, const Pre&) const {
        const int row0 = u.pm * BM + wr * 64 + fr, col0 = u.pn * BM + wc * 32 + 8 * fq;
#pragma unroll
        for (int ai = 0; ai < 2; ++ai)
#pragma unroll
            for (int m = 0; m < 4; ++m) { const size_t r = (size_t)(row0 + ai * HALF + m * 16);
#pragma unroll
                for (int bj = 0; bj < 2; ++bj) { const u32x4 g = *(const u32x4*)(G + r * ldg + col0 + bj * HALF);
                    f32x4 g0 = {bflo(g.x), bfhi(g.x), bflo(g.y), bfhi(g.y)}, g1 = {bflo(g.z), bfhi(g.z), bflo(g.w), bfhi(g.w)};
                    const f32x4 t0 = g0 * acc[ai][bj][m][0], t1 = g1 * acc[ai][bj][m][1];
                    u32x4 w; w.x = cvt_pk_bf16(t0[0], t0[1]); w.y = cvt_pk_bf16(t0[2], t0[3]); w.z = cvt_pk_bf16(t1[0], t1[1]); w.w = cvt_pk_bf16(t1[2], t1[3]);
                    *(u32x4*)(T + r * ldc + col0 + bj * HALF) = w; } }
    }
};
struct EpiGate2 {
    static constexpr bool PERM = true, AFTER_DRAIN = false, MIDK = false; typedef NoPre::Pre Pre; __device__ __forceinline__ Pre prefetch(const Unit&, int, int) const { return Pre{}; }
    const bf16_t* G; int ldg; const bf16_t* T; bf16_t* O; int ldc;
    __device__ __forceinline__ void operator()(const f32x4 (&acc)[2][2][4][2], const Unit& u, int wr, int wc, int fr, int fq, const Pre&) const {
        const int row0 = u.pm * BM + wr * 64 + fr, col0 = u.pn * BM + wc * 32 + 8 * fq;
#pragma unroll
        for (int ai = 0; ai < 2; ++ai)
#pragma unroll
            for (int m = 0; m < 4; ++m) { const size_t r = (size_t)(row0 + ai * HALF + m * 16);
#pragma unroll
                for (int bj = 0; bj < 2; ++bj) { const u32x4 g = *(const u32x4*)(G + r * ldg + col0 + bj * HALF);
                    f32x4 g0 = {bflo(g.x), bfhi(g.x), bflo(g.y), bfhi(g.y)}, g1 = {bflo(g.z), bfhi(g.z), bflo(g.w), bfhi(g.w)};
                    const u32x4 tt = *(const u32x4*)(T + r * ldc + col0 + bj * HALF);
                    const f32x4 v0 = (f32x4){bflo(tt.x), bfhi(tt.x), bflo(tt.y), bfhi(tt.y)} + g0 * acc[ai][bj][m][0], v1 = (f32x4){bflo(tt.z), bfhi(tt.z), bflo(tt.w), bfhi(tt.w)} + g1 * acc[ai][bj][m][1];
                    u32x4 w; w.x = cvt_pk_bf16(v0[0], v0[1]); w.y = cvt_pk_bf16(v0[2], v0[3]); w.z = cvt_pk_bf16(v1[0], v1[1]); w.w = cvt_pk_bf16(v1[2], v1[3]);
                    *(u32x4*)(O + r * ldc + col0 + bj * HALF) = w; } }
    }
};
struct EpiF32 {
    static constexpr bool PERM = true, AFTER_DRAIN = false, MIDK = false; typedef NoPre::Pre Pre; __device__ __forceinline__ Pre prefetch(const Unit&, int, int) const { return Pre{}; }
    bf16_t* O; int ldc;
    __device__ __forceinline__ void operator()(const f32x4 (&acc)[2][2][4][2], const Unit& u, int wr, int wc, int fr, int fq, const Pre&) const {
        const int row0 = u.pm * BM + wr * 64 + fr, col0 = u.pn * BM + wc * 32 + 8 * fq;
#pragma unroll
        for (int ai = 0; ai < 2; ++ai)
#pragma unroll
            for (int m = 0; m < 4; ++m)
#pragma unroll
                for (int bj = 0; bj < 2; ++bj) { const f32x4 v0 = acc[ai][bj][m][0], v1 = acc[ai][bj][m][1]; u32x4 w; w.x = cvt_pk_bf16(v0[0], v0[1]); w.y = cvt_pk_bf16(v0[2], v0[3]); w.z = cvt_pk_bf16(v1[0], v1[1]); w.w = cvt_pk_bf16(v1[2], v1[3]);
                    *(u32x4*)(O + (size_t)(row0 + ai * HALF + m * 16) * ldc + col0 + bj * HALF) = w; }
    }
};
struct EpiPle2 {
    static constexpr bool PERM = true, AFTER_DRAIN = false, MIDK = false; typedef NoPre::Pre Pre; __device__ __forceinline__ Pre prefetch(const Unit&, int, int) const { return Pre{}; }
    const bf16_t* PP; float* x; int ldc; const ssq_t* ss_in; bf16_t* xb; ssq_t* ssacc;
    __device__ __forceinline__ void operator()(const f32x4 (&acc)[2][2][4][2], const Unit& u, int wr, int wc, int fr_, int fq_, const Pre&) const {
        int fr = fr_, fq = fq_; asm volatile("" : "+v"(fr), "+v"(fq));
        const int row0 = u.pm * BM + wr * 64 + fr, col0 = u.pn * BM + wc * 32 + 8 * fq;
        const PG8_GAS float* gx_ = (const PG8_GAS float*)x; const PG8_GAS bf16_t* gp_ = (const PG8_GAS bf16_t*)PP;
        f32x4 xv[4][2][2][2]; u32x4 pv[4][2][2]; ssq_t sv[4][2];
#define PG8_PLE_LOAD(q) do { _Pragma("unroll") for (int mm = 0; mm < 2; ++mm) { sv[q][mm] = ss_in ? ((const PG8_GAS ssq_t*)ss_in)[row0 + ((q) >> 1) * HALF + (((q) & 1) * 2 + mm) * 16] : 0u; _Pragma("unroll") for (int bj = 0; bj < 2; ++bj) { const size_t off = (size_t)(row0 + ((q) >> 1) * HALF + (((q) & 1) * 2 + mm) * 16) * ldc + col0 + bj * HALF; \
            pv[q][mm][bj] = *(const PG8_GAS u32x4*)(gp_ + off); xv[q][mm][bj][0] = *(const PG8_GAS f32x4*)(gx_ + off); xv[q][mm][bj][1] = *(const PG8_GAS f32x4*)(gx_ + off + 4); } } __builtin_amdgcn_sched_barrier(0); } while (0)
#define PG8_PLE_STEP(q, mm) do { constexpr int ai = (q) >> 1, m = ((q) & 1) * 2 + (mm); const int r = row0 + ai * HALF + m * 16; ssq_t sq_ = sv[q][mm]; asm volatile("" : "+v"(sq_));   const float rs = ss_in ? rstd_fix(sq_) : 1.0f; float part = 0.f; \
            _Pragma("unroll") for (int bj = 0; bj < 2; ++bj) { const size_t off = (size_t)r * ldc + col0 + bj * HALF; \
                f32x4 a0 = acc[ai][bj][m][0] * rs, a1 = acc[ai][bj][m][1] * rs; \
                _Pragma("unroll") for (int j = 0; j < 4; ++j) { a0[j] = sigm(a0[j]); a1[j] = sigm(a1[j]); } \
                const u32x4 pw = pv[q][mm][bj]; \
                const f32x4 v0 = xv[q][mm][bj][0] + a0 * (f32x4){bflo(pw.x), bfhi(pw.x), bflo(pw.y), bfhi(pw.y)}, v1 = xv[q][mm][bj][1] + a1 * (f32x4){bflo(pw.z), bfhi(pw.z), bflo(pw.w), bfhi(pw.w)}; \
                *(PG8_GAS f32x4*)((PG8_GAS float*)x + off) = v0; *(PG8_GAS f32x4*)((PG8_GAS float*)x + off + 4) = v1; \
                if (xb) { u32x4 w; w.x = cvt_pk_bf16(v0[0], v0[1]); w.y = cvt_pk_bf16(v0[2], v0[3]); w.z = cvt_pk_bf16(v1[0], v1[1]); w.w = cvt_pk_bf16(v1[2], v1[3]); *(PG8_GAS u32x4*)((PG8_GAS bf16_t*)xb + off) = w; } \
                part += (v0[0] * v0[0] + v0[1] * v0[1]) + (v0[2] * v0[2] + v0[3] * v0[3]) + (v1[0] * v1[0] + v1[1] * v1[1]) + (v1[2] * v1[2] + v1[3] * v1[3]); } \
            if (ssacc) { part = quad_sum(part, fr, fq); if (fq == 0) __hip_atomic_fetch_add((PG8_GAS ssq_t*)ssacc + r, ss_fix(part), __ATOMIC_RELAXED, __HIP_MEMORY_SCOPE_AGENT); } } while (0)
        PG8_PLE_LOAD(0);
        PG8_PLE_STEP(0, 0); __builtin_amdgcn_sched_barrier(0);
        PG8_PLE_LOAD(1);
        PG8_PLE_STEP(0, 1); PG8_PLE_STEP(1, 0); __builtin_amdgcn_sched_barrier(0);
        PG8_PLE_LOAD(2);
        PG8_PLE_STEP(1, 1); PG8_PLE_STEP(2, 0); __builtin_amdgcn_sched_barrier(0);
        PG8_PLE_LOAD(3);
        PG8_PLE_STEP(2, 1); PG8_PLE_STEP(3, 0); PG8_PLE_STEP(3, 1);
#undef PG8_PLE_LOAD
#undef PG8_PLE_STEP
    }
};
}
#define GAS __attribute__((address_space(1)))
#define LAS __attribute__((address_space(3)))
typedef unsigned short bf16;
typedef unsigned v4u __attribute__((ext_vector_type(4)));
typedef float f32x4 __attribute__((ext_vector_type(4)));
typedef short bf16x8 __attribute__((ext_vector_type(8)));
typedef GAS unsigned gu32;
typedef GAS unsigned long long gu64;
#define RLX_AGENT __ATOMIC_RELAXED, __HIP_MEMORY_SCOPE_AGENT
#define LDS_WAIT() asm volatile("s_waitcnt lgkmcnt(0)" ::: "memory")
#define VM_WAIT() asm volatile("s_waitcnt vmcnt(0)" ::: "memory")
__device__ __forceinline__ unsigned long long rt() { return __builtin_amdgcn_s_memrealtime(); }
__device__ __forceinline__ unsigned f2bf(float f) { unsigned u = __builtin_bit_cast(unsigned, f); return (u + 0x7fffu + ((u >> 16) & 1u)) >> 16; }
__device__ __forceinline__ unsigned pk2(float lo, float hi) { return f2bf(lo) | (f2bf(hi) << 16); }

#define XB_TMO      128
#define XB_XCNT(j)  (256  + 64 * (j))
#define XB_XSUB(j)  (1280 + 64 * (j))
#define XB_XGEN(j)  (2304 + 64 * (j))
#define XB_TOP      3328
#define XB_TOPGEN   3392
#define XCD_BAR_WORDS 3456
#define XB_SPIN_CAP (1u << 18)

__device__ __forceinline__ unsigned xb_ld(unsigned* p)              { return __hip_atomic_load(p, __ATOMIC_RELAXED, __HIP_MEMORY_SCOPE_AGENT); }
__device__ __forceinline__ unsigned xb_add(unsigned* p, unsigned v) { return __hip_atomic_fetch_add(p, v, __ATOMIC_RELAXED, __HIP_MEMORY_SCOPE_AGENT); }
__device__ __forceinline__ unsigned xb_xcc_id() { return (unsigned)__builtin_amdgcn_s_getreg((3 << 11) | 20) & 0xFu; }
#define XB_SPIN(cond, bar) do { unsigned _sp = 0; while (cond) { __builtin_amdgcn_s_sleep(1); \
    if ((++_sp & 255u) == 0u) { if (xb_ld(&(bar)[XB_TMO])) break; if (_sp > XB_SPIN_CAP) { atomicAdd(&(bar)[XB_TMO], 1u); break; } } } } while (0)

__device__ __forceinline__ int lane_now() { int l; asm volatile("v_mbcnt_lo_u32_b32 %0, -1, 0\n\tv_mbcnt_hi_u32_b32 %0, -1, %0" : "=v"(l)); return l; }
struct XcdBarrier {
    unsigned* bar; unsigned x; int wave;
    volatile LAS unsigned* st;
};

__device__ __forceinline__ XcdBarrier xcd_barrier_post(unsigned* bar, volatile LAS unsigned* st, int wave) {
    XcdBarrier b; b.bar = bar; b.x = xb_xcc_id(); b.st = st; b.wave = wave;
    if (wave == 0 && lane_now() == 0) (void)xb_add(&bar[XB_XCNT(b.x)], 1u);
    return b;
}
__device__ __forceinline__ void xcd_barrier_complete(unsigned* bar, unsigned x, unsigned& nloc, unsigned& nx) {
    const unsigned G = gridDim.x * gridDim.y * gridDim.z;
    unsigned sum, cnt, mine, sp = 0u;
    for (;;) {
        sum = 0u; cnt = 0u; mine = 0u;
#pragma unroll
        for (unsigned j = 0; j < 16; ++j) { const unsigned c = xb_ld(&bar[XB_XCNT(j)]); sum += c; cnt += (c > 0u) ? 1u : 0u; mine = (j == x) ? c : mine; }
        if (sum == G) break;
        __builtin_amdgcn_s_sleep(1);
        if ((++sp & 255u) == 0u) { if (xb_ld(&bar[XB_TMO])) break; if (sp > XB_SPIN_CAP) { atomicAdd(&bar[XB_TMO], 1u); break; } }
    }
    nloc = mine > 0u ? mine : 1u; nx = cnt > 0u ? cnt : 1u;
}

__device__ __forceinline__ void xcd_barrier(const XcdBarrier& b) {
    asm volatile("s_waitcnt vmcnt(0)" ::: "memory");
    __syncthreads();
    if (b.wave == 0 && lane_now() == 0) {
        unsigned* bar = b.bar;
        __builtin_amdgcn_s_waitcnt(0);
        unsigned nloc = b.st[0], nx = b.st[1];
        if (nloc == 0u) { xcd_barrier_complete(bar, b.x, nloc, nx); b.st[0] = nloc; b.st[1] = nx; }
        const unsigned old = xb_add(&bar[XB_XSUB(b.x)], 1u);
        const unsigned gen = old / nloc;
        if (old + 1u == (gen + 1u) * nloc) {
            __builtin_amdgcn_fence(__ATOMIC_RELEASE, "agent");
            asm volatile("s_waitcnt vmcnt(0)" ::: "memory");
            const unsigned og = xb_add(&bar[XB_TOP], 1u);
            const unsigned tg = og / nx;
            if (og + 1u == (tg + 1u) * nx) xb_add(&bar[XB_TOPGEN], 1u);
            else XB_SPIN(xb_ld(&bar[XB_TOPGEN]) == tg, bar);
            __builtin_amdgcn_fence(__ATOMIC_ACQUIRE, "agent");
            xb_add(&bar[XB_XGEN(b.x)], 1u);
            asm volatile("s_waitcnt vmcnt(0)" ::: "memory");
        } else {
            XB_SPIN(xb_ld(&bar[XB_XGEN(b.x)]) == gen, bar);
            __builtin_amdgcn_fence(__ATOMIC_ACQUIRE, "agent");
            asm volatile("s_waitcnt vmcnt(0)" ::: "memory");
        }
    }
    __syncthreads();
}
constexpr int NWAVES = 8, NTHR = NWAVES * 64;
constexpr int BATCH = 4, SEQ = 4096, D = 1024, M = BATCH * SEQ, NIN = 5640, NPROJ = 3584, PLE = 256;
constexpr int DFF = 2816, NEXP = 8, DFFE = 3584, NLAYER = 2;
constexpr int AH = 8, AHD = 64, ABLK = 256, ANB = SEQ / ABLK;
constexpr int MH = 4, MDK = 128;
constexpr float RMS_EPS = 1e-6f;
constexpr float C2 = 0.125f * 1.4426950408889634f;
constexpr int PC_Q = 0, PC_K = 512, PC_V = 1024, PC_QKM = 1536, PC_VM = 2560, PC_OM = 3072, PC_GA = 3584, PC_GB = 4608;

constexpr size_t MiB = 1u << 20;
constexpr size_t WS_CTL = 0, CTL_ZERO_BYTES = 1 * MiB;
constexpr int NPROJX = 5888;
constexpr size_t WS_WIN = 1 * MiB, WS_WOA = 24 * MiB, WS_WOB = 26 * MiB, WS_WOUT = 28 * MiB, WS_WD13 = 32 * MiB, WS_WD2 = 43 * MiB, WS_WPG = 49 * MiB, WS_WPP = 53 * MiB, WS_PB = 54 * MiB;
constexpr size_t WS_WE = 70 * MiB;
constexpr size_t WS_SMALL = 154 * MiB;
constexpr size_t WS_XB = 161 * MiB;
constexpr size_t WS_SS0 = WS_SMALL + 5 * MiB;
constexpr size_t WS_IFPRE = WS_SMALL, WS_KMEAN = WS_SMALL + 1 * MiB, WS_GSEL = WS_SMALL + 4 * MiB;
constexpr size_t WS_HB = 161 * MiB, WS_QKC = 193 * MiB, WS_YA = 225 * MiB, WS_YB = 225 * MiB + 1024  , WS_MIXED = 257 * MiB, WS_ST = 289 * MiB, WS_PROJ = 309 * MiB, WS_END = 485 * MiB;
constexpr size_t WS_TOPI = WS_SMALL + 2 * MiB, WS_TOPG = WS_TOPI + 256 * 1024, WS_DEST = WS_TOPG + 256 * 1024, WS_ROWTOK = WS_SMALL + 3 * MiB, WS_TILEE = WS_ROWTOK + 512 * 1024, WS_NTILES = WS_TILEE + 4096;
constexpr int MOE_MAXROWS = 2 * M + NEXP * 256;
constexpr size_t WS_WE2B = 448 * MiB;
constexpr size_t WS_XG = 193 * MiB, WS_Y = 261 * MiB, WS_GHH = 329 * MiB;
static_assert(WS_XG + (size_t)MOE_MAXROWS * D * 2 <= WS_Y && WS_Y + (size_t)MOE_MAXROWS * D * 2 <= WS_GHH && WS_GHH + (size_t)MOE_MAXROWS * DFFE <= WS_END, "MoE buffers");
constexpr size_t WS_GT = WS_PROJ + (size_t)M * NPROJ * 2;
static_assert(WS_GT + (size_t)64 * MiB <= WS_END, "gate tiles inside the old proj region");
constexpr size_t WS_TMP = WS_HB;
constexpr size_t WS_GH = WS_PROJ, WS_PP = WS_PROJ;
constexpr int CW_TMO = 0, CW_CODE = 1, CW_BAR = 4096;
constexpr int CW_SS = 65536;
static_assert((CW_SS + 3 * M) * 4 <= (int)CTL_ZERO_BYTES, "SS accumulators inside the zeroed region");

constexpr int RING_OFF = 0, RING_BYTES = 131072;
constexpr int LDSCTL_OFF = RING_BYTES, MISC_OFF = LDSCTL_OFF + 320;
constexpr int LDS_BYTES = 147456;
struct Frame {
    LAS unsigned char* lds;
    volatile LAS unsigned* MISC;
    gu32* ctl;
    int wave;
    int vcu, G;
    unsigned char* ws;
};
__device__ __forceinline__ int opaque(int v) { asm volatile("" : "+v"(v)); return v; }
#define PHASE_LOCALS() const int tid = F.wave * 64 + lane_now(), lane = tid & 63; (void)lane
__device__ __forceinline__ float shx(float v, int o, int lane) { return __int_as_float(__builtin_amdgcn_ds_bpermute((lane ^ o) << 2, __float_as_int(v))); }
__device__ __forceinline__ float wave_sum(float v, int lane) {
#pragma unroll
    for (int o = 1; o < 64; o <<= 1) v += shx(v, o, lane);
    return v;
}
__device__ __forceinline__ float wave_max(float v, int lane) {
#pragma unroll
    for (int o = 1; o < 64; o <<= 1) v = fmaxf(v, shx(v, o, lane));
    return v;
}
__device__ __forceinline__ float bf2f(bf16 u) { return __uint_as_float((unsigned)u << 16); }
__device__ __forceinline__ float bflo(unsigned w) { return __uint_as_float(w << 16); }
__device__ __forceinline__ float bfhi(unsigned w) { return __uint_as_float(w & 0xffff0000u); }
__device__ __forceinline__ float sigm(float x) { return pg8::sigm(x); }

__device__ __forceinline__ void tr_item(const float* W, int ld, int K, int N, bf16* WT, int rowstep, int row_off, LAS float* scr, int item, int lane, const float* gk = nullptr, int nrows = 32) {
    const int nblk = N / 32, kb = item / nblk, nb = item % nblk, k0 = 64 * kb, n0 = 32 * nb;
#pragma unroll 32
    for (int i = 0; i < 32; ++i) { const int kk = 2 * i + (lane >> 5); scr[kk * 33 + (lane & 31)] = W[(size_t)(k0 + kk) * ld + n0 + (lane & 31)] * (gk ? gk[k0 + kk] : 1.0f); }
    LDS_WAIT(); asm volatile("" ::: "memory");
    const int c = lane & 7;
#pragma unroll
    for (int j = 0; j < 4; ++j) { const int n = (lane >> 3) + 8 * j; const LAS float* s = scr + (8 * c) * 33 + n;
        v4u o; o.x = pk2(s[0 * 33], s[1 * 33]); o.y = pk2(s[2 * 33], s[3 * 33]); o.z = pk2(s[4 * 33], s[5 * 33]); o.w = pk2(s[6 * 33], s[7 * 33]);
        const int nn = n0 + n, drow = (nn >> 7) * rowstep + (nn & 127) + row_off;
        if (n < nrows) *(GAS v4u*)(WT + (size_t)drow * K + k0 + 8 * c) = o; }
    LDS_WAIT(); asm volatile("" ::: "memory");
}
__device__ __forceinline__ void tr_tile(const float* W, int ld, int K, int ntn, bf16* WT, int rowstep, int row_off, LAS float* scr, int tile, int wave, int lane, const float* gk, bool permqk, float f8scale = 0.f) {
    const int kb = tile / ntn, nb = tile % ntn, k0 = 64 * kb, n0 = 256 * nb;
    f32x4 v[8];
#pragma unroll
    for (int i = 0; i < 8; ++i) v[i] = *(const f32x4*)(W + (size_t)(k0 + wave + 8 * i) * ld + n0 + 4 * lane);
#pragma unroll
    for (int i = 0; i < 8; ++i) { const int k = wave + 8 * i; const float g = gk ? gk[k0 + k] : 1.0f; LAS float* d = scr + k * 257 + 4 * lane; d[0] = v[i][0] * g; d[1] = v[i][1] * g; d[2] = v[i][2] * g; d[3] = v[i][3] * g; }
    __syncthreads();
    const int tid = wave * 64 + lane, c = tid & 7;
#pragma unroll
    for (int j = 0; j < 4; ++j) { const int n = (tid >> 3) + 64 * j; const LAS float* p = scr + (8 * c) * 257 + n;
        v4u o; o.x = pk2(p[0], p[257]); o.y = pk2(p[2 * 257], p[3 * 257]); o.z = pk2(p[4 * 257], p[5 * 257]); o.w = pk2(p[6 * 257], p[7 * 257]);
        const int nn = n0 + n, drow = permqk ? (nn & ~255) + (((nn >> 5) & 1) << 7) + (((nn >> 6) & 3) << 5) + (nn & 31) + row_off : (nn >> 7) * rowstep + (nn & 127) + row_off;
        if (f8scale != 0.f) { uint2 o8; int a_ = __builtin_amdgcn_cvt_pk_fp8_f32(p[0] * f8scale, p[257] * f8scale, 0, false); a_ = __builtin_amdgcn_cvt_pk_fp8_f32(p[2 * 257] * f8scale, p[3 * 257] * f8scale, a_, true);
            int b_ = __builtin_amdgcn_cvt_pk_fp8_f32(p[4 * 257] * f8scale, p[5 * 257] * f8scale, 0, false); b_ = __builtin_amdgcn_cvt_pk_fp8_f32(p[6 * 257] * f8scale, p[7 * 257] * f8scale, b_, true);
            o8.x = (unsigned)a_; o8.y = (unsigned)b_; *(uint2*)((unsigned char*)WT + (size_t)drow * K + k0 + 8 * c) = o8; }
        else *(GAS v4u*)(WT + (size_t)drow * K + k0 + 8 * c) = o; }
    __syncthreads();
}
#define TTJOBG(W_, ld_, K_, N_, WT_, rs_, ro_, gk_) if (!found) { const int I_ = ((K_) / 64) * ((N_) / 256); if (r < I_) { jb.W = (W_); jb.ld = (ld_); jb.K = (K_); jb.N = (N_); jb.WT = (WT_); jb.rowstep = (rs_); jb.row_off = (ro_); jb.gk = (gk_); jb.nrows = 32; found = true; } else r -= I_; }
struct TrJob { const float* W; int ld, K, N; bf16* WT; int rowstep, row_off; const float* gk; int nrows; };
#define TRJOBG(W_, ld_, K_, N_, WT_, rs_, ro_, gk_, nr_) if (!found) { const int I_ = ((K_) / 64) * ((N_) / 32); if (r < I_) { jb.W = (W_); jb.ld = (ld_); jb.K = (K_); jb.N = (N_); jb.WT = (WT_); jb.rowstep = (rs_); jb.row_off = (ro_); jb.gk = (gk_); jb.nrows = (nr_); found = true; } else r -= I_; }
#define TRJOB(W_, ld_, K_, N_, WT_, rs_, ro_) TRJOBG(W_, ld_, K_, N_, WT_, rs_, ro_, nullptr, 32)

struct Inputs { const float* p[25]; };
enum { I_X = 0, I_P, I_GMIX, I_WIN, I_GQ, I_GK, I_CONVW, I_CONVB, I_BI, I_BF, I_GH, I_WOA, I_WOB, I_WOUT, I_GFFN, I_WD1, I_WD3, I_WD2, I_WR, I_WE1, I_WE3, I_WE2, I_GPLE, I_WPG, I_WPP };

constexpr int PER_LAYER_T = 16 * 4 + 16 * 10 + 16 * 8 + 2 * (8 * 4) + 2 * (16 * 4) + 4 * 4, NTILES_T = 2 * PER_LAYER_T + 2 * (16 * 11) + 44 * 4, P0_URGENT = 16 * 4 + 16 * 10 + 16 * 8;
__device__ __forceinline__ void p0_tile(Frame& F, const Inputs& in, int r_in, int lane) {
    int r = r_in; bool found = false; TrJob jb;
            jb.W = nullptr; jb.ld = 0; jb.K = 64; jb.N = 256; jb.WT = nullptr; jb.rowstep = 128; jb.row_off = 0; jb.gk = nullptr; jb.nrows = 32;
#pragma unroll
            for (int l = 0; l < 2; ++l) {
                if (!found) { const int I_ = 16 * 4; if (r < I_) { jb.W = in.p[I_WIN] + (size_t)l * D * NIN; jb.ld = NIN; jb.K = D; jb.N = 1024; jb.WT = (bf16*)(F.ws + WS_WIN) + (size_t)l * NPROJX * D; jb.rowstep = 128; jb.row_off = 0; jb.gk = in.p[I_GMIX] + l * D; jb.nrows = 33; found = true; } else r -= I_; }
                TTJOBG(in.p[I_WIN] + (size_t)l * D * NIN + 1024, NIN, D, 2560, (bf16*)(F.ws + WS_WIN) + (size_t)l * NPROJX * D, 128, 1024, in.p[I_GMIX] + l * D)
                TTJOBG(in.p[I_WIN] + (size_t)l * D * NIN + 3592, NIN, D, 2048, (bf16*)(F.ws + WS_WIN) + (size_t)l * NPROJX * D, 128, 3584, in.p[I_GMIX] + l * D)
                if (!found) { const int I_ = 8 * 4; if (r < I_) { jb.W = in.p[I_WOA] + (size_t)l * 512 * D; jb.ld = D; jb.K = D; jb.N = D; jb.WT = (bf16*)(F.ws + WS_WOA) + (size_t)l * D * D; jb.rowstep = 128; jb.row_off = 0; jb.gk = nullptr; found = true; } else r -= I_; }
                if (!found) { const int I_ = 8 * 4; if (r < I_) { jb.W = in.p[I_WOB] + (size_t)l * 512 * D; jb.ld = D; jb.K = D; jb.N = D; jb.WT = (bf16*)(F.ws + WS_WOA) + (size_t)l * D * D + 512; jb.rowstep = 128; jb.row_off = 0; jb.gk = nullptr; found = true; } else r -= I_; }
                TTJOBG(in.p[I_WOUT] + (size_t)l * D * D, D, D, D, (bf16*)(F.ws + WS_WOUT) + (size_t)l * D * D, 128, 0, nullptr)
                TTJOBG(in.p[I_WPG] + (size_t)l * D * D, D, D, D, (bf16*)(F.ws + WS_WPG) + (size_t)l * D * D, 128, 0, (l == 0) ? in.p[I_GPLE] : nullptr)
                TTJOBG(in.p[I_WPP] + (size_t)l * PLE * D, D, PLE, D, (bf16*)(F.ws + WS_WPP) + (size_t)l * D * PLE, 128, 0, nullptr)
            }
            TTJOBG(in.p[I_WD1], DFF, D, DFF, (bf16*)(F.ws + WS_WD13), 256, 0, in.p[I_GFFN])
            TTJOBG(in.p[I_WD3], DFF, D, DFF, (bf16*)(F.ws + WS_WD13), 256, 128, in.p[I_GFFN])
            TTJOBG(in.p[I_WD2], D, DFF, D, (bf16*)(F.ws + WS_WD2), 128, 0, nullptr)
    if (found) tr_tile(jb.W, jb.ld, jb.K, jb.N / 256, jb.WT, jb.rowstep, jb.row_off, (LAS float*)(F.lds + RING_OFF), r, F.wave, lane, jb.gk, jb.nrows == 33);
}
constexpr int P_CHUNKS = 64;
__device__ __forceinline__ void p_chunk(Frame& F, const Inputs& in, int c, int tid) {
    const size_t n8 = (size_t)2 * M * PLE / 8, per = n8 / P_CHUNKS;
    for (size_t i = (size_t)c * per + tid; i < (size_t)(c + 1) * per; i += NTHR) {
        const f32x4 a = *(const f32x4*)(in.p[I_P] + i * 8), b = *(const f32x4*)(in.p[I_P] + i * 8 + 4);
        v4u o; o.x = pk2(a[0], a[1]); o.y = pk2(a[2], a[3]); o.z = pk2(b[0], b[1]); o.w = pk2(b[2], b[3]);
        *(v4u*)((bf16*)(F.ws + WS_PB) + i * 8) = o; }
}
__device__ __forceinline__ void p0_prologue(Frame& F, const Inputs& in, int parts = 7) {
    PHASE_LOCALS();
    LAS float* scr = (LAS float*)(F.lds + RING_OFF + F.wave * 16384);
    const int gw = F.vcu * NWAVES + F.wave, NGW = F.G * NWAVES;
    if (parts & 1) {
        for (int it = F.vcu; it < P0_URGENT; it += F.G) p0_tile(F, in, it, lane);
        for (int it = gw; it < 32; it += NGW) { const int l = it >> 4;
            tr_item(in.p[I_WIN] + (size_t)l * D * NIN + 3584, NIN, D, 32, (bf16*)(F.ws + WS_WIN) + (size_t)l * NPROJX * D, 128, 5632, scr, it & 15, lane, in.p[I_GMIX] + l * D, 8); }
    }
    if (parts & 2) { pg8::ssq_t* SS0 = (pg8::ssq_t*)(F.ws + WS_SS0); bf16* XB = (bf16*)(F.ws + WS_XB);
      for (int m = gw; m < M; m += NGW) { const f32x4* xr = (const f32x4*)(in.p[I_X] + (size_t)m * D) + lane; unsigned long long* o8 = (unsigned long long*)(XB + (size_t)m * D) + lane; float ss = 0.f;
#pragma unroll
          for (int j = 0; j < 4; ++j) { const f32x4 v = xr[64 * j]; ss += (v[0] * v[0] + v[1] * v[1]) + (v[2] * v[2] + v[3] * v[3]); o8[64 * j] = (unsigned long long)pk2(v[0], v[1]) | ((unsigned long long)pk2(v[2], v[3]) << 32); }
          ss = wave_sum(ss, lane); if (lane == 0) SS0[m] = pg8::ss_fix(ss); } }
}
__device__ __forceinline__ void p_conv_expert(Frame& F, const Inputs& in, int e) {
    PHASE_LOCALS();
    LAS float* scr = (LAS float*)(F.lds + RING_OFF + F.wave * 16384);
    const int gw = F.vcu * NWAVES + F.wave, NGW = F.G * NWAVES;
    constexpr int NITEMS = 2 * (16 * 112) + 56 * 32;
    bf16* W13 = (bf16*)(F.ws + WS_WE); bf16* W2 = W13 + (size_t)2 * DFFE * D;
    for (int it = gw; it < NITEMS; it += NGW) {
        int r = it; bool found = false; TrJob jb;
        jb.W = nullptr; jb.ld = 0; jb.K = 64; jb.N = 32; jb.WT = nullptr; jb.rowstep = 128; jb.row_off = 0; jb.gk = nullptr; jb.nrows = 32;
        TRJOB(in.p[I_WE1] + (size_t)e * D * DFFE, DFFE, D, DFFE, W13, 256, 0)
        TRJOB(in.p[I_WE3] + (size_t)e * D * DFFE, DFFE, D, DFFE, W13, 256, 128)
        TRJOB(in.p[I_WE2] + (size_t)e * DFFE * D, D, DFFE, D, W2, 128, 0)
        if (found) tr_item(jb.W, jb.ld, jb.K, jb.N, jb.WT, jb.rowstep, jb.row_off, scr, r, lane, jb.gk, jb.nrows);
    }
}

template <int MODE>
__device__ __forceinline__ void phase_norm(Frame& F, const float* xsrc, const float* g, bf16* hb, const float* wx, int ldw, const float* b_i, const float* b_f, float* ifpre, float* gsel) {
    PHASE_LOCALS();
    LAS float* wl = (LAS float*)F.lds;
    if (MODE == 1 || MODE == 2) {
        for (int i = tid; i < 1024 * 2; i += NTHR) { const int c = i >> 1, hlf = i & 1; *(LAS f32x4*)(wl + c * 8 + 4 * hlf) = *(const f32x4*)(wx + (size_t)c * ldw + 4 * hlf); }
        __syncthreads();
    }
    const int gw = F.vcu * NWAVES + F.wave, NGW = F.G * NWAVES;
    f32x4 gv[4];
#pragma unroll
    for (int j = 0; j < 4; ++j) gv[j] = ((const f32x4*)g)[lane + 64 * j];
    f32x4 vn[4]; uint2 yan[4], ybn[4]; float2 tgn = make_float2(0.f, 0.f), tgc = tgn; int2 tdn = make_int2(0, 0);
#pragma unroll
    for (int j = 0; j < 4; ++j) { vn[j] = (f32x4){0.f, 0.f, 0.f, 0.f}; yan[j] = make_uint2(0u, 0u); ybn[j] = make_uint2(0u, 0u); }
    if (gw < M) {
        if (MODE == 3) { tgc = *(const float2*)((const float*)(F.ws + WS_TOPG) + (size_t)gw * 2); const int2 td0 = *(const int2*)((const int*)(F.ws + WS_DEST) + (size_t)gw * 2);
            const bf16* y1 = (const bf16*)(F.ws + WS_Y) + (size_t)td0.x * D; const bf16* y2 = (const bf16*)(F.ws + WS_Y) + (size_t)td0.y * D;
#pragma unroll
            for (int j = 0; j < 4; ++j) { yan[j] = *(const uint2*)(y1 + 4 * lane + 256 * j); ybn[j] = *(const uint2*)(y2 + 4 * lane + 256 * j); }
            if (gw + NGW < M) { tgn = *(const float2*)((const float*)(F.ws + WS_TOPG) + (size_t)(gw + NGW) * 2); tdn = *(const int2*)((const int*)(F.ws + WS_DEST) + (size_t)(gw + NGW) * 2); } }
#pragma unroll
        for (int j = 0; j < 4; ++j) vn[j] = ((const f32x4*)(xsrc + (size_t)gw * D) + lane)[64 * j];
    }
    for (int m = gw; m < M; m += NGW) {
        f32x4 v[4]; uint2 ya[4], yb[4]; float s = 0.f; const float2 tg = tgc;
#pragma unroll
        for (int j = 0; j < 4; ++j) { v[j] = vn[j]; ya[j] = yan[j]; yb[j] = ybn[j]; }
        if (m + NGW < M) {
            const int mn = m + NGW;
            if (MODE == 3) { tgc = tgn; const bf16* y1 = (const bf16*)(F.ws + WS_Y) + (size_t)tdn.x * D; const bf16* y2 = (const bf16*)(F.ws + WS_Y) + (size_t)tdn.y * D;
#pragma unroll
                for (int j = 0; j < 4; ++j) { yan[j] = *(const uint2*)(y1 + 4 * lane + 256 * j); ybn[j] = *(const uint2*)(y2 + 4 * lane + 256 * j); }
                if (mn + NGW < M) { tgn = *(const float2*)((const float*)(F.ws + WS_TOPG) + (size_t)(mn + NGW) * 2); tdn = *(const int2*)((const int*)(F.ws + WS_DEST) + (size_t)(mn + NGW) * 2); } }
#pragma unroll
            for (int j = 0; j < 4; ++j) vn[j] = ((const f32x4*)(xsrc + (size_t)mn * D) + lane)[64 * j];
        }
        if (MODE == 3) {
#pragma unroll
            for (int j = 0; j < 4; ++j) { const uint2 a = ya[j], b = yb[j];
                v[j][0] += tg.x * bflo(a.x) + tg.y * bflo(b.x); v[j][1] += tg.x * bfhi(a.x) + tg.y * bfhi(b.x); v[j][2] += tg.x * bflo(a.y) + tg.y * bflo(b.y); v[j][3] += tg.x * bfhi(a.y) + tg.y * bfhi(b.y);
                ((f32x4*)(const_cast<float*>(xsrc) + (size_t)m * D))[lane + 64 * j] = v[j]; }
        }
#pragma unroll
        for (int j = 0; j < 4; ++j) s += (v[j][0] * v[j][0] + v[j][1] * v[j][1]) + (v[j][2] * v[j][2] + v[j][3] * v[j][3]);
        const float rstd = 1.0f / sqrtf(wave_sum(s, lane) * (1.0f / D) + RMS_EPS);
        unsigned long long* o8 = (unsigned long long*)(hb + (size_t)m * D) + lane;
#pragma unroll
        for (int j = 0; j < 4; ++j) { v[j] = v[j] * rstd * gv[j];
            o8[64 * j] = (unsigned long long)pk2(v[j][0], v[j][1]) | ((unsigned long long)pk2(v[j][2], v[j][3]) << 32); }
        if (MODE == 1 || MODE == 2) {
            float a[8];
#pragma unroll
            for (int k = 0; k < 8; ++k) a[k] = 0.f;
#pragma unroll
            for (int j = 0; j < 4; ++j)
#pragma unroll
                for (int q = 0; q < 4; ++q) { const int c = 4 * lane + 256 * j + q; const f32x4 w0 = *(const LAS f32x4*)(wl + c * 8), w1 = *(const LAS f32x4*)(wl + c * 8 + 4); const float y = v[j][q];
                    a[0] += y * w0[0]; a[1] += y * w0[1]; a[2] += y * w0[2]; a[3] += y * w0[3]; a[4] += y * w1[0]; a[5] += y * w1[1]; a[6] += y * w1[2]; a[7] += y * w1[3]; }
#pragma unroll
            for (int k = 0; k < 8; ++k) a[k] = wave_sum(a[k], lane);
            if (MODE == 1) {
                if (lane == 0) {
                    f32x4 o0 = {a[0] + b_i[0], a[1] + b_i[1], a[2] + b_i[2], a[3] + b_i[3]}, o1 = {a[4] + b_f[0], a[5] + b_f[1], a[6] + b_f[2], a[7] + b_f[3]};
                    *(f32x4*)(ifpre + (size_t)m * 8) = o0; *(f32x4*)(ifpre + (size_t)m * 8 + 4) = o1; }
            } else {
                int i1 = 0; float v1 = a[0];
#pragma unroll
                for (int k = 1; k < 8; ++k) if (a[k] > v1) { v1 = a[k]; i1 = k; }
                int i2 = -1; float v2 = -INFINITY;
#pragma unroll
                for (int k = 0; k < 8; ++k) if (k != i1 && a[k] > v2) { v2 = a[k]; i2 = k; }
                const float g1 = 1.0f / (1.0f + expf(v2 - v1)), g2 = 1.0f - g1;
                if (lane < 8) gsel[(size_t)m * 8 + lane] = (lane == i1) ? g1 : (lane == i2) ? g2 : 0.f;
                if (lane == 0) { *(int2*)((int*)(F.ws + WS_TOPI) + (size_t)m * 2) = make_int2(i1, i2); *(float2*)((float*)(F.ws + WS_TOPG) + (size_t)m * 2) = make_float2(g1, g2); }
            }
        }
    }
    if (MODE == 1 || MODE == 2) __syncthreads();
}

__device__ __forceinline__ void phase_prep(Frame& F, const Inputs& in, int l, int parts = 3) {
    PHASE_LOCALS();
    bf16* PROJ = (bf16*)(F.ws + WS_PROJ); float* kmean = (float*)(F.ws + WS_KMEAN); bf16* QKC = (bf16*)(F.ws + WS_QKC);
    const float* gq = in.p[I_GQ] + l * AHD; const float* gk = in.p[I_GK] + l * AHD;
    LAS float* kt = (LAS float*)F.lds; LAS float* part = kt + 256 * 65;
    if (parts & 1) for (int u = F.vcu; u < (M / 256) * AH; u += F.G) {
        const int pm = u >> 3, h = u & 7, row = tid >> 1, hf = tid & 1; const size_t grow = (size_t)pm * 256 + row;
#pragma unroll
        for (int which = 0; which < 2; ++which) {
            bf16* ptr = PROJ + grow * NPROJ + (which ? PC_K : PC_Q) + h * AHD + hf * 32; const float* gg = (which ? gk : gq) + hf * 32;
            bf16* optr = (parts & 4) ? (bf16*)(F.ws + WS_MIXED) + (grow & 255) * NPROJ + (which ? PC_K : PC_Q) + h * AHD + hf * 32 : ptr;
            float v[32]; float ss = 0.f;
#pragma unroll
            for (int i = 0; i < 4; ++i) { const v4u w = *(const v4u*)(ptr + 8 * i);
                v[8 * i + 0] = bflo(w.x); v[8 * i + 1] = bfhi(w.x); v[8 * i + 2] = bflo(w.y); v[8 * i + 3] = bfhi(w.y); v[8 * i + 4] = bflo(w.z); v[8 * i + 5] = bfhi(w.z); v[8 * i + 6] = bflo(w.w); v[8 * i + 7] = bfhi(w.w); }
#pragma unroll
            for (int i = 0; i < 32; ++i) ss += v[i] * v[i];
            ss += shx(ss, 1, lane);
            const float r = (1.0f / sqrtf(ss * (1.0f / AHD) + RMS_EPS)) * (which ? 1.0f : C2);
#pragma unroll
            for (int i = 0; i < 32; ++i) v[i] = v[i] * r * gg[i];
            if (which) {
#pragma unroll
                for (int i = 0; i < 32; ++i) kt[row * 65 + hf * 32 + i] = v[i]; }
#pragma unroll
            for (int i = 0; i < 4; ++i) { v4u o; o.x = pk2(v[8 * i], v[8 * i + 1]); o.y = pk2(v[8 * i + 2], v[8 * i + 3]); o.z = pk2(v[8 * i + 4], v[8 * i + 5]); o.w = pk2(v[8 * i + 6], v[8 * i + 7]); *(v4u*)(optr + 8 * i) = o; }
        }
        __syncthreads();
        { const int c = tid & 63, pt = tid >> 6; float s = 0.f;
            for (int i = 0; i < 32; ++i) s += kt[(pt * 32 + i) * 65 + c];
            part[pt * 64 + c] = s; }
        __syncthreads();
        if (tid < 64) { float tot = 0.f;
#pragma unroll
            for (int pt = 0; pt < 8; ++pt) tot += part[pt * 64 + tid];
            const int b = pm >> 4, n = pm & 15;
            ((parts & 4) ? (float*)(F.ws + WS_MIXED) + 4 * 1024 * 1024 : kmean)[(((size_t)(b * AH + h)) * ANB + n) * AHD + tid] = tot * (1.0f / ABLK); }
        __syncthreads();
    }
    if (parts & 2) {
        const float* cw = in.p[I_CONVW] + (size_t)l * 4 * 1024; const float* cb = in.p[I_CONVB] + (size_t)l * 1024;
        const int ch = tid & 127, c0 = ch * 8; const float sc = (c0 >= 512) ? 0.08838834764831845f : 1.0f;
        float w[4][8], bia[8];
#pragma unroll
        for (int j = 0; j < 4; ++j) { const f32x4 w0 = *(const f32x4*)(cw + j * 1024 + c0), w1 = *(const f32x4*)(cw + j * 1024 + c0 + 4);
            w[j][0] = w0[0]; w[j][1] = w0[1]; w[j][2] = w0[2]; w[j][3] = w0[3]; w[j][4] = w1[0]; w[j][5] = w1[1]; w[j][6] = w1[2]; w[j][7] = w1[3]; }
        { const f32x4 b0 = *(const f32x4*)(cb + c0), b1 = *(const f32x4*)(cb + c0 + 4); bia[0] = b0[0]; bia[1] = b0[1]; bia[2] = b0[2]; bia[3] = b0[3]; bia[4] = b1[0]; bia[5] = b1[1]; bia[6] = b1[2]; bia[7] = b1[3]; }
        for (int run = F.vcu * 4 + (tid >> 7); run < M / 16; run += F.G * 4) {
            const int r0 = run * 16, t0 = r0 & (SEQ - 1);
            v4u xin[19];
#pragma unroll
            for (int i = 0; i < 19; ++i) { xin[i] = (v4u){0u, 0u, 0u, 0u}; if (i >= 3 || t0 > 0) xin[i] = *(const v4u*)(PROJ + (size_t)(r0 - 3 + i) * NPROJ + PC_QKM + c0); }
#pragma unroll
            for (int i = 0; i < 16; ++i) { float a[8];
#pragma unroll
                for (int k = 0; k < 8; ++k) a[k] = bia[k];
#pragma unroll
                for (int j = 0; j < 4; ++j) { const v4u x = xin[i + j];
                    a[0] += w[j][0] * bflo(x.x); a[1] += w[j][1] * bfhi(x.x); a[2] += w[j][2] * bflo(x.y); a[3] += w[j][3] * bfhi(x.y); a[4] += w[j][4] * bflo(x.z); a[5] += w[j][5] * bfhi(x.z); a[6] += w[j][6] * bflo(x.w); a[7] += w[j][7] * bfhi(x.w); }
#pragma unroll
                for (int k = 0; k < 8; ++k) a[k] = a[k] * sigm(a[k]) * sc;
                v4u o; o.x = pk2(a[0], a[1]); o.y = pk2(a[2], a[3]); o.z = pk2(a[4], a[5]); o.w = pk2(a[6], a[7]);
                *(v4u*)(QKC + (size_t)(r0 + i) * 1024 + c0) = o; }
        }
    }
}

__device__ __forceinline__ float dot64(const bf16* kr, const float (&q)[64]) {
    float a = 0.f;
#pragma unroll
    for (int i = 0; i < 8; ++i) { const v4u w = *(const v4u*)(kr + 8 * i);
        a += q[8 * i] * bflo(w.x) + q[8 * i + 1] * bfhi(w.x) + q[8 * i + 2] * bflo(w.y) + q[8 * i + 3] * bfhi(w.y) + q[8 * i + 4] * bflo(w.z) + q[8 * i + 5] * bfhi(w.z) + q[8 * i + 6] * bflo(w.w) + q[8 * i + 7] * bfhi(w.w); }
    return a;
}
__device__ __forceinline__ void phase_attn_naive(Frame& F) {
    const bf16* PROJ = (const bf16*)(F.ws + WS_PROJ); const float* kmean = (const float*)(F.ws + WS_KMEAN); bf16* YA = (bf16*)(F.ws + WS_YA);
    LAS float* sc = (LAS float*)F.lds + F.wave * 1088; LAS float* qs = sc + 1024;
    const int gw = F.vcu * NWAVES + F.wave, NGW = F.G * NWAVES, lane = lane_now();
    for (int item = gw; item < BATCH * AH * SEQ; item += NGW) {
        const int q = item & (SEQ - 1), bh = item >> 12, b = bh >> 3, h = bh & 7, blk = q >> 8;
        const size_t rb = (size_t)b * SEQ;
        qs[lane] = bf2f(PROJ[(rb + q) * NPROJ + PC_Q + h * AHD + lane]);
        asm volatile("s_waitcnt lgkmcnt(0)" ::: "memory");
        float qr[64];
#pragma unroll
        for (int i = 0; i < 16; ++i) { const f32x4 t = *(const LAS f32x4*)(qs + 4 * i); qr[4 * i] = t[0]; qr[4 * i + 1] = t[1]; qr[4 * i + 2] = t[2]; qr[4 * i + 3] = t[3]; }
        float gv = -INFINITY;
        if (lane < blk) { const float* km = kmean + ((size_t)bh * ANB + lane) * AHD; float a = 0.f;
#pragma unroll
            for (int i = 0; i < 16; ++i) { const f32x4 t = *(const f32x4*)(km + 4 * i); a += qr[4 * i] * t[0] + qr[4 * i + 1] * t[1] + qr[4 * i + 2] * t[2] + qr[4 * i + 3] * t[3]; }
            gv = a; }
        unsigned selmask = 0u;
        for (int s = 0; s < 3 && s < blk; ++s) { const float mx = wave_max(gv, lane); const unsigned long long bal = __ballot(gv == mx && lane < blk); const int idx = __ffsll((long long)bal) - 1;
            selmask |= 1u << idx; if (lane == idx) gv = -INFINITY; }
        int slot = 0;
        for (int n = 0; n < blk; ++n) if ((selmask >> n) & 1u) {
#pragma unroll
            for (int jj = 0; jj < 4; ++jj) { const int key = n * ABLK + lane + 64 * jj; sc[slot * 256 + lane + 64 * jj] = dot64(PROJ + (rb + key) * NPROJ + PC_K + h * AHD, qr); }
            ++slot; }
#pragma unroll
        for (int jj = 0; jj < 4; ++jj) { const int key = blk * ABLK + lane + 64 * jj; const float a = dot64(PROJ + (rb + key) * NPROJ + PC_K + h * AHD, qr); sc[slot * 256 + lane + 64 * jj] = (key > q) ? -INFINITY : a; }
        const int ntot = (slot + 1) * 256;
        asm volatile("s_waitcnt lgkmcnt(0)" ::: "memory");
        float mx = -INFINITY; for (int i = lane; i < ntot; i += 64) mx = fmaxf(mx, sc[i]); mx = wave_max(mx, lane);
        float sum = 0.f; for (int i = lane; i < ntot; i += 64) { const float p = pg8::ex2(sc[i] - mx); sc[i] = p; sum += p; } sum = wave_sum(sum, lane);
        asm volatile("s_waitcnt lgkmcnt(0)" ::: "memory");
        float o = 0.f; slot = 0;
        for (int n = 0; n < blk; ++n) if ((selmask >> n) & 1u) { const bf16* vp = PROJ + (rb + n * ABLK) * NPROJ + PC_V + h * AHD + lane;
            for (int j = 0; j < 256; ++j) o += sc[slot * 256 + j] * bf2f(vp[(size_t)j * NPROJ]);
            ++slot; }
        { const bf16* vp = PROJ + (rb + blk * ABLK) * NPROJ + PC_V + h * AHD + lane; const int je = q - blk * ABLK;
            for (int j = 0; j <= je; ++j) o += sc[slot * 256 + j] * bf2f(vp[(size_t)j * NPROJ]); }
        YA[(rb + q) * 1024 + h * AHD + lane] = (bf16)f2bf(o / sum);
        asm volatile("s_waitcnt lgkmcnt(0)" ::: "memory");
    }
}

__device__ __forceinline__ void phase_mlstm_naive(Frame& F, const Inputs& in, int l) {
    if (blockIdx.x >= BATCH * MH) return;
    const bf16* PROJ = (const bf16*)(F.ws + WS_PROJ); const bf16* QKC = (const bf16*)(F.ws + WS_QKC); const float* ifpre = (const float*)(F.ws + WS_IFPRE); bf16* YB = (bf16*)(F.ws + WS_YB);
    const float* gh = in.p[I_GH] + l * MDK;
    const int bh = blockIdx.x, b = bh >> 2, h = bh & 3, tid = F.wave * 64 + lane_now(), lane = tid & 63, e = tid & 127, g = tid >> 7;
    LAS float* qs = (LAS float*)F.lds; LAS float* ks = qs + 16 * 128; LAS float* vs = ks + 16 * 128; LAS float* red = vs + 16 * 128; LAS float* redd = red + 16 * 4 * 128;
    LAS float* gi = redd + 64; LAS float* gf = gi + 16; LAS float* ms = gf + 16;
    float C[32], nn[32];
#pragma unroll
    for (int i = 0; i < 32; ++i) { C[i] = 0.f; nn[i] = 0.f; }
    float m = 0.f;
    for (int t0 = 0; t0 < SEQ; t0 += 16) {
        for (int i = tid; i < 16 * 128; i += NTHR) { const int st = i >> 7, d = i & 127; const size_t r = (size_t)b * SEQ + t0 + st;
            qs[i] = bf2f(QKC[r * 1024 + h * MDK + d]); ks[i] = bf2f(QKC[r * 1024 + 512 + h * MDK + d]); vs[i] = bf2f(PROJ[r * NPROJ + PC_VM + h * MDK + d]); }
        if (tid < 16) { const size_t r = (size_t)b * SEQ + t0 + tid; gi[tid] = ifpre[r * 8 + h]; const float x = ifpre[r * 8 + 4 + h]; gf[tid] = fminf(x, 0.f) - log1pf(expf(-fabsf(x))); }
        __syncthreads();
        for (int st = 0; st < 16; ++st) {
            const float li = gi[st], lf = gf[st], mn = fmaxf(lf + m, li), wC = expf(lf + m - mn), wS = expf(li - mn); m = mn;
            const float ve = vs[st * 128 + e]; float pn = 0.f, pd = 0.f;
#pragma unroll
            for (int i4 = 0; i4 < 8; ++i4) { const f32x4 k4 = *(const LAS f32x4*)(ks + st * 128 + 32 * g + 4 * i4), q4 = *(const LAS f32x4*)(qs + st * 128 + 32 * g + 4 * i4);
#pragma unroll
                for (int j = 0; j < 4; ++j) { const int i = 4 * i4 + j; const float kd = wS * k4[j]; C[i] = wC * C[i] + kd * ve; nn[i] = wC * nn[i] + kd; pn += q4[j] * C[i]; pd += q4[j] * nn[i]; } }
            red[(st * 4 + g) * 128 + e] = pn; if (e == 0) redd[st * 4 + g] = pd; if (tid == 0) ms[st] = mn;
        }
        __syncthreads();
#pragma unroll
        for (int s2 = 0; s2 < 2; ++s2) { const int st = 2 * F.wave + s2; const float den = (redd[st * 4] + redd[st * 4 + 1]) + (redd[st * 4 + 2] + redd[st * 4 + 3]);
            const float dn = 1.0f / fmaxf(fabsf(den), expf(-ms[st]));
            const float h0 = ((red[(st * 4) * 128 + lane] + red[(st * 4 + 1) * 128 + lane]) + (red[(st * 4 + 2) * 128 + lane] + red[(st * 4 + 3) * 128 + lane])) * dn;
            const float h1 = ((red[(st * 4) * 128 + 64 + lane] + red[(st * 4 + 1) * 128 + 64 + lane]) + (red[(st * 4 + 2) * 128 + 64 + lane] + red[(st * 4 + 3) * 128 + 64 + lane])) * dn;
            const float rr = 1.0f / sqrtf(wave_sum(h0 * h0 + h1 * h1, lane) * (1.0f / MDK) + RMS_EPS);
            const size_t r = (size_t)b * SEQ + t0 + st;
            const float o0 = sigm(bf2f(PROJ[r * NPROJ + PC_OM + h * MDK + lane])), o1 = sigm(bf2f(PROJ[r * NPROJ + PC_OM + h * MDK + 64 + lane]));
            YB[r * 1024 + h * MDK + lane] = (bf16)f2bf(h0 * rr * gh[lane] * o0); YB[r * 1024 + h * MDK + 64 + lane] = (bf16)f2bf(h1 * rr * gh[64 + lane] * o1); }
        __syncthreads();
    }
}
typedef short bf16x8s __attribute__((ext_vector_type(8)));
typedef short s16x4 __attribute__((ext_vector_type(4)));
typedef float f32x16 __attribute__((ext_vector_type(16)));
constexpr size_t ST_DCT = WS_ST, ST_DN = WS_ST + 16 * MiB, ST_NIN = ST_DN + 128 * 1024, ST_MLOC = ST_NIN + 128 * 1024, ST_BL = ST_MLOC + 4096, ST_MIN = ST_BL + 4096;
constexpr size_t ST_CINT = WS_MIXED;
constexpr int SM_OFF = LDSCTL_OFF + 1024;
__device__ __forceinline__ unsigned off_b(unsigned row, unsigned ch) { return 256u * row + 16u * (ch ^ (((row & 3u) << 2) | ((row >> 2) & 3u))); }
__device__ __forceinline__ s16x4 vtr(const LAS unsigned char* p) { return __builtin_bit_cast(s16x4, __builtin_amdgcn_ds_read_tr16_b64_v4i16((LAS s16x4*)p)); }
__device__ __forceinline__ int crow(int r, int hi) { return (r & 3) + 8 * (r >> 2) + 4 * hi; }
__device__ __forceinline__ float shu(float v, int o, int lane) { return __int_as_float(__builtin_amdgcn_ds_bpermute((lane - o) << 2, __float_as_int(v))); }
__device__ __forceinline__ float shl(float v, int src) { return __int_as_float(__builtin_amdgcn_ds_bpermute(src << 2, __float_as_int(v))); }
__device__ __forceinline__ float logsig(float x) { return fminf(x, 0.f) - log1pf(expf(-fabsf(x))); }
__device__ __forceinline__ bf16x8s tr_frag(const LAS unsigned char* img, int lane, int row0, int c) {
    const unsigned h = lane >> 5, blk = (lane >> 4) & 1, q = (lane & 15) >> 2, p = lane & 3;
    const s16x4 lo = vtr(img + off_b(row0 + 8 * h + q, 4 * c + 2 * blk + (p >> 1)) + 8 * (p & 1)), hi = vtr(img + off_b(row0 + 8 * h + 4 + q, 4 * c + 2 * blk + (p >> 1)) + 8 * (p & 1));
    return (bf16x8s){lo[0], lo[1], lo[2], lo[3], hi[0], hi[1], hi[2], hi[3]};
}
__device__ __forceinline__ bf16x8s tr_frag_perm(const LAS unsigned char* img, int lane, int row0, int c) {
    const unsigned h = lane >> 5, blk = (lane >> 4) & 1, q = (lane & 15) >> 2, p = lane & 3;
    const s16x4 lo = vtr(img + off_b(row0 + 4 * h + q, 4 * c + 2 * blk + (p >> 1)) + 8 * (p & 1)), hi = vtr(img + off_b(row0 + 8 + 4 * h + q, 4 * c + 2 * blk + (p >> 1)) + 8 * (p & 1));
    return (bf16x8s){lo[0], lo[1], lo[2], lo[3], hi[0], hi[1], hi[2], hi[3]};
}
__device__ __forceinline__ void chunk_gates(const float* ifpre, size_t row0, int h, int lane, float (&bc)[4], float (&ii)[4], float& bL) {
#pragma unroll
    for (int k = 0; k < 4; ++k) { const size_t r = row0 + 4 * lane + k; ii[k] = ifpre[r * 8 + h]; bc[k] = logsig(ifpre[r * 8 + 4 + h]); }
    bc[1] += bc[0]; bc[2] += bc[1]; bc[3] += bc[2];
    float inc = bc[3];
#pragma unroll
    for (int o = 1; o < 64; o <<= 1) { const float t = shu(inc, o, lane); if (lane >= o) inc += t; }
    const float excl = inc - bc[3];
#pragma unroll
    for (int k = 0; k < 4; ++k) bc[k] += excl;
    bL = shl(inc, 63);
}

__device__ __forceinline__ void phase_mlstm_m1(Frame& F, const Inputs& in, int l) {
    PHASE_LOCALS();
    const bf16* PROJ = (const bf16*)(F.ws + WS_PROJ); bf16* QKC = (bf16*)(F.ws + WS_QKC); const float* ifpre = (const float*)(F.ws + WS_IFPRE);
    float* dCT = (float*)(F.ws + ST_DCT); float* DN = (float*)(F.ws + ST_DN); float* MLOC = (float*)(F.ws + ST_MLOC); float* BL = (float*)(F.ws + ST_BL);
    LAS unsigned char* Kimg = F.lds; LAS unsigned char* Vimg = F.lds + 65536; LAS float* sw = (LAS float*)(F.lds + SM_OFF);
    const int r32 = lane & 31, hi = lane >> 5;
    for (int unit = F.vcu; unit < BATCH * MH * 16; unit += F.G) {
        const int bh = unit >> 4, c = unit & 15, b = bh >> 2, h = bh & 3; const size_t row0 = (size_t)b * SEQ + c * 256;
        { const float* cw = in.p[I_CONVW] + (size_t)l * 4 * 1024; const float* cb = in.p[I_CONVB] + (size_t)l * 1024;
          const int cc = tid & 31, c0 = (cc < 16 ? 0 : 512) + h * MDK + 8 * (cc & 15), run = tid >> 5; const float sc = (cc >= 16) ? 0.08838834764831845f : 1.0f;
          float w[4][8], bia[8];
#pragma unroll
          for (int j = 0; j < 4; ++j) { const f32x4 w0 = *(const f32x4*)(cw + j * 1024 + c0), w1 = *(const f32x4*)(cw + j * 1024 + c0 + 4);
              w[j][0] = w0[0]; w[j][1] = w0[1]; w[j][2] = w0[2]; w[j][3] = w0[3]; w[j][4] = w1[0]; w[j][5] = w1[1]; w[j][6] = w1[2]; w[j][7] = w1[3]; }
          { const f32x4 b0 = *(const f32x4*)(cb + c0), b1 = *(const f32x4*)(cb + c0 + 4); bia[0] = b0[0]; bia[1] = b0[1]; bia[2] = b0[2]; bia[3] = b0[3]; bia[4] = b1[0]; bia[5] = b1[1]; bia[6] = b1[2]; bia[7] = b1[3]; }
          const size_t r0 = row0 + 16 * run; const bool first = (c == 0 && run == 0);
          v4u xin[19];
#pragma unroll
          for (int i = 0; i < 19; ++i) { xin[i] = (v4u){0u, 0u, 0u, 0u}; if (i >= 3 || !first) xin[i] = *(const v4u*)(PROJ + (r0 - 3 + i) * NPROJ + PC_QKM + c0); }
#pragma unroll
          for (int i = 0; i < 16; ++i) { float a[8];
#pragma unroll
              for (int k = 0; k < 8; ++k) a[k] = bia[k];
#pragma unroll
              for (int j = 0; j < 4; ++j) { const v4u x = xin[i + j];
                  a[0] += w[j][0] * bflo(x.x); a[1] += w[j][1] * bfhi(x.x); a[2] += w[j][2] * bflo(x.y); a[3] += w[j][3] * bfhi(x.y); a[4] += w[j][4] * bflo(x.z); a[5] += w[j][5] * bfhi(x.z); a[6] += w[j][6] * bflo(x.w); a[7] += w[j][7] * bfhi(x.w); }
#pragma unroll
              for (int k = 0; k < 8; ++k) a[k] = a[k] * sigm(a[k]) * sc;
              v4u o; o.x = pk2(a[0], a[1]); o.y = pk2(a[2], a[3]); o.z = pk2(a[4], a[5]); o.w = pk2(a[6], a[7]);
              *(v4u*)(QKC + (r0 + i) * 1024 + c0) = o; } }
        if (F.wave == 0) {
            float bc[4], ii[4], bL; chunk_gates(ifpre, row0, h, lane, bc, ii, bL);
            float g[4]; float mx = -INFINITY;
#pragma unroll
            for (int k = 0; k < 4; ++k) { g[k] = bL - bc[k] + ii[k]; mx = fmaxf(mx, g[k]); }
            mx = wave_max(mx, lane);
#pragma unroll
            for (int k = 0; k < 4; ++k) sw[4 * lane + k] = pg8::ex2((g[k] - mx) * 1.4426950408889634f);
            if (lane == 0) { MLOC[unit] = mx; BL[unit] = bL; }
        }
        asm volatile("s_waitcnt vmcnt(0)" ::: "memory");
        __syncthreads();
        for (int i = tid; i < 4096; i += NTHR) { const int s = i >> 4, ch = i & 15; const float w = sw[s];
            const v4u kv = *(const v4u*)(QKC + (row0 + s) * 1024 + 512 + h * MDK + 8 * ch);
            v4u ko; ko.x = pk2(bflo(kv.x) * w, bfhi(kv.x) * w); ko.y = pk2(bflo(kv.y) * w, bfhi(kv.y) * w); ko.z = pk2(bflo(kv.z) * w, bfhi(kv.z) * w); ko.w = pk2(bflo(kv.w) * w, bfhi(kv.w) * w);
            *(LAS v4u*)(Kimg + off_b(s, ch)) = ko;
            *(LAS v4u*)(Vimg + off_b(s, ch)) = *(const v4u*)(PROJ + (row0 + s) * NPROJ + PC_VM + h * MDK + 8 * ch); }
        __syncthreads();
        const int dt = F.wave >> 1, c0 = 2 * (F.wave & 1);
        f32x16 acc0, acc1;
#pragma unroll
        for (int i = 0; i < 16; ++i) { acc0[i] = 0.f; acc1[i] = 0.f; }
#pragma unroll 4
        for (int ks = 0; ks < 16; ++ks) {
            const bf16x8s a = tr_frag(Kimg, lane, 16 * ks, dt), b0 = tr_frag(Vimg, lane, 16 * ks, c0), b1 = tr_frag(Vimg, lane, 16 * ks, c0 + 1);
            acc0 = __builtin_amdgcn_mfma_f32_32x32x16_bf16(a, b0, acc0, 0, 0, 0);
            acc1 = __builtin_amdgcn_mfma_f32_32x32x16_bf16(a, b1, acc1, 0, 0, 0);
        }
#pragma unroll
        for (int g = 0; g < 4; ++g) { const int d = 32 * dt + 8 * g + 4 * hi;
            *(f32x4*)(dCT + ((size_t)unit * 128 + 32 * c0 + r32) * 128 + d) = (f32x4){acc0[4 * g], acc0[4 * g + 1], acc0[4 * g + 2], acc0[4 * g + 3]};
            *(f32x4*)(dCT + ((size_t)unit * 128 + 32 * (c0 + 1) + r32) * 128 + d) = (f32x4){acc1[4 * g], acc1[4 * g + 1], acc1[4 * g + 2], acc1[4 * g + 3]}; }
        { const int d = tid & 127, part = tid >> 7; float s0 = 0.f, s1 = 0.f;
#pragma unroll 8
            for (int t = 0; t < 64; t += 2) { s0 += bf2f(*(const LAS bf16*)(Kimg + off_b(64 * part + t, d >> 3) + 2 * (d & 7))); s1 += bf2f(*(const LAS bf16*)(Kimg + off_b(64 * part + t + 1, d >> 3) + 2 * (d & 7))); }
            sw[256 + tid] = s0 + s1; }
        __syncthreads();
        if (tid < 128) DN[(size_t)unit * 128 + tid] = (sw[256 + tid] + sw[256 + 128 + tid]) + (sw[256 + 256 + tid] + sw[256 + 384 + tid]);
        __syncthreads();
    }
}

__device__ __forceinline__ void phase_mlstm_m2(Frame& F) {
    PHASE_LOCALS();
    const float* dCT = (const float*)(F.ws + ST_DCT); const float* DN = (const float*)(F.ws + ST_DN); const float* MLOC = (const float*)(F.ws + ST_MLOC); const float* BL = (const float*)(F.ws + ST_BL);
    bf16* CinT = (bf16*)(F.ws + ST_CINT); float* NIN = (float*)(F.ws + ST_NIN); float* MIN = (float*)(F.ws + ST_MIN);
    LAS float* al = (LAS float*)(F.lds + SM_OFF); LAS float* be = al + 16;
    for (int item = F.vcu; item < 256; item += F.G) {
        const int bh = item >> 4, sl = item & 15;
        if (tid == 0) { float m = 0.f;
            for (int c = 0; c < 16; ++c) { const int u = bh * 16 + c; const float bl = BL[u], ml = MLOC[u]; if (sl == 0) MIN[u] = m;
                const float mo = fmaxf(bl + m, ml); al[c] = expf(bl + m - mo); be[c] = expf(ml - mo); m = mo; } }
        __syncthreads();
        { const size_t idx = (size_t)sl * 1024 + 2 * tid; float s0 = 0.f, s1 = 0.f;
#pragma unroll
            for (int c = 0; c < 16; ++c) { const size_t u = (size_t)bh * 16 + c; const float2 dc = *(const float2*)(dCT + u * 16384 + idx);
                *(unsigned*)(CinT + u * 16384 + idx) = pk2(s0, s1); s0 = al[c] * s0 + be[c] * dc.x; s1 = al[c] * s1 + be[c] * dc.y; } }
        if (sl == 0 && tid < 128) { float s = 0.f;
#pragma unroll
            for (int c = 0; c < 16; ++c) { const size_t u = (size_t)bh * 16 + c; NIN[u * 128 + tid] = s; s = al[c] * s + be[c] * DN[u * 128 + tid]; } }
        __syncthreads();
    }
}

__device__ __forceinline__ void phase_mlstm_m3(Frame& F, const Inputs& in, int l, int reps = 1) {
    PHASE_LOCALS();
    const bf16* PROJ = (const bf16*)(F.ws + WS_PROJ); const bf16* QKC = (const bf16*)(F.ws + WS_QKC); const float* ifpre = (const float*)(F.ws + WS_IFPRE);
    const float* dCT = (const float*)(F.ws + ST_DCT); const float* DN = (const float*)(F.ws + ST_DN); const float* MLOC = (const float*)(F.ws + ST_MLOC); const float* BLV = (const float*)(F.ws + ST_BL); bf16* YB = (bf16*)(F.ws + WS_YB);
    const float* gh = in.p[I_GH] + l * MDK;
    LAS unsigned char* Vimg = F.lds; LAS unsigned char* Cimg = F.lds + 65536; LAS unsigned char* Kimg = F.lds + 65536;
    LAS float* us = (LAS float*)(F.lds + SM_OFF); LAS float* Mt = us + 256; LAS float* aw = Mt + 256; LAS float* em = aw + 256; LAS float* inv = em + 256; LAS float* nin_s = inv + 256; LAS float* coef = nin_s + 128;
    const int r32 = lane & 31, hi = lane >> 5, wave = F.wave;
    for (int unit = F.vcu; unit < reps * BATCH * MH * 16; unit += F.G) {
        const int unit_ = unit; { const int unit = unit_ & (BATCH * MH * 16 - 1);
        const int bh = unit >> 4, c = unit & 15, b = bh >> 2, h = bh & 3; const size_t row0 = (size_t)b * SEQ + c * 256;
        if (tid < 32) coef[tid] = (tid < 16) ? BLV[bh * 16 + tid] : MLOC[bh * 16 + tid - 16];
        for (int i = tid; i < 4096; i += NTHR) { const int s = i >> 4, ch = i & 15;
            *(LAS v4u*)(Vimg + off_b(s, ch)) = *(const v4u*)(PROJ + (row0 + s) * NPROJ + PC_VM + h * MDK + 8 * ch); }
        __syncthreads();
        if (tid == 0) { float mm = 0.f;
            for (int cc = 0; cc < c; ++cc) { const float bl = coef[cc], ml = coef[16 + cc], mo = fmaxf(bl + mm, ml); coef[cc] = pg8::ex2((bl + mm - mo) * 1.4426950408889634f); coef[16 + cc] = pg8::ex2((ml - mo) * 1.4426950408889634f); mm = mo; }
            coef[32] = mm; }
        __syncthreads();
        { float st[32];
#pragma unroll
            for (int i = 0; i < 32; ++i) st[i] = 0.f;
            f32x4 sa[8], sb[8], sc[8];
            const float* sbase = dCT + ((size_t)(bh * 16)) * 16384 + 32 * tid;
#define M3_LD(buf, cc_) do { const int ci_ = ((cc_) < 15) ? (cc_) : 15;   \
                const f32x4* src_ = (const f32x4*)(sbase + (size_t)ci_ * 16384); _Pragma("unroll") for (int i = 0; i < 8; ++i) buf[i] = src_[i]; __builtin_amdgcn_sched_barrier(0); } while (0)
#define M3_FM(buf, cc_) do { if ((cc_) < c) { const float al = coef[(cc_)], be = coef[16 + (cc_)]; \
                _Pragma("unroll") for (int i = 0; i < 8; ++i) { const f32x4 v = buf[i]; st[4 * i] = al * st[4 * i] + be * v[0]; st[4 * i + 1] = al * st[4 * i + 1] + be * v[1]; st[4 * i + 2] = al * st[4 * i + 2] + be * v[2]; st[4 * i + 3] = al * st[4 * i + 3] + be * v[3]; } } \
                __builtin_amdgcn_sched_barrier(0); } while (0)
            if (c > 0) { M3_LD(sa, 0); M3_LD(sb, 1);
                for (int cc = 0; cc < c; cc += 3) { M3_LD(sc, cc + 2); M3_FM(sa, cc); M3_LD(sa, cc + 3); M3_FM(sb, cc + 1); M3_LD(sb, cc + 4); M3_FM(sc, cc + 2); } }
#undef M3_LD
#undef M3_FM
            LAS unsigned char* dst = Cimg + (tid >> 2) * 272 + (tid & 3) * 64;
#pragma unroll
            for (int i = 0; i < 4; ++i) { v4u o; o.x = pk2(st[8 * i], st[8 * i + 1]); o.y = pk2(st[8 * i + 2], st[8 * i + 3]); o.z = pk2(st[8 * i + 4], st[8 * i + 5]); o.w = pk2(st[8 * i + 6], st[8 * i + 7]); *(LAS v4u*)(dst + 16 * i) = o; }
            if (tid < 128) { float dnv[16];
#pragma unroll
                for (int cc = 0; cc < 16; ++cc) dnv[cc] = DN[((size_t)(bh * 16 + cc)) * 128 + tid];
                float sn = 0.f;
#pragma unroll
                for (int cc = 0; cc < 16; ++cc) if (cc < c) sn = coef[cc] * sn + coef[16 + cc] * dnv[cc];
                nin_s[tid] = sn; } }
        if (wave == 0) {
            float bc[4], ii[4], bL; chunk_gates(ifpre, row0, h, lane, bc, ii, bL);
            float u[4], pm[4];
#pragma unroll
            for (int k = 0; k < 4; ++k) u[k] = ii[k] - bc[k];
            pm[0] = u[0]; pm[1] = fmaxf(pm[0], u[1]); pm[2] = fmaxf(pm[1], u[2]); pm[3] = fmaxf(pm[2], u[3]);
            float inc = pm[3];
#pragma unroll
            for (int o = 1; o < 64; o <<= 1) { const float t = shu(inc, o, lane); if (lane >= o) inc = fmaxf(inc, t); }
            float excl = shu(inc, 1, lane); if (lane == 0) excl = -INFINITY;
            const float m_in = coef[32];
#pragma unroll
            for (int k = 0; k < 4; ++k) { const float Mx = fmaxf(m_in, fmaxf(pm[k], excl)); const int s = 4 * lane + k; us[s] = u[k]; Mt[s] = Mx; aw[s] = pg8::ex2((m_in - Mx) * 1.4426950408889634f); em[s] = pg8::ex2(-(bc[k] + Mx) * 1.4426950408889634f); }
        }
        __syncthreads();
        const int t = 32 * wave + r32;
        bf16x8s qf[8];
#pragma unroll
        for (int ks = 0; ks < 8; ++ks) qf[ks] = *(const bf16x8s*)(QKC + (row0 + t) * 1024 + h * MDK + 16 * ks + 8 * hi);
        float qn = 0.f;
#pragma unroll
        for (int ks = 0; ks < 8; ++ks)
#pragma unroll
            for (int j = 0; j < 8; ++j) qn += bf2f((bf16)qf[ks][j]) * nin_s[16 * ks + 8 * hi + j];
        qn += shx(qn, 32, lane);
        f32x16 acc[4];
#pragma unroll
        for (int cc = 0; cc < 4; ++cc)
#pragma unroll
            for (int i = 0; i < 16; ++i) acc[cc][i] = 0.f;
#pragma unroll
        for (int cc = 0; cc < 4; ++cc)
#pragma unroll
            for (int ks = 0; ks < 8; ++ks) { const bf16x8s bq = *(const LAS bf16x8s*)(Cimg + (32 * cc + r32) * 272 + 2 * (16 * ks + 8 * hi));
                acc[cc] = __builtin_amdgcn_mfma_f32_32x32x16_bf16(qf[ks], bq, acc[cc], 0, 0, 0); }
#pragma unroll
        for (int rg = 0; rg < 16; ++rg) { const float a = aw[32 * wave + crow(rg, hi)];
#pragma unroll
            for (int cc = 0; cc < 4; ++cc) acc[cc][rg] *= a; }
        { v4u kst[8];
#pragma unroll
          for (int i = 0; i < 8; ++i) { const int idx = tid + NTHR * i, s_ = idx >> 4, ch = idx & 15; kst[i] = *(const v4u*)(QKC + (row0 + s_) * 1024 + 512 + h * MDK + 8 * ch); }
          __syncthreads();
#pragma unroll
          for (int i = 0; i < 8; ++i) { const int idx = tid + NTHR * i, s_ = idx >> 4, ch = idx & 15; *(LAS v4u*)(Kimg + off_b(s_, ch)) = kst[i]; }
          __syncthreads(); }
        const float Ml = Mt[t]; float den = 0.f;
        for (int j = 0; j <= wave; ++j) {
            f32x16 X;
#pragma unroll
            for (int i = 0; i < 16; ++i) X[i] = 0.f;
#pragma unroll
            for (int ks = 0; ks < 8; ++ks) { const bf16x8s ka = *(const LAS bf16x8s*)(Kimg + off_b(32 * j + r32, 2 * ks + hi));
                X = __builtin_amdgcn_mfma_f32_32x32x16_bf16(ka, qf[ks], X, 0, 0, 0); }
#pragma unroll
            for (int rg = 0; rg < 16; ++rg) { const int s = 32 * j + crow(rg, hi); float w = pg8::ex2((us[s] - Ml) * 1.4426950408889634f); if (s > t) w = 0.f;     const float pv = X[rg] * w; X[rg] = pv; den += pv; }
            v4u p0, p1;
            p0.x = pk2(X[0], X[1]); p0.y = pk2(X[2], X[3]); p0.z = pk2(X[4], X[5]); p0.w = pk2(X[6], X[7]);
            p1.x = pk2(X[8], X[9]); p1.y = pk2(X[10], X[11]); p1.z = pk2(X[12], X[13]); p1.w = pk2(X[14], X[15]);
            const bf16x8s pa0 = __builtin_bit_cast(bf16x8s, p0), pa1 = __builtin_bit_cast(bf16x8s, p1);
#pragma unroll
            for (int cc = 0; cc < 4; ++cc) {
                acc[cc] = __builtin_amdgcn_mfma_f32_32x32x16_bf16(pa0, tr_frag_perm(Vimg, lane, 32 * j, cc), acc[cc], 0, 0, 0);
                acc[cc] = __builtin_amdgcn_mfma_f32_32x32x16_bf16(pa1, tr_frag_perm(Vimg, lane, 32 * j + 16, cc), acc[cc], 0, 0, 0); }
        }
        den += shx(den, 32, lane);
        { const float dt = aw[t] * qn + den; inv[t] = 1.0f / fmaxf(fabsf(dt), em[t]); }
        asm volatile("s_waitcnt lgkmcnt(0)" ::: "memory");
        float rr[16];
#pragma unroll
        for (int rg = 0; rg < 16; ++rg) { const float f = inv[32 * wave + crow(rg, hi)]; float sq = 0.f;
#pragma unroll
            for (int cc = 0; cc < 4; ++cc) { acc[cc][rg] *= f; sq += acc[cc][rg] * acc[cc][rg]; }
#pragma unroll
            for (int o = 1; o < 32; o <<= 1) sq += shx(sq, o, lane);
            rr[rg] = 1.0f / sqrtf(sq * (1.0f / MDK) + RMS_EPS); }
#pragma unroll
        for (int cc = 0; cc < 4; ++cc) { const int e = 32 * cc + r32; const float ge = gh[e];
#pragma unroll
            for (int rg = 0; rg < 16; ++rg) { const size_t r = row0 + 32 * wave + crow(rg, hi);
                const float o = sigm(bf2f(PROJ[r * NPROJ + PC_OM + h * MDK + e]));
                YB[r * 1024 + h * MDK + e] = (bf16)f2bf(acc[cc][rg] * rr[rg] * ge * o); } }
        __syncthreads();
        }
    }
}
#include <hip/hip_bf16.h>
namespace attn_body {
using bf16=__hip_bfloat16;
using bf16x8=__attribute__((ext_vector_type(8)))short;
using s16x4=__attribute__((ext_vector_type(4)))short;
using f32x16=__attribute__((ext_vector_type(16)))float;
using u32x4=__attribute__((ext_vector_type(4)))unsigned;
using f32x4_t=__attribute__((ext_vector_type(4)))float;
constexpr int BATCH=4,NHEAD=8,SEQ=4096,D=64,DM=3584,DMO=1024;
constexpr float NEGBIG=-200.f;
constexpr int NW=8,QBLK=32,QB=QBLK*NW,KVBLK=64,NQB=SEQ/QB;
constexpr int ATTN_PITCH=DM, ATTN_UNIT_ROWS=QB;
__device__ __forceinline__ int crow(int r,int hi){return (r&3)+8*(r>>2)+4*hi;}
#define SBAR() __builtin_amdgcn_sched_barrier(0)
__device__ __forceinline__ void cmask(f32x16&p0,f32x16&p1,int jb,int qrel,int hi){
  const float NEG=-INFINITY; int kb=64*jb+4*hi;
  #pragma unroll
  for(int r=0;r<16;++r){int kv=kb+(r&3)+8*(r>>2); if(kv>qrel)p0[r]=NEG; if(kv+32>qrel)p1[r]=NEG;}
}

constexpr int NSLOT=3, SLOTB=8192;
constexpr int LDS_K=0, LDS_V=NSLOT*SLOTB, LDS_WS=2*NSLOT*SLOTB, LDS_OST=LDS_WS+NW*64*4, LDS_KMS=LDS_OST+NW*4096  , LDS_BYTES=LDS_KMS+4096;
constexpr float C2=0.125f*1.4426950408889634f;
__device__ __forceinline__ void glds16(const void*gsrc,unsigned lds_dst){unsigned keep;
  asm volatile("s_mov_b32 %0, m0\n\ts_mov_b32 m0, %2\n\ts_nop 0\n\tglobal_load_lds_dwordx4 %1, off\n\ts_mov_b32 m0, %0":"=&s"(keep):"v"(gsrc),"s"(lds_dst):"memory");}
__device__ __forceinline__ float max3f(float a,float b,float c){float r;asm("v_max3_f32 %0, %1, %2, %3":"=v"(r):"v"(a),"v"(b),"v"(c));return r;}
__device__ __forceinline__ float max2f(float a,float b){float r;asm("v_max_f32_e32 %0, %1, %2":"=v"(r):"v"(a),"v"(b));return r;}
__device__ __forceinline__ float fadd_s(float a,float b){float r;asm("v_add_f32_e32 %0, %1, %2":"=v"(r):"v"(a),"v"(b));return r;}
__device__ __forceinline__ float fsub_s(float a,float b){float r;asm("v_sub_f32_e32 %0, %1, %2":"=v"(r):"v"(a),"v"(b));return r;}
typedef float f32x2_t __attribute__((ext_vector_type(2))); typedef __bf16 bf16x2_t __attribute__((ext_vector_type(2)));
__device__ __forceinline__ unsigned cvtpk_s(float lo,float hi){f32x2_t v={lo,hi};bf16x2_t b=__builtin_convertvector(v,bf16x2_t);return __builtin_bit_cast(unsigned,b);}
#define WAIT_BAR(N) asm volatile("s_waitcnt vmcnt(" #N ") lgkmcnt(0)\n\ts_barrier":::"memory")

__device__ __forceinline__ void qkt(f32x16&p0,f32x16&p1,const char*Kslot,const bf16x8*qr,const f32x16&negm,int r32,int hi){
  const char*kb=Kslot+hi*1024+r32*16;
  #pragma unroll
  for(int d0=0;d0<4;++d0){
    const bf16x8 b0=*reinterpret_cast<const bf16x8*>(kb+d0*2048);
    const bf16x8 b1=*reinterpret_cast<const bf16x8*>(kb+d0*2048+512);
    if(d0==0){p0=__builtin_amdgcn_mfma_f32_32x32x16_bf16(b0,qr[0],negm,0,0,0);p1=__builtin_amdgcn_mfma_f32_32x32x16_bf16(b1,qr[0],negm,0,0,0);}
    else{p0=__builtin_amdgcn_mfma_f32_32x32x16_bf16(b0,qr[d0],p0,0,0,0);p1=__builtin_amdgcn_mfma_f32_32x32x16_bf16(b1,qr[d0],p1,0,0,0);}}
}
typedef __attribute__((address_space(3))) const char* lds_cptr;
typedef short v4i16_t __attribute__((ext_vector_type(4)));
__device__ __forceinline__ void kload8(bf16x8*kf,lds_cptr kp){
  kf[0]=*(const __attribute__((address_space(3))) bf16x8*)(kp);      kf[1]=*(const __attribute__((address_space(3))) bf16x8*)(kp+512);
  kf[2]=*(const __attribute__((address_space(3))) bf16x8*)(kp+2048); kf[3]=*(const __attribute__((address_space(3))) bf16x8*)(kp+2560);
  kf[4]=*(const __attribute__((address_space(3))) bf16x8*)(kp+4096); kf[5]=*(const __attribute__((address_space(3))) bf16x8*)(kp+4608);
  kf[6]=*(const __attribute__((address_space(3))) bf16x8*)(kp+6144); kf[7]=*(const __attribute__((address_space(3))) bf16x8*)(kp+6656);
}
__device__ __forceinline__ void kload2(bf16x8*kf,lds_cptr kp,int j){ kf[2*j]=*(const __attribute__((address_space(3))) bf16x8*)(kp+j*2048); kf[2*j+1]=*(const __attribute__((address_space(3))) bf16x8*)(kp+j*2048+512); }
__device__ __forceinline__ s16x4 vtr(lds_cptr p){ return __builtin_bit_cast(s16x4,__builtin_amdgcn_ds_read_tr16_b64_v4i16((__attribute__((address_space(3))) v4i16_t*)p)); }
__device__ __forceinline__ float rowmax(const f32x16&p0,const f32x16&p1){
  float a=max3f(p0[0],p0[1],p1[0]),b=max3f(p0[2],p0[3],p1[1]);a=max3f(a,p1[2],p1[3]);
  #pragma unroll
  for(int r=4;r<16;r+=4){a=max3f(a,p0[r],p0[r+1]);b=max3f(b,p0[r+2],p0[r+3]);a=max3f(a,p1[r],p1[r+1]);b=max3f(b,p1[r+2],p1[r+3]);}
  const float m=max2f(a,b);
  auto rr=__builtin_amdgcn_permlane32_swap(__float_as_uint(m),__float_as_uint(m),false,false);
  return max2f(__uint_as_float(rr[0]),__uint_as_float(rr[1]));
}
__device__ __forceinline__ void pv(f32x16*o,int vb,bf16x8 pa0,bf16x8 pa1,bf16x8 pa2,bf16x8 pa3){
  #pragma unroll
  for(int d0=0;d0<2;++d0){s16x4 lo[4],hi[4];
    #pragma unroll
    for(int ks=0;ks<4;++ks){
      asm volatile("ds_read_b64_tr_b16 %0,%1 offset:%c2":"=&v"(lo[ks]):"v"(vb),"i"(d0*4096+ks*1024):"memory");
      asm volatile("ds_read_b64_tr_b16 %0,%1 offset:%c2":"=&v"(hi[ks]):"v"(vb),"i"(d0*4096+ks*1024+512):"memory");}
    asm volatile("s_waitcnt lgkmcnt(0)":::"memory");SBAR();
    #define PK(k) (bf16x8){lo[k][0],lo[k][1],lo[k][2],lo[k][3],hi[k][0],hi[k][1],hi[k][2],hi[k][3]}
    o[d0]=__builtin_amdgcn_mfma_f32_32x32x16_bf16(pa0,PK(0),o[d0],0,0,0);
    o[d0]=__builtin_amdgcn_mfma_f32_32x32x16_bf16(pa1,PK(1),o[d0],0,0,0);
    o[d0]=__builtin_amdgcn_mfma_f32_32x32x16_bf16(pa2,PK(2),o[d0],0,0,0);
    o[d0]=__builtin_amdgcn_mfma_f32_32x32x16_bf16(pa3,PK(3),o[d0],0,0,0);
    #undef PK
  }
}

#ifndef ATTN_STORE16
#define ATTN_STORE16(p,v) (*(u32x4*)(p)=(v))
#endif
template<int THRL> __device__ __forceinline__ void attn_unit(int b,int h,int qb,const bf16*Q,const bf16*__restrict__ K,const bf16*__restrict__ V,bf16*O,const float*__restrict__ kmean,char*shm,int wave_in){
  int tid_; asm volatile("v_mbcnt_lo_u32_b32 %0, -1, 0\n\tv_mbcnt_hi_u32_b32 %0, -1, %0":"=v"(tid_)); tid_+=64*wave_in; const int tid=tid_,lane=tid&63,r32=lane&31,hi=lane>>5; const int wid=__builtin_amdgcn_readfirstlane(tid>>6);
  const long rowbase=(long)b*SEQ; const int q0=qb*QB;
  const bf16*Qw=Q+(rowbase+q0+wid*QBLK)*DM+h*D;
  const bf16*Kh=K+rowbase*DM+h*D,*Vh=V+rowbase*DM+h*D;
  const unsigned lds0=(unsigned)(uintptr_t)shm;
  float*wsf=(float*)(shm+LDS_WS)+wid*64;
  const bf16*ksrc=Kh+(long)lane*DM+wid*8;
  const bf16*vsrc=Vh+(long)(16*(wid&3)+(lane>>2))*DM+(wid>>2)*32+(lane&3)*8;
  const unsigned kdst=lds0+LDS_K+wid*1024, vdst=lds0+LDS_V+wid*1024;
  #define DMA_K(t,slot) glds16(ksrc+(long)(t)*KVBLK*DM,(unsigned)__builtin_amdgcn_readfirstlane(kdst+(slot)))
  #define DMA_V(t,slot) glds16(vsrc+(long)(t)*KVBLK*DM,(unsigned)__builtin_amdgcn_readfirstlane(vdst+(slot)))
  const int vb0=(int)(lds0+LDS_V)+((lane>>4)&1)*32+(lane&3)*8+(4*hi+((lane&15)>>2))*64;
  const char*Kbase=shm+LDS_K; bf16x8 kf[8];
  const lds_cptr shm3=(lds_cptr)shm; const lds_cptr kp0=shm3+LDS_K+hi*1024+r32*16; const lds_cptr vp0=shm3+LDS_V+((lane>>4)&1)*32+(lane&3)*8+(4*hi+((lane&15)>>2))*64;
  const int NT=(q0+QB)/KVBLK;
  DMA_K(0,0);DMA_V(0,0);DMA_K(1,SLOTB);
  bf16x8 qr[4];
  #pragma unroll
  for(int d0=0;d0<4;++d0)qr[d0]=*reinterpret_cast<const bf16x8*>(&Qw[(long)r32*DM+d0*16+hi*8]);

  unsigned selm=0u;
  if(qb>0){
    typedef __attribute__((address_space(3))) f32x4_t lds_f4;
    if(wid<4){ const int n_=tid>>4,d4_=(tid&15)*4; const f32x4_t s_=*reinterpret_cast<const f32x4_t*>(kmean+n_*128+d4_)+*reinterpret_cast<const f32x4_t*>(kmean+n_*128+64+d4_);
      *(lds_f4*)((lds_cptr)shm+LDS_KMS+(n_*64+d4_)*4)=s_; }
    asm volatile("s_waitcnt lgkmcnt(0)\n\ts_barrier":::"memory");
    float g[16];
    #pragma unroll
    for(int n=0;n<16;++n)g[n]=-INFINITY;
    #pragma unroll
    for(int n=0;n<15;++n) if(n<qb){
      const lds_cptr km=(lds_cptr)shm+LDS_KMS+(n*64+8*hi)*4; float a=0.f;
      #pragma unroll
      for(int d0=0;d0<4;++d0){ const f32x4_t k0=*(const lds_f4*)(km+64*d0),k1=*(const lds_f4*)(km+64*d0+16);
        #pragma unroll
        for(int j=0;j<4;++j){ a+=__uint_as_float((unsigned)(unsigned short)qr[d0][j]<<16)*k0[j]; a+=__uint_as_float((unsigned)(unsigned short)qr[d0][4+j]<<16)*k1[j]; } }
      auto rr=__builtin_amdgcn_permlane32_swap(__float_as_uint(a),__float_as_uint(a),false,false); g[n]=__uint_as_float(rr[0])+__uint_as_float(rr[1]);
    }
    #pragma unroll
    for(int s=0;s<3;++s) if(s<qb){ float best=-INFINITY; int bi=0;
      #pragma unroll
      for(int n=0;n<15;++n) if(g[n]>best){best=g[n];bi=n;}
      selm|=1u<<bi;
      #pragma unroll
      for(int n=0;n<15;++n) if(n==bi)g[n]=-INFINITY; }
  }
  selm|=1u<<qb;
  float mhat=0.f,l_reg=0.f;f32x16 o[2];f32x16 negm; { float z_=0.f; asm volatile("":"+v"(z_));
    _Pragma("unroll") for(int r_=0;r_<16;++r_){o[0][r_]=z_;o[1][r_]=z_;negm[r_]=z_;} } asm volatile("":"+v"(negm));
  const int qrel=wid*QBLK+r32;
  #define NEGSET(blk) do{ const float nv_=((selm>>(blk))&1u)?-mhat:NEGBIG; _Pragma("unroll") for(int r_=0;r_<16;++r_)negm[r_]=nv_; asm volatile("":"+v"(negm)); }while(0)
  NEGSET(0);
  #define CMASK(P0,P1,t) do{int jb_=(t)-(NT-4); if(jb_>=0)cmask(P0,P1,jb_,qrel,hi); }while(0)
  bool resc=false;
  #define START(P0,P1) do{ const float rm=rowmax(P0,P1); resc=false; \
    { const float dl=rm; mhat=fadd_s(mhat,dl); \
      _Pragma("unroll") for(int r=0;r<16;++r){P0[r]=fsub_s(P0[r],dl);P1[r]=fsub_s(P1[r],dl);} \
      NEGSET(0); } \
    _Pragma("unroll") for(int r=0;r<16;++r)P0[r]=__builtin_amdgcn_exp2f(P0[r]); }while(0)
  #define RESC() do{ if(resc){ asm volatile("s_waitcnt lgkmcnt(0)":::"memory"); \
      _Pragma("unroll") for(int d_=0;d_<2;++d_) _Pragma("unroll") for(int r=0;r<16;++r)o[d_][r]*=wsf[crow(r,hi)]; } }while(0)
  f32x16 pA0,pA1,pB0,pB1;
  int sl_prev=0,sl_cur=0,sl_next=SLOTB;
  #define ROT() do{sl_prev=sl_cur;sl_cur=sl_next;sl_next=(sl_next==(NSLOT-1)*SLOTB)?0:sl_next+SLOTB;}while(0)
  DMA_K(2,2*SLOTB);
  WAIT_BAR(3);
  qkt(pA0,pA1,Kbase,qr,negm,r32,hi);asm volatile("s_nop 15\n\ts_nop 7":"+v"(pA0),"+v"(pA1));CMASK(pA0,pA1,0);
  START(pA0,pA1);
  _Pragma("unroll") for(int r=0;r<16;++r)pA1[r]=__builtin_amdgcn_exp2f(pA1[r]);
  WAIT_BAR(0);
  DMA_K(3,0);DMA_V(1,SLOTB);
  ROT();
  kload8(kf,kp0+sl_cur);
  WAIT_BAR(2);
  s16x4 vlo[8],vhi[8]; u32x4 pw0,pw1,pw2,pw3;
  #define PKW(P,B) cvtpk_s(P[B],P[B+1])
  #define PAF(k) __builtin_bit_cast(bf16x8,pw##k)
  #define VFR(i) (bf16x8){vlo[i][0],vlo[i][1],vlo[i][2],vlo[i][3],vhi[i][0],vhi[i][1],vhi[i][2],vhi[i][3]}
  #define PIN(x) asm volatile("":"+v"(x))
  #define MX3(a,b,c) __builtin_fmaxf(__builtin_fmaxf((a),(b)),(c))
  #define GAPA(MF,A0,A1,A2,A3,W0,W1,PW) do{ MF; sacc+=A0; sacc+=A1; sacc+=A2; sacc+=A3; PIN(sacc); W0; W1; PIN(PW); SBAR(); }while(0)
  #define EX(v) __builtin_amdgcn_exp2f(v)
  #define GAPB(MF,X,B) do{ MF; X[B]=EX(X[B]); X[B+1]=EX(X[B+1]); X[B+2]=EX(X[B+2]); X[B+3]=EX(X[B+3]); PIN(X); SBAR(); }while(0)
  #define VRD(i) do{ vlo[i]=vtr(vp_+(((i)>>2)*4096+((i)&3)*1024)); vhi[i]=vtr(vp_+(((i)>>2)*4096+((i)&3)*1024+512)); }while(0)
  #define KRD(G,j) do{ if(G){ kload2(kf,kp0+sl_next,j); SBAR(); } }while(0)
  #define STEP(C0,C1,P0,P1,t,GK,GV,GL) do{ SBAR(); \
    const lds_cptr vp_=vp0+sl_prev; \
    VRD(0); SBAR(); float sacc=(P0[0]+P0[1]); \
    GAPA(C0=__builtin_amdgcn_mfma_f32_32x32x16_bf16(kf[0],qr[0],negm,0,0,0), P0[2],P0[3],P0[4],P0[5],     pw0[0]=PKW(P0,0), pw0[1]=PKW(P0,2), pw0); \
    VRD(4); SBAR(); GAPA(C1=__builtin_amdgcn_mfma_f32_32x32x16_bf16(kf[1],qr[0],negm,0,0,0), P0[6],P0[7],P0[8],P0[9],     pw0[2]=PKW(P0,4), pw0[3]=PKW(P0,6), pw0); \
    VRD(1); SBAR(); GAPA(C0=__builtin_amdgcn_mfma_f32_32x32x16_bf16(kf[2],qr[1],C0,0,0,0),   P0[10],P0[11],P0[12],P0[13], pw1[0]=PKW(P0,8), pw1[1]=PKW(P0,10), pw1); \
    VRD(5); SBAR(); GAPA(C1=__builtin_amdgcn_mfma_f32_32x32x16_bf16(kf[3],qr[1],C1,0,0,0),   P0[14],P0[15],P1[0],P1[1],   pw1[2]=PKW(P0,12),pw1[3]=PKW(P0,14), pw1); \
    VRD(2); SBAR(); GAPA(C0=__builtin_amdgcn_mfma_f32_32x32x16_bf16(kf[4],qr[2],C0,0,0,0),   P1[2],P1[3],P1[4],P1[5],     pw2[0]=PKW(P1,0), pw2[1]=PKW(P1,2), pw2); \
    VRD(6); SBAR(); GAPA(C1=__builtin_amdgcn_mfma_f32_32x32x16_bf16(kf[5],qr[2],C1,0,0,0),   P1[6],P1[7],P1[8],P1[9],     pw2[2]=PKW(P1,4), pw2[3]=PKW(P1,6), pw2); \
    VRD(3); SBAR(); GAPA(C0=__builtin_amdgcn_mfma_f32_32x32x16_bf16(kf[6],qr[3],C0,0,0,0),   P1[10],P1[11],P1[12],P1[13], pw3[0]=PKW(P1,8), pw3[1]=PKW(P1,10), pw3); \
    VRD(7); SBAR(); GAPA(C1=__builtin_amdgcn_mfma_f32_32x32x16_bf16(kf[7],qr[3],C1,0,0,0),   P1[14],P1[15],0.f,0.f,       pw3[2]=PKW(P1,12),pw3[3]=PKW(P1,14), pw3); \
    l_reg+=sacc; \
    if(GK){DMA_K((t)+3,sl_cur);} if(GV){DMA_V((t)+1,sl_next);} \
    CMASK(C0,C1,t); \
    { float a=MX3(C0[0],C0[1],C1[0]),b=MX3(C0[2],C0[3],C1[1]); a=MX3(a,C1[2],C1[3]); \
      _Pragma("unroll") for(int r=4;r<16;r+=4){a=MX3(a,C0[r],C0[r+1]);b=MX3(b,C0[r+2],C0[r+3]);a=MX3(a,C1[r],C1[r+1]);b=MX3(b,C1[r+2],C1[r+3]);} \
      float rm=__builtin_fmaxf(a,b); { auto rr=__builtin_amdgcn_permlane32_swap(__float_as_uint(rm),__float_as_uint(rm),false,false); rm=__builtin_fmaxf(__uint_as_float(rr[0]),__uint_as_float(rr[1])); } \
      resc=false; \
      if(__builtin_expect(__any(rm>(float)THRL),0)){ const float dl=__builtin_fmaxf(rm,0.f); mhat+=dl; \
        _Pragma("unroll") for(int r=0;r<16;++r){C0[r]-=dl;C1[r]-=dl;} \
        NEGSET((t)>>2); \
        const float f=__builtin_amdgcn_exp2f(-dl); l_reg*=f; if(hi==0)wsf[r32]=f; resc=true; } } \
    SBAR(); \
    GAPB(o[0]=__builtin_amdgcn_mfma_f32_32x32x16_bf16(PAF(0),VFR(0),o[0],0,0,0), C0,0); \
    GAPB(o[1]=__builtin_amdgcn_mfma_f32_32x32x16_bf16(PAF(0),VFR(4),o[1],0,0,0), C0,4); \
    KRD(GL,0); GAPB(o[0]=__builtin_amdgcn_mfma_f32_32x32x16_bf16(PAF(1),VFR(1),o[0],0,0,0), C0,8); \
    KRD(GL,1); GAPB(o[1]=__builtin_amdgcn_mfma_f32_32x32x16_bf16(PAF(1),VFR(5),o[1],0,0,0), C0,12); \
    KRD(GL,2); GAPB(o[0]=__builtin_amdgcn_mfma_f32_32x32x16_bf16(PAF(2),VFR(2),o[0],0,0,0), C1,0); \
    KRD(GL,3); GAPB(o[1]=__builtin_amdgcn_mfma_f32_32x32x16_bf16(PAF(2),VFR(6),o[1],0,0,0), C1,4); \
    GAPB(o[0]=__builtin_amdgcn_mfma_f32_32x32x16_bf16(PAF(3),VFR(3),o[0],0,0,0), C1,8); \
    GAPB(o[1]=__builtin_amdgcn_mfma_f32_32x32x16_bf16(PAF(3),VFR(7),o[1],0,0,0), C1,12); \
    }while(0)
  int t=1;
  #undef CMASK
  #define CMASK(P0,P1,t) do{}while(0)
  for(;t+5<NT;t+=2){
    STEP(pB0,pB1,pA0,pA1,t,true,true,true);     WAIT_BAR(2); RESC(); ROT();
    if(((t+1)&3)==0)NEGSET((t+1)>>2);
    STEP(pA0,pA1,pB0,pB1,t+1,true,true,true);   WAIT_BAR(2); RESC(); ROT();
  }
  #undef CMASK
  #define CMASK(P0,P1,t) do{int jb_=(t)-(NT-4); if(jb_>=0)cmask(P0,P1,jb_,qrel,hi); }while(0)
  #define ENDW(tt) do{ if((tt)+3<NT){WAIT_BAR(2);} else if((tt)+2<NT){WAIT_BAR(1);} else {WAIT_BAR(0);} }while(0)
  for(;t+1<NT;t+=2){
    STEP(pB0,pB1,pA0,pA1,t,(t+3<NT),(t+1<NT),(t+1<NT));       ENDW(t);   RESC(); ROT();
    if(((t+1)&3)==0)NEGSET((t+1)>>2);
    STEP(pA0,pA1,pB0,pB1,t+1,(t+4<NT),(t+2<NT),(t+2<NT));     ENDW(t+1); RESC(); ROT();
  }
  STEP(pB0,pB1,pA0,pA1,NT-1,false,false,false); RESC();
  { float sacc=pB0[0]+pB0[1]; _Pragma("unroll") for(int r=2;r<16;++r)sacc+=pB0[r]; _Pragma("unroll") for(int r=0;r<16;++r)sacc+=pB1[r]; l_reg+=sacc;
    pw0=(u32x4){PKW(pB0,0),PKW(pB0,2),PKW(pB0,4),PKW(pB0,6)};pw1=(u32x4){PKW(pB0,8),PKW(pB0,10),PKW(pB0,12),PKW(pB0,14)};pw2=(u32x4){PKW(pB1,0),PKW(pB1,2),PKW(pB1,4),PKW(pB1,6)};pw3=(u32x4){PKW(pB1,8),PKW(pB1,10),PKW(pB1,12),PKW(pB1,14)};
    SBAR(); pv(o,vb0+sl_cur,PAF(0),PAF(1),PAF(2),PAF(3)); }
  #undef PKW
  #undef PAF
  #undef VFR
  #undef PIN
  #undef MX3
  #undef GAPA
  #undef GAPB
  #undef EX
  #undef VRD
  #undef KRD
  #undef STEP
  #undef ENDW
  {auto rr=__builtin_amdgcn_permlane32_swap(__float_as_uint(l_reg),__float_as_uint(l_reg),false,false);l_reg=__uint_as_float(rr[0])+__uint_as_float(rr[1]);}
  if(hi==0)wsf[32+r32]=l_reg;asm volatile("s_waitcnt lgkmcnt(0)":::"memory");
  float rli[16];
  #pragma unroll
  for(int r=0;r<16;++r)rli[r]=__builtin_amdgcn_rcpf(wsf[32+crow(r,hi)]);
  bf16*Ow=O+(rowbase+q0+wid*QBLK)*DMO+h*D;
  { bf16*stg=(bf16*)(shm+LDS_OST)+wid*2048;
    #pragma unroll
    for(int r=0;r<16;++r){const int orow=crow(r,hi);
      #pragma unroll
      for(int d0=0;d0<2;++d0)stg[orow*64+d0*32+r32]=__float2bfloat16(o[d0][r]*rli[r]);}
    asm volatile("s_waitcnt lgkmcnt(0)":::"memory");
    #pragma unroll
    for(int i=0;i<4;++i){const int row=i*8+(lane>>3),ch=lane&7; const u32x4 v=*(const u32x4*)(stg+row*64+ch*8); ATTN_STORE16(Ow+(long)row*DMO+ch*8,v);} }
  asm volatile("s_waitcnt lgkmcnt(0)\n\ts_barrier":::"memory");
  #undef DMA_K
  #undef DMA_V
  #undef CMASK
  #undef NEGSET
  #undef START
  #undef RESC
  #undef ROT
}
constexpr int ATTN_LDS_BYTES=LDS_BYTES;
struct AttnTensors { const bf16* Q; const bf16* K; const bf16* V; bf16* O; const float* kmean; };
struct AttnUnit { int bh; int qb; };
struct StaticOrder {
  int vcu,G;
  __device__ __forceinline__ explicit StaticOrder(int grid,int block):vcu((grid%8==0)?(block%8)*(grid/8)+block/8:block),G(grid){}
  __device__ __forceinline__ bool next(int i,AttnUnit&u)const{ const int idx=(i>>1)*G+vcu; if(idx>=BATCH*NHEAD*8)return false; const int s=idx&7; u.bh=idx>>3; u.qb=(i&1)?15-s:s; return true; }
  __device__ __forceinline__ void a_ready(const AttnUnit&)const{}
  __device__ __forceinline__ void done(const AttnUnit&)const{}
};
template<class Sched,int THRL=8> __device__ __forceinline__ void attn_phase(char*lds,const AttnTensors&T,const Sched&S,int wave_in){
  AttnUnit u;
  for(int i=0;S.next(i,u);++i){ S.a_ready(u); attn_unit<THRL>(u.bh/NHEAD,u.bh%NHEAD,u.qb,T.Q,T.K,T.V,T.O,T.kmean+(size_t)u.bh*16*128,lds,wave_in); S.done(u); }
}
#undef SBAR
#undef WAIT_BAR
}
__device__ __forceinline__ void phase_moe_route(Frame& F) {
    PHASE_LOCALS();
    if ((int)blockIdx.x >= 4 * (M / 256)) return;
    const int j = blockIdx.x >> 2, quarter = blockIdx.x & 3;
    const int* TOPI = (const int*)(F.ws + WS_TOPI); int* DEST = (int*)(F.ws + WS_DEST); int* ROWTOK = (int*)(F.ws + WS_ROWTOK); int* TILEE = (int*)(F.ws + WS_TILEE); int* NTILES = (int*)(F.ws + WS_NTILES);
    LAS int* cnt = (LAS int*)F.lds; LAS int* tot = cnt + 64 * 8; LAS int* basej = tot + 8; LAS int* pstart = basej + 8; LAS int* wcnt = pstart + 16; LAS int* dsts = wcnt + 32;
    for (int i = tid; i < 64 * 8; i += NTHR) cnt[i] = 0;
    __syncthreads();
    for (int m0 = tid; m0 < M; m0 += 8 * NTHR) { int2 e[8];
#pragma unroll
        for (int k = 0; k < 8; ++k) e[k] = *(const int2*)(TOPI + (size_t)(m0 + k * NTHR) * 2);
#pragma unroll
        for (int k = 0; k < 8; ++k) { const int m = m0 + k * NTHR; __hip_atomic_fetch_add(cnt + (m >> 8) * 8 + e[k].x, 1, __ATOMIC_RELAXED, __HIP_MEMORY_SCOPE_WORKGROUP); __hip_atomic_fetch_add(cnt + (m >> 8) * 8 + e[k].y, 1, __ATOMIC_RELAXED, __HIP_MEMORY_SCOPE_WORKGROUP); } }
    __syncthreads();
    if (tid < 8) { int s = 0, bj = 0; for (int jj = 0; jj < 64; ++jj) { if (jj == j) bj = s; s += cnt[jj * 8 + tid]; } tot[tid] = s; basej[tid] = bj; }
    __syncthreads();
    if (tid == 0) { int ps = 0; for (int e = 0; e < 8; ++e) { pstart[e] = ps; ps += (tot[e] + 255) & ~255; } pstart[8] = ps; }
    __syncthreads();
    const int m = 256 * j + tid; int e1 = -1, e2 = -1, rk1 = 0, rk2 = 0;
    if (tid < 256) { const int2 e = *(const int2*)(TOPI + (size_t)m * 2); e1 = e.x; e2 = e.y; }
    if (tid < 256) {
#pragma unroll
        for (int e = 0; e < 8; ++e) { const bool has = (e1 == e) || (e2 == e); const unsigned long long mask = __ballot(has); const int rk = __popcll(mask & ((1ull << lane) - 1ull));
            if (e1 == e) rk1 = rk; if (e2 == e) rk2 = rk; if (lane == 0) wcnt[F.wave * 8 + e] = __popcll(mask); }
    }
    __syncthreads();
    if (tid < 256) {
        int o1 = 0, o2 = 0;
        for (int w = 0; w < F.wave; ++w) { o1 += wcnt[w * 8 + e1]; o2 += wcnt[w * 8 + e2]; }
        const int d1 = pstart[e1] + basej[e1] + o1 + rk1, d2 = pstart[e2] + basej[e2] + o2 + rk2;
        if (quarter == 0) *(int2*)(DEST + (size_t)m * 2) = make_int2(d1, d2);
        dsts[2 * tid] = d1; dsts[2 * tid + 1] = d2;
    }
    __syncthreads();
    { const bf16* __restrict__ HB = (const bf16*)(F.ws + WS_HB); bf16* __restrict__ XG = (bf16*)(F.ws + WS_XG);
      for (int i0 = quarter * 64 * 128 + tid; i0 < (quarter + 1) * 64 * 128; i0 += 8 * NTHR) { v4u val[8];
#pragma unroll
          for (int k = 0; k < 8; ++k) { const int i = i0 + k * NTHR; val[k] = *(const v4u*)(HB + (size_t)(256 * j + (i >> 7)) * D + 8 * (i & 127)); }
#pragma unroll
          for (int k = 0; k < 8; ++k) { const int i = i0 + k * NTHR, t = i >> 7; const v4u w = val[k];
#define C8_(v) __builtin_amdgcn_fmed3f((v), -448.0f, 448.0f)
              int a_ = __builtin_amdgcn_cvt_pk_fp8_f32(C8_(bflo(w.x)), C8_(bfhi(w.x)), 0, false); a_ = __builtin_amdgcn_cvt_pk_fp8_f32(C8_(bflo(w.y)), C8_(bfhi(w.y)), a_, true);
              int b_ = __builtin_amdgcn_cvt_pk_fp8_f32(C8_(bflo(w.z)), C8_(bfhi(w.z)), 0, false); b_ = __builtin_amdgcn_cvt_pk_fp8_f32(C8_(bflo(w.w)), C8_(bfhi(w.w)), b_, true);
#undef C8_
              uint2 o8; o8.x = (unsigned)a_; o8.y = (unsigned)b_;
              *(uint2*)((unsigned char*)XG + (size_t)dsts[2 * t] * D + 8 * (i & 127)) = o8; *(uint2*)((unsigned char*)XG + (size_t)dsts[2 * t + 1] * D + 8 * (i & 127)) = o8; } } }
    if (j == 0 && quarter == 0) {
        const int nt = pstart[8] >> 8;
        for (int i = tid; i < nt; i += NTHR) { int e = 0; for (int k = 1; k < 8; ++k) if (256 * i >= pstart[k]) e = k; TILEE[i] = e; }
        if (tid == 0) NTILES[0] = nt;
    }
    __syncthreads();
}
__device__ __forceinline__ int moe_ntiles(Frame& F) { return __builtin_amdgcn_readfirstlane((int)__hip_atomic_load((const unsigned*)(F.ws + WS_NTILES), RLX_AGENT)); }
__device__ __forceinline__ void phase_moe_gather(Frame& F) {
    PHASE_LOCALS();
    const int nrows = moe_ntiles(F) * 256; const int* __restrict__ ROWTOK = (const int*)(F.ws + WS_ROWTOK); const bf16* __restrict__ HB = (const bf16*)(F.ws + WS_HB); bf16* __restrict__ XG = (bf16*)(F.ws + WS_XG);
    const int total = nrows * 128, stride = F.G * NTHR;
    for (int idx0 = F.vcu * NTHR + tid; idx0 < total; idx0 += 8 * stride) {
        int tok[8]; v4u val[8];
#pragma unroll
        for (int k = 0; k < 8; ++k) { const int idx = idx0 + k * stride; tok[k] = (idx < total) ? ROWTOK[idx >> 7] : 0; }
#pragma unroll
        for (int k = 0; k < 8; ++k) { const int idx = idx0 + k * stride; val[k] = *(const v4u*)(HB + (size_t)tok[k] * D + 8 * (idx & 127)); }
#pragma unroll
        for (int k = 0; k < 8; ++k) { const int idx = idx0 + k * stride; if (idx < total) *(v4u*)(XG + (size_t)(idx >> 7) * D + 8 * (idx & 127)) = val[k]; }
    }
}
constexpr float W2_F8SCALE = 64.0f, GH_F8SCALE = 4.0f;
constexpr float W13_F8SCALE = 32.0f;
constexpr int CW_Q = 2048, CW_DONE = 3072;
constexpr int QN_E13 = 2 * (16 * 14), QN_E2 = 56 * 4;
constexpr int QN0 = NEXP * (QN_E13 + QN_E2), QN3 = (NTILES_T - P0_URGENT) + P_CHUNKS;
__device__ __forceinline__ void conv_item(Frame& F, const Inputs& in, int q, int it, int lane) {
    if (q == 3) { if (it < NTILES_T - P0_URGENT) p0_tile(F, in, P0_URGENT + it, lane); else p_chunk(F, in, it - (NTILES_T - P0_URGENT), F.wave * 64 + lane); return; }
    unsigned char* W13 = F.ws + WS_WE; unsigned char* W2 = W13 + (size_t)NEXP * 2 * DFFE * D;
    const int per = QN_E13 + QN_E2, e = it / per; int r = it % per;
    bool found = false; TrJob jb;
    jb.W = nullptr; jb.ld = 0; jb.K = 64; jb.N = 256; jb.WT = nullptr; jb.rowstep = 128; jb.row_off = 0; jb.gk = nullptr; jb.nrows = 32;
    bf16* W13e = (bf16*)(W13 + (size_t)e * 2 * DFFE * D);
    TTJOBG(in.p[I_WE1] + (size_t)e * D * DFFE, DFFE, D, DFFE, W13e, 256, 0, nullptr)
    TTJOBG(in.p[I_WE3] + (size_t)e * D * DFFE, DFFE, D, DFFE, W13e, 256, 128, nullptr)
    const bool is13 = found;
    TTJOBG(in.p[I_WE2] + (size_t)e * DFFE * D, D, DFFE, D, (bf16*)(W2 + (size_t)e * D * DFFE), 128, 0, nullptr)
    if (found) tr_tile(jb.W, jb.ld, jb.K, jb.N / 256, jb.WT, jb.rowstep, jb.row_off, (LAS float*)(F.lds + RING_OFF), r, F.wave, lane, jb.gk, false, is13 ? W13_F8SCALE : W2_F8SCALE);
}
struct TileJob0 { const float* W; unsigned char* WT; int ld, K, rowstep, row_off, k0, n0; float sc; };
__device__ __forceinline__ TileJob0 tile_job0(Frame& F, const Inputs& in, int it) {
    unsigned char* W13 = F.ws + WS_WE; unsigned char* W2 = W13 + (size_t)NEXP * 2 * DFFE * D;
    const int per = QN_E13 + QN_E2, e = it / per, r = it % per; TileJob0 j;
    if (r < QN_E13) { const int h3 = (r >= QN_E13 / 2) ? 1 : 0, rr = r - h3 * (QN_E13 / 2);
        j.W = in.p[h3 ? I_WE3 : I_WE1] + (size_t)e * D * DFFE; j.ld = DFFE; j.K = D; j.WT = W13 + (size_t)e * 2 * DFFE * D; j.rowstep = 256; j.row_off = 128 * h3; j.k0 = 64 * (rr / 14); j.n0 = 256 * (rr % 14); j.sc = W13_F8SCALE; }
    else { const int rr = r - QN_E13; j.W = in.p[I_WE2] + (size_t)e * DFFE * D; j.ld = D; j.K = DFFE; j.WT = W2 + (size_t)e * D * DFFE; j.rowstep = 128; j.row_off = 0; j.k0 = 64 * (rr / 4); j.n0 = 256 * (rr % 4); j.sc = W2_F8SCALE; }
    return j;
}
__device__ __forceinline__ void conv_queue0(Frame& F, const Inputs& in, int nitems, int stop_site, unsigned n_long) {
    PHASE_LOCALS();
    gu32* head = F.ctl + CW_Q; gu32* done = F.ctl + CW_DONE + 64 * (stop_site < 0 ? 0 : stop_site);
    volatile LAS unsigned* slot = F.MISC + 16; LAS float* scr = (LAS float*)(F.lds + RING_OFF); const int wave = F.wave;
#define Q0_TAKE() do { if (tid == 0) { unsigned b_ = 0xffffffffu; if (!(stop_site >= 0 && __hip_atomic_load(done, RLX_AGENT) >= n_long)) b_ = __hip_atomic_fetch_add(head, 1u, RLX_AGENT); slot[0] = b_; } } while (0)
#define Q0_LOAD(J, V) do { _Pragma("unroll") for (int i = 0; i < 8; ++i) V[i] = *(const f32x4*)(J.W + (size_t)(J.k0 + wave + 8 * i) * J.ld + J.n0 + 4 * lane); } while (0)
    Q0_TAKE();
    __syncthreads();
    unsigned base = slot[0];
    __syncthreads();
    if (base >= (unsigned)nitems) return;
    TileJob0 a = tile_job0(F, in, (int)base); f32x4 v[8], vn[8];
    Q0_LOAD(a, v);
    for (;;) {
        Q0_TAKE();
#pragma unroll
        for (int i = 0; i < 8; ++i) { LAS float* d = scr + (wave + 8 * i) * 257 + 4 * lane; d[0] = v[i][0]; d[1] = v[i][1]; d[2] = v[i][2]; d[3] = v[i][3]; }
        __syncthreads();
        base = slot[0];
        const bool more = base < (unsigned)nitems; TileJob0 b = a;
        if (more) { b = tile_job0(F, in, (int)base); Q0_LOAD(b, vn); }
        { const int c = tid & 7;
#pragma unroll
          for (int jj = 0; jj < 4; ++jj) { const int n = (tid >> 3) + 64 * jj; const LAS float* p = scr + (8 * c) * 257 + n; const float sc = a.sc;
              const int nn = a.n0 + n, drow = (nn >> 7) * a.rowstep + (nn & 127) + a.row_off;
              int a_ = __builtin_amdgcn_cvt_pk_fp8_f32(p[0] * sc, p[257] * sc, 0, false); a_ = __builtin_amdgcn_cvt_pk_fp8_f32(p[2 * 257] * sc, p[3 * 257] * sc, a_, true);
              int b_ = __builtin_amdgcn_cvt_pk_fp8_f32(p[4 * 257] * sc, p[5 * 257] * sc, 0, false); b_ = __builtin_amdgcn_cvt_pk_fp8_f32(p[6 * 257] * sc, p[7 * 257] * sc, b_, true);
              uint2 o8; o8.x = (unsigned)a_; o8.y = (unsigned)b_; *(uint2*)(a.WT + (size_t)drow * a.K + a.k0 + 8 * c) = o8; } }
        __syncthreads();
        if (!more) break;
        a = b;
#pragma unroll
        for (int i = 0; i < 8; ++i) v[i] = vn[i];
    }
#undef Q0_TAKE
#undef Q0_LOAD
}
__device__ __forceinline__ void conv_queue(Frame& F, const Inputs& in, int q, int nitems, int stop_site, unsigned n_long) {
    if (q == 0) { conv_queue0(F, in, nitems, stop_site, n_long); return; }
    PHASE_LOCALS();
    gu32* head = F.ctl + CW_Q + 64 * q; gu32* done = F.ctl + CW_DONE + 64 * (stop_site < 0 ? 0 : stop_site);
    volatile LAS unsigned* slot = F.MISC + 16;
    for (;;) {
        if (tid == 0) { unsigned base = 0xffffffffu;
            if (!(stop_site >= 0 && __hip_atomic_load(done, RLX_AGENT) >= n_long)) base = __hip_atomic_fetch_add(head, 1u, RLX_AGENT);
            slot[0] = base; }
        __syncthreads();
        const unsigned base = slot[0];
        __syncthreads();
        if (base >= (unsigned)nitems) break;
        conv_item(F, in, q, (int)base, lane);
    }
}
__device__ __forceinline__ void conv_fill_tail(Frame& F, const Inputs& in, int q, int nitems, int site, int mine, int maxc, int nlong) {
    if (nlong >= F.G) return;
    if (mine == maxc) { if (F.wave == 0 && lane_now() == 0) __hip_atomic_fetch_add(F.ctl + CW_DONE + 64 * site, 1u, RLX_AGENT); }
    else conv_queue(F, in, q, nitems, site, (unsigned)nlong);
}
__device__ __forceinline__ void conv_fill_all(Frame& F, const Inputs& in, int q, int nitems, int site) {
    __syncthreads();
    if (F.wave == 0 && lane_now() == 0) __hip_atomic_fetch_add(F.ctl + CW_DONE + 64 * site, 1u, RLX_AGENT);
    conv_queue(F, in, q, nitems, site, (unsigned)F.G);
}
__device__ __forceinline__ void conv_fill_tail_rr(Frame& F, const Inputs& in, int q, int nitems, int site, int nunits, int c) {
    const int maxu = (nunits + F.G - 1) / F.G, n_long = nunits - (maxu - 1) * F.G;
    conv_fill_tail(F, in, q, nitems, site, c < n_long ? maxu : maxu - 1, maxu, n_long);
}
__device__ __forceinline__ const LAS unsigned* moe_tile_table(Frame& F, int ntr) {
    LAS unsigned* tab = (LAS unsigned*)(F.lds + SM_OFF); const int tid = F.wave * 64 + lane_now();
    __syncthreads();
    if (tid < ntr) tab[tid] = __hip_atomic_load((const unsigned*)(F.ws + WS_TILEE) + tid, RLX_AGENT);
    __syncthreads();
    return tab;
}
namespace pg8 {
struct MoeOrder {
    static constexpr bool SEGMENTED = true;
    const PG8_LAS unsigned* tile_e; int ntr, nct, bpe, G, c;
    __device__ __forceinline__ bool next(int i, Unit& u) const {
        const int T = ntr * nct; long p;
        if (SEGMENTED && G % 8 == 0) { const int per = G / 8, x = c % 8, s = c / 8, seg = (T + 7) / 8; const long q = (long)i * per + s; if (q >= seg) return false; p = (long)x * seg + q; }
        else p = (long)i * G + c;
        if (p >= T) return false;
        u.pm = (int)(p / nct); u.pn = (int)(p % nct);
        const int e = __builtin_amdgcn_readfirstlane((int)tile_e[u.pm]);
        u.pb = e * bpe + u.pn; return true;
    }
    __device__ __forceinline__ int count_of(int cc) const { const int T = ntr * nct;
        if (SEGMENTED && G % 8 == 0) { const int per = G / 8, x = cc % 8, s = cc / 8, seg = (T + 7) / 8; int sx = T - x * seg; sx = sx < 0 ? 0 : (sx > seg ? seg : sx); return s < sx ? (sx - s + per - 1) / per : 0; }
        return cc < T ? (T - cc + G - 1) / G : 0; }
    __device__ __forceinline__ void tails(int& mine, int& maxc, int& nlong) const { mine = count_of(c); const int T = ntr * nct;
        if (!(SEGMENTED && G % 8 == 0)) { maxc = (T + G - 1) / G; nlong = T - (maxc - 1) * G; return; }
        const int per = G / 8, seg = (T + 7) / 8; maxc = (seg + per - 1) / per; nlong = 0;
        for (int x = 0; x < 8; ++x) { int sx = T - x * seg; sx = sx < 0 ? 0 : (sx > seg ? seg : sx); int k = sx - (maxc - 1) * per; k = k < 0 ? 0 : (k > per ? per : k); nlong += k; } }
    __device__ __forceinline__ void a_ready(const Unit&) const {}
    __device__ __forceinline__ void done(const Unit&) const {}
};
template <bool ACCUM> struct EpiY {
    static constexpr bool PERM = true, AFTER_DRAIN = false, MIDK = false; typedef NoPre::Pre Pre; __device__ __forceinline__ Pre prefetch(const Unit&, int, int) const { return Pre{}; }
    bf16_t* Y; int ldc; float osc;
    __device__ __forceinline__ void operator()(const f32x4 (&acc)[2][2][4][2], const Unit& u, int wr, int wc, int fr, int fq, const Pre&) const {
        const int row0 = u.pm * BM + wr * 64 + fr, col0 = u.pn * BM + wc * 32 + 8 * fq;
#pragma unroll
        for (int ai = 0; ai < 2; ++ai)
#pragma unroll
            for (int m = 0; m < 4; ++m) { bf16_t* rowp = Y + (size_t)(row0 + ai * HALF + m * 16) * ldc + col0;
#pragma unroll
                for (int bj = 0; bj < 2; ++bj) { f32x4 v0 = acc[ai][bj][m][0] * osc, v1 = acc[ai][bj][m][1] * osc;
                    if (ACCUM) { const u32x4 y = *(const u32x4*)(rowp + bj * HALF);
                        v0 += (f32x4){bflo(y.x), bfhi(y.x), bflo(y.y), bfhi(y.y)}; v1 += (f32x4){bflo(y.z), bfhi(y.z), bflo(y.w), bfhi(y.w)}; }
                    u32x4 w; w.x = cvt_pk_bf16(v0[0], v0[1]); w.y = cvt_pk_bf16(v0[2], v0[3]); w.z = cvt_pk_bf16(v1[0], v1[1]); w.w = cvt_pk_bf16(v1[2], v1[3]);
                    *(u32x4*)(rowp + bj * HALF) = w; } }
    }
};
}
struct Args { Inputs in; float* out; unsigned char* ws; int ph_lo, ph_hi, li, pad; };
#ifndef MLSTM_NAIVE
#define MLSTM_NAIVE 0
#endif
#ifndef ATTN_NAIVE
#define ATTN_NAIVE 0
#endif
#ifndef MOE_NAIVE
#define MOE_NAIVE 0
#endif
#ifndef MK_PER_PHASE
#define MK_PER_PHASE 0
#endif
constexpr int MAX_LAUNCH = 64;

__global__ void __launch_bounds__(NTHR, 2) mega_fwd(Args args) {
    extern __shared__ __attribute__((aligned(16))) unsigned char lds[];
    Frame F;
    F.lds = (LAS unsigned char*)lds;
    F.MISC = (volatile LAS unsigned*)(F.lds + MISC_OFF);
    F.wave = __builtin_amdgcn_readfirstlane((int)(threadIdx.x >> 6));
    F.G = gridDim.x; { const int bx = blockIdx.x; F.vcu = (F.G % 8 == 0) ? (bx % 8) * (F.G / 8) + bx / 8 : bx; }
    F.ws = args.ws; F.ctl = (gu32*)(args.ws + WS_CTL);
    const Inputs& in = args.in;
    for (int u = threadIdx.x; u < (LDS_BYTES - LDSCTL_OFF) / 4; u += NTHR) ((LAS unsigned*)(F.lds + LDSCTL_OFF))[u] = 0u;
    __syncthreads();
    XcdBarrier bar = xcd_barrier_post((unsigned*)(F.ctl + CW_BAR) + args.li * XCD_BAR_WORDS, F.MISC + 8, F.wave);
    const int lo = args.ph_lo, hi = args.ph_hi;
    int ph = 0;
__attribute__((unused)) auto phq = [](int p) { asm volatile("" : "+s"(p)); return p; };
#define RUN() (lo <= phq(ph) && phq(ph) < hi)
#define SEAM() do { if (lo <= phq(ph) && phq(ph) + 1 < hi) xcd_barrier(bar); ++ph; } while (0)
    auto wsp = [&]() { unsigned char* p_ = args.ws; asm volatile("" : "+s"(p_)); return p_; };
#define HB ((bf16*)(wsp() + WS_HB))
#define PROJ ((bf16*)(wsp() + WS_PROJ))
#define YA ((bf16*)(wsp() + WS_YA))
#define YB ((bf16*)(wsp() + WS_YB))
#define MIXED ((bf16*)(wsp() + WS_MIXED))
#define TMP ((bf16*)(wsp() + WS_TMP))
#define GH ((bf16*)(wsp() + WS_GH))
#define PP ((bf16*)(wsp() + WS_PP))
#define IFPRE ((float*)(wsp() + WS_IFPRE))
#define GSEL ((float*)(wsp() + WS_GSEL))
#define XB ((bf16*)(wsp() + WS_XB))
#define XB2 ((bf16*)(wsp() + WS_QKC))
#define SSACC ((pg8::ssq_t*)((unsigned*)(wsp() + WS_CTL) + CW_SS))
    float* const X = args.out;


#ifndef SK_P0
        if (RUN()) p0_prologue(F, in);
#endif

    SEAM();
    { constexpr int l = 0;
        const float* xs = (l == 0) ? in.p[I_X] : X;
        if (RUN()) {
            const bf16* A_ = (l == 0) ? XB : XB2; const bf16* W_ = (const bf16*)(F.ws + WS_WIN) + (size_t)l * NPROJX * D; const pg8::ssq_t* ss_ = (l == 0) ? (const pg8::ssq_t*)(F.ws + WS_SS0) : (const pg8::ssq_t*)(SSACC + 2 * M);
            { pg8::Gemm g{A_, W_, M, 1024, D}; pg8::StaticOrder S; S.init(M, 1024, F.G, (int)blockIdx.x);
              pg8::EpiQK E{PROJ, (unsigned)NPROJ, ss_, in.p[I_GQ] + l * AHD, in.p[I_GK] + l * AHD, (float*)(wsp() + WS_KMEAN), C2};
              pg8::gemm_phase<pg8::EpiQK, pg8::StaticOrder, true, true>(F.lds + RING_OFF, g, S, E, F.wave); }
            { pg8::Gemm g{A_, W_ + (size_t)1024 * D, M, NPROJX - 1024, D}; pg8::StaticOrder S; S.init(M, NPROJX - 1024, F.G, (int)blockIdx.x);
              pg8::EpiProj E{PROJ, NPROJ, PC_GA / 256, ss_, NPROJX / 256 - 1, IFPRE, in.p[I_BI] + l * MH, in.p[I_BF] + l * MH, (bf16*)(wsp() + WS_GT), 4};
              pg8::gemm_phase<pg8::EpiProj, pg8::StaticOrder, true, true>(F.lds + RING_OFF, g, S, E, F.wave);
              if (l == 0) conv_fill_tail_rr(F, in, 3, QN3, 0, (M / 256) * ((NPROJX - 1024) / 256), (int)blockIdx.x);
              else conv_fill_tail_rr(F, in, 0, QN0, 2, (M / 256) * ((NPROJX - 1024) / 256), (int)blockIdx.x); }
        }
        SEAM();
        if (RUN()) {
#if !MLSTM_NAIVE
            phase_mlstm_m1(F, in, l);
#endif
#if ATTN_NAIVE
            phase_attn_naive(F);
#else
            { const attn_body::AttnTensors AT{(const attn_body::bf16*)(PROJ + PC_Q), (const attn_body::bf16*)(PROJ + PC_K), (const attn_body::bf16*)(PROJ + PC_V), (attn_body::bf16*)YA, (const float*)(F.ws + WS_KMEAN)};
              const attn_body::StaticOrder S((int)F.G, (int)blockIdx.x);
              attn_body::attn_phase<attn_body::StaticOrder>((char*)lds + RING_OFF, AT, S, F.wave); }
#endif
        }

        SEAM();

#if MLSTM_NAIVE
        if (RUN()) phase_mlstm_naive(F, in, l);
        SEAM();
#else
        if (RUN()) { phase_mlstm_m3(F, in, l);
            if (l == 0) { conv_queue(F, in, 3, QN3, -1, 0u); conv_fill_all(F, in, 0, QN0, 5); } else conv_fill_all(F, in, 0, QN0, 4); }
        SEAM();
#endif


        if (RUN()) { pg8::Gemm g{YA, (const bf16*)(F.ws + WS_WOA) + (size_t)l * D * D, M, D, D}; pg8::StaticOrder S; S.init(M, D, F.G, (int)blockIdx.x);
            pg8::EpiMerge E{(const bf16*)(wsp() + WS_GT), MIXED, D};
            pg8::gemm_phase<pg8::EpiMerge, pg8::StaticOrder, true, true>(F.lds + RING_OFF, g, S, E, F.wave); }
        SEAM();
        if (RUN()) { pg8::Gemm g{MIXED, (const bf16*)(F.ws + WS_WOUT) + (size_t)l * D * D, M, D, D}; pg8::StaticOrder S; S.init(M, D, F.G, (int)blockIdx.x);
            pg8::EpiResid E{xs, X, D, nullptr, 0, (l == 0) ? XB : nullptr, (l == 0) ? SSACC : nullptr};
            pg8::gemm_phase<pg8::EpiResid, pg8::StaticOrder, true, true>(F.lds + RING_OFF, g, S, E, F.wave); }
        SEAM();
        if (l == 0) {
            if (RUN()) { pg8::Gemm g{XB, (const bf16*)(F.ws + WS_WD13), M, 2 * DFF, D}; pg8::StaticOrder S; S.init(M, 2 * DFF, F.G, (int)blockIdx.x);
                pg8::EpiSwiglu E{GH, DFF, SSACC, 1.0f, 0.f};
                pg8::gemm_phase<pg8::EpiSwiglu, pg8::StaticOrder, true, true>(F.lds + RING_OFF, g, S, E, F.wave);
                conv_fill_tail_rr(F, in, 0, QN0, 1, (M / 256) * (2 * DFF / 256), (int)blockIdx.x); }
            SEAM();
            if (RUN()) { pg8::Gemm g{GH, (const bf16*)(F.ws + WS_WD2), M, D, DFF}; pg8::StaticOrder S; S.init(M, D, F.G, (int)blockIdx.x);
                pg8::EpiResid E{X, X, D, nullptr, 0, XB, SSACC + M};
                pg8::gemm_phase<pg8::EpiResid, pg8::StaticOrder, true, true>(F.lds + RING_OFF, g, S, E, F.wave); }
            SEAM();
        } else {
            if (RUN()) phase_norm<2>(F, X, in.p[I_GFFN] + l * D, HB, in.p[I_WR], NEXP, nullptr, nullptr, nullptr, GSEL);
            SEAM();
#if MOE_NAIVE
            for (int e = 0; e < NEXP; ++e) {

#ifndef SK_CONVE
        if (RUN()) p_conv_expert(F, in, e);
#endif

                SEAM();
                if (RUN()) { pg8::Gemm g{HB, (const bf16*)(F.ws + WS_WE), M, 2 * DFFE, D}; pg8::StaticOrder S; S.init(M, 2 * DFFE, F.G, (int)blockIdx.x);
                    pg8::EpiSwiglu E{GH, DFFE, nullptr, 1.0f, 0.f};
                    pg8::gemm_phase<pg8::EpiSwiglu, pg8::StaticOrder, true, true>(F.lds + RING_OFF, g, S, E, F.wave); }
                SEAM();
                if (RUN()) { pg8::Gemm g{GH, (const bf16*)(F.ws + WS_WE) + (size_t)2 * DFFE * D, M, D, DFFE}; pg8::StaticOrder S; S.init(M, D, F.G, (int)blockIdx.x);
                    pg8::EpiResid E{X, X, D, GSEL + e, NEXP, nullptr, nullptr};
                    pg8::gemm_phase<pg8::EpiResid, pg8::StaticOrder, true, true>(F.lds + RING_OFF, g, S, E, F.wave); }
                SEAM();
            }
#else
            if (RUN()) { phase_moe_route(F); conv_queue(F, in, 0, QN0, -1, 0u); }
            SEAM();
            if (RUN()) { pg8::Gemm g{(const bf16*)(F.ws + WS_XG), (const bf16*)(F.ws + WS_WE), MOE_MAXROWS, 2 * DFFE, D / 2};
                const int ntr_ = moe_ntiles(F); pg8::MoeOrder S{moe_tile_table(F, ntr_), ntr_, 2 * DFFE / 256, 2 * DFFE / 256, F.G, (int)blockIdx.x};
                pg8::EpiSwiglu E{(bf16*)(F.ws + WS_GHH), DFFE, nullptr, 1.0f / W13_F8SCALE, GH_F8SCALE};
                pg8::gemm_phase<pg8::EpiSwiglu, pg8::MoeOrder, true, true, true>(F.lds + RING_OFF, g, S, E, F.wave); }
            SEAM();
            if (RUN()) { pg8::Gemm g{(const bf16*)(F.ws + WS_GHH), (const bf16*)(F.ws + WS_WE + (size_t)NEXP * 2 * DFFE * D), MOE_MAXROWS, D, DFFE / 2};
                const int ntr_ = moe_ntiles(F); pg8::MoeOrder S{moe_tile_table(F, ntr_), ntr_, D / 256, D / 256, F.G, (int)blockIdx.x};
                pg8::EpiY<false> E{(bf16*)(F.ws + WS_Y), D, 1.0f / (W2_F8SCALE * GH_F8SCALE)}; pg8::gemm_phase<pg8::EpiY<false>, pg8::MoeOrder, true, true, true>(F.lds + RING_OFF, g, S, E, F.wave); }
            SEAM();
#endif
        }
        if (l == 1) {
            if (RUN()) { if (!MOE_NAIVE) phase_norm<3>(F, X, in.p[I_GPLE] + l * D, HB, nullptr, 0, nullptr, nullptr, nullptr, nullptr);
                else phase_norm<0>(F, X, in.p[I_GPLE] + l * D, HB, nullptr, 0, nullptr, nullptr, nullptr, nullptr); }
            SEAM();
        }
        if (RUN()) {
            { pg8::Gemm g{(const bf16*)(F.ws + WS_PB) + (size_t)l * M * PLE, (const bf16*)(F.ws + WS_WPP) + (size_t)l * D * PLE, M, D, PLE}; pg8::StaticOrder S; S.init(M, D, F.G, (int)blockIdx.x);
              pg8::EpiF32 E{PP, D};
              pg8::gemm_phase<pg8::EpiF32, pg8::StaticOrder, true, true>(F.lds + RING_OFF, g, S, E, F.wave); }
            { pg8::Gemm g{(l == 0) ? XB : HB, (const bf16*)(F.ws + WS_WPG) + (size_t)l * D * D, M, D, D}; pg8::StaticOrder S; S.init(M, D, F.G, (int)blockIdx.x);
              pg8::EpiPle2 E{PP, X, D, (l == 0) ? (const pg8::ssq_t*)(SSACC + M) : nullptr, (l == 0) ? XB2 : nullptr, (l == 0) ? SSACC + 2 * M : nullptr};
              pg8::gemm_phase<pg8::EpiPle2, pg8::StaticOrder, true, true>(F.lds + RING_OFF, g, S, E, F.wave); }
        }
        SEAM();
    }
    { constexpr int l = 1;
        const float* xs = (l == 0) ? in.p[I_X] : X;
        if (RUN()) {
            const bf16* A_ = (l == 0) ? XB : XB2; const bf16* W_ = (const bf16*)(F.ws + WS_WIN) + (size_t)l * NPROJX * D; const pg8::ssq_t* ss_ = (l == 0) ? (const pg8::ssq_t*)(F.ws + WS_SS0) : (const pg8::ssq_t*)(SSACC + 2 * M);
            { pg8::Gemm g{A_, W_, M, 1024, D}; pg8::StaticOrder S; S.init(M, 1024, F.G, (int)blockIdx.x);
              pg8::EpiQK E{PROJ, (unsigned)NPROJ, ss_, in.p[I_GQ] + l * AHD, in.p[I_GK] + l * AHD, (float*)(wsp() + WS_KMEAN), C2};
              pg8::gemm_phase<pg8::EpiQK, pg8::StaticOrder, true, true>(F.lds + RING_OFF, g, S, E, F.wave); }
            { pg8::Gemm g{A_, W_ + (size_t)1024 * D, M, NPROJX - 1024, D}; pg8::StaticOrder S; S.init(M, NPROJX - 1024, F.G, (int)blockIdx.x);
              pg8::EpiProj E{PROJ, NPROJ, PC_GA / 256, ss_, NPROJX / 256 - 1, IFPRE, in.p[I_BI] + l * MH, in.p[I_BF] + l * MH, (bf16*)(wsp() + WS_GT), 4};
              pg8::gemm_phase<pg8::EpiProj, pg8::StaticOrder, true, true>(F.lds + RING_OFF, g, S, E, F.wave);
              if (l == 0) conv_fill_tail_rr(F, in, 3, QN3, 0, (M / 256) * ((NPROJX - 1024) / 256), (int)blockIdx.x);
              else conv_fill_tail_rr(F, in, 0, QN0, 2, (M / 256) * ((NPROJX - 1024) / 256), (int)blockIdx.x); }
        }
        SEAM();
        if (RUN()) {
#if !MLSTM_NAIVE
            phase_mlstm_m1(F, in, l);
#endif
#if ATTN_NAIVE
            phase_attn_naive(F);
#else
            { const attn_body::AttnTensors AT{(const attn_body::bf16*)(PROJ + PC_Q), (const attn_body::bf16*)(PROJ + PC_K), (const attn_body::bf16*)(PROJ + PC_V), (attn_body::bf16*)YA, (const float*)(F.ws + WS_KMEAN)};
              const attn_body::StaticOrder S((int)F.G, (int)blockIdx.x);
              attn_body::attn_phase<attn_body::StaticOrder>((char*)lds + RING_OFF, AT, S, F.wave); }
#endif
        }

        SEAM();

#if MLSTM_NAIVE
        if (RUN()) phase_mlstm_naive(F, in, l);
        SEAM();
#else
        if (RUN()) { phase_mlstm_m3(F, in, l);
            if (l == 0) { conv_queue(F, in, 3, QN3, -1, 0u); conv_fill_all(F, in, 0, QN0, 5); } else conv_fill_all(F, in, 0, QN0, 4); }
        SEAM();
#endif


        if (RUN()) { pg8::Gemm g{YA, (const bf16*)(F.ws + WS_WOA) + (size_t)l * D * D, M, D, D}; pg8::StaticOrder S; S.init(M, D, F.G, (int)blockIdx.x);
            pg8::EpiMerge E{(const bf16*)(wsp() + WS_GT), MIXED, D};
            pg8::gemm_phase<pg8::EpiMerge, pg8::StaticOrder, true, true>(F.lds + RING_OFF, g, S, E, F.wave); }
        SEAM();
        if (RUN()) { pg8::Gemm g{MIXED, (const bf16*)(F.ws + WS_WOUT) + (size_t)l * D * D, M, D, D}; pg8::StaticOrder S; S.init(M, D, F.G, (int)blockIdx.x);
            pg8::EpiResid E{xs, X, D, nullptr, 0, (l == 0) ? XB : nullptr, (l == 0) ? SSACC : nullptr};
            pg8::gemm_phase<pg8::EpiResid, pg8::StaticOrder, true, true>(F.lds + RING_OFF, g, S, E, F.wave); }
        SEAM();
        if (l == 0) {
            if (RUN()) { pg8::Gemm g{XB, (const bf16*)(F.ws + WS_WD13), M, 2 * DFF, D}; pg8::StaticOrder S; S.init(M, 2 * DFF, F.G, (int)blockIdx.x);
                pg8::EpiSwiglu E{GH, DFF, SSACC, 1.0f, 0.f};
                pg8::gemm_phase<pg8::EpiSwiglu, pg8::StaticOrder, true, true>(F.lds + RING_OFF, g, S, E, F.wave);
                conv_fill_tail_rr(F, in, 0, QN0, 1, (M / 256) * (2 * DFF / 256), (int)blockIdx.x); }
            SEAM();
            if (RUN()) { pg8::Gemm g{GH, (const bf16*)(F.ws + WS_WD2), M, D, DFF}; pg8::StaticOrder S; S.init(M, D, F.G, (int)blockIdx.x);
                pg8::EpiResid E{X, X, D, nullptr, 0, XB, SSACC + M};
                pg8::gemm_phase<pg8::EpiResid, pg8::StaticOrder, true, true>(F.lds + RING_OFF, g, S, E, F.wave); }
            SEAM();
        } else {
            if (RUN()) phase_norm<2>(F, X, in.p[I_GFFN] + l * D, HB, in.p[I_WR], NEXP, nullptr, nullptr, nullptr, GSEL);
            SEAM();
#if MOE_NAIVE
            for (int e = 0; e < NEXP; ++e) {

#ifndef SK_CONVE
        if (RUN()) p_conv_expert(F, in, e);
#endif

                SEAM();
                if (RUN()) { pg8::Gemm g{HB, (const bf16*)(F.ws + WS_WE), M, 2 * DFFE, D}; pg8::StaticOrder S; S.init(M, 2 * DFFE, F.G, (int)blockIdx.x);
                    pg8::EpiSwiglu E{GH, DFFE, nullptr, 1.0f, 0.f};
                    pg8::gemm_phase<pg8::EpiSwiglu, pg8::StaticOrder, true, true>(F.lds + RING_OFF, g, S, E, F.wave); }
                SEAM();
                if (RUN()) { pg8::Gemm g{GH, (const bf16*)(F.ws + WS_WE) + (size_t)2 * DFFE * D, M, D, DFFE}; pg8::StaticOrder S; S.init(M, D, F.G, (int)blockIdx.x);
                    pg8::EpiResid E{X, X, D, GSEL + e, NEXP, nullptr, nullptr};
                    pg8::gemm_phase<pg8::EpiResid, pg8::StaticOrder, true, true>(F.lds + RING_OFF, g, S, E, F.wave); }
                SEAM();
            }
#else
            if (RUN()) { phase_moe_route(F); conv_queue(F, in, 0, QN0, -1, 0u); }
            SEAM();
            if (RUN()) { pg8::Gemm g{(const bf16*)(F.ws + WS_XG), (const bf16*)(F.ws + WS_WE), MOE_MAXROWS, 2 * DFFE, D / 2};
                const int ntr_ = moe_ntiles(F); pg8::MoeOrder S{moe_tile_table(F, ntr_), ntr_, 2 * DFFE / 256, 2 * DFFE / 256, F.G, (int)blockIdx.x};
                pg8::EpiSwiglu E{(bf16*)(F.ws + WS_GHH), DFFE, nullptr, 1.0f / W13_F8SCALE, GH_F8SCALE};
                pg8::gemm_phase<pg8::EpiSwiglu, pg8::MoeOrder, true, true, true>(F.lds + RING_OFF, g, S, E, F.wave); }
            SEAM();
            if (RUN()) { pg8::Gemm g{(const bf16*)(F.ws + WS_GHH), (const bf16*)(F.ws + WS_WE + (size_t)NEXP * 2 * DFFE * D), MOE_MAXROWS, D, DFFE / 2};
                const int ntr_ = moe_ntiles(F); pg8::MoeOrder S{moe_tile_table(F, ntr_), ntr_, D / 256, D / 256, F.G, (int)blockIdx.x};
                pg8::EpiY<false> E{(bf16*)(F.ws + WS_Y), D, 1.0f / (W2_F8SCALE * GH_F8SCALE)}; pg8::gemm_phase<pg8::EpiY<false>, pg8::MoeOrder, true, true, true>(F.lds + RING_OFF, g, S, E, F.wave); }
            SEAM();
#endif
        }
        if (l == 1) {
            if (RUN()) { if (!MOE_NAIVE) phase_norm<3>(F, X, in.p[I_GPLE] + l * D, HB, nullptr, 0, nullptr, nullptr, nullptr, nullptr);
                else phase_norm<0>(F, X, in.p[I_GPLE] + l * D, HB, nullptr, 0, nullptr, nullptr, nullptr, nullptr); }
            SEAM();
        }
        if (RUN()) {
            { pg8::Gemm g{(const bf16*)(F.ws + WS_PB) + (size_t)l * M * PLE, (const bf16*)(F.ws + WS_WPP) + (size_t)l * D * PLE, M, D, PLE}; pg8::StaticOrder S; S.init(M, D, F.G, (int)blockIdx.x);
              pg8::EpiF32 E{PP, D};
              pg8::gemm_phase<pg8::EpiF32, pg8::StaticOrder, true, true>(F.lds + RING_OFF, g, S, E, F.wave); }
            { pg8::Gemm g{(l == 0) ? XB : HB, (const bf16*)(F.ws + WS_WPG) + (size_t)l * D * D, M, D, D}; pg8::StaticOrder S; S.init(M, D, F.G, (int)blockIdx.x);
              pg8::EpiPle2 E{PP, X, D, (l == 0) ? (const pg8::ssq_t*)(SSACC + M) : nullptr, (l == 0) ? XB2 : nullptr, (l == 0) ? SSACC + 2 * M : nullptr};
              pg8::gemm_phase<pg8::EpiPle2, pg8::StaticOrder, true, true>(F.lds + RING_OFF, g, S, E, F.wave); }
        }
        SEAM();
    }
#undef RUN
#undef HB
#undef PROJ
#undef YA
#undef YB
#undef MIXED
#undef TMP
#undef GH
#undef PP
#undef IFPRE
#undef GSEL
#undef XB
#undef XB2
#undef SSACC
#undef SEAM
}
constexpr int N_PHASES = 1 + (5 + 2 + 1) + (5 + 1 + (MOE_NAIVE ? 3 * NEXP : 3) + 2);

extern "C" void kernel_launch(void* const* d_in, const int* in_sizes, int n_in, void* d_out, int out_size, void* d_ws, size_t ws_size, hipStream_t stream) {
    static int grid = 0;
    if (grid == 0) {
        if (n_in != 25 || in_sizes[0] != M * D || out_size != M * D || ws_size < WS_END) { fprintf(stderr, "kernel_launch: unexpected shapes / workspace (n_in %d, ws %zu); nothing launched\n", n_in, ws_size); grid = -1; return; }
        int dev = 0, cus = 0, per_cu = 0;
        if (hipGetDevice(&dev) != hipSuccess || hipDeviceGetAttribute(&cus, hipDeviceAttributeMultiprocessorCount, dev) != hipSuccess) { grid = -1; return; }
        if (hipFuncSetAttribute((const void*)mega_fwd, hipFuncAttributeMaxDynamicSharedMemorySize, LDS_BYTES) != hipSuccess) { grid = -1; return; }
        if (hipOccupancyMaxActiveBlocksPerMultiprocessor(&per_cu, (const void*)mega_fwd, NTHR, LDS_BYTES) != hipSuccess || per_cu < 1) { fprintf(stderr, "kernel_launch: occupancy query reports %d\n", per_cu); }
        (void)hipGetLastError();
        grid = cus;
    }
    if (grid < 0) return;
    if (hipMemsetAsync((char*)d_ws + WS_CTL, 0, CTL_ZERO_BYTES, stream) != hipSuccess) return;
    Args a{};
    for (int i = 0; i < 25; ++i) a.in.p[i] = (const float*)d_in[i];
    a.out = (float*)d_out; a.ws = (unsigned char*)d_ws;
#if MK_PER_PHASE
    for (int li = 0; li < N_PHASES; ++li) { a.ph_lo = li; a.ph_hi = li + 1; a.li = 0; hipLaunchKernelGGL(mega_fwd, dim3(grid), dim3(NTHR), LDS_BYTES, stream, a); }
#else
    a.ph_lo = 0; a.ph_hi = N_PHASES; a.li = 0;
    hipLaunchKernelGGL(mega_fwd, dim3(grid), dim3(NTHR), LDS_BYTES, stream, a);
#endif
}
```

```cpp
#include <hip/hip_runtime.h>
#include <cstdio>
#include <cstdint>
#include <cmath>
namespace pg8 {
#define PG8_LAS __attribute__((address_space(3)))
typedef unsigned short bf16_t;
typedef short bf16x8 __attribute__((ext_vector_type(8)));
typedef float f32x4 __attribute__((ext_vector_type(4)));
typedef unsigned u32x4 __attribute__((ext_vector_type(4)));
typedef int v8i32 __attribute__((ext_vector_type(8)));
typedef int v4i32 __attribute__((ext_vector_type(4)));
constexpr int BM = 256, BK = 64, HALF = 128, HTB = HALF * BK * 2  , STAGE_BYTES = 8 * HTB, NXCD = 8, WGM = 8;

__host__ __device__ __forceinline__ int lds_byte(int r, int c) { const int st = (r >> 4) * 2 + (c >> 5), rr = r & 15, cc = c & 31, ob = rr * 64 + cc * 2; return st * 1024 + (ob ^ (((ob >> 9) & 1) << 5)); }
__host__ __device__ __forceinline__ void stage_rc(int b, int& R, int& C) { const int st = b / 1024, sb = b % 1024, swz = sb ^ (((sb >> 9) & 1) << 5); R = (st >> 1) * 16 + swz / 64; C = (st & 1) * 32 + (swz % 64) / 2; }
__host__ __device__ __forceinline__ int perm32(int rho) { const int n = rho >> 4, i = rho & 15; return 8 * (i >> 2) + 4 * n + (i & 3); }

struct Unit { int pm, pn, pb; };
struct Gemm { const bf16_t* A; const bf16_t* Bt; int M, N, K; };

struct StaticOrder {
    int nM, nN, nwg, G, c;
    __host__ __device__ void init(int M, int N, int G_, int c_) { nM = M / BM; nN = N / BM; nwg = nM * nN; G = G_; c = c_; }
    __host__ __device__ bool next(int i, Unit& u) const {
        const long L = (long)i * G + c; if (L >= nwg) return false;
        int wgid = (int)L; { const int q = nwg / NXCD, r = nwg % NXCD, xcd = wgid % NXCD, off = wgid / NXCD; wgid = (xcd < r ? xcd * (q + 1) : r * (q + 1) + (xcd - r) * q) + off; }
        const int nig = WGM * nN, gid = wgid / nig, fm = gid * WGM, gsz = (nM - fm) < WGM ? (nM - fm) : WGM;
        u.pm = fm + ((wgid % nig) % gsz); u.pn = (wgid % nig) / gsz; u.pb = u.pn; return true;
    }
    __device__ __forceinline__ void a_ready(const Unit&) const {}
    __device__ __forceinline__ void done(const Unit&) const {}
};

__device__ __forceinline__ unsigned cvt_pk_bf16(float lo, float hi) { unsigned r; asm volatile("v_cvt_pk_bf16_f32 %0, %1, %2" : "=v"(r) : "v"(lo), "v"(hi)); return r; }
template <class Epi, class Sched, bool ALIGN_EPI = false, bool SP2 = false, bool F8 = false>
__device__ __forceinline__ void gemm_phase(PG8_LAS unsigned char* lds, const Gemm g, const Sched& S, const Epi& E, int wave_in) {
    int tid_; asm volatile("v_mbcnt_lo_u32_b32 %0, -1, 0\n\tv_mbcnt_hi_u32_b32 %0, -1, %0" : "=v"(tid_)); tid_ += 64 * wave_in;
    const int tid = tid_, wid = __builtin_amdgcn_readfirstlane(tid >> 6), lane = tid & 63, wr = wid >> 2, wc = wid & 3, fr = lane & 15, fq = lane >> 4;
    const int K = g.K, nt = K / BK;
    unsigned voffA[2], voffB[2];
#pragma unroll
    for (int i = 0; i < 2; ++i) { int R, C; stage_rc(tid * 16 + i * 8192, R, C); const int Rb = Epi::PERM ? ((R & ~31) + perm32(R & 31)) : R;
        voffA[i] = (unsigned)(R * K + C) * 2u; voffB[i] = (unsigned)(Rb * K + C) * 2u; }
    const size_t kstep = (size_t)(BK * 2);
    const size_t hstep = (size_t)HALF * K * 2;
    const size_t tstep = 2 * hstep;
    const unsigned ldsw = (unsigned)wid * 1024u;
    const int aoff = lds_byte(wr * 64 + fr, fq * 8), boff = lds_byte(wc * 32 + fr, fq * 8);
    const int aofk0 = F8 ? lds_byte(wr * 64 + fr, 16 * fq) : aoff, aofk1 = F8 ? lds_byte(wr * 64 + fr, 16 * fq + 8) : aoff + 1024, bofk0 = F8 ? lds_byte(wc * 32 + fr, 16 * fq) : boff, bofk1 = F8 ? lds_byte(wc * 32 + fr, 16 * fq + 8) : boff + 1024;
#define PG8_SA(b, h) (((b) * 2 + (h)) * HTB)
#define PG8_SB(b, h) ((4 + (b) * 2 + (h)) * HTB)
#define PG8_STAGE(bufoff, gbase, voff) do { _Pragma("unroll") for (int _i = 0; _i < 2; ++_i) \
        __builtin_amdgcn_global_load_lds((const unsigned*)((const char*)(gbase) + (voff)[_i]), (PG8_LAS unsigned*)(lds + (bufoff) + ldsw + _i * 8192), 16, 0, 0); } while (0)
#define PG8_LDA(dst, b, h) do { if constexpr (F8) { _Pragma("unroll") for (int m = 0; m < 4; ++m) { dst##8[m].lo = *(const PG8_LAS v4i32*)(lds + PG8_SA(b, h) + aofk0 + m * 2048); dst##8[m].hi = *(const PG8_LAS v4i32*)(lds + PG8_SA(b, h) + aofk1 + m * 2048); } } \
        else { _Pragma("unroll") for (int m = 0; m < 4; ++m) _Pragma("unroll") for (int k = 0; k < 2; ++k) dst[m][k] = *(const PG8_LAS bf16x8*)(lds + PG8_SA(b, h) + (k ? aofk1 : aofk0) + m * 2048); } } while (0)
#define PG8_LDB(dst, b, h) do { if constexpr (F8) { _Pragma("unroll") for (int n = 0; n < 2; ++n) { dst##8[n].lo = *(const PG8_LAS v4i32*)(lds + PG8_SB(b, h) + bofk0 + n * 2048); dst##8[n].hi = *(const PG8_LAS v4i32*)(lds + PG8_SB(b, h) + bofk1 + n * 2048); } } \
        else { _Pragma("unroll") for (int n = 0; n < 2; ++n) _Pragma("unroll") for (int k = 0; k < 2; ++k) dst[n][k] = *(const PG8_LAS bf16x8*)(lds + PG8_SB(b, h) + (k ? bofk1 : bofk0) + n * 2048); } } while (0)
#define PG8_MMA(ai, bj, At, Bt) do { __builtin_amdgcn_s_setprio(1); \
        if constexpr (F8) { _Pragma("unroll") for (int m = 0; m < 4; ++m) _Pragma("unroll") for (int n = 0; n < 2; ++n) \
            asm volatile("v_mfma_scale_f32_16x16x128_f8f6f4 %0, %1, %2, %0, %3, %3 op_sel_hi:[0,0,0]" : "+v"(acc[ai][bj][m][n]) : "v"(Bt##8[n]), "v"(At##8[m]), "v"(f8one)); } \
        else { _Pragma("unroll") for (int m = 0; m < 4; ++m) _Pragma("unroll") for (int n = 0; n < 2; ++n) _Pragma("unroll") for (int k = 0; k < 2; ++k) \
            acc[ai][bj][m][n] = __builtin_amdgcn_mfma_f32_16x16x32_bf16(Bt[n][k], At[m][k], acc[ai][bj][m][n], 0, 0, 0); } \
        __builtin_amdgcn_s_setprio(0); } while (0)
#define PG8_WAIT_V(n) asm volatile("s_waitcnt vmcnt(" #n ")" ::: "memory")
#define PG8_WAIT_L(n) asm volatile("s_waitcnt lgkmcnt(" #n ")" ::: "memory")
#define PG8_BAR __builtin_amdgcn_s_barrier()
#define PG8_SCHED __builtin_amdgcn_sched_barrier(0)
    Unit cur, nxt; int ui = 0;
    if (!S.next(0, cur)) return;
    typename Epi::Pre pre = E.prefetch(cur, wr, fr);
    f32x4 acc[2][2][4][2];
#pragma unroll
    for (int a = 0; a < 2; ++a)
#pragma unroll
        for (int b = 0; b < 2; ++b)
#pragma unroll
            for (int m = 0; m < 4; ++m)
#pragma unroll
                for (int n = 0; n < 2; ++n) acc[a][b][m][n] = (f32x4){0.f, 0.f, 0.f, 0.f};
    bf16x8 At[4][2], B0[2][2], B1[2][2];
    int f8one = 0x7f7f7f7f; asm volatile("" : "+v"(f8one));
    v8i32 At8[4], B08[2], B18[2];
    const char* cA = (const char*)g.A + (size_t)cur.pm * tstep; const char* cB = (const char*)g.Bt + (size_t)cur.pb * tstep;
    S.a_ready(cur);
    if constexpr (SP2) {
        PG8_STAGE(PG8_SB(0, 0), cB, voffB); PG8_STAGE(PG8_SB(0, 1), cB + hstep, voffB); PG8_STAGE(PG8_SA(0, 0), cA, voffA); PG8_STAGE(PG8_SA(0, 1), cA + hstep, voffA);
        if (wr == 1) PG8_BAR;
        PG8_WAIT_V(2); PG8_BAR;
        PG8_STAGE(PG8_SB(1, 0), cB + kstep, voffB); PG8_STAGE(PG8_SA(1, 0), cA + kstep, voffA); PG8_STAGE(PG8_SB(1, 1), cB + hstep + kstep, voffB);
        PG8_WAIT_V(6); PG8_BAR;
    } else {
        PG8_STAGE(PG8_SB(0, 0), cB, voffB); PG8_STAGE(PG8_SA(0, 0), cA, voffA); PG8_STAGE(PG8_SB(0, 1), cB + hstep, voffB); PG8_STAGE(PG8_SA(0, 1), cA + hstep, voffA);
        if (wr == 1) PG8_BAR;
        PG8_WAIT_V(4); PG8_BAR;
        PG8_STAGE(PG8_SB(1, 0), cB + kstep, voffB); PG8_STAGE(PG8_SA(1, 0), cA + kstep, voffA); PG8_STAGE(PG8_SB(1, 1), cB + hstep + kstep, voffB);
        PG8_WAIT_V(6); PG8_BAR;
    }
    for (;;) {
        const bool has_next = S.next(ui + 1, nxt);
        const char* nA = has_next ? (const char*)g.A + (size_t)nxt.pm * tstep : cA; const char* nB = has_next ? (const char*)g.Bt + (size_t)nxt.pb * tstep : cB;
        _Pragma("nounroll") for (int t = 0; t < nt; t += 2) {
            const bool last = (t == nt - 2);
            const char* a1 = cA + (size_t)(t + 1) * kstep;
            const char* a2 = last ? nA : cA + (size_t)(t + 2) * kstep; const char* b2 = last ? nB : cB + (size_t)(t + 2) * kstep;
            const char* a3 = a2 + kstep; const char* b3 = b2 + kstep;
            if (last && has_next) S.a_ready(nxt);
            if constexpr (Epi::MIDK) { if (t == Epi::MID_T) E.mid(acc, cur, wr, wc, fr, fq); }
            if constexpr (SP2) {
            PG8_LDB(B0, 0, 0); PG8_LDB(B1, 0, 1); PG8_SCHED; PG8_LDA(At, 0, 0); PG8_STAGE(PG8_SA(1, 1), a1 + hstep, voffA);
            PG8_WAIT_V(8); PG8_WAIT_L(0); PG8_BAR; PG8_MMA(0, 0, At, B0); PG8_MMA(0, 1, At, B1); PG8_BAR; PG8_SCHED;
            PG8_LDA(At, 0, 1); PG8_STAGE(PG8_SB(0, 0), b2, voffB); PG8_STAGE(PG8_SB(0, 1), b2 + hstep, voffB); PG8_STAGE(PG8_SA(0, 0), a2, voffA);
            PG8_WAIT_V(8); PG8_WAIT_L(0); PG8_BAR; PG8_MMA(1, 0, At, B0); PG8_MMA(1, 1, At, B1); PG8_BAR; PG8_SCHED;
            PG8_LDB(B0, 1, 0); PG8_LDB(B1, 1, 1); PG8_SCHED; PG8_LDA(At, 1, 0); PG8_STAGE(PG8_SA(0, 1), a2 + hstep, voffA);
            PG8_WAIT_V(8); PG8_WAIT_L(0); PG8_BAR; PG8_MMA(0, 0, At, B0); PG8_MMA(0, 1, At, B1); PG8_BAR; PG8_SCHED;
            PG8_LDA(At, 1, 1); PG8_STAGE(PG8_SB(1, 0), b3, voffB); PG8_STAGE(PG8_SB(1, 1), b3 + hstep, voffB); PG8_STAGE(PG8_SA(1, 0), a3, voffA);
            PG8_WAIT_V(8); PG8_WAIT_L(0); PG8_BAR; PG8_MMA(1, 0, At, B0); PG8_MMA(1, 1, At, B1); PG8_BAR; PG8_SCHED;
            } else {
            PG8_LDB(B0, 0, 0); PG8_SCHED; PG8_LDA(At, 0, 0); PG8_STAGE(PG8_SA(1, 1), a1 + hstep, voffA);
            PG8_WAIT_L(8); PG8_BAR; PG8_WAIT_L(0); PG8_MMA(0, 0, At, B0); PG8_BAR; PG8_SCHED;
            PG8_LDB(B1, 0, 1); PG8_STAGE(PG8_SB(0, 0), b2, voffB);
            PG8_BAR; PG8_WAIT_L(0); PG8_MMA(0, 1, At, B1); PG8_BAR;
            PG8_LDA(At, 0, 1); PG8_STAGE(PG8_SA(0, 0), a2, voffA);
            PG8_BAR; PG8_WAIT_L(0); PG8_MMA(1, 0, At, B0); PG8_BAR; PG8_SCHED;
            PG8_STAGE(PG8_SB(0, 1), b2 + hstep, voffB);
            PG8_WAIT_V(6); PG8_BAR; PG8_MMA(1, 1, At, B1); PG8_BAR;
            PG8_LDB(B0, 1, 0); PG8_SCHED; PG8_LDA(At, 1, 0); PG8_STAGE(PG8_SA(0, 1), a2 + hstep, voffA);
            PG8_WAIT_L(8); PG8_BAR; PG8_WAIT_L(0); PG8_MMA(0, 0, At, B0); PG8_BAR; PG8_SCHED;
            PG8_LDB(B1, 1, 1); PG8_STAGE(PG8_SB(1, 0), b3, voffB);
            PG8_BAR; PG8_WAIT_L(0); PG8_MMA(0, 1, At, B1); PG8_BAR;
            PG8_LDA(At, 1, 1); PG8_STAGE(PG8_SA(1, 0), a3, voffA);
            PG8_BAR; PG8_WAIT_L(0); PG8_MMA(1, 0, At, B0); PG8_BAR; PG8_SCHED;
            PG8_STAGE(PG8_SB(1, 1), b3 + hstep, voffB);
            PG8_WAIT_V(6); PG8_BAR; PG8_MMA(1, 1, At, B1); PG8_BAR;
            }
        }
        if constexpr (ALIGN_EPI) { if (wr == 0) PG8_BAR; }
        if constexpr (F8) asm volatile("s_nop 15\n\ts_nop 15" ::: "memory");
        if constexpr (!Epi::AFTER_DRAIN) { E(acc, cur, wr, wc, fr, fq, pre); S.done(cur); }
        if (!has_next) break;
#pragma unroll
        for (int a = 0; a < 2; ++a)
#pragma unroll
            for (int b = 0; b < 2; ++b)
#pragma unroll
                for (int m = 0; m < 4; ++m)
#pragma unroll
                    for (int n = 0; n < 2; ++n) acc[a][b][m][n] = (f32x4){0.f, 0.f, 0.f, 0.f};
        cur = nxt; cA = nA; cB = nB; ++ui; pre = E.prefetch(cur, wr, fr);
        if constexpr (ALIGN_EPI) { if (wr == 1) PG8_BAR; }
    }
    PG8_WAIT_V(0);
    if constexpr (!ALIGN_EPI) { if (wr == 0) PG8_BAR; }
    PG8_BAR;
    if constexpr (Epi::AFTER_DRAIN) { E.fused(acc, cur, wr, wc, fr, fq, lds, wid, lane); S.done(cur); }
#undef PG8_SA
#undef PG8_SB
#undef PG8_STAGE
#undef PG8_LDA
#undef PG8_LDB
#undef PG8_MMA
#undef PG8_WAIT_V
#undef PG8_WAIT_L
#undef PG8_BAR
#undef PG8_SCHED
}
}
namespace pg8 {
#define PG8_GAS __attribute__((address_space(1)))
typedef unsigned u32x2 __attribute__((ext_vector_type(2)));
__device__ __forceinline__ float ex2(float x) { return __builtin_amdgcn_exp2f(x); }
__device__ __forceinline__ float sigm(float x) { return __builtin_amdgcn_rcpf(1.0f + ex2(-1.4426950408889634f * x)); }
__device__ __forceinline__ float bflo(unsigned w) { return __uint_as_float(w << 16); }
__device__ __forceinline__ float bfhi(unsigned w) { return __uint_as_float(w & 0xffff0000u); }

typedef unsigned ssq_t;
__device__ __forceinline__ ssq_t ss_fix(float v) { return (ssq_t)(v * 1024.0f); }
__device__ __forceinline__ float rstd_fix(ssq_t s) { return __builtin_amdgcn_rsqf((float)s * (1.0f / (1024.0f * 1024.0f)) + 1e-6f); }
struct NoPre { struct Pre {}; __device__ __forceinline__ Pre prefetch(const Unit&, int, int) const { return Pre{}; } };
struct SsPre { struct Pre { ssq_t s[8]; };
    __device__ __forceinline__ static Pre load(const ssq_t* ss, const Unit& u, int wr, int fr) { Pre p;
#pragma unroll
        for (int i = 0; i < 8; ++i) p.s[i] = ss ? ss[u.pm * BM + wr * 64 + fr + (i >> 2) * HALF + (i & 3) * 16] : 0u;
        return p; } };
__device__ __forceinline__ float quad_sum(float v, int fr, int fq) {
    const int lane = fr + 16 * fq;
    v += __int_as_float(__builtin_amdgcn_ds_bpermute((lane ^ 16) << 2, __float_as_int(v)));
    v += __int_as_float(__builtin_amdgcn_ds_bpermute((lane ^ 32) << 2, __float_as_int(v)));
    return v;
}
struct EpiQK {
    static constexpr bool PERM = true, AFTER_DRAIN = false, MIDK = false; typedef SsPre::Pre Pre;
    bf16_t* O; unsigned ldc; const ssq_t* ss; const float* g_q; const float* g_k; float* kmp; float qscale;
    __device__ __forceinline__ Pre prefetch(const Unit& u, int wr, int fr) const { return SsPre::load(ss, u, wr, fr); }
    __device__ __forceinline__ void operator()(const f32x4 (&acc)[2][2][4][2], const Unit& u, int wr, int wc, int fr_, int fq_, const Pre& pre) const {
        int fr = fr_, fq = fq_; asm volatile("" : "+v"(fr), "+v"(fq));
        const bool isq = u.pn < 2; const float* gg = (isq ? g_q : g_k) + 8 * fq; const float osc = isq ? qscale : 1.0f;
        f32x4 gn[2][2], cs[2][2];
#pragma unroll
        for (int bj = 0; bj < 2; ++bj)
#pragma unroll
            for (int n = 0; n < 2; ++n) { gn[bj][n] = *(const f32x4*)(gg + 32 * bj + 4 * n); cs[bj][n] = (f32x4){0.f, 0.f, 0.f, 0.f}; }
        const unsigned obase = (unsigned)(u.pm * BM + wr * 64 + fr) * ldc + (unsigned)(u.pn * BM + wc * 64 + 8 * fq);
#pragma unroll
        for (int ai = 0; ai < 2; ++ai)
#pragma unroll
            for (int m = 0; m < 4; ++m) { const float rs = rstd_fix(pre.s[ai * 4 + m]);
                float q2 = 0.f;
#pragma unroll
                for (int bj = 0; bj < 2; ++bj)
#pragma unroll
                    for (int n = 0; n < 2; ++n) { const f32x4 a = acc[ai][bj][m][n]; q2 += (a[0] * a[0] + a[1] * a[1]) + (a[2] * a[2] + a[3] * a[3]); }
                q2 = quad_sum(q2, fr, fq);
                const float rr = rs * __builtin_amdgcn_rsqf(rs * rs * q2 * (1.0f / 64.0f) + 1e-6f) * osc;
                const unsigned off = obase + (unsigned)(ai * HALF + m * 16) * ldc;
#pragma unroll
                for (int bj = 0; bj < 2; ++bj) { const f32x4 o0 = acc[ai][bj][m][0] * (gn[bj][0] * rr), o1 = acc[ai][bj][m][1] * (gn[bj][1] * rr); cs[bj][0] += o0; cs[bj][1] += o1;
                    u32x4 w; w.x = cvt_pk_bf16(o0[0], o0[1]); w.y = cvt_pk_bf16(o0[2], o0[3]); w.z = cvt_pk_bf16(o1[0], o1[1]); w.w = cvt_pk_bf16(o1[2], o1[3]);
                    *(u32x4*)(O + off + 32 * bj) = w; }
                asm volatile("" : "+v"(cs[0][0]), "+v"(cs[0][1]), "+v"(cs[1][0]), "+v"(cs[1][1]));
                __builtin_amdgcn_sched_barrier(0); }
        if (!isq) {
            const int lane = fr + 16 * fq;
#pragma unroll
            for (int o = 1; o < 16; o <<= 1)
#pragma unroll
                for (int bj = 0; bj < 2; ++bj)
#pragma unroll
                    for (int n = 0; n < 2; ++n)
#pragma unroll
                        for (int j = 0; j < 4; ++j) cs[bj][n][j] += __int_as_float(__builtin_amdgcn_ds_bpermute((lane ^ o) << 2, __float_as_int(cs[bj][n][j])));
            if (fr == 0) { float* kp = kmp + ((((unsigned)(u.pm >> 4) * 8 + (u.pn & 1) * 4 + wc) * 16 + (u.pm & 15)) * 2 + wr) * 64 + 8 * fq;
#pragma unroll
                for (int bj = 0; bj < 2; ++bj) { *(f32x4*)(kp + 32 * bj) = cs[bj][0]; *(f32x4*)(kp + 32 * bj + 4) = cs[bj][1]; } }
        }
    }
};
struct EpiProj {
    static constexpr bool PERM = true, AFTER_DRAIN = false, MIDK = false; typedef SsPre::Pre Pre;
    bf16_t* O; int ldc; int sig_from; const ssq_t* ss; int gate_tile; float* ifpre; const float* b_i; const float* b_f; bf16_t* GT; int pn0;
    __device__ __forceinline__ Pre prefetch(const Unit& u, int wr, int fr) const { return SsPre::load(ss, u, wr, fr); }
    __device__ __forceinline__ void operator()(const f32x4 (&acc)[2][2][4][2], const Unit& u_, int wr, int wc, int fr, int fq, const Pre& pre) const {
        Unit u = u_; u.pn += pn0;
        const int row0 = u.pm * BM + wr * 64 + fr, col0 = u.pn * BM + wc * 32 + 8 * fq; const bool sg = u.pn >= sig_from;
        if (u.pn == gate_tile) {
            if (wc == 0 && fq == 0) { const f32x4 bi = *(const f32x4*)b_i, bf = *(const f32x4*)b_f;
#pragma unroll
                for (int ai = 0; ai < 2; ++ai)
#pragma unroll
                    for (int m = 0; m < 4; ++m) { const int r = row0 + ai * HALF + m * 16; const float rs = rstd_fix(pre.s[ai * 4 + m]);
                        *(f32x4*)(ifpre + (size_t)r * 8) = acc[ai][0][m][0] * rs + bi; *(f32x4*)(ifpre + (size_t)r * 8 + 4) = acc[ai][0][m][1] * rs + bf; } }
            return; }
#pragma unroll
        for (int ai = 0; ai < 2; ++ai)
#pragma unroll
            for (int m = 0; m < 4; ++m) { const int r = row0 + ai * HALF + m * 16; bf16_t* rowp = O + (size_t)r * ldc + col0; const float rs = rstd_fix(pre.s[ai * 4 + m]);
#pragma unroll
                for (int bj = 0; bj < 2; ++bj) { f32x4 v0 = acc[ai][bj][m][0] * rs, v1 = acc[ai][bj][m][1] * rs;
                    if (sg) {
#pragma unroll
                        for (int j = 0; j < 4; ++j) { v0[j] = sigm(v0[j]); v1[j] = sigm(v1[j]); } }
                    u32x4 w; w.x = cvt_pk_bf16(v0[0], v0[1]); w.y = cvt_pk_bf16(v0[2], v0[3]); w.z = cvt_pk_bf16(v1[0], v1[1]); w.w = cvt_pk_bf16(v1[2], v1[3]);
                    if (sg) *(u32x4*)(GT + ((((size_t)u.pm * 8 + (u.pn - sig_from)) * 16 + (ai * 8 + m * 2 + bj)) * 8 + (wr * 4 + wc)) * 512 + (fr + 16 * fq) * 8) = w;
                    else *(u32x4*)(rowp + bj * HALF) = w; } }
    }
};
struct EpiSwiglu {
    static constexpr bool PERM = true, AFTER_DRAIN = false, MIDK = false; typedef SsPre::Pre Pre;
    bf16_t* O; int ldc; const ssq_t* ss; float osc; float f8out;
    __device__ __forceinline__ Pre prefetch(const Unit& u, int wr, int fr) const { return SsPre::load(ss, u, wr, fr); }
    __device__ __forceinline__ void operator()(const f32x4 (&acc)[2][2][4][2], const Unit& u, int wr, int wc, int fr_, int fq_, const Pre& pre) const {
        int fr = fr_, fq = fq_; asm volatile("" : "+v"(fr), "+v"(fq));
        const unsigned obase = (unsigned)(u.pm * BM + wr * 64 + fr) * (unsigned)ldc + (unsigned)(u.pn * HALF + wc * 32 + 8 * fq);
#pragma unroll
        for (int ai = 0; ai < 2; ++ai)
#pragma unroll
            for (int m = 0; m < 4; ++m) { bf16_t* rowp = O + (obase + (unsigned)(ai * HALF + m * 16) * (unsigned)ldc); const float rs = (ss ? rstd_fix(pre.s[ai * 4 + m]) : 1.0f) * osc;
                const float nl = -1.4426950408889634f * rs, ic = __builtin_amdgcn_rcpf(rs * rs * (f8out != 0.f ? f8out : 1.0f));
                f32x4 v0, v1;
#pragma unroll
                for (int j = 0; j < 4; ++j) { const float g0 = acc[ai][0][m][0][j], g1 = acc[ai][0][m][1][j];
                    v0[j] = (g0 * acc[ai][1][m][0][j]) * __builtin_amdgcn_rcpf(fmaf(ex2(g0 * nl), ic, ic)); v1[j] = (g1 * acc[ai][1][m][1][j]) * __builtin_amdgcn_rcpf(fmaf(ex2(g1 * nl), ic, ic)); }
                if (f8out != 0.f) {
#pragma unroll
                    for (int j = 0; j < 4; ++j) { v0[j] = __builtin_amdgcn_fmed3f(v0[j], -448.0f, 448.0f); v1[j] = __builtin_amdgcn_fmed3f(v1[j], -448.0f, 448.0f); }
                    int a_ = __builtin_amdgcn_cvt_pk_fp8_f32(v0[0], v0[1], 0, false); a_ = __builtin_amdgcn_cvt_pk_fp8_f32(v0[2], v0[3], a_, true);
                    int b_ = __builtin_amdgcn_cvt_pk_fp8_f32(v1[0], v1[1], 0, false); b_ = __builtin_amdgcn_cvt_pk_fp8_f32(v1[2], v1[3], b_, true);
                    u32x2 w8; w8.x = (unsigned)a_; w8.y = (unsigned)b_; *(u32x2*)((unsigned char*)O + (obase + (unsigned)(ai * HALF + m * 16) * (unsigned)ldc)) = w8; }
                else { u32x4 w; w.x = cvt_pk_bf16(v0[0], v0[1]); w.y = cvt_pk_bf16(v0[2], v0[3]); w.z = cvt_pk_bf16(v1[0], v1[1]); w.w = cvt_pk_bf16(v1[2], v1[3]);
                    *(u32x4*)rowp = w; } }
    }
};
struct EpiResid {
    static constexpr bool PERM = true, AFTER_DRAIN = false, MIDK = false; typedef NoPre::Pre Pre; __device__ __forceinline__ Pre prefetch(const Unit&, int, int) const { return Pre{}; }
    const float* base; float* out; int ldc; const float* rowscale; int rs_ld; bf16_t* xb; ssq_t* ssacc;
    __device__ __forceinline__ void operator()(const f32x4 (&acc)[2][2][4][2], const Unit& u, int wr, int wc, int fr_, int fq_, const Pre&) const {
        int fr = fr_, fq = fq_; asm volatile("" : "+v"(fr), "+v"(fq));
        const int row0 = u.pm * BM + wr * 64 + fr, col0 = u.pn * BM + wc * 32 + 8 * fq;
        const PG8_GAS float* gb_ = (const PG8_GAS float*)base;
        f32x4 bv[2][4][2][2];
#define PG8_RESID_LOAD(ai) do { _Pragma("unroll") for (int m = 0; m < 4; ++m) _Pragma("unroll") for (int bj = 0; bj < 2; ++bj) { const size_t off = (size_t)(row0 + (ai) * HALF + m * 16) * ldc + col0 + bj * HALF; \
            bv[ai][m][bj][0] = *(const PG8_GAS f32x4*)(gb_ + off); bv[ai][m][bj][1] = *(const PG8_GAS f32x4*)(gb_ + off + 4); } __builtin_amdgcn_sched_barrier(0); } while (0)
#define PG8_RESID_STEP(ai, m) do { const int r = row0 + (ai) * HALF + (m) * 16; const float s = rowscale ? rowscale[(size_t)r * rs_ld] : 1.0f; float part = 0.f; \
            _Pragma("unroll") for (int bj = 0; bj < 2; ++bj) { const size_t off = (size_t)r * ldc + col0 + bj * HALF; \
                const f32x4 v0 = bv[ai][m][bj][0] + acc[ai][bj][m][0] * s, v1 = bv[ai][m][bj][1] + acc[ai][bj][m][1] * s; \
                *(PG8_GAS f32x4*)((PG8_GAS float*)out + off) = v0; *(PG8_GAS f32x4*)((PG8_GAS float*)out + off + 4) = v1; \
                if (xb) { u32x4 w; w.x = cvt_pk_bf16(v0[0], v0[1]); w.y = cvt_pk_bf16(v0[2], v0[3]); w.z = cvt_pk_bf16(v1[0], v1[1]); w.w = cvt_pk_bf16(v1[2], v1[3]); *(PG8_GAS u32x4*)((PG8_GAS bf16_t*)xb + off) = w; } \
                part += (v0[0] * v0[0] + v0[1] * v0[1]) + (v0[2] * v0[2] + v0[3] * v0[3]) + (v1[0] * v1[0] + v1[1] * v1[1]) + (v1[2] * v1[2] + v1[3] * v1[3]); } \
            if (ssacc) { part = quad_sum(part, fr, fq); if (fq == 0) __hip_atomic_fetch_add((PG8_GAS ssq_t*)ssacc + r, ss_fix(part), __ATOMIC_RELAXED, __HIP_MEMORY_SCOPE_AGENT); } } while (0)
        PG8_RESID_LOAD(0);
        PG8_RESID_STEP(0, 0); PG8_RESID_STEP(0, 1); __builtin_amdgcn_sched_barrier(0);
        PG8_RESID_LOAD(1);
        PG8_RESID_STEP(0, 2); PG8_RESID_STEP(0, 3); PG8_RESID_STEP(1, 0); PG8_RESID_STEP(1, 1); PG8_RESID_STEP(1, 2); PG8_RESID_STEP(1, 3);
#undef PG8_RESID_LOAD
#undef PG8_RESID_STEP
    }
};
struct EpiMerge {
    static constexpr bool PERM = true, AFTER_DRAIN = false, MIDK = true; static constexpr int MID_T = 8; typedef NoPre::Pre Pre; __device__ __forceinline__ Pre prefetch(const Unit&, int, int) const { return Pre{}; }
    const bf16_t* GT; bf16_t* O; int ldc;
    __device__ __forceinline__ void mid(f32x4 (&acc)[2][2][4][2], const Unit& u, int wr, int wc, int fr_, int fq_) const {
        int fr = fr_, fq = fq_; asm volatile("" : "+v"(fr), "+v"(fq));
        const PG8_GAS bf16_t* ga_ = (const PG8_GAS bf16_t*)GT + ((size_t)u.pm * 8 + u.pn) * 65536 + (size_t)(wr * 4 + wc) * 512 + (fr + 16 * fq) * 8;
#pragma unroll
        for (int ai = 0; ai < 2; ++ai) { u32x4 ga[4][2], gb[4][2];
#pragma unroll
            for (int m = 0; m < 4; ++m)
#pragma unroll
                for (int bj = 0; bj < 2; ++bj) { const size_t fo = (size_t)(ai * 8 + m * 2 + bj) * 4096; ga[m][bj] = *(const PG8_GAS u32x4*)(ga_ + fo); gb[m][bj] = *(const PG8_GAS u32x4*)(ga_ + 4 * 65536 + fo); }
            __builtin_amdgcn_sched_barrier(0);
#pragma unroll
            for (int m = 0; m < 4; ++m)
#pragma unroll
                for (int bj = 0; bj < 2; ++bj) { const u32x4 a = ga[m][bj], b = gb[m][bj];
                    const f32x4 a0 = {bflo(a.x), bfhi(a.x), bflo(a.y), bfhi(a.y)}, a1 = {bflo(a.z), bfhi(a.z), bflo(a.w), bfhi(a.w)}, b0 = {bflo(b.x), bfhi(b.x), bflo(b.y), bfhi(b.y)}, b1 = {bflo(b.z), bfhi(b.z), bflo(b.w), bfhi(b.w)};
#pragma unroll
                    for (int j = 0; j < 4; ++j) { acc[ai][bj][m][0][j] *= a0[j] * __builtin_amdgcn_rcpf(fmaxf(b0[j], 1e-30f)); acc[ai][bj][m][1][j] *= a1[j] * __builtin_amdgcn_rcpf(fmaxf(b1[j], 1e-30f)); } }
            __builtin_amdgcn_sched_barrier(0); }
    }
    __device__ __forceinline__ void operator()(const f32x4 (&acc)[2][2][4][2], const Unit& u, int wr, int wc, int fr_, int fq_, const Pre&) const {
        int fr = fr_, fq = fq_; asm volatile("" : "+v"(fr), "+v"(fq));
        const int row0 = u.pm * BM + wr * 64 + fr, col0 = u.pn * BM + wc * 32 + 8 * fq;
        const PG8_GAS bf16_t* gb_ = (const PG8_GAS bf16_t*)GT + ((size_t)u.pm * 8 + 4 + u.pn) * 65536 + (size_t)(wr * 4 + wc) * 512 + (fr + 16 * fq) * 8;
        u32x4 gb[2][4][2];
#pragma unroll
        for (int ai = 0; ai < 2; ++ai)
#pragma unroll
            for (int m = 0; m < 4; ++m)
#pragma unroll
                for (int bj = 0; bj < 2; ++bj) gb[ai][m][bj] = *(const PG8_GAS u32x4*)(gb_ + (size_t)(ai * 8 + m * 2 + bj) * 4096);
        __builtin_amdgcn_sched_barrier(0);
#pragma unroll
        for (int ai = 0; ai < 2; ++ai)
#pragma unroll
            for (int m = 0; m < 4; ++m) { const size_t r = (size_t)(row0 + ai * HALF + m * 16);
#pragma unroll
                for (int bj = 0; bj < 2; ++bj) { const u32x4 b = gb[ai][m][bj];
                    const f32x4 b0 = {bflo(b.x), bfhi(b.x), bflo(b.y), bfhi(b.y)}, b1 = {bflo(b.z), bfhi(b.z), bflo(b.w), bfhi(b.w)};
                    const f32x4 v0 = acc[ai][bj][m][0] * b0, v1 = acc[ai][bj][m][1] * b1;
                    u32x4 w; w.x = cvt_pk_bf16(v0[0], v0[1]); w.y = cvt_pk_bf16(v0[2], v0[3]); w.z = cvt_pk_bf16(v1[0], v1[1]); w.w = cvt_pk_bf16(v1[2], v1[3]);
                    *(PG8_GAS u32x4*)((PG8_GAS bf16_t*)O + r * ldc + col0 + bj * HALF) = w; } }
    }
};
struct EpiGate1 {
    static constexpr bool PERM = true, AFTER_DRAIN = false, MIDK = false; typedef NoPre::Pre Pre; __device__ __forceinline__ Pre prefetch(const Unit&, int, int) const { return Pre{}; }
    const bf16_t* G; int ldg; bf16_t* T; int ldc;
    __device__ __forceinline__ void operator()(const f32x4 (&acc)[2][2][4][2], const Unit& u, int wr, int wc, int fr, int fq, const Pre&) const {
        const int row0 = u.pm * BM + wr * 64 + fr, col0 = u.pn * BM + wc * 32 + 8 * fq;
#pragma unroll
        for (int ai = 0; ai < 2; ++ai)
#pragma unroll
            for (int m = 0; m < 4; ++m) { const size_t r = (size_t)(row0 + ai * HALF + m * 16);
#pragma unroll
                for (int bj = 0; bj < 2; ++bj) { const u32x4 g = *(const u32x4*)(G + r * ldg + col0 + bj * HALF);
                    f32x4 g0 = {bflo(g.x), bfhi(g.x), bflo(g.y), bfhi(g.y)}, g1 = {bflo(g.z), bfhi(g.z), bflo(g.w), bfhi(g.w)};
                    const f32x4 t0 = g0 * acc[ai][bj][m][0], t1 = g1 * acc[ai][bj][m][1];
                    u32x4 w; w.x = cvt_pk_bf16(t0[0], t0[1]); w.y = cvt_pk_bf16(t0[2], t0[3]); w.z = cvt_pk_bf16(t1[0], t1[1]); w.w = cvt_pk_bf16(t1[2], t1[3]);
                    *(u32x4*)(T + r * ldc + col0 + bj * HALF) = w; } }
    }
};
struct EpiGate2 {
    static constexpr bool PERM = true, AFTER_DRAIN = false, MIDK = false; typedef NoPre::Pre Pre; __device__ __forceinline__ Pre prefetch(const Unit&, int, int) const { return Pre{}; }
    const bf16_t* G; int ldg; const bf16_t* T; bf16_t* O; int ldc;
    __device__ __forceinline__ void operator()(const f32x4 (&acc)[2][2][4][2], const Unit& u, int wr, int wc, int fr, int fq, const Pre&) const {
        const int row0 = u.pm * BM + wr * 64 + fr, col0 = u.pn * BM + wc * 32 + 8 * fq;
#pragma unroll
        for (int ai = 0; ai < 2; ++ai)
#pragma unroll
            for (int m = 0; m < 4; ++m) { const size_t r = (size_t)(row0 + ai * HALF + m * 16);
#pragma unroll
                for (int bj = 0; bj < 2; ++bj) { const u32x4 g = *(const u32x4*)(G + r * ldg + col0 + bj * HALF);
                    f32x4 g0 = {bflo(g.x), bfhi(g.x), bflo(g.y), bfhi(g.y)}, g1 = {bflo(g.z), bfhi(g.z), bflo(g.w), bfhi(g.w)};
                    const u32x4 tt = *(const u32x4*)(T + r * ldc + col0 + bj * HALF);
                    const f32x4 v0 = (f32x4){bflo(tt.x), bfhi(tt.x), bflo(tt.y), bfhi(tt.y)} + g0 * acc[ai][bj][m][0], v1 = (f32x4){bflo(tt.z), bfhi(tt.z), bflo(tt.w), bfhi(tt.w)} + g1 * acc[ai][bj][m][1];
                    u32x4 w; w.x = cvt_pk_bf16(v0[0], v0[1]); w.y = cvt_pk_bf16(v0[2], v0[3]); w.z = cvt_pk_bf16(v1[0], v1[1]); w.w = cvt_pk_bf16(v1[2], v1[3]);
                    *(u32x4*)(O + r * ldc + col0 + bj * HALF) = w; } }
    }
};
struct EpiF32 {
    static constexpr bool PERM = true, AFTER_DRAIN = false, MIDK = false; typedef NoPre::Pre Pre; __device__ __forceinline__ Pre prefetch(const Unit&, int, int) const { return Pre{}; }
    bf16_t* O; int ldc;
    __device__ __forceinline__ void operator()(const f32x4 (&acc)[2][2][4][2], const Unit& u, int wr, int wc, int fr, int fq, const Pre&) const {
        const int row0 = u.pm * BM + wr * 64 + fr, col0 = u.pn * BM + wc * 32 + 8 * fq;
#pragma unroll
        for (int ai = 0; ai < 2; ++ai)
#pragma unroll
            for (int m = 0; m < 4; ++m)
#pragma unroll
                for (int bj = 0; bj < 2; ++bj) { const f32x4 v0 = acc[ai][bj][m][0], v1 = acc[ai][bj][m][1]; u32x4 w; w.x = cvt_pk_bf16(v0[0], v0[1]); w.y = cvt_pk_bf16(v0[2], v0[3]); w.z = cvt_pk_bf16(v1[0], v1[1]); w.w = cvt_pk_bf16(v1[2], v1[3]);
                    *(u32x4*)(O + (size_t)(row0 + ai * HALF + m * 16) * ldc + col0 + bj * HALF) = w; }
    }
};
struct EpiPle2 {
    static constexpr bool PERM = true, AFTER_DRAIN = false, MIDK = false; typedef NoPre::Pre Pre; __device__ __forceinline__ Pre prefetch(const Unit&, int, int) const { return Pre{}; }
    const bf16_t* PP; float* x; int ldc; const ssq_t* ss_in; bf16_t* xb; ssq_t* ssacc;
    __device__ __forceinline__ void operator()(const f32x4 (&acc)[2][2][4][2], const Unit& u, int wr, int wc, int fr_, int fq_, const Pre&) const {
        int fr = fr_, fq = fq_; asm volatile("" : "+v"(fr), "+v"(fq));
        const int row0 = u.pm * BM + wr * 64 + fr, col0 = u.pn * BM + wc * 32 + 8 * fq;
        const PG8_GAS float* gx_ = (const PG8_GAS float*)x; const PG8_GAS bf16_t* gp_ = (const PG8_GAS bf16_t*)PP;
        f32x4 xv[4][2][2][2]; u32x4 pv[4][2][2]; ssq_t sv[4][2];
#define PG8_PLE_LOAD(q) do { _Pragma("unroll") for (int mm = 0; mm < 2; ++mm) { sv[q][mm] = ss_in ? ((const PG8_GAS ssq_t*)ss_in)[row0 + ((q) >> 1) * HALF + (((q) & 1) * 2 + mm) * 16] : 0u; _Pragma("unroll") for (int bj = 0; bj < 2; ++bj) { const size_t off = (size_t)(row0 + ((q) >> 1) * HALF + (((q) & 1) * 2 + mm) * 16) * ldc + col0 + bj * HALF; \
            pv[q][mm][bj] = *(const PG8_GAS u32x4*)(gp_ + off); xv[q][mm][bj][0] = *(const PG8_GAS f32x4*)(gx_ + off); xv[q][mm][bj][1] = *(const PG8_GAS f32x4*)(gx_ + off + 4); } } __builtin_amdgcn_sched_barrier(0); } while (0)
#define PG8_PLE_STEP(q, mm) do { constexpr int ai = (q) >> 1, m = ((q) & 1) * 2 + (mm); const int r = row0 + ai * HALF + m * 16; ssq_t sq_ = sv[q][mm]; asm volatile("" : "+v"(sq_));   const float rs = ss_in ? rstd_fix(sq_) : 1.0f; float part = 0.f; \
            _Pragma("unroll") for (int bj = 0; bj < 2; ++bj) { const size_t off = (size_t)r * ldc + col0 + bj * HALF; \
                f32x4 a0 = acc[ai][bj][m][0] * rs, a1 = acc[ai][bj][m][1] * rs; \
                _Pragma("unroll") for (int j = 0; j < 4; ++j) { a0[j] = sigm(a0[j]); a1[j] = sigm(a1[j]); } \
                const u32x4 pw = pv[q][mm][bj]; \
                const f32x4 v0 = xv[q][mm][bj][0] + a0 * (f32x4){bflo(pw.x), bfhi(pw.x), bflo(pw.y), bfhi(pw.y)}, v1 = xv[q][mm][bj][1] + a1 * (f32x4){bflo(pw.z), bfhi(pw.z), bflo(pw.w), bfhi(pw.w)}; \
                *(PG8_GAS f32x4*)((PG8_GAS float*)x + off) = v0; *(PG8_GAS f32x4*)((PG8_GAS float*)x + off + 4) = v1; \
                if (xb) { u32x4 w; w.x = cvt_pk_bf16(v0[0], v0[1]); w.y = cvt_pk_bf16(v0[2], v0[3]); w.z = cvt_pk_bf16(v1[0], v1[1]); w.w = cvt_pk_bf16(v1[2], v1[3]); *(PG8_GAS u32x4*)((PG8_GAS bf16_t*)xb + off) = w; } \
                part += (v0[0] * v0[0] + v0[1] * v0[1]) + (v0[2] * v0[2] + v0[3] * v0[3]) + (v1[0] * v1[0] + v1[1] * v1[1]) + (v1[2] * v1[2] + v1[3] * v1[3]); } \
            if (ssacc) { part = quad_sum(part, fr, fq); if (fq == 0) __hip_atomic_fetch_add((PG8_GAS ssq_t*)ssacc + r, ss_fix(part), __ATOMIC_RELAXED, __HIP_MEMORY_SCOPE_AGENT); } } while (0)
        PG8_PLE_LOAD(0);
        PG8_PLE_STEP(0, 0); __builtin_amdgcn_sched_barrier(0);
        PG8_PLE_LOAD(1);
        PG8_PLE_STEP(0, 1); PG8_PLE_STEP(1, 0); __builtin_amdgcn_sched_barrier(0);
        PG8_PLE_LOAD(2);
        PG8_PLE_STEP(1, 1); PG8_PLE_STEP(2, 0); __builtin_amdgcn_sched_barrier(0);
        PG8_PLE_LOAD(3);
        PG8_PLE_STEP(2, 1); PG8_PLE_STEP(3, 0); PG8_PLE_STEP(3, 1);
#undef PG8_PLE_LOAD
#undef PG8_PLE_STEP
    }
};
}
#define GAS __attribute__((address_space(1)))
#define LAS __attribute__((address_space(3)))
typedef unsigned short bf16;
typedef unsigned v4u __attribute__((ext_vector_type(4)));
typedef float f32x4 __attribute__((ext_vector_type(4)));
typedef short bf16x8 __attribute__((ext_vector_type(8)));
typedef GAS unsigned gu32;
typedef GAS unsigned long long gu64;
#define RLX_AGENT __ATOMIC_RELAXED, __HIP_MEMORY_SCOPE_AGENT
#define LDS_WAIT() asm volatile("s_waitcnt lgkmcnt(0)" ::: "memory")
#define VM_WAIT() asm volatile("s_waitcnt vmcnt(0)" ::: "memory")
__device__ __forceinline__ unsigned long long rt() { return __builtin_amdgcn_s_memrealtime(); }
__device__ __forceinline__ unsigned f2bf(float f) { unsigned u = __builtin_bit_cast(unsigned, f); return (u + 0x7fffu + ((u >> 16) & 1u)) >> 16; }
__device__ __forceinline__ unsigned pk2(float lo, float hi) { return f2bf(lo) | (f2bf(hi) << 16); }

#define XB_TMO      128
#define XB_XCNT(j)  (256  + 64 * (j))
#define XB_XSUB(j)  (1280 + 64 * (j))
#define XB_XGEN(j)  (2304 + 64 * (j))
#define XB_TOP      3328
#define XB_TOPGEN   3392
#define XCD_BAR_WORDS 3456
#define XB_SPIN_CAP (1u << 18)

__device__ __forceinline__ unsigned xb_ld(unsigned* p)              { return __hip_atomic_load(p, __ATOMIC_RELAXED, __HIP_MEMORY_SCOPE_AGENT); }
__device__ __forceinline__ unsigned xb_add(unsigned* p, unsigned v) { return __hip_atomic_fetch_add(p, v, __ATOMIC_RELAXED, __HIP_MEMORY_SCOPE_AGENT); }
__device__ __forceinline__ unsigned xb_xcc_id() { return (unsigned)__builtin_amdgcn_s_getreg((3 << 11) | 20) & 0xFu; }
#define XB_SPIN(cond, bar) do { unsigned _sp = 0; while (cond) { __builtin_amdgcn_s_sleep(1); \
    if ((++_sp & 255u) == 0u) { if (xb_ld(&(bar)[XB_TMO])) break; if (_sp > XB_SPIN_CAP) { atomicAdd(&(bar)[XB_TMO], 1u); break; } } } } while (0)

__device__ __forceinline__ int lane_now() { int l; asm volatile("v_mbcnt_lo_u32_b32 %0, -1, 0\n\tv_mbcnt_hi_u32_b32 %0, -1, %0" : "=v"(l)); return l; }
struct XcdBarrier {
    unsigned* bar; unsigned x; int wave;
    volatile LAS unsigned* st;
};

__device__ __forceinline__ XcdBarrier xcd_barrier_post(unsigned* bar, volatile LAS unsigned* st, int wave) {
    XcdBarrier b; b.bar = bar; b.x = xb_xcc_id(); b.st = st; b.wave = wave;
    if (wave == 0 && lane_now() == 0) (void)xb_add(&bar[XB_XCNT(b.x)], 1u);
    return b;
}
__device__ __forceinline__ void xcd_barrier_complete(unsigned* bar, unsigned x, unsigned& nloc, unsigned& nx) {
    const unsigned G = gridDim.x * gridDim.y * gridDim.z;
    unsigned sum, cnt, mine, sp = 0u;
    for (;;) {
        sum = 0u; cnt = 0u; mine = 0u;
#pragma unroll
        for (unsigned j = 0; j < 16; ++j) { const unsigned c = xb_ld(&bar[XB_XCNT(j)]); sum += c; cnt += (c > 0u) ? 1u : 0u; mine = (j == x) ? c : mine; }
        if (sum == G) break;
        __builtin_amdgcn_s_sleep(1);
        if ((++sp & 255u) == 0u) { if (xb_ld(&bar[XB_TMO])) break; if (sp > XB_SPIN_CAP) { atomicAdd(&bar[XB_TMO], 1u); break; } }
    }
    nloc = mine > 0u ? mine : 1u; nx = cnt > 0u ? cnt : 1u;
}

__device__ __forceinline__ void xcd_barrier(const XcdBarrier& b) {
    asm volatile("s_waitcnt vmcnt(0)" ::: "memory");
    __syncthreads();
    if (b.wave == 0 && lane_now() == 0) {
        unsigned* bar = b.bar;
        __builtin_amdgcn_s_waitcnt(0);
        unsigned nloc = b.st[0], nx = b.st[1];
        if (nloc == 0u) { xcd_barrier_complete(bar, b.x, nloc, nx); b.st[0] = nloc; b.st[1] = nx; }
        const unsigned old = xb_add(&bar[XB_XSUB(b.x)], 1u);
        const unsigned gen = old / nloc;
        if (old + 1u == (gen + 1u) * nloc) {
            __builtin_amdgcn_fence(__ATOMIC_RELEASE, "agent");
            asm volatile("s_waitcnt vmcnt(0)" ::: "memory");
            const unsigned og = xb_add(&bar[XB_TOP], 1u);
            const unsigned tg = og / nx;
            if (og + 1u == (tg + 1u) * nx) xb_add(&bar[XB_TOPGEN], 1u);
            else XB_SPIN(xb_ld(&bar[XB_TOPGEN]) == tg, bar);
            __builtin_amdgcn_fence(__ATOMIC_ACQUIRE, "agent");
            xb_add(&bar[XB_XGEN(b.x)], 1u);
            asm volatile("s_waitcnt vmcnt(0)" ::: "memory");
        } else {
            XB_SPIN(xb_ld(&bar[XB_XGEN(b.x)]) == gen, bar);
            __builtin_amdgcn_fence(__ATOMIC_ACQUIRE, "agent");
            asm volatile("s_waitcnt vmcnt(0)" ::: "memory");
        }
    }
    __syncthreads();
}
constexpr int NWAVES = 8, NTHR = NWAVES * 64;
constexpr int BATCH = 4, SEQ = 4096, D = 1024, M = BATCH * SEQ, NIN = 5640, NPROJ = 3584, PLE = 256;
constexpr int DFF = 2816, NEXP = 8, DFFE = 3584, NLAYER = 2;
constexpr int AH = 8, AHD = 64, ABLK = 256, ANB = SEQ / ABLK;
constexpr int MH = 4, MDK = 128;
constexpr float RMS_EPS = 1e-6f;
constexpr float C2 = 0.125f * 1.4426950408889634f;
constexpr int PC_Q = 0, PC_K = 512, PC_V = 1024, PC_QKM = 1536, PC_VM = 2560, PC_OM = 3072, PC_GA = 3584, PC_GB = 4608;

constexpr size_t MiB = 1u << 20;
constexpr size_t WS_CTL = 0, CTL_ZERO_BYTES = 1 * MiB;
constexpr int NPROJX = 5888;
constexpr size_t WS_WIN = 1 * MiB, WS_WOA = 24 * MiB, WS_WOB = 26 * MiB, WS_WOUT = 28 * MiB, WS_WD13 = 32 * MiB, WS_WD2 = 43 * MiB, WS_WPG = 49 * MiB, WS_WPP = 53 * MiB, WS_PB = 54 * MiB;
constexpr size_t WS_WE = 70 * MiB;
constexpr size_t WS_SMALL = 154 * MiB;
constexpr size_t WS_XB = 161 * MiB;
constexpr size_t WS_SS0 = WS_SMALL + 5 * MiB;
constexpr size_t WS_IFPRE = WS_SMALL, WS_KMEAN = WS_SMALL + 1 * MiB, WS_GSEL = WS_SMALL + 4 * MiB;
constexpr size_t WS_HB = 161 * MiB, WS_QKC = 193 * MiB, WS_YA = 225 * MiB, WS_YB = 225 * MiB + 1024  , WS_MIXED = 257 * MiB, WS_ST = 289 * MiB, WS_PROJ = 309 * MiB, WS_END = 485 * MiB;
constexpr size_t WS_TOPI = WS_SMALL + 2 * MiB, WS_TOPG = WS_TOPI + 256 * 1024, WS_DEST = WS_TOPG + 256 * 1024, WS_ROWTOK = WS_SMALL + 3 * MiB, WS_TILEE = WS_ROWTOK + 512 * 1024, WS_NTILES = WS_TILEE + 4096;
constexpr int MOE_MAXROWS = 2 * M + NEXP * 256;
constexpr size_t WS_WE2B = 448 * MiB;
constexpr size_t WS_XG = 193 * MiB, WS_Y = 261 * MiB, WS_GHH = 329 * MiB;
static_assert(WS_XG + (size_t)MOE_MAXROWS * D * 2 <= WS_Y && WS_Y + (size_t)MOE_MAXROWS * D * 2 <= WS_GHH && WS_GHH + (size_t)MOE_MAXROWS * DFFE <= WS_END, "MoE buffers");
constexpr size_t WS_GT = WS_PROJ + (size_t)M * NPROJ * 2;
static_assert(WS_GT + (size_t)64 * MiB <= WS_END, "gate tiles inside the old proj region");
constexpr size_t WS_TMP = WS_HB;
constexpr size_t WS_GH = WS_PROJ, WS_PP = WS_PROJ;
constexpr int CW_TMO = 0, CW_CODE = 1, CW_BAR = 4096;
constexpr int CW_SS = 65536;
static_assert((CW_SS + 3 * M) * 4 <= (int)CTL_ZERO_BYTES, "SS accumulators inside the zeroed region");

constexpr int RING_OFF = 0, RING_BYTES = 131072;
constexpr int LDSCTL_OFF = RING_BYTES, MISC_OFF = LDSCTL_OFF + 320;
constexpr int LDS_BYTES = 147456;
struct Frame {
    LAS unsigned char* lds;
    volatile LAS unsigned* MISC;
    gu32* ctl;
    int wave;
    int vcu, G;
    unsigned char* ws;
};
__device__ __forceinline__ int opaque(int v) { asm volatile("" : "+v"(v)); return v; }
#define PHASE_LOCALS() const int tid = F.wave * 64 + lane_now(), lane = tid & 63; (void)lane
__device__ __forceinline__ float shx(float v, int o, int lane) { return __int_as_float(__builtin_amdgcn_ds_bpermute((lane ^ o) << 2, __float_as_int(v))); }
__device__ __forceinline__ float wave_sum(float v, int lane) {
#pragma unroll
    for (int o = 1; o < 64; o <<= 1) v += shx(v, o, lane);
    return v;
}
__device__ __forceinline__ float wave_max(float v, int lane) {
#pragma unroll
    for (int o = 1; o < 64; o <<= 1) v = fmaxf(v, shx(v, o, lane));
    return v;
}
__device__ __forceinline__ float bf2f(bf16 u) { return __uint_as_float((unsigned)u << 16); }
__device__ __forceinline__ float bflo(unsigned w) { return __uint_as_float(w << 16); }
__device__ __forceinline__ float bfhi(unsigned w) { return __uint_as_float(w & 0xffff0000u); }
__device__ __forceinline__ float sigm(float x) { return pg8::sigm(x); }

__device__ __forceinline__ void tr_item(const float* W, int ld, int K, int N, bf16* WT, int rowstep, int row_off, LAS float* scr, int item, int lane, const float* gk = nullptr, int nrows = 32) {
    const int nblk = N / 32, kb = item / nblk, nb = item % nblk, k0 = 64 * kb, n0 = 32 * nb;
#pragma unroll 32
    for (int i = 0; i < 32; ++i) { const int kk = 2 * i + (lane >> 5); scr[kk * 33 + (lane & 31)] = W[(size_t)(k0 + kk) * ld + n0 + (lane & 31)] * (gk ? gk[k0 + kk] : 1.0f); }
    LDS_WAIT(); asm volatile("" ::: "memory");
    const int c = lane & 7;
#pragma unroll
    for (int j = 0; j < 4; ++j) { const int n = (lane >> 3) + 8 * j; const LAS float* s = scr + (8 * c) * 33 + n;
        v4u o; o.x = pk2(s[0 * 33], s[1 * 33]); o.y = pk2(s[2 * 33], s[3 * 33]); o.z = pk2(s[4 * 33], s[5 * 33]); o.w = pk2(s[6 * 33], s[7 * 33]);
        const int nn = n0 + n, drow = (nn >> 7) * rowstep + (nn & 127) + row_off;
        if (n < nrows) *(GAS v4u*)(WT + (size_t)drow * K + k0 + 8 * c) = o; }
    LDS_WAIT(); asm volatile("" ::: "memory");
}
__device__ __forceinline__ void tr_tile(const float* W, int ld, int K, int ntn, bf16* WT, int rowstep, int row_off, LAS float* scr, int tile, int wave, int lane, const float* gk, bool permqk, float f8scale = 0.f) {
    const int kb = tile / ntn, nb = tile % ntn, k0 = 64 * kb, n0 = 256 * nb;
    f32x4 v[8];
#pragma unroll
    for (int i = 0; i < 8; ++i) v[i] = *(const f32x4*)(W + (size_t)(k0 + wave + 8 * i) * ld + n0 + 4 * lane);
#pragma unroll
    for (int i = 0; i < 8; ++i) { const int k = wave + 8 * i; const float g = gk ? gk[k0 + k] : 1.0f; LAS float* d = scr + k * 257 + 4 * lane; d[0] = v[i][0] * g; d[1] = v[i][1] * g; d[2] = v[i][2] * g; d[3] = v[i][3] * g; }
    __syncthreads();
    const int tid = wave * 64 + lane, c = tid & 7;
#pragma unroll
    for (int j = 0; j < 4; ++j) { const int n = (tid >> 3) + 64 * j; const LAS float* p = scr + (8 * c) * 257 + n;
        v4u o; o.x = pk2(p[0], p[257]); o.y = pk2(p[2 * 257], p[3 * 257]); o.z = pk2(p[4 * 257], p[5 * 257]); o.w = pk2(p[6 * 257], p[7 * 257]);
        const int nn = n0 + n, drow = permqk ? (nn & ~255) + (((nn >> 5) & 1) << 7) + (((nn >> 6) & 3) << 5) + (nn & 31) + row_off : (nn >> 7) * rowstep + (nn & 127) + row_off;
        if (f8scale != 0.f) { uint2 o8; int a_ = __builtin_amdgcn_cvt_pk_fp8_f32(p[0] * f8scale, p[257] * f8scale, 0, false); a_ = __builtin_amdgcn_cvt_pk_fp8_f32(p[2 * 257] * f8scale, p[3 * 257] * f8scale, a_, true);
            int b_ = __builtin_amdgcn_cvt_pk_fp8_f32(p[4 * 257] * f8scale, p[5 * 257] * f8scale, 0, false); b_ = __builtin_amdgcn_cvt_pk_fp8_f32(p[6 * 257] * f8scale, p[7 * 257] * f8scale, b_, true);
            o8.x = (unsigned)a_; o8.y = (unsigned)b_; *(uint2*)((unsigned char*)WT + (size_t)drow * K + k0 + 8 * c) = o8; }
        else *(GAS v4u*)(WT + (size_t)drow * K + k0 + 8 * c) = o; }
    __syncthreads();
}
#define TTJOBG(W_, ld_, K_, N_, WT_, rs_, ro_, gk_) if (!found) { const int I_ = ((K_) / 64) * ((N_) / 256); if (r < I_) { jb.W = (W_); jb.ld = (ld_); jb.K = (K_); jb.N = (N_); jb.WT = (WT_); jb.rowstep = (rs_); jb.row_off = (ro_); jb.gk = (gk_); jb.nrows = 32; found = true; } else r -= I_; }
struct TrJob { const float* W; int ld, K, N; bf16* WT; int rowstep, row_off; const float* gk; int nrows; };
#define TRJOBG(W_, ld_, K_, N_, WT_, rs_, ro_, gk_, nr_) if (!found) { const int I_ = ((K_) / 64) * ((N_) / 32); if (r < I_) { jb.W = (W_); jb.ld = (ld_); jb.K = (K_); jb.N = (N_); jb.WT = (WT_); jb.rowstep = (rs_); jb.row_off = (ro_); jb.gk = (gk_); jb.nrows = (nr_); found = true; } else r -= I_; }
#define TRJOB(W_, ld_, K_, N_, WT_, rs_, ro_) TRJOBG(W_, ld_, K_, N_, WT_, rs_, ro_, nullptr, 32)

struct Inputs { const float* p[25]; };
enum { I_X = 0, I_P, I_GMIX, I_WIN, I_GQ, I_GK, I_CONVW, I_CONVB, I_BI, I_BF, I_GH, I_WOA, I_WOB, I_WOUT, I_GFFN, I_WD1, I_WD3, I_WD2, I_WR, I_WE1, I_WE3, I_WE2, I_GPLE, I_WPG, I_WPP };

constexpr int PER_LAYER_T = 16 * 4 + 16 * 10 + 16 * 8 + 2 * (8 * 4) + 2 * (16 * 4) + 4 * 4, NTILES_T = 2 * PER_LAYER_T + 2 * (16 * 11) + 44 * 4, P0_URGENT = 16 * 4 + 16 * 10 + 16 * 8;
__device__ __forceinline__ void p0_tile(Frame& F, const Inputs& in, int r_in, int lane) {
    int r = r_in; bool found = false; TrJob jb;
            jb.W = nullptr; jb.ld = 0; jb.K = 64; jb.N = 256; jb.WT = nullptr; jb.rowstep = 128; jb.row_off = 0; jb.gk = nullptr; jb.nrows = 32;
#pragma unroll
            for (int l = 0; l < 2; ++l) {
                if (!found) { const int I_ = 16 * 4; if (r < I_) { jb.W = in.p[I_WIN] + (size_t)l * D * NIN; jb.ld = NIN; jb.K = D; jb.N = 1024; jb.WT = (bf16*)(F.ws + WS_WIN) + (size_t)l * NPROJX * D; jb.rowstep = 128; jb.row_off = 0; jb.gk = in.p[I_GMIX] + l * D; jb.nrows = 33; found = true; } else r -= I_; }
                TTJOBG(in.p[I_WIN] + (size_t)l * D * NIN + 1024, NIN, D, 2560, (bf16*)(F.ws + WS_WIN) + (size_t)l * NPROJX * D, 128, 1024, in.p[I_GMIX] + l * D)
                TTJOBG(in.p[I_WIN] + (size_t)l * D * NIN + 3592, NIN, D, 2048, (bf16*)(F.ws + WS_WIN) + (size_t)l * NPROJX * D, 128, 3584, in.p[I_GMIX] + l * D)
                if (!found) { const int I_ = 8 * 4; if (r < I_) { jb.W = in.p[I_WOA] + (size_t)l * 512 * D; jb.ld = D; jb.K = D; jb.N = D; jb.WT = (bf16*)(F.ws + WS_WOA) + (size_t)l * D * D; jb.rowstep = 128; jb.row_off = 0; jb.gk = nullptr; found = true; } else r -= I_; }
                if (!found) { const int I_ = 8 * 4; if (r < I_) { jb.W = in.p[I_WOB] + (size_t)l * 512 * D; jb.ld = D; jb.K = D; jb.N = D; jb.WT = (bf16*)(F.ws + WS_WOA) + (size_t)l * D * D + 512; jb.rowstep = 128; jb.row_off = 0; jb.gk = nullptr; found = true; } else r -= I_; }
                TTJOBG(in.p[I_WOUT] + (size_t)l * D * D, D, D, D, (bf16*)(F.ws + WS_WOUT) + (size_t)l * D * D, 128, 0, nullptr)
                TTJOBG(in.p[I_WPG] + (size_t)l * D * D, D, D, D, (bf16*)(F.ws + WS_WPG) + (size_t)l * D * D, 128, 0, (l == 0) ? in.p[I_GPLE] : nullptr)
                TTJOBG(in.p[I_WPP] + (size_t)l * PLE * D, D, PLE, D, (bf16*)(F.ws + WS_WPP) + (size_t)l * D * PLE, 128, 0, nullptr)
            }
            TTJOBG(in.p[I_WD1], DFF, D, DFF, (bf16*)(F.ws + WS_WD13), 256, 0, in.p[I_GFFN])
            TTJOBG(in.p[I_WD3], DFF, D, DFF, (bf16*)(F.ws + WS_WD13), 256, 128, in.p[I_GFFN])
            TTJOBG(in.p[I_WD2], D, DFF, D, (bf16*)(F.ws + WS_WD2), 128, 0, nullptr)
    if (found) tr_tile(jb.W, jb.ld, jb.K, jb.N / 256, jb.WT, jb.rowstep, jb.row_off, (LAS float*)(F.lds + RING_OFF), r, F.wave, lane, jb.gk, jb.nrows == 33);
}
constexpr int P_CHUNKS = 64;
__device__ __forceinline__ void p_chunk(Frame& F, const Inputs& in, int c, int tid) {
    const size_t n8 = (size_t)2 * M * PLE / 8, per = n8 / P_CHUNKS;
    for (size_t i = (size_t)c * per + tid; i < (size_t)(c + 1) * per; i += NTHR) {
        const f32x4 a = *(const f32x4*)(in.p[I_P] + i * 8), b = *(const f32x4*)(in.p[I_P] + i * 8 + 4);
        v4u o; o.x = pk2(a[0], a[1]); o.y = pk2(a[2], a[3]); o.z = pk2(b[0], b[1]); o.w = pk2(b[2], b[3]);
        *(v4u*)((bf16*)(F.ws + WS_PB) + i * 8) = o; }
}
__device__ __forceinline__ void p0_prologue(Frame& F, const Inputs& in, int parts = 7) {
    PHASE_LOCALS();
    LAS float* scr = (LAS float*)(F.lds + RING_OFF + F.wave * 16384);
    const int gw = F.vcu * NWAVES + F.wave, NGW = F.G * NWAVES;
    if (parts & 1) {
        for (int it = F.vcu; it < P0_URGENT; it += F.G) p0_tile(F, in, it, lane);
        for (int it = gw; it < 32; it += NGW) { const int l = it >> 4;
            tr_item(in.p[I_WIN] + (size_t)l * D * NIN + 3584, NIN, D, 32, (bf16*)(F.ws + WS_WIN) + (size_t)l * NPROJX * D, 128, 5632, scr, it & 15, lane, in.p[I_GMIX] + l * D, 8); }
    }
    if (parts & 2) { pg8::ssq_t* SS0 = (pg8::ssq_t*)(F.ws + WS_SS0); bf16* XB = (bf16*)(F.ws + WS_XB);
      for (int m = gw; m < M; m += NGW) { const f32x4* xr = (const f32x4*)(in.p[I_X] + (size_t)m * D) + lane; unsigned long long* o8 = (unsigned long long*)(XB + (size_t)m * D) + lane; float ss = 0.f;
#pragma unroll
          for (int j = 0; j < 4; ++j) { const f32x4 v = xr[64 * j]; ss += (v[0] * v[0] + v[1] * v[1]) + (v[2] * v[2] + v[3] * v[3]); o8[64 * j] = (unsigned long long)pk2(v[0], v[1]) | ((unsigned long long)pk2(v[2], v[3]) << 32); }
          ss = wave_sum(ss, lane); if (lane == 0) SS0[m] = pg8::ss_fix(ss); } }
}
__device__ __forceinline__ void p_conv_expert(Frame& F, const Inputs& in, int e) {
    PHASE_LOCALS();
    LAS float* scr = (LAS float*)(F.lds + RING_OFF + F.wave * 16384);
    const int gw = F.vcu * NWAVES + F.wave, NGW = F.G * NWAVES;
    constexpr int NITEMS = 2 * (16 * 112) + 56 * 32;
    bf16* W13 = (bf16*)(F.ws + WS_WE); bf16* W2 = W13 + (size_t)2 * DFFE * D;
    for (int it = gw; it < NITEMS; it += NGW) {
        int r = it; bool found = false; TrJob jb;
        jb.W = nullptr; jb.ld = 0; jb.K = 64; jb.N = 32; jb.WT = nullptr; jb.rowstep = 128; jb.row_off = 0; jb.gk = nullptr; jb.nrows = 32;
        TRJOB(in.p[I_WE1] + (size_t)e * D * DFFE, DFFE, D, DFFE, W13, 256, 0)
        TRJOB(in.p[I_WE3] + (size_t)e * D * DFFE, DFFE, D, DFFE, W13, 256, 128)
        TRJOB(in.p[I_WE2] + (size_t)e * DFFE * D, D, DFFE, D, W2, 128, 0)
        if (found) tr_item(jb.W, jb.ld, jb.K, jb.N, jb.WT, jb.rowstep, jb.row_off, scr, r, lane, jb.gk, jb.nrows);
    }
}

template <int MODE>
__device__ __forceinline__ void phase_norm(Frame& F, const float* xsrc, const float* g, bf16* hb, const float* wx, int ldw, const float* b_i, const float* b_f, float* ifpre, float* gsel) {
    PHASE_LOCALS();
    LAS float* wl = (LAS float*)F.lds;
    if (MODE == 1 || MODE == 2) {
        for (int i = tid; i < 1024 * 2; i += NTHR) { const int c = i >> 1, hlf = i & 1; *(LAS f32x4*)(wl + c * 8 + 4 * hlf) = *(const f32x4*)(wx + (size_t)c * ldw + 4 * hlf); }
        __syncthreads();
    }
    const int gw = F.vcu * NWAVES + F.wave, NGW = F.G * NWAVES;
    f32x4 gv[4];
#pragma unroll
    for (int j = 0; j < 4; ++j) gv[j] = ((const f32x4*)g)[lane + 64 * j];
    f32x4 vn[4]; uint2 yan[4], ybn[4]; float2 tgn = make_float2(0.f, 0.f), tgc = tgn; int2 tdn = make_int2(0, 0);
#pragma unroll
    for (int j = 0; j < 4; ++j) { vn[j] = (f32x4){0.f, 0.f, 0.f, 0.f}; yan[j] = make_uint2(0u, 0u); ybn[j] = make_uint2(0u, 0u); }
    if (gw < M) {
        if (MODE == 3) { tgc = *(const float2*)((const float*)(F.ws + WS_TOPG) + (size_t)gw * 2); const int2 td0 = *(const int2*)((const int*)(F.ws + WS_DEST) + (size_t)gw * 2);
            const bf16* y1 = (const bf16*)(F.ws + WS_Y) + (size_t)td0.x * D; const bf16* y2 = (const bf16*)(F.ws + WS_Y) + (size_t)td0.y * D;
#pragma unroll
            for (int j = 0; j < 4; ++j) { yan[j] = *(const uint2*)(y1 + 4 * lane + 256 * j); ybn[j] = *(const uint2*)(y2 + 4 * lane + 256 * j); }
            if (gw + NGW < M) { tgn = *(const float2*)((const float*)(F.ws + WS_TOPG) + (size_t)(gw + NGW) * 2); tdn = *(const int2*)((const int*)(F.ws + WS_DEST) + (size_t)(gw + NGW) * 2); } }
#pragma unroll
        for (int j = 0; j < 4; ++j) vn[j] = ((const f32x4*)(xsrc + (size_t)gw * D) + lane)[64 * j];
    }
    for (int m = gw; m < M; m += NGW) {
        f32x4 v[4]; uint2 ya[4], yb[4]; float s = 0.f; const float2 tg = tgc;
#pragma unroll
        for (int j = 0; j < 4; ++j) { v[j] = vn[j]; ya[j] = yan[j]; yb[j] = ybn[j]; }
        if (m + NGW < M) {
            const int mn = m + NGW;
            if (MODE == 3) { tgc = tgn; const bf16* y1 = (const bf16*)(F.ws + WS_Y) + (size_t)tdn.x * D; const bf16* y2 = (const bf16*)(F.ws + WS_Y) + (size_t)tdn.y * D;
#pragma unroll
                for (int j = 0; j < 4; ++j) { yan[j] = *(const uint2*)(y1 + 4 * lane + 256 * j); ybn[j] = *(const uint2*)(y2 + 4 * lane + 256 * j); }
                if (mn + NGW < M) { tgn = *(const float2*)((const float*)(F.ws + WS_TOPG) + (size_t)(mn + NGW) * 2); tdn = *(const int2*)((const int*)(F.ws + WS_DEST) + (size_t)(mn + NGW) * 2); } }
#pragma unroll
            for (int j = 0; j < 4; ++j) vn[j] = ((const f32x4*)(xsrc + (size_t)mn * D) + lane)[64 * j];
        }
        if (MODE == 3) {
#pragma unroll
            for (int j = 0; j < 4; ++j) { const uint2 a = ya[j], b = yb[j];
                v[j][0] += tg.x * bflo(a.x) + tg.y * bflo(b.x); v[j][1] += tg.x * bfhi(a.x) + tg.y * bfhi(b.x); v[j][2] += tg.x * bflo(a.y) + tg.y * bflo(b.y); v[j][3] += tg.x * bfhi(a.y) + tg.y * bfhi(b.y);
                ((f32x4*)(const_cast<float*>(xsrc) + (size_t)m * D))[lane + 64 * j] = v[j]; }
        }
#pragma unroll
        for (int j = 0; j < 4; ++j) s += (v[j][0] * v[j][0] + v[j][1] * v[j][1]) + (v[j][2] * v[j][2] + v[j][3] * v[j][3]);
        const float rstd = 1.0f / sqrtf(wave_sum(s, lane) * (1.0f / D) + RMS_EPS);
        unsigned long long* o8 = (unsigned long long*)(hb + (size_t)m * D) + lane;
#pragma unroll
        for (int j = 0; j < 4; ++j) { v[j] = v[j] * rstd * gv[j];
            o8[64 * j] = (unsigned long long)pk2(v[j][0], v[j][1]) | ((unsigned long long)pk2(v[j][2], v[j][3]) << 32); }
        if (MODE == 1 || MODE == 2) {
            float a[8];
#pragma unroll
            for (int k = 0; k < 8; ++k) a[k] = 0.f;
#pragma unroll
            for (int j = 0; j < 4; ++j)
#pragma unroll
                for (int q = 0; q < 4; ++q) { const int c = 4 * lane + 256 * j + q; const f32x4 w0 = *(const LAS f32x4*)(wl + c * 8), w1 = *(const LAS f32x4*)(wl + c * 8 + 4); const float y = v[j][q];
                    a[0] += y * w0[0]; a[1] += y * w0[1]; a[2] += y * w0[2]; a[3] += y * w0[3]; a[4] += y * w1[0]; a[5] += y * w1[1]; a[6] += y * w1[2]; a[7] += y * w1[3]; }
#pragma unroll
            for (int k = 0; k < 8; ++k) a[k] = wave_sum(a[k], lane);
            if (MODE == 1) {
                if (lane == 0) {
                    f32x4 o0 = {a[0] + b_i[0], a[1] + b_i[1], a[2] + b_i[2], a[3] + b_i[3]}, o1 = {a[4] + b_f[0], a[5] + b_f[1], a[6] + b_f[2], a[7] + b_f[3]};
                    *(f32x4*)(ifpre + (size_t)m * 8) = o0; *(f32x4*)(ifpre + (size_t)m * 8 + 4) = o1; }
            } else {
                int i1 = 0; float v1 = a[0];
#pragma unroll
                for (int k = 1; k < 8; ++k) if (a[k] > v1) { v1 = a[k]; i1 = k; }
                int i2 = -1; float v2 = -INFINITY;
#pragma unroll
                for (int k = 0; k < 8; ++k) if (k != i1 && a[k] > v2) { v2 = a[k]; i2 = k; }
                const float g1 = 1.0f / (1.0f + expf(v2 - v1)), g2 = 1.0f - g1;
                if (lane < 8) gsel[(size_t)m * 8 + lane] = (lane == i1) ? g1 : (lane == i2) ? g2 : 0.f;
                if (lane == 0) { *(int2*)((int*)(F.ws + WS_TOPI) + (size_t)m * 2) = make_int2(i1, i2); *(float2*)((float*)(F.ws + WS_TOPG) + (size_t)m * 2) = make_float2(g1, g2); }
            }
        }
    }
    if (MODE == 1 || MODE == 2) __syncthreads();
}

__device__ __forceinline__ void phase_prep(Frame& F, const Inputs& in, int l, int parts = 3) {
    PHASE_LOCALS();
    bf16* PROJ = (bf16*)(F.ws + WS_PROJ); float* kmean = (float*)(F.ws + WS_KMEAN); bf16* QKC = (bf16*)(F.ws + WS_QKC);
    const float* gq = in.p[I_GQ] + l * AHD; const float* gk = in.p[I_GK] + l * AHD;
    LAS float* kt = (LAS float*)F.lds; LAS float* part = kt + 256 * 65;
    if (parts & 1) for (int u = F.vcu; u < (M / 256) * AH; u += F.G) {
        const int pm = u >> 3, h = u & 7, row = tid >> 1, hf = tid & 1; const size_t grow = (size_t)pm * 256 + row;
#pragma unroll
        for (int which = 0; which < 2; ++which) {
            bf16* ptr = PROJ + grow * NPROJ + (which ? PC_K : PC_Q) + h * AHD + hf * 32; const float* gg = (which ? gk : gq) + hf * 32;
            bf16* optr = (parts & 4) ? (bf16*)(F.ws + WS_MIXED) + (grow & 255) * NPROJ + (which ? PC_K : PC_Q) + h * AHD + hf * 32 : ptr;
            float v[32]; float ss = 0.f;
#pragma unroll
            for (int i = 0; i < 4; ++i) { const v4u w = *(const v4u*)(ptr + 8 * i);
                v[8 * i + 0] = bflo(w.x); v[8 * i + 1] = bfhi(w.x); v[8 * i + 2] = bflo(w.y); v[8 * i + 3] = bfhi(w.y); v[8 * i + 4] = bflo(w.z); v[8 * i + 5] = bfhi(w.z); v[8 * i + 6] = bflo(w.w); v[8 * i + 7] = bfhi(w.w); }
#pragma unroll
            for (int i = 0; i < 32; ++i) ss += v[i] * v[i];
            ss += shx(ss, 1, lane);
            const float r = (1.0f / sqrtf(ss * (1.0f / AHD) + RMS_EPS)) * (which ? 1.0f : C2);
#pragma unroll
            for (int i = 0; i < 32; ++i) v[i] = v[i] * r * gg[i];
            if (which) {
#pragma unroll
                for (int i = 0; i < 32; ++i) kt[row * 65 + hf * 32 + i] = v[i]; }
#pragma unroll
            for (int i = 0; i < 4; ++i) { v4u o; o.x = pk2(v[8 * i], v[8 * i + 1]); o.y = pk2(v[8 * i + 2], v[8 * i + 3]); o.z = pk2(v[8 * i + 4], v[8 * i + 5]); o.w = pk2(v[8 * i + 6], v[8 * i + 7]); *(v4u*)(optr + 8 * i) = o; }
        }
        __syncthreads();
        { const int c = tid & 63, pt = tid >> 6; float s = 0.f;
            for (int i = 0; i < 32; ++i) s += kt[(pt * 32 + i) * 65 + c];
            part[pt * 64 + c] = s; }
        __syncthreads();
        if (tid < 64) { float tot = 0.f;
#pragma unroll
            for (int pt = 0; pt < 8; ++pt) tot += part[pt * 64 + tid];
            const int b = pm >> 4, n = pm & 15;
            ((parts & 4) ? (float*)(F.ws + WS_MIXED) + 4 * 1024 * 1024 : kmean)[(((size_t)(b * AH + h)) * ANB + n) * AHD + tid] = tot * (1.0f / ABLK); }
        __syncthreads();
    }
    if (parts & 2) {
        const float* cw = in.p[I_CONVW] + (size_t)l * 4 * 1024; const float* cb = in.p[I_CONVB] + (size_t)l * 1024;
        const int ch = tid & 127, c0 = ch * 8; const float sc = (c0 >= 512) ? 0.08838834764831845f : 1.0f;
        float w[4][8], bia[8];
#pragma unroll
        for (int j = 0; j < 4; ++j) { const f32x4 w0 = *(const f32x4*)(cw + j * 1024 + c0), w1 = *(const f32x4*)(cw + j * 1024 + c0 + 4);
            w[j][0] = w0[0]; w[j][1] = w0[1]; w[j][2] = w0[2]; w[j][3] = w0[3]; w[j][4] = w1[0]; w[j][5] = w1[1]; w[j][6] = w1[2]; w[j][7] = w1[3]; }
        { const f32x4 b0 = *(const f32x4*)(cb + c0), b1 = *(const f32x4*)(cb + c0 + 4); bia[0] = b0[0]; bia[1] = b0[1]; bia[2] = b0[2]; bia[3] = b0[3]; bia[4] = b1[0]; bia[5] = b1[1]; bia[6] = b1[2]; bia[7] = b1[3]; }
        for (int run = F.vcu * 4 + (tid >> 7); run < M / 16; run += F.G * 4) {
            const int r0 = run * 16, t0 = r0 & (SEQ - 1);
            v4u xin[19];
#pragma unroll
            for (int i = 0; i < 19; ++i) { xin[i] = (v4u){0u, 0u, 0u, 0u}; if (i >= 3 || t0 > 0) xin[i] = *(const v4u*)(PROJ + (size_t)(r0 - 3 + i) * NPROJ + PC_QKM + c0); }
#pragma unroll
            for (int i = 0; i < 16; ++i) { float a[8];
#pragma unroll
                for (int k = 0; k < 8; ++k) a[k] = bia[k];
#pragma unroll
                for (int j = 0; j < 4; ++j) { const v4u x = xin[i + j];
                    a[0] += w[j][0] * bflo(x.x); a[1] += w[j][1] * bfhi(x.x); a[2] += w[j][2] * bflo(x.y); a[3] += w[j][3] * bfhi(x.y); a[4] += w[j][4] * bflo(x.z); a[5] += w[j][5] * bfhi(x.z); a[6] += w[j][6] * bflo(x.w); a[7] += w[j][7] * bfhi(x.w); }
#pragma unroll
                for (int k = 0; k < 8; ++k) a[k] = a[k] * sigm(a[k]) * sc;
                v4u o; o.x = pk2(a[0], a[1]); o.y = pk2(a[2], a[3]); o.z = pk2(a[4], a[5]); o.w = pk2(a[6], a[7]);
                *(v4u*)(QKC + (size_t)(r0 + i) * 1024 + c0) = o; }
        }
    }
}

__device__ __forceinline__ float dot64(const bf16* kr, const float (&q)[64]) {
    float a = 0.f;
#pragma unroll
    for (int i = 0; i < 8; ++i) { const v4u w = *(const v4u*)(kr + 8 * i);
        a += q[8 * i] * bflo(w.x) + q[8 * i + 1] * bfhi(w.x) + q[8 * i + 2] * bflo(w.y) + q[8 * i + 3] * bfhi(w.y) + q[8 * i + 4] * bflo(w.z) + q[8 * i + 5] * bfhi(w.z) + q[8 * i + 6] * bflo(w.w) + q[8 * i + 7] * bfhi(w.w); }
    return a;
}
__device__ __forceinline__ void phase_attn_naive(Frame& F) {
    const bf16* PROJ = (const bf16*)(F.ws + WS_PROJ); const float* kmean = (const float*)(F.ws + WS_KMEAN); bf16* YA = (bf16*)(F.ws + WS_YA);
    LAS float* sc = (LAS float*)F.lds + F.wave * 1088; LAS float* qs = sc + 1024;
    const int gw = F.vcu * NWAVES + F.wave, NGW = F.G * NWAVES, lane = lane_now();
    for (int item = gw; item < BATCH * AH * SEQ; item += NGW) {
        const int q = item & (SEQ - 1), bh = item >> 12, b = bh >> 3, h = bh & 7, blk = q >> 8;
        const size_t rb = (size_t)b * SEQ;
        qs[lane] = bf2f(PROJ[(rb + q) * NPROJ + PC_Q + h * AHD + lane]);
        asm volatile("s_waitcnt lgkmcnt(0)" ::: "memory");
        float qr[64];
#pragma unroll
        for (int i = 0; i < 16; ++i) { const f32x4 t = *(const LAS f32x4*)(qs + 4 * i); qr[4 * i] = t[0]; qr[4 * i + 1] = t[1]; qr[4 * i + 2] = t[2]; qr[4 * i + 3] = t[3]; }
        float gv = -INFINITY;
        if (lane < blk) { const float* km = kmean + ((size_t)bh * ANB + lane) * AHD; float a = 0.f;
#pragma unroll
            for (int i = 0; i < 16; ++i) { const f32x4 t = *(const f32x4*)(km + 4 * i); a += qr[4 * i] * t[0] + qr[4 * i + 1] * t[1] + qr[4 * i + 2] * t[2] + qr[4 * i + 3] * t[3]; }
            gv = a; }
        unsigned selmask = 0u;
        for (int s = 0; s < 3 && s < blk; ++s) { const float mx = wave_max(gv, lane); const unsigned long long bal = __ballot(gv == mx && lane < blk); const int idx = __ffsll((long long)bal) - 1;
            selmask |= 1u << idx; if (lane == idx) gv = -INFINITY; }
        int slot = 0;
        for (int n = 0; n < blk; ++n) if ((selmask >> n) & 1u) {
#pragma unroll
            for (int jj = 0; jj < 4; ++jj) { const int key = n * ABLK + lane + 64 * jj; sc[slot * 256 + lane + 64 * jj] = dot64(PROJ + (rb + key) * NPROJ + PC_K + h * AHD, qr); }
            ++slot; }
#pragma unroll
        for (int jj = 0; jj < 4; ++jj) { const int key = blk * ABLK + lane + 64 * jj; const float a = dot64(PROJ + (rb + key) * NPROJ + PC_K + h * AHD, qr); sc[slot * 256 + lane + 64 * jj] = (key > q) ? -INFINITY : a; }
        const int ntot = (slot + 1) * 256;
        asm volatile("s_waitcnt lgkmcnt(0)" ::: "memory");
        float mx = -INFINITY; for (int i = lane; i < ntot; i += 64) mx = fmaxf(mx, sc[i]); mx = wave_max(mx, lane);
        float sum = 0.f; for (int i = lane; i < ntot; i += 64) { const float p = pg8::ex2(sc[i] - mx); sc[i] = p; sum += p; } sum = wave_sum(sum, lane);
        asm volatile("s_waitcnt lgkmcnt(0)" ::: "memory");
        float o = 0.f; slot = 0;
        for (int n = 0; n < blk; ++n) if ((selmask >> n) & 1u) { const bf16* vp = PROJ + (rb + n * ABLK) * NPROJ + PC_V + h * AHD + lane;
            for (int j = 0; j < 256; ++j) o += sc[slot * 256 + j] * bf2f(vp[(size_t)j * NPROJ]);
            ++slot; }
        { const bf16* vp = PROJ + (rb + blk * ABLK) * NPROJ + PC_V + h * AHD + lane; const int je = q - blk * ABLK;
            for (int j = 0; j <= je; ++j) o += sc[slot * 256 + j] * bf2f(vp[(size_t)j * NPROJ]); }
        YA[(rb + q) * 1024 + h * AHD + lane] = (bf16)f2bf(o / sum);
        asm volatile("s_waitcnt lgkmcnt(0)" ::: "memory");
    }
}

__device__ __forceinline__ void phase_mlstm_naive(Frame& F, const Inputs& in, int l) {
    if (blockIdx.x >= BATCH * MH) return;
    const bf16* PROJ = (const bf16*)(F.ws + WS_PROJ); const bf16* QKC = (const bf16*)(F.ws + WS_QKC); const float* ifpre = (const float*)(F.ws + WS_IFPRE); bf16* YB = (bf16*)(F.ws + WS_YB);
    const float* gh = in.p[I_GH] + l * MDK;
    const int bh = blockIdx.x, b = bh >> 2, h = bh & 3, tid = F.wave * 64 + lane_now(), lane = tid & 63, e = tid & 127, g = tid >> 7;
    LAS float* qs = (LAS float*)F.lds; LAS float* ks = qs + 16 * 128; LAS float* vs = ks + 16 * 128; LAS float* red = vs + 16 * 128; LAS float* redd = red + 16 * 4 * 128;
    LAS float* gi = redd + 64; LAS float* gf = gi + 16; LAS float* ms = gf + 16;
    float C[32], nn[32];
#pragma unroll
    for (int i = 0; i < 32; ++i) { C[i] = 0.f; nn[i] = 0.f; }
    float m = 0.f;
    for (int t0 = 0; t0 < SEQ; t0 += 16) {
        for (int i = tid; i < 16 * 128; i += NTHR) { const int st = i >> 7, d = i & 127; const size_t r = (size_t)b * SEQ + t0 + st;
            qs[i] = bf2f(QKC[r * 1024 + h * MDK + d]); ks[i] = bf2f(QKC[r * 1024 + 512 + h * MDK + d]); vs[i] = bf2f(PROJ[r * NPROJ + PC_VM + h * MDK + d]); }
        if (tid < 16) { const size_t r = (size_t)b * SEQ + t0 + tid; gi[tid] = ifpre[r * 8 + h]; const float x = ifpre[r * 8 + 4 + h]; gf[tid] = fminf(x, 0.f) - log1pf(expf(-fabsf(x))); }
        __syncthreads();
        for (int st = 0; st < 16; ++st) {
            const float li = gi[st], lf = gf[st], mn = fmaxf(lf + m, li), wC = expf(lf + m - mn), wS = expf(li - mn); m = mn;
            const float ve = vs[st * 128 + e]; float pn = 0.f, pd = 0.f;
#pragma unroll
            for (int i4 = 0; i4 < 8; ++i4) { const f32x4 k4 = *(const LAS f32x4*)(ks + st * 128 + 32 * g + 4 * i4), q4 = *(const LAS f32x4*)(qs + st * 128 + 32 * g + 4 * i4);
#pragma unroll
                for (int j = 0; j < 4; ++j) { const int i = 4 * i4 + j; const float kd = wS * k4[j]; C[i] = wC * C[i] + kd * ve; nn[i] = wC * nn[i] + kd; pn += q4[j] * C[i]; pd += q4[j] * nn[i]; } }
            red[(st * 4 + g) * 128 + e] = pn; if (e == 0) redd[st * 4 + g] = pd; if (tid == 0) ms[st] = mn;
        }
        __syncthreads();
#pragma unroll
        for (int s2 = 0; s2 < 2; ++s2) { const int st = 2 * F.wave + s2; const float den = (redd[st * 4] + redd[st * 4 + 1]) + (redd[st * 4 + 2] + redd[st * 4 + 3]);
            const float dn = 1.0f / fmaxf(fabsf(den), expf(-ms[st]));
            const float h0 = ((red[(st * 4) * 128 + lane] + red[(st * 4 + 1) * 128 + lane]) + (red[(st * 4 + 2) * 128 + lane] + red[(st * 4 + 3) * 128 + lane])) * dn;
            const float h1 = ((red[(st * 4) * 128 + 64 + lane] + red[(st * 4 + 1) * 128 + 64 + lane]) + (red[(st * 4 + 2) * 128 + 64 + lane] + red[(st * 4 + 3) * 128 + 64 + lane])) * dn;
            const float rr = 1.0f / sqrtf(wave_sum(h0 * h0 + h1 * h1, lane) * (1.0f / MDK) + RMS_EPS);
            const size_t r = (size_t)b * SEQ + t0 + st;
            const float o0 = sigm(bf2f(PROJ[r * NPROJ + PC_OM + h * MDK + lane])), o1 = sigm(bf2f(PROJ[r * NPROJ + PC_OM + h * MDK + 64 + lane]));
            YB[r * 1024 + h * MDK + lane] = (bf16)f2bf(h0 * rr * gh[lane] * o0); YB[r * 1024 + h * MDK + 64 + lane] = (bf16)f2bf(h1 * rr * gh[64 + lane] * o1); }
        __syncthreads();
    }
}
typedef short bf16x8s __attribute__((ext_vector_type(8)));
typedef short s16x4 __attribute__((ext_vector_type(4)));
typedef float f32x16 __attribute__((ext_vector_type(16)));
constexpr size_t ST_DCT = WS_ST, ST_DN = WS_ST + 16 * MiB, ST_NIN = ST_DN + 128 * 1024, ST_MLOC = ST_NIN + 128 * 1024, ST_BL = ST_MLOC + 4096, ST_MIN = ST_BL + 4096;
constexpr size_t ST_CINT = WS_MIXED;
constexpr int SM_OFF = LDSCTL_OFF + 1024;
__device__ __forceinline__ unsigned off_b(unsigned row, unsigned ch) { return 256u * row + 16u * (ch ^ (((row & 3u) << 2) | ((row >> 2) & 3u))); }
__device__ __forceinline__ s16x4 vtr(const LAS unsigned char* p) { return __builtin_bit_cast(s16x4, __builtin_amdgcn_ds_read_tr16_b64_v4i16((LAS s16x4*)p)); }
__device__ __forceinline__ int crow(int r, int hi) { return (r & 3) + 8 * (r >> 2) + 4 * hi; }
__device__ __forceinline__ float shu(float v, int o, int lane) { return __int_as_float(__builtin_amdgcn_ds_bpermute((lane - o) << 2, __float_as_int(v))); }
__device__ __forceinline__ float shl(float v, int src) { return __int_as_float(__builtin_amdgcn_ds_bpermute(src << 2, __float_as_int(v))); }
__device__ __forceinline__ float logsig(float x) { return fminf(x, 0.f) - log1pf(expf(-fabsf(x))); }
__device__ __forceinline__ bf16x8s tr_frag(const LAS unsigned char* img, int lane, int row0, int c) {
    const unsigned h = lane >> 5, blk = (lane >> 4) & 1, q = (lane & 15) >> 2, p = lane & 3;
    const s16x4 lo = vtr(img + off_b(row0 + 8 * h + q, 4 * c + 2 * blk + (p >> 1)) + 8 * (p & 1)), hi = vtr(img + off_b(row0 + 8 * h + 4 + q, 4 * c + 2 * blk + (p >> 1)) + 8 * (p & 1));
    return (bf16x8s){lo[0], lo[1], lo[2], lo[3], hi[0], hi[1], hi[2], hi[3]};
}
__device__ __forceinline__ bf16x8s tr_frag_perm(const LAS unsigned char* img, int lane, int row0, int c) {
    const unsigned h = lane >> 5, blk = (lane >> 4) & 1, q = (lane & 15) >> 2, p = lane & 3;
    const s16x4 lo = vtr(img + off_b(row0 + 4 * h + q, 4 * c + 2 * blk + (p >> 1)) + 8 * (p & 1)), hi = vtr(img + off_b(row0 + 8 + 4 * h + q, 4 * c + 2 * blk + (p >> 1)) + 8 * (p & 1));
    return (bf16x8s){lo[0], lo[1], lo[2], lo[3], hi[0], hi[1], hi[2], hi[3]};
}
__device__ __forceinline__ void chunk_gates(const float* ifpre, size_t row0, int h, int lane, float (&bc)[4], float (&ii)[4], float& bL) {
#pragma unroll
    for (int k = 0; k < 4; ++k) { const size_t r = row0 + 4 * lane + k; ii[k] = ifpre[r * 8 + h]; bc[k] = logsig(ifpre[r * 8 + 4 + h]); }
    bc[1] += bc[0]; bc[2] += bc[1]; bc[3] += bc[2];
    float inc = bc[3];
#pragma unroll
    for (int o = 1; o < 64; o <<= 1) { const float t = shu(inc, o, lane); if (lane >= o) inc += t; }
    const float excl = inc - bc[3];
#pragma unroll
    for (int k = 0; k < 4; ++k) bc[k] += excl;
    bL = shl(inc, 63);
}

__device__ __forceinline__ void phase_mlstm_m1(Frame& F, const Inputs& in, int l) {
    PHASE_LOCALS();
    const bf16* PROJ = (const bf16*)(F.ws + WS_PROJ); bf16* QKC = (bf16*)(F.ws + WS_QKC); const float* ifpre = (const float*)(F.ws + WS_IFPRE);
    float* dCT = (float*)(F.ws + ST_DCT); float* DN = (float*)(F.ws + ST_DN); float* MLOC = (float*)(F.ws + ST_MLOC); float* BL = (float*)(F.ws + ST_BL);
    LAS unsigned char* Kimg = F.lds; LAS unsigned char* Vimg = F.lds + 65536; LAS float* sw = (LAS float*)(F.lds + SM_OFF);
    const int r32 = lane & 31, hi = lane >> 5;
    for (int unit = F.vcu; unit < BATCH * MH * 16; unit += F.G) {
        const int bh = unit >> 4, c = unit & 15, b = bh >> 2, h = bh & 3; const size_t row0 = (size_t)b * SEQ + c * 256;
        { const float* cw = in.p[I_CONVW] + (size_t)l * 4 * 1024; const float* cb = in.p[I_CONVB] + (size_t)l * 1024;
          const int cc = tid & 31, c0 = (cc < 16 ? 0 : 512) + h * MDK + 8 * (cc & 15), run = tid >> 5; const float sc = (cc >= 16) ? 0.08838834764831845f : 1.0f;
          float w[4][8], bia[8];
#pragma unroll
          for (int j = 0; j < 4; ++j) { const f32x4 w0 = *(const f32x4*)(cw + j * 1024 + c0), w1 = *(const f32x4*)(cw + j * 1024 + c0 + 4);
              w[j][0] = w0[0]; w[j][1] = w0[1]; w[j][2] = w0[2]; w[j][3] = w0[3]; w[j][4] = w1[0]; w[j][5] = w1[1]; w[j][6] = w1[2]; w[j][7] = w1[3]; }
          { const f32x4 b0 = *(const f32x4*)(cb + c0), b1 = *(const f32x4*)(cb + c0 + 4); bia[0] = b0[0]; bia[1] = b0[1]; bia[2] = b0[2]; bia[3] = b0[3]; bia[4] = b1[0]; bia[5] = b1[1]; bia[6] = b1[2]; bia[7] = b1[3]; }
          const size_t r0 = row0 + 16 * run; const bool first = (c == 0 && run == 0);
          v4u xin[19];
#pragma unroll
          for (int i = 0; i < 19; ++i) { xin[i] = (v4u){0u, 0u, 0u, 0u}; if (i >= 3 || !first) xin[i] = *(const v4u*)(PROJ + (r0 - 3 + i) * NPROJ + PC_QKM + c0); }
#pragma unroll
          for (int i = 0; i < 16; ++i) { float a[8];
#pragma unroll
              for (int k = 0; k < 8; ++k) a[k] = bia[k];
#pragma unroll
              for (int j = 0; j < 4; ++j) { const v4u x = xin[i + j];
                  a[0] += w[j][0] * bflo(x.x); a[1] += w[j][1] * bfhi(x.x); a[2] += w[j][2] * bflo(x.y); a[3] += w[j][3] * bfhi(x.y); a[4] += w[j][4] * bflo(x.z); a[5] += w[j][5] * bfhi(x.z); a[6] += w[j][6] * bflo(x.w); a[7] += w[j][7] * bfhi(x.w); }
#pragma unroll
              for (int k = 0; k < 8; ++k) a[k] = a[k] * sigm(a[k]) * sc;
              v4u o; o.x = pk2(a[0], a[1]); o.y = pk2(a[2], a[3]); o.z = pk2(a[4], a[5]); o.w = pk2(a[6], a[7]);
              *(v4u*)(QKC + (r0 + i) * 1024 + c0) = o; } }
        if (F.wave == 0) {
            float bc[4], ii[4], bL; chunk_gates(ifpre, row0, h, lane, bc, ii, bL);
            float g[4]; float mx = -INFINITY;
#pragma unroll
            for (int k = 0; k < 4; ++k) { g[k] = bL - bc[k] + ii[k]; mx = fmaxf(mx, g[k]); }
            mx = wave_max(mx, lane);
#pragma unroll
            for (int k = 0; k < 4; ++k) sw[4 * lane + k] = pg8::ex2((g[k] - mx) * 1.4426950408889634f);
            if (lane == 0) { MLOC[unit] = mx; BL[unit] = bL; }
        }
        asm volatile("s_waitcnt vmcnt(0)" ::: "memory");
        __syncthreads();
        for (int i = tid; i < 4096; i += NTHR) { const int s = i >> 4, ch = i & 15; const float w = sw[s];
            const v4u kv = *(const v4u*)(QKC + (row0 + s) * 1024 + 512 + h * MDK + 8 * ch);
            v4u ko; ko.x = pk2(bflo(kv.x) * w, bfhi(kv.x) * w); ko.y = pk2(bflo(kv.y) * w, bfhi(kv.y) * w); ko.z = pk2(bflo(kv.z) * w, bfhi(kv.z) * w); ko.w = pk2(bflo(kv.w) * w, bfhi(kv.w) * w);
            *(LAS v4u*)(Kimg + off_b(s, ch)) = ko;
            *(LAS v4u*)(Vimg + off_b(s, ch)) = *(const v4u*)(PROJ + (row0 + s) * NPROJ + PC_VM + h * MDK + 8 * ch); }
        __syncthreads();
        const int dt = F.wave >> 1, c0 = 2 * (F.wave & 1);
        f32x16 acc0, acc1;
#pragma unroll
        for (int i = 0; i < 16; ++i) { acc0[i] = 0.f; acc1[i] = 0.f; }
#pragma unroll 4
        for (int ks = 0; ks < 16; ++ks) {
            const bf16x8s a = tr_frag(Kimg, lane, 16 * ks, dt), b0 = tr_frag(Vimg, lane, 16 * ks, c0), b1 = tr_frag(Vimg, lane, 16 * ks, c0 + 1);
            acc0 = __builtin_amdgcn_mfma_f32_32x32x16_bf16(a, b0, acc0, 0, 0, 0);
            acc1 = __builtin_amdgcn_mfma_f32_32x32x16_bf16(a, b1, acc1, 0, 0, 0);
        }
#pragma unroll
        for (int g = 0; g < 4; ++g) { const int d = 32 * dt + 8 * g + 4 * hi;
            *(f32x4*)(dCT + ((size_t)unit * 128 + 32 * c0 + r32) * 128 + d) = (f32x4){acc0[4 * g], acc0[4 * g + 1], acc0[4 * g + 2], acc0[4 * g + 3]};
            *(f32x4*)(dCT + ((size_t)unit * 128 + 32 * (c0 + 1) + r32) * 128 + d) = (f32x4){acc1[4 * g], acc1[4 * g + 1], acc1[4 * g + 2], acc1[4 * g + 3]}; }
        { const int d = tid & 127, part = tid >> 7; float s0 = 0.f, s1 = 0.f;
#pragma unroll 8
            for (int t = 0; t < 64; t += 2) { s0 += bf2f(*(const LAS bf16*)(Kimg + off_b(64 * part + t, d >> 3) + 2 * (d & 7))); s1 += bf2f(*(const LAS bf16*)(Kimg + off_b(64 * part + t + 1, d >> 3) + 2 * (d & 7))); }
            sw[256 + tid] = s0 + s1; }
        __syncthreads();
        if (tid < 128) DN[(size_t)unit * 128 + tid] = (sw[256 + tid] + sw[256 + 128 + tid]) + (sw[256 + 256 + tid] + sw[256 + 384 + tid]);
        __syncthreads();
    }
}

__device__ __forceinline__ void phase_mlstm_m2(Frame& F) {
    PHASE_LOCALS();
    const float* dCT = (const float*)(F.ws + ST_DCT); const float* DN = (const float*)(F.ws + ST_DN); const float* MLOC = (const float*)(F.ws + ST_MLOC); const float* BL = (const float*)(F.ws + ST_BL);
    bf16* CinT = (bf16*)(F.ws + ST_CINT); float* NIN = (float*)(F.ws + ST_NIN); float* MIN = (float*)(F.ws + ST_MIN);
    LAS float* al = (LAS float*)(F.lds + SM_OFF); LAS float* be = al + 16;
    for (int item = F.vcu; item < 256; item += F.G) {
        const int bh = item >> 4, sl = item & 15;
        if (tid == 0) { float m = 0.f;
            for (int c = 0; c < 16; ++c) { const int u = bh * 16 + c; const float bl = BL[u], ml = MLOC[u]; if (sl == 0) MIN[u] = m;
                const float mo = fmaxf(bl + m, ml); al[c] = expf(bl + m - mo); be[c] = expf(ml - mo); m = mo; } }
        __syncthreads();
        { const size_t idx = (size_t)sl * 1024 + 2 * tid; float s0 = 0.f, s1 = 0.f;
#pragma unroll
            for (int c = 0; c < 16; ++c) { const size_t u = (size_t)bh * 16 + c; const float2 dc = *(const float2*)(dCT + u * 16384 + idx);
                *(unsigned*)(CinT + u * 16384 + idx) = pk2(s0, s1); s0 = al[c] * s0 + be[c] * dc.x; s1 = al[c] * s1 + be[c] * dc.y; } }
        if (sl == 0 && tid < 128) { float s = 0.f;
#pragma unroll
            for (int c = 0; c < 16; ++c) { const size_t u = (size_t)bh * 16 + c; NIN[u * 128 + tid] = s; s = al[c] * s + be[c] * DN[u * 128 + tid]; } }
        __syncthreads();
    }
}

__device__ __forceinline__ void phase_mlstm_m3(Frame& F, const Inputs& in, int l, int reps = 1) {
    PHASE_LOCALS();
    const bf16* PROJ = (const bf16*)(F.ws + WS_PROJ); const bf16* QKC = (const bf16*)(F.ws + WS_QKC); const float* ifpre = (const float*)(F.ws + WS_IFPRE);
    const float* dCT = (const float*)(F.ws + ST_DCT); const float* DN = (const float*)(F.ws + ST_DN); const float* MLOC = (const float*)(F.ws + ST_MLOC); const float* BLV = (const float*)(F.ws + ST_BL); bf16* YB = (bf16*)(F.ws + WS_YB);
    const float* gh = in.p[I_GH] + l * MDK;
    LAS unsigned char* Vimg = F.lds; LAS unsigned char* Cimg = F.lds + 65536; LAS unsigned char* Kimg = F.lds + 65536;
    LAS float* us = (LAS float*)(F.lds + SM_OFF); LAS float* Mt = us + 256; LAS float* aw = Mt + 256; LAS float* em = aw + 256; LAS float* inv = em + 256; LAS float* nin_s = inv + 256; LAS float* coef = nin_s + 128;
    const int r32 = lane & 31, hi = lane >> 5, wave = F.wave;
    for (int unit = F.vcu; unit < reps * BATCH * MH * 16; unit += F.G) {
        const int unit_ = unit; { const int unit = unit_ & (BATCH * MH * 16 - 1);
        const int bh = unit >> 4, c = unit & 15, b = bh >> 2, h = bh & 3; const size_t row0 = (size_t)b * SEQ + c * 256;
        if (tid < 32) coef[tid] = (tid < 16) ? BLV[bh * 16 + tid] : MLOC[bh * 16 + tid - 16];
        for (int i = tid; i < 4096; i += NTHR) { const int s = i >> 4, ch = i & 15;
            *(LAS v4u*)(Vimg + off_b(s, ch)) = *(const v4u*)(PROJ + (row0 + s) * NPROJ + PC_VM + h * MDK + 8 * ch); }
        __syncthreads();
        if (tid == 0) { float mm = 0.f;
            for (int cc = 0; cc < c; ++cc) { const float bl = coef[cc], ml = coef[16 + cc], mo = fmaxf(bl + mm, ml); coef[cc] = pg8::ex2((bl + mm - mo) * 1.4426950408889634f); coef[16 + cc] = pg8::ex2((ml - mo) * 1.4426950408889634f); mm = mo; }
            coef[32] = mm; }
        __syncthreads();
        { float st[32];
#pragma unroll
            for (int i = 0; i < 32; ++i) st[i] = 0.f;
            f32x4 sa[8], sb[8], sc[8];
            const float* sbase = dCT + ((size_t)(bh * 16)) * 16384 + 32 * tid;
#define M3_LD(buf, cc_) do { const int ci_ = ((cc_) < 15) ? (cc_) : 15;   \
                const f32x4* src_ = (const f32x4*)(sbase + (size_t)ci_ * 16384); _Pragma("unroll") for (int i = 0; i < 8; ++i) buf[i] = src_[i]; __builtin_amdgcn_sched_barrier(0); } while (0)
#define M3_FM(buf, cc_) do { if ((cc_) < c) { const float al = coef[(cc_)], be = coef[16 + (cc_)]; \
                _Pragma("unroll") for (int i = 0; i < 8; ++i) { const f32x4 v = buf[i]; st[4 * i] = al * st[4 * i] + be * v[0]; st[4 * i + 1] = al * st[4 * i + 1] + be * v[1]; st[4 * i + 2] = al * st[4 * i + 2] + be * v[2]; st[4 * i + 3] = al * st[4 * i + 3] + be * v[3]; } } \
                __builtin_amdgcn_sched_barrier(0); } while (0)
            if (c > 0) { M3_LD(sa, 0); M3_LD(sb, 1);
                for (int cc = 0; cc < c; cc += 3) { M3_LD(sc, cc + 2); M3_FM(sa, cc); M3_LD(sa, cc + 3); M3_FM(sb, cc + 1); M3_LD(sb, cc + 4); M3_FM(sc, cc + 2); } }
#undef M3_LD
#undef M3_FM
            LAS unsigned char* dst = Cimg + (tid >> 2) * 272 + (tid & 3) * 64;
#pragma unroll
            for (int i = 0; i < 4; ++i) { v4u o; o.x = pk2(st[8 * i], st[8 * i + 1]); o.y = pk2(st[8 * i + 2], st[8 * i + 3]); o.z = pk2(st[8 * i + 4], st[8 * i + 5]); o.w = pk2(st[8 * i + 6], st[8 * i + 7]); *(LAS v4u*)(dst + 16 * i) = o; }
            if (tid < 128) { float dnv[16];
#pragma unroll
                for (int cc = 0; cc < 16; ++cc) dnv[cc] = DN[((size_t)(bh * 16 + cc)) * 128 + tid];
                float sn = 0.f;
#pragma unroll
                for (int cc = 0; cc < 16; ++cc) if (cc < c) sn = coef[cc] * sn + coef[16 + cc] * dnv[cc];
                nin_s[tid] = sn; } }
        if (wave == 0) {
            float bc[4], ii[4], bL; chunk_gates(ifpre, row0, h, lane, bc, ii, bL);
            float u[4], pm[4];
#pragma unroll
            for (int k = 0; k < 4; ++k) u[k] = ii[k] - bc[k];
            pm[0] = u[0]; pm[1] = fmaxf(pm[0], u[1]); pm[2] = fmaxf(pm[1], u[2]); pm[3] = fmaxf(pm[2], u[3]);
            float inc = pm[3];
#pragma unroll
            for (int o = 1; o < 64; o <<= 1) { const float t = shu(inc, o, lane); if (lane >= o) inc = fmaxf(inc, t); }
            float excl = shu(inc, 1, lane); if (lane == 0) excl = -INFINITY;
            const float m_in = coef[32];
#pragma unroll
            for (int k = 0; k < 4; ++k) { const float Mx = fmaxf(m_in, fmaxf(pm[k], excl)); const int s = 4 * lane + k; us[s] = u[k]; Mt[s] = Mx; aw[s] = pg8::ex2((m_in - Mx) * 1.4426950408889634f); em[s] = pg8::ex2(-(bc[k] + Mx) * 1.4426950408889634f); }
        }
        __syncthreads();
        const int t = 32 * wave + r32;
        bf16x8s qf[8];
#pragma unroll
        for (int ks = 0; ks < 8; ++ks) qf[ks] = *(const bf16x8s*)(QKC + (row0 + t) * 1024 + h * MDK + 16 * ks + 8 * hi);
        float qn = 0.f;
#pragma unroll
        for (int ks = 0; ks < 8; ++ks)
#pragma unroll
            for (int j = 0; j < 8; ++j) qn += bf2f((bf16)qf[ks][j]) * nin_s[16 * ks + 8 * hi + j];
        qn += shx(qn, 32, lane);
        f32x16 acc[4];
#pragma unroll
        for (int cc = 0; cc < 4; ++cc)
#pragma unroll
            for (int i = 0; i < 16; ++i) acc[cc][i] = 0.f;
#pragma unroll
        for (int cc = 0; cc < 4; ++cc)
#pragma unroll
            for (int ks = 0; ks < 8; ++ks) { const bf16x8s bq = *(const LAS bf16x8s*)(Cimg + (32 * cc + r32) * 272 + 2 * (16 * ks + 8 * hi));
                acc[cc] = __builtin_amdgcn_mfma_f32_32x32x16_bf16(qf[ks], bq, acc[cc], 0, 0, 0); }
#pragma unroll
        for (int rg = 0; rg < 16; ++rg) { const float a = aw[32 * wave + crow(rg, hi)];
#pragma unroll
            for (int cc = 0; cc < 4; ++cc) acc[cc][rg] *= a; }
        { v4u kst[8];
#pragma unroll
          for (int i = 0; i < 8; ++i) { const int idx = tid + NTHR * i, s_ = idx >> 4, ch = idx & 15; kst[i] = *(const v4u*)(QKC + (row0 + s_) * 1024 + 512 + h * MDK + 8 * ch); }
          __syncthreads();
#pragma unroll
          for (int i = 0; i < 8; ++i) { const int idx = tid + NTHR * i, s_ = idx >> 4, ch = idx & 15; *(LAS v4u*)(Kimg + off_b(s_, ch)) = kst[i]; }
          __syncthreads(); }
        const float Ml = Mt[t]; float den = 0.f;
        for (int j = 0; j <= wave; ++j) {
            f32x16 X;
#pragma unroll
            for (int i = 0; i < 16; ++i) X[i] = 0.f;
#pragma unroll
            for (int ks = 0; ks < 8; ++ks) { const bf16x8s ka = *(const LAS bf16x8s*)(Kimg + off_b(32 * j + r32, 2 * ks + hi));
                X = __builtin_amdgcn_mfma_f32_32x32x16_bf16(ka, qf[ks], X, 0, 0, 0); }
#pragma unroll
            for (int rg = 0; rg < 16; ++rg) { const int s = 32 * j + crow(rg, hi); float w = pg8::ex2((us[s] - Ml) * 1.4426950408889634f); if (s > t) w = 0.f;     const float pv = X[rg] * w; X[rg] = pv; den += pv; }
            v4u p0, p1;
            p0.x = pk2(X[0], X[1]); p0.y = pk2(X[2], X[3]); p0.z = pk2(X[4], X[5]); p0.w = pk2(X[6], X[7]);
            p1.x = pk2(X[8], X[9]); p1.y = pk2(X[10], X[11]); p1.z = pk2(X[12], X[13]); p1.w = pk2(X[14], X[15]);
            const bf16x8s pa0 = __builtin_bit_cast(bf16x8s, p0), pa1 = __builtin_bit_cast(bf16x8s, p1);
#pragma unroll
            for (int cc = 0; cc < 4; ++cc) {
                acc[cc] = __builtin_amdgcn_mfma_f32_32x32x16_bf16(pa0, tr_frag_perm(Vimg, lane, 32 * j, cc), acc[cc], 0, 0, 0);
                acc[cc] = __builtin_amdgcn_mfma_f32_32x32x16_bf16(pa1, tr_frag_perm(Vimg, lane, 32 * j + 16, cc), acc[cc], 0, 0, 0); }
        }
        den += shx(den, 32, lane);
        { const float dt = aw[t] * qn + den; inv[t] = 1.0f / fmaxf(fabsf(dt), em[t]); }
        asm volatile("s_waitcnt lgkmcnt(0)" ::: "memory");
        float rr[16];
#pragma unroll
        for (int rg = 0; rg < 16; ++rg) { const float f = inv[32 * wave + crow(rg, hi)]; float sq = 0.f;
#pragma unroll
            for (int cc = 0; cc < 4; ++cc) { acc[cc][rg] *= f; sq += acc[cc][rg] * acc[cc][rg]; }
#pragma unroll
            for (int o = 1; o < 32; o <<= 1) sq += shx(sq, o, lane);
            rr[rg] = 1.0f / sqrtf(sq * (1.0f / MDK) + RMS_EPS); }
#pragma unroll
        for (int cc = 0; cc < 4; ++cc) { const int e = 32 * cc + r32; const float ge = gh[e];
#pragma unroll
            for (int rg = 0; rg < 16; ++rg) { const size_t r = row0 + 32 * wave + crow(rg, hi);
                const float o = sigm(bf2f(PROJ[r * NPROJ + PC_OM + h * MDK + e]));
                YB[r * 1024 + h * MDK + e] = (bf16)f2bf(acc[cc][rg] * rr[rg] * ge * o); } }
        __syncthreads();
        }
    }
}
#include <hip/hip_bf16.h>
namespace attn_body {
using bf16=__hip_bfloat16;
using bf16x8=__attribute__((ext_vector_type(8)))short;
using s16x4=__attribute__((ext_vector_type(4)))short;
using f32x16=__attribute__((ext_vector_type(16)))float;
using u32x4=__attribute__((ext_vector_type(4)))unsigned;
using f32x4_t=__attribute__((ext_vector_type(4)))float;
constexpr int BATCH=4,NHEAD=8,SEQ=4096,D=64,DM=3584,DMO=1024;
constexpr float NEGBIG=-200.f;
constexpr int NW=8,QBLK=32,QB=QBLK*NW,KVBLK=64,NQB=SEQ/QB;
constexpr int ATTN_PITCH=DM, ATTN_UNIT_ROWS=QB;
__device__ __forceinline__ int crow(int r,int hi){return (r&3)+8*(r>>2)+4*hi;}
#define SBAR() __builtin_amdgcn_sched_barrier(0)
__device__ __forceinline__ void cmask(f32x16&p0,f32x16&p1,int jb,int qrel,int hi){
  const float NEG=-INFINITY; int kb=64*jb+4*hi;
  #pragma unroll
  for(int r=0;r<16;++r){int kv=kb+(r&3)+8*(r>>2); if(kv>qrel)p0[r]=NEG; if(kv+32>qrel)p1[r]=NEG;}
}

constexpr int NSLOT=3, SLOTB=8192;
constexpr int LDS_K=0, LDS_V=NSLOT*SLOTB, LDS_WS=2*NSLOT*SLOTB, LDS_OST=LDS_WS+NW*64*4, LDS_KMS=LDS_OST+NW*4096  , LDS_BYTES=LDS_KMS+4096;
constexpr float C2=0.125f*1.4426950408889634f;
__device__ __forceinline__ void glds16(const void*gsrc,unsigned lds_dst){unsigned keep;
  asm volatile("s_mov_b32 %0, m0\n\ts_mov_b32 m0, %2\n\ts_nop 0\n\tglobal_load_lds_dwordx4 %1, off\n\ts_mov_b32 m0, %0":"=&s"(keep):"v"(gsrc),"s"(lds_dst):"memory");}
__device__ __forceinline__ float max3f(float a,float b,float c){float r;asm("v_max3_f32 %0, %1, %2, %3":"=v"(r):"v"(a),"v"(b),"v"(c));return r;}
__device__ __forceinline__ float max2f(float a,float b){float r;asm("v_max_f32_e32 %0, %1, %2":"=v"(r):"v"(a),"v"(b));return r;}
__device__ __forceinline__ float fadd_s(float a,float b){float r;asm("v_add_f32_e32 %0, %1, %2":"=v"(r):"v"(a),"v"(b));return r;}
__device__ __forceinline__ float fsub_s(float a,float b){float r;asm("v_sub_f32_e32 %0, %1, %2":"=v"(r):"v"(a),"v"(b));return r;}
typedef float f32x2_t __attribute__((ext_vector_type(2))); typedef __bf16 bf16x2_t __attribute__((ext_vector_type(2)));
__device__ __forceinline__ unsigned cvtpk_s(float lo,float hi){f32x2_t v={lo,hi};bf16x2_t b=__builtin_convertvector(v,bf16x2_t);return __builtin_bit_cast(unsigned,b);}
#define WAIT_BAR(N) asm volatile("s_waitcnt vmcnt(" #N ") lgkmcnt(0)\n\ts_barrier":::"memory")

__device__ __forceinline__ void qkt(f32x16&p0,f32x16&p1,const char*Kslot,const bf16x8*qr,const f32x16&negm,int r32,int hi){
  const char*kb=Kslot+hi*1024+r32*16;
  #pragma unroll
  for(int d0=0;d0<4;++d0){
    const bf16x8 b0=*reinterpret_cast<const bf16x8*>(kb+d0*2048);
    const bf16x8 b1=*reinterpret_cast<const bf16x8*>(kb+d0*2048+512);
    if(d0==0){p0=__builtin_amdgcn_mfma_f32_32x32x16_bf16(b0,qr[0],negm,0,0,0);p1=__builtin_amdgcn_mfma_f32_32x32x16_bf16(b1,qr[0],negm,0,0,0);}
    else{p0=__builtin_amdgcn_mfma_f32_32x32x16_bf16(b0,qr[d0],p0,0,0,0);p1=__builtin_amdgcn_mfma_f32_32x32x16_bf16(b1,qr[d0],p1,0,0,0);}}
}
typedef __attribute__((address_space(3))) const char* lds_cptr;
typedef short v4i16_t __attribute__((ext_vector_type(4)));
__device__ __forceinline__ void kload8(bf16x8*kf,lds_cptr kp){
  kf[0]=*(const __attribute__((address_space(3))) bf16x8*)(kp);      kf[1]=*(const __attribute__((address_space(3))) bf16x8*)(kp+512);
  kf[2]=*(const __attribute__((address_space(3))) bf16x8*)(kp+2048); kf[3]=*(const __attribute__((address_space(3))) bf16x8*)(kp+2560);
  kf[4]=*(const __attribute__((address_space(3))) bf16x8*)(kp+4096); kf[5]=*(const __attribute__((address_space(3))) bf16x8*)(kp+4608);
  kf[6]=*(const __attribute__((address_space(3))) bf16x8*)(kp+6144); kf[7]=*(const __attribute__((address_space(3))) bf16x8*)(kp+6656);
}
__device__ __forceinline__ void kload2(bf16x8*kf,lds_cptr kp,int j){ kf[2*j]=*(const __attribute__((address_space(3))) bf16x8*)(kp+j*2048); kf[2*j+1]=*(const __attribute__((address_space(3))) bf16x8*)(kp+j*2048+512); }
__device__ __forceinline__ s16x4 vtr(lds_cptr p){ return __builtin_bit_cast(s16x4,__builtin_amdgcn_ds_read_tr16_b64_v4i16((__attribute__((address_space(3))) v4i16_t*)p)); }
__device__ __forceinline__ float rowmax(const f32x16&p0,const f32x16&p1){
  float a=max3f(p0[0],p0[1],p1[0]),b=max3f(p0[2],p0[3],p1[1]);a=max3f(a,p1[2],p1[3]);
  #pragma unroll
  for(int r=4;r<16;r+=4){a=max3f(a,p0[r],p0[r+1]);b=max3f(b,p0[r+2],p0[r+3]);a=max3f(a,p1[r],p1[r+1]);b=max3f(b,p1[r+2],p1[r+3]);}
  const float m=max2f(a,b);
  auto rr=__builtin_amdgcn_permlane32_swap(__float_as_uint(m),__float_as_uint(m),false,false);
  return max2f(__uint_as_float(rr[0]),__uint_as_float(rr[1]));
}
__device__ __forceinline__ void pv(f32x16*o,int vb,bf16x8 pa0,bf16x8 pa1,bf16x8 pa2,bf16x8 pa3){
  #pragma unroll
  for(int d0=0;d0<2;++d0){s16x4 lo[4],hi[4];
    #pragma unroll
    for(int ks=0;ks<4;++ks){
      asm volatile("ds_read_b64_tr_b16 %0,%1 offset:%c2":"=&v"(lo[ks]):"v"(vb),"i"(d0*4096+ks*1024):"memory");
      asm volatile("ds_read_b64_tr_b16 %0,%1 offset:%c2":"=&v"(hi[ks]):"v"(vb),"i"(d0*4096+ks*1024+512):"memory");}
    asm volatile("s_waitcnt lgkmcnt(0)":::"memory");SBAR();
    #define PK(k) (bf16x8){lo[k][0],lo[k][1],lo[k][2],lo[k][3],hi[k][0],hi[k][1],hi[k][2],hi[k][3]}
    o[d0]=__builtin_amdgcn_mfma_f32_32x32x16_bf16(pa0,PK(0),o[d0],0,0,0);
    o[d0]=__builtin_amdgcn_mfma_f32_32x32x16_bf16(pa1,PK(1),o[d0],0,0,0);
    o[d0]=__builtin_amdgcn_mfma_f32_32x32x16_bf16(pa2,PK(2),o[d0],0,0,0);
    o[d0]=__builtin_amdgcn_mfma_f32_32x32x16_bf16(pa3,PK(3),o[d0],0,0,0);
    #undef PK
  }
}

#ifndef ATTN_STORE16
#define ATTN_STORE16(p,v) (*(u32x4*)(p)=(v))
#endif
template<int THRL> __device__ __forceinline__ void attn_unit(int b,int h,int qb,const bf16*Q,const bf16*__restrict__ K,const bf16*__restrict__ V,bf16*O,const float*__restrict__ kmean,char*shm,int wave_in){
  int tid_; asm volatile("v_mbcnt_lo_u32_b32 %0, -1, 0\n\tv_mbcnt_hi_u32_b32 %0, -1, %0":"=v"(tid_)); tid_+=64*wave_in; const int tid=tid_,lane=tid&63,r32=lane&31,hi=lane>>5; const int wid=__builtin_amdgcn_readfirstlane(tid>>6);
  const long rowbase=(long)b*SEQ; const int q0=qb*QB;
  const bf16*Qw=Q+(rowbase+q0+wid*QBLK)*DM+h*D;
  const bf16*Kh=K+rowbase*DM+h*D,*Vh=V+rowbase*DM+h*D;
  const unsigned lds0=(unsigned)(uintptr_t)shm;
  float*wsf=(float*)(shm+LDS_WS)+wid*64;
  const bf16*ksrc=Kh+(long)lane*DM+wid*8;
  const bf16*vsrc=Vh+(long)(16*(wid&3)+(lane>>2))*DM+(wid>>2)*32+(lane&3)*8;
  const unsigned kdst=lds0+LDS_K+wid*1024, vdst=lds0+LDS_V+wid*1024;
  #define DMA_K(t,slot) glds16(ksrc+(long)(t)*KVBLK*DM,(unsigned)__builtin_amdgcn_readfirstlane(kdst+(slot)))
  #define DMA_V(t,slot) glds16(vsrc+(long)(t)*KVBLK*DM,(unsigned)__builtin_amdgcn_readfirstlane(vdst+(slot)))
  const int vb0=(int)(lds0+LDS_V)+((lane>>4)&1)*32+(lane&3)*8+(4*hi+((lane&15)>>2))*64;
  const char*Kbase=shm+LDS_K; bf16x8 kf[8];
  const lds_cptr shm3=(lds_cptr)shm; const lds_cptr kp0=shm3+LDS_K+hi*1024+r32*16; const lds_cptr vp0=shm3+LDS_V+((lane>>4)&1)*32+(lane&3)*8+(4*hi+((lane&15)>>2))*64;
  const int NT=(q0+QB)/KVBLK;
  DMA_K(0,0);DMA_V(0,0);DMA_K(1,SLOTB);
  bf16x8 qr[4];
  #pragma unroll
  for(int d0=0;d0<4;++d0)qr[d0]=*reinterpret_cast<const bf16x8*>(&Qw[(long)r32*DM+d0*16+hi*8]);

  unsigned selm=0u;
  if(qb>0){
    typedef __attribute__((address_space(3))) f32x4_t lds_f4;
    if(wid<4){ const int n_=tid>>4,d4_=(tid&15)*4; const f32x4_t s_=*reinterpret_cast<const f32x4_t*>(kmean+n_*128+d4_)+*reinterpret_cast<const f32x4_t*>(kmean+n_*128+64+d4_);
      *(lds_f4*)((lds_cptr)shm+LDS_KMS+(n_*64+d4_)*4)=s_; }
    asm volatile("s_waitcnt lgkmcnt(0)\n\ts_barrier":::"memory");
    float g[16];
    #pragma unroll
    for(int n=0;n<16;++n)g[n]=-INFINITY;
    #pragma unroll
    for(int n=0;n<15;++n) if(n<qb){
      const lds_cptr km=(lds_cptr)shm+LDS_KMS+(n*64+8*hi)*4; float a=0.f;
      #pragma unroll
      for(int d0=0;d0<4;++d0){ const f32x4_t k0=*(const lds_f4*)(km+64*d0),k1=*(const lds_f4*)(km+64*d0+16);
        #pragma unroll
        for(int j=0;j<4;++j){ a+=__uint_as_float((unsigned)(unsigned short)qr[d0][j]<<16)*k0[j]; a+=__uint_as_float((unsigned)(unsigned short)qr[d0][4+j]<<16)*k1[j]; } }
      auto rr=__builtin_amdgcn_permlane32_swap(__float_as_uint(a),__float_as_uint(a),false,false); g[n]=__uint_as_float(rr[0])+__uint_as_float(rr[1]);
    }
    #pragma unroll
    for(int s=0;s<3;++s) if(s<qb){ float best=-INFINITY; int bi=0;
      #pragma unroll
      for(int n=0;n<15;++n) if(g[n]>best){best=g[n];bi=n;}
      selm|=1u<<bi;
      #pragma unroll
      for(int n=0;n<15;++n) if(n==bi)g[n]=-INFINITY; }
  }
  selm|=1u<<qb;
  float mhat=0.f,l_reg=0.f;f32x16 o[2];f32x16 negm; { float z_=0.f; asm volatile("":"+v"(z_));
    _Pragma("unroll") for(int r_=0;r_<16;++r_){o[0][r_]=z_;o[1][r_]=z_;negm[r_]=z_;} } asm volatile("":"+v"(negm));
  const int qrel=wid*QBLK+r32;
  #define NEGSET(blk) do{ const float nv_=((selm>>(blk))&1u)?-mhat:NEGBIG; _Pragma("unroll") for(int r_=0;r_<16;++r_)negm[r_]=nv_; asm volatile("":"+v"(negm)); }while(0)
  NEGSET(0);
  #define CMASK(P0,P1,t) do{int jb_=(t)-(NT-4); if(jb_>=0)cmask(P0,P1,jb_,qrel,hi); }while(0)
  bool resc=false;
  #define START(P0,P1) do{ const float rm=rowmax(P0,P1); resc=false; \
    { const float dl=rm; mhat=fadd_s(mhat,dl); \
      _Pragma("unroll") for(int r=0;r<16;++r){P0[r]=fsub_s(P0[r],dl);P1[r]=fsub_s(P1[r],dl);} \
      NEGSET(0); } \
    _Pragma("unroll") for(int r=0;r<16;++r)P0[r]=__builtin_amdgcn_exp2f(P0[r]); }while(0)
  #define RESC() do{ if(resc){ asm volatile("s_waitcnt lgkmcnt(0)":::"memory"); \
      _Pragma("unroll") for(int d_=0;d_<2;++d_) _Pragma("unroll") for(int r=0;r<16;++r)o[d_][r]*=wsf[crow(r,hi)]; } }while(0)
  f32x16 pA0,pA1,pB0,pB1;
  int sl_prev=0,sl_cur=0,sl_next=SLOTB;
  #define ROT() do{sl_prev=sl_cur;sl_cur=sl_next;sl_next=(sl_next==(NSLOT-1)*SLOTB)?0:sl_next+SLOTB;}while(0)
  DMA_K(2,2*SLOTB);
  WAIT_BAR(3);
  qkt(pA0,pA1,Kbase,qr,negm,r32,hi);asm volatile("s_nop 15\n\ts_nop 7":"+v"(pA0),"+v"(pA1));CMASK(pA0,pA1,0);
  START(pA0,pA1);
  _Pragma("unroll") for(int r=0;r<16;++r)pA1[r]=__builtin_amdgcn_exp2f(pA1[r]);
  WAIT_BAR(0);
  DMA_K(3,0);DMA_V(1,SLOTB);
  ROT();
  kload8(kf,kp0+sl_cur);
  WAIT_BAR(2);
  s16x4 vlo[8],vhi[8]; u32x4 pw0,pw1,pw2,pw3;
  #define PKW(P,B) cvtpk_s(P[B],P[B+1])
  #define PAF(k) __builtin_bit_cast(bf16x8,pw##k)
  #define VFR(i) (bf16x8){vlo[i][0],vlo[i][1],vlo[i][2],vlo[i][3],vhi[i][0],vhi[i][1],vhi[i][2],vhi[i][3]}
  #define PIN(x) asm volatile("":"+v"(x))
  #define MX3(a,b,c) __builtin_fmaxf(__builtin_fmaxf((a),(b)),(c))
  #define GAPA(MF,A0,A1,A2,A3,W0,W1,PW) do{ MF; sacc+=A0; sacc+=A1; sacc+=A2; sacc+=A3; PIN(sacc); W0; W1; PIN(PW); SBAR(); }while(0)
  #define EX(v) __builtin_amdgcn_exp2f(v)
  #define GAPB(MF,X,B) do{ MF; X[B]=EX(X[B]); X[B+1]=EX(X[B+1]); X[B+2]=EX(X[B+2]); X[B+3]=EX(X[B+3]); PIN(X); SBAR(); }while(0)
  #define VRD(i) do{ vlo[i]=vtr(vp_+(((i)>>2)*4096+((i)&3)*1024)); vhi[i]=vtr(vp_+(((i)>>2)*4096+((i)&3)*1024+512)); }while(0)
  #define KRD(G,j) do{ if(G){ kload2(kf,kp0+sl_next,j); SBAR(); } }while(0)
  #define STEP(C0,C1,P0,P1,t,GK,GV,GL) do{ SBAR(); \
    const lds_cptr vp_=vp0+sl_prev; \
    VRD(0); SBAR(); float sacc=(P0[0]+P0[1]); \
    GAPA(C0=__builtin_amdgcn_mfma_f32_32x32x16_bf16(kf[0],qr[0],negm,0,0,0), P0[2],P0[3],P0[4],P0[5],     pw0[0]=PKW(P0,0), pw0[1]=PKW(P0,2), pw0); \
    VRD(4); SBAR(); GAPA(C1=__builtin_amdgcn_mfma_f32_32x32x16_bf16(kf[1],qr[0],negm,0,0,0), P0[6],P0[7],P0[8],P0[9],     pw0[2]=PKW(P0,4), pw0[3]=PKW(P0,6), pw0); \
    VRD(1); SBAR(); GAPA(C0=__builtin_amdgcn_mfma_f32_32x32x16_bf16(kf[2],qr[1],C0,0,0,0),   P0[10],P0[11],P0[12],P0[13], pw1[0]=PKW(P0,8), pw1[1]=PKW(P0,10), pw1); \
    VRD(5); SBAR(); GAPA(C1=__builtin_amdgcn_mfma_f32_32x32x16_bf16(kf[3],qr[1],C1,0,0,0),   P0[14],P0[15],P1[0],P1[1],   pw1[2]=PKW(P0,12),pw1[3]=PKW(P0,14), pw1); \
    VRD(2); SBAR(); GAPA(C0=__builtin_amdgcn_mfma_f32_32x32x16_bf16(kf[4],qr[2],C0,0,0,0),   P1[2],P1[3],P1[4],P1[5],     pw2[0]=PKW(P1,0), pw2[1]=PKW(P1,2), pw2); \
    VRD(6); SBAR(); GAPA(C1=__builtin_amdgcn_mfma_f32_32x32x16_bf16(kf[5],qr[2],C1,0,0,0),   P1[6],P1[7],P1[8],P1[9],     pw2[2]=PKW(P1,4), pw2[3]=PKW(P1,6), pw2); \
    VRD(3); SBAR(); GAPA(C0=__builtin_amdgcn_mfma_f32_32x32x16_bf16(kf[6],qr[3],C0,0,0,0),   P1[10],P1[11],P1[12],P1[13], pw3[0]=PKW(P1,8), pw3[1]=PKW(P1,10), pw3); \
    VRD(7); SBAR(); GAPA(C1=__builtin_amdgcn_mfma_f32_32x32x16_bf16(kf[7],qr[3],C1,0,0,0),   P1[14],P1[15],0.f,0.f,       pw3[2]=PKW(P1,12),pw3[3]=PKW(P1,14), pw3); \
    l_reg+=sacc; \
    if(GK){DMA_K((t)+3,sl_cur);} if(GV){DMA_V((t)+1,sl_next);} \
    CMASK(C0,C1,t); \
    { float a=MX3(C0[0],C0[1],C1[0]),b=MX3(C0[2],C0[3],C1[1]); a=MX3(a,C1[2],C1[3]); \
      _Pragma("unroll") for(int r=4;r<16;r+=4){a=MX3(a,C0[r],C0[r+1]);b=MX3(b,C0[r+2],C0[r+3]);a=MX3(a,C1[r],C1[r+1]);b=MX3(b,C1[r+2],C1[r+3]);} \
      float rm=__builtin_fmaxf(a,b); { auto rr=__builtin_amdgcn_permlane32_swap(__float_as_uint(rm),__float_as_uint(rm),false,false); rm=__builtin_fmaxf(__uint_as_float(rr[0]),__uint_as_float(rr[1])); } \
      resc=false; \
      if(__builtin_expect(__any(rm>(float)THRL),0)){ const float dl=__builtin_fmaxf(rm,0.f); mhat+=dl; \
        _Pragma("unroll") for(int r=0;r<16;++r){C0[r]-=dl;C1[r]-=dl;} \
        NEGSET((t)>>2); \
        const float f=__builtin_amdgcn_exp2f(-dl); l_reg*=f; if(hi==0)wsf[r32]=f; resc=true; } } \
    SBAR(); \
    GAPB(o[0]=__builtin_amdgcn_mfma_f32_32x32x16_bf16(PAF(0),VFR(0),o[0],0,0,0), C0,0); \
    GAPB(o[1]=__builtin_amdgcn_mfma_f32_32x32x16_bf16(PAF(0),VFR(4),o[1],0,0,0), C0,4); \
    KRD(GL,0); GAPB(o[0]=__builtin_amdgcn_mfma_f32_32x32x16_bf16(PAF(1),VFR(1),o[0],0,0,0), C0,8); \
    KRD(GL,1); GAPB(o[1]=__builtin_amdgcn_mfma_f32_32x32x16_bf16(PAF(1),VFR(5),o[1],0,0,0), C0,12); \
    KRD(GL,2); GAPB(o[0]=__builtin_amdgcn_mfma_f32_32x32x16_bf16(PAF(2),VFR(2),o[0],0,0,0), C1,0); \
    KRD(GL,3); GAPB(o[1]=__builtin_amdgcn_mfma_f32_32x32x16_bf16(PAF(2),VFR(6),o[1],0,0,0), C1,4); \
    GAPB(o[0]=__builtin_amdgcn_mfma_f32_32x32x16_bf16(PAF(3),VFR(3),o[0],0,0,0), C1,8); \
    GAPB(o[1]=__builtin_amdgcn_mfma_f32_32x32x16_bf16(PAF(3),VFR(7),o[1],0,0,0), C1,12); \
    }while(0)
  int t=1;
  #undef CMASK
  #define CMASK(P0,P1,t) do{}while(0)
  for(;t+5<NT;t+=2){
    STEP(pB0,pB1,pA0,pA1,t,true,true,true);     WAIT_BAR(2); RESC(); ROT();
    if(((t+1)&3)==0)NEGSET((t+1)>>2);
    STEP(pA0,pA1,pB0,pB1,t+1,true,true,true);   WAIT_BAR(2); RESC(); ROT();
  }
  #undef CMASK
  #define CMASK(P0,P1,t) do{int jb_=(t)-(NT-4); if(jb_>=0)cmask(P0,P1,jb_,qrel,hi); }while(0)
  #define ENDW(tt) do{ if((tt)+3<NT){WAIT_BAR(2);} else if((tt)+2<NT){WAIT_BAR(1);} else {WAIT_BAR(0);} }while(0)
  for(;t+1<NT;t+=2){
    STEP(pB0,pB1,pA0,pA1,t,(t+3<NT),(t+1<NT),(t+1<NT));       ENDW(t);   RESC(); ROT();
    if(((t+1)&3)==0)NEGSET((t+1)>>2);
    STEP(pA0,pA1,pB0,pB1,t+1,(t+4<NT),(t+2<NT),(t+2<NT));     ENDW(t+1); RESC(); ROT();
  }
  STEP(pB0,pB1,pA0,pA1,NT-1,false,false,false); RESC();
  { float sacc=pB0[0]+pB0[1]; _Pragma("unroll") for(int r=2;r<16;++r)sacc+=pB0[r]; _Pragma("unroll") for(int r=0;r<16;++r)sacc+=pB1[r]; l_reg+=sacc;
    pw0=(u32x4){PKW(pB0,0),PKW(pB0,2),PKW(pB0,4),PKW(pB0,6)};pw1=(u32x4){PKW(pB0,8),PKW(pB0,10),PKW(pB0,12),PKW(pB0,14)};pw2=(u32x4){PKW(pB1,0),PKW(pB1,2),PKW(pB1,4),PKW(pB1,6)};pw3=(u32x4){PKW(pB1,8),PKW(pB1,10),PKW(pB1,12),PKW(pB1,14)};
    SBAR(); pv(o,vb0+sl_cur,PAF(0),PAF(1),PAF(2),PAF(3)); }
  #undef PKW
  #undef PAF
  #undef VFR
  #undef PIN
  #undef MX3
  #undef GAPA
  #undef GAPB
  #undef EX
  #undef VRD
  #undef KRD
  #undef STEP
  #undef ENDW
  {auto rr=__builtin_amdgcn_permlane32_swap(__float_as_uint(l_reg),__float_as_uint(l_reg),false,false);l_reg=__uint_as_float(rr[0])+__uint_as_float(rr[1]);}
  if(hi==0)wsf[32+r32]=l_reg;asm volatile("s_waitcnt lgkmcnt(0)":::"memory");
  float rli[16];
  #pragma unroll
  for(int r=0;r<16;++r)rli[r]=__builtin_amdgcn_rcpf(wsf[32+crow(r,hi)]);
  bf16*Ow=O+(rowbase+q0+wid*QBLK)*DMO+h*D;
  { bf16*stg=(bf16*)(shm+LDS_OST)+wid*2048;
    #pragma unroll
    for(int r=0;r<16;++r){const int orow=crow(r,hi);
      #pragma unroll
      for(int d0=0;d0<2;++d0)stg[orow*64+d0*32+r32]=__float2bfloat16(o[d0][r]*rli[r]);}
    asm volatile("s_waitcnt lgkmcnt(0)":::"memory");
    #pragma unroll
    for(int i=0;i<4;++i){const int row=i*8+(lane>>3),ch=lane&7; const u32x4 v=*(const u32x4*)(stg+row*64+ch*8); ATTN_STORE16(Ow+(long)row*DMO+ch*8,v);} }
  asm volatile("s_waitcnt lgkmcnt(0)\n\ts_barrier":::"memory");
  #undef DMA_K
  #undef DMA_V
  #undef CMASK
  #undef NEGSET
  #undef START
  #undef RESC
  #undef ROT
}
constexpr int ATTN_LDS_BYTES=LDS_BYTES;
struct AttnTensors { const bf16* Q; const bf16* K; const bf16* V; bf16* O; const float* kmean; };
struct AttnUnit { int bh; int qb; };
struct StaticOrder {
  int vcu,G;
  __device__ __forceinline__ explicit StaticOrder(int grid,int block):vcu((grid%8==0)?(block%8)*(grid/8)+block/8:block),G(grid){}
  __device__ __forceinline__ bool next(int i,AttnUnit&u)const{ const int idx=(i>>1)*G+vcu; if(idx>=BATCH*NHEAD*8)return false; const int s=idx&7; u.bh=idx>>3; u.qb=(i&1)?15-s:s; return true; }
  __device__ __forceinline__ void a_ready(const AttnUnit&)const{}
  __device__ __forceinline__ void done(const AttnUnit&)const{}
};
template<class Sched,int THRL=8> __device__ __forceinline__ void attn_phase(char*lds,const AttnTensors&T,const Sched&S,int wave_in){
  AttnUnit u;
  for(int i=0;S.next(i,u);++i){ S.a_ready(u); attn_unit<THRL>(u.bh/NHEAD,u.bh%NHEAD,u.qb,T.Q,T.K,T.V,T.O,T.kmean+(size_t)u.bh*16*128,lds,wave_in); S.done(u); }
}
#undef SBAR
#undef WAIT_BAR
}
__device__ __forceinline__ void phase_moe_route(Frame& F) {
    PHASE_LOCALS();
    if ((int)blockIdx.x >= 4 * (M / 256)) return;
    const int j = blockIdx.x >> 2, quarter = blockIdx.x & 3;
    const int* TOPI = (const int*)(F.ws + WS_TOPI); int* DEST = (int*)(F.ws + WS_DEST); int* ROWTOK = (int*)(F.ws + WS_ROWTOK); int* TILEE = (int*)(F.ws + WS_TILEE); int* NTILES = (int*)(F.ws + WS_NTILES);
    LAS int* cnt = (LAS int*)F.lds; LAS int* tot = cnt + 64 * 8; LAS int* basej = tot + 8; LAS int* pstart = basej + 8; LAS int* wcnt = pstart + 16; LAS int* dsts = wcnt + 32;
    for (int i = tid; i < 64 * 8; i += NTHR) cnt[i] = 0;
    __syncthreads();
    for (int m0 = tid; m0 < M; m0 += 8 * NTHR) { int2 e[8];
#pragma unroll
        for (int k = 0; k < 8; ++k) e[k] = *(const int2*)(TOPI + (size_t)(m0 + k * NTHR) * 2);
#pragma unroll
        for (int k = 0; k < 8; ++k) { const int m = m0 + k * NTHR; __hip_atomic_fetch_add(cnt + (m >> 8) * 8 + e[k].x, 1, __ATOMIC_RELAXED, __HIP_MEMORY_SCOPE_WORKGROUP); __hip_atomic_fetch_add(cnt + (m >> 8) * 8 + e[k].y, 1, __ATOMIC_RELAXED, __HIP_MEMORY_SCOPE_WORKGROUP); } }
    __syncthreads();
    if (tid < 8) { int s = 0, bj = 0; for (int jj = 0; jj < 64; ++jj) { if (jj == j) bj = s; s += cnt[jj * 8 + tid]; } tot[tid] = s; basej[tid] = bj; }
    __syncthreads();
    if (tid == 0) { int ps = 0; for (int e = 0; e < 8; ++e) { pstart[e] = ps; ps += (tot[e] + 255) & ~255; } pstart[8] = ps; }
    __syncthreads();
    const int m = 256 * j + tid; int e1 = -1, e2 = -1, rk1 = 0, rk2 = 0;
    if (tid < 256) { const int2 e = *(const int2*)(TOPI + (size_t)m * 2); e1 = e.x; e2 = e.y; }
    if (tid < 256) {
#pragma unroll
        for (int e = 0; e < 8; ++e) { const bool has = (e1 == e) || (e2 == e); const unsigned long long mask = __ballot(has); const int rk = __popcll(mask & ((1ull << lane) - 1ull));
            if (e1 == e) rk1 = rk; if (e2 == e) rk2 = rk; if (lane == 0) wcnt[F.wave * 8 + e] = __popcll(mask); }
    }
    __syncthreads();
    if (tid < 256) {
        int o1 = 0, o2 = 0;
        for (int w = 0; w < F.wave; ++w) { o1 += wcnt[w * 8 + e1]; o2 += wcnt[w * 8 + e2]; }
        const int d1 = pstart[e1] + basej[e1] + o1 + rk1, d2 = pstart[e2] + basej[e2] + o2 + rk2;
        if (quarter == 0) *(int2*)(DEST + (size_t)m * 2) = make_int2(d1, d2);
        dsts[2 * tid] = d1; dsts[2 * tid + 1] = d2;
    }
    __syncthreads();
    { const bf16* __restrict__ HB = (const bf16*)(F.ws + WS_HB); bf16* __restrict__ XG = (bf16*)(F.ws + WS_XG);
      for (int i0 = quarter * 64 * 128 + tid; i0 < (quarter + 1) * 64 * 128; i0 += 8 * NTHR) { v4u val[8];
#pragma unroll
          for (int k = 0; k < 8; ++k) { const int i = i0 + k * NTHR; val[k] = *(const v4u*)(HB + (size_t)(256 * j + (i >> 7)) * D + 8 * (i & 127)); }
#pragma unroll
          for (int k = 0; k < 8; ++k) { const int i = i0 + k * NTHR, t = i >> 7; const v4u w = val[k];
#define C8_(v) __builtin_amdgcn_fmed3f((v), -448.0f, 448.0f)
              int a_ = __builtin_amdgcn_cvt_pk_fp8_f32(C8_(bflo(w.x)), C8_(bfhi(w.x)), 0, false); a_ = __builtin_amdgcn_cvt_pk_fp8_f32(C8_(bflo(w.y)), C8_(bfhi(w.y)), a_, true);
              int b_ = __builtin_amdgcn_cvt_pk_fp8_f32(C8_(bflo(w.z)), C8_(bfhi(w.z)), 0, false); b_ = __builtin_amdgcn_cvt_pk_fp8_f32(C8_(bflo(w.w)), C8_(bfhi(w.w)), b_, true);
#undef C8_
              uint2 o8; o8.x = (unsigned)a_; o8.y = (unsigned)b_;
              *(uint2*)((unsigned char*)XG + (size_t)dsts[2 * t] * D + 8 * (i & 127)) = o8; *(uint2*)((unsigned char*)XG + (size_t)dsts[2 * t + 1] * D + 8 * (i & 127)) = o8; } } }
    if (j == 0 && quarter == 0) {
        const int nt = pstart[8] >> 8;
        for (int i = tid; i < nt; i += NTHR) { int e = 0; for (int k = 1; k < 8; ++k) if (256 * i >= pstart[k]) e = k; TILEE[i] = e; }
        if (tid == 0) NTILES[0] = nt;
    }
    __syncthreads();
}
__device__ __forceinline__ int moe_ntiles(Frame& F) { return __builtin_amdgcn_readfirstlane((int)__hip_atomic_load((const unsigned*)(F.ws + WS_NTILES), RLX_AGENT)); }
__device__ __forceinline__ void phase_moe_gather(Frame& F) {
    PHASE_LOCALS();
    const int nrows = moe_ntiles(F) * 256; const int* __restrict__ ROWTOK = (const int*)(F.ws + WS_ROWTOK); const bf16* __restrict__ HB = (const bf16*)(F.ws + WS_HB); bf16* __restrict__ XG = (bf16*)(F.ws + WS_XG);
    const int total = nrows * 128, stride = F.G * NTHR;
    for (int idx0 = F.vcu * NTHR + tid; idx0 < total; idx0 += 8 * stride) {
        int tok[8]; v4u val[8];
#pragma unroll
        for (int k = 0; k < 8; ++k) { const int idx = idx0 + k * stride; tok[k] = (idx < total) ? ROWTOK[idx >> 7] : 0; }
#pragma unroll
        for (int k = 0; k < 8; ++k) { const int idx = idx0 + k * stride; val[k] = *(const v4u*)(HB + (size_t)tok[k] * D + 8 * (idx & 127)); }
#pragma unroll
        for (int k = 0; k < 8; ++k) { const int idx = idx0 + k * stride; if (idx < total) *(v4u*)(XG + (size_t)(idx >> 7) * D + 8 * (idx & 127)) = val[k]; }
    }
}
constexpr float W2_F8SCALE = 64.0f, GH_F8SCALE = 4.0f;
constexpr float W13_F8SCALE = 32.0f;
constexpr int CW_Q = 2048, CW_DONE = 3072;
constexpr int QN_E13 = 2 * (16 * 14), QN_E2 = 56 * 4;
constexpr int QN0 = NEXP * (QN_E13 + QN_E2), QN3 = (NTILES_T - P0_URGENT) + P_CHUNKS;
__device__ __forceinline__ void conv_item(Frame& F, const Inputs& in, int q, int it, int lane) {
    if (q == 3) { if (it < NTILES_T - P0_URGENT) p0_tile(F, in, P0_URGENT + it, lane); else p_chunk(F, in, it - (NTILES_T - P0_URGENT), F.wave * 64 + lane); return; }
    unsigned char* W13 = F.ws + WS_WE; unsigned char* W2 = W13 + (size_t)NEXP * 2 * DFFE * D;
    const int per = QN_E13 + QN_E2, e = it / per; int r = it % per;
    bool found = false; TrJob jb;
    jb.W = nullptr; jb.ld = 0; jb.K = 64; jb.N = 256; jb.WT = nullptr; jb.rowstep = 128; jb.row_off = 0; jb.gk = nullptr; jb.nrows = 32;
    bf16* W13e = (bf16*)(W13 + (size_t)e * 2 * DFFE * D);
    TTJOBG(in.p[I_WE1] + (size_t)e * D * DFFE, DFFE, D, DFFE, W13e, 256, 0, nullptr)
    TTJOBG(in.p[I_WE3] + (size_t)e * D * DFFE, DFFE, D, DFFE, W13e, 256, 128, nullptr)
    const bool is13 = found;
    TTJOBG(in.p[I_WE2] + (size_t)e * DFFE * D, D, DFFE, D, (bf16*)(W2 + (size_t)e * D * DFFE), 128, 0, nullptr)
    if (found) tr_tile(jb.W, jb.ld, jb.K, jb.N / 256, jb.WT, jb.rowstep, jb.row_off, (LAS float*)(F.lds + RING_OFF), r, F.wave, lane, jb.gk, false, is13 ? W13_F8SCALE : W2_F8SCALE);
}
struct TileJob0 { const float* W; unsigned char* WT; int ld, K, rowstep, row_off, k0, n0; float sc; };
__device__ __forceinline__ TileJob0 tile_job0(Frame& F, const Inputs& in, int it) {
    unsigned char* W13 = F.ws + WS_WE; unsigned char* W2 = W13 + (size_t)NEXP * 2 * DFFE * D;
    const int per = QN_E13 + QN_E2, e = it / per, r = it % per; TileJob0 j;
    if (r < QN_E13) { const int h3 = (r >= QN_E13 / 2) ? 1 : 0, rr = r - h3 * (QN_E13 / 2);
        j.W = in.p[h3 ? I_WE3 : I_WE1] + (size_t)e * D * DFFE; j.ld = DFFE; j.K = D; j.WT = W13 + (size_t)e * 2 * DFFE * D; j.rowstep = 256; j.row_off = 128 * h3; j.k0 = 64 * (rr / 14); j.n0 = 256 * (rr % 14); j.sc = W13_F8SCALE; }
    else { const int rr = r - QN_E13; j.W = in.p[I_WE2] + (size_t)e * DFFE * D; j.ld = D; j.K = DFFE; j.WT = W2 + (size_t)e * D * DFFE; j.rowstep = 128; j.row_off = 0; j.k0 = 64 * (rr / 4); j.n0 = 256 * (rr % 4); j.sc = W2_F8SCALE; }
    return j;
}
__device__ __forceinline__ void conv_queue0(Frame& F, const Inputs& in, int nitems, int stop_site, unsigned n_long) {
    PHASE_LOCALS();
    gu32* head = F.ctl + CW_Q; gu32* done = F.ctl + CW_DONE + 64 * (stop_site < 0 ? 0 : stop_site);
    volatile LAS unsigned* slot = F.MISC + 16; LAS float* scr = (LAS float*)(F.lds + RING_OFF); const int wave = F.wave;
#define Q0_TAKE() do { if (tid == 0) { unsigned b_ = 0xffffffffu; if (!(stop_site >= 0 && __hip_atomic_load(done, RLX_AGENT) >= n_long)) b_ = __hip_atomic_fetch_add(head, 1u, RLX_AGENT); slot[0] = b_; } } while (0)
#define Q0_LOAD(J, V) do { _Pragma("unroll") for (int i = 0; i < 8; ++i) V[i] = *(const f32x4*)(J.W + (size_t)(J.k0 + wave + 8 * i) * J.ld + J.n0 + 4 * lane); } while (0)
    Q0_TAKE();
    __syncthreads();
    unsigned base = slot[0];
    __syncthreads();
    if (base >= (unsigned)nitems) return;
    TileJob0 a = tile_job0(F, in, (int)base); f32x4 v[8], vn[8];
    Q0_LOAD(a, v);
    for (;;) {
        Q0_TAKE();
#pragma unroll
        for (int i = 0; i < 8; ++i) { LAS float* d = scr + (wave + 8 * i) * 257 + 4 * lane; d[0] = v[i][0]; d[1] = v[i][1]; d[2] = v[i][2]; d[3] = v[i][3]; }
        __syncthreads();
        base = slot[0];
        const bool more = base < (unsigned)nitems; TileJob0 b = a;
        if (more) { b = tile_job0(F, in, (int)base); Q0_LOAD(b, vn); }
        { const int c = tid & 7;
#pragma unroll
          for (int jj = 0; jj < 4; ++jj) { const int n = (tid >> 3) + 64 * jj; const LAS float* p = scr + (8 * c) * 257 + n; const float sc = a.sc;
              const int nn = a.n0 + n, drow = (nn >> 7) * a.rowstep + (nn & 127) + a.row_off;
              int a_ = __builtin_amdgcn_cvt_pk_fp8_f32(p[0] * sc, p[257] * sc, 0, false); a_ = __builtin_amdgcn_cvt_pk_fp8_f32(p[2 * 257] * sc, p[3 * 257] * sc, a_, true);
              int b_ = __builtin_amdgcn_cvt_pk_fp8_f32(p[4 * 257] * sc, p[5 * 257] * sc, 0, false); b_ = __builtin_amdgcn_cvt_pk_fp8_f32(p[6 * 257] * sc, p[7 * 257] * sc, b_, true);
              uint2 o8; o8.x = (unsigned)a_; o8.y = (unsigned)b_; *(uint2*)(a.WT + (size_t)drow * a.K + a.k0 + 8 * c) = o8; } }
        __syncthreads();
        if (!more) break;
        a = b;
#pragma unroll
        for (int i = 0; i < 8; ++i) v[i] = vn[i];
    }
#undef Q0_TAKE
#undef Q0_LOAD
}
__device__ __forceinline__ void conv_queue(Frame& F, const Inputs& in, int q, int nitems, int stop_site, unsigned n_long) {
    if (q == 0) { conv_queue0(F, in, nitems, stop_site, n_long); return; }
    PHASE_LOCALS();
    gu32* head = F.ctl + CW_Q + 64 * q; gu32* done = F.ctl + CW_DONE + 64 * (stop_site < 0 ? 0 : stop_site);
    volatile LAS unsigned* slot = F.MISC + 16;
    for (;;) {
        if (tid == 0) { unsigned base = 0xffffffffu;
            if (!(stop_site >= 0 && __hip_atomic_load(done, RLX_AGENT) >= n_long)) base = __hip_atomic_fetch_add(head, 1u, RLX_AGENT);
            slot[0] = base; }
        __syncthreads();
        const unsigned base = slot[0];
        __syncthreads();
        if (base >= (unsigned)nitems) break;
        conv_item(F, in, q, (int)base, lane);
    }
}
__device__ __forceinline__ void conv_fill_tail(Frame& F, const Inputs& in, int q, int nitems, int site, int mine, int maxc, int nlong) {
    if (nlong >= F.G) return;
    if (mine == maxc) { if (F.wave == 0 && lane_now() == 0) __hip_atomic_fetch_add(F.ctl + CW_DONE + 64 * site, 1u, RLX_AGENT); }
    else conv_queue(F, in, q, nitems, site, (unsigned)nlong);
}
__device__ __forceinline__ void conv_fill_all(Frame& F, const Inputs& in, int q, int nitems, int site) {
    __syncthreads();
    if (F.wave == 0 && lane_now() == 0) __hip_atomic_fetch_add(F.ctl + CW_DONE + 64 * site, 1u, RLX_AGENT);
    conv_queue(F, in, q, nitems, site, (unsigned)F.G);
}
__device__ __forceinline__ void conv_fill_tail_rr(Frame& F, const Inputs& in, int q, int nitems, int site, int nunits, int c) {
    const int maxu = (nunits + F.G - 1) / F.G, n_long = nunits - (maxu - 1) * F.G;
    conv_fill_tail(F, in, q, nitems, site, c < n_long ? maxu : maxu - 1, maxu, n_long);
}
__device__ __forceinline__ const LAS unsigned* moe_tile_table(Frame& F, int ntr) {
    LAS unsigned* tab = (LAS unsigned*)(F.lds + SM_OFF); const int tid = F.wave * 64 + lane_now();
    __syncthreads();
    if (tid < ntr) tab[tid] = __hip_atomic_load((const unsigned*)(F.ws + WS_TILEE) + tid, RLX_AGENT);
    __syncthreads();
    return tab;
}
namespace pg8 {
struct MoeOrder {
    static constexpr bool SEGMENTED = true;
    const PG8_LAS unsigned* tile_e; int ntr, nct, bpe, G, c;
    __device__ __forceinline__ bool next(int i, Unit& u) const {
        const int T = ntr * nct; long p;
        if (SEGMENTED && G % 8 == 0) { const int per = G / 8, x = c % 8, s = c / 8, seg = (T + 7) / 8; const long q = (long)i * per + s; if (q >= seg) return false; p = (long)x * seg + q; }
        else p = (long)i * G + c;
        if (p >= T) return false;
        u.pm = (int)(p / nct); u.pn = (int)(p % nct);
        const int e = __builtin_amdgcn_readfirstlane((int)tile_e[u.pm]);
        u.pb = e * bpe + u.pn; return true;
    }
    __device__ __forceinline__ int count_of(int cc) const { const int T = ntr * nct;
        if (SEGMENTED && G % 8 == 0) { const int per = G / 8, x = cc % 8, s = cc / 8, seg = (T + 7) / 8; int sx = T - x * seg; sx = sx < 0 ? 0 : (sx > seg ? seg : sx); return s < sx ? (sx - s + per - 1) / per : 0; }
        return cc < T ? (T - cc + G - 1) / G : 0; }
    __device__ __forceinline__ void tails(int& mine, int& maxc, int& nlong) const { mine = count_of(c); const int T = ntr * nct;
        if (!(SEGMENTED && G % 8 == 0)) { maxc = (T + G - 1) / G; nlong = T - (maxc - 1) * G; return; }
        const int per = G / 8, seg = (T + 7) / 8; maxc = (seg + per - 1) / per; nlong = 0;
        for (int x = 0; x < 8; ++x) { int sx = T - x * seg; sx = sx < 0 ? 0 : (sx > seg ? seg : sx); int k = sx - (maxc - 1) * per; k = k < 0 ? 0 : (k > per ? per : k); nlong += k; } }
    __device__ __forceinline__ void a_ready(const Unit&) const {}
    __device__ __forceinline__ void done(const Unit&) const {}
};
template <bool ACCUM> struct EpiY {
    static constexpr bool PERM = true, AFTER_DRAIN = false, MIDK = false; typedef NoPre::Pre Pre; __device__ __forceinline__ Pre prefetch(const Unit&, int, int) const { return Pre{}; }
    bf16_t* Y; int ldc; float osc;
    __device__ __forceinline__ void operator()(const f32x4 (&acc)[2][2][4][2], const Unit& u, int wr, int wc, int fr, int fq, const Pre&) const {
        const int row0 = u.pm * BM + wr * 64 + fr, col0 = u.pn * BM + wc * 32 + 8 * fq;
#pragma unroll
        for (int ai = 0; ai < 2; ++ai)
#pragma unroll
            for (int m = 0; m < 4; ++m) { bf16_t* rowp = Y + (size_t)(row0 + ai * HALF + m * 16) * ldc + col0;
#pragma unroll
                for (int bj = 0; bj < 2; ++bj) { f32x4 v0 = acc[ai][bj][m][0] * osc, v1 = acc[ai][bj][m][1] * osc;
                    if (ACCUM) { const u32x4 y = *(const u32x4*)(rowp + bj * HALF);
                        v0 += (f32x4){bflo(y.x), bfhi(y.x), bflo(y.y), bfhi(y.y)}; v1 += (f32x4){bflo(y.z), bfhi(y.z), bflo(y.w), bfhi(y.w)}; }
                    u32x4 w; w.x = cvt_pk_bf16(v0[0], v0[1]); w.y = cvt_pk_bf16(v0[2], v0[3]); w.z = cvt_pk_bf16(v1[0], v1[1]); w.w = cvt_pk_bf16(v1[2], v1[3]);
                    *(u32x4*)(rowp + bj * HALF) = w; } }
    }
};
}
struct Args { Inputs in; float* out; unsigned char* ws; int ph_lo, ph_hi, li, pad; };
#ifndef MLSTM_NAIVE
#define MLSTM_NAIVE 0
#endif
#ifndef ATTN_NAIVE
#define ATTN_NAIVE 0
#endif
#ifndef MOE_NAIVE
#define MOE_NAIVE 0
#endif
#ifndef MK_PER_PHASE
#define MK_PER_PHASE 0
#endif
constexpr int MAX_LAUNCH = 64;

__global__ void __launch_bounds__(NTHR, 2) mega_fwd(Args args) {
    extern __shared__ __attribute__((aligned(16))) unsigned char lds[];
    Frame F;
    F.lds = (LAS unsigned char*)lds;
    F.MISC = (volatile LAS unsigned*)(F.lds + MISC_OFF);
    F.wave = __builtin_amdgcn_readfirstlane((int)(threadIdx.x >> 6));
    F.G = gridDim.x; { const int bx = blockIdx.x; F.vcu = (F.G % 8 == 0) ? (bx % 8) * (F.G / 8) + bx / 8 : bx; }
    F.ws = args.ws; F.ctl = (gu32*)(args.ws + WS_CTL);
    const Inputs& in = args.in;
    for (int u = threadIdx.x; u < (LDS_BYTES - LDSCTL_OFF) / 4; u += NTHR) ((LAS unsigned*)(F.lds + LDSCTL_OFF))[u] = 0u;
    __syncthreads();
    XcdBarrier bar = xcd_barrier_post((unsigned*)(F.ctl + CW_BAR) + args.li * XCD_BAR_WORDS, F.MISC + 8, F.wave);
    const int lo = args.ph_lo, hi = args.ph_hi;
    int ph = 0;
__attribute__((unused)) auto phq = [](int p) { asm volatile("" : "+s"(p)); return p; };
#define RUN() (lo <= phq(ph) && phq(ph) < hi)
#define SEAM() do { if (lo <= phq(ph) && phq(ph) + 1 < hi) xcd_barrier(bar); ++ph; } while (0)
    auto wsp = [&]() { unsigned char* p_ = args.ws; asm volatile("" : "+s"(p_)); return p_; };
#define HB ((bf16*)(wsp() + WS_HB))
#define PROJ ((bf16*)(wsp() + WS_PROJ))
#define YA ((bf16*)(wsp() + WS_YA))
#define YB ((bf16*)(wsp() + WS_YB))
#define MIXED ((bf16*)(wsp() + WS_MIXED))
#define TMP ((bf16*)(wsp() + WS_TMP))
#define GH ((bf16*)(wsp() + WS_GH))
#define PP ((bf16*)(wsp() + WS_PP))
#define IFPRE ((float*)(wsp() + WS_IFPRE))
#define GSEL ((float*)(wsp() + WS_GSEL))
#define XB ((bf16*)(wsp() + WS_XB))
#define XB2 ((bf16*)(wsp() + WS_QKC))
#define SSACC ((pg8::ssq_t*)((unsigned*)(wsp() + WS_CTL) + CW_SS))
    float* const X = args.out;


#ifndef SK_P0
        if (RUN()) p0_prologue(F, in);
#endif

    SEAM();
    { constexpr int l = 0;
        const float* xs = (l == 0) ? in.p[I_X] : X;
        if (RUN()) {
            const bf16* A_ = (l == 0) ? XB : XB2; const bf16* W_ = (const bf16*)(F.ws + WS_WIN) + (size_t)l * NPROJX * D; const pg8::ssq_t* ss_ = (l == 0) ? (const pg8::ssq_t*)(F.ws + WS_SS0) : (const pg8::ssq_t*)(SSACC + 2 * M);
            { pg8::Gemm g{A_, W_, M, 1024, D}; pg8::StaticOrder S; S.init(M, 1024, F.G, (int)blockIdx.x);
              pg8::EpiQK E{PROJ, (unsigned)NPROJ, ss_, in.p[I_GQ] + l * AHD, in.p[I_GK] + l * AHD, (float*)(wsp() + WS_KMEAN), C2};
              pg8::gemm_phase<pg8::EpiQK, pg8::StaticOrder, true, true>(F.lds + RING_OFF, g, S, E, F.wave); }
            { pg8::Gemm g{A_, W_ + (size_t)1024 * D, M, NPROJX - 1024, D}; pg8::StaticOrder S; S.init(M, NPROJX - 1024, F.G, (int)blockIdx.x);
              pg8::EpiProj E{PROJ, NPROJ, PC_GA / 256, ss_, NPROJX / 256 - 1, IFPRE, in.p[I_BI] + l * MH, in.p[I_BF] + l * MH, (bf16*)(wsp() + WS_GT), 4};
              pg8::gemm_phase<pg8::EpiProj, pg8::StaticOrder, true, true>(F.lds + RING_OFF, g, S, E, F.wave);
              if (l == 0) conv_fill_tail_rr(F, in, 3, QN3, 0, (M / 256) * ((NPROJX - 1024) / 256), (int)blockIdx.x);
              else conv_fill_tail_rr(F, in, 0, QN0, 2, (M / 256) * ((NPROJX - 1024) / 256), (int)blockIdx.x); }
        }
        SEAM();
        if (RUN()) {
#if !MLSTM_NAIVE
            phase_mlstm_m1(F, in, l);
#endif
#if ATTN_NAIVE
            phase_attn_naive(F);
#else
            { const attn_body::AttnTensors AT{(const attn_body::bf16*)(PROJ + PC_Q), (const attn_body::bf16*)(PROJ + PC_K), (const attn_body::bf16*)(PROJ + PC_V), (attn_body::bf16*)YA, (const float*)(F.ws + WS_KMEAN)};
              const attn_body::StaticOrder S((int)F.G, (int)blockIdx.x);
              attn_body::attn_phase<attn_body::StaticOrder>((char*)lds + RING_OFF, AT, S, F.wave); }
#endif
        }

        SEAM();

#if MLSTM_NAIVE
        if (RUN()) phase_mlstm_naive(F, in, l);
        SEAM();
#else
        if (RUN()) { phase_mlstm_m3(F, in, l);
            if (l == 0) { conv_queue(F, in, 3, QN3, -1, 0u); conv_fill_all(F, in, 0, QN0, 5); } else conv_fill_all(F, in, 0, QN0, 4); }
        SEAM();
#endif


        if (RUN()) { pg8::Gemm g{YA, (const bf16*)(F.ws + WS_WOA) + (size_t)l * D * D, M, D, D}; pg8::StaticOrder S; S.init(M, D, F.G, (int)blockIdx.x);
            pg8::EpiMerge E{(const bf16*)(wsp() + WS_GT), MIXED, D};
            pg8::gemm_phase<pg8::EpiMerge, pg8::StaticOrder, true, true>(F.lds + RING_OFF, g, S, E, F.wave); }
        SEAM();
        if (RUN()) { pg8::Gemm g{MIXED, (const bf16*)(F.ws + WS_WOUT) + (size_t)l * D * D, M, D, D}; pg8::StaticOrder S; S.init(M, D, F.G, (int)blockIdx.x);
            pg8::EpiResid E{xs, X, D, nullptr, 0, (l == 0) ? XB : nullptr, (l == 0) ? SSACC : nullptr};
            pg8::gemm_phase<pg8::EpiResid, pg8::StaticOrder, true, true>(F.lds + RING_OFF, g, S, E, F.wave); }
        SEAM();
        if (l == 0) {
            if (RUN()) { pg8::Gemm g{XB, (const bf16*)(F.ws + WS_WD13), M, 2 * DFF, D}; pg8::StaticOrder S; S.init(M, 2 * DFF, F.G, (int)blockIdx.x);
                pg8::EpiSwiglu E{GH, DFF, SSACC, 1.0f, 0.f};
                pg8::gemm_phase<pg8::EpiSwiglu, pg8::StaticOrder, true, true>(F.lds + RING_OFF, g, S, E, F.wave);
                conv_fill_tail_rr(F, in, 0, QN0, 1, (M / 256) * (2 * DFF / 256), (int)blockIdx.x); }
            SEAM();
            if (RUN()) { pg8::Gemm g{GH, (const bf16*)(F.ws + WS_WD2), M, D, DFF}; pg8::StaticOrder S; S.init(M, D, F.G, (int)blockIdx.x);
                pg8::EpiResid E{X, X, D, nullptr, 0, XB, SSACC + M};
                pg8::gemm_phase<pg8::EpiResid, pg8::StaticOrder, true, true>(F.lds + RING_OFF, g, S, E, F.wave); }
            SEAM();
        } else {
            if (RUN()) phase_norm<2>(F, X, in.p[I_GFFN] + l * D, HB, in.p[I_WR], NEXP, nullptr, nullptr, nullptr, GSEL);
            SEAM();
#if MOE_NAIVE
            for (int e = 0; e < NEXP; ++e) {

#ifndef SK_CONVE
        if (RUN()) p_conv_expert(F, in, e);
#endif

                SEAM();
                if (RUN()) { pg8::Gemm g{HB, (const bf16*)(F.ws + WS_WE), M, 2 * DFFE, D}; pg8::StaticOrder S; S.init(M, 2 * DFFE, F.G, (int)blockIdx.x);
                    pg8::EpiSwiglu E{GH, DFFE, nullptr, 1.0f, 0.f};
                    pg8::gemm_phase<pg8::EpiSwiglu, pg8::StaticOrder, true, true>(F.lds + RING_OFF, g, S, E, F.wave); }
                SEAM();
                if (RUN()) { pg8::Gemm g{GH, (const bf16*)(F.ws + WS_WE) + (size_t)2 * DFFE * D, M, D, DFFE}; pg8::StaticOrder S; S.init(M, D, F.G, (int)blockIdx.x);
                    pg8::EpiResid E{X, X, D, GSEL + e, NEXP, nullptr, nullptr};
                    pg8::gemm_phase<pg8::EpiResid, pg8::StaticOrder, true, true>(F.lds + RING_OFF, g, S, E, F.wave); }
                SEAM();
            }
#else
            if (RUN()) { phase_moe_route(F); conv_queue(F, in, 0, QN0, -1, 0u); }
            SEAM();
            if (RUN()) { pg8::Gemm g{(const bf16*)(F.ws + WS_XG), (const bf16*)(F.ws + WS_WE), MOE_MAXROWS, 2 * DFFE, D / 2};
                const int ntr_ = moe_ntiles(F); pg8::MoeOrder S{moe_tile_table(F, ntr_), ntr_, 2 * DFFE / 256, 2 * DFFE / 256, F.G, (int)blockIdx.x};
                pg8::EpiSwiglu E{(bf16*)(F.ws + WS_GHH), DFFE, nullptr, 1.0f / W13_F8SCALE, GH_F8SCALE};
                pg8::gemm_phase<pg8::EpiSwiglu, pg8::MoeOrder, true, true, true>(F.lds + RING_OFF, g, S, E, F.wave); }
            SEAM();
            if (RUN()) { pg8::Gemm g{(const bf16*)(F.ws + WS_GHH), (const bf16*)(F.ws + WS_WE + (size_t)NEXP * 2 * DFFE * D), MOE_MAXROWS, D, DFFE / 2};
                const int ntr_ = moe_ntiles(F); pg8::MoeOrder S{moe_tile_table(F, ntr_), ntr_, D / 256, D / 256, F.G, (int)blockIdx.x};
                pg8::EpiY<false> E{(bf16*)(F.ws + WS_Y), D, 1.0f / (W2_F8SCALE * GH_F8SCALE)}; pg8::gemm_phase<pg8::EpiY<false>, pg8::MoeOrder, true, true, true>(F.lds + RING_OFF, g, S, E, F.wave); }
            SEAM();
#endif
        }
        if (l == 1) {
            if (RUN()) { if (!MOE_NAIVE) phase_norm<3>(F, X, in.p[I_GPLE] + l * D, HB, nullptr, 0, nullptr, nullptr, nullptr, nullptr);
                else phase_norm<0>(F, X, in.p[I_GPLE] + l * D, HB, nullptr, 0, nullptr, nullptr, nullptr, nullptr); }
            SEAM();
        }
        if (RUN()) {
            { pg8::Gemm g{(const bf16*)(F.ws + WS_PB) + (size_t)l * M * PLE, (const bf16*)(F.ws + WS_WPP) + (size_t)l * D * PLE, M, D, PLE}; pg8::StaticOrder S; S.init(M, D, F.G, (int)blockIdx.x);
              pg8::EpiF32 E{PP, D};
              pg8::gemm_phase<pg8::EpiF32, pg8::StaticOrder, true, true>(F.lds + RING_OFF, g, S, E, F.wave); }
            { pg8::Gemm g{(l == 0) ? XB : HB, (const bf16*)(F.ws + WS_WPG) + (size_t)l * D * D, M, D, D}; pg8::StaticOrder S; S.init(M, D, F.G, (int)blockIdx.x);
              pg8::EpiPle2 E{PP, X, D, (l == 0) ? (const pg8::ssq_t*)(SSACC + M) : nullptr, (l == 0) ? XB2 : nullptr, (l == 0) ? SSACC + 2 * M : nullptr};
              pg8::gemm_phase<pg8::EpiPle2, pg8::StaticOrder, true, true>(F.lds + RING_OFF, g, S, E, F.wave); }
        }
        SEAM();
    }
    { constexpr int l = 1;
        const float* xs = (l == 0) ? in.p[I_X] : X;
        if (RUN()) {
            const bf16* A_ = (l == 0) ? XB : XB2; const bf16* W_ = (const bf16*)(F.ws + WS_WIN) + (size_t)l * NPROJX * D; const pg8::ssq_t* ss_ = (l == 0) ? (const pg8::ssq_t*)(F.ws + WS_SS0) : (const pg8::ssq_t*)(SSACC + 2 * M);
            { pg8::Gemm g{A_, W_, M, 1024, D}; pg8::StaticOrder S; S.init(M, 1024, F.G, (int)blockIdx.x);
              pg8::EpiQK E{PROJ, (unsigned)NPROJ, ss_, in.p[I_GQ] + l * AHD, in.p[I_GK] + l * AHD, (float*)(wsp() + WS_KMEAN), C2};
              pg8::gemm_phase<pg8::EpiQK, pg8::StaticOrder, true, true>(F.lds + RING_OFF, g, S, E, F.wave); }
            { pg8::Gemm g{A_, W_ + (size_t)1024 * D, M, NPROJX - 1024, D}; pg8::StaticOrder S; S.init(M, NPROJX - 1024, F.G, (int)blockIdx.x);
              pg8::EpiProj E{PROJ, NPROJ, PC_GA / 256, ss_, NPROJX / 256 - 1, IFPRE, in.p[I_BI] + l * MH, in.p[I_BF] + l * MH, (bf16*)(wsp() + WS_GT), 4};
              pg8::gemm_phase<pg8::EpiProj, pg8::StaticOrder, true, true>(F.lds + RING_OFF, g, S, E, F.wave);
              if (l == 0) conv_fill_tail_rr(F, in, 3, QN3, 0, (M / 256) * ((NPROJX - 1024) / 256), (int)blockIdx.x);
              else conv_fill_tail_rr(F, in, 0, QN0, 2, (M / 256) * ((NPROJX - 1024) / 256), (int)blockIdx.x); }
        }
        SEAM();
        if (RUN()) {
#if !MLSTM_NAIVE
            phase_mlstm_m1(F, in, l);
#endif
#if ATTN_NAIVE
            phase_attn_naive(F);
#else
            { const attn_body::AttnTensors AT{(const attn_body::bf16*)(PROJ + PC_Q), (const attn_body::bf16*)(PROJ + PC_K), (const attn_body::bf16*)(PROJ + PC_V), (attn_body::bf16*)YA, (const float*)(F.ws + WS_KMEAN)};
              const attn_body::StaticOrder S((int)F.G, (int)blockIdx.x);
              attn_body::attn_phase<attn_body::StaticOrder>((char*)lds + RING_OFF, AT, S, F.wave); }
#endif
        }

        SEAM();

#if MLSTM_NAIVE
        if (RUN()) phase_mlstm_naive(F, in, l);
        SEAM();
#else
        if (RUN()) { phase_mlstm_m3(F, in, l);
            if (l == 0) { conv_queue(F, in, 3, QN3, -1, 0u); conv_fill_all(F, in, 0, QN0, 5); } else conv_fill_all(F, in, 0, QN0, 4); }
        SEAM();
#endif


        if (RUN()) { pg8::Gemm g{YA, (const bf16*)(F.ws + WS_WOA) + (size_t)l * D * D, M, D, D}; pg8::StaticOrder S; S.init(M, D, F.G, (int)blockIdx.x);
            pg8::EpiMerge E{(const bf16*)(wsp() + WS_GT), MIXED, D};
            pg8::gemm_phase<pg8::EpiMerge, pg8::StaticOrder, true, true>(F.lds + RING_OFF, g, S, E, F.wave); }
        SEAM();
        if (RUN()) { pg8::Gemm g{MIXED, (const bf16*)(F.ws + WS_WOUT) + (size_t)l * D * D, M, D, D}; pg8::StaticOrder S; S.init(M, D, F.G, (int)blockIdx.x);
            pg8::EpiResid E{xs, X, D, nullptr, 0, (l == 0) ? XB : nullptr, (l == 0) ? SSACC : nullptr};
            pg8::gemm_phase<pg8::EpiResid, pg8::StaticOrder, true, true>(F.lds + RING_OFF, g, S, E, F.wave); }
        SEAM();
        if (l == 0) {
            if (RUN()) { pg8::Gemm g{XB, (const bf16*)(F.ws + WS_WD13), M, 2 * DFF, D}; pg8::StaticOrder S; S.init(M, 2 * DFF, F.G, (int)blockIdx.x);
                pg8::EpiSwiglu E{GH, DFF, SSACC, 1.0f, 0.f};
                pg8::gemm_phase<pg8::EpiSwiglu, pg8::StaticOrder, true, true>(F.lds + RING_OFF, g, S, E, F.wave);
                conv_fill_tail_rr(F, in, 0, QN0, 1, (M / 256) * (2 * DFF / 256), (int)blockIdx.x); }
            SEAM();
            if (RUN()) { pg8::Gemm g{GH, (const bf16*)(F.ws + WS_WD2), M, D, DFF}; pg8::StaticOrder S; S.init(M, D, F.G, (int)blockIdx.x);
                pg8::EpiResid E{X, X, D, nullptr, 0, XB, SSACC + M};
                pg8::gemm_phase<pg8::EpiResid, pg8::StaticOrder, true, true>(F.lds + RING_OFF, g, S, E, F.wave); }
            SEAM();
        } else {
            if (RUN()) phase_norm<2>(F, X, in.p[I_GFFN] + l * D, HB, in.p[I_WR], NEXP, nullptr, nullptr, nullptr, GSEL);
            SEAM();
#if MOE_NAIVE
            for (int e = 0; e < NEXP; ++e) {

#ifndef SK_CONVE
        if (RUN()) p_conv_expert(F, in, e);
#endif

                SEAM();
                if (RUN()) { pg8::Gemm g{HB, (const bf16*)(F.ws + WS_WE), M, 2 * DFFE, D}; pg8::StaticOrder S; S.init(M, 2 * DFFE, F.G, (int)blockIdx.x);
                    pg8::EpiSwiglu E{GH, DFFE, nullptr, 1.0f, 0.f};
                    pg8::gemm_phase<pg8::EpiSwiglu, pg8::StaticOrder, true, true>(F.lds + RING_OFF, g, S, E, F.wave); }
                SEAM();
                if (RUN()) { pg8::Gemm g{GH, (const bf16*)(F.ws + WS_WE) + (size_t)2 * DFFE * D, M, D, DFFE}; pg8::StaticOrder S; S.init(M, D, F.G, (int)blockIdx.x);
                    pg8::EpiResid E{X, X, D, GSEL + e, NEXP, nullptr, nullptr};
                    pg8::gemm_phase<pg8::EpiResid, pg8::StaticOrder, true, true>(F.lds + RING_OFF, g, S, E, F.wave); }
                SEAM();
            }
#else
            if (RUN()) { phase_moe_route(F); conv_queue(F, in, 0, QN0, -1, 0u); }
            SEAM();
            if (RUN()) { pg8::Gemm g{(const bf16*)(F.ws + WS_XG), (const bf16*)(F.ws + WS_WE), MOE_MAXROWS, 2 * DFFE, D / 2};
                const int ntr_ = moe_ntiles(F); pg8::MoeOrder S{moe_tile_table(F, ntr_), ntr_, 2 * DFFE / 256, 2 * DFFE / 256, F.G, (int)blockIdx.x};
                pg8::EpiSwiglu E{(bf16*)(F.ws + WS_GHH), DFFE, nullptr, 1.0f / W13_F8SCALE, GH_F8SCALE};
                pg8::gemm_phase<pg8::EpiSwiglu, pg8::MoeOrder, true, true, true>(F.lds + RING_OFF, g, S, E, F.wave); }
            SEAM();
            if (RUN()) { pg8::Gemm g{(const bf16*)(F.ws + WS_GHH), (const bf16*)(F.ws + WS_WE + (size_t)NEXP * 2 * DFFE * D), MOE_MAXROWS, D, DFFE / 2};
                const int ntr_ = moe_ntiles(F); pg8::MoeOrder S{moe_tile_table(F, ntr_), ntr_, D / 256, D / 256, F.G, (int)blockIdx.x};
                pg8::EpiY<false> E{(bf16*)(F.ws + WS_Y), D, 1.0f / (W2_F8SCALE * GH_F8SCALE)}; pg8::gemm_phase<pg8::EpiY<false>, pg8::MoeOrder, true, true, true>(F.lds + RING_OFF, g, S, E, F.wave); }
            SEAM();
#endif
        }
        if (l == 1) {
            if (RUN()) { if (!MOE_NAIVE) phase_norm<3>(F, X, in.p[I_GPLE] + l * D, HB, nullptr, 0, nullptr, nullptr, nullptr, nullptr);
                else phase_norm<0>(F, X, in.p[I_GPLE] + l * D, HB, nullptr, 0, nullptr, nullptr, nullptr, nullptr); }
            SEAM();
        }
        if (RUN()) {
            { pg8::Gemm g{(const bf16*)(F.ws + WS_PB) + (size_t)l * M * PLE, (const bf16*)(F.ws + WS_WPP) + (size_t)l * D * PLE, M, D, PLE}; pg8::StaticOrder S; S.init(M, D, F.G, (int)blockIdx.x);
              pg8::EpiF32 E{PP, D};
              pg8::gemm_phase<pg8::EpiF32, pg8::StaticOrder, true, true>(F.lds + RING_OFF, g, S, E, F.wave); }
            { pg8::Gemm g{(l == 0) ? XB : HB, (const bf16*)(F.ws + WS_WPG) + (size_t)l * D * D, M, D, D}; pg8::StaticOrder S; S.init(M, D, F.G, (int)blockIdx.x);
              pg8::EpiPle2 E{PP, X, D, (l == 0) ? (const pg8::ssq_t*)(SSACC + M) : nullptr, (l == 0) ? XB2 : nullptr, (l == 0) ? SSACC + 2 * M : nullptr};
              pg8::gemm_phase<pg8::EpiPle2, pg8::StaticOrder, true, true>(F.lds + RING_OFF, g, S, E, F.wave); }
        }
        SEAM();
    }
#undef RUN
#undef HB
#undef PROJ
#undef YA
#undef YB
#undef MIXED
#undef TMP
#undef GH
#undef PP
#undef IFPRE
#undef GSEL
#undef XB
#undef XB2
#undef SSACC
#undef SEAM
}
constexpr int N_PHASES = 1 + (5 + 2 + 1) + (5 + 1 + (MOE_NAIVE ? 3 * NEXP : 3) + 2);

extern "C" void kernel_launch(void* const* d_in, const int* in_sizes, int n_in, void* d_out, int out_size, void* d_ws, size_t ws_size, hipStream_t stream) {
    static int grid = 0;
    if (grid == 0) {
        if (n_in != 25 || in_sizes[0] != M * D || out_size != M * D || ws_size < WS_END) { fprintf(stderr, "kernel_launch: unexpected shapes / workspace (n_in %d, ws %zu); nothing launched\n", n_in, ws_size); grid = -1; return; }
        int dev = 0, cus = 0, per_cu = 0;
        if (hipGetDevice(&dev) != hipSuccess || hipDeviceGetAttribute(&cus, hipDeviceAttributeMultiprocessorCount, dev) != hipSuccess) { grid = -1; return; }
        if (hipFuncSetAttribute((const void*)mega_fwd, hipFuncAttributeMaxDynamicSharedMemorySize, LDS_BYTES) != hipSuccess) { grid = -1; return; }
        if (hipOccupancyMaxActiveBlocksPerMultiprocessor(&per_cu, (const void*)mega_fwd, NTHR, LDS_BYTES) != hipSuccess || per_cu < 1) { fprintf(stderr, "kernel_launch: occupancy query reports %d\n", per_cu); }
        (void)hipGetLastError();
        grid = cus;
    }
    if (grid < 0) return;
    if (hipMemsetAsync((char*)d_ws + WS_CTL, 0, CTL_ZERO_BYTES, stream) != hipSuccess) return;
    Args a{};
    for (int i = 0; i < 25; ++i) a.in.p[i] = (const float*)d_in[i];
    a.out = (float*)d_out; a.ws = (unsigned char*)d_ws;
#if MK_PER_PHASE
    for (int li = 0; li < N_PHASES; ++li) { a.ph_lo = li; a.ph_hi = li + 1; a.li = 0; hipLaunchKernelGGL(mega_fwd, dim3(grid), dim3(NTHR), LDS_BYTES, stream, a); }
#else
    a.ph_lo = 0; a.ph_hi = N_PHASES; a.li = 0;
    hipLaunchKernelGGL(mega_fwd, dim3(grid), dim3(NTHR), LDS_BYTES, stream, a);
#endif
}
```

```cpp
#include <hip/hip_runtime.h>
#include <cstdio>
#include <cstdint>
#include <cmath>
namespace pg8 {
#define PG8_LAS __attribute__((address_space(3)))
typedef unsigned short bf16_t;
typedef short bf16x8 __attribute__((ext_vector_type(8)));
typedef float f32x4 __attribute__((ext_vector_type(4)));
typedef unsigned u32x4 __attribute__((ext_vector_type(4)));
typedef int v8i32 __attribute__((ext_vector_type(8)));
typedef int v4i32 __attribute__((ext_vector_type(4)));
constexpr int BM = 256, BK = 64, HALF = 128, HTB = HALF * BK * 2  , STAGE_BYTES = 8 * HTB, NXCD = 8, WGM = 8;

__host__ __device__ __forceinline__ int lds_byte(int r, int c) { const int st = (r >> 4) * 2 + (c >> 5), rr = r & 15, cc = c & 31, ob = rr * 64 + cc * 2; return st * 1024 + (ob ^ (((ob >> 9) & 1) << 5)); }
__host__ __device__ __forceinline__ void stage_rc(int b, int& R, int& C) { const int st = b / 1024, sb = b % 1024, swz = sb ^ (((sb >> 9) & 1) << 5); R = (st >> 1) * 16 + swz / 64; C = (st & 1) * 32 + (swz % 64) / 2; }
__host__ __device__ __forceinline__ int perm32(int rho) { const int n = rho >> 4, i = rho & 15; return 8 * (i >> 2) + 4 * n + (i & 3); }

struct Unit { int pm, pn, pb; };
struct Gemm { const bf16_t* A; const bf16_t* Bt; int M, N, K; };

struct StaticOrder {
    int nM, nN, nwg, G, c;
    __host__ __device__ void init(int M, int N, int G_, int c_) { nM = M / BM; nN = N / BM; nwg = nM * nN; G = G_; c = c_; }
    __host__ __device__ bool next(int i, Unit& u) const {
        const long L = (long)i * G + c; if (L >= nwg) return false;
        int wgid = (int)L; { const int q = nwg / NXCD, r = nwg % NXCD, xcd = wgid % NXCD, off = wgid / NXCD; wgid = (xcd < r ? xcd * (q + 1) : r * (q + 1) + (xcd - r) * q) + off; }
        const int nig = WGM * nN, gid = wgid / nig, fm = gid * WGM, gsz = (nM - fm) < WGM ? (nM - fm) : WGM;
        u.pm = fm + ((wgid % nig) % gsz); u.pn = (wgid % nig) / gsz; u.pb = u.pn; return true;
    }
    __device__ __forceinline__ void a_ready(const Unit&) const {}
    __device__ __forceinline__ void done(const Unit&) const {}
};

__device__ __forceinline__ unsigned cvt_pk_bf16(float lo, float hi) { unsigned r; asm volatile("v_cvt_pk_bf16_f32 %0, %1, %2" : "=v"(r) : "v"(lo), "v"(hi)); return r; }
template <class Epi, class Sched, bool ALIGN_EPI = false, bool SP2 = false, bool F8 = false>
__device__ __forceinline__ void gemm_phase(PG8_LAS unsigned char* lds, const Gemm g, const Sched& S, const Epi& E, int wave_in) {
    int tid_; asm volatile("v_mbcnt_lo_u32_b32 %0, -1, 0\n\tv_mbcnt_hi_u32_b32 %0, -1, %0" : "=v"(tid_)); tid_ += 64 * wave_in;
    const int tid = tid_, wid = __builtin_amdgcn_readfirstlane(tid >> 6), lane = tid & 63, wr = wid >> 2, wc = wid & 3, fr = lane & 15, fq = lane >> 4;
    const int K = g.K, nt = K / BK;
    unsigned voffA[2], voffB[2];
#pragma unroll
    for (int i = 0; i < 2; ++i) { int R, C; stage_rc(tid * 16 + i * 8192, R, C); const int Rb = Epi::PERM ? ((R & ~31) + perm32(R & 31)) : R;
        voffA[i] = (unsigned)(R * K + C) * 2u; voffB[i] = (unsigned)(Rb * K + C) * 2u; }
    const size_t kstep = (size_t)(BK * 2);
    const size_t hstep = (size_t)HALF * K * 2;
    const size_t tstep = 2 * hstep;
    const unsigned ldsw = (unsigned)wid * 1024u;
    const int aoff = lds_byte(wr * 64 + fr, fq * 8), boff = lds_byte(wc * 32 + fr, fq * 8);
    const int aofk0 = F8 ? lds_byte(wr * 64 + fr, 16 * fq) : aoff, aofk1 = F8 ? lds_byte(wr * 64 + fr, 16 * fq + 8) : aoff + 1024, bofk0 = F8 ? lds_byte(wc * 32 + fr, 16 * fq) : boff, bofk1 = F8 ? lds_byte(wc * 32 + fr, 16 * fq + 8) : boff + 1024;
#define PG8_SA(b, h) (((b) * 2 + (h)) * HTB)
#define PG8_SB(b, h) ((4 + (b) * 2 + (h)) * HTB)
#define PG8_STAGE(bufoff, gbase, voff) do { _Pragma("unroll") for (int _i = 0; _i < 2; ++_i) \
        __builtin_amdgcn_global_load_lds((const unsigned*)((const char*)(gbase) + (voff)[_i]), (PG8_LAS unsigned*)(lds + (bufoff) + ldsw + _i * 8192), 16, 0, 0); } while (0)
#define PG8_LDA(dst, b, h) do { if constexpr (F8) { _Pragma("unroll") for (int m = 0; m < 4; ++m) { dst##8[m].lo = *(const PG8_LAS v4i32*)(lds + PG8_SA(b, h) + aofk0 + m * 2048); dst##8[m].hi = *(const PG8_LAS v4i32*)(lds + PG8_SA(b, h) + aofk1 + m * 2048); } } \
        else { _Pragma("unroll") for (int m = 0; m < 4; ++m) _Pragma("unroll") for (int k = 0; k < 2; ++k) dst[m][k] = *(const PG8_LAS bf16x8*)(lds + PG8_SA(b, h) + (k ? aofk1 : aofk0) + m * 2048); } } while (0)
#define PG8_LDB(dst, b, h) do { if constexpr (F8) { _Pragma("unroll") for (int n = 0; n < 2; ++n) { dst##8[n].lo = *(const PG8_LAS v4i32*)(lds + PG8_SB(b, h) + bofk0 + n * 2048); dst##8[n].hi = *(const PG8_LAS v4i32*)(lds + PG8_SB(b, h) + bofk1 + n * 2048); } } \
        else { _Pragma("unroll") for (int n = 0; n < 2; ++n) _Pragma("unroll") for (int k = 0; k < 2; ++k) dst[n][k] = *(const PG8_LAS bf16x8*)(lds + PG8_SB(b, h) + (k ? bofk1 : bofk0) + n * 2048); } } while (0)
#define PG8_MMA(ai, bj, At, Bt) do { __builtin_amdgcn_s_setprio(1); \
        if constexpr (F8) { _Pragma("unroll") for (int m = 0; m < 4; ++m) _Pragma("unroll") for (int n = 0; n < 2; ++n) \
            asm volatile("v_mfma_scale_f32_16x16x128_f8f6f4 %0, %1, %2, %0, %3, %3 op_sel_hi:[0,0,0]" : "+v"(acc[ai][bj][m][n]) : "v"(Bt##8[n]), "v"(At##8[m]), "v"(f8one)); } \
        else { _Pragma("unroll") for (int m = 0; m < 4; ++m) _Pragma("unroll") for (int n = 0; n < 2; ++n) _Pragma("unroll") for (int k = 0; k < 2; ++k) \
            acc[ai][bj][m][n] = __builtin_amdgcn_mfma_f32_16x16x32_bf16(Bt[n][k], At[m][k], acc[ai][bj][m][n], 0, 0, 0); } \
        __builtin_amdgcn_s_setprio(0); } while (0)
#define PG8_WAIT_V(n) asm volatile("s_waitcnt vmcnt(" #n ")" ::: "memory")
#define PG8_WAIT_L(n) asm volatile("s_waitcnt lgkmcnt(" #n ")" ::: "memory")
#define PG8_BAR __builtin_amdgcn_s_barrier()
#define PG8_SCHED __builtin_amdgcn_sched_barrier(0)
    Unit cur, nxt; int ui = 0;
    if (!S.next(0, cur)) return;
    typename Epi::Pre pre = E.prefetch(cur, wr, fr);
    f32x4 acc[2][2][4][2];
#pragma unroll
    for (int a = 0; a < 2; ++a)
#pragma unroll
        for (int b = 0; b < 2; ++b)
#pragma unroll
            for (int m = 0; m < 4; ++m)
#pragma unroll
                for (int n = 0; n < 2; ++n) acc[a][b][m][n] = (f32x4){0.f, 0.f, 0.f, 0.f};
    bf16x8 At[4][2], B0[2][2], B1[2][2];
    int f8one = 0x7f7f7f7f; asm volatile("" : "+v"(f8one));
    v8i32 At8[4], B08[2], B18[2];
    const char* cA = (const char*)g.A + (size_t)cur.pm * tstep; const char* cB = (const char*)g.Bt + (size_t)cur.pb * tstep;
    S.a_ready(cur);
    if constexpr (SP2) {
        PG8_STAGE(PG8_SB(0, 0), cB, voffB); PG8_STAGE(PG8_SB(0, 1), cB + hstep, voffB); PG8_STAGE(PG8_SA(0, 0), cA, voffA); PG8_STAGE(PG8_SA(0, 1), cA + hstep, voffA);
        if (wr == 1) PG8_BAR;
        PG8_WAIT_V(2); PG8_BAR;
        PG8_STAGE(PG8_SB(1, 0), cB + kstep, voffB); PG8_STAGE(PG8_SA(1, 0), cA + kstep, voffA); PG8_STAGE(PG8_SB(1, 1), cB + hstep + kstep, voffB);
        PG8_WAIT_V(6); PG8_BAR;
    } else {
        PG8_STAGE(PG8_SB(0, 0), cB, voffB); PG8_STAGE(PG8_SA(0, 0), cA, voffA); PG8_STAGE(PG8_SB(0, 1), cB + hstep, voffB); PG8_STAGE(PG8_SA(0, 1), cA + hstep, voffA);
        if (wr == 1) PG8_BAR;
        PG8_WAIT_V(4); PG8_BAR;
        PG8_STAGE(PG8_SB(1, 0), cB + kstep, voffB); PG8_STAGE(PG8_SA(1, 0), cA + kstep, voffA); PG8_STAGE(PG8_SB(1, 1), cB + hstep + kstep, voffB);
        PG8_WAIT_V(6); PG8_BAR;
    }
    for (;;) {
        const bool has_next = S.next(ui + 1, nxt);
        const char* nA = has_next ? (const char*)g.A + (size_t)nxt.pm * tstep : cA; const char* nB = has_next ? (const char*)g.Bt + (size_t)nxt.pb * tstep : cB;
        _Pragma("nounroll") for (int t = 0; t < nt; t += 2) {
            const bool last = (t == nt - 2);
            const char* a1 = cA + (size_t)(t + 1) * kstep;
            const char* a2 = last ? nA : cA + (size_t)(t + 2) * kstep; const char* b2 = last ? nB : cB + (size_t)(t + 2) * kstep;
            const char* a3 = a2 + kstep; const char* b3 = b2 + kstep;
            if (last && has_next) S.a_ready(nxt);
            if constexpr (Epi::MIDK) { if (t == Epi::MID_T) E.mid(acc, cur, wr, wc, fr, fq); }
            if constexpr (SP2) {
            PG8_LDB(B0, 0, 0); PG8_LDB(B1, 0, 1); PG8_SCHED; PG8_LDA(At, 0, 0); PG8_STAGE(PG8_SA(1, 1), a1 + hstep, voffA);
            PG8_WAIT_V(8); PG8_WAIT_L(0); PG8_BAR; PG8_MMA(0, 0, At, B0); PG8_MMA(0, 1, At, B1); PG8_BAR; PG8_SCHED;
            PG8_LDA(At, 0, 1); PG8_STAGE(PG8_SB(0, 0), b2, voffB); PG8_STAGE(PG8_SB(0, 1), b2 + hstep, voffB); PG8_STAGE(PG8_SA(0, 0), a2, voffA);
            PG8_WAIT_V(8); PG8_WAIT_L(0); PG8_BAR; PG8_MMA(1, 0, At, B0); PG8_MMA(1, 1, At, B1); PG8_BAR; PG8_SCHED;
            PG8_LDB(B0, 1, 0); PG8_LDB(B1, 1, 1); PG8_SCHED; PG8_LDA(At, 1, 0); PG8_STAGE(PG8_SA(0, 1), a2 + hstep, voffA);
            PG8_WAIT_V(8); PG8_WAIT_L(0); PG8_BAR; PG8_MMA(0, 0, At, B0); PG8_MMA(0, 1, At, B1); PG8_BAR; PG8_SCHED;
            PG8_LDA(At, 1, 1); PG8_STAGE(PG8_SB(1, 0), b3, voffB); PG8_STAGE(PG8_SB(1, 1), b3 + hstep, voffB); PG8_STAGE(PG8_SA(1, 0), a3, voffA);
            PG8_WAIT_V(8); PG8_WAIT_L(0); PG8_BAR; PG8_MMA(1, 0, At, B0); PG8_MMA(1, 1, At, B1); PG8_BAR; PG8_SCHED;
            } else {
            PG8_LDB(B0, 0, 0); PG8_SCHED; PG8_LDA(At, 0, 0); PG8_STAGE(PG8_SA(1, 1), a1 + hstep, voffA);
            PG8_WAIT_L(8); PG8_BAR; PG8_WAIT_L(0); PG8_MMA(0, 0, At, B0); PG8_BAR; PG8_SCHED;
            PG8_LDB(B1, 0, 1); PG8_STAGE(PG8_SB(0, 0), b2, voffB);
            PG8_BAR; PG8_WAIT_L(0); PG8_MMA(0, 1, At, B1); PG8_BAR;
            PG8_LDA(At, 0, 1); PG8_STAGE(PG8_SA(0, 0), a2, voffA);
            PG8_BAR; PG8_WAIT_L(0); PG8_MMA(1, 0, At, B0); PG8_BAR; PG8_SCHED;
            PG8_STAGE(PG8_SB(0, 1), b2 + hstep, voffB);
            PG8_WAIT_V(6); PG8_BAR; PG8_MMA(1, 1, At, B1); PG8_BAR;
            PG8_LDB(B0, 1, 0); PG8_SCHED; PG8_LDA(At, 1, 0); PG8_STAGE(PG8_SA(0, 1), a2 + hstep, voffA);
            PG8_WAIT_L(8); PG8_BAR; PG8_WAIT_L(0); PG8_MMA(0, 0, At, B0); PG8_BAR; PG8_SCHED;
            PG8_LDB(B1, 1, 1); PG8_STAGE(PG8_SB(1, 0), b3, voffB);
            PG8_BAR; PG8_WAIT_L(0); PG8_MMA(0, 1, At, B1); PG8_BAR;
            PG8_LDA(At, 1, 1); PG8_STAGE(PG8_SA(1, 0), a3, voffA);
            PG8_BAR; PG8_WAIT_L(0); PG8_MMA(1, 0, At, B0); PG8_BAR; PG8_SCHED;
            PG8_STAGE(PG8_SB(1, 1), b3 + hstep, voffB);
            PG8_WAIT_V(6); PG8_BAR; PG8_MMA(1, 1, At, B1); PG8_BAR;
            }
        }
        if constexpr (ALIGN_EPI) { if (wr == 0) PG8_BAR; }
        if constexpr (F8) asm volatile("s_nop 15\n\ts_nop 15" ::: "memory");
        if constexpr (!Epi::AFTER_DRAIN) { E(acc, cur, wr, wc, fr, fq, pre); S.done(cur); }
        if (!has_next) break;
#pragma unroll
        for (int a = 0; a < 2; ++a)
#pragma unroll
            for (int b = 0; b < 2; ++b)
#pragma unroll
                for (int m = 0; m < 4; ++m)
#pragma unroll
                    for (int n = 0; n < 2; ++n) acc[a][b][m][n] = (f32x4){0.f, 0.f, 0.f, 0.f};
        cur = nxt; cA = nA; cB = nB; ++ui; pre = E.prefetch(cur, wr, fr);
        if constexpr (ALIGN_EPI) { if (wr == 1) PG8_BAR; }
    }
    PG8_WAIT_V(0);
    if constexpr (!ALIGN_EPI) { if (wr == 0) PG8_BAR; }
    PG8_BAR;
    if constexpr (Epi::AFTER_DRAIN) { E.fused(acc, cur, wr, wc, fr, fq, lds, wid, lane); S.done(cur); }
#undef PG8_SA
#undef PG8_SB
#undef PG8_STAGE
#undef PG8_LDA
#undef PG8_LDB
#undef PG8_MMA
#undef PG8_WAIT_V
#undef PG8_WAIT_L
#undef PG8_BAR
#undef PG8_SCHED
}
}
namespace pg8 {
#define PG8_GAS __attribute__((address_space(1)))
typedef unsigned u32x2 __attribute__((ext_vector_type(2)));
__device__ __forceinline__ float ex2(float x) { return __builtin_amdgcn_exp2f(x); }
__device__ __forceinline__ float sigm(float x) { return __builtin_amdgcn_rcpf(1.0f + ex2(-1.4426950408889634f * x)); }
__device__ __forceinline__ float bflo(unsigned w) { return __uint_as_float(w << 16); }
__device__ __forceinline__ float bfhi(unsigned w) { return __uint_as_float(w & 0xffff0000u); }

typedef unsigned ssq_t;
__device__ __forceinline__ ssq_t ss_fix(float v) { return (ssq_t)(v * 1024.0f); }
__device__ __forceinline__ float rstd_fix(ssq_t s) { return __builtin_amdgcn_rsqf((float)s * (1.0f / (1024.0f * 1024.0f)) + 1e-6f); }
struct NoPre { struct Pre {}; __device__ __forceinline__ Pre prefetch(const Unit&, int, int) const { return Pre{}; } };
struct SsPre { struct Pre { ssq_t s[8]; };
    __device__ __forceinline__ static Pre load(const ssq_t* ss, const Unit& u, int wr, int fr) { Pre p;
#pragma unroll
        for (int i = 0; i < 8; ++i) p.s[i] = ss ? ss[u.pm * BM + wr * 64 + fr + (i >> 2) * HALF + (i & 3) * 16] : 0u;
        return p; } };
__device__ __forceinline__ float quad_sum(float v, int fr, int fq) {
    const int lane = fr + 16 * fq;
    v += __int_as_float(__builtin_amdgcn_ds_bpermute((lane ^ 16) << 2, __float_as_int(v)));
    v += __int_as_float(__builtin_amdgcn_ds_bpermute((lane ^ 32) << 2, __float_as_int(v)));
    return v;
}
struct EpiQK {
    static constexpr bool PERM = true, AFTER_DRAIN = false, MIDK = false; typedef SsPre::Pre Pre;
    bf16_t* O; unsigned ldc; const ssq_t* ss; const float* g_q; const float* g_k; float* kmp; float qscale;
    __device__ __forceinline__ Pre prefetch(const Unit& u, int wr, int fr) const { return SsPre::load(ss, u, wr, fr); }
    __device__ __forceinline__ void operator()(const f32x4 (&acc)[2][2][4][2], const Unit& u, int wr, int wc, int fr_, int fq_, const Pre& pre) const {
        int fr = fr_, fq = fq_; asm volatile("" : "+v"(fr), "+v"(fq));
        const bool isq = u.pn < 2; const float* gg = (isq ? g_q : g_k) + 8 * fq; const float osc = isq ? qscale : 1.0f;
        f32x4 gn[2][2], cs[2][2];
#pragma unroll
        for (int bj = 0; bj < 2; ++bj)
#pragma unroll
            for (int n = 0; n < 2; ++n) { gn[bj][n] = *(const f32x4*)(gg + 32 * bj + 4 * n); cs[bj][n] = (f32x4){0.f, 0.f, 0.f, 0.f}; }
        const unsigned obase = (unsigned)(u.pm * BM + wr * 64 + fr) * ldc + (unsigned)(u.pn * BM + wc * 64 + 8 * fq);
#pragma unroll
        for (int ai = 0; ai < 2; ++ai)
#pragma unroll
            for (int m = 0; m < 4; ++m) { const float rs = rstd_fix(pre.s[ai * 4 + m]);
                float q2 = 0.f;
#pragma unroll
                for (int bj = 0; bj < 2; ++bj)
#pragma unroll
                    for (int n = 0; n < 2; ++n) { const f32x4 a = acc[ai][bj][m][n]; q2 += (a[0] * a[0] + a[1] * a[1]) + (a[2] * a[2] + a[3] * a[3]); }
                q2 = quad_sum(q2, fr, fq);
                const float rr = rs * __builtin_amdgcn_rsqf(rs * rs * q2 * (1.0f / 64.0f) + 1e-6f) * osc;
                const unsigned off = obase + (unsigned)(ai * HALF + m * 16) * ldc;
#pragma unroll
                for (int bj = 0; bj < 2; ++bj) { const f32x4 o0 = acc[ai][bj][m][0] * (gn[bj][0] * rr), o1 = acc[ai][bj][m][1] * (gn[bj][1] * rr); cs[bj][0] += o0; cs[bj][1] += o1;
                    u32x4 w; w.x = cvt_pk_bf16(o0[0], o0[1]); w.y = cvt_pk_bf16(o0[2], o0[3]); w.z = cvt_pk_bf16(o1[0], o1[1]); w.w = cvt_pk_bf16(o1[2], o1[3]);
                    *(u32x4*)(O + off + 32 * bj) = w; }
                asm volatile("" : "+v"(cs[0][0]), "+v"(cs[0][1]), "+v"(cs[1][0]), "+v"(cs[1][1]));
                __builtin_amdgcn_sched_barrier(0); }
        if (!isq) {
            const int lane = fr + 16 * fq;
#pragma unroll
            for (int o = 1; o < 16; o <<= 1)
#pragma unroll
                for (int bj = 0; bj < 2; ++bj)
#pragma unroll
                    for (int n = 0; n < 2; ++n)
#pragma unroll
                        for (int j = 0; j < 4; ++j) cs[bj][n][j] += __int_as_float(__builtin_amdgcn_ds_bpermute((lane ^ o) << 2, __float_as_int(cs[bj][n][j])));
            if (fr == 0) { float* kp = kmp + ((((unsigned)(u.pm >> 4) * 8 + (u.pn & 1) * 4 + wc) * 16 + (u.pm & 15)) * 2 + wr) * 64 + 8 * fq;
#pragma unroll
                for (int bj = 0; bj < 2; ++bj) { *(f32x4*)(kp + 32 * bj) = cs[bj][0]; *(f32x4*)(kp + 32 * bj + 4) = cs[bj][1]; } }
        }
    }
};
struct EpiProj {
    static constexpr bool PERM = true, AFTER_DRAIN = false, MIDK = false; typedef SsPre::Pre Pre;
    bf16_t* O; int ldc; int sig_from; const ssq_t* ss; int gate_tile; float* ifpre; const float* b_i; const float* b_f; bf16_t* GT; int pn0;
    __device__ __forceinline__ Pre prefetch(const Unit& u, int wr, int fr) const { return SsPre::load(ss, u, wr, fr); }
    __device__ __forceinline__ void operator()(const f32x4 (&acc)[2][2][4][2], const Unit& u_, int wr, int wc, int fr, int fq, const Pre& pre) const {
        Unit u = u_; u.pn += pn0;
        const int row0 = u.pm * BM + wr * 64 + fr, col0 = u.pn * BM + wc * 32 + 8 * fq; const bool sg = u.pn >= sig_from;
        if (u.pn == gate_tile) {
            if (wc == 0 && fq == 0) { const f32x4 bi = *(const f32x4*)b_i, bf = *(const f32x4*)b_f;
#pragma unroll
                for (int ai = 0; ai < 2; ++ai)
#pragma unroll
                    for (int m = 0; m < 4; ++m) { const int r = row0 + ai * HALF + m * 16; const float rs = rstd_fix(pre.s[ai * 4 + m]);
                        *(f32x4*)(ifpre + (size_t)r * 8) = acc[ai][0][m][0] * rs + bi; *(f32x4*)(ifpre + (size_t)r * 8 + 4) = acc[ai][0][m][1] * rs + bf; } }
            return; }
#pragma unroll
        for (int ai = 0; ai < 2; ++ai)
#pragma unroll
            for (int m = 0; m < 4; ++m) { const int r = row0 + ai * HALF + m * 16; bf16_t* rowp = O + (size_t)r * ldc + col0; const float rs = rstd_fix(pre.s[ai * 4 + m]);
#pragma unroll
                for (int bj = 0; bj < 2; ++bj) { f32x4 v0 = acc[ai][bj][m][0] * rs, v1 = acc[ai][bj][m][1] * rs;
                    if (sg) {
#pragma unroll
                        for (int j = 0; j < 4; ++j) { v0[j] = sigm(v0[j]); v1[j] = sigm(v1[j]); } }
                    u32x4 w; w.x = cvt_pk_bf16(v0[0], v0[1]); w.y = cvt_pk_bf16(v0[2], v0[3]); w.z = cvt_pk_bf16(v1[0], v1[1]); w.w = cvt_pk_bf16(v1[2], v1[3]);
                    if (sg) *(u32x4*)(GT + ((((size_t)u.pm * 8 + (u.pn - sig_from)) * 16 + (ai * 8 + m * 2 + bj)) * 8 + (wr * 4 + wc)) * 512 + (fr + 16 * fq) * 8) = w;
                    else *(u32x4*)(rowp + bj * HALF) = w; } }
    }
};
struct EpiSwiglu {
    static constexpr bool PERM = true, AFTER_DRAIN = false, MIDK = false; typedef SsPre::Pre Pre;
    bf16_t* O; int ldc; const ssq_t* ss; float osc; float f8out;
    __device__ __forceinline__ Pre prefetch(const Unit& u, int wr, int fr) const { return SsPre::load(ss, u, wr, fr); }
    __device__ __forceinline__ void operator()(const f32x4 (&acc)[2][2][4][2], const Unit& u, int wr, int wc, int fr_, int fq_, const Pre& pre) const {
        int fr = fr_, fq = fq_; asm volatile("" : "+v"(fr), "+v"(fq));
        const unsigned obase = (unsigned)(u.pm * BM + wr * 64 + fr) * (unsigned)ldc + (unsigned)(u.pn * HALF + wc * 32 + 8 * fq);
#pragma unroll
        for (int ai = 0; ai < 2; ++ai)
#pragma unroll
            for (int m = 0; m < 4; ++m) { bf16_t* rowp = O + (obase + (unsigned)(ai * HALF + m * 16) * (unsigned)ldc); const float rs = (ss ? rstd_fix(pre.s[ai * 4 + m]) : 1.0f) * osc;
                const float nl = -1.4426950408889634f * rs, ic = __builtin_amdgcn_rcpf(rs * rs * (f8out != 0.f ? f8out : 1.0f));
                f32x4 v0, v1;
#pragma unroll
                for (int j = 0; j < 4; ++j) { const float g0 = acc[ai][0][m][0][j], g1 = acc[ai][0][m][1][j];
                    v0[j] = (g0 * acc[ai][1][m][0][j]) * __builtin_amdgcn_rcpf(fmaf(ex2(g0 * nl), ic, ic)); v1[j] = (g1 * acc[ai][1][m][1][j]) * __builtin_amdgcn_rcpf(fmaf(ex2(g1 * nl), ic, ic)); }
                if (f8out != 0.f) {
#pragma unroll
                    for (int j = 0; j < 4; ++j) { v0[j] = __builtin_amdgcn_fmed3f(v0[j], -448.0f, 448.0f); v1[j] = __builtin_amdgcn_fmed3f(v1[j], -448.0f, 448.0f); }
                    int a_ = __builtin_amdgcn_cvt_pk_fp8_f32(v0[0], v0[1], 0, false); a_ = __builtin_amdgcn_cvt_pk_fp8_f32(v0[2], v0[3], a_, true);
                    int b_ = __builtin_amdgcn_cvt_pk_fp8_f32(v1[0], v1[1], 0, false); b_ = __builtin_amdgcn_cvt_pk_fp8_f32(v1[2], v1[3], b_, true);
                    u32x2 w8; w8.x = (unsigned)a_; w8.y = (unsigned)b_; *(u32x2*)((unsigned char*)O + (obase + (unsigned)(ai * HALF + m * 16) * (unsigned)ldc)) = w8; }
                else { u32x4 w; w.x = cvt_pk_bf16(v0[0], v0[1]); w.y = cvt_pk_bf16(v0[2], v0[3]); w.z = cvt_pk_bf16(v1[0], v1[1]); w.w = cvt_pk_bf16(v1[2], v1[3]);
                    *(u32x4*)rowp = w; } }
    }
};
struct EpiResid {
    static constexpr bool PERM = true, AFTER_DRAIN = false, MIDK = false; typedef NoPre::Pre Pre; __device__ __forceinline__ Pre prefetch(const Unit&, int, int) const { return Pre{}; }
    const float* base; float* out; int ldc; const float* rowscale; int rs_ld; bf16_t* xb; ssq_t* ssacc;
    __device__ __forceinline__ void operator()(const f32x4 (&acc)[2][2][4][2], const Unit& u, int wr, int wc, int fr_, int fq_, const Pre&) const {
        int fr = fr_, fq = fq_; asm volatile("" : "+v"(fr), "+v"(fq));
        const int row0 = u.pm * BM + wr * 64 + fr, col0 = u.pn * BM + wc * 32 + 8 * fq;
        const PG8_GAS float* gb_ = (const PG8_GAS float*)base;
        f32x4 bv[2][4][2][2];
#define PG8_RESID_LOAD(ai) do { _Pragma("unroll") for (int m = 0; m < 4; ++m) _Pragma("unroll") for (int bj = 0; bj < 2; ++bj) { const size_t off = (size_t)(row0 + (ai) * HALF + m * 16) * ldc + col0 + bj * HALF; \
            bv[ai][m][bj][0] = *(const PG8_GAS f32x4*)(gb_ + off); bv[ai][m][bj][1] = *(const PG8_GAS f32x4*)(gb_ + off + 4); } __builtin_amdgcn_sched_barrier(0); } while (0)
#define PG8_RESID_STEP(ai, m) do { const int r = row0 + (ai) * HALF + (m) * 16; const float s = rowscale ? rowscale[(size_t)r * rs_ld] : 1.0f; float part = 0.f; \
            _Pragma("unroll") for (int bj = 0; bj < 2; ++bj) { const size_t off = (size_t)r * ldc + col0 + bj * HALF; \
                const f32x4 v0 = bv[ai][m][bj][0] + acc[ai][bj][m][0] * s, v1 = bv[ai][m][bj][1] + acc[ai][bj][m][1] * s; \
                *(PG8_GAS f32x4*)((PG8_GAS float*)out + off) = v0; *(PG8_GAS f32x4*)((PG8_GAS float*)out + off + 4) = v1; \
                if (xb) { u32x4 w; w.x = cvt_pk_bf16(v0[0], v0[1]); w.y = cvt_pk_bf16(v0[2], v0[3]); w.z = cvt_pk_bf16(v1[0], v1[1]); w.w = cvt_pk_bf16(v1[2], v1[3]); *(PG8_GAS u32x4*)((PG8_GAS bf16_t*)xb + off) = w; } \
                part += (v0[0] * v0[0] + v0[1] * v0[1]) + (v0[2] * v0[2] + v0[3] * v0[3]) + (v1[0] * v1[0] + v1[1] * v1[1]) + (v1[2] * v1[2] + v1[3] * v1[3]); } \
            if (ssacc) { part = quad_sum(part, fr, fq); if (fq == 0) __hip_atomic_fetch_add((PG8_GAS ssq_t*)ssacc + r, ss_fix(part), __ATOMIC_RELAXED, __HIP_MEMORY_SCOPE_AGENT); } } while (0)
        PG8_RESID_LOAD(0);
        PG8_RESID_STEP(0, 0); PG8_RESID_STEP(0, 1); __builtin_amdgcn_sched_barrier(0);
        PG8_RESID_LOAD(1);
        PG8_RESID_STEP(0, 2); PG8_RESID_STEP(0, 3); PG8_RESID_STEP(1, 0); PG8_RESID_STEP(1, 1); PG8_RESID_STEP(1, 2); PG8_RESID_STEP(1, 3);
#undef PG8_RESID_LOAD
#undef PG8_RESID_STEP
    }
};
struct EpiMerge {
    static constexpr bool PERM = true, AFTER_DRAIN = false, MIDK = true; static constexpr int MID_T = 8; typedef NoPre::Pre Pre; __device__ __forceinline__ Pre prefetch(const Unit&, int, int) const { return Pre{}; }
    const bf16_t* GT; bf16_t* O; int ldc;
    __device__ __forceinline__ void mid(f32x4 (&acc)[2][2][4][2], const Unit& u, int wr, int wc, int fr_, int fq_) const {
        int fr = fr_, fq = fq_; asm volatile("" : "+v"(fr), "+v"(fq));
        const PG8_GAS bf16_t* ga_ = (const PG8_GAS bf16_t*)GT + ((size_t)u.pm * 8 + u.pn) * 65536 + (size_t)(wr * 4 + wc) * 512 + (fr + 16 * fq) * 8;
#pragma unroll
        for (int ai = 0; ai < 2; ++ai) { u32x4 ga[4][2], gb[4][2];
#pragma unroll
            for (int m = 0; m < 4; ++m)
#pragma unroll
                for (int bj = 0; bj < 2; ++bj) { const size_t fo = (size_t)(ai * 8 + m * 2 + bj) * 4096; ga[m][bj] = *(const PG8_GAS u32x4*)(ga_ + fo); gb[m][bj] = *(const PG8_GAS u32x4*)(ga_ + 4 * 65536 + fo); }
            __builtin_amdgcn_sched_barrier(0);
#pragma unroll
            for (int m = 0; m < 4; ++m)
#pragma unroll
                for (int bj = 0; bj < 2; ++bj) { const u32x4 a = ga[m][bj], b = gb[m][bj];
                    const f32x4 a0 = {bflo(a.x), bfhi(a.x), bflo(a.y), bfhi(a.y)}, a1 = {bflo(a.z), bfhi(a.z), bflo(a.w), bfhi(a.w)}, b0 = {bflo(b.x), bfhi(b.x), bflo(b.y), bfhi(b.y)}, b1 = {bflo(b.z), bfhi(b.z), bflo(b.w), bfhi(b.w)};
#pragma unroll
                    for (int j = 0; j < 4; ++j) { acc[ai][bj][m][0][j] *= a0[j] * __builtin_amdgcn_rcpf(fmaxf(b0[j], 1e-30f)); acc[ai][bj][m][1][j] *= a1[j] * __builtin_amdgcn_rcpf(fmaxf(b1[j], 1e-30f)); } }
            __builtin_amdgcn_sched_barrier(0); }
    }
    __device__ __forceinline__ void operator()(const f32x4 (&acc)[2][2][4][2], const Unit& u, int wr, int wc, int fr_, int fq_, const Pre&) const {
        int fr = fr_, fq = fq_; asm volatile("" : "+v"(fr), "+v"(fq));
        const int row0 = u.pm * BM + wr * 64 + fr, col0 = u.pn * BM + wc * 32 + 8 * fq;
        const PG8_GAS bf16_t* gb_ = (const PG8_GAS bf16_t*)GT + ((size_t)u.pm * 8 + 4 + u.pn) * 65536 + (size_t)(wr * 4 + wc) * 512 + (fr + 16 * fq) * 8;
        u32x4 gb[2][4][2];
#pragma unroll
        for (int ai = 0; ai < 2; ++ai)
#pragma unroll
            for (int m = 0; m < 4; ++m)
#pragma unroll
                for (int bj = 0; bj < 2; ++bj) gb[ai][m][bj] = *(const PG8_GAS u32x4*)(gb_ + (size_t)(ai * 8 + m * 2 + bj) * 4096);
        __builtin_amdgcn_sched_barrier(0);
#pragma unroll
        for (int ai = 0; ai < 2; ++ai)
#pragma unroll
            for (int m = 0; m < 4; ++m) { const size_t r = (size_t)(row0 + ai * HALF + m * 16);
#pragma unroll
                for (int bj = 0; bj < 2; ++bj) { const u32x4 b = gb[ai][m][bj];
                    const f32x4 b0 = {bflo(b.x), bfhi(b.x), bflo(b.y), bfhi(b.y)}, b1 = {bflo(b.z), bfhi(b.z), bflo(b.w), bfhi(b.w)};
                    const f32x4 v0 = acc[ai][bj][m][0] * b0, v1 = acc[ai][bj][m][1] * b1;
                    u32x4 w; w.x = cvt_pk_bf16(v0[0], v0[1]); w.y = cvt_pk_bf16(v0[2], v0[3]); w.z = cvt_pk_bf16(v1[0], v1[1]); w.w = cvt_pk_bf16(v1[2], v1[3]);
                    *(PG8_GAS u32x4*)((PG8_GAS bf16_t*)O + r * ldc + col0 + bj * HALF) = w; } }
    }
};
struct EpiGate1 {
    static constexpr bool PERM = true, AFTER_DRAIN = false, MIDK = false; typedef NoPre::Pre Pre; __device__ __forceinline__ Pre prefetch(const Unit&, int, int) const { return Pre{}; }
    const bf16_t* G; int ldg; bf16_t* T; int ldc;
    __device__ __forceinline__ void operator()(const f32x4 (&acc)[2][2][4][2], const Unit& u, int wr, int wc, int fr, int fq, const Pre&) const {
        const int row0 = u.pm * BM + wr * 64 + fr, col0 = u.pn * BM + wc * 32 + 8 * fq;
#pragma unroll
        for (int ai = 0; ai < 2; ++ai)
#pragma unroll
            for (int m = 0; m < 4; ++m) { const size_t r = (size_t)(row0 + ai * HALF + m * 16);
#pragma unroll
                for (int bj = 0; bj < 2; ++bj) { const u32x4 g = *(const u32x4*)(G + r * ldg + col0 + bj * HALF);
                    f32x4 g0 = {bflo(g.x), bfhi(g.x), bflo(g.y), bfhi(g.y)}, g1 = {bflo(g.z), bfhi(g.z), bflo(g.w), bfhi(g.w)};
                    const f32x4 t0 = g0 * acc[ai][bj][m][0], t1 = g1 * acc[ai][bj][m][1];
                    u32x4 w; w.x = cvt_pk_bf16(t0[0], t0[1]); w.y = cvt_pk_bf16(t0[2], t0[3]); w.z = cvt_pk_bf16(t1[0], t1[1]); w.w = cvt_pk_bf16(t1[2], t1[3]);
                    *(u32x4*)(T + r * ldc + col0 + bj * HALF) = w; } }
    }
};
struct EpiGate2 {
    static constexpr bool PERM = true, AFTER_DRAIN = false, MIDK = false; typedef NoPre::Pre Pre; __device__ __forceinline__ Pre prefetch(const Unit&, int, int) const { return Pre{}; }
    const bf16_t* G; int ldg; const bf16_t* T; bf16_t* O; int ldc;
    __device__ __forceinline__ void operator()(const f32x4 (&acc)[2][2][4][2], const Unit& u, int wr, int wc, int fr, int fq, const Pre&) const {
        const int row0 = u.pm * BM + wr * 64 + fr, col0 = u.pn * BM + wc * 32 + 8 * fq;
#pragma unroll
        for (int ai = 0; ai < 2; ++ai)
#pragma unroll
            for (int m = 0; m < 4; ++m) { const size_t r = (size_t)(row0 + ai * HALF + m * 16);
#pragma unroll
                for (int bj = 0; bj < 2; ++bj) { const u32x4 g = *(const u32x4*)(G + r * ldg + col0 + bj * HALF);
                    f32x4 g0 = {bflo(g.x), bfhi(g.x), bflo(g.y), bfhi(g.y)}, g1 = {bflo(g.z), bfhi(g.z), bflo(g.w), bfhi(g.w)};
                    const u32x4 tt = *(const u32x4*)(T + r * ldc + col0 + bj * HALF);
                    const f32x4 v0 = (f32x4){bflo(tt.x), bfhi(tt.x), bflo(tt.y), bfhi(tt.y)} + g0 * acc[ai][bj][m][0], v1 = (f32x4){bflo(tt.z), bfhi(tt.z), bflo(tt.w), bfhi(tt.w)} + g1 * acc[ai][bj][m][1];
                    u32x4 w; w.x = cvt_pk_bf16(v0[0], v0[1]); w.y = cvt_pk_bf16(v0[2], v0[3]); w.z = cvt_pk_bf16(v1[0], v1[1]); w.w = cvt_pk_bf16(v1[2], v1[3]);
                    *(u32x4*)(O + r * ldc + col0 + bj * HALF) = w; } }
    }
};
struct EpiF32 {
    static constexpr bool PERM = true, AFTER_DRAIN = false, MIDK = false; typedef NoPre::Pre Pre; __device__ __forceinline__ Pre prefetch(const Unit&, int, int) const { return Pre{}; }
    bf16_t* O; int ldc;
    __device__ __forceinline__ void operator()(const f32x4 (&acc)[2][2][4][2], const Unit& u, int wr, int wc, int fr, int fq, const Pre&) const {
        const int row0 = u.pm * BM + wr * 64 + fr, col0 = u.pn * BM + wc * 32 + 8 * fq;
#pragma unroll
        for (int ai = 0; ai < 2; ++ai)
#pragma unroll
            for (int m = 0; m < 4; ++m)
#pragma unroll
                for (int bj = 0; bj < 2; ++bj) { const f32x4 v0 = acc[ai][bj][m][0], v1 = acc[ai][bj][m][1]; u32x4 w; w.x = cvt_pk_bf16(v0[0], v0[1]); w.y = cvt_pk_bf16(v0[2], v0[3]); w.z = cvt_pk_bf16(v1[0], v1[1]); w.w = cvt_pk_bf16(v1[2], v1[3]);
                    *(u32x4*)(O + (size_t)(row0 + ai * HALF + m * 16) * ldc + col0 + bj * HALF) = w; }
    }
};
struct EpiPle2 {
    static constexpr bool PERM = true, AFTER_DRAIN = false, MIDK = false; typedef NoPre::Pre Pre; __device__ __forceinline__ Pre prefetch(const Unit&, int, int) const { return Pre{}; }
    const bf16_t* PP; float* x; int ldc; const ssq_t* ss_in; bf16_t* xb; ssq_t* ssacc; float osc;
    __device__ __forceinline__ void operator()(const f32x4 (&acc)[2][2][4][2], const Unit& u, int wr, int wc, int fr_, int fq_, const Pre&) const {
        int fr = fr_, fq = fq_; asm volatile("" : "+v"(fr), "+v"(fq));
        const int row0 = u.pm * BM + wr * 64 + fr, col0 = u.pn * BM + wc * 32 + 8 * fq;
        const PG8_GAS float* gx_ = (const PG8_GAS float*)x; const PG8_GAS bf16_t* gp_ = (const PG8_GAS bf16_t*)PP;
        f32x4 xv[4][2][2][2]; u32x4 pv[4][2][2]; ssq_t sv[4][2];
#define PG8_PLE_LOAD(q) do { _Pragma("unroll") for (int mm = 0; mm < 2; ++mm) { sv[q][mm] = ss_in ? ((const PG8_GAS ssq_t*)ss_in)[row0 + ((q) >> 1) * HALF + (((q) & 1) * 2 + mm) * 16] : 0u; _Pragma("unroll") for (int bj = 0; bj < 2; ++bj) { const size_t off = (size_t)(row0 + ((q) >> 1) * HALF + (((q) & 1) * 2 + mm) * 16) * ldc + col0 + bj * HALF; \
            pv[q][mm][bj] = *(const PG8_GAS u32x4*)(gp_ + off); xv[q][mm][bj][0] = *(const PG8_GAS f32x4*)(gx_ + off); xv[q][mm][bj][1] = *(const PG8_GAS f32x4*)(gx_ + off + 4); } } __builtin_amdgcn_sched_barrier(0); } while (0)
#define PG8_PLE_STEP(q, mm) do { constexpr int ai = (q) >> 1, m = ((q) & 1) * 2 + (mm); const int r = row0 + ai * HALF + m * 16; ssq_t sq_ = sv[q][mm]; asm volatile("" : "+v"(sq_));   const float rs = (ss_in ? rstd_fix(sq_) : 1.0f) * osc; float part = 0.f; \
            _Pragma("unroll") for (int bj = 0; bj < 2; ++bj) { const size_t off = (size_t)r * ldc + col0 + bj * HALF; \
                f32x4 a0 = acc[ai][bj][m][0] * rs, a1 = acc[ai][bj][m][1] * rs; \
                _Pragma("unroll") for (int j = 0; j < 4; ++j) { a0[j] = sigm(a0[j]); a1[j] = sigm(a1[j]); } \
                const u32x4 pw = pv[q][mm][bj]; \
                const f32x4 v0 = xv[q][mm][bj][0] + a0 * (f32x4){bflo(pw.x), bfhi(pw.x), bflo(pw.y), bfhi(pw.y)}, v1 = xv[q][mm][bj][1] + a1 * (f32x4){bflo(pw.z), bfhi(pw.z), bflo(pw.w), bfhi(pw.w)}; \
                *(PG8_GAS f32x4*)((PG8_GAS float*)x + off) = v0; *(PG8_GAS f32x4*)((PG8_GAS float*)x + off + 4) = v1; \
                if (xb) { u32x4 w; w.x = cvt_pk_bf16(v0[0], v0[1]); w.y = cvt_pk_bf16(v0[2], v0[3]); w.z = cvt_pk_bf16(v1[0], v1[1]); w.w = cvt_pk_bf16(v1[2], v1[3]); *(PG8_GAS u32x4*)((PG8_GAS bf16_t*)xb + off) = w; } \
                part += (v0[0] * v0[0] + v0[1] * v0[1]) + (v0[2] * v0[2] + v0[3] * v0[3]) + (v1[0] * v1[0] + v1[1] * v1[1]) + (v1[2] * v1[2] + v1[3] * v1[3]); } \
            if (ssacc) { part = quad_sum(part, fr, fq); if (fq == 0) __hip_atomic_fetch_add((PG8_GAS ssq_t*)ssacc + r, ss_fix(part), __ATOMIC_RELAXED, __HIP_MEMORY_SCOPE_AGENT); } } while (0)
        PG8_PLE_LOAD(0);
        PG8_PLE_STEP(0, 0); __builtin_amdgcn_sched_barrier(0);
        PG8_PLE_LOAD(1);
        PG8_PLE_STEP(0, 1); PG8_PLE_STEP(1, 0); __builtin_amdgcn_sched_barrier(0);
        PG8_PLE_LOAD(2);
        PG8_PLE_STEP(1, 1); PG8_PLE_STEP(2, 0); __builtin_amdgcn_sched_barrier(0);
        PG8_PLE_LOAD(3);
        PG8_PLE_STEP(2, 1); PG8_PLE_STEP(3, 0); PG8_PLE_STEP(3, 1);
#undef PG8_PLE_LOAD
#undef PG8_PLE_STEP
    }
};
}
#define GAS __attribute__((address_space(1)))
#define LAS __attribute__((address_space(3)))
typedef unsigned short bf16;
typedef unsigned v4u __attribute__((ext_vector_type(4)));
typedef float f32x4 __attribute__((ext_vector_type(4)));
typedef short bf16x8 __attribute__((ext_vector_type(8)));
typedef GAS unsigned gu32;
typedef GAS unsigned long long gu64;
#define RLX_AGENT __ATOMIC_RELAXED, __HIP_MEMORY_SCOPE_AGENT
#define LDS_WAIT() asm volatile("s_waitcnt lgkmcnt(0)" ::: "memory")
#define VM_WAIT() asm volatile("s_waitcnt vmcnt(0)" ::: "memory")
__device__ __forceinline__ unsigned long long rt() { return __builtin_amdgcn_s_memrealtime(); }
__device__ __forceinline__ unsigned f2bf(float f) { unsigned u = __builtin_bit_cast(unsigned, f); return (u + 0x7fffu + ((u >> 16) & 1u)) >> 16; }
__device__ __forceinline__ unsigned pk2(float lo, float hi) { return f2bf(lo) | (f2bf(hi) << 16); }

#define XB_TMO      128
#define XB_XCNT(j)  (256  + 64 * (j))
#define XB_XSUB(j)  (1280 + 64 * (j))
#define XB_XGEN(j)  (2304 + 64 * (j))
#define XB_TOP      3328
#define XB_TOPGEN   3392
#define XCD_BAR_WORDS 3456
#define XB_SPIN_CAP (1u << 18)

__device__ __forceinline__ unsigned xb_ld(unsigned* p)              { return __hip_atomic_load(p, __ATOMIC_RELAXED, __HIP_MEMORY_SCOPE_AGENT); }
__device__ __forceinline__ unsigned xb_add(unsigned* p, unsigned v) { return __hip_atomic_fetch_add(p, v, __ATOMIC_RELAXED, __HIP_MEMORY_SCOPE_AGENT); }
__device__ __forceinline__ unsigned xb_xcc_id() { return (unsigned)__builtin_amdgcn_s_getreg((3 << 11) | 20) & 0xFu; }
#define XB_SPIN(cond, bar) do { unsigned _sp = 0; while (cond) { __builtin_amdgcn_s_sleep(1); \
    if ((++_sp & 255u) == 0u) { if (xb_ld(&(bar)[XB_TMO])) break; if (_sp > XB_SPIN_CAP) { atomicAdd(&(bar)[XB_TMO], 1u); break; } } } } while (0)

__device__ __forceinline__ int lane_now() { int l; asm volatile("v_mbcnt_lo_u32_b32 %0, -1, 0\n\tv_mbcnt_hi_u32_b32 %0, -1, %0" : "=v"(l)); return l; }
struct XcdBarrier {
    unsigned* bar; unsigned x; int wave;
    volatile LAS unsigned* st;
};

__device__ __forceinline__ XcdBarrier xcd_barrier_post(unsigned* bar, volatile LAS unsigned* st, int wave) {
    XcdBarrier b; b.bar = bar; b.x = xb_xcc_id(); b.st = st; b.wave = wave;
    if (wave == 0 && lane_now() == 0) (void)xb_add(&bar[XB_XCNT(b.x)], 1u);
    return b;
}
__device__ __forceinline__ void xcd_barrier_complete(unsigned* bar, unsigned x, unsigned& nloc, unsigned& nx) {
    const unsigned G = gridDim.x * gridDim.y * gridDim.z;
    unsigned sum, cnt, mine, sp = 0u;
    for (;;) {
        sum = 0u; cnt = 0u; mine = 0u;
#pragma unroll
        for (unsigned j = 0; j < 16; ++j) { const unsigned c = xb_ld(&bar[XB_XCNT(j)]); sum += c; cnt += (c > 0u) ? 1u : 0u; mine = (j == x) ? c : mine; }
        if (sum == G) break;
        __builtin_amdgcn_s_sleep(1);
        if ((++sp & 255u) == 0u) { if (xb_ld(&bar[XB_TMO])) break; if (sp > XB_SPIN_CAP) { atomicAdd(&bar[XB_TMO], 1u); break; } }
    }
    nloc = mine > 0u ? mine : 1u; nx = cnt > 0u ? cnt : 1u;
}

__device__ __forceinline__ void xcd_barrier(const XcdBarrier& b) {
    asm volatile("s_waitcnt vmcnt(0)" ::: "memory");
    __syncthreads();
    if (b.wave == 0 && lane_now() == 0) {
        unsigned* bar = b.bar;
        __builtin_amdgcn_s_waitcnt(0);
        unsigned nloc = b.st[0], nx = b.st[1];
        if (nloc == 0u) { xcd_barrier_complete(bar, b.x, nloc, nx); b.st[0] = nloc; b.st[1] = nx; }
        const unsigned old = xb_add(&bar[XB_XSUB(b.x)], 1u);
        const unsigned gen = old / nloc;
        if (old + 1u == (gen + 1u) * nloc) {
            __builtin_amdgcn_fence(__ATOMIC_RELEASE, "agent");
            asm volatile("s_waitcnt vmcnt(0)" ::: "memory");
            const unsigned og = xb_add(&bar[XB_TOP], 1u);
            const unsigned tg = og / nx;
            if (og + 1u == (tg + 1u) * nx) xb_add(&bar[XB_TOPGEN], 1u);
            else XB_SPIN(xb_ld(&bar[XB_TOPGEN]) == tg, bar);
            __builtin_amdgcn_fence(__ATOMIC_ACQUIRE, "agent");
            xb_add(&bar[XB_XGEN(b.x)], 1u);
            asm volatile("s_waitcnt vmcnt(0)" ::: "memory");
        } else {
            XB_SPIN(xb_ld(&bar[XB_XGEN(b.x)]) == gen, bar);
            __builtin_amdgcn_fence(__ATOMIC_ACQUIRE, "agent");
            asm volatile("s_waitcnt vmcnt(0)" ::: "memory");
        }
    }
    __syncthreads();
}
constexpr int NWAVES = 8, NTHR = NWAVES * 64;
constexpr int BATCH = 4, SEQ = 4096, D = 1024, M = BATCH * SEQ, NIN = 5640, NPROJ = 3584, PLE = 256;
constexpr int DFF = 2816, NEXP = 8, DFFE = 3584, NLAYER = 2;
constexpr int AH = 8, AHD = 64, ABLK = 256, ANB = SEQ / ABLK;
constexpr int MH = 4, MDK = 128;
constexpr float RMS_EPS = 1e-6f;
constexpr float C2 = 0.125f * 1.4426950408889634f;
constexpr int PC_Q = 0, PC_K = 512, PC_V = 1024, PC_QKM = 1536, PC_VM = 2560, PC_OM = 3072, PC_GA = 3584, PC_GB = 4608;

constexpr size_t MiB = 1u << 20;
constexpr size_t WS_CTL = 0, CTL_ZERO_BYTES = 1 * MiB;
constexpr int NPROJX = 5888;
constexpr size_t WS_WIN = 1 * MiB, WS_WOA = 24 * MiB, WS_WOB = 26 * MiB, WS_WOUT = 28 * MiB, WS_WD13 = 32 * MiB, WS_WD2 = 43 * MiB, WS_WPG = 49 * MiB, WS_WPP = 53 * MiB, WS_PB = 54 * MiB;
constexpr size_t WS_WE = 70 * MiB;
constexpr size_t WS_SMALL = 154 * MiB;
constexpr size_t WS_XB = 161 * MiB;
constexpr size_t WS_SS0 = WS_SMALL + 5 * MiB;
constexpr size_t WS_IFPRE = WS_SMALL, WS_KMEAN = WS_SMALL + 1 * MiB, WS_GSEL = WS_SMALL + 4 * MiB;
constexpr size_t WS_HB = 161 * MiB, WS_QKC = 193 * MiB, WS_YA = 225 * MiB, WS_YB = 225 * MiB + 1024  , WS_MIXED = 257 * MiB, WS_ST = 289 * MiB, WS_PROJ = 309 * MiB, WS_END = 485 * MiB;
constexpr size_t WS_TOPI = WS_SMALL + 2 * MiB, WS_TOPG = WS_TOPI + 256 * 1024, WS_DEST = WS_TOPG + 256 * 1024, WS_ROWTOK = WS_SMALL + 3 * MiB, WS_TILEE = WS_ROWTOK + 512 * 1024, WS_NTILES = WS_TILEE + 4096;
constexpr int MOE_MAXROWS = 2 * M + NEXP * 256;
constexpr size_t WS_WE2B = 448 * MiB;
constexpr size_t WS_XG = 193 * MiB, WS_Y = 261 * MiB, WS_GHH = 329 * MiB;
static_assert(WS_XG + (size_t)MOE_MAXROWS * D * 2 <= WS_Y && WS_Y + (size_t)MOE_MAXROWS * D * 2 <= WS_GHH && WS_GHH + (size_t)MOE_MAXROWS * DFFE <= WS_END, "MoE buffers");
constexpr size_t WS_GT = WS_PROJ + (size_t)M * NPROJ * 2;
static_assert(WS_GT + (size_t)64 * MiB <= WS_END, "gate tiles inside the old proj region");
constexpr size_t WS_TMP = WS_HB;
constexpr size_t WS_GH = WS_PROJ, WS_PP = WS_PROJ;
constexpr int CW_TMO = 0, CW_CODE = 1, CW_BAR = 4096;
constexpr int CW_SS = 65536;
static_assert((CW_SS + 3 * M) * 4 <= (int)CTL_ZERO_BYTES, "SS accumulators inside the zeroed region");

constexpr int RING_OFF = 0, RING_BYTES = 131072;
constexpr int LDSCTL_OFF = RING_BYTES, MISC_OFF = LDSCTL_OFF + 320;
constexpr int LDS_BYTES = 147456;
struct Frame {
    LAS unsigned char* lds;
    volatile LAS unsigned* MISC;
    gu32* ctl;
    int wave;
    int vcu, G;
    unsigned char* ws;
};
__device__ __forceinline__ int opaque(int v) { asm volatile("" : "+v"(v)); return v; }
#define PHASE_LOCALS() const int tid = F.wave * 64 + lane_now(), lane = tid & 63; (void)lane
__device__ __forceinline__ float shx(float v, int o, int lane) { return __int_as_float(__builtin_amdgcn_ds_bpermute((lane ^ o) << 2, __float_as_int(v))); }
__device__ __forceinline__ float wave_sum(float v, int lane) {
#pragma unroll
    for (int o = 1; o < 64; o <<= 1) v += shx(v, o, lane);
    return v;
}
__device__ __forceinline__ float wave_max(float v, int lane) {
#pragma unroll
    for (int o = 1; o < 64; o <<= 1) v = fmaxf(v, shx(v, o, lane));
    return v;
}
__device__ __forceinline__ float bf2f(bf16 u) { return __uint_as_float((unsigned)u << 16); }
__device__ __forceinline__ float bflo(unsigned w) { return __uint_as_float(w << 16); }
__device__ __forceinline__ float bfhi(unsigned w) { return __uint_as_float(w & 0xffff0000u); }
__device__ __forceinline__ float sigm(float x) { return pg8::sigm(x); }

__device__ __forceinline__ void tr_item(const float* W, int ld, int K, int N, bf16* WT, int rowstep, int row_off, LAS float* scr, int item, int lane, const float* gk = nullptr, int nrows = 32) {
    const int nblk = N / 32, kb = item / nblk, nb = item % nblk, k0 = 64 * kb, n0 = 32 * nb;
#pragma unroll 32
    for (int i = 0; i < 32; ++i) { const int kk = 2 * i + (lane >> 5); scr[kk * 33 + (lane & 31)] = W[(size_t)(k0 + kk) * ld + n0 + (lane & 31)] * (gk ? gk[k0 + kk] : 1.0f); }
    LDS_WAIT(); asm volatile("" ::: "memory");
    const int c = lane & 7;
#pragma unroll
    for (int j = 0; j < 4; ++j) { const int n = (lane >> 3) + 8 * j; const LAS float* s = scr + (8 * c) * 33 + n;
        v4u o; o.x = pk2(s[0 * 33], s[1 * 33]); o.y = pk2(s[2 * 33], s[3 * 33]); o.z = pk2(s[4 * 33], s[5 * 33]); o.w = pk2(s[6 * 33], s[7 * 33]);
        const int nn = n0 + n, drow = (nn >> 7) * rowstep + (nn & 127) + row_off;
        if (n < nrows) *(GAS v4u*)(WT + (size_t)drow * K + k0 + 8 * c) = o; }
    LDS_WAIT(); asm volatile("" ::: "memory");
}
__device__ __forceinline__ void tr_tile(const float* W, int ld, int K, int ntn, bf16* WT, int rowstep, int row_off, LAS float* scr, int tile, int wave, int lane, const float* gk, bool permqk, float f8scale = 0.f) {
    const int kb = tile / ntn, nb = tile % ntn, k0 = 64 * kb, n0 = 256 * nb;
    f32x4 v[8];
#pragma unroll
    for (int i = 0; i < 8; ++i) v[i] = *(const f32x4*)(W + (size_t)(k0 + wave + 8 * i) * ld + n0 + 4 * lane);
#pragma unroll
    for (int i = 0; i < 8; ++i) { const int k = wave + 8 * i; const float g = gk ? gk[k0 + k] : 1.0f; LAS float* d = scr + k * 257 + 4 * lane; d[0] = v[i][0] * g; d[1] = v[i][1] * g; d[2] = v[i][2] * g; d[3] = v[i][3] * g; }
    __syncthreads();
    const int tid = wave * 64 + lane, c = tid & 7;
#pragma unroll
    for (int j = 0; j < 4; ++j) { const int n = (tid >> 3) + 64 * j; const LAS float* p = scr + (8 * c) * 257 + n;
        v4u o; o.x = pk2(p[0], p[257]); o.y = pk2(p[2 * 257], p[3 * 257]); o.z = pk2(p[4 * 257], p[5 * 257]); o.w = pk2(p[6 * 257], p[7 * 257]);
        const int nn = n0 + n, drow = permqk ? (nn & ~255) + (((nn >> 5) & 1) << 7) + (((nn >> 6) & 3) << 5) + (nn & 31) + row_off : (nn >> 7) * rowstep + (nn & 127) + row_off;
        if (f8scale != 0.f) { uint2 o8; int a_ = __builtin_amdgcn_cvt_pk_fp8_f32(p[0] * f8scale, p[257] * f8scale, 0, false); a_ = __builtin_amdgcn_cvt_pk_fp8_f32(p[2 * 257] * f8scale, p[3 * 257] * f8scale, a_, true);
            int b_ = __builtin_amdgcn_cvt_pk_fp8_f32(p[4 * 257] * f8scale, p[5 * 257] * f8scale, 0, false); b_ = __builtin_amdgcn_cvt_pk_fp8_f32(p[6 * 257] * f8scale, p[7 * 257] * f8scale, b_, true);
            o8.x = (unsigned)a_; o8.y = (unsigned)b_; *(uint2*)((unsigned char*)WT + (size_t)drow * K + k0 + 8 * c) = o8; }
        else *(GAS v4u*)(WT + (size_t)drow * K + k0 + 8 * c) = o; }
    __syncthreads();
}
#define TTJOBG(W_, ld_, K_, N_, WT_, rs_, ro_, gk_) if (!found) { const int I_ = ((K_) / 64) * ((N_) / 256); if (r < I_) { jb.W = (W_); jb.ld = (ld_); jb.K = (K_); jb.N = (N_); jb.WT = (WT_); jb.rowstep = (rs_); jb.row_off = (ro_); jb.gk = (gk_); jb.nrows = 32; found = true; } else r -= I_; }
struct TrJob { const float* W; int ld, K, N; bf16* WT; int rowstep, row_off; const float* gk; int nrows; };
#define TRJOBG256(W_, ld_, K_, N_, WT_, rs_, ro_, gk_, nr_) if (!found) { const int I_ = ((K_) / 64) * ((N_) / 256); if (r < I_) { jb.W = (W_); jb.ld = (ld_); jb.K = (K_); jb.N = (N_); jb.WT = (WT_); jb.rowstep = (rs_); jb.row_off = (ro_); jb.gk = (gk_); jb.nrows = (nr_); found = true; } else r -= I_; }
constexpr float WPG_F8SCALE = 32.0f, HB_F8SCALE = 16.0f;
#define TRJOBG(W_, ld_, K_, N_, WT_, rs_, ro_, gk_, nr_) if (!found) { const int I_ = ((K_) / 64) * ((N_) / 32); if (r < I_) { jb.W = (W_); jb.ld = (ld_); jb.K = (K_); jb.N = (N_); jb.WT = (WT_); jb.rowstep = (rs_); jb.row_off = (ro_); jb.gk = (gk_); jb.nrows = (nr_); found = true; } else r -= I_; }
#define TRJOB(W_, ld_, K_, N_, WT_, rs_, ro_) TRJOBG(W_, ld_, K_, N_, WT_, rs_, ro_, nullptr, 32)

struct Inputs { const float* p[25]; };
enum { I_X = 0, I_P, I_GMIX, I_WIN, I_GQ, I_GK, I_CONVW, I_CONVB, I_BI, I_BF, I_GH, I_WOA, I_WOB, I_WOUT, I_GFFN, I_WD1, I_WD3, I_WD2, I_WR, I_WE1, I_WE3, I_WE2, I_GPLE, I_WPG, I_WPP };

constexpr int PER_LAYER_T = 16 * 4 + 16 * 10 + 16 * 8 + 2 * (8 * 4) + 2 * (16 * 4) + 4 * 4, NTILES_T = 2 * PER_LAYER_T + 2 * (16 * 11) + 44 * 4, P0_URGENT = 16 * 4 + 16 * 10 + 16 * 8;
__device__ __forceinline__ void p0_tile(Frame& F, const Inputs& in, int r_in, int lane) {
    int r = r_in; bool found = false; TrJob jb;
            jb.W = nullptr; jb.ld = 0; jb.K = 64; jb.N = 256; jb.WT = nullptr; jb.rowstep = 128; jb.row_off = 0; jb.gk = nullptr; jb.nrows = 32;
#pragma unroll
            for (int l = 0; l < 2; ++l) {
                if (!found) { const int I_ = 16 * 4; if (r < I_) { jb.W = in.p[I_WIN] + (size_t)l * D * NIN; jb.ld = NIN; jb.K = D; jb.N = 1024; jb.WT = (bf16*)(F.ws + WS_WIN) + (size_t)l * NPROJX * D; jb.rowstep = 128; jb.row_off = 0; jb.gk = in.p[I_GMIX] + l * D; jb.nrows = 33; found = true; } else r -= I_; }
                TTJOBG(in.p[I_WIN] + (size_t)l * D * NIN + 1024, NIN, D, 2560, (bf16*)(F.ws + WS_WIN) + (size_t)l * NPROJX * D, 128, 1024, in.p[I_GMIX] + l * D)
                TTJOBG(in.p[I_WIN] + (size_t)l * D * NIN + 3592, NIN, D, 2048, (bf16*)(F.ws + WS_WIN) + (size_t)l * NPROJX * D, 128, 3584, in.p[I_GMIX] + l * D)
                if (!found) { const int I_ = 8 * 4; if (r < I_) { jb.W = in.p[I_WOA] + (size_t)l * 512 * D; jb.ld = D; jb.K = D; jb.N = D; jb.WT = (bf16*)(F.ws + WS_WOA) + (size_t)l * D * D; jb.rowstep = 128; jb.row_off = 0; jb.gk = nullptr; found = true; } else r -= I_; }
                if (!found) { const int I_ = 8 * 4; if (r < I_) { jb.W = in.p[I_WOB] + (size_t)l * 512 * D; jb.ld = D; jb.K = D; jb.N = D; jb.WT = (bf16*)(F.ws + WS_WOA) + (size_t)l * D * D + 512; jb.rowstep = 128; jb.row_off = 0; jb.gk = nullptr; found = true; } else r -= I_; }
                TTJOBG(in.p[I_WOUT] + (size_t)l * D * D, D, D, D, (bf16*)(F.ws + WS_WOUT) + (size_t)l * D * D, 128, 0, nullptr)
                TRJOBG256(in.p[I_WPG] + (size_t)l * D * D, D, D, D, (bf16*)(F.ws + WS_WPG) + (size_t)l * D * D, 128, 0, (l == 0) ? in.p[I_GPLE] : nullptr, (l == 0) ? 32 : 34)
                TTJOBG(in.p[I_WPP] + (size_t)l * PLE * D, D, PLE, D, (bf16*)(F.ws + WS_WPP) + (size_t)l * D * PLE, 128, 0, nullptr)
            }
            TTJOBG(in.p[I_WD1], DFF, D, DFF, (bf16*)(F.ws + WS_WD13), 256, 0, in.p[I_GFFN])
            TTJOBG(in.p[I_WD3], DFF, D, DFF, (bf16*)(F.ws + WS_WD13), 256, 128, in.p[I_GFFN])
            TTJOBG(in.p[I_WD2], D, DFF, D, (bf16*)(F.ws + WS_WD2), 128, 0, nullptr)
    if (found) tr_tile(jb.W, jb.ld, jb.K, jb.N / 256, jb.WT, jb.rowstep, jb.row_off, (LAS float*)(F.lds + RING_OFF), r, F.wave, lane, jb.gk, jb.nrows == 33, jb.nrows == 34 ? WPG_F8SCALE : 0.f);
}
constexpr int P_CHUNKS = 64;
__device__ __forceinline__ void p_chunk(Frame& F, const Inputs& in, int c, int tid) {
    const size_t n8 = (size_t)2 * M * PLE / 8, per = n8 / P_CHUNKS;
    for (size_t i = (size_t)c * per + tid; i < (size_t)(c + 1) * per; i += NTHR) {
        const f32x4 a = *(const f32x4*)(in.p[I_P] + i * 8), b = *(const f32x4*)(in.p[I_P] + i * 8 + 4);
        v4u o; o.x = pk2(a[0], a[1]); o.y = pk2(a[2], a[3]); o.z = pk2(b[0], b[1]); o.w = pk2(b[2], b[3]);
        *(v4u*)((bf16*)(F.ws + WS_PB) + i * 8) = o; }
}
__device__ __forceinline__ void p0_prologue(Frame& F, const Inputs& in, int parts = 7) {
    PHASE_LOCALS();
    LAS float* scr = (LAS float*)(F.lds + RING_OFF + F.wave * 16384);
    const int gw = F.vcu * NWAVES + F.wave, NGW = F.G * NWAVES;
    if (parts & 1) {
        for (int it = F.vcu; it < P0_URGENT; it += F.G) p0_tile(F, in, it, lane);
        for (int it = gw; it < 32; it += NGW) { const int l = it >> 4;
            tr_item(in.p[I_WIN] + (size_t)l * D * NIN + 3584, NIN, D, 32, (bf16*)(F.ws + WS_WIN) + (size_t)l * NPROJX * D, 128, 5632, scr, it & 15, lane, in.p[I_GMIX] + l * D, 8); }
    }
    if (parts & 2) { pg8::ssq_t* SS0 = (pg8::ssq_t*)(F.ws + WS_SS0); bf16* XB = (bf16*)(F.ws + WS_XB);
      for (int m = gw; m < M; m += NGW) { const f32x4* xr = (const f32x4*)(in.p[I_X] + (size_t)m * D) + lane; unsigned long long* o8 = (unsigned long long*)(XB + (size_t)m * D) + lane; float ss = 0.f;
#pragma unroll
          for (int j = 0; j < 4; ++j) { const f32x4 v = xr[64 * j]; ss += (v[0] * v[0] + v[1] * v[1]) + (v[2] * v[2] + v[3] * v[3]); o8[64 * j] = (unsigned long long)pk2(v[0], v[1]) | ((unsigned long long)pk2(v[2], v[3]) << 32); }
          ss = wave_sum(ss, lane); if (lane == 0) SS0[m] = pg8::ss_fix(ss); } }
}
__device__ __forceinline__ void p_conv_expert(Frame& F, const Inputs& in, int e) {
    PHASE_LOCALS();
    LAS float* scr = (LAS float*)(F.lds + RING_OFF + F.wave * 16384);
    const int gw = F.vcu * NWAVES + F.wave, NGW = F.G * NWAVES;
    constexpr int NITEMS = 2 * (16 * 112) + 56 * 32;
    bf16* W13 = (bf16*)(F.ws + WS_WE); bf16* W2 = W13 + (size_t)2 * DFFE * D;
    for (int it = gw; it < NITEMS; it += NGW) {
        int r = it; bool found = false; TrJob jb;
        jb.W = nullptr; jb.ld = 0; jb.K = 64; jb.N = 32; jb.WT = nullptr; jb.rowstep = 128; jb.row_off = 0; jb.gk = nullptr; jb.nrows = 32;
        TRJOB(in.p[I_WE1] + (size_t)e * D * DFFE, DFFE, D, DFFE, W13, 256, 0)
        TRJOB(in.p[I_WE3] + (size_t)e * D * DFFE, DFFE, D, DFFE, W13, 256, 128)
        TRJOB(in.p[I_WE2] + (size_t)e * DFFE * D, D, DFFE, D, W2, 128, 0)
        if (found) tr_item(jb.W, jb.ld, jb.K, jb.N, jb.WT, jb.rowstep, jb.row_off, scr, r, lane, jb.gk, jb.nrows);
    }
}

template <int MODE>
__device__ __forceinline__ void phase_norm(Frame& F, const float* xsrc, const float* g, bf16* hb, const float* wx, int ldw, const float* b_i, const float* b_f, float* ifpre, float* gsel) {
    PHASE_LOCALS();
    LAS float* wl = (LAS float*)F.lds;
    if (MODE == 1 || MODE == 2) {
        for (int i = tid; i < 1024 * 2; i += NTHR) { const int c = i >> 1, hlf = i & 1; *(LAS f32x4*)(wl + c * 8 + 4 * hlf) = *(const f32x4*)(wx + (size_t)c * ldw + 4 * hlf); }
        __syncthreads();
    }
    const int gw = F.vcu * NWAVES + F.wave, NGW = F.G * NWAVES;
    f32x4 gv[4];
#pragma unroll
    for (int j = 0; j < 4; ++j) gv[j] = ((const f32x4*)g)[lane + 64 * j];
    f32x4 vn[4]; uint2 yan[4], ybn[4]; float2 tgn = make_float2(0.f, 0.f), tgc = tgn; int2 tdn = make_int2(0, 0);
#pragma unroll
    for (int j = 0; j < 4; ++j) { vn[j] = (f32x4){0.f, 0.f, 0.f, 0.f}; yan[j] = make_uint2(0u, 0u); ybn[j] = make_uint2(0u, 0u); }
    if (gw < M) {
        if (MODE == 3) { tgc = *(const float2*)((const float*)(F.ws + WS_TOPG) + (size_t)gw * 2); const int2 td0 = *(const int2*)((const int*)(F.ws + WS_DEST) + (size_t)gw * 2);
            const bf16* y1 = (const bf16*)(F.ws + WS_Y) + (size_t)td0.x * D; const bf16* y2 = (const bf16*)(F.ws + WS_Y) + (size_t)td0.y * D;
#pragma unroll
            for (int j = 0; j < 4; ++j) { yan[j] = *(const uint2*)(y1 + 4 * lane + 256 * j); ybn[j] = *(const uint2*)(y2 + 4 * lane + 256 * j); }
            if (gw + NGW < M) { tgn = *(const float2*)((const float*)(F.ws + WS_TOPG) + (size_t)(gw + NGW) * 2); tdn = *(const int2*)((const int*)(F.ws + WS_DEST) + (size_t)(gw + NGW) * 2); } }
#pragma unroll
        for (int j = 0; j < 4; ++j) vn[j] = ((const f32x4*)(xsrc + (size_t)gw * D) + lane)[64 * j];
    }
    for (int m = gw; m < M; m += NGW) {
        f32x4 v[4]; uint2 ya[4], yb[4]; float s = 0.f; const float2 tg = tgc;
#pragma unroll
        for (int j = 0; j < 4; ++j) { v[j] = vn[j]; ya[j] = yan[j]; yb[j] = ybn[j]; }
        if (m + NGW < M) {
            const int mn = m + NGW;
            if (MODE == 3) { tgc = tgn; const bf16* y1 = (const bf16*)(F.ws + WS_Y) + (size_t)tdn.x * D; const bf16* y2 = (const bf16*)(F.ws + WS_Y) + (size_t)tdn.y * D;
#pragma unroll
                for (int j = 0; j < 4; ++j) { yan[j] = *(const uint2*)(y1 + 4 * lane + 256 * j); ybn[j] = *(const uint2*)(y2 + 4 * lane + 256 * j); }
                if (mn + NGW < M) { tgn = *(const float2*)((const float*)(F.ws + WS_TOPG) + (size_t)(mn + NGW) * 2); tdn = *(const int2*)((const int*)(F.ws + WS_DEST) + (size_t)(mn + NGW) * 2); } }
#pragma unroll
            for (int j = 0; j < 4; ++j) vn[j] = ((const f32x4*)(xsrc + (size_t)mn * D) + lane)[64 * j];
        }
        if (MODE == 3) {
#pragma unroll
            for (int j = 0; j < 4; ++j) { const uint2 a = ya[j], b = yb[j];
                v[j][0] += tg.x * bflo(a.x) + tg.y * bflo(b.x); v[j][1] += tg.x * bfhi(a.x) + tg.y * bfhi(b.x); v[j][2] += tg.x * bflo(a.y) + tg.y * bflo(b.y); v[j][3] += tg.x * bfhi(a.y) + tg.y * bfhi(b.y);
                ((f32x4*)(const_cast<float*>(xsrc) + (size_t)m * D))[lane + 64 * j] = v[j]; }
        }
#pragma unroll
        for (int j = 0; j < 4; ++j) s += (v[j][0] * v[j][0] + v[j][1] * v[j][1]) + (v[j][2] * v[j][2] + v[j][3] * v[j][3]);
        const float rstd = 1.0f / sqrtf(wave_sum(s, lane) * (1.0f / D) + RMS_EPS);
        unsigned long long* o8 = (unsigned long long*)(hb + (size_t)m * D) + lane;
#pragma unroll
        for (int j = 0; j < 4; ++j) { v[j] = v[j] * rstd * gv[j];
            if (MODE == 3) {
                int a_ = __builtin_amdgcn_cvt_pk_fp8_f32(__builtin_amdgcn_fmed3f(v[j][0] * HB_F8SCALE, -448.0f, 448.0f), __builtin_amdgcn_fmed3f(v[j][1] * HB_F8SCALE, -448.0f, 448.0f), 0, false);
                a_ = __builtin_amdgcn_cvt_pk_fp8_f32(__builtin_amdgcn_fmed3f(v[j][2] * HB_F8SCALE, -448.0f, 448.0f), __builtin_amdgcn_fmed3f(v[j][3] * HB_F8SCALE, -448.0f, 448.0f), a_, true);
                ((unsigned*)((unsigned char*)hb + (size_t)m * D))[lane + 64 * j] = (unsigned)a_; }
            else o8[64 * j] = (unsigned long long)pk2(v[j][0], v[j][1]) | ((unsigned long long)pk2(v[j][2], v[j][3]) << 32); }
        if (MODE == 1 || MODE == 2) {
            float a[8];
#pragma unroll
            for (int k = 0; k < 8; ++k) a[k] = 0.f;
#pragma unroll
            for (int j = 0; j < 4; ++j)
#pragma unroll
                for (int q = 0; q < 4; ++q) { const int c = 4 * lane + 256 * j + q; const f32x4 w0 = *(const LAS f32x4*)(wl + c * 8), w1 = *(const LAS f32x4*)(wl + c * 8 + 4); const float y = v[j][q];
                    a[0] += y * w0[0]; a[1] += y * w0[1]; a[2] += y * w0[2]; a[3] += y * w0[3]; a[4] += y * w1[0]; a[5] += y * w1[1]; a[6] += y * w1[2]; a[7] += y * w1[3]; }
#pragma unroll
            for (int k = 0; k < 8; ++k) a[k] = wave_sum(a[k], lane);
            if (MODE == 1) {
                if (lane == 0) {
                    f32x4 o0 = {a[0] + b_i[0], a[1] + b_i[1], a[2] + b_i[2], a[3] + b_i[3]}, o1 = {a[4] + b_f[0], a[5] + b_f[1], a[6] + b_f[2], a[7] + b_f[3]};
                    *(f32x4*)(ifpre + (size_t)m * 8) = o0; *(f32x4*)(ifpre + (size_t)m * 8 + 4) = o1; }
            } else {
                int i1 = 0; float v1 = a[0];
#pragma unroll
                for (int k = 1; k < 8; ++k) if (a[k] > v1) { v1 = a[k]; i1 = k; }
                int i2 = -1; float v2 = -INFINITY;
#pragma unroll
                for (int k = 0; k < 8; ++k) if (k != i1 && a[k] > v2) { v2 = a[k]; i2 = k; }
                const float g1 = 1.0f / (1.0f + expf(v2 - v1)), g2 = 1.0f - g1;
                if (lane < 8) gsel[(size_t)m * 8 + lane] = (lane == i1) ? g1 : (lane == i2) ? g2 : 0.f;
                if (lane == 0) { *(int2*)((int*)(F.ws + WS_TOPI) + (size_t)m * 2) = make_int2(i1, i2); *(float2*)((float*)(F.ws + WS_TOPG) + (size_t)m * 2) = make_float2(g1, g2); }
            }
        }
    }
    if (MODE == 1 || MODE == 2) __syncthreads();
}

__device__ __forceinline__ void phase_prep(Frame& F, const Inputs& in, int l, int parts = 3) {
    PHASE_LOCALS();
    bf16* PROJ = (bf16*)(F.ws + WS_PROJ); float* kmean = (float*)(F.ws + WS_KMEAN); bf16* QKC = (bf16*)(F.ws + WS_QKC);
    const float* gq = in.p[I_GQ] + l * AHD; const float* gk = in.p[I_GK] + l * AHD;
    LAS float* kt = (LAS float*)F.lds; LAS float* part = kt + 256 * 65;
    if (parts & 1) for (int u = F.vcu; u < (M / 256) * AH; u += F.G) {
        const int pm = u >> 3, h = u & 7, row = tid >> 1, hf = tid & 1; const size_t grow = (size_t)pm * 256 + row;
#pragma unroll
        for (int which = 0; which < 2; ++which) {
            bf16* ptr = PROJ + grow * NPROJ + (which ? PC_K : PC_Q) + h * AHD + hf * 32; const float* gg = (which ? gk : gq) + hf * 32;
            bf16* optr = (parts & 4) ? (bf16*)(F.ws + WS_MIXED) + (grow & 255) * NPROJ + (which ? PC_K : PC_Q) + h * AHD + hf * 32 : ptr;
            float v[32]; float ss = 0.f;
#pragma unroll
            for (int i = 0; i < 4; ++i) { const v4u w = *(const v4u*)(ptr + 8 * i);
                v[8 * i + 0] = bflo(w.x); v[8 * i + 1] = bfhi(w.x); v[8 * i + 2] = bflo(w.y); v[8 * i + 3] = bfhi(w.y); v[8 * i + 4] = bflo(w.z); v[8 * i + 5] = bfhi(w.z); v[8 * i + 6] = bflo(w.w); v[8 * i + 7] = bfhi(w.w); }
#pragma unroll
            for (int i = 0; i < 32; ++i) ss += v[i] * v[i];
            ss += shx(ss, 1, lane);
            const float r = (1.0f / sqrtf(ss * (1.0f / AHD) + RMS_EPS)) * (which ? 1.0f : C2);
#pragma unroll
            for (int i = 0; i < 32; ++i) v[i] = v[i] * r * gg[i];
            if (which) {
#pragma unroll
                for (int i = 0; i < 32; ++i) kt[row * 65 + hf * 32 + i] = v[i]; }
#pragma unroll
            for (int i = 0; i < 4; ++i) { v4u o; o.x = pk2(v[8 * i], v[8 * i + 1]); o.y = pk2(v[8 * i + 2], v[8 * i + 3]); o.z = pk2(v[8 * i + 4], v[8 * i + 5]); o.w = pk2(v[8 * i + 6], v[8 * i + 7]); *(v4u*)(optr + 8 * i) = o; }
        }
        __syncthreads();
        { const int c = tid & 63, pt = tid >> 6; float s = 0.f;
            for (int i = 0; i < 32; ++i) s += kt[(pt * 32 + i) * 65 + c];
            part[pt * 64 + c] = s; }
        __syncthreads();
        if (tid < 64) { float tot = 0.f;
#pragma unroll
            for (int pt = 0; pt < 8; ++pt) tot += part[pt * 64 + tid];
            const int b = pm >> 4, n = pm & 15;
            ((parts & 4) ? (float*)(F.ws + WS_MIXED) + 4 * 1024 * 1024 : kmean)[(((size_t)(b * AH + h)) * ANB + n) * AHD + tid] = tot * (1.0f / ABLK); }
        __syncthreads();
    }
    if (parts & 2) {
        const float* cw = in.p[I_CONVW] + (size_t)l * 4 * 1024; const float* cb = in.p[I_CONVB] + (size_t)l * 1024;
        const int ch = tid & 127, c0 = ch * 8; const float sc = (c0 >= 512) ? 0.08838834764831845f : 1.0f;
        float w[4][8], bia[8];
#pragma unroll
        for (int j = 0; j < 4; ++j) { const f32x4 w0 = *(const f32x4*)(cw + j * 1024 + c0), w1 = *(const f32x4*)(cw + j * 1024 + c0 + 4);
            w[j][0] = w0[0]; w[j][1] = w0[1]; w[j][2] = w0[2]; w[j][3] = w0[3]; w[j][4] = w1[0]; w[j][5] = w1[1]; w[j][6] = w1[2]; w[j][7] = w1[3]; }
        { const f32x4 b0 = *(const f32x4*)(cb + c0), b1 = *(const f32x4*)(cb + c0 + 4); bia[0] = b0[0]; bia[1] = b0[1]; bia[2] = b0[2]; bia[3] = b0[3]; bia[4] = b1[0]; bia[5] = b1[1]; bia[6] = b1[2]; bia[7] = b1[3]; }
        for (int run = F.vcu * 4 + (tid >> 7); run < M / 16; run += F.G * 4) {
            const int r0 = run * 16, t0 = r0 & (SEQ - 1);
            v4u xin[19];
#pragma unroll
            for (int i = 0; i < 19; ++i) { xin[i] = (v4u){0u, 0u, 0u, 0u}; if (i >= 3 || t0 > 0) xin[i] = *(const v4u*)(PROJ + (size_t)(r0 - 3 + i) * NPROJ + PC_QKM + c0); }
#pragma unroll
            for (int i = 0; i < 16; ++i) { float a[8];
#pragma unroll
                for (int k = 0; k < 8; ++k) a[k] = bia[k];
#pragma unroll
                for (int j = 0; j < 4; ++j) { const v4u x = xin[i + j];
                    a[0] += w[j][0] * bflo(x.x); a[1] += w[j][1] * bfhi(x.x); a[2] += w[j][2] * bflo(x.y); a[3] += w[j][3] * bfhi(x.y); a[4] += w[j][4] * bflo(x.z); a[5] += w[j][5] * bfhi(x.z); a[6] += w[j][6] * bflo(x.w); a[7] += w[j][7] * bfhi(x.w); }
#pragma unroll
                for (int k = 0; k < 8; ++k) a[k] = a[k] * sigm(a[k]) * sc;
                v4u o; o.x = pk2(a[0], a[1]); o.y = pk2(a[2], a[3]); o.z = pk2(a[4], a[5]); o.w = pk2(a[6], a[7]);
                *(v4u*)(QKC + (size_t)(r0 + i) * 1024 + c0) = o; }
        }
    }
}

__device__ __forceinline__ float dot64(const bf16* kr, const float (&q)[64]) {
    float a = 0.f;
#pragma unroll
    for (int i = 0; i < 8; ++i) { const v4u w = *(const v4u*)(kr + 8 * i);
        a += q[8 * i] * bflo(w.x) + q[8 * i + 1] * bfhi(w.x) + q[8 * i + 2] * bflo(w.y) + q[8 * i + 3] * bfhi(w.y) + q[8 * i + 4] * bflo(w.z) + q[8 * i + 5] * bfhi(w.z) + q[8 * i + 6] * bflo(w.w) + q[8 * i + 7] * bfhi(w.w); }
    return a;
}
__device__ __forceinline__ void phase_attn_naive(Frame& F) {
    const bf16* PROJ = (const bf16*)(F.ws + WS_PROJ); const float* kmean = (const float*)(F.ws + WS_KMEAN); bf16* YA = (bf16*)(F.ws + WS_YA);
    LAS float* sc = (LAS float*)F.lds + F.wave * 1088; LAS float* qs = sc + 1024;
    const int gw = F.vcu * NWAVES + F.wave, NGW = F.G * NWAVES, lane = lane_now();
    for (int item = gw; item < BATCH * AH * SEQ; item += NGW) {
        const int q = item & (SEQ - 1), bh = item >> 12, b = bh >> 3, h = bh & 7, blk = q >> 8;
        const size_t rb = (size_t)b * SEQ;
        qs[lane] = bf2f(PROJ[(rb + q) * NPROJ + PC_Q + h * AHD + lane]);
        asm volatile("s_waitcnt lgkmcnt(0)" ::: "memory");
        float qr[64];
#pragma unroll
        for (int i = 0; i < 16; ++i) { const f32x4 t = *(const LAS f32x4*)(qs + 4 * i); qr[4 * i] = t[0]; qr[4 * i + 1] = t[1]; qr[4 * i + 2] = t[2]; qr[4 * i + 3] = t[3]; }
        float gv = -INFINITY;
        if (lane < blk) { const float* km = kmean + ((size_t)bh * ANB + lane) * AHD; float a = 0.f;
#pragma unroll
            for (int i = 0; i < 16; ++i) { const f32x4 t = *(const f32x4*)(km + 4 * i); a += qr[4 * i] * t[0] + qr[4 * i + 1] * t[1] + qr[4 * i + 2] * t[2] + qr[4 * i + 3] * t[3]; }
            gv = a; }
        unsigned selmask = 0u;
        for (int s = 0; s < 3 && s < blk; ++s) { const float mx = wave_max(gv, lane); const unsigned long long bal = __ballot(gv == mx && lane < blk); const int idx = __ffsll((long long)bal) - 1;
            selmask |= 1u << idx; if (lane == idx) gv = -INFINITY; }
        int slot = 0;
        for (int n = 0; n < blk; ++n) if ((selmask >> n) & 1u) {
#pragma unroll
            for (int jj = 0; jj < 4; ++jj) { const int key = n * ABLK + lane + 64 * jj; sc[slot * 256 + lane + 64 * jj] = dot64(PROJ + (rb + key) * NPROJ + PC_K + h * AHD, qr); }
            ++slot; }
#pragma unroll
        for (int jj = 0; jj < 4; ++jj) { const int key = blk * ABLK + lane + 64 * jj; const float a = dot64(PROJ + (rb + key) * NPROJ + PC_K + h * AHD, qr); sc[slot * 256 + lane + 64 * jj] = (key > q) ? -INFINITY : a; }
        const int ntot = (slot + 1) * 256;
        asm volatile("s_waitcnt lgkmcnt(0)" ::: "memory");
        float mx = -INFINITY; for (int i = lane; i < ntot; i += 64) mx = fmaxf(mx, sc[i]); mx = wave_max(mx, lane);
        float sum = 0.f; for (int i = lane; i < ntot; i += 64) { const float p = pg8::ex2(sc[i] - mx); sc[i] = p; sum += p; } sum = wave_sum(sum, lane);
        asm volatile("s_waitcnt lgkmcnt(0)" ::: "memory");
        float o = 0.f; slot = 0;
        for (int n = 0; n < blk; ++n) if ((selmask >> n) & 1u) { const bf16* vp = PROJ + (rb + n * ABLK) * NPROJ + PC_V + h * AHD + lane;
            for (int j = 0; j < 256; ++j) o += sc[slot * 256 + j] * bf2f(vp[(size_t)j * NPROJ]);
            ++slot; }
        { const bf16* vp = PROJ + (rb + blk * ABLK) * NPROJ + PC_V + h * AHD + lane; const int je = q - blk * ABLK;
            for (int j = 0; j <= je; ++j) o += sc[slot * 256 + j] * bf2f(vp[(size_t)j * NPROJ]); }
        YA[(rb + q) * 1024 + h * AHD + lane] = (bf16)f2bf(o / sum);
        asm volatile("s_waitcnt lgkmcnt(0)" ::: "memory");
    }
}

__device__ __forceinline__ void phase_mlstm_naive(Frame& F, const Inputs& in, int l) {
    if (blockIdx.x >= BATCH * MH) return;
    const bf16* PROJ = (const bf16*)(F.ws + WS_PROJ); const bf16* QKC = (const bf16*)(F.ws + WS_QKC); const float* ifpre = (const float*)(F.ws + WS_IFPRE); bf16* YB = (bf16*)(F.ws + WS_YB);
    const float* gh = in.p[I_GH] + l * MDK;
    const int bh = blockIdx.x, b = bh >> 2, h = bh & 3, tid = F.wave * 64 + lane_now(), lane = tid & 63, e = tid & 127, g = tid >> 7;
    LAS float* qs = (LAS float*)F.lds; LAS float* ks = qs + 16 * 128; LAS float* vs = ks + 16 * 128; LAS float* red = vs + 16 * 128; LAS float* redd = red + 16 * 4 * 128;
    LAS float* gi = redd + 64; LAS float* gf = gi + 16; LAS float* ms = gf + 16;
    float C[32], nn[32];
#pragma unroll
    for (int i = 0; i < 32; ++i) { C[i] = 0.f; nn[i] = 0.f; }
    float m = 0.f;
    for (int t0 = 0; t0 < SEQ; t0 += 16) {
        for (int i = tid; i < 16 * 128; i += NTHR) { const int st = i >> 7, d = i & 127; const size_t r = (size_t)b * SEQ + t0 + st;
            qs[i] = bf2f(QKC[r * 1024 + h * MDK + d]); ks[i] = bf2f(QKC[r * 1024 + 512 + h * MDK + d]); vs[i] = bf2f(PROJ[r * NPROJ + PC_VM + h * MDK + d]); }
        if (tid < 16) { const size_t r = (size_t)b * SEQ + t0 + tid; gi[tid] = ifpre[r * 8 + h]; const float x = ifpre[r * 8 + 4 + h]; gf[tid] = fminf(x, 0.f) - log1pf(expf(-fabsf(x))); }
        __syncthreads();
        for (int st = 0; st < 16; ++st) {
            const float li = gi[st], lf = gf[st], mn = fmaxf(lf + m, li), wC = expf(lf + m - mn), wS = expf(li - mn); m = mn;
            const float ve = vs[st * 128 + e]; float pn = 0.f, pd = 0.f;
#pragma unroll
            for (int i4 = 0; i4 < 8; ++i4) { const f32x4 k4 = *(const LAS f32x4*)(ks + st * 128 + 32 * g + 4 * i4), q4 = *(const LAS f32x4*)(qs + st * 128 + 32 * g + 4 * i4);
#pragma unroll
                for (int j = 0; j < 4; ++j) { const int i = 4 * i4 + j; const float kd = wS * k4[j]; C[i] = wC * C[i] + kd * ve; nn[i] = wC * nn[i] + kd; pn += q4[j] * C[i]; pd += q4[j] * nn[i]; } }
            red[(st * 4 + g) * 128 + e] = pn; if (e == 0) redd[st * 4 + g] = pd; if (tid == 0) ms[st] = mn;
        }
        __syncthreads();
#pragma unroll
        for (int s2 = 0; s2 < 2; ++s2) { const int st = 2 * F.wave + s2; const float den = (redd[st * 4] + redd[st * 4 + 1]) + (redd[st * 4 + 2] + redd[st * 4 + 3]);
            const float dn = 1.0f / fmaxf(fabsf(den), expf(-ms[st]));
            const float h0 = ((red[(st * 4) * 128 + lane] + red[(st * 4 + 1) * 128 + lane]) + (red[(st * 4 + 2) * 128 + lane] + red[(st * 4 + 3) * 128 + lane])) * dn;
            const float h1 = ((red[(st * 4) * 128 + 64 + lane] + red[(st * 4 + 1) * 128 + 64 + lane]) + (red[(st * 4 + 2) * 128 + 64 + lane] + red[(st * 4 + 3) * 128 + 64 + lane])) * dn;
            const float rr = 1.0f / sqrtf(wave_sum(h0 * h0 + h1 * h1, lane) * (1.0f / MDK) + RMS_EPS);
            const size_t r = (size_t)b * SEQ + t0 + st;
            const float o0 = sigm(bf2f(PROJ[r * NPROJ + PC_OM + h * MDK + lane])), o1 = sigm(bf2f(PROJ[r * NPROJ + PC_OM + h * MDK + 64 + lane]));
            YB[r * 1024 + h * MDK + lane] = (bf16)f2bf(h0 * rr * gh[lane] * o0); YB[r * 1024 + h * MDK + 64 + lane] = (bf16)f2bf(h1 * rr * gh[64 + lane] * o1); }
        __syncthreads();
    }
}
typedef short bf16x8s __attribute__((ext_vector_type(8)));
typedef short s16x4 __attribute__((ext_vector_type(4)));
typedef float f32x16 __attribute__((ext_vector_type(16)));
constexpr size_t ST_DCT = WS_ST, ST_DN = WS_ST + 16 * MiB, ST_NIN = ST_DN + 128 * 1024, ST_MLOC = ST_NIN + 128 * 1024, ST_BL = ST_MLOC + 4096, ST_MIN = ST_BL + 4096;
constexpr size_t ST_CINT = WS_MIXED;
constexpr int SM_OFF = LDSCTL_OFF + 1024;
__device__ __forceinline__ unsigned off_b(unsigned row, unsigned ch) { return 256u * row + 16u * (ch ^ (((row & 3u) << 2) | ((row >> 2) & 3u))); }
__device__ __forceinline__ s16x4 vtr(const LAS unsigned char* p) { return __builtin_bit_cast(s16x4, __builtin_amdgcn_ds_read_tr16_b64_v4i16((LAS s16x4*)p)); }
__device__ __forceinline__ int crow(int r, int hi) { return (r & 3) + 8 * (r >> 2) + 4 * hi; }
__device__ __forceinline__ float shu(float v, int o, int lane) { return __int_as_float(__builtin_amdgcn_ds_bpermute((lane - o) << 2, __float_as_int(v))); }
__device__ __forceinline__ float shl(float v, int src) { return __int_as_float(__builtin_amdgcn_ds_bpermute(src << 2, __float_as_int(v))); }
__device__ __forceinline__ float logsig(float x) { return fminf(x, 0.f) - log1pf(expf(-fabsf(x))); }
__device__ __forceinline__ bf16x8s tr_frag(const LAS unsigned char* img, int lane, int row0, int c) {
    const unsigned h = lane >> 5, blk = (lane >> 4) & 1, q = (lane & 15) >> 2, p = lane & 3;
    const s16x4 lo = vtr(img + off_b(row0 + 8 * h + q, 4 * c + 2 * blk + (p >> 1)) + 8 * (p & 1)), hi = vtr(img + off_b(row0 + 8 * h + 4 + q, 4 * c + 2 * blk + (p >> 1)) + 8 * (p & 1));
    return (bf16x8s){lo[0], lo[1], lo[2], lo[3], hi[0], hi[1], hi[2], hi[3]};
}
__device__ __forceinline__ bf16x8s tr_frag_perm(const LAS unsigned char* img, int lane, int row0, int c) {
    const unsigned h = lane >> 5, blk = (lane >> 4) & 1, q = (lane & 15) >> 2, p = lane & 3;
    const s16x4 lo = vtr(img + off_b(row0 + 4 * h + q, 4 * c + 2 * blk + (p >> 1)) + 8 * (p & 1)), hi = vtr(img + off_b(row0 + 8 + 4 * h + q, 4 * c + 2 * blk + (p >> 1)) + 8 * (p & 1));
    return (bf16x8s){lo[0], lo[1], lo[2], lo[3], hi[0], hi[1], hi[2], hi[3]};
}
__device__ __forceinline__ void chunk_gates(const float* ifpre, size_t row0, int h, int lane, float (&bc)[4], float (&ii)[4], float& bL) {
#pragma unroll
    for (int k = 0; k < 4; ++k) { const size_t r = row0 + 4 * lane + k; ii[k] = ifpre[r * 8 + h]; bc[k] = logsig(ifpre[r * 8 + 4 + h]); }
    bc[1] += bc[0]; bc[2] += bc[1]; bc[3] += bc[2];
    float inc = bc[3];
#pragma unroll
    for (int o = 1; o < 64; o <<= 1) { const float t = shu(inc, o, lane); if (lane >= o) inc += t; }
    const float excl = inc - bc[3];
#pragma unroll
    for (int k = 0; k < 4; ++k) bc[k] += excl;
    bL = shl(inc, 63);
}

__device__ __forceinline__ void phase_mlstm_m1(Frame& F, const Inputs& in, int l) {
    PHASE_LOCALS();
    const bf16* PROJ = (const bf16*)(F.ws + WS_PROJ); bf16* QKC = (bf16*)(F.ws + WS_QKC); const float* ifpre = (const float*)(F.ws + WS_IFPRE);
    float* dCT = (float*)(F.ws + ST_DCT); float* DN = (float*)(F.ws + ST_DN); float* MLOC = (float*)(F.ws + ST_MLOC); float* BL = (float*)(F.ws + ST_BL);
    LAS unsigned char* Kimg = F.lds; LAS unsigned char* Vimg = F.lds + 65536; LAS float* sw = (LAS float*)(F.lds + SM_OFF);
    const int r32 = lane & 31, hi = lane >> 5;
    for (int unit = F.vcu; unit < BATCH * MH * 16; unit += F.G) {
        const int bh = unit >> 4, c = unit & 15, b = bh >> 2, h = bh & 3; const size_t row0 = (size_t)b * SEQ + c * 256;
        { const float* cw = in.p[I_CONVW] + (size_t)l * 4 * 1024; const float* cb = in.p[I_CONVB] + (size_t)l * 1024;
          const int cc = tid & 31, c0 = (cc < 16 ? 0 : 512) + h * MDK + 8 * (cc & 15), run = tid >> 5; const float sc = (cc >= 16) ? 0.08838834764831845f : 1.0f;
          float w[4][8], bia[8];
#pragma unroll
          for (int j = 0; j < 4; ++j) { const f32x4 w0 = *(const f32x4*)(cw + j * 1024 + c0), w1 = *(const f32x4*)(cw + j * 1024 + c0 + 4);
              w[j][0] = w0[0]; w[j][1] = w0[1]; w[j][2] = w0[2]; w[j][3] = w0[3]; w[j][4] = w1[0]; w[j][5] = w1[1]; w[j][6] = w1[2]; w[j][7] = w1[3]; }
          { const f32x4 b0 = *(const f32x4*)(cb + c0), b1 = *(const f32x4*)(cb + c0 + 4); bia[0] = b0[0]; bia[1] = b0[1]; bia[2] = b0[2]; bia[3] = b0[3]; bia[4] = b1[0]; bia[5] = b1[1]; bia[6] = b1[2]; bia[7] = b1[3]; }
          const size_t r0 = row0 + 16 * run; const bool first = (c == 0 && run == 0);
          v4u xin[19];
#pragma unroll
          for (int i = 0; i < 19; ++i) { xin[i] = (v4u){0u, 0u, 0u, 0u}; if (i >= 3 || !first) xin[i] = *(const v4u*)(PROJ + (r0 - 3 + i) * NPROJ + PC_QKM + c0); }
#pragma unroll
          for (int i = 0; i < 16; ++i) { float a[8];
#pragma unroll
              for (int k = 0; k < 8; ++k) a[k] = bia[k];
#pragma unroll
              for (int j = 0; j < 4; ++j) { const v4u x = xin[i + j];
                  a[0] += w[j][0] * bflo(x.x); a[1] += w[j][1] * bfhi(x.x); a[2] += w[j][2] * bflo(x.y); a[3] += w[j][3] * bfhi(x.y); a[4] += w[j][4] * bflo(x.z); a[5] += w[j][5] * bfhi(x.z); a[6] += w[j][6] * bflo(x.w); a[7] += w[j][7] * bfhi(x.w); }
#pragma unroll
              for (int k = 0; k < 8; ++k) a[k] = a[k] * sigm(a[k]) * sc;
              v4u o; o.x = pk2(a[0], a[1]); o.y = pk2(a[2], a[3]); o.z = pk2(a[4], a[5]); o.w = pk2(a[6], a[7]);
              *(v4u*)(QKC + (r0 + i) * 1024 + c0) = o; } }
        if (F.wave == 0) {
            float bc[4], ii[4], bL; chunk_gates(ifpre, row0, h, lane, bc, ii, bL);
            float g[4]; float mx = -INFINITY;
#pragma unroll
            for (int k = 0; k < 4; ++k) { g[k] = bL - bc[k] + ii[k]; mx = fmaxf(mx, g[k]); }
            mx = wave_max(mx, lane);
#pragma unroll
            for (int k = 0; k < 4; ++k) sw[4 * lane + k] = pg8::ex2((g[k] - mx) * 1.4426950408889634f);
            if (lane == 0) { MLOC[unit] = mx; BL[unit] = bL; }
        }
        asm volatile("s_waitcnt vmcnt(0)" ::: "memory");
        __syncthreads();
        for (int i = tid; i < 4096; i += NTHR) { const int s = i >> 4, ch = i & 15; const float w = sw[s];
            const v4u kv = *(const v4u*)(QKC + (row0 + s) * 1024 + 512 + h * MDK + 8 * ch);
            v4u ko; ko.x = pk2(bflo(kv.x) * w, bfhi(kv.x) * w); ko.y = pk2(bflo(kv.y) * w, bfhi(kv.y) * w); ko.z = pk2(bflo(kv.z) * w, bfhi(kv.z) * w); ko.w = pk2(bflo(kv.w) * w, bfhi(kv.w) * w);
            *(LAS v4u*)(Kimg + off_b(s, ch)) = ko;
            *(LAS v4u*)(Vimg + off_b(s, ch)) = *(const v4u*)(PROJ + (row0 + s) * NPROJ + PC_VM + h * MDK + 8 * ch); }
        __syncthreads();
        const int dt = F.wave >> 1, c0 = 2 * (F.wave & 1);
        f32x16 acc0, acc1;
#pragma unroll
        for (int i = 0; i < 16; ++i) { acc0[i] = 0.f; acc1[i] = 0.f; }
#pragma unroll 4
        for (int ks = 0; ks < 16; ++ks) {
            const bf16x8s a = tr_frag(Kimg, lane, 16 * ks, dt), b0 = tr_frag(Vimg, lane, 16 * ks, c0), b1 = tr_frag(Vimg, lane, 16 * ks, c0 + 1);
            acc0 = __builtin_amdgcn_mfma_f32_32x32x16_bf16(a, b0, acc0, 0, 0, 0);
            acc1 = __builtin_amdgcn_mfma_f32_32x32x16_bf16(a, b1, acc1, 0, 0, 0);
        }
#pragma unroll
        for (int g = 0; g < 4; ++g) { const int d = 32 * dt + 8 * g + 4 * hi;
            *(f32x4*)(dCT + ((size_t)unit * 128 + 32 * c0 + r32) * 128 + d) = (f32x4){acc0[4 * g], acc0[4 * g + 1], acc0[4 * g + 2], acc0[4 * g + 3]};
            *(f32x4*)(dCT + ((size_t)unit * 128 + 32 * (c0 + 1) + r32) * 128 + d) = (f32x4){acc1[4 * g], acc1[4 * g + 1], acc1[4 * g + 2], acc1[4 * g + 3]}; }
        { const int d = tid & 127, part = tid >> 7; float s0 = 0.f, s1 = 0.f;
#pragma unroll 8
            for (int t = 0; t < 64; t += 2) { s0 += bf2f(*(const LAS bf16*)(Kimg + off_b(64 * part + t, d >> 3) + 2 * (d & 7))); s1 += bf2f(*(const LAS bf16*)(Kimg + off_b(64 * part + t + 1, d >> 3) + 2 * (d & 7))); }
            sw[256 + tid] = s0 + s1; }
        __syncthreads();
        if (tid < 128) DN[(size_t)unit * 128 + tid] = (sw[256 + tid] + sw[256 + 128 + tid]) + (sw[256 + 256 + tid] + sw[256 + 384 + tid]);
        __syncthreads();
    }
}

__device__ __forceinline__ void phase_mlstm_m2(Frame& F) {
    PHASE_LOCALS();
    const float* dCT = (const float*)(F.ws + ST_DCT); const float* DN = (const float*)(F.ws + ST_DN); const float* MLOC = (const float*)(F.ws + ST_MLOC); const float* BL = (const float*)(F.ws + ST_BL);
    bf16* CinT = (bf16*)(F.ws + ST_CINT); float* NIN = (float*)(F.ws + ST_NIN); float* MIN = (float*)(F.ws + ST_MIN);
    LAS float* al = (LAS float*)(F.lds + SM_OFF); LAS float* be = al + 16;
    for (int item = F.vcu; item < 256; item += F.G) {
        const int bh = item >> 4, sl = item & 15;
        if (tid == 0) { float m = 0.f;
            for (int c = 0; c < 16; ++c) { const int u = bh * 16 + c; const float bl = BL[u], ml = MLOC[u]; if (sl == 0) MIN[u] = m;
                const float mo = fmaxf(bl + m, ml); al[c] = expf(bl + m - mo); be[c] = expf(ml - mo); m = mo; } }
        __syncthreads();
        { const size_t idx = (size_t)sl * 1024 + 2 * tid; float s0 = 0.f, s1 = 0.f;
#pragma unroll
            for (int c = 0; c < 16; ++c) { const size_t u = (size_t)bh * 16 + c; const float2 dc = *(const float2*)(dCT + u * 16384 + idx);
                *(unsigned*)(CinT + u * 16384 + idx) = pk2(s0, s1); s0 = al[c] * s0 + be[c] * dc.x; s1 = al[c] * s1 + be[c] * dc.y; } }
        if (sl == 0 && tid < 128) { float s = 0.f;
#pragma unroll
            for (int c = 0; c < 16; ++c) { const size_t u = (size_t)bh * 16 + c; NIN[u * 128 + tid] = s; s = al[c] * s + be[c] * DN[u * 128 + tid]; } }
        __syncthreads();
    }
}

__device__ __forceinline__ void phase_mlstm_m3(Frame& F, const Inputs& in, int l, int reps = 1) {
    PHASE_LOCALS();
    const bf16* PROJ = (const bf16*)(F.ws + WS_PROJ); const bf16* QKC = (const bf16*)(F.ws + WS_QKC); const float* ifpre = (const float*)(F.ws + WS_IFPRE);
    const float* dCT = (const float*)(F.ws + ST_DCT); const float* DN = (const float*)(F.ws + ST_DN); const float* MLOC = (const float*)(F.ws + ST_MLOC); const float* BLV = (const float*)(F.ws + ST_BL); bf16* YB = (bf16*)(F.ws + WS_YB);
    const float* gh = in.p[I_GH] + l * MDK;
    LAS unsigned char* Vimg = F.lds; LAS unsigned char* Cimg = F.lds + 65536; LAS unsigned char* Kimg = F.lds + 65536;
    LAS float* us = (LAS float*)(F.lds + SM_OFF); LAS float* Mt = us + 256; LAS float* aw = Mt + 256; LAS float* em = aw + 256; LAS float* inv = em + 256; LAS float* nin_s = inv + 256; LAS float* coef = nin_s + 128;
    const int r32 = lane & 31, hi = lane >> 5, wave = F.wave;
    for (int unit = F.vcu; unit < reps * BATCH * MH * 16; unit += F.G) {
        const int unit_ = unit; { const int unit = unit_ & (BATCH * MH * 16 - 1);
        const int bh = unit >> 4, c = unit & 15, b = bh >> 2, h = bh & 3; const size_t row0 = (size_t)b * SEQ + c * 256;
        if (tid < 32) coef[tid] = (tid < 16) ? BLV[bh * 16 + tid] : MLOC[bh * 16 + tid - 16];
        for (int i = tid; i < 4096; i += NTHR) { const int s = i >> 4, ch = i & 15;
            *(LAS v4u*)(Vimg + off_b(s, ch)) = *(const v4u*)(PROJ + (row0 + s) * NPROJ + PC_VM + h * MDK + 8 * ch); }
        __syncthreads();
        if (tid == 0) { float mm = 0.f;
            for (int cc = 0; cc < c; ++cc) { const float bl = coef[cc], ml = coef[16 + cc], mo = fmaxf(bl + mm, ml); coef[cc] = pg8::ex2((bl + mm - mo) * 1.4426950408889634f); coef[16 + cc] = pg8::ex2((ml - mo) * 1.4426950408889634f); mm = mo; }
            coef[32] = mm; }
        __syncthreads();
        { float st[32];
#pragma unroll
            for (int i = 0; i < 32; ++i) st[i] = 0.f;
            f32x4 sa[8], sb[8], sc[8];
            const float* sbase = dCT + ((size_t)(bh * 16)) * 16384 + 32 * tid;
#define M3_LD(buf, cc_) do { const int ci_ = ((cc_) < 15) ? (cc_) : 15;   \
                const f32x4* src_ = (const f32x4*)(sbase + (size_t)ci_ * 16384); _Pragma("unroll") for (int i = 0; i < 8; ++i) buf[i] = src_[i]; __builtin_amdgcn_sched_barrier(0); } while (0)
#define M3_FM(buf, cc_) do { if ((cc_) < c) { const float al = coef[(cc_)], be = coef[16 + (cc_)]; \
                _Pragma("unroll") for (int i = 0; i < 8; ++i) { const f32x4 v = buf[i]; st[4 * i] = al * st[4 * i] + be * v[0]; st[4 * i + 1] = al * st[4 * i + 1] + be * v[1]; st[4 * i + 2] = al * st[4 * i + 2] + be * v[2]; st[4 * i + 3] = al * st[4 * i + 3] + be * v[3]; } } \
                __builtin_amdgcn_sched_barrier(0); } while (0)
            if (c > 0) { M3_LD(sa, 0); M3_LD(sb, 1);
                for (int cc = 0; cc < c; cc += 3) { M3_LD(sc, cc + 2); M3_FM(sa, cc); M3_LD(sa, cc + 3); M3_FM(sb, cc + 1); M3_LD(sb, cc + 4); M3_FM(sc, cc + 2); } }
#undef M3_LD
#undef M3_FM
            LAS unsigned char* dst = Cimg + (tid >> 2) * 272 + (tid & 3) * 64;
#pragma unroll
            for (int i = 0; i < 4; ++i) { v4u o; o.x = pk2(st[8 * i], st[8 * i + 1]); o.y = pk2(st[8 * i + 2], st[8 * i + 3]); o.z = pk2(st[8 * i + 4], st[8 * i + 5]); o.w = pk2(st[8 * i + 6], st[8 * i + 7]); *(LAS v4u*)(dst + 16 * i) = o; }
            if (tid < 128) { float dnv[16];
#pragma unroll
                for (int cc = 0; cc < 16; ++cc) dnv[cc] = DN[((size_t)(bh * 16 + cc)) * 128 + tid];
                float sn = 0.f;
#pragma unroll
                for (int cc = 0; cc < 16; ++cc) if (cc < c) sn = coef[cc] * sn + coef[16 + cc] * dnv[cc];
                nin_s[tid] = sn; } }
        if (wave == 0) {
            float bc[4], ii[4], bL; chunk_gates(ifpre, row0, h, lane, bc, ii, bL);
            float u[4], pm[4];
#pragma unroll
            for (int k = 0; k < 4; ++k) u[k] = ii[k] - bc[k];
            pm[0] = u[0]; pm[1] = fmaxf(pm[0], u[1]); pm[2] = fmaxf(pm[1], u[2]); pm[3] = fmaxf(pm[2], u[3]);
            float inc = pm[3];
#pragma unroll
            for (int o = 1; o < 64; o <<= 1) { const float t = shu(inc, o, lane); if (lane >= o) inc = fmaxf(inc, t); }
            float excl = shu(inc, 1, lane); if (lane == 0) excl = -INFINITY;
            const float m_in = coef[32];
#pragma unroll
            for (int k = 0; k < 4; ++k) { const float Mx = fmaxf(m_in, fmaxf(pm[k], excl)); const int s = 4 * lane + k; us[s] = u[k]; Mt[s] = Mx; aw[s] = pg8::ex2((m_in - Mx) * 1.4426950408889634f); em[s] = pg8::ex2(-(bc[k] + Mx) * 1.4426950408889634f); }
        }
        __syncthreads();
        const int t = 32 * wave + r32;
        bf16x8s qf[8];
#pragma unroll
        for (int ks = 0; ks < 8; ++ks) qf[ks] = *(const bf16x8s*)(QKC + (row0 + t) * 1024 + h * MDK + 16 * ks + 8 * hi);
        float qn = 0.f;
#pragma unroll
        for (int ks = 0; ks < 8; ++ks)
#pragma unroll
            for (int j = 0; j < 8; ++j) qn += bf2f((bf16)qf[ks][j]) * nin_s[16 * ks + 8 * hi + j];
        qn += shx(qn, 32, lane);
        f32x16 acc[4];
#pragma unroll
        for (int cc = 0; cc < 4; ++cc)
#pragma unroll
            for (int i = 0; i < 16; ++i) acc[cc][i] = 0.f;
#pragma unroll
        for (int cc = 0; cc < 4; ++cc)
#pragma unroll
            for (int ks = 0; ks < 8; ++ks) { const bf16x8s bq = *(const LAS bf16x8s*)(Cimg + (32 * cc + r32) * 272 + 2 * (16 * ks + 8 * hi));
                acc[cc] = __builtin_amdgcn_mfma_f32_32x32x16_bf16(qf[ks], bq, acc[cc], 0, 0, 0); }
#pragma unroll
        for (int rg = 0; rg < 16; ++rg) { const float a = aw[32 * wave + crow(rg, hi)];
#pragma unroll
            for (int cc = 0; cc < 4; ++cc) acc[cc][rg] *= a; }
        { v4u kst[8];
#pragma unroll
          for (int i = 0; i < 8; ++i) { const int idx = tid + NTHR * i, s_ = idx >> 4, ch = idx & 15; kst[i] = *(const v4u*)(QKC + (row0 + s_) * 1024 + 512 + h * MDK + 8 * ch); }
          __syncthreads();
#pragma unroll
          for (int i = 0; i < 8; ++i) { const int idx = tid + NTHR * i, s_ = idx >> 4, ch = idx & 15; *(LAS v4u*)(Kimg + off_b(s_, ch)) = kst[i]; }
          __syncthreads(); }
        const float Ml = Mt[t]; float den = 0.f;
        for (int j = 0; j <= wave; ++j) {
            f32x16 X;
#pragma unroll
            for (int i = 0; i < 16; ++i) X[i] = 0.f;
#pragma unroll
            for (int ks = 0; ks < 8; ++ks) { const bf16x8s ka = *(const LAS bf16x8s*)(Kimg + off_b(32 * j + r32, 2 * ks + hi));
                X = __builtin_amdgcn_mfma_f32_32x32x16_bf16(ka, qf[ks], X, 0, 0, 0); }
#pragma unroll
            for (int rg = 0; rg < 16; ++rg) { const int s = 32 * j + crow(rg, hi); float w = pg8::ex2((us[s] - Ml) * 1.4426950408889634f); if (s > t) w = 0.f;     const float pv = X[rg] * w; X[rg] = pv; den += pv; }
            v4u p0, p1;
            p0.x = pk2(X[0], X[1]); p0.y = pk2(X[2], X[3]); p0.z = pk2(X[4], X[5]); p0.w = pk2(X[6], X[7]);
            p1.x = pk2(X[8], X[9]); p1.y = pk2(X[10], X[11]); p1.z = pk2(X[12], X[13]); p1.w = pk2(X[14], X[15]);
            const bf16x8s pa0 = __builtin_bit_cast(bf16x8s, p0), pa1 = __builtin_bit_cast(bf16x8s, p1);
#pragma unroll
            for (int cc = 0; cc < 4; ++cc) {
                acc[cc] = __builtin_amdgcn_mfma_f32_32x32x16_bf16(pa0, tr_frag_perm(Vimg, lane, 32 * j, cc), acc[cc], 0, 0, 0);
                acc[cc] = __builtin_amdgcn_mfma_f32_32x32x16_bf16(pa1, tr_frag_perm(Vimg, lane, 32 * j + 16, cc), acc[cc], 0, 0, 0); }
        }
        den += shx(den, 32, lane);
        { const float dt = aw[t] * qn + den; inv[t] = 1.0f / fmaxf(fabsf(dt), em[t]); }
        asm volatile("s_waitcnt lgkmcnt(0)" ::: "memory");
        float rr[16];
#pragma unroll
        for (int rg = 0; rg < 16; ++rg) { const float f = inv[32 * wave + crow(rg, hi)]; float sq = 0.f;
#pragma unroll
            for (int cc = 0; cc < 4; ++cc) { acc[cc][rg] *= f; sq += acc[cc][rg] * acc[cc][rg]; }
#pragma unroll
            for (int o = 1; o < 32; o <<= 1) sq += shx(sq, o, lane);
            rr[rg] = 1.0f / sqrtf(sq * (1.0f / MDK) + RMS_EPS); }
#pragma unroll
        for (int cc = 0; cc < 4; ++cc) { const int e = 32 * cc + r32; const float ge = gh[e];
#pragma unroll
            for (int rg = 0; rg < 16; ++rg) { const size_t r = row0 + 32 * wave + crow(rg, hi);
                const float o = sigm(bf2f(PROJ[r * NPROJ + PC_OM + h * MDK + e]));
                YB[r * 1024 + h * MDK + e] = (bf16)f2bf(acc[cc][rg] * rr[rg] * ge * o); } }
        __syncthreads();
        }
    }
}
#include <hip/hip_bf16.h>
namespace attn_body {
using bf16=__hip_bfloat16;
using bf16x8=__attribute__((ext_vector_type(8)))short;
using s16x4=__attribute__((ext_vector_type(4)))short;
using f32x16=__attribute__((ext_vector_type(16)))float;
using u32x4=__attribute__((ext_vector_type(4)))unsigned;
using f32x4_t=__attribute__((ext_vector_type(4)))float;
constexpr int BATCH=4,NHEAD=8,SEQ=4096,D=64,DM=3584,DMO=1024;
constexpr float NEGBIG=-200.f;
constexpr int NW=8,QBLK=32,QB=QBLK*NW,KVBLK=64,NQB=SEQ/QB;
constexpr int ATTN_PITCH=DM, ATTN_UNIT_ROWS=QB;
__device__ __forceinline__ int crow(int r,int hi){return (r&3)+8*(r>>2)+4*hi;}
#define SBAR() __builtin_amdgcn_sched_barrier(0)
__device__ __forceinline__ void cmask(f32x16&p0,f32x16&p1,int jb,int qrel,int hi){
  const float NEG=-INFINITY; int kb=64*jb+4*hi;
  #pragma unroll
  for(int r=0;r<16;++r){int kv=kb+(r&3)+8*(r>>2); if(kv>qrel)p0[r]=NEG; if(kv+32>qrel)p1[r]=NEG;}
}

constexpr int NSLOT=3, SLOTB=8192;
constexpr int LDS_K=0, LDS_V=NSLOT*SLOTB, LDS_WS=2*NSLOT*SLOTB, LDS_OST=LDS_WS+NW*64*4, LDS_KMS=LDS_OST+NW*4096  , LDS_BYTES=LDS_KMS+4096;
constexpr float C2=0.125f*1.4426950408889634f;
__device__ __forceinline__ void glds16(const void*gsrc,unsigned lds_dst){unsigned keep;
  asm volatile("s_mov_b32 %0, m0\n\ts_mov_b32 m0, %2\n\ts_nop 0\n\tglobal_load_lds_dwordx4 %1, off\n\ts_mov_b32 m0, %0":"=&s"(keep):"v"(gsrc),"s"(lds_dst):"memory");}
__device__ __forceinline__ float max3f(float a,float b,float c){float r;asm("v_max3_f32 %0, %1, %2, %3":"=v"(r):"v"(a),"v"(b),"v"(c));return r;}
__device__ __forceinline__ float max2f(float a,float b){float r;asm("v_max_f32_e32 %0, %1, %2":"=v"(r):"v"(a),"v"(b));return r;}
__device__ __forceinline__ float fadd_s(float a,float b){float r;asm("v_add_f32_e32 %0, %1, %2":"=v"(r):"v"(a),"v"(b));return r;}
__device__ __forceinline__ float fsub_s(float a,float b){float r;asm("v_sub_f32_e32 %0, %1, %2":"=v"(r):"v"(a),"v"(b));return r;}
typedef float f32x2_t __attribute__((ext_vector_type(2))); typedef __bf16 bf16x2_t __attribute__((ext_vector_type(2)));
__device__ __forceinline__ unsigned cvtpk_s(float lo,float hi){f32x2_t v={lo,hi};bf16x2_t b=__builtin_convertvector(v,bf16x2_t);return __builtin_bit_cast(unsigned,b);}
#define WAIT_BAR(N) asm volatile("s_waitcnt vmcnt(" #N ") lgkmcnt(0)\n\ts_barrier":::"memory")

__device__ __forceinline__ void qkt(f32x16&p0,f32x16&p1,const char*Kslot,const bf16x8*qr,const f32x16&negm,int r32,int hi){
  const char*kb=Kslot+hi*1024+r32*16;
  #pragma unroll
  for(int d0=0;d0<4;++d0){
    const bf16x8 b0=*reinterpret_cast<const bf16x8*>(kb+d0*2048);
    const bf16x8 b1=*reinterpret_cast<const bf16x8*>(kb+d0*2048+512);
    if(d0==0){p0=__builtin_amdgcn_mfma_f32_32x32x16_bf16(b0,qr[0],negm,0,0,0);p1=__builtin_amdgcn_mfma_f32_32x32x16_bf16(b1,qr[0],negm,0,0,0);}
    else{p0=__builtin_amdgcn_mfma_f32_32x32x16_bf16(b0,qr[d0],p0,0,0,0);p1=__builtin_amdgcn_mfma_f32_32x32x16_bf16(b1,qr[d0],p1,0,0,0);}}
}
typedef __attribute__((address_space(3))) const char* lds_cptr;
typedef short v4i16_t __attribute__((ext_vector_type(4)));
__device__ __forceinline__ void kload8(bf16x8*kf,lds_cptr kp){
  kf[0]=*(const __attribute__((address_space(3))) bf16x8*)(kp);      kf[1]=*(const __attribute__((address_space(3))) bf16x8*)(kp+512);
  kf[2]=*(const __attribute__((address_space(3))) bf16x8*)(kp+2048); kf[3]=*(const __attribute__((address_space(3))) bf16x8*)(kp+2560);
  kf[4]=*(const __attribute__((address_space(3))) bf16x8*)(kp+4096); kf[5]=*(const __attribute__((address_space(3))) bf16x8*)(kp+4608);
  kf[6]=*(const __attribute__((address_space(3))) bf16x8*)(kp+6144); kf[7]=*(const __attribute__((address_space(3))) bf16x8*)(kp+6656);
}
__device__ __forceinline__ void kload2(bf16x8*kf,lds_cptr kp,int j){ kf[2*j]=*(const __attribute__((address_space(3))) bf16x8*)(kp+j*2048); kf[2*j+1]=*(const __attribute__((address_space(3))) bf16x8*)(kp+j*2048+512); }
__device__ __forceinline__ s16x4 vtr(lds_cptr p){ return __builtin_bit_cast(s16x4,__builtin_amdgcn_ds_read_tr16_b64_v4i16((__attribute__((address_space(3))) v4i16_t*)p)); }
__device__ __forceinline__ float rowmax(const f32x16&p0,const f32x16&p1){
  float a=max3f(p0[0],p0[1],p1[0]),b=max3f(p0[2],p0[3],p1[1]);a=max3f(a,p1[2],p1[3]);
  #pragma unroll
  for(int r=4;r<16;r+=4){a=max3f(a,p0[r],p0[r+1]);b=max3f(b,p0[r+2],p0[r+3]);a=max3f(a,p1[r],p1[r+1]);b=max3f(b,p1[r+2],p1[r+3]);}
  const float m=max2f(a,b);
  auto rr=__builtin_amdgcn_permlane32_swap(__float_as_uint(m),__float_as_uint(m),false,false);
  return max2f(__uint_as_float(rr[0]),__uint_as_float(rr[1]));
}
__device__ __forceinline__ void pv(f32x16*o,int vb,bf16x8 pa0,bf16x8 pa1,bf16x8 pa2,bf16x8 pa3){
  #pragma unroll
  for(int d0=0;d0<2;++d0){s16x4 lo[4],hi[4];
    #pragma unroll
    for(int ks=0;ks<4;++ks){
      asm volatile("ds_read_b64_tr_b16 %0,%1 offset:%c2":"=&v"(lo[ks]):"v"(vb),"i"(d0*4096+ks*1024):"memory");
      asm volatile("ds_read_b64_tr_b16 %0,%1 offset:%c2":"=&v"(hi[ks]):"v"(vb),"i"(d0*4096+ks*1024+512):"memory");}
    asm volatile("s_waitcnt lgkmcnt(0)":::"memory");SBAR();
    #define PK(k) (bf16x8){lo[k][0],lo[k][1],lo[k][2],lo[k][3],hi[k][0],hi[k][1],hi[k][2],hi[k][3]}
    o[d0]=__builtin_amdgcn_mfma_f32_32x32x16_bf16(pa0,PK(0),o[d0],0,0,0);
    o[d0]=__builtin_amdgcn_mfma_f32_32x32x16_bf16(pa1,PK(1),o[d0],0,0,0);
    o[d0]=__builtin_amdgcn_mfma_f32_32x32x16_bf16(pa2,PK(2),o[d0],0,0,0);
    o[d0]=__builtin_amdgcn_mfma_f32_32x32x16_bf16(pa3,PK(3),o[d0],0,0,0);
    #undef PK
  }
}

#ifndef ATTN_STORE16
#define ATTN_STORE16(p,v) (*(u32x4*)(p)=(v))
#endif
template<int THRL> __device__ __forceinline__ void attn_unit(int b,int h,int qb,const bf16*Q,const bf16*__restrict__ K,const bf16*__restrict__ V,bf16*O,const float*__restrict__ kmean,char*shm,int wave_in){
  int tid_; asm volatile("v_mbcnt_lo_u32_b32 %0, -1, 0\n\tv_mbcnt_hi_u32_b32 %0, -1, %0":"=v"(tid_)); tid_+=64*wave_in; const int tid=tid_,lane=tid&63,r32=lane&31,hi=lane>>5; const int wid=__builtin_amdgcn_readfirstlane(tid>>6);
  const long rowbase=(long)b*SEQ; const int q0=qb*QB;
  const bf16*Qw=Q+(rowbase+q0+wid*QBLK)*DM+h*D;
  const bf16*Kh=K+rowbase*DM+h*D,*Vh=V+rowbase*DM+h*D;
  const unsigned lds0=(unsigned)(uintptr_t)shm;
  float*wsf=(float*)(shm+LDS_WS)+wid*64;
  const bf16*ksrc=Kh+(long)lane*DM+wid*8;
  const bf16*vsrc=Vh+(long)(16*(wid&3)+(lane>>2))*DM+(wid>>2)*32+(lane&3)*8;
  const unsigned kdst=lds0+LDS_K+wid*1024, vdst=lds0+LDS_V+wid*1024;
  #define DMA_K(t,slot) glds16(ksrc+(long)(t)*KVBLK*DM,(unsigned)__builtin_amdgcn_readfirstlane(kdst+(slot)))
  #define DMA_V(t,slot) glds16(vsrc+(long)(t)*KVBLK*DM,(unsigned)__builtin_amdgcn_readfirstlane(vdst+(slot)))
  const int vb0=(int)(lds0+LDS_V)+((lane>>4)&1)*32+(lane&3)*8+(4*hi+((lane&15)>>2))*64;
  const char*Kbase=shm+LDS_K; bf16x8 kf[8];
  const lds_cptr shm3=(lds_cptr)shm; const lds_cptr kp0=shm3+LDS_K+hi*1024+r32*16; const lds_cptr vp0=shm3+LDS_V+((lane>>4)&1)*32+(lane&3)*8+(4*hi+((lane&15)>>2))*64;
  const int NT=(q0+QB)/KVBLK;
  DMA_K(0,0);DMA_V(0,0);DMA_K(1,SLOTB);
  bf16x8 qr[4];
  #pragma unroll
  for(int d0=0;d0<4;++d0)qr[d0]=*reinterpret_cast<const bf16x8*>(&Qw[(long)r32*DM+d0*16+hi*8]);

  unsigned selm=0u;
  if(qb>0){
    typedef __attribute__((address_space(3))) f32x4_t lds_f4;
    if(wid<4){ const int n_=tid>>4,d4_=(tid&15)*4; const f32x4_t s_=*reinterpret_cast<const f32x4_t*>(kmean+n_*128+d4_)+*reinterpret_cast<const f32x4_t*>(kmean+n_*128+64+d4_);
      *(lds_f4*)((lds_cptr)shm+LDS_KMS+(n_*64+d4_)*4)=s_; }
    asm volatile("s_waitcnt lgkmcnt(0)\n\ts_barrier":::"memory");
    float g[16];
    #pragma unroll
    for(int n=0;n<16;++n)g[n]=-INFINITY;
    #pragma unroll
    for(int n=0;n<15;++n) if(n<qb){
      const lds_cptr km=(lds_cptr)shm+LDS_KMS+(n*64+8*hi)*4; float a=0.f;
      #pragma unroll
      for(int d0=0;d0<4;++d0){ const f32x4_t k0=*(const lds_f4*)(km+64*d0),k1=*(const lds_f4*)(km+64*d0+16);
        #pragma unroll
        for(int j=0;j<4;++j){ a+=__uint_as_float((unsigned)(unsigned short)qr[d0][j]<<16)*k0[j]; a+=__uint_as_float((unsigned)(unsigned short)qr[d0][4+j]<<16)*k1[j]; } }
      auto rr=__builtin_amdgcn_permlane32_swap(__float_as_uint(a),__float_as_uint(a),false,false); g[n]=__uint_as_float(rr[0])+__uint_as_float(rr[1]);
    }
    #pragma unroll
    for(int s=0;s<3;++s) if(s<qb){ float best=-INFINITY; int bi=0;
      #pragma unroll
      for(int n=0;n<15;++n) if(g[n]>best){best=g[n];bi=n;}
      selm|=1u<<bi;
      #pragma unroll
      for(int n=0;n<15;++n) if(n==bi)g[n]=-INFINITY; }
  }
  selm|=1u<<qb;
  float mhat=0.f,l_reg=0.f;f32x16 o[2];f32x16 negm; { float z_=0.f; asm volatile("":"+v"(z_));
    _Pragma("unroll") for(int r_=0;r_<16;++r_){o[0][r_]=z_;o[1][r_]=z_;negm[r_]=z_;} } asm volatile("":"+v"(negm));
  const int qrel=wid*QBLK+r32;
  #define NEGSET(blk) do{ const float nv_=((selm>>(blk))&1u)?-mhat:NEGBIG; _Pragma("unroll") for(int r_=0;r_<16;++r_)negm[r_]=nv_; asm volatile("":"+v"(negm)); }while(0)
  NEGSET(0);
  #define CMASK(P0,P1,t) do{int jb_=(t)-(NT-4); if(jb_>=0)cmask(P0,P1,jb_,qrel,hi); }while(0)
  bool resc=false;
  #define START(P0,P1) do{ const float rm=rowmax(P0,P1); resc=false; \
    { const float dl=rm; mhat=fadd_s(mhat,dl); \
      _Pragma("unroll") for(int r=0;r<16;++r){P0[r]=fsub_s(P0[r],dl);P1[r]=fsub_s(P1[r],dl);} \
      NEGSET(0); } \
    _Pragma("unroll") for(int r=0;r<16;++r)P0[r]=__builtin_amdgcn_exp2f(P0[r]); }while(0)
  #define RESC() do{ if(resc){ asm volatile("s_waitcnt lgkmcnt(0)":::"memory"); \
      _Pragma("unroll") for(int d_=0;d_<2;++d_) _Pragma("unroll") for(int r=0;r<16;++r)o[d_][r]*=wsf[crow(r,hi)]; } }while(0)
  f32x16 pA0,pA1,pB0,pB1;
  int sl_prev=0,sl_cur=0,sl_next=SLOTB;
  #define ROT() do{sl_prev=sl_cur;sl_cur=sl_next;sl_next=(sl_next==(NSLOT-1)*SLOTB)?0:sl_next+SLOTB;}while(0)
  DMA_K(2,2*SLOTB);
  WAIT_BAR(3);
  qkt(pA0,pA1,Kbase,qr,negm,r32,hi);asm volatile("s_nop 15\n\ts_nop 7":"+v"(pA0),"+v"(pA1));CMASK(pA0,pA1,0);
  START(pA0,pA1);
  _Pragma("unroll") for(int r=0;r<16;++r)pA1[r]=__builtin_amdgcn_exp2f(pA1[r]);
  WAIT_BAR(0);
  DMA_K(3,0);DMA_V(1,SLOTB);
  ROT();
  kload8(kf,kp0+sl_cur);
  WAIT_BAR(2);
  s16x4 vlo[8],vhi[8]; u32x4 pw0,pw1,pw2,pw3;
  #define PKW(P,B) cvtpk_s(P[B],P[B+1])
  #define PAF(k) __builtin_bit_cast(bf16x8,pw##k)
  #define VFR(i) (bf16x8){vlo[i][0],vlo[i][1],vlo[i][2],vlo[i][3],vhi[i][0],vhi[i][1],vhi[i][2],vhi[i][3]}
  #define PIN(x) asm volatile("":"+v"(x))
  #define MX3(a,b,c) __builtin_fmaxf(__builtin_fmaxf((a),(b)),(c))
  #define GAPA(MF,A0,A1,A2,A3,W0,W1,PW) do{ MF; sacc+=A0; sacc+=A1; sacc+=A2; sacc+=A3; PIN(sacc); W0; W1; PIN(PW); SBAR(); }while(0)
  #define EX(v) __builtin_amdgcn_exp2f(v)
  #define GAPB(MF,X,B) do{ MF; X[B]=EX(X[B]); X[B+1]=EX(X[B+1]); X[B+2]=EX(X[B+2]); X[B+3]=EX(X[B+3]); PIN(X); SBAR(); }while(0)
  #define VRD(i) do{ vlo[i]=vtr(vp_+(((i)>>2)*4096+((i)&3)*1024)); vhi[i]=vtr(vp_+(((i)>>2)*4096+((i)&3)*1024+512)); }while(0)
  #define KRD(G,j) do{ if(G){ kload2(kf,kp0+sl_next,j); SBAR(); } }while(0)
  #define STEP(C0,C1,P0,P1,t,GK,GV,GL) do{ SBAR(); \
    const lds_cptr vp_=vp0+sl_prev; \
    VRD(0); SBAR(); float sacc=(P0[0]+P0[1]); \
    GAPA(C0=__builtin_amdgcn_mfma_f32_32x32x16_bf16(kf[0],qr[0],negm,0,0,0), P0[2],P0[3],P0[4],P0[5],     pw0[0]=PKW(P0,0), pw0[1]=PKW(P0,2), pw0); \
    VRD(4); SBAR(); GAPA(C1=__builtin_amdgcn_mfma_f32_32x32x16_bf16(kf[1],qr[0],negm,0,0,0), P0[6],P0[7],P0[8],P0[9],     pw0[2]=PKW(P0,4), pw0[3]=PKW(P0,6), pw0); \
    VRD(1); SBAR(); GAPA(C0=__builtin_amdgcn_mfma_f32_32x32x16_bf16(kf[2],qr[1],C0,0,0,0),   P0[10],P0[11],P0[12],P0[13], pw1[0]=PKW(P0,8), pw1[1]=PKW(P0,10), pw1); \
    VRD(5); SBAR(); GAPA(C1=__builtin_amdgcn_mfma_f32_32x32x16_bf16(kf[3],qr[1],C1,0,0,0),   P0[14],P0[15],P1[0],P1[1],   pw1[2]=PKW(P0,12),pw1[3]=PKW(P0,14), pw1); \
    VRD(2); SBAR(); GAPA(C0=__builtin_amdgcn_mfma_f32_32x32x16_bf16(kf[4],qr[2],C0,0,0,0),   P1[2],P1[3],P1[4],P1[5],     pw2[0]=PKW(P1,0), pw2[1]=PKW(P1,2), pw2); \
    VRD(6); SBAR(); GAPA(C1=__builtin_amdgcn_mfma_f32_32x32x16_bf16(kf[5],qr[2],C1,0,0,0),   P1[6],P1[7],P1[8],P1[9],     pw2[2]=PKW(P1,4), pw2[3]=PKW(P1,6), pw2); \
    VRD(3); SBAR(); GAPA(C0=__builtin_amdgcn_mfma_f32_32x32x16_bf16(kf[6],qr[3],C0,0,0,0),   P1[10],P1[11],P1[12],P1[13], pw3[0]=PKW(P1,8), pw3[1]=PKW(P1,10), pw3); \
    VRD(7); SBAR(); GAPA(C1=__builtin_amdgcn_mfma_f32_32x32x16_bf16(kf[7],qr[3],C1,0,0,0),   P1[14],P1[15],0.f,0.f,       pw3[2]=PKW(P1,12),pw3[3]=PKW(P1,14), pw3); \
    l_reg+=sacc; \
    if(GK){DMA_K((t)+3,sl_cur);} if(GV){DMA_V((t)+1,sl_next);} \
    CMASK(C0,C1,t); \
    { float a=MX3(C0[0],C0[1],C1[0]),b=MX3(C0[2],C0[3],C1[1]); a=MX3(a,C1[2],C1[3]); \
      _Pragma("unroll") for(int r=4;r<16;r+=4){a=MX3(a,C0[r],C0[r+1]);b=MX3(b,C0[r+2],C0[r+3]);a=MX3(a,C1[r],C1[r+1]);b=MX3(b,C1[r+2],C1[r+3]);} \
      float rm=__builtin_fmaxf(a,b); { auto rr=__builtin_amdgcn_permlane32_swap(__float_as_uint(rm),__float_as_uint(rm),false,false); rm=__builtin_fmaxf(__uint_as_float(rr[0]),__uint_as_float(rr[1])); } \
      resc=false; \
      if(__builtin_expect(__any(rm>(float)THRL),0)){ const float dl=__builtin_fmaxf(rm,0.f); mhat+=dl; \
        _Pragma("unroll") for(int r=0;r<16;++r){C0[r]-=dl;C1[r]-=dl;} \
        NEGSET((t)>>2); \
        const float f=__builtin_amdgcn_exp2f(-dl); l_reg*=f; if(hi==0)wsf[r32]=f; resc=true; } } \
    SBAR(); \
    GAPB(o[0]=__builtin_amdgcn_mfma_f32_32x32x16_bf16(PAF(0),VFR(0),o[0],0,0,0), C0,0); \
    GAPB(o[1]=__builtin_amdgcn_mfma_f32_32x32x16_bf16(PAF(0),VFR(4),o[1],0,0,0), C0,4); \
    KRD(GL,0); GAPB(o[0]=__builtin_amdgcn_mfma_f32_32x32x16_bf16(PAF(1),VFR(1),o[0],0,0,0), C0,8); \
    KRD(GL,1); GAPB(o[1]=__builtin_amdgcn_mfma_f32_32x32x16_bf16(PAF(1),VFR(5),o[1],0,0,0), C0,12); \
    KRD(GL,2); GAPB(o[0]=__builtin_amdgcn_mfma_f32_32x32x16_bf16(PAF(2),VFR(2),o[0],0,0,0), C1,0); \
    KRD(GL,3); GAPB(o[1]=__builtin_amdgcn_mfma_f32_32x32x16_bf16(PAF(2),VFR(6),o[1],0,0,0), C1,4); \
    GAPB(o[0]=__builtin_amdgcn_mfma_f32_32x32x16_bf16(PAF(3),VFR(3),o[0],0,0,0), C1,8); \
    GAPB(o[1]=__builtin_amdgcn_mfma_f32_32x32x16_bf16(PAF(3),VFR(7),o[1],0,0,0), C1,12); \
    }while(0)
  int t=1;
  #undef CMASK
  #define CMASK(P0,P1,t) do{}while(0)
  for(;t+5<NT;t+=2){
    STEP(pB0,pB1,pA0,pA1,t,true,true,true);     WAIT_BAR(2); RESC(); ROT();
    if(((t+1)&3)==0)NEGSET((t+1)>>2);
    STEP(pA0,pA1,pB0,pB1,t+1,true,true,true);   WAIT_BAR(2); RESC(); ROT();
  }
  #undef CMASK
  #define CMASK(P0,P1,t) do{int jb_=(t)-(NT-4); if(jb_>=0)cmask(P0,P1,jb_,qrel,hi); }while(0)
  #define ENDW(tt) do{ if((tt)+3<NT){WAIT_BAR(2);} else if((tt)+2<NT){WAIT_BAR(1);} else {WAIT_BAR(0);} }while(0)
  for(;t+1<NT;t+=2){
    STEP(pB0,pB1,pA0,pA1,t,(t+3<NT),(t+1<NT),(t+1<NT));       ENDW(t);   RESC(); ROT();
    if(((t+1)&3)==0)NEGSET((t+1)>>2);
    STEP(pA0,pA1,pB0,pB1,t+1,(t+4<NT),(t+2<NT),(t+2<NT));     ENDW(t+1); RESC(); ROT();
  }
  STEP(pB0,pB1,pA0,pA1,NT-1,false,false,false); RESC();
  { float sacc=pB0[0]+pB0[1]; _Pragma("unroll") for(int r=2;r<16;++r)sacc+=pB0[r]; _Pragma("unroll") for(int r=0;r<16;++r)sacc+=pB1[r]; l_reg+=sacc;
    pw0=(u32x4){PKW(pB0,0),PKW(pB0,2),PKW(pB0,4),PKW(pB0,6)};pw1=(u32x4){PKW(pB0,8),PKW(pB0,10),PKW(pB0,12),PKW(pB0,14)};pw2=(u32x4){PKW(pB1,0),PKW(pB1,2),PKW(pB1,4),PKW(pB1,6)};pw3=(u32x4){PKW(pB1,8),PKW(pB1,10),PKW(pB1,12),PKW(pB1,14)};
    SBAR(); pv(o,vb0+sl_cur,PAF(0),PAF(1),PAF(2),PAF(3)); }
  #undef PKW
  #undef PAF
  #undef VFR
  #undef PIN
  #undef MX3
  #undef GAPA
  #undef GAPB
  #undef EX
  #undef VRD
  #undef KRD
  #undef STEP
  #undef ENDW
  {auto rr=__builtin_amdgcn_permlane32_swap(__float_as_uint(l_reg),__float_as_uint(l_reg),false,false);l_reg=__uint_as_float(rr[0])+__uint_as_float(rr[1]);}
  if(hi==0)wsf[32+r32]=l_reg;asm volatile("s_waitcnt lgkmcnt(0)":::"memory");
  float rli[16];
  #pragma unroll
  for(int r=0;r<16;++r)rli[r]=__builtin_amdgcn_rcpf(wsf[32+crow(r,hi)]);
  bf16*Ow=O+(rowbase+q0+wid*QBLK)*DMO+h*D;
  { bf16*stg=(bf16*)(shm+LDS_OST)+wid*2048;
    #pragma unroll
    for(int r=0;r<16;++r){const int orow=crow(r,hi);
      #pragma unroll
      for(int d0=0;d0<2;++d0)stg[orow*64+d0*32+r32]=__float2bfloat16(o[d0][r]*rli[r]);}
    asm volatile("s_waitcnt lgkmcnt(0)":::"memory");
    #pragma unroll
    for(int i=0;i<4;++i){const int row=i*8+(lane>>3),ch=lane&7; const u32x4 v=*(const u32x4*)(stg+row*64+ch*8); ATTN_STORE16(Ow+(long)row*DMO+ch*8,v);} }
  asm volatile("s_waitcnt lgkmcnt(0)\n\ts_barrier":::"memory");
  #undef DMA_K
  #undef DMA_V
  #undef CMASK
  #undef NEGSET
  #undef START
  #undef RESC
  #undef ROT
}
constexpr int ATTN_LDS_BYTES=LDS_BYTES;
struct AttnTensors { const bf16* Q; const bf16* K; const bf16* V; bf16* O; const float* kmean; };
struct AttnUnit { int bh; int qb; };
struct StaticOrder {
  int vcu,G;
  __device__ __forceinline__ explicit StaticOrder(int grid,int block):vcu((grid%8==0)?(block%8)*(grid/8)+block/8:block),G(grid){}
  __device__ __forceinline__ bool next(int i,AttnUnit&u)const{ const int idx=(i>>1)*G+vcu; if(idx>=BATCH*NHEAD*8)return false; const int s=idx&7; u.bh=idx>>3; u.qb=(i&1)?15-s:s; return true; }
  __device__ __forceinline__ void a_ready(const AttnUnit&)const{}
  __device__ __forceinline__ void done(const AttnUnit&)const{}
};
template<class Sched,int THRL=8> __device__ __forceinline__ void attn_phase(char*lds,const AttnTensors&T,const Sched&S,int wave_in){
  AttnUnit u;
  for(int i=0;S.next(i,u);++i){ S.a_ready(u); attn_unit<THRL>(u.bh/NHEAD,u.bh%NHEAD,u.qb,T.Q,T.K,T.V,T.O,T.kmean+(size_t)u.bh*16*128,lds,wave_in); S.done(u); }
}
#undef SBAR
#undef WAIT_BAR
}
__device__ __forceinline__ void phase_moe_route(Frame& F) {
    PHASE_LOCALS();
    if ((int)blockIdx.x >= 4 * (M / 256)) return;
    const int j = blockIdx.x >> 2, quarter = blockIdx.x & 3;
    const int* TOPI = (const int*)(F.ws + WS_TOPI); int* DEST = (int*)(F.ws + WS_DEST); int* ROWTOK = (int*)(F.ws + WS_ROWTOK); int* TILEE = (int*)(F.ws + WS_TILEE); int* NTILES = (int*)(F.ws + WS_NTILES);
    LAS int* cnt = (LAS int*)F.lds; LAS int* tot = cnt + 64 * 8; LAS int* basej = tot + 8; LAS int* pstart = basej + 8; LAS int* wcnt = pstart + 16; LAS int* dsts = wcnt + 32;
    for (int i = tid; i < 64 * 8; i += NTHR) cnt[i] = 0;
    __syncthreads();
    for (int m0 = tid; m0 < M; m0 += 8 * NTHR) { int2 e[8];
#pragma unroll
        for (int k = 0; k < 8; ++k) e[k] = *(const int2*)(TOPI + (size_t)(m0 + k * NTHR) * 2);
#pragma unroll
        for (int k = 0; k < 8; ++k) { const int m = m0 + k * NTHR; __hip_atomic_fetch_add(cnt + (m >> 8) * 8 + e[k].x, 1, __ATOMIC_RELAXED, __HIP_MEMORY_SCOPE_WORKGROUP); __hip_atomic_fetch_add(cnt + (m >> 8) * 8 + e[k].y, 1, __ATOMIC_RELAXED, __HIP_MEMORY_SCOPE_WORKGROUP); } }
    __syncthreads();
    if (tid < 8) { int s = 0, bj = 0; for (int jj = 0; jj < 64; ++jj) { if (jj == j) bj = s; s += cnt[jj * 8 + tid]; } tot[tid] = s; basej[tid] = bj; }
    __syncthreads();
    if (tid == 0) { int ps = 0; for (int e = 0; e < 8; ++e) { pstart[e] = ps; ps += (tot[e] + 255) & ~255; } pstart[8] = ps; }
    __syncthreads();
    const int m = 256 * j + tid; int e1 = -1, e2 = -1, rk1 = 0, rk2 = 0;
    if (tid < 256) { const int2 e = *(const int2*)(TOPI + (size_t)m * 2); e1 = e.x; e2 = e.y; }
    if (tid < 256) {
#pragma unroll
        for (int e = 0; e < 8; ++e) { const bool has = (e1 == e) || (e2 == e); const unsigned long long mask = __ballot(has); const int rk = __popcll(mask & ((1ull << lane) - 1ull));
            if (e1 == e) rk1 = rk; if (e2 == e) rk2 = rk; if (lane == 0) wcnt[F.wave * 8 + e] = __popcll(mask); }
    }
    __syncthreads();
    if (tid < 256) {
        int o1 = 0, o2 = 0;
        for (int w = 0; w < F.wave; ++w) { o1 += wcnt[w * 8 + e1]; o2 += wcnt[w * 8 + e2]; }
        const int d1 = pstart[e1] + basej[e1] + o1 + rk1, d2 = pstart[e2] + basej[e2] + o2 + rk2;
        if (quarter == 0) *(int2*)(DEST + (size_t)m * 2) = make_int2(d1, d2);
        dsts[2 * tid] = d1; dsts[2 * tid + 1] = d2;
    }
    __syncthreads();
    { const bf16* __restrict__ HB = (const bf16*)(F.ws + WS_HB); bf16* __restrict__ XG = (bf16*)(F.ws + WS_XG);
      for (int i0 = quarter * 64 * 128 + tid; i0 < (quarter + 1) * 64 * 128; i0 += 8 * NTHR) { v4u val[8];
#pragma unroll
          for (int k = 0; k < 8; ++k) { const int i = i0 + k * NTHR; val[k] = *(const v4u*)(HB + (size_t)(256 * j + (i >> 7)) * D + 8 * (i & 127)); }
#pragma unroll
          for (int k = 0; k < 8; ++k) { const int i = i0 + k * NTHR, t = i >> 7; const v4u w = val[k];
#define C8_(v) __builtin_amdgcn_fmed3f((v), -448.0f, 448.0f)
              int a_ = __builtin_amdgcn_cvt_pk_fp8_f32(C8_(bflo(w.x)), C8_(bfhi(w.x)), 0, false); a_ = __builtin_amdgcn_cvt_pk_fp8_f32(C8_(bflo(w.y)), C8_(bfhi(w.y)), a_, true);
              int b_ = __builtin_amdgcn_cvt_pk_fp8_f32(C8_(bflo(w.z)), C8_(bfhi(w.z)), 0, false); b_ = __builtin_amdgcn_cvt_pk_fp8_f32(C8_(bflo(w.w)), C8_(bfhi(w.w)), b_, true);
#undef C8_
              uint2 o8; o8.x = (unsigned)a_; o8.y = (unsigned)b_;
              *(uint2*)((unsigned char*)XG + (size_t)dsts[2 * t] * D + 8 * (i & 127)) = o8; *(uint2*)((unsigned char*)XG + (size_t)dsts[2 * t + 1] * D + 8 * (i & 127)) = o8; } } }
    if (j == 0 && quarter == 0) {
        const int nt = pstart[8] >> 8;
        for (int i = tid; i < nt; i += NTHR) { int e = 0; for (int k = 1; k < 8; ++k) if (256 * i >= pstart[k]) e = k; TILEE[i] = e; }
        if (tid == 0) NTILES[0] = nt;
    }
    __syncthreads();
}
__device__ __forceinline__ int moe_ntiles(Frame& F) { return __builtin_amdgcn_readfirstlane((int)__hip_atomic_load((const unsigned*)(F.ws + WS_NTILES), RLX_AGENT)); }
__device__ __forceinline__ void phase_moe_gather(Frame& F) {
    PHASE_LOCALS();
    const int nrows = moe_ntiles(F) * 256; const int* __restrict__ ROWTOK = (const int*)(F.ws + WS_ROWTOK); const bf16* __restrict__ HB = (const bf16*)(F.ws + WS_HB); bf16* __restrict__ XG = (bf16*)(F.ws + WS_XG);
    const int total = nrows * 128, stride = F.G * NTHR;
    for (int idx0 = F.vcu * NTHR + tid; idx0 < total; idx0 += 8 * stride) {
        int tok[8]; v4u val[8];
#pragma unroll
        for (int k = 0; k < 8; ++k) { const int idx = idx0 + k * stride; tok[k] = (idx < total) ? ROWTOK[idx >> 7] : 0; }
#pragma unroll
        for (int k = 0; k < 8; ++k) { const int idx = idx0 + k * stride; val[k] = *(const v4u*)(HB + (size_t)tok[k] * D + 8 * (idx & 127)); }
#pragma unroll
        for (int k = 0; k < 8; ++k) { const int idx = idx0 + k * stride; if (idx < total) *(v4u*)(XG + (size_t)(idx >> 7) * D + 8 * (idx & 127)) = val[k]; }
    }
}
constexpr float W2_F8SCALE = 64.0f, GH_F8SCALE = 4.0f;
constexpr float W13_F8SCALE = 32.0f;
constexpr int CW_Q = 2048, CW_DONE = 3072;
constexpr int QN_E13 = 2 * (16 * 14), QN_E2 = 56 * 4;
constexpr int QN0 = NEXP * (QN_E13 + QN_E2), QN3 = (NTILES_T - P0_URGENT) + P_CHUNKS;
__device__ __forceinline__ void conv_item(Frame& F, const Inputs& in, int q, int it, int lane) {
    if (q == 3) { if (it < NTILES_T - P0_URGENT) p0_tile(F, in, P0_URGENT + it, lane); else p_chunk(F, in, it - (NTILES_T - P0_URGENT), F.wave * 64 + lane); return; }
    unsigned char* W13 = F.ws + WS_WE; unsigned char* W2 = W13 + (size_t)NEXP * 2 * DFFE * D;
    const int per = QN_E13 + QN_E2, e = it / per; int r = it % per;
    bool found = false; TrJob jb;
    jb.W = nullptr; jb.ld = 0; jb.K = 64; jb.N = 256; jb.WT = nullptr; jb.rowstep = 128; jb.row_off = 0; jb.gk = nullptr; jb.nrows = 32;
    bf16* W13e = (bf16*)(W13 + (size_t)e * 2 * DFFE * D);
    TTJOBG(in.p[I_WE1] + (size_t)e * D * DFFE, DFFE, D, DFFE, W13e, 256, 0, nullptr)
    TTJOBG(in.p[I_WE3] + (size_t)e * D * DFFE, DFFE, D, DFFE, W13e, 256, 128, nullptr)
    const bool is13 = found;
    TTJOBG(in.p[I_WE2] + (size_t)e * DFFE * D, D, DFFE, D, (bf16*)(W2 + (size_t)e * D * DFFE), 128, 0, nullptr)
    if (found) tr_tile(jb.W, jb.ld, jb.K, jb.N / 256, jb.WT, jb.rowstep, jb.row_off, (LAS float*)(F.lds + RING_OFF), r, F.wave, lane, jb.gk, false, is13 ? W13_F8SCALE : W2_F8SCALE);
}
struct TileJob0 { const float* W; unsigned char* WT; int ld, K, rowstep, row_off, k0, n0; float sc; };
__device__ __forceinline__ TileJob0 tile_job0(Frame& F, const Inputs& in, int it) {
    unsigned char* W13 = F.ws + WS_WE; unsigned char* W2 = W13 + (size_t)NEXP * 2 * DFFE * D;
    const int per = QN_E13 + QN_E2, e = it / per, r = it % per; TileJob0 j;
    if (r < QN_E13) { const int h3 = (r >= QN_E13 / 2) ? 1 : 0, rr = r - h3 * (QN_E13 / 2);
        j.W = in.p[h3 ? I_WE3 : I_WE1] + (size_t)e * D * DFFE; j.ld = DFFE; j.K = D; j.WT = W13 + (size_t)e * 2 * DFFE * D; j.rowstep = 256; j.row_off = 128 * h3; j.k0 = 64 * (rr / 14); j.n0 = 256 * (rr % 14); j.sc = W13_F8SCALE; }
    else { const int rr = r - QN_E13; j.W = in.p[I_WE2] + (size_t)e * DFFE * D; j.ld = D; j.K = DFFE; j.WT = W2 + (size_t)e * D * DFFE; j.rowstep = 128; j.row_off = 0; j.k0 = 64 * (rr / 4); j.n0 = 256 * (rr % 4); j.sc = W2_F8SCALE; }
    return j;
}
__device__ __forceinline__ void conv_queue0(Frame& F, const Inputs& in, int nitems, int stop_site, unsigned n_long) {
    PHASE_LOCALS();
    gu32* head = F.ctl + CW_Q; gu32* done = F.ctl + CW_DONE + 64 * (stop_site < 0 ? 0 : stop_site);
    volatile LAS unsigned* slot = F.MISC + 16; LAS float* scr = (LAS float*)(F.lds + RING_OFF); const int wave = F.wave;
#define Q0_TAKE() do { if (tid == 0) { unsigned b_ = 0xffffffffu; if (!(stop_site >= 0 && __hip_atomic_load(done, RLX_AGENT) >= n_long)) b_ = __hip_atomic_fetch_add(head, 1u, RLX_AGENT); slot[0] = b_; } } while (0)
#define Q0_LOAD(J, V) do { _Pragma("unroll") for (int i = 0; i < 8; ++i) V[i] = *(const f32x4*)(J.W + (size_t)(J.k0 + wave + 8 * i) * J.ld + J.n0 + 4 * lane); } while (0)
    Q0_TAKE();
    __syncthreads();
    unsigned base = slot[0];
    __syncthreads();
    if (base >= (unsigned)nitems) return;
    TileJob0 a = tile_job0(F, in, (int)base); f32x4 v[8], vn[8];
    Q0_LOAD(a, v);
    for (;;) {
        Q0_TAKE();
#pragma unroll
        for (int i = 0; i < 8; ++i) { LAS float* d = scr + (wave + 8 * i) * 257 + 4 * lane; d[0] = v[i][0]; d[1] = v[i][1]; d[2] = v[i][2]; d[3] = v[i][3]; }
        __syncthreads();
        base = slot[0];
        const bool more = base < (unsigned)nitems; TileJob0 b = a;
        if (more) { b = tile_job0(F, in, (int)base); Q0_LOAD(b, vn); }
        { const int c = tid & 7;
#pragma unroll
          for (int jj = 0; jj < 4; ++jj) { const int n = (tid >> 3) + 64 * jj; const LAS float* p = scr + (8 * c) * 257 + n; const float sc = a.sc;
              const int nn = a.n0 + n, drow = (nn >> 7) * a.rowstep + (nn & 127) + a.row_off;
              int a_ = __builtin_amdgcn_cvt_pk_fp8_f32(p[0] * sc, p[257] * sc, 0, false); a_ = __builtin_amdgcn_cvt_pk_fp8_f32(p[2 * 257] * sc, p[3 * 257] * sc, a_, true);
              int b_ = __builtin_amdgcn_cvt_pk_fp8_f32(p[4 * 257] * sc, p[5 * 257] * sc, 0, false); b_ = __builtin_amdgcn_cvt_pk_fp8_f32(p[6 * 257] * sc, p[7 * 257] * sc, b_, true);
              uint2 o8; o8.x = (unsigned)a_; o8.y = (unsigned)b_; *(uint2*)(a.WT + (size_t)drow * a.K + a.k0 + 8 * c) = o8; } }
        __syncthreads();
        if (!more) break;
        a = b;
#pragma unroll
        for (int i = 0; i < 8; ++i) v[i] = vn[i];
    }
#undef Q0_TAKE
#undef Q0_LOAD
}
__device__ __forceinline__ void conv_queue(Frame& F, const Inputs& in, int q, int nitems, int stop_site, unsigned n_long) {
    if (q == 0) { conv_queue0(F, in, nitems, stop_site, n_long); return; }
    PHASE_LOCALS();
    gu32* head = F.ctl + CW_Q + 64 * q; gu32* done = F.ctl + CW_DONE + 64 * (stop_site < 0 ? 0 : stop_site);
    volatile LAS unsigned* slot = F.MISC + 16;
    for (;;) {
        if (tid == 0) { unsigned base = 0xffffffffu;
            if (!(stop_site >= 0 && __hip_atomic_load(done, RLX_AGENT) >= n_long)) base = __hip_atomic_fetch_add(head, 1u, RLX_AGENT);
            slot[0] = base; }
        __syncthreads();
        const unsigned base = slot[0];
        __syncthreads();
        if (base >= (unsigned)nitems) break;
        conv_item(F, in, q, (int)base, lane);
    }
}
__device__ __forceinline__ void conv_fill_tail(Frame& F, const Inputs& in, int q, int nitems, int site, int mine, int maxc, int nlong) {
    if (nlong >= F.G) return;
    if (mine == maxc) { if (F.wave == 0 && lane_now() == 0) __hip_atomic_fetch_add(F.ctl + CW_DONE + 64 * site, 1u, RLX_AGENT); }
    else conv_queue(F, in, q, nitems, site, (unsigned)nlong);
}
__device__ __forceinline__ void conv_fill_all(Frame& F, const Inputs& in, int q, int nitems, int site) {
    __syncthreads();
    if (F.wave == 0 && lane_now() == 0) __hip_atomic_fetch_add(F.ctl + CW_DONE + 64 * site, 1u, RLX_AGENT);
    conv_queue(F, in, q, nitems, site, (unsigned)F.G);
}
__device__ __forceinline__ void conv_fill_tail_rr(Frame& F, const Inputs& in, int q, int nitems, int site, int nunits, int c) {
    const int maxu = (nunits + F.G - 1) / F.G, n_long = nunits - (maxu - 1) * F.G;
    conv_fill_tail(F, in, q, nitems, site, c < n_long ? maxu : maxu - 1, maxu, n_long);
}
__device__ __forceinline__ const LAS unsigned* moe_tile_table(Frame& F, int ntr) {
    LAS unsigned* tab = (LAS unsigned*)(F.lds + SM_OFF); const int tid = F.wave * 64 + lane_now();
    __syncthreads();
    if (tid < ntr) tab[tid] = __hip_atomic_load((const unsigned*)(F.ws + WS_TILEE) + tid, RLX_AGENT);
    __syncthreads();
    return tab;
}
namespace pg8 {
struct MoeOrder {
    static constexpr bool SEGMENTED = true;
    const PG8_LAS unsigned* tile_e; int ntr, nct, bpe, G, c;
    __device__ __forceinline__ bool next(int i, Unit& u) const {
        const int T = ntr * nct; long p;
        if (SEGMENTED && G % 8 == 0) { const int per = G / 8, x = c % 8, s = c / 8, seg = (T + 7) / 8; const long q = (long)i * per + s; if (q >= seg) return false; p = (long)x * seg + q; }
        else p = (long)i * G + c;
        if (p >= T) return false;
        u.pm = (int)(p / nct); u.pn = (int)(p % nct);
        const int e = __builtin_amdgcn_readfirstlane((int)tile_e[u.pm]);
        u.pb = e * bpe + u.pn; return true;
    }
    __device__ __forceinline__ int count_of(int cc) const { const int T = ntr * nct;
        if (SEGMENTED && G % 8 == 0) { const int per = G / 8, x = cc % 8, s = cc / 8, seg = (T + 7) / 8; int sx = T - x * seg; sx = sx < 0 ? 0 : (sx > seg ? seg : sx); return s < sx ? (sx - s + per - 1) / per : 0; }
        return cc < T ? (T - cc + G - 1) / G : 0; }
    __device__ __forceinline__ void tails(int& mine, int& maxc, int& nlong) const { mine = count_of(c); const int T = ntr * nct;
        if (!(SEGMENTED && G % 8 == 0)) { maxc = (T + G - 1) / G; nlong = T - (maxc - 1) * G; return; }
        const int per = G / 8, seg = (T + 7) / 8; maxc = (seg + per - 1) / per; nlong = 0;
        for (int x = 0; x < 8; ++x) { int sx = T - x * seg; sx = sx < 0 ? 0 : (sx > seg ? seg : sx); int k = sx - (maxc - 1) * per; k = k < 0 ? 0 : (k > per ? per : k); nlong += k; } }
    __device__ __forceinline__ void a_ready(const Unit&) const {}
    __device__ __forceinline__ void done(const Unit&) const {}
};
template <bool ACCUM> struct EpiY {
    static constexpr bool PERM = true, AFTER_DRAIN = false, MIDK = false; typedef NoPre::Pre Pre; __device__ __forceinline__ Pre prefetch(const Unit&, int, int) const { return Pre{}; }
    bf16_t* Y; int ldc; float osc;
    __device__ __forceinline__ void operator()(const f32x4 (&acc)[2][2][4][2], const Unit& u, int wr, int wc, int fr, int fq, const Pre&) const {
        const int row0 = u.pm * BM + wr * 64 + fr, col0 = u.pn * BM + wc * 32 + 8 * fq;
#pragma unroll
        for (int ai = 0; ai < 2; ++ai)
#pragma unroll
            for (int m = 0; m < 4; ++m) { bf16_t* rowp = Y + (size_t)(row0 + ai * HALF + m * 16) * ldc + col0;
#pragma unroll
                for (int bj = 0; bj < 2; ++bj) { f32x4 v0 = acc[ai][bj][m][0] * osc, v1 = acc[ai][bj][m][1] * osc;
                    if (ACCUM) { const u32x4 y = *(const u32x4*)(rowp + bj * HALF);
                        v0 += (f32x4){bflo(y.x), bfhi(y.x), bflo(y.y), bfhi(y.y)}; v1 += (f32x4){bflo(y.z), bfhi(y.z), bflo(y.w), bfhi(y.w)}; }
                    u32x4 w; w.x = cvt_pk_bf16(v0[0], v0[1]); w.y = cvt_pk_bf16(v0[2], v0[3]); w.z = cvt_pk_bf16(v1[0], v1[1]); w.w = cvt_pk_bf16(v1[2], v1[3]);
                    *(u32x4*)(rowp + bj * HALF) = w; } }
    }
};
}
struct Args { Inputs in; float* out; unsigned char* ws; int ph_lo, ph_hi, li, pad; };
#ifndef MLSTM_NAIVE
#define MLSTM_NAIVE 0
#endif
#ifndef ATTN_NAIVE
#define ATTN_NAIVE 0
#endif
#ifndef MOE_NAIVE
#define MOE_NAIVE 0
#endif
#ifndef MK_PER_PHASE
#define MK_PER_PHASE 0
#endif
constexpr int MAX_LAUNCH = 64;

__global__ void __launch_bounds__(NTHR, 2) mega_fwd(Args args) {
    extern __shared__ __attribute__((aligned(16))) unsigned char lds[];
    Frame F;
    F.lds = (LAS unsigned char*)lds;
    F.MISC = (volatile LAS unsigned*)(F.lds + MISC_OFF);
    F.wave = __builtin_amdgcn_readfirstlane((int)(threadIdx.x >> 6));
    F.G = gridDim.x; { const int bx = blockIdx.x; F.vcu = (F.G % 8 == 0) ? (bx % 8) * (F.G / 8) + bx / 8 : bx; }
    F.ws = args.ws; F.ctl = (gu32*)(args.ws + WS_CTL);
    const Inputs& in = args.in;
    for (int u = threadIdx.x; u < (LDS_BYTES - LDSCTL_OFF) / 4; u += NTHR) ((LAS unsigned*)(F.lds + LDSCTL_OFF))[u] = 0u;
    __syncthreads();
    XcdBarrier bar = xcd_barrier_post((unsigned*)(F.ctl + CW_BAR) + args.li * XCD_BAR_WORDS, F.MISC + 8, F.wave);
    const int lo = args.ph_lo, hi = args.ph_hi;
    int ph = 0;
__attribute__((unused)) auto phq = [](int p) { asm volatile("" : "+s"(p)); return p; };
#define RUN() (lo <= phq(ph) && phq(ph) < hi)
#define SEAM() do { if (lo <= phq(ph) && phq(ph) + 1 < hi) xcd_barrier(bar); ++ph; } while (0)
    auto wsp = [&]() { unsigned char* p_ = args.ws; asm volatile("" : "+s"(p_)); return p_; };
#define HB ((bf16*)(wsp() + WS_HB))
#define PROJ ((bf16*)(wsp() + WS_PROJ))
#define YA ((bf16*)(wsp() + WS_YA))
#define YB ((bf16*)(wsp() + WS_YB))
#define MIXED ((bf16*)(wsp() + WS_MIXED))
#define TMP ((bf16*)(wsp() + WS_TMP))
#define GH ((bf16*)(wsp() + WS_GH))
#define PP ((bf16*)(wsp() + WS_PP))
#define IFPRE ((float*)(wsp() + WS_IFPRE))
#define GSEL ((float*)(wsp() + WS_GSEL))
#define XB ((bf16*)(wsp() + WS_XB))
#define XB2 ((bf16*)(wsp() + WS_QKC))
#define SSACC ((pg8::ssq_t*)((unsigned*)(wsp() + WS_CTL) + CW_SS))
    float* const X = args.out;


#ifndef SK_P0
        if (RUN()) p0_prologue(F, in);
#endif

    SEAM();
    { constexpr int l = 0;
        const float* xs = (l == 0) ? in.p[I_X] : X;
        if (RUN()) {
            const bf16* A_ = (l == 0) ? XB : XB2; const bf16* W_ = (const bf16*)(F.ws + WS_WIN) + (size_t)l * NPROJX * D; const pg8::ssq_t* ss_ = (l == 0) ? (const pg8::ssq_t*)(F.ws + WS_SS0) : (const pg8::ssq_t*)(SSACC + 2 * M);
            { pg8::Gemm g{A_, W_, M, 1024, D}; pg8::StaticOrder S; S.init(M, 1024, F.G, (int)blockIdx.x);
              pg8::EpiQK E{PROJ, (unsigned)NPROJ, ss_, in.p[I_GQ] + l * AHD, in.p[I_GK] + l * AHD, (float*)(wsp() + WS_KMEAN), C2};
              pg8::gemm_phase<pg8::EpiQK, pg8::StaticOrder, true, true>(F.lds + RING_OFF, g, S, E, F.wave); }
            { pg8::Gemm g{A_, W_ + (size_t)1024 * D, M, NPROJX - 1024, D}; pg8::StaticOrder S; S.init(M, NPROJX - 1024, F.G, (int)blockIdx.x);
              pg8::EpiProj E{PROJ, NPROJ, PC_GA / 256, ss_, NPROJX / 256 - 1, IFPRE, in.p[I_BI] + l * MH, in.p[I_BF] + l * MH, (bf16*)(wsp() + WS_GT), 4};
              pg8::gemm_phase<pg8::EpiProj, pg8::StaticOrder, true, true>(F.lds + RING_OFF, g, S, E, F.wave);
              if (l == 0) conv_fill_tail_rr(F, in, 3, QN3, 0, (M / 256) * ((NPROJX - 1024) / 256), (int)blockIdx.x);
              else conv_fill_tail_rr(F, in, 0, QN0, 2, (M / 256) * ((NPROJX - 1024) / 256), (int)blockIdx.x); }
        }
        SEAM();
        if (RUN()) {
#if !MLSTM_NAIVE
            phase_mlstm_m1(F, in, l);
#endif
#if ATTN_NAIVE
            phase_attn_naive(F);
#else
            { const attn_body::AttnTensors AT{(const attn_body::bf16*)(PROJ + PC_Q), (const attn_body::bf16*)(PROJ + PC_K), (const attn_body::bf16*)(PROJ + PC_V), (attn_body::bf16*)YA, (const float*)(F.ws + WS_KMEAN)};
              const attn_body::StaticOrder S((int)F.G, (int)blockIdx.x);
              attn_body::attn_phase<attn_body::StaticOrder>((char*)lds + RING_OFF, AT, S, F.wave); }
#endif
        }

        SEAM();

#if MLSTM_NAIVE
        if (RUN()) phase_mlstm_naive(F, in, l);
        SEAM();
#else
        if (RUN()) { phase_mlstm_m3(F, in, l);
            if (l == 0) { conv_queue(F, in, 3, QN3, -1, 0u); conv_fill_all(F, in, 0, QN0, 5); } else conv_fill_all(F, in, 0, QN0, 4); }
        SEAM();
#endif


        if (RUN()) { pg8::Gemm g{YA, (const bf16*)(F.ws + WS_WOA) + (size_t)l * D * D, M, D, D}; pg8::StaticOrder S; S.init(M, D, F.G, (int)blockIdx.x);
            pg8::EpiMerge E{(const bf16*)(wsp() + WS_GT), MIXED, D};
            pg8::gemm_phase<pg8::EpiMerge, pg8::StaticOrder, true, true>(F.lds + RING_OFF, g, S, E, F.wave); }
        SEAM();
        if (RUN()) { pg8::Gemm g{MIXED, (const bf16*)(F.ws + WS_WOUT) + (size_t)l * D * D, M, D, D}; pg8::StaticOrder S; S.init(M, D, F.G, (int)blockIdx.x);
            pg8::EpiResid E{xs, X, D, nullptr, 0, (l == 0) ? XB : nullptr, (l == 0) ? SSACC : nullptr};
            pg8::gemm_phase<pg8::EpiResid, pg8::StaticOrder, true, true>(F.lds + RING_OFF, g, S, E, F.wave); }
        SEAM();
        if (l == 0) {
            if (RUN()) { pg8::Gemm g{XB, (const bf16*)(F.ws + WS_WD13), M, 2 * DFF, D}; pg8::StaticOrder S; S.init(M, 2 * DFF, F.G, (int)blockIdx.x);
                pg8::EpiSwiglu E{GH, DFF, SSACC, 1.0f, 0.f};
                pg8::gemm_phase<pg8::EpiSwiglu, pg8::StaticOrder, true, true>(F.lds + RING_OFF, g, S, E, F.wave);
                conv_fill_tail_rr(F, in, 0, QN0, 1, (M / 256) * (2 * DFF / 256), (int)blockIdx.x); }
            SEAM();
            if (RUN()) { pg8::Gemm g{GH, (const bf16*)(F.ws + WS_WD2), M, D, DFF}; pg8::StaticOrder S; S.init(M, D, F.G, (int)blockIdx.x);
                pg8::EpiResid E{X, X, D, nullptr, 0, XB, SSACC + M};
                pg8::gemm_phase<pg8::EpiResid, pg8::StaticOrder, true, true>(F.lds + RING_OFF, g, S, E, F.wave); }
            SEAM();
        } else {
            if (RUN()) phase_norm<2>(F, X, in.p[I_GFFN] + l * D, HB, in.p[I_WR], NEXP, nullptr, nullptr, nullptr, GSEL);
            SEAM();
#if MOE_NAIVE
            for (int e = 0; e < NEXP; ++e) {

#ifndef SK_CONVE
        if (RUN()) p_conv_expert(F, in, e);
#endif

                SEAM();
                if (RUN()) { pg8::Gemm g{HB, (const bf16*)(F.ws + WS_WE), M, 2 * DFFE, D}; pg8::StaticOrder S; S.init(M, 2 * DFFE, F.G, (int)blockIdx.x);
                    pg8::EpiSwiglu E{GH, DFFE, nullptr, 1.0f, 0.f};
                    pg8::gemm_phase<pg8::EpiSwiglu, pg8::StaticOrder, true, true>(F.lds + RING_OFF, g, S, E, F.wave); }
                SEAM();
                if (RUN()) { pg8::Gemm g{GH, (const bf16*)(F.ws + WS_WE) + (size_t)2 * DFFE * D, M, D, DFFE}; pg8::StaticOrder S; S.init(M, D, F.G, (int)blockIdx.x);
                    pg8::EpiResid E{X, X, D, GSEL + e, NEXP, nullptr, nullptr};
                    pg8::gemm_phase<pg8::EpiResid, pg8::StaticOrder, true, true>(F.lds + RING_OFF, g, S, E, F.wave); }
                SEAM();
            }
#else
            if (RUN()) { phase_moe_route(F); conv_queue(F, in, 0, QN0, -1, 0u); }
            SEAM();
            if (RUN()) { pg8::Gemm g{(const bf16*)(F.ws + WS_XG), (const bf16*)(F.ws + WS_WE), MOE_MAXROWS, 2 * DFFE, D / 2};
                const int ntr_ = moe_ntiles(F); pg8::MoeOrder S{moe_tile_table(F, ntr_), ntr_, 2 * DFFE / 256, 2 * DFFE / 256, F.G, (int)blockIdx.x};
                pg8::EpiSwiglu E{(bf16*)(F.ws + WS_GHH), DFFE, nullptr, 1.0f / W13_F8SCALE, GH_F8SCALE};
                pg8::gemm_phase<pg8::EpiSwiglu, pg8::MoeOrder, true, true, true>(F.lds + RING_OFF, g, S, E, F.wave); }
            SEAM();
            if (RUN()) { pg8::Gemm g{(const bf16*)(F.ws + WS_GHH), (const bf16*)(F.ws + WS_WE + (size_t)NEXP * 2 * DFFE * D), MOE_MAXROWS, D, DFFE / 2};
                const int ntr_ = moe_ntiles(F); pg8::MoeOrder S{moe_tile_table(F, ntr_), ntr_, D / 256, D / 256, F.G, (int)blockIdx.x};
                pg8::EpiY<false> E{(bf16*)(F.ws + WS_Y), D, 1.0f / (W2_F8SCALE * GH_F8SCALE)}; pg8::gemm_phase<pg8::EpiY<false>, pg8::MoeOrder, true, true, true>(F.lds + RING_OFF, g, S, E, F.wave); }
            SEAM();
#endif
        }
        if (l == 1) {
            if (RUN()) { if (!MOE_NAIVE) phase_norm<3>(F, X, in.p[I_GPLE] + l * D, HB, nullptr, 0, nullptr, nullptr, nullptr, nullptr);
                else phase_norm<0>(F, X, in.p[I_GPLE] + l * D, HB, nullptr, 0, nullptr, nullptr, nullptr, nullptr); }
            SEAM();
        }
        if (RUN()) {
            { pg8::Gemm g{(const bf16*)(F.ws + WS_PB) + (size_t)l * M * PLE, (const bf16*)(F.ws + WS_WPP) + (size_t)l * D * PLE, M, D, PLE}; pg8::StaticOrder S; S.init(M, D, F.G, (int)blockIdx.x);
              pg8::EpiF32 E{PP, D};
              pg8::gemm_phase<pg8::EpiF32, pg8::StaticOrder, true, true>(F.lds + RING_OFF, g, S, E, F.wave); }
            if constexpr (l == 0) { pg8::Gemm g{XB, (const bf16*)(F.ws + WS_WPG), M, D, D}; pg8::StaticOrder S; S.init(M, D, F.G, (int)blockIdx.x);
              pg8::EpiPle2 E{PP, X, D, (const pg8::ssq_t*)(SSACC + M), XB2, SSACC + 2 * M, 1.0f};
              pg8::gemm_phase<pg8::EpiPle2, pg8::StaticOrder, true, true>(F.lds + RING_OFF, g, S, E, F.wave); }
            else { pg8::Gemm g{HB, (const bf16*)(F.ws + WS_WPG) + (size_t)l * D * D, M, D, D / 2}; pg8::StaticOrder S; S.init(M, D, F.G, (int)blockIdx.x);
              pg8::EpiPle2 E{PP, X, D, nullptr, nullptr, nullptr, 1.0f / (WPG_F8SCALE * HB_F8SCALE)};
              pg8::gemm_phase<pg8::EpiPle2, pg8::StaticOrder, true, true, true>(F.lds + RING_OFF, g, S, E, F.wave); }
        }
        SEAM();
    }
    { constexpr int l = 1;
        const float* xs = (l == 0) ? in.p[I_X] : X;
        if (RUN()) {
            const bf16* A_ = (l == 0) ? XB : XB2; const bf16* W_ = (const bf16*)(F.ws + WS_WIN) + (size_t)l * NPROJX * D; const pg8::ssq_t* ss_ = (l == 0) ? (const pg8::ssq_t*)(F.ws + WS_SS0) : (const pg8::ssq_t*)(SSACC + 2 * M);
            { pg8::Gemm g{A_, W_, M, 1024, D}; pg8::StaticOrder S; S.init(M, 1024, F.G, (int)blockIdx.x);
              pg8::EpiQK E{PROJ, (unsigned)NPROJ, ss_, in.p[I_GQ] + l * AHD, in.p[I_GK] + l * AHD, (float*)(wsp() + WS_KMEAN), C2};
              pg8::gemm_phase<pg8::EpiQK, pg8::StaticOrder, true, true>(F.lds + RING_OFF, g, S, E, F.wave); }
            { pg8::Gemm g{A_, W_ + (size_t)1024 * D, M, NPROJX - 1024, D}; pg8::StaticOrder S; S.init(M, NPROJX - 1024, F.G, (int)blockIdx.x);
              pg8::EpiProj E{PROJ, NPROJ, PC_GA / 256, ss_, NPROJX / 256 - 1, IFPRE, in.p[I_BI] + l * MH, in.p[I_BF] + l * MH, (bf16*)(wsp() + WS_GT), 4};
              pg8::gemm_phase<pg8::EpiProj, pg8::StaticOrder, true, true>(F.lds + RING_OFF, g, S, E, F.wave);
              if (l == 0) conv_fill_tail_rr(F, in, 3, QN3, 0, (M / 256) * ((NPROJX - 1024) / 256), (int)blockIdx.x);
              else conv_fill_tail_rr(F, in, 0, QN0, 2, (M / 256) * ((NPROJX - 1024) / 256), (int)blockIdx.x); }
        }
        SEAM();
        if (RUN()) {
#if !MLSTM_NAIVE
            phase_mlstm_m1(F, in, l);
#endif
#if ATTN_NAIVE
            phase_attn_naive(F);
#else
            { const attn_body::AttnTensors AT{(const attn_body::bf16*)(PROJ + PC_Q), (const attn_body::bf16*)(PROJ + PC_K), (const attn_body::bf16*)(PROJ + PC_V), (attn_body::bf16*)YA, (const float*)(F.ws + WS_KMEAN)};
              const attn_body::StaticOrder S((int)F.G, (int)blockIdx.x);
              attn_body::attn_phase<attn_body::StaticOrder>((char*)lds + RING_OFF, AT, S, F.wave); }
#endif
        }

        SEAM();

#if MLSTM_NAIVE
        if (RUN()) phase_mlstm_naive(F, in, l);
        SEAM();
#else
        if (RUN()) { phase_mlstm_m3(F, in, l);
            if (l == 0) { conv_queue(F, in, 3, QN3, -1, 0u); conv_fill_all(F, in, 0, QN0, 5); } else conv_fill_all(F, in, 0, QN0, 4); }
        SEAM();
#endif


        if (RUN()) { pg8::Gemm g{YA, (const bf16*)(F.ws + WS_WOA) + (size_t)l * D * D, M, D, D}; pg8::StaticOrder S; S.init(M, D, F.G, (int)blockIdx.x);
            pg8::EpiMerge E{(const bf16*)(wsp() + WS_GT), MIXED, D};
            pg8::gemm_phase<pg8::EpiMerge, pg8::StaticOrder, true, true>(F.lds + RING_OFF, g, S, E, F.wave); }
        SEAM();
        if (RUN()) { pg8::Gemm g{MIXED, (const bf16*)(F.ws + WS_WOUT) + (size_t)l * D * D, M, D, D}; pg8::StaticOrder S; S.init(M, D, F.G, (int)blockIdx.x);
            pg8::EpiResid E{xs, X, D, nullptr, 0, (l == 0) ? XB : nullptr, (l == 0) ? SSACC : nullptr};
            pg8::gemm_phase<pg8::EpiResid, pg8::StaticOrder, true, true>(F.lds + RING_OFF, g, S, E, F.wave); }
        SEAM();
        if (l == 0) {
            if (RUN()) { pg8::Gemm g{XB, (const bf16*)(F.ws + WS_WD13), M, 2 * DFF, D}; pg8::StaticOrder S; S.init(M, 2 * DFF, F.G, (int)blockIdx.x);
                pg8::EpiSwiglu E{GH, DFF, SSACC, 1.0f, 0.f};
                pg8::gemm_phase<pg8::EpiSwiglu, pg8::StaticOrder, true, true>(F.lds + RING_OFF, g, S, E, F.wave);
                conv_fill_tail_rr(F, in, 0, QN0, 1, (M / 256) * (2 * DFF / 256), (int)blockIdx.x); }
            SEAM();
            if (RUN()) { pg8::Gemm g{GH, (const bf16*)(F.ws + WS_WD2), M, D, DFF}; pg8::StaticOrder S; S.init(M, D, F.G, (int)blockIdx.x);
                pg8::EpiResid E{X, X, D, nullptr, 0, XB, SSACC + M};
                pg8::gemm_phase<pg8::EpiResid, pg8::StaticOrder, true, true>(F.lds + RING_OFF, g, S, E, F.wave); }
            SEAM();
        } else {
            if (RUN()) phase_norm<2>(F, X, in.p[I_GFFN] + l * D, HB, in.p[I_WR], NEXP, nullptr, nullptr, nullptr, GSEL);
            SEAM();
#if MOE_NAIVE
            for (int e = 0; e < NEXP; ++e) {

#ifndef SK_CONVE
        if (RUN()) p_conv_expert(F, in, e);
#endif

                SEAM();
                if (RUN()) { pg8::Gemm g{HB, (const bf16*)(F.ws + WS_WE), M, 2 * DFFE, D}; pg8::StaticOrder S; S.init(M, 2 * DFFE, F.G, (int)blockIdx.x);
                    pg8::EpiSwiglu E{GH, DFFE, nullptr, 1.0f, 0.f};
                    pg8::gemm_phase<pg8::EpiSwiglu, pg8::StaticOrder, true, true>(F.lds + RING_OFF, g, S, E, F.wave); }
                SEAM();
                if (RUN()) { pg8::Gemm g{GH, (const bf16*)(F.ws + WS_WE) + (size_t)2 * DFFE * D, M, D, DFFE}; pg8::StaticOrder S; S.init(M, D, F.G, (int)blockIdx.x);
                    pg8::EpiResid E{X, X, D, GSEL + e, NEXP, nullptr, nullptr};
                    pg8::gemm_phase<pg8::EpiResid, pg8::StaticOrder, true, true>(F.lds + RING_OFF, g, S, E, F.wave); }
                SEAM();
            }
#else
            if (RUN()) { phase_moe_route(F); conv_queue(F, in, 0, QN0, -1, 0u); }
            SEAM();
            if (RUN()) { pg8::Gemm g{(const bf16*)(F.ws + WS_XG), (const bf16*)(F.ws + WS_WE), MOE_MAXROWS, 2 * DFFE, D / 2};
                const int ntr_ = moe_ntiles(F); pg8::MoeOrder S{moe_tile_table(F, ntr_), ntr_, 2 * DFFE / 256, 2 * DFFE / 256, F.G, (int)blockIdx.x};
                pg8::EpiSwiglu E{(bf16*)(F.ws + WS_GHH), DFFE, nullptr, 1.0f / W13_F8SCALE, GH_F8SCALE};
                pg8::gemm_phase<pg8::EpiSwiglu, pg8::MoeOrder, true, true, true>(F.lds + RING_OFF, g, S, E, F.wave); }
            SEAM();
            if (RUN()) { pg8::Gemm g{(const bf16*)(F.ws + WS_GHH), (const bf16*)(F.ws + WS_WE + (size_t)NEXP * 2 * DFFE * D), MOE_MAXROWS, D, DFFE / 2};
                const int ntr_ = moe_ntiles(F); pg8::MoeOrder S{moe_tile_table(F, ntr_), ntr_, D / 256, D / 256, F.G, (int)blockIdx.x};
                pg8::EpiY<false> E{(bf16*)(F.ws + WS_Y), D, 1.0f / (W2_F8SCALE * GH_F8SCALE)}; pg8::gemm_phase<pg8::EpiY<false>, pg8::MoeOrder, true, true, true>(F.lds + RING_OFF, g, S, E, F.wave); }
            SEAM();
#endif
        }
        if (l == 1) {
            if (RUN()) { if (!MOE_NAIVE) phase_norm<3>(F, X, in.p[I_GPLE] + l * D, HB, nullptr, 0, nullptr, nullptr, nullptr, nullptr);
                else phase_norm<0>(F, X, in.p[I_GPLE] + l * D, HB, nullptr, 0, nullptr, nullptr, nullptr, nullptr); }
            SEAM();
        }
        if (RUN()) {
            { pg8::Gemm g{(const bf16*)(F.ws + WS_PB) + (size_t)l * M * PLE, (const bf16*)(F.ws + WS_WPP) + (size_t)l * D * PLE, M, D, PLE}; pg8::StaticOrder S; S.init(M, D, F.G, (int)blockIdx.x);
              pg8::EpiF32 E{PP, D};
              pg8::gemm_phase<pg8::EpiF32, pg8::StaticOrder, true, true>(F.lds + RING_OFF, g, S, E, F.wave); }
            if constexpr (l == 0) { pg8::Gemm g{XB, (const bf16*)(F.ws + WS_WPG), M, D, D}; pg8::StaticOrder S; S.init(M, D, F.G, (int)blockIdx.x);
              pg8::EpiPle2 E{PP, X, D, (const pg8::ssq_t*)(SSACC + M), XB2, SSACC + 2 * M, 1.0f};
              pg8::gemm_phase<pg8::EpiPle2, pg8::StaticOrder, true, true>(F.lds + RING_OFF, g, S, E, F.wave); }
            else { pg8::Gemm g{HB, (const bf16*)(F.ws + WS_WPG) + (size_t)l * D * D, M, D, D / 2}; pg8::StaticOrder S; S.init(M, D, F.G, (int)blockIdx.x);
              pg8::EpiPle2 E{PP, X, D, nullptr, nullptr, nullptr, 1.0f / (WPG_F8SCALE * HB_F8SCALE)};
              pg8::gemm_phase<pg8::EpiPle2, pg8::StaticOrder, true, true, true>(F.lds + RING_OFF, g, S, E, F.wave); }
        }
        SEAM();
    }
#undef RUN
#undef HB
#undef PROJ
#undef YA
#undef YB
#undef MIXED
#undef TMP
#undef GH
#undef PP
#undef IFPRE
#undef GSEL
#undef XB
#undef XB2
#undef SSACC
#undef SEAM
}
constexpr int N_PHASES = 1 + (5 + 2 + 1) + (5 + 1 + (MOE_NAIVE ? 3 * NEXP : 3) + 2);

extern "C" void kernel_launch(void* const* d_in, const int* in_sizes, int n_in, void* d_out, int out_size, void* d_ws, size_t ws_size, hipStream_t stream) {
    static int grid = 0;
    if (grid == 0) {
        if (n_in != 25 || in_sizes[0] != M * D || out_size != M * D || ws_size < WS_END) { fprintf(stderr, "kernel_launch: unexpected shapes / workspace (n_in %d, ws %zu); nothing launched\n", n_in, ws_size); grid = -1; return; }
        int dev = 0, cus = 0, per_cu = 0;
        if (hipGetDevice(&dev) != hipSuccess || hipDeviceGetAttribute(&cus, hipDeviceAttributeMultiprocessorCount, dev) != hipSuccess) { grid = -1; return; }
        if (hipFuncSetAttribute((const void*)mega_fwd, hipFuncAttributeMaxDynamicSharedMemorySize, LDS_BYTES) != hipSuccess) { grid = -1; return; }
        if (hipOccupancyMaxActiveBlocksPerMultiprocessor(&per_cu, (const void*)mega_fwd, NTHR, LDS_BYTES) != hipSuccess || per_cu < 1) { fprintf(stderr, "kernel_launch: occupancy query reports %d\n", per_cu); }
        (void)hipGetLastError();
        grid = cus;
    }
    if (grid < 0) return;
    if (hipMemsetAsync((char*)d_ws + WS_CTL, 0, CTL_ZERO_BYTES, stream) != hipSuccess) return;
    Args a{};
    for (int i = 0; i < 25; ++i) a.in.p[i] = (const float*)d_in[i];
    a.out = (float*)d_out; a.ws = (unsigned char*)d_ws;
#if MK_PER_PHASE
    for (int li = 0; li < N_PHASES; ++li) { a.ph_lo = li; a.ph_hi = li + 1; a.li = 0; hipLaunchKernelGGL(mega_fwd, dim3(grid), dim3(NTHR), LDS_BYTES, stream, a); }
#else
    a.ph_lo = 0; a.ph_hi = N_PHASES; a.li = 0;
    hipLaunchKernelGGL(mega_fwd, dim3(grid), dim3(NTHR), LDS_BYTES, stream, a);
#endif
}
```

```cpp
#include <hip/hip_runtime.h>
#include <cstdio>
#include <cstdint>
#include <cmath>
namespace pg8 {
#define PG8_LAS __attribute__((address_space(3)))
typedef unsigned short bf16_t;
typedef short bf16x8 __attribute__((ext_vector_type(8)));
typedef float f32x4 __attribute__((ext_vector_type(4)));
typedef unsigned u32x4 __attribute__((ext_vector_type(4)));
typedef int v8i32 __attribute__((ext_vector_type(8)));
typedef int v4i32 __attribute__((ext_vector_type(4)));
constexpr int BM = 256, BK = 64, HALF = 128, HTB = HALF * BK * 2  , STAGE_BYTES = 8 * HTB, NXCD = 8, WGM = 8;

__host__ __device__ __forceinline__ int lds_byte(int r, int c) { const int st = (r >> 4) * 2 + (c >> 5), rr = r & 15, cc = c & 31, ob = rr * 64 + cc * 2; return st * 1024 + (ob ^ (((ob >> 9) & 1) << 5)); }
__host__ __device__ __forceinline__ void stage_rc(int b, int& R, int& C) { const int st = b / 1024, sb = b % 1024, swz = sb ^ (((sb >> 9) & 1) << 5); R = (st >> 1) * 16 + swz / 64; C = (st & 1) * 32 + (swz % 64) / 2; }
__host__ __device__ __forceinline__ int perm32(int rho) { const int n = rho >> 4, i = rho & 15; return 8 * (i >> 2) + 4 * n + (i & 3); }

struct Unit { int pm, pn, pb; };
struct Gemm { const bf16_t* A; const bf16_t* Bt; int M, N, K; };

struct StaticOrder {
    int nM, nN, nwg, G, c;
    __host__ __device__ void init(int M, int N, int G_, int c_) { nM = M / BM; nN = N / BM; nwg = nM * nN; G = G_; c = c_; }
    __host__ __device__ bool next(int i, Unit& u) const {
        const long L = (long)i * G + c; if (L >= nwg) return false;
        int wgid = (int)L; { const int q = nwg / NXCD, r = nwg % NXCD, xcd = wgid % NXCD, off = wgid / NXCD; wgid = (xcd < r ? xcd * (q + 1) : r * (q + 1) + (xcd - r) * q) + off; }
        const int nig = WGM * nN, gid = wgid / nig, fm = gid * WGM, gsz = (nM - fm) < WGM ? (nM - fm) : WGM;
        u.pm = fm + ((wgid % nig) % gsz); u.pn = (wgid % nig) / gsz; u.pb = u.pn; return true;
    }
    __device__ __forceinline__ void a_ready(const Unit&) const {}
    __device__ __forceinline__ void done(const Unit&) const {}
};

__device__ __forceinline__ unsigned cvt_pk_bf16(float lo, float hi) { unsigned r; asm volatile("v_cvt_pk_bf16_f32 %0, %1, %2" : "=v"(r) : "v"(lo), "v"(hi)); return r; }
template <class Epi, class Sched, bool ALIGN_EPI = false, bool SP2 = false, bool F8 = false>
__device__ __forceinline__ void gemm_phase(PG8_LAS unsigned char* lds, const Gemm g, const Sched& S, const Epi& E, int wave_in) {
    int tid_; asm volatile("v_mbcnt_lo_u32_b32 %0, -1, 0\n\tv_mbcnt_hi_u32_b32 %0, -1, %0" : "=v"(tid_)); tid_ += 64 * wave_in;
    const int tid = tid_, wid = __builtin_amdgcn_readfirstlane(tid >> 6), lane = tid & 63, wr = wid >> 2, wc = wid & 3, fr = lane & 15, fq = lane >> 4;
    const int K = g.K, nt = K / BK;
    unsigned voffA[2], voffB[2];
#pragma unroll
    for (int i = 0; i < 2; ++i) { int R, C; stage_rc(tid * 16 + i * 8192, R, C); const int Rb = Epi::PERM ? ((R & ~31) + perm32(R & 31)) : R;
        voffA[i] = (unsigned)(R * K + C) * 2u; voffB[i] = (unsigned)(Rb * K + C) * 2u; }
    const size_t kstep = (size_t)(BK * 2);
    const size_t hstep = (size_t)HALF * K * 2;
    const size_t tstep = 2 * hstep;
    const unsigned ldsw = (unsigned)wid * 1024u;
    const int aoff = lds_byte(wr * 64 + fr, fq * 8), boff = lds_byte(wc * 32 + fr, fq * 8);
    const int aofk0 = F8 ? lds_byte(wr * 64 + fr, 16 * fq) : aoff, aofk1 = F8 ? lds_byte(wr * 64 + fr, 16 * fq + 8) : aoff + 1024, bofk0 = F8 ? lds_byte(wc * 32 + fr, 16 * fq) : boff, bofk1 = F8 ? lds_byte(wc * 32 + fr, 16 * fq + 8) : boff + 1024;
#define PG8_SA(b, h) (((b) * 2 + (h)) * HTB)
#define PG8_SB(b, h) ((4 + (b) * 2 + (h)) * HTB)
#define PG8_STAGE(bufoff, gbase, voff) do { _Pragma("unroll") for (int _i = 0; _i < 2; ++_i) \
        __builtin_amdgcn_global_load_lds((const unsigned*)((const char*)(gbase) + (voff)[_i]), (PG8_LAS unsigned*)(lds + (bufoff) + ldsw + _i * 8192), 16, 0, 0); } while (0)
#define PG8_LDA(dst, b, h) do { if constexpr (F8) { _Pragma("unroll") for (int m = 0; m < 4; ++m) { dst##8[m].lo = *(const PG8_LAS v4i32*)(lds + PG8_SA(b, h) + aofk0 + m * 2048); dst##8[m].hi = *(const PG8_LAS v4i32*)(lds + PG8_SA(b, h) + aofk1 + m * 2048); } } \
        else { _Pragma("unroll") for (int m = 0; m < 4; ++m) _Pragma("unroll") for (int k = 0; k < 2; ++k) dst[m][k] = *(const PG8_LAS bf16x8*)(lds + PG8_SA(b, h) + (k ? aofk1 : aofk0) + m * 2048); } } while (0)
#define PG8_LDB(dst, b, h) do { if constexpr (F8) { _Pragma("unroll") for (int n = 0; n < 2; ++n) { dst##8[n].lo = *(const PG8_LAS v4i32*)(lds + PG8_SB(b, h) + bofk0 + n * 2048); dst##8[n].hi = *(const PG8_LAS v4i32*)(lds + PG8_SB(b, h) + bofk1 + n * 2048); } } \
        else { _Pragma("unroll") for (int n = 0; n < 2; ++n) _Pragma("unroll") for (int k = 0; k < 2; ++k) dst[n][k] = *(const PG8_LAS bf16x8*)(lds + PG8_SB(b, h) + (k ? bofk1 : bofk0) + n * 2048); } } while (0)
#define PG8_MMA(ai, bj, At, Bt) do { __builtin_amdgcn_s_setprio(1); \
        if constexpr (F8) { _Pragma("unroll") for (int m = 0; m < 4; ++m) _Pragma("unroll") for (int n = 0; n < 2; ++n) \
            asm volatile("v_mfma_scale_f32_16x16x128_f8f6f4 %0, %1, %2, %0, %3, %3 op_sel_hi:[0,0,0]" : "+v"(acc[ai][bj][m][n]) : "v"(Bt##8[n]), "v"(At##8[m]), "v"(f8one)); } \
        else { _Pragma("unroll") for (int m = 0; m < 4; ++m) _Pragma("unroll") for (int n = 0; n < 2; ++n) _Pragma("unroll") for (int k = 0; k < 2; ++k) \
            acc[ai][bj][m][n] = __builtin_amdgcn_mfma_f32_16x16x32_bf16(Bt[n][k], At[m][k], acc[ai][bj][m][n], 0, 0, 0); } \
        __builtin_amdgcn_s_setprio(0); } while (0)
#define PG8_WAIT_V(n) asm volatile("s_waitcnt vmcnt(" #n ")" ::: "memory")
#define PG8_WAIT_L(n) asm volatile("s_waitcnt lgkmcnt(" #n ")" ::: "memory")
#define PG8_BAR __builtin_amdgcn_s_barrier()
#define PG8_SCHED __builtin_amdgcn_sched_barrier(0)
    Unit cur, nxt; int ui = 0;
    if (!S.next(0, cur)) return;
    typename Epi::Pre pre = E.prefetch(cur, wr, fr);
    f32x4 acc[2][2][4][2];
#pragma unroll
    for (int a = 0; a < 2; ++a)
#pragma unroll
        for (int b = 0; b < 2; ++b)
#pragma unroll
            for (int m = 0; m < 4; ++m)
#pragma unroll
                for (int n = 0; n < 2; ++n) acc[a][b][m][n] = (f32x4){0.f, 0.f, 0.f, 0.f};
    bf16x8 At[4][2], B0[2][2], B1[2][2];
    int f8one = 0x7f7f7f7f; asm volatile("" : "+v"(f8one));
    v8i32 At8[4], B08[2], B18[2];
    const char* cA = (const char*)g.A + (size_t)cur.pm * tstep; const char* cB = (const char*)g.Bt + (size_t)cur.pb * tstep;
    S.a_ready(cur);
    if constexpr (SP2) {
        PG8_STAGE(PG8_SB(0, 0), cB, voffB); PG8_STAGE(PG8_SB(0, 1), cB + hstep, voffB); PG8_STAGE(PG8_SA(0, 0), cA, voffA); PG8_STAGE(PG8_SA(0, 1), cA + hstep, voffA);
        if (wr == 1) PG8_BAR;
        PG8_WAIT_V(2); PG8_BAR;
        PG8_STAGE(PG8_SB(1, 0), cB + kstep, voffB); PG8_STAGE(PG8_SA(1, 0), cA + kstep, voffA); PG8_STAGE(PG8_SB(1, 1), cB + hstep + kstep, voffB);
        PG8_WAIT_V(6); PG8_BAR;
    } else {
        PG8_STAGE(PG8_SB(0, 0), cB, voffB); PG8_STAGE(PG8_SA(0, 0), cA, voffA); PG8_STAGE(PG8_SB(0, 1), cB + hstep, voffB); PG8_STAGE(PG8_SA(0, 1), cA + hstep, voffA);
        if (wr == 1) PG8_BAR;
        PG8_WAIT_V(4); PG8_BAR;
        PG8_STAGE(PG8_SB(1, 0), cB + kstep, voffB); PG8_STAGE(PG8_SA(1, 0), cA + kstep, voffA); PG8_STAGE(PG8_SB(1, 1), cB + hstep + kstep, voffB);
        PG8_WAIT_V(6); PG8_BAR;
    }
    for (;;) {
        const bool has_next = S.next(ui + 1, nxt);
        const char* nA = has_next ? (const char*)g.A + (size_t)nxt.pm * tstep : cA; const char* nB = has_next ? (const char*)g.Bt + (size_t)nxt.pb * tstep : cB;
        _Pragma("nounroll") for (int t = 0; t < nt; t += 2) {
            const bool last = (t == nt - 2);
            const char* a1 = cA + (size_t)(t + 1) * kstep;
            const char* a2 = last ? nA : cA + (size_t)(t + 2) * kstep; const char* b2 = last ? nB : cB + (size_t)(t + 2) * kstep;
            const char* a3 = a2 + kstep; const char* b3 = b2 + kstep;
            if (last && has_next) S.a_ready(nxt);
            if constexpr (Epi::MIDK) { if (t == Epi::MID_T) E.mid(acc, cur, wr, wc, fr, fq); }
            if constexpr (SP2) {
            PG8_LDB(B0, 0, 0); PG8_LDB(B1, 0, 1); PG8_SCHED; PG8_LDA(At, 0, 0); PG8_STAGE(PG8_SA(1, 1), a1 + hstep, voffA);
            PG8_WAIT_V(8); PG8_WAIT_L(0); PG8_BAR; PG8_MMA(0, 0, At, B0); PG8_MMA(0, 1, At, B1); PG8_BAR; PG8_SCHED;
            PG8_LDA(At, 0, 1); PG8_STAGE(PG8_SB(0, 0), b2, voffB); PG8_STAGE(PG8_SB(0, 1), b2 + hstep, voffB); PG8_STAGE(PG8_SA(0, 0), a2, voffA);
            PG8_WAIT_V(8); PG8_WAIT_L(0); PG8_BAR; PG8_MMA(1, 0, At, B0); PG8_MMA(1, 1, At, B1); PG8_BAR; PG8_SCHED;
            PG8_LDB(B0, 1, 0); PG8_LDB(B1, 1, 1); PG8_SCHED; PG8_LDA(At, 1, 0); PG8_STAGE(PG8_SA(0, 1), a2 + hstep, voffA);
            PG8_WAIT_V(8); PG8_WAIT_L(0); PG8_BAR; PG8_MMA(0, 0, At, B0); PG8_MMA(0, 1, At, B1); PG8_BAR; PG8_SCHED;
            PG8_LDA(At, 1, 1); PG8_STAGE(PG8_SB(1, 0), b3, voffB); PG8_STAGE(PG8_SB(1, 1), b3 + hstep, voffB); PG8_STAGE(PG8_SA(1, 0), a3, voffA);
            PG8_WAIT_V(8); PG8_WAIT_L(0); PG8_BAR; PG8_MMA(1, 0, At, B0); PG8_MMA(1, 1, At, B1); PG8_BAR; PG8_SCHED;
            } else {
            PG8_LDB(B0, 0, 0); PG8_SCHED; PG8_LDA(At, 0, 0); PG8_STAGE(PG8_SA(1, 1), a1 + hstep, voffA);
            PG8_WAIT_L(8); PG8_BAR; PG8_WAIT_L(0); PG8_MMA(0, 0, At, B0); PG8_BAR; PG8_SCHED;
            PG8_LDB(B1, 0, 1); PG8_STAGE(PG8_SB(0, 0), b2, voffB);
            PG8_BAR; PG8_WAIT_L(0); PG8_MMA(0, 1, At, B1); PG8_BAR;
            PG8_LDA(At, 0, 1); PG8_STAGE(PG8_SA(0, 0), a2, voffA);
            PG8_BAR; PG8_WAIT_L(0); PG8_MMA(1, 0, At, B0); PG8_BAR; PG8_SCHED;
            PG8_STAGE(PG8_SB(0, 1), b2 + hstep, voffB);
            PG8_WAIT_V(6); PG8_BAR; PG8_MMA(1, 1, At, B1); PG8_BAR;
            PG8_LDB(B0, 1, 0); PG8_SCHED; PG8_LDA(At, 1, 0); PG8_STAGE(PG8_SA(0, 1), a2 + hstep, voffA);
            PG8_WAIT_L(8); PG8_BAR; PG8_WAIT_L(0); PG8_MMA(0, 0, At, B0); PG8_BAR; PG8_SCHED;
            PG8_LDB(B1, 1, 1); PG8_STAGE(PG8_SB(1, 0), b3, voffB);
            PG8_BAR; PG8_WAIT_L(0); PG8_MMA(0, 1, At, B1); PG8_BAR;
            PG8_LDA(At, 1, 1); PG8_STAGE(PG8_SA(1, 0), a3, voffA);
            PG8_BAR; PG8_WAIT_L(0); PG8_MMA(1, 0, At, B0); PG8_BAR; PG8_SCHED;
            PG8_STAGE(PG8_SB(1, 1), b3 + hstep, voffB);
            PG8_WAIT_V(6); PG8_BAR; PG8_MMA(1, 1, At, B1); PG8_BAR;
            }
        }
        if constexpr (ALIGN_EPI) { if (wr == 0) PG8_BAR; }
        if constexpr (F8) asm volatile("s_nop 15\n\ts_nop 15" ::: "memory");
        if constexpr (!Epi::AFTER_DRAIN) { E(acc, cur, wr, wc, fr, fq, pre); S.done(cur); }
        if (!has_next) break;
#pragma unroll
        for (int a = 0; a < 2; ++a)
#pragma unroll
            for (int b = 0; b < 2; ++b)
#pragma unroll
                for (int m = 0; m < 4; ++m)
#pragma unroll
                    for (int n = 0; n < 2; ++n) acc[a][b][m][n] = (f32x4){0.f, 0.f, 0.f, 0.f};
        cur = nxt; cA = nA; cB = nB; ++ui; pre = E.prefetch(cur, wr, fr);
        if constexpr (ALIGN_EPI) { if (wr == 1) PG8_BAR; }
    }
    PG8_WAIT_V(0);
    if constexpr (!ALIGN_EPI) { if (wr == 0) PG8_BAR; }
    PG8_BAR;
    if constexpr (Epi::AFTER_DRAIN) { E.fused(acc, cur, wr, wc, fr, fq, lds, wid, lane); S.done(cur); }
#undef PG8_SA
#undef PG8_SB
#undef PG8_STAGE
#undef PG8_LDA
#undef PG8_LDB
#undef PG8_MMA
#undef PG8_WAIT_V
#undef PG8_WAIT_L
#undef PG8_BAR
#undef PG8_SCHED
}
}
namespace pg8 {
#define PG8_GAS __attribute__((address_space(1)))
typedef unsigned u32x2 __attribute__((ext_vector_type(2)));
__device__ __forceinline__ float ex2(float x) { return __builtin_amdgcn_exp2f(x); }
__device__ __forceinline__ float sigm(float x) { return __builtin_amdgcn_rcpf(1.0f + ex2(-1.4426950408889634f * x)); }
__device__ __forceinline__ float bflo(unsigned w) { return __uint_as_float(w << 16); }
__device__ __forceinline__ float bfhi(unsigned w) { return __uint_as_float(w & 0xffff0000u); }

typedef unsigned ssq_t;
__device__ __forceinline__ ssq_t ss_fix(float v) { return (ssq_t)(v * 1024.0f); }
__device__ __forceinline__ float rstd_fix(ssq_t s) { return __builtin_amdgcn_rsqf((float)s * (1.0f / (1024.0f * 1024.0f)) + 1e-6f); }
struct NoPre { struct Pre {}; __device__ __forceinline__ Pre prefetch(const Unit&, int, int) const { return Pre{}; } };
struct SsPre { struct Pre { ssq_t s[8]; };
    __device__ __forceinline__ static Pre load(const ssq_t* ss, const Unit& u, int wr, int fr) { Pre p;
#pragma unroll
        for (int i = 0; i < 8; ++i) p.s[i] = ss ? ss[u.pm * BM + wr * 64 + fr + (i >> 2) * HALF + (i & 3) * 16] : 0u;
        return p; } };
__device__ __forceinline__ float quad_sum(float v, int fr, int fq) {
    const int lane = fr + 16 * fq;
    v += __int_as_float(__builtin_amdgcn_ds_bpermute((lane ^ 16) << 2, __float_as_int(v)));
    v += __int_as_float(__builtin_amdgcn_ds_bpermute((lane ^ 32) << 2, __float_as_int(v)));
    return v;
}
struct EpiQK {
    static constexpr bool PERM = true, AFTER_DRAIN = false, MIDK = false; typedef SsPre::Pre Pre;
    bf16_t* O; unsigned ldc; const ssq_t* ss; const float* g_q; const float* g_k; float* kmp; float qscale;
    __device__ __forceinline__ Pre prefetch(const Unit& u, int wr, int fr) const { return SsPre::load(ss, u, wr, fr); }
    __device__ __forceinline__ void operator()(const f32x4 (&acc)[2][2][4][2], const Unit& u, int wr, int wc, int fr_, int fq_, const Pre& pre) const {
        int fr = fr_, fq = fq_; asm volatile("" : "+v"(fr), "+v"(fq));
        const bool isq = u.pn < 2; const float* gg = (isq ? g_q : g_k) + 8 * fq; const float osc = isq ? qscale : 1.0f;
        f32x4 gn[2][2], cs[2][2];
#pragma unroll
        for (int bj = 0; bj < 2; ++bj)
#pragma unroll
            for (int n = 0; n < 2; ++n) { gn[bj][n] = *(const f32x4*)(gg + 32 * bj + 4 * n); cs[bj][n] = (f32x4){0.f, 0.f, 0.f, 0.f}; }
        const unsigned obase = (unsigned)(u.pm * BM + wr * 64 + fr) * ldc + (unsigned)(u.pn * BM + wc * 64 + 8 * fq);
#pragma unroll
        for (int ai = 0; ai < 2; ++ai)
#pragma unroll
            for (int m = 0; m < 4; ++m) { const float rs = rstd_fix(pre.s[ai * 4 + m]);
                float q2 = 0.f;
#pragma unroll
                for (int bj = 0; bj < 2; ++bj)
#pragma unroll
                    for (int n = 0; n < 2; ++n) { const f32x4 a = acc[ai][bj][m][n]; q2 += (a[0] * a[0] + a[1] * a[1]) + (a[2] * a[2] + a[3] * a[3]); }
                q2 = quad_sum(q2, fr, fq);
                const float rr = rs * __builtin_amdgcn_rsqf(rs * rs * q2 * (1.0f / 64.0f) + 1e-6f) * osc;
                const unsigned off = obase + (unsigned)(ai * HALF + m * 16) * ldc;
#pragma unroll
                for (int bj = 0; bj < 2; ++bj) { const f32x4 o0 = acc[ai][bj][m][0] * (gn[bj][0] * rr), o1 = acc[ai][bj][m][1] * (gn[bj][1] * rr); cs[bj][0] += o0; cs[bj][1] += o1;
                    u32x4 w; w.x = cvt_pk_bf16(o0[0], o0[1]); w.y = cvt_pk_bf16(o0[2], o0[3]); w.z = cvt_pk_bf16(o1[0], o1[1]); w.w = cvt_pk_bf16(o1[2], o1[3]);
                    *(u32x4*)(O + off + 32 * bj) = w; }
                asm volatile("" : "+v"(cs[0][0]), "+v"(cs[0][1]), "+v"(cs[1][0]), "+v"(cs[1][1]));
                __builtin_amdgcn_sched_barrier(0); }
        if (!isq) {
            const int lane = fr + 16 * fq;
#pragma unroll
            for (int o = 1; o < 16; o <<= 1)
#pragma unroll
                for (int bj = 0; bj < 2; ++bj)
#pragma unroll
                    for (int n = 0; n < 2; ++n)
#pragma unroll
                        for (int j = 0; j < 4; ++j) cs[bj][n][j] += __int_as_float(__builtin_amdgcn_ds_bpermute((lane ^ o) << 2, __float_as_int(cs[bj][n][j])));
            if (fr == 0) { float* kp = kmp + ((((unsigned)(u.pm >> 4) * 8 + (u.pn & 1) * 4 + wc) * 16 + (u.pm & 15)) * 2 + wr) * 64 + 8 * fq;
#pragma unroll
                for (int bj = 0; bj < 2; ++bj) { *(f32x4*)(kp + 32 * bj) = cs[bj][0]; *(f32x4*)(kp + 32 * bj + 4) = cs[bj][1]; } }
        }
    }
};
struct EpiProj {
    static constexpr bool PERM = true, AFTER_DRAIN = false, MIDK = false; typedef SsPre::Pre Pre;
    bf16_t* O; int ldc; int sig_from; const ssq_t* ss; int gate_tile; float* ifpre; const float* b_i; const float* b_f; bf16_t* GT; int pn0;
    __device__ __forceinline__ Pre prefetch(const Unit& u, int wr, int fr) const { return SsPre::load(ss, u, wr, fr); }
    __device__ __forceinline__ void operator()(const f32x4 (&acc)[2][2][4][2], const Unit& u_, int wr, int wc, int fr, int fq, const Pre& pre) const {
        Unit u = u_; u.pn += pn0;
        const int row0 = u.pm * BM + wr * 64 + fr, col0 = u.pn * BM + wc * 32 + 8 * fq; const bool sg = u.pn >= sig_from;
        if (u.pn == gate_tile) {
            if (wc == 0 && fq == 0) { const f32x4 bi = *(const f32x4*)b_i, bf = *(const f32x4*)b_f;
#pragma unroll
                for (int ai = 0; ai < 2; ++ai)
#pragma unroll
                    for (int m = 0; m < 4; ++m) { const int r = row0 + ai * HALF + m * 16; const float rs = rstd_fix(pre.s[ai * 4 + m]);
                        *(f32x4*)(ifpre + (size_t)r * 8) = acc[ai][0][m][0] * rs + bi; *(f32x4*)(ifpre + (size_t)r * 8 + 4) = acc[ai][0][m][1] * rs + bf; } }
            return; }
#pragma unroll
        for (int ai = 0; ai < 2; ++ai)
#pragma unroll
            for (int m = 0; m < 4; ++m) { const int r = row0 + ai * HALF + m * 16; bf16_t* rowp = O + (size_t)r * ldc + col0; const float rs = rstd_fix(pre.s[ai * 4 + m]);
#pragma unroll
                for (int bj = 0; bj < 2; ++bj) { f32x4 v0 = acc[ai][bj][m][0] * rs, v1 = acc[ai][bj][m][1] * rs;
                    if (sg) {
#pragma unroll
                        for (int j = 0; j < 4; ++j) { v0[j] = sigm(v0[j]); v1[j] = sigm(v1[j]); } }
                    u32x4 w; w.x = cvt_pk_bf16(v0[0], v0[1]); w.y = cvt_pk_bf16(v0[2], v0[3]); w.z = cvt_pk_bf16(v1[0], v1[1]); w.w = cvt_pk_bf16(v1[2], v1[3]);
                    if (sg) *(u32x4*)(GT + ((((size_t)u.pm * 8 + (u.pn - sig_from)) * 16 + (ai * 8 + m * 2 + bj)) * 8 + (wr * 4 + wc)) * 512 + (fr + 16 * fq) * 8) = w;
                    else *(u32x4*)(rowp + bj * HALF) = w; } }
    }
};
struct EpiSwiglu {
    static constexpr bool PERM = true, AFTER_DRAIN = false, MIDK = false; typedef SsPre::Pre Pre;
    bf16_t* O; int ldc; const ssq_t* ss; float osc; float f8out;
    __device__ __forceinline__ Pre prefetch(const Unit& u, int wr, int fr) const { return SsPre::load(ss, u, wr, fr); }
    __device__ __forceinline__ void operator()(const f32x4 (&acc)[2][2][4][2], const Unit& u, int wr, int wc, int fr_, int fq_, const Pre& pre) const {
        int fr = fr_, fq = fq_; asm volatile("" : "+v"(fr), "+v"(fq));
        const unsigned obase = (unsigned)(u.pm * BM + wr * 64 + fr) * (unsigned)ldc + (unsigned)(u.pn * HALF + wc * 32 + 8 * fq);
#pragma unroll
        for (int ai = 0; ai < 2; ++ai)
#pragma unroll
            for (int m = 0; m < 4; ++m) { bf16_t* rowp = O + (obase + (unsigned)(ai * HALF + m * 16) * (unsigned)ldc); const float rs = (ss ? rstd_fix(pre.s[ai * 4 + m]) : 1.0f) * osc;
                const float nl = -1.4426950408889634f * rs, ic = __builtin_amdgcn_rcpf(rs * rs * (f8out != 0.f ? f8out : 1.0f));
                f32x4 v0, v1;
#pragma unroll
                for (int j = 0; j < 4; ++j) { const float g0 = acc[ai][0][m][0][j], g1 = acc[ai][0][m][1][j];
                    v0[j] = (g0 * acc[ai][1][m][0][j]) * __builtin_amdgcn_rcpf(fmaf(ex2(g0 * nl), ic, ic)); v1[j] = (g1 * acc[ai][1][m][1][j]) * __builtin_amdgcn_rcpf(fmaf(ex2(g1 * nl), ic, ic)); }
                if (f8out != 0.f) {
#pragma unroll
                    for (int j = 0; j < 4; ++j) { v0[j] = __builtin_amdgcn_fmed3f(v0[j], -448.0f, 448.0f); v1[j] = __builtin_amdgcn_fmed3f(v1[j], -448.0f, 448.0f); }
                    int a_ = __builtin_amdgcn_cvt_pk_fp8_f32(v0[0], v0[1], 0, false); a_ = __builtin_amdgcn_cvt_pk_fp8_f32(v0[2], v0[3], a_, true);
                    int b_ = __builtin_amdgcn_cvt_pk_fp8_f32(v1[0], v1[1], 0, false); b_ = __builtin_amdgcn_cvt_pk_fp8_f32(v1[2], v1[3], b_, true);
                    u32x2 w8; w8.x = (unsigned)a_; w8.y = (unsigned)b_; *(u32x2*)((unsigned char*)O + (obase + (unsigned)(ai * HALF + m * 16) * (unsigned)ldc)) = w8; }
                else { u32x4 w; w.x = cvt_pk_bf16(v0[0], v0[1]); w.y = cvt_pk_bf16(v0[2], v0[3]); w.z = cvt_pk_bf16(v1[0], v1[1]); w.w = cvt_pk_bf16(v1[2], v1[3]);
                    *(u32x4*)rowp = w; } }
    }
};
struct EpiResid {
    static constexpr bool PERM = true, AFTER_DRAIN = false, MIDK = false; typedef NoPre::Pre Pre; __device__ __forceinline__ Pre prefetch(const Unit&, int, int) const { return Pre{}; }
    const float* base; float* out; int ldc; const float* rowscale; int rs_ld; bf16_t* xb; ssq_t* ssacc;
    __device__ __forceinline__ void operator()(const f32x4 (&acc)[2][2][4][2], const Unit& u, int wr, int wc, int fr_, int fq_, const Pre&) const {
        int fr = fr_, fq = fq_; asm volatile("" : "+v"(fr), "+v"(fq));
        const int row0 = u.pm * BM + wr * 64 + fr, col0 = u.pn * BM + wc * 32 + 8 * fq;
        const PG8_GAS float* gb_ = (const PG8_GAS float*)base;
        f32x4 bv[2][4][2][2];
#define PG8_RESID_LOAD(ai) do { _Pragma("unroll") for (int m = 0; m < 4; ++m) _Pragma("unroll") for (int bj = 0; bj < 2; ++bj) { const size_t off = (size_t)(row0 + (ai) * HALF + m * 16) * ldc + col0 + bj * HALF; \
            bv[ai][m][bj][0] = *(const PG8_GAS f32x4*)(gb_ + off); bv[ai][m][bj][1] = *(const PG8_GAS f32x4*)(gb_ + off + 4); } __builtin_amdgcn_sched_barrier(0); } while (0)
#define PG8_RESID_STEP(ai, m) do { const int r = row0 + (ai) * HALF + (m) * 16; const float s = rowscale ? rowscale[(size_t)r * rs_ld] : 1.0f; float part = 0.f; \
            _Pragma("unroll") for (int bj = 0; bj < 2; ++bj) { const size_t off = (size_t)r * ldc + col0 + bj * HALF; \
                const f32x4 v0 = bv[ai][m][bj][0] + acc[ai][bj][m][0] * s, v1 = bv[ai][m][bj][1] + acc[ai][bj][m][1] * s; \
                *(PG8_GAS f32x4*)((PG8_GAS float*)out + off) = v0; *(PG8_GAS f32x4*)((PG8_GAS float*)out + off + 4) = v1; \
                if (xb) { u32x4 w; w.x = cvt_pk_bf16(v0[0], v0[1]); w.y = cvt_pk_bf16(v0[2], v0[3]); w.z = cvt_pk_bf16(v1[0], v1[1]); w.w = cvt_pk_bf16(v1[2], v1[3]); *(PG8_GAS u32x4*)((PG8_GAS bf16_t*)xb + off) = w; } \
                part += (v0[0] * v0[0] + v0[1] * v0[1]) + (v0[2] * v0[2] + v0[3] * v0[3]) + (v1[0] * v1[0] + v1[1] * v1[1]) + (v1[2] * v1[2] + v1[3] * v1[3]); } \
            if (ssacc) { part = quad_sum(part, fr, fq); if (fq == 0) __hip_atomic_fetch_add((PG8_GAS ssq_t*)ssacc + r, ss_fix(part), __ATOMIC_RELAXED, __HIP_MEMORY_SCOPE_AGENT); } } while (0)
        PG8_RESID_LOAD(0);
        PG8_RESID_STEP(0, 0); PG8_RESID_STEP(0, 1); __builtin_amdgcn_sched_barrier(0);
        PG8_RESID_LOAD(1);
        PG8_RESID_STEP(0, 2); PG8_RESID_STEP(0, 3); PG8_RESID_STEP(1, 0); PG8_RESID_STEP(1, 1); PG8_RESID_STEP(1, 2); PG8_RESID_STEP(1, 3);
#undef PG8_RESID_LOAD
#undef PG8_RESID_STEP
    }
};
struct EpiMerge {
    static constexpr bool PERM = true, AFTER_DRAIN = false, MIDK = true; static constexpr int MID_T = 8; typedef NoPre::Pre Pre; __device__ __forceinline__ Pre prefetch(const Unit&, int, int) const { return Pre{}; }
    const bf16_t* GT; bf16_t* O; int ldc;
    __device__ __forceinline__ void mid(f32x4 (&acc)[2][2][4][2], const Unit& u, int wr, int wc, int fr_, int fq_) const {
        int fr = fr_, fq = fq_; asm volatile("" : "+v"(fr), "+v"(fq));
        const PG8_GAS bf16_t* ga_ = (const PG8_GAS bf16_t*)GT + ((size_t)u.pm * 8 + u.pn) * 65536 + (size_t)(wr * 4 + wc) * 512 + (fr + 16 * fq) * 8;
#pragma unroll
        for (int ai = 0; ai < 2; ++ai) { u32x4 ga[4][2], gb[4][2];
#pragma unroll
            for (int m = 0; m < 4; ++m)
#pragma unroll
                for (int bj = 0; bj < 2; ++bj) { const size_t fo = (size_t)(ai * 8 + m * 2 + bj) * 4096; ga[m][bj] = *(const PG8_GAS u32x4*)(ga_ + fo); gb[m][bj] = *(const PG8_GAS u32x4*)(ga_ + 4 * 65536 + fo); }
            __builtin_amdgcn_sched_barrier(0);
#pragma unroll
            for (int m = 0; m < 4; ++m)
#pragma unroll
                for (int bj = 0; bj < 2; ++bj) { const u32x4 a = ga[m][bj], b = gb[m][bj];
                    const f32x4 a0 = {bflo(a.x), bfhi(a.x), bflo(a.y), bfhi(a.y)}, a1 = {bflo(a.z), bfhi(a.z), bflo(a.w), bfhi(a.w)}, b0 = {bflo(b.x), bfhi(b.x), bflo(b.y), bfhi(b.y)}, b1 = {bflo(b.z), bfhi(b.z), bflo(b.w), bfhi(b.w)};
#pragma unroll
                    for (int j = 0; j < 4; ++j) { acc[ai][bj][m][0][j] *= a0[j] * __builtin_amdgcn_rcpf(fmaxf(b0[j], 1e-30f)); acc[ai][bj][m][1][j] *= a1[j] * __builtin_amdgcn_rcpf(fmaxf(b1[j], 1e-30f)); } }
            __builtin_amdgcn_sched_barrier(0); }
    }
    __device__ __forceinline__ void operator()(const f32x4 (&acc)[2][2][4][2], const Unit& u, int wr, int wc, int fr_, int fq_, const Pre&) const {
        int fr = fr_, fq = fq_; asm volatile("" : "+v"(fr), "+v"(fq));
        const int row0 = u.pm * BM + wr * 64 + fr, col0 = u.pn * BM + wc * 32 + 8 * fq;
        const PG8_GAS bf16_t* gb_ = (const PG8_GAS bf16_t*)GT + ((size_t)u.pm * 8 + 4 + u.pn) * 65536 + (size_t)(wr * 4 + wc) * 512 + (fr + 16 * fq) * 8;
        u32x4 gb[2][4][2];
#pragma unroll
        for (int ai = 0; ai < 2; ++ai)
#pragma unroll
            for (int m = 0; m < 4; ++m)
#pragma unroll
                for (int bj = 0; bj < 2; ++bj) gb[ai][m][bj] = *(const PG8_GAS u32x4*)(gb_ + (size_t)(ai * 8 + m * 2 + bj) * 4096);
        __builtin_amdgcn_sched_barrier(0);
#pragma unroll
        for (int ai = 0; ai < 2; ++ai)
#pragma unroll
            for (int m = 0; m < 4; ++m) { const size_t r = (size_t)(row0 + ai * HALF + m * 16);
#pragma unroll
                for (int bj = 0; bj < 2; ++bj) { const u32x4 b = gb[ai][m][bj];
                    const f32x4 b0 = {bflo(b.x), bfhi(b.x), bflo(b.y), bfhi(b.y)}, b1 = {bflo(b.z), bfhi(b.z), bflo(b.w), bfhi(b.w)};
                    const f32x4 v0 = acc[ai][bj][m][0] * b0, v1 = acc[ai][bj][m][1] * b1;
                    u32x4 w; w.x = cvt_pk_bf16(v0[0], v0[1]); w.y = cvt_pk_bf16(v0[2], v0[3]); w.z = cvt_pk_bf16(v1[0], v1[1]); w.w = cvt_pk_bf16(v1[2], v1[3]);
                    *(PG8_GAS u32x4*)((PG8_GAS bf16_t*)O + r * ldc + col0 + bj * HALF) = w; } }
    }
};
struct EpiGate1 {
    static constexpr bool PERM = true, AFTER_DRAIN = false, MIDK = false; typedef NoPre::Pre Pre; __device__ __forceinline__ Pre prefetch(const Unit&, int, int) const { return Pre{}; }
    const bf16_t* G; int ldg; bf16_t* T; int ldc;
    __device__ __forceinline__ void operator()(const f32x4 (&acc)[2][2][4][2], const Unit& u, int wr, int wc, int fr, int fq, const Pre&) const {
        const int row0 = u.pm * BM + wr * 64 + fr, col0 = u.pn * BM + wc * 32 + 8 * fq;
#pragma unroll
        for (int ai = 0; ai < 2; ++ai)
#pragma unroll
            for (int m = 0; m < 4; ++m) { const size_t r = (size_t)(row0 + ai * HALF + m * 16);
#pragma unroll
                for (int bj = 0; bj < 2; ++bj) { const u32x4 g = *(const u32x4*)(G + r * ldg + col0 + bj * HALF);
                    f32x4 g0 = {bflo(g.x), bfhi(g.x), bflo(g.y), bfhi(g.y)}, g1 = {bflo(g.z), bfhi(g.z), bflo(g.w), bfhi(g.w)};
                    const f32x4 t0 = g0 * acc[ai][bj][m][0], t1 = g1 * acc[ai][bj][m][1];
                    u32x4 w; w.x = cvt_pk_bf16(t0[0], t0[1]); w.y = cvt_pk_bf16(t0[2], t0[3]); w.z = cvt_pk_bf16(t1[0], t1[1]); w.w = cvt_pk_bf16(t1[2], t1[3]);
                    *(u32x4*)(T + r * ldc + col0 + bj * HALF) = w; } }
    }
};
struct EpiGate2 {
    static constexpr bool PERM = true, AFTER_DRAIN = false, MIDK = false; typedef NoPre::Pre Pre; __device__ __forceinline__ Pre prefetch(const Unit&, int, int) const { return Pre{}; }
    const bf16_t* G; int ldg; const bf16_t* T; bf16_t* O; int ldc;
    __device__ __forceinline__ void operator()(const f32x4 (&acc)[2][2][4][2], const Unit& u, int wr, int wc, int fr, int fq, const Pre&) const {
        const int row0 = u.pm * BM + wr * 64 + fr, col0 = u.pn * BM + wc * 32 + 8 * fq;
#pragma unroll
        for (int ai = 0; ai < 2; ++ai)
#pragma unroll
            for (int m = 0; m < 4; ++m) { const size_t r = (size_t)(row0 + ai * HALF + m * 16);
#pragma unroll
                for (int bj = 0; bj < 2; ++bj) { const u32x4 g = *(const u32x4*)(G + r * ldg + col0 + bj * HALF);
                    f32x4 g0 = {bflo(g.x), bfhi(g.x), bflo(g.y), bfhi(g.y)}, g1 = {bflo(g.z), bfhi(g.z), bflo(g.w), bfhi(g.w)};
                    const u32x4 tt = *(const u32x4*)(T + r * ldc + col0 + bj * HALF);
                    const f32x4 v0 = (f32x4){bflo(tt.x), bfhi(tt.x), bflo(tt.y), bfhi(tt.y)} + g0 * acc[ai][bj][m][0], v1 = (f32x4){bflo(tt.z), bfhi(tt.z), bflo(tt.w), bfhi(tt.w)} + g1 * acc[ai][bj][m][1];
                    u32x4 w; w.x = cvt_pk_bf16(v0[0], v0[1]); w.y = cvt_pk_bf16(v0[2], v0[3]); w.z = cvt_pk_bf16(v1[0], v1[1]); w.w = cvt_pk_bf16(v1[2], v1[3]);
                    *(u32x4*)(O + r * ldc + col0 + bj * HALF) = w; } }
    }
};
struct EpiF32 {
    static constexpr bool PERM = true, AFTER_DRAIN = false, MIDK = false; typedef NoPre::Pre Pre; __device__ __forceinline__ Pre prefetch(const Unit&, int, int) const { return Pre{}; }
    bf16_t* O; int ldc;
    __device__ __forceinline__ void operator()(const f32x4 (&acc)[2][2][4][2], const Unit& u, int wr, int wc, int fr, int fq, const Pre&) const {
        const int row0 = u.pm * BM + wr * 64 + fr, col0 = u.pn * BM + wc * 32 + 8 * fq;
#pragma unroll
        for (int ai = 0; ai < 2; ++ai)
#pragma unroll
            for (int m = 0; m < 4; ++m)
#pragma unroll
                for (int bj = 0; bj < 2; ++bj) { const f32x4 v0 = acc[ai][bj][m][0], v1 = acc[ai][bj][m][1]; u32x4 w; w.x = cvt_pk_bf16(v0[0], v0[1]); w.y = cvt_pk_bf16(v0[2], v0[3]); w.z = cvt_pk_bf16(v1[0], v1[1]); w.w = cvt_pk_bf16(v1[2], v1[3]);
                    *(u32x4*)(O + (size_t)(row0 + ai * HALF + m * 16) * ldc + col0 + bj * HALF) = w; }
    }
};
struct EpiPle2 {
    static constexpr bool PERM = true, AFTER_DRAIN = false, MIDK = false; typedef NoPre::Pre Pre; __device__ __forceinline__ Pre prefetch(const Unit&, int, int) const { return Pre{}; }
    const bf16_t* PP; float* x; int ldc; const ssq_t* ss_in; bf16_t* xb; ssq_t* ssacc; float osc;
    __device__ __forceinline__ void operator()(const f32x4 (&acc)[2][2][4][2], const Unit& u, int wr, int wc, int fr_, int fq_, const Pre&) const {
        int fr = fr_, fq = fq_; asm volatile("" : "+v"(fr), "+v"(fq));
        const int row0 = u.pm * BM + wr * 64 + fr, col0 = u.pn * BM + wc * 32 + 8 * fq;
        const PG8_GAS float* gx_ = (const PG8_GAS float*)x; const PG8_GAS bf16_t* gp_ = (const PG8_GAS bf16_t*)PP;
        f32x4 xv[4][2][2][2]; u32x4 pv[4][2][2]; ssq_t sv[4][2];
#define PG8_PLE_LOAD(q) do { _Pragma("unroll") for (int mm = 0; mm < 2; ++mm) { sv[q][mm] = ss_in ? ((const PG8_GAS ssq_t*)ss_in)[row0 + ((q) >> 1) * HALF + (((q) & 1) * 2 + mm) * 16] : 0u; _Pragma("unroll") for (int bj = 0; bj < 2; ++bj) { const size_t off = (size_t)(row0 + ((q) >> 1) * HALF + (((q) & 1) * 2 + mm) * 16) * ldc + col0 + bj * HALF; \
            pv[q][mm][bj] = *(const PG8_GAS u32x4*)(gp_ + off); xv[q][mm][bj][0] = *(const PG8_GAS f32x4*)(gx_ + off); xv[q][mm][bj][1] = *(const PG8_GAS f32x4*)(gx_ + off + 4); } } __builtin_amdgcn_sched_barrier(0); } while (0)
#define PG8_PLE_STEP(q, mm) do { constexpr int ai = (q) >> 1, m = ((q) & 1) * 2 + (mm); const int r = row0 + ai * HALF + m * 16; ssq_t sq_ = sv[q][mm]; asm volatile("" : "+v"(sq_));   const float rs = (ss_in ? rstd_fix(sq_) : 1.0f) * osc; float part = 0.f; \
            _Pragma("unroll") for (int bj = 0; bj < 2; ++bj) { const size_t off = (size_t)r * ldc + col0 + bj * HALF; \
                f32x4 a0 = acc[ai][bj][m][0] * rs, a1 = acc[ai][bj][m][1] * rs; \
                _Pragma("unroll") for (int j = 0; j < 4; ++j) { a0[j] = sigm(a0[j]); a1[j] = sigm(a1[j]); } \
                const u32x4 pw = pv[q][mm][bj]; \
                const f32x4 v0 = xv[q][mm][bj][0] + a0 * (f32x4){bflo(pw.x), bfhi(pw.x), bflo(pw.y), bfhi(pw.y)}, v1 = xv[q][mm][bj][1] + a1 * (f32x4){bflo(pw.z), bfhi(pw.z), bflo(pw.w), bfhi(pw.w)}; \
                *(PG8_GAS f32x4*)((PG8_GAS float*)x + off) = v0; *(PG8_GAS f32x4*)((PG8_GAS float*)x + off + 4) = v1; \
                if (xb) { u32x4 w; w.x = cvt_pk_bf16(v0[0], v0[1]); w.y = cvt_pk_bf16(v0[2], v0[3]); w.z = cvt_pk_bf16(v1[0], v1[1]); w.w = cvt_pk_bf16(v1[2], v1[3]); *(PG8_GAS u32x4*)((PG8_GAS bf16_t*)xb + off) = w; } \
                part += (v0[0] * v0[0] + v0[1] * v0[1]) + (v0[2] * v0[2] + v0[3] * v0[3]) + (v1[0] * v1[0] + v1[1] * v1[1]) + (v1[2] * v1[2] + v1[3] * v1[3]); } \
            if (ssacc) { part = quad_sum(part, fr, fq); if (fq == 0) __hip_atomic_fetch_add((PG8_GAS ssq_t*)ssacc + r, ss_fix(part), __ATOMIC_RELAXED, __HIP_MEMORY_SCOPE_AGENT); } } while (0)
        PG8_PLE_LOAD(0);
        PG8_PLE_STEP(0, 0); __builtin_amdgcn_sched_barrier(0);
        PG8_PLE_LOAD(1);
        PG8_PLE_STEP(0, 1); PG8_PLE_STEP(1, 0); __builtin_amdgcn_sched_barrier(0);
        PG8_PLE_LOAD(2);
        PG8_PLE_STEP(1, 1); PG8_PLE_STEP(2, 0); __builtin_amdgcn_sched_barrier(0);
        PG8_PLE_LOAD(3);
        PG8_PLE_STEP(2, 1); PG8_PLE_STEP(3, 0); PG8_PLE_STEP(3, 1);
#undef PG8_PLE_LOAD
#undef PG8_PLE_STEP
    }
};
}
#define GAS __attribute__((address_space(1)))
#define LAS __attribute__((address_space(3)))
typedef unsigned short bf16;
typedef unsigned v4u __attribute__((ext_vector_type(4)));
typedef float f32x4 __attribute__((ext_vector_type(4)));
typedef short bf16x8 __attribute__((ext_vector_type(8)));
typedef GAS unsigned gu32;
typedef GAS unsigned long long gu64;
#define RLX_AGENT __ATOMIC_RELAXED, __HIP_MEMORY_SCOPE_AGENT
#define LDS_WAIT() asm volatile("s_waitcnt lgkmcnt(0)" ::: "memory")
#define VM_WAIT() asm volatile("s_waitcnt vmcnt(0)" ::: "memory")
__device__ __forceinline__ unsigned long long rt() { return __builtin_amdgcn_s_memrealtime(); }
__device__ __forceinline__ unsigned f2bf(float f) { unsigned u = __builtin_bit_cast(unsigned, f); return (u + 0x7fffu + ((u >> 16) & 1u)) >> 16; }
__device__ __forceinline__ unsigned pk2(float lo, float hi) { return f2bf(lo) | (f2bf(hi) << 16); }

#define XB_TMO      128
#define XB_XCNT(j)  (256  + 64 * (j))
#define XB_XSUB(j)  (1280 + 64 * (j))
#define XB_XGEN(j)  (2304 + 64 * (j))
#define XB_TOP      3328
#define XB_TOPGEN   3392
#define XCD_BAR_WORDS 3456
#define XB_SPIN_CAP (1u << 18)

__device__ __forceinline__ unsigned xb_ld(unsigned* p)              { return __hip_atomic_load(p, __ATOMIC_RELAXED, __HIP_MEMORY_SCOPE_AGENT); }
__device__ __forceinline__ unsigned xb_add(unsigned* p, unsigned v) { return __hip_atomic_fetch_add(p, v, __ATOMIC_RELAXED, __HIP_MEMORY_SCOPE_AGENT); }
__device__ __forceinline__ unsigned xb_xcc_id() { return (unsigned)__builtin_amdgcn_s_getreg((3 << 11) | 20) & 0xFu; }
#define XB_SPIN(cond, bar) do { unsigned _sp = 0; while (cond) { __builtin_amdgcn_s_sleep(1); \
    if ((++_sp & 255u) == 0u) { if (xb_ld(&(bar)[XB_TMO])) break; if (_sp > XB_SPIN_CAP) { atomicAdd(&(bar)[XB_TMO], 1u); break; } } } } while (0)

__device__ __forceinline__ int lane_now() { int l; asm volatile("v_mbcnt_lo_u32_b32 %0, -1, 0\n\tv_mbcnt_hi_u32_b32 %0, -1, %0" : "=v"(l)); return l; }
struct XcdBarrier {
    unsigned* bar; unsigned x; int wave;
    volatile LAS unsigned* st;
};

__device__ __forceinline__ XcdBarrier xcd_barrier_post(unsigned* bar, volatile LAS unsigned* st, int wave) {
    XcdBarrier b; b.bar = bar; b.x = xb_xcc_id(); b.st = st; b.wave = wave;
    if (wave == 0 && lane_now() == 0) (void)xb_add(&bar[XB_XCNT(b.x)], 1u);
    return b;
}
__device__ __forceinline__ void xcd_barrier_complete(unsigned* bar, unsigned x, unsigned& nloc, unsigned& nx) {
    const unsigned G = gridDim.x * gridDim.y * gridDim.z;
    unsigned sum, cnt, mine, sp = 0u;
    for (;;) {
        sum = 0u; cnt = 0u; mine = 0u;
#pragma unroll
        for (unsigned j = 0; j < 16; ++j) { const unsigned c = xb_ld(&bar[XB_XCNT(j)]); sum += c; cnt += (c > 0u) ? 1u : 0u; mine = (j == x) ? c : mine; }
        if (sum == G) break;
        __builtin_amdgcn_s_sleep(1);
        if ((++sp & 255u) == 0u) { if (xb_ld(&bar[XB_TMO])) break; if (sp > XB_SPIN_CAP) { atomicAdd(&bar[XB_TMO], 1u); break; } }
    }
    nloc = mine > 0u ? mine : 1u; nx = cnt > 0u ? cnt : 1u;
}

__device__ __forceinline__ void xcd_barrier(const XcdBarrier& b) {
    asm volatile("s_waitcnt vmcnt(0)" ::: "memory");
    __syncthreads();
    if (b.wave == 0 && lane_now() == 0) {
        unsigned* bar = b.bar;
        __builtin_amdgcn_s_waitcnt(0);
        unsigned nloc = b.st[0], nx = b.st[1];
        if (nloc == 0u) { xcd_barrier_complete(bar, b.x, nloc, nx); b.st[0] = nloc; b.st[1] = nx; }
        const unsigned old = xb_add(&bar[XB_XSUB(b.x)], 1u);
        const unsigned gen = old / nloc;
        if (old + 1u == (gen + 1u) * nloc) {
            __builtin_amdgcn_fence(__ATOMIC_RELEASE, "agent");
            asm volatile("s_waitcnt vmcnt(0)" ::: "memory");
            const unsigned og = xb_add(&bar[XB_TOP], 1u);
            const unsigned tg = og / nx;
            if (og + 1u == (tg + 1u) * nx) xb_add(&bar[XB_TOPGEN], 1u);
            else XB_SPIN(xb_ld(&bar[XB_TOPGEN]) == tg, bar);
            __builtin_amdgcn_fence(__ATOMIC_ACQUIRE, "agent");
            xb_add(&bar[XB_XGEN(b.x)], 1u);
            asm volatile("s_waitcnt vmcnt(0)" ::: "memory");
        } else {
            XB_SPIN(xb_ld(&bar[XB_XGEN(b.x)]) == gen, bar);
            __builtin_amdgcn_fence(__ATOMIC_ACQUIRE, "agent");
            asm volatile("s_waitcnt vmcnt(0)" ::: "memory");
        }
    }
    __syncthreads();
}
constexpr int NWAVES = 8, NTHR = NWAVES * 64;
constexpr int BATCH = 4, SEQ = 4096, D = 1024, M = BATCH * SEQ, NIN = 5640, NPROJ = 3584, PLE = 256;
constexpr int DFF = 2816, NEXP = 8, DFFE = 3584, NLAYER = 2;
constexpr int AH = 8, AHD = 64, ABLK = 256, ANB = SEQ / ABLK;
constexpr int MH = 4, MDK = 128;
constexpr float RMS_EPS = 1e-6f;
constexpr float C2 = 0.125f * 1.4426950408889634f;
constexpr int PC_Q = 0, PC_K = 512, PC_V = 1024, PC_QKM = 1536, PC_VM = 2560, PC_OM = 3072, PC_GA = 3584, PC_GB = 4608;

constexpr size_t MiB = 1u << 20;
constexpr size_t WS_CTL = 0, CTL_ZERO_BYTES = 1 * MiB;
constexpr int NPROJX = 5888;
constexpr size_t WS_WIN = 1 * MiB, WS_WOA = 24 * MiB, WS_WOB = 26 * MiB, WS_WOUT = 28 * MiB, WS_WD13 = 32 * MiB, WS_WD2 = 43 * MiB, WS_WPG = 49 * MiB, WS_WPP = 53 * MiB, WS_PB = 54 * MiB;
constexpr size_t WS_WE = 70 * MiB;
constexpr size_t WS_SMALL = 154 * MiB;
constexpr size_t WS_XB = 161 * MiB;
constexpr size_t WS_SS0 = WS_SMALL + 5 * MiB;
constexpr size_t WS_IFPRE = WS_SMALL, WS_KMEAN = WS_SMALL + 1 * MiB, WS_GSEL = WS_SMALL + 4 * MiB;
constexpr size_t WS_HB = 161 * MiB, WS_QKC = 193 * MiB, WS_YA = 225 * MiB, WS_YB = 225 * MiB + 1024  , WS_MIXED = 257 * MiB, WS_ST = 289 * MiB, WS_PROJ = 309 * MiB, WS_END = 485 * MiB;
constexpr size_t WS_TOPI = WS_SMALL + 2 * MiB, WS_TOPG = WS_TOPI + 256 * 1024, WS_DEST = WS_TOPG + 256 * 1024, WS_ROWTOK = WS_SMALL + 3 * MiB, WS_TILEE = WS_ROWTOK + 512 * 1024, WS_NTILES = WS_TILEE + 4096;
constexpr int MOE_MAXROWS = 2 * M + NEXP * 256;
constexpr size_t WS_WE2B = 448 * MiB;
constexpr size_t WS_XG = 193 * MiB, WS_Y = 261 * MiB, WS_GHH = 329 * MiB;
static_assert(WS_XG + (size_t)MOE_MAXROWS * D * 2 <= WS_Y && WS_Y + (size_t)MOE_MAXROWS * D * 2 <= WS_GHH && WS_GHH + (size_t)MOE_MAXROWS * DFFE <= WS_END, "MoE buffers");
constexpr size_t WS_GT = WS_PROJ + (size_t)M * NPROJ * 2;
static_assert(WS_GT + (size_t)64 * MiB <= WS_END, "gate tiles inside the old proj region");
constexpr size_t WS_TMP = WS_HB;
constexpr size_t WS_GH = WS_PROJ, WS_PP = WS_PROJ;
constexpr int CW_TMO = 0, CW_CODE = 1, CW_BAR = 4096;
constexpr int CW_SS = 65536;
static_assert((CW_SS + 3 * M) * 4 <= (int)CTL_ZERO_BYTES, "SS accumulators inside the zeroed region");

constexpr int RING_OFF = 0, RING_BYTES = 131072;
constexpr int LDSCTL_OFF = RING_BYTES, MISC_OFF = LDSCTL_OFF + 320;
constexpr int LDS_BYTES = 147456;
struct Frame {
    LAS unsigned char* lds;
    volatile LAS unsigned* MISC;
    gu32* ctl;
    int wave;
    int vcu, G;
    unsigned char* ws;
};
__device__ __forceinline__ int opaque(int v) { asm volatile("" : "+v"(v)); return v; }
#define PHASE_LOCALS() const int tid = F.wave * 64 + lane_now(), lane = tid & 63; (void)lane
__device__ __forceinline__ float shx(float v, int o, int lane) { return __int_as_float(__builtin_amdgcn_ds_bpermute((lane ^ o) << 2, __float_as_int(v))); }
__device__ __forceinline__ float wave_sum(float v, int lane) {
#pragma unroll
    for (int o = 1; o < 64; o <<= 1) v += shx(v, o, lane);
    return v;
}
__device__ __forceinline__ float wave_max(float v, int lane) {
#pragma unroll
    for (int o = 1; o < 64; o <<= 1) v = fmaxf(v, shx(v, o, lane));
    return v;
}
__device__ __forceinline__ float bf2f(bf16 u) { return __uint_as_float((unsigned)u << 16); }
__device__ __forceinline__ float bflo(unsigned w) { return __uint_as_float(w << 16); }
__device__ __forceinline__ float bfhi(unsigned w) { return __uint_as_float(w & 0xffff0000u); }
__device__ __forceinline__ float sigm(float x) { return pg8::sigm(x); }

__device__ __forceinline__ void tr_item(const float* W, int ld, int K, int N, bf16* WT, int rowstep, int row_off, LAS float* scr, int item, int lane, const float* gk = nullptr, int nrows = 32) {
    const int nblk = N / 32, kb = item / nblk, nb = item % nblk, k0 = 64 * kb, n0 = 32 * nb;
#pragma unroll 32
    for (int i = 0; i < 32; ++i) { const int kk = 2 * i + (lane >> 5); scr[kk * 33 + (lane & 31)] = W[(size_t)(k0 + kk) * ld + n0 + (lane & 31)] * (gk ? gk[k0 + kk] : 1.0f); }
    LDS_WAIT(); asm volatile("" ::: "memory");
    const int c = lane & 7;
#pragma unroll
    for (int j = 0; j < 4; ++j) { const int n = (lane >> 3) + 8 * j; const LAS float* s = scr + (8 * c) * 33 + n;
        v4u o; o.x = pk2(s[0 * 33], s[1 * 33]); o.y = pk2(s[2 * 33], s[3 * 33]); o.z = pk2(s[4 * 33], s[5 * 33]); o.w = pk2(s[6 * 33], s[7 * 33]);
        const int nn = n0 + n, drow = (nn >> 7) * rowstep + (nn & 127) + row_off;
        if (n < nrows) *(GAS v4u*)(WT + (size_t)drow * K + k0 + 8 * c) = o; }
    LDS_WAIT(); asm volatile("" ::: "memory");
}
__device__ __forceinline__ void tr_tile(const float* W, int ld, int K, int ntn, bf16* WT, int rowstep, int row_off, LAS float* scr, int tile, int wave, int lane, const float* gk, bool permqk, float f8scale = 0.f) {
    const int kb = tile / ntn, nb = tile % ntn, k0 = 64 * kb, n0 = 256 * nb;
    f32x4 v[8];
#pragma unroll
    for (int i = 0; i < 8; ++i) v[i] = *(const f32x4*)(W + (size_t)(k0 + wave + 8 * i) * ld + n0 + 4 * lane);
#pragma unroll
    for (int i = 0; i < 8; ++i) { const int k = wave + 8 * i; const float g = gk ? gk[k0 + k] : 1.0f; LAS float* d = scr + k * 257 + 4 * lane; d[0] = v[i][0] * g; d[1] = v[i][1] * g; d[2] = v[i][2] * g; d[3] = v[i][3] * g; }
    __syncthreads();
    const int tid = wave * 64 + lane, c = tid & 7;
#pragma unroll
    for (int j = 0; j < 4; ++j) { const int n = (tid >> 3) + 64 * j; const LAS float* p = scr + (8 * c) * 257 + n;
        v4u o; o.x = pk2(p[0], p[257]); o.y = pk2(p[2 * 257], p[3 * 257]); o.z = pk2(p[4 * 257], p[5 * 257]); o.w = pk2(p[6 * 257], p[7 * 257]);
        const int nn = n0 + n, drow = permqk ? (nn & ~255) + (((nn >> 5) & 1) << 7) + (((nn >> 6) & 3) << 5) + (nn & 31) + row_off : (nn >> 7) * rowstep + (nn & 127) + row_off;
        if (f8scale != 0.f) { uint2 o8; int a_ = __builtin_amdgcn_cvt_pk_fp8_f32(p[0] * f8scale, p[257] * f8scale, 0, false); a_ = __builtin_amdgcn_cvt_pk_fp8_f32(p[2 * 257] * f8scale, p[3 * 257] * f8scale, a_, true);
            int b_ = __builtin_amdgcn_cvt_pk_fp8_f32(p[4 * 257] * f8scale, p[5 * 257] * f8scale, 0, false); b_ = __builtin_amdgcn_cvt_pk_fp8_f32(p[6 * 257] * f8scale, p[7 * 257] * f8scale, b_, true);
            o8.x = (unsigned)a_; o8.y = (unsigned)b_; *(uint2*)((unsigned char*)WT + (size_t)drow * K + k0 + 8 * c) = o8; }
        else *(GAS v4u*)(WT + (size_t)drow * K + k0 + 8 * c) = o; }
    __syncthreads();
}
#define TTJOBG(W_, ld_, K_, N_, WT_, rs_, ro_, gk_) if (!found) { const int I_ = ((K_) / 64) * ((N_) / 256); if (r < I_) { jb.W = (W_); jb.ld = (ld_); jb.K = (K_); jb.N = (N_); jb.WT = (WT_); jb.rowstep = (rs_); jb.row_off = (ro_); jb.gk = (gk_); jb.nrows = 32; found = true; } else r -= I_; }
struct TrJob { const float* W; int ld, K, N; bf16* WT; int rowstep, row_off; const float* gk; int nrows; };
#define TRJOBG256(W_, ld_, K_, N_, WT_, rs_, ro_, gk_, nr_) if (!found) { const int I_ = ((K_) / 64) * ((N_) / 256); if (r < I_) { jb.W = (W_); jb.ld = (ld_); jb.K = (K_); jb.N = (N_); jb.WT = (WT_); jb.rowstep = (rs_); jb.row_off = (ro_); jb.gk = (gk_); jb.nrows = (nr_); found = true; } else r -= I_; }
constexpr float WPG_F8SCALE = 32.0f, HB_F8SCALE = 16.0f;
#define TRJOBG(W_, ld_, K_, N_, WT_, rs_, ro_, gk_, nr_) if (!found) { const int I_ = ((K_) / 64) * ((N_) / 32); if (r < I_) { jb.W = (W_); jb.ld = (ld_); jb.K = (K_); jb.N = (N_); jb.WT = (WT_); jb.rowstep = (rs_); jb.row_off = (ro_); jb.gk = (gk_); jb.nrows = (nr_); found = true; } else r -= I_; }
#define TRJOB(W_, ld_, K_, N_, WT_, rs_, ro_) TRJOBG(W_, ld_, K_, N_, WT_, rs_, ro_, nullptr, 32)

struct Inputs { const float* p[25]; };
enum { I_X = 0, I_P, I_GMIX, I_WIN, I_GQ, I_GK, I_CONVW, I_CONVB, I_BI, I_BF, I_GH, I_WOA, I_WOB, I_WOUT, I_GFFN, I_WD1, I_WD3, I_WD2, I_WR, I_WE1, I_WE3, I_WE2, I_GPLE, I_WPG, I_WPP };

constexpr int PER_LAYER_T = 16 * 4 + 16 * 10 + 16 * 8 + 2 * (8 * 4) + 2 * (16 * 4) + 4 * 4, NTILES_T = 2 * PER_LAYER_T + 2 * (16 * 11) + 44 * 4, P0_URGENT = 16 * 4 + 16 * 10 + 16 * 8;
__device__ __forceinline__ void p0_tile(Frame& F, const Inputs& in, int r_in, int lane) {
    int r = r_in; bool found = false; TrJob jb;
            jb.W = nullptr; jb.ld = 0; jb.K = 64; jb.N = 256; jb.WT = nullptr; jb.rowstep = 128; jb.row_off = 0; jb.gk = nullptr; jb.nrows = 32;
#pragma unroll
            for (int l = 0; l < 2; ++l) {
                if (!found) { const int I_ = 16 * 4; if (r < I_) { jb.W = in.p[I_WIN] + (size_t)l * D * NIN; jb.ld = NIN; jb.K = D; jb.N = 1024; jb.WT = (bf16*)(F.ws + WS_WIN) + (size_t)l * NPROJX * D; jb.rowstep = 128; jb.row_off = 0; jb.gk = in.p[I_GMIX] + l * D; jb.nrows = 33; found = true; } else r -= I_; }
                TTJOBG(in.p[I_WIN] + (size_t)l * D * NIN + 1024, NIN, D, 2560, (bf16*)(F.ws + WS_WIN) + (size_t)l * NPROJX * D, 128, 1024, in.p[I_GMIX] + l * D)
                TTJOBG(in.p[I_WIN] + (size_t)l * D * NIN + 3592, NIN, D, 2048, (bf16*)(F.ws + WS_WIN) + (size_t)l * NPROJX * D, 128, 3584, in.p[I_GMIX] + l * D)
                if (!found) { const int I_ = 8 * 4; if (r < I_) { jb.W = in.p[I_WOA] + (size_t)l * 512 * D; jb.ld = D; jb.K = D; jb.N = D; jb.WT = (bf16*)(F.ws + WS_WOA) + (size_t)l * D * D; jb.rowstep = 128; jb.row_off = 0; jb.gk = nullptr; found = true; } else r -= I_; }
                if (!found) { const int I_ = 8 * 4; if (r < I_) { jb.W = in.p[I_WOB] + (size_t)l * 512 * D; jb.ld = D; jb.K = D; jb.N = D; jb.WT = (bf16*)(F.ws + WS_WOA) + (size_t)l * D * D + 512; jb.rowstep = 128; jb.row_off = 0; jb.gk = nullptr; found = true; } else r -= I_; }
                TTJOBG(in.p[I_WOUT] + (size_t)l * D * D, D, D, D, (bf16*)(F.ws + WS_WOUT) + (size_t)l * D * D, 128, 0, nullptr)
                TRJOBG256(in.p[I_WPG] + (size_t)l * D * D, D, D, D, (bf16*)(F.ws + WS_WPG) + (size_t)l * D * D, 128, 0, (l == 0) ? in.p[I_GPLE] : nullptr, (l == 0) ? 32 : 34)
                TTJOBG(in.p[I_WPP] + (size_t)l * PLE * D, D, PLE, D, (bf16*)(F.ws + WS_WPP) + (size_t)l * D * PLE, 128, 0, nullptr)
            }
            TTJOBG(in.p[I_WD1], DFF, D, DFF, (bf16*)(F.ws + WS_WD13), 256, 0, in.p[I_GFFN])
            TTJOBG(in.p[I_WD3], DFF, D, DFF, (bf16*)(F.ws + WS_WD13), 256, 128, in.p[I_GFFN])
            TTJOBG(in.p[I_WD2], D, DFF, D, (bf16*)(F.ws + WS_WD2), 128, 0, nullptr)
    if (found) tr_tile(jb.W, jb.ld, jb.K, jb.N / 256, jb.WT, jb.rowstep, jb.row_off, (LAS float*)(F.lds + RING_OFF), r, F.wave, lane, jb.gk, jb.nrows == 33, jb.nrows == 34 ? WPG_F8SCALE : 0.f);
}
constexpr int P_CHUNKS = 64;
__device__ __forceinline__ void p_chunk(Frame& F, const Inputs& in, int c, int tid) {
    const size_t n8 = (size_t)2 * M * PLE / 8, per = n8 / P_CHUNKS;
    for (size_t i = (size_t)c * per + tid; i < (size_t)(c + 1) * per; i += NTHR) {
        const f32x4 a = *(const f32x4*)(in.p[I_P] + i * 8), b = *(const f32x4*)(in.p[I_P] + i * 8 + 4);
        v4u o; o.x = pk2(a[0], a[1]); o.y = pk2(a[2], a[3]); o.z = pk2(b[0], b[1]); o.w = pk2(b[2], b[3]);
        *(v4u*)((bf16*)(F.ws + WS_PB) + i * 8) = o; }
}
__device__ __forceinline__ void p0_prologue(Frame& F, const Inputs& in, int parts = 7) {
    PHASE_LOCALS();
    LAS float* scr = (LAS float*)(F.lds + RING_OFF + F.wave * 16384);
    const int gw = F.vcu * NWAVES + F.wave, NGW = F.G * NWAVES;
    if (parts & 1) {
        for (int it = F.vcu; it < P0_URGENT; it += F.G) p0_tile(F, in, it, lane);
        for (int it = gw; it < 32; it += NGW) { const int l = it >> 4;
            tr_item(in.p[I_WIN] + (size_t)l * D * NIN + 3584, NIN, D, 32, (bf16*)(F.ws + WS_WIN) + (size_t)l * NPROJX * D, 128, 5632, scr, it & 15, lane, in.p[I_GMIX] + l * D, 8); }
    }
    if (parts & 2) { pg8::ssq_t* SS0 = (pg8::ssq_t*)(F.ws + WS_SS0); bf16* XB = (bf16*)(F.ws + WS_XB);
      for (int m = gw; m < M; m += NGW) { const f32x4* xr = (const f32x4*)(in.p[I_X] + (size_t)m * D) + lane; unsigned long long* o8 = (unsigned long long*)(XB + (size_t)m * D) + lane; float ss = 0.f;
#pragma unroll
          for (int j = 0; j < 4; ++j) { const f32x4 v = xr[64 * j]; ss += (v[0] * v[0] + v[1] * v[1]) + (v[2] * v[2] + v[3] * v[3]); o8[64 * j] = (unsigned long long)pk2(v[0], v[1]) | ((unsigned long long)pk2(v[2], v[3]) << 32); }
          ss = wave_sum(ss, lane); if (lane == 0) SS0[m] = pg8::ss_fix(ss); } }
}
__device__ __forceinline__ void p_conv_expert(Frame& F, const Inputs& in, int e) {
    PHASE_LOCALS();
    LAS float* scr = (LAS float*)(F.lds + RING_OFF + F.wave * 16384);
    const int gw = F.vcu * NWAVES + F.wave, NGW = F.G * NWAVES;
    constexpr int NITEMS = 2 * (16 * 112) + 56 * 32;
    bf16* W13 = (bf16*)(F.ws + WS_WE); bf16* W2 = W13 + (size_t)2 * DFFE * D;
    for (int it = gw; it < NITEMS; it += NGW) {
        int r = it; bool found = false; TrJob jb;
        jb.W = nullptr; jb.ld = 0; jb.K = 64; jb.N = 32; jb.WT = nullptr; jb.rowstep = 128; jb.row_off = 0; jb.gk = nullptr; jb.nrows = 32;
        TRJOB(in.p[I_WE1] + (size_t)e * D * DFFE, DFFE, D, DFFE, W13, 256, 0)
        TRJOB(in.p[I_WE3] + (size_t)e * D * DFFE, DFFE, D, DFFE, W13, 256, 128)
        TRJOB(in.p[I_WE2] + (size_t)e * DFFE * D, D, DFFE, D, W2, 128, 0)
        if (found) tr_item(jb.W, jb.ld, jb.K, jb.N, jb.WT, jb.rowstep, jb.row_off, scr, r, lane, jb.gk, jb.nrows);
    }
}

typedef unsigned v2u_ __attribute__((ext_vector_type(2))); typedef float v2f_ __attribute__((ext_vector_type(2))); typedef int v2i_ __attribute__((ext_vector_type(2)));
template <int MODE>
__device__ __forceinline__ void phase_norm(Frame& F, const float* xsrc, const float* g, bf16* hb, const float* wx, int ldw, const float* b_i, const float* b_f, float* ifpre, float* gsel) {
    PHASE_LOCALS();
    LAS float* wl = (LAS float*)F.lds;
    if (MODE == 1 || MODE == 2) {
        for (int i = tid; i < 1024 * 2; i += NTHR) { const int c = i >> 1, hlf = i & 1; *(LAS f32x4*)(wl + c * 8 + 4 * hlf) = *(const f32x4*)(wx + (size_t)c * ldw + 4 * hlf); }
        __syncthreads();
    }
    const int gw = F.vcu * NWAVES + F.wave, NGW = F.G * NWAVES;
    f32x4 gv[4];
#pragma unroll
    for (int j = 0; j < 4; ++j) gv[j] = ((const GAS f32x4*)g)[lane + 64 * j];
    f32x4 vn[4]; uint2 yan[4], ybn[4]; float2 tgn = make_float2(0.f, 0.f), tgc = tgn; int2 tdn = make_int2(0, 0);
#pragma unroll
    for (int j = 0; j < 4; ++j) { vn[j] = (f32x4){0.f, 0.f, 0.f, 0.f}; yan[j] = make_uint2(0u, 0u); ybn[j] = make_uint2(0u, 0u); }
    if (gw < M) {
        if (MODE == 3) { { const v2f_ t_ = *(const GAS v2f_*)((const GAS float*)(F.ws + WS_TOPG) + (size_t)gw * 2); tgc = make_float2(t_.x, t_.y); } const v2i_ td0 = *(const GAS v2i_*)((const GAS int*)(F.ws + WS_DEST) + (size_t)gw * 2);
            const GAS bf16* y1 = (const GAS bf16*)(F.ws + WS_Y) + (size_t)td0.x * D; const GAS bf16* y2 = (const GAS bf16*)(F.ws + WS_Y) + (size_t)td0.y * D;
#pragma unroll
            for (int j = 0; j < 4; ++j) { { const v2u_ a_ = *(const GAS v2u_*)(y1 + 4 * lane + 256 * j), b_ = *(const GAS v2u_*)(y2 + 4 * lane + 256 * j); yan[j] = make_uint2(a_.x, a_.y); ybn[j] = make_uint2(b_.x, b_.y); } }
            if (gw + NGW < M) { { const v2f_ t_ = *(const GAS v2f_*)((const GAS float*)(F.ws + WS_TOPG) + (size_t)(gw + NGW) * 2); tgn = make_float2(t_.x, t_.y); const v2i_ d_ = *(const GAS v2i_*)((const GAS int*)(F.ws + WS_DEST) + (size_t)(gw + NGW) * 2); tdn = make_int2(d_.x, d_.y); } } }
#pragma unroll
        for (int j = 0; j < 4; ++j) vn[j] = ((const GAS f32x4*)((const GAS float*)xsrc + (size_t)gw * D) + lane)[64 * j];
    }
    for (int m = gw; m < M; m += NGW) {
        f32x4 v[4]; uint2 ya[4], yb[4]; float s = 0.f; const float2 tg = tgc;
#pragma unroll
        for (int j = 0; j < 4; ++j) { v[j] = vn[j]; ya[j] = yan[j]; yb[j] = ybn[j]; }
        if (m + NGW < M) {
            const int mn = m + NGW;
            if (MODE == 3) { tgc = tgn; const GAS bf16* y1 = (const GAS bf16*)(F.ws + WS_Y) + (size_t)tdn.x * D; const GAS bf16* y2 = (const GAS bf16*)(F.ws + WS_Y) + (size_t)tdn.y * D;
#pragma unroll
                for (int j = 0; j < 4; ++j) { { const v2u_ a_ = *(const GAS v2u_*)(y1 + 4 * lane + 256 * j), b_ = *(const GAS v2u_*)(y2 + 4 * lane + 256 * j); yan[j] = make_uint2(a_.x, a_.y); ybn[j] = make_uint2(b_.x, b_.y); } }
                if (mn + NGW < M) { { const v2f_ t_ = *(const GAS v2f_*)((const GAS float*)(F.ws + WS_TOPG) + (size_t)(mn + NGW) * 2); tgn = make_float2(t_.x, t_.y); const v2i_ d_ = *(const GAS v2i_*)((const GAS int*)(F.ws + WS_DEST) + (size_t)(mn + NGW) * 2); tdn = make_int2(d_.x, d_.y); } } }
#pragma unroll
            for (int j = 0; j < 4; ++j) vn[j] = ((const GAS f32x4*)((const GAS float*)xsrc + (size_t)mn * D) + lane)[64 * j];
        }
        if (MODE == 3) {
#pragma unroll
            for (int j = 0; j < 4; ++j) { const uint2 a = ya[j], b = yb[j];
                v[j][0] += tg.x * bflo(a.x) + tg.y * bflo(b.x); v[j][1] += tg.x * bfhi(a.x) + tg.y * bfhi(b.x); v[j][2] += tg.x * bflo(a.y) + tg.y * bflo(b.y); v[j][3] += tg.x * bfhi(a.y) + tg.y * bfhi(b.y);
                ((GAS f32x4*)((GAS float*)const_cast<float*>(xsrc) + (size_t)m * D))[lane + 64 * j] = v[j]; }
        }
#pragma unroll
        for (int j = 0; j < 4; ++j) s += (v[j][0] * v[j][0] + v[j][1] * v[j][1]) + (v[j][2] * v[j][2] + v[j][3] * v[j][3]);
        const float rstd = 1.0f / sqrtf(wave_sum(s, lane) * (1.0f / D) + RMS_EPS);
        GAS unsigned long long* o8 = (GAS unsigned long long*)((GAS bf16*)hb + (size_t)m * D) + lane;
#pragma unroll
        for (int j = 0; j < 4; ++j) { v[j] = v[j] * rstd * gv[j];
            if (MODE == 3) {
                int a_ = __builtin_amdgcn_cvt_pk_fp8_f32(__builtin_amdgcn_fmed3f(v[j][0] * HB_F8SCALE, -448.0f, 448.0f), __builtin_amdgcn_fmed3f(v[j][1] * HB_F8SCALE, -448.0f, 448.0f), 0, false);
                a_ = __builtin_amdgcn_cvt_pk_fp8_f32(__builtin_amdgcn_fmed3f(v[j][2] * HB_F8SCALE, -448.0f, 448.0f), __builtin_amdgcn_fmed3f(v[j][3] * HB_F8SCALE, -448.0f, 448.0f), a_, true);
                ((GAS unsigned*)((GAS unsigned char*)hb + (size_t)m * D))[lane + 64 * j] = (unsigned)a_; }
            else o8[64 * j] = (unsigned long long)pk2(v[j][0], v[j][1]) | ((unsigned long long)pk2(v[j][2], v[j][3]) << 32); }
        if (MODE == 1 || MODE == 2) {
            float a[8];
#pragma unroll
            for (int k = 0; k < 8; ++k) a[k] = 0.f;
#pragma unroll
            for (int j = 0; j < 4; ++j)
#pragma unroll
                for (int q = 0; q < 4; ++q) { const int c = 4 * lane + 256 * j + q; const f32x4 w0 = *(const LAS f32x4*)(wl + c * 8), w1 = *(const LAS f32x4*)(wl + c * 8 + 4); const float y = v[j][q];
                    a[0] += y * w0[0]; a[1] += y * w0[1]; a[2] += y * w0[2]; a[3] += y * w0[3]; a[4] += y * w1[0]; a[5] += y * w1[1]; a[6] += y * w1[2]; a[7] += y * w1[3]; }
#pragma unroll
            for (int k = 0; k < 8; ++k) a[k] = wave_sum(a[k], lane);
            if (MODE == 1) {
                if (lane == 0) {
                    f32x4 o0 = {a[0] + b_i[0], a[1] + b_i[1], a[2] + b_i[2], a[3] + b_i[3]}, o1 = {a[4] + b_f[0], a[5] + b_f[1], a[6] + b_f[2], a[7] + b_f[3]};
                    *(f32x4*)(ifpre + (size_t)m * 8) = o0; *(f32x4*)(ifpre + (size_t)m * 8 + 4) = o1; }
            } else {
                int i1 = 0; float v1 = a[0];
#pragma unroll
                for (int k = 1; k < 8; ++k) if (a[k] > v1) { v1 = a[k]; i1 = k; }
                int i2 = -1; float v2 = -INFINITY;
#pragma unroll
                for (int k = 0; k < 8; ++k) if (k != i1 && a[k] > v2) { v2 = a[k]; i2 = k; }
                const float g1 = 1.0f / (1.0f + expf(v2 - v1)), g2 = 1.0f - g1;
                if (lane < 8) ((GAS float*)gsel)[(size_t)m * 8 + lane] = (lane == i1) ? g1 : (lane == i2) ? g2 : 0.f;
                if (lane == 0) { *(GAS v2i_*)((GAS int*)(F.ws + WS_TOPI) + (size_t)m * 2) = (v2i_){i1, i2}; *(GAS v2f_*)((GAS float*)(F.ws + WS_TOPG) + (size_t)m * 2) = (v2f_){g1, g2}; }
            }
        }
    }
    if (MODE == 1 || MODE == 2) __syncthreads();
}

__device__ __forceinline__ void phase_prep(Frame& F, const Inputs& in, int l, int parts = 3) {
    PHASE_LOCALS();
    bf16* PROJ = (bf16*)(F.ws + WS_PROJ); float* kmean = (float*)(F.ws + WS_KMEAN); bf16* QKC = (bf16*)(F.ws + WS_QKC);
    const float* gq = in.p[I_GQ] + l * AHD; const float* gk = in.p[I_GK] + l * AHD;
    LAS float* kt = (LAS float*)F.lds; LAS float* part = kt + 256 * 65;
    if (parts & 1) for (int u = F.vcu; u < (M / 256) * AH; u += F.G) {
        const int pm = u >> 3, h = u & 7, row = tid >> 1, hf = tid & 1; const size_t grow = (size_t)pm * 256 + row;
#pragma unroll
        for (int which = 0; which < 2; ++which) {
            bf16* ptr = PROJ + grow * NPROJ + (which ? PC_K : PC_Q) + h * AHD + hf * 32; const float* gg = (which ? gk : gq) + hf * 32;
            bf16* optr = (parts & 4) ? (bf16*)(F.ws + WS_MIXED) + (grow & 255) * NPROJ + (which ? PC_K : PC_Q) + h * AHD + hf * 32 : ptr;
            float v[32]; float ss = 0.f;
#pragma unroll
            for (int i = 0; i < 4; ++i) { const v4u w = *(const v4u*)(ptr + 8 * i);
                v[8 * i + 0] = bflo(w.x); v[8 * i + 1] = bfhi(w.x); v[8 * i + 2] = bflo(w.y); v[8 * i + 3] = bfhi(w.y); v[8 * i + 4] = bflo(w.z); v[8 * i + 5] = bfhi(w.z); v[8 * i + 6] = bflo(w.w); v[8 * i + 7] = bfhi(w.w); }
#pragma unroll
            for (int i = 0; i < 32; ++i) ss += v[i] * v[i];
            ss += shx(ss, 1, lane);
            const float r = (1.0f / sqrtf(ss * (1.0f / AHD) + RMS_EPS)) * (which ? 1.0f : C2);
#pragma unroll
            for (int i = 0; i < 32; ++i) v[i] = v[i] * r * gg[i];
            if (which) {
#pragma unroll
                for (int i = 0; i < 32; ++i) kt[row * 65 + hf * 32 + i] = v[i]; }
#pragma unroll
            for (int i = 0; i < 4; ++i) { v4u o; o.x = pk2(v[8 * i], v[8 * i + 1]); o.y = pk2(v[8 * i + 2], v[8 * i + 3]); o.z = pk2(v[8 * i + 4], v[8 * i + 5]); o.w = pk2(v[8 * i + 6], v[8 * i + 7]); *(v4u*)(optr + 8 * i) = o; }
        }
        __syncthreads();
        { const int c = tid & 63, pt = tid >> 6; float s = 0.f;
            for (int i = 0; i < 32; ++i) s += kt[(pt * 32 + i) * 65 + c];
            part[pt * 64 + c] = s; }
        __syncthreads();
        if (tid < 64) { float tot = 0.f;
#pragma unroll
            for (int pt = 0; pt < 8; ++pt) tot += part[pt * 64 + tid];
            const int b = pm >> 4, n = pm & 15;
            ((parts & 4) ? (float*)(F.ws + WS_MIXED) + 4 * 1024 * 1024 : kmean)[(((size_t)(b * AH + h)) * ANB + n) * AHD + tid] = tot * (1.0f / ABLK); }
        __syncthreads();
    }
    if (parts & 2) {
        const float* cw = in.p[I_CONVW] + (size_t)l * 4 * 1024; const float* cb = in.p[I_CONVB] + (size_t)l * 1024;
        const int ch = tid & 127, c0 = ch * 8; const float sc = (c0 >= 512) ? 0.08838834764831845f : 1.0f;
        float w[4][8], bia[8];
#pragma unroll
        for (int j = 0; j < 4; ++j) { const f32x4 w0 = *(const f32x4*)(cw + j * 1024 + c0), w1 = *(const f32x4*)(cw + j * 1024 + c0 + 4);
            w[j][0] = w0[0]; w[j][1] = w0[1]; w[j][2] = w0[2]; w[j][3] = w0[3]; w[j][4] = w1[0]; w[j][5] = w1[1]; w[j][6] = w1[2]; w[j][7] = w1[3]; }
        { const f32x4 b0 = *(const f32x4*)(cb + c0), b1 = *(const f32x4*)(cb + c0 + 4); bia[0] = b0[0]; bia[1] = b0[1]; bia[2] = b0[2]; bia[3] = b0[3]; bia[4] = b1[0]; bia[5] = b1[1]; bia[6] = b1[2]; bia[7] = b1[3]; }
        for (int run = F.vcu * 4 + (tid >> 7); run < M / 16; run += F.G * 4) {
            const int r0 = run * 16, t0 = r0 & (SEQ - 1);
            v4u xin[19];
#pragma unroll
            for (int i = 0; i < 19; ++i) { xin[i] = (v4u){0u, 0u, 0u, 0u}; if (i >= 3 || t0 > 0) xin[i] = *(const v4u*)(PROJ + (size_t)(r0 - 3 + i) * NPROJ + PC_QKM + c0); }
#pragma unroll
            for (int i = 0; i < 16; ++i) { float a[8];
#pragma unroll
                for (int k = 0; k < 8; ++k) a[k] = bia[k];
#pragma unroll
                for (int j = 0; j < 4; ++j) { const v4u x = xin[i + j];
                    a[0] += w[j][0] * bflo(x.x); a[1] += w[j][1] * bfhi(x.x); a[2] += w[j][2] * bflo(x.y); a[3] += w[j][3] * bfhi(x.y); a[4] += w[j][4] * bflo(x.z); a[5] += w[j][5] * bfhi(x.z); a[6] += w[j][6] * bflo(x.w); a[7] += w[j][7] * bfhi(x.w); }
#pragma unroll
                for (int k = 0; k < 8; ++k) a[k] = a[k] * sigm(a[k]) * sc;
                v4u o; o.x = pk2(a[0], a[1]); o.y = pk2(a[2], a[3]); o.z = pk2(a[4], a[5]); o.w = pk2(a[6], a[7]);
                *(v4u*)(QKC + (size_t)(r0 + i) * 1024 + c0) = o; }
        }
    }
}

__device__ __forceinline__ float dot64(const bf16* kr, const float (&q)[64]) {
    float a = 0.f;
#pragma unroll
    for (int i = 0; i < 8; ++i) { const v4u w = *(const v4u*)(kr + 8 * i);
        a += q[8 * i] * bflo(w.x) + q[8 * i + 1] * bfhi(w.x) + q[8 * i + 2] * bflo(w.y) + q[8 * i + 3] * bfhi(w.y) + q[8 * i + 4] * bflo(w.z) + q[8 * i + 5] * bfhi(w.z) + q[8 * i + 6] * bflo(w.w) + q[8 * i + 7] * bfhi(w.w); }
    return a;
}
__device__ __forceinline__ void phase_attn_naive(Frame& F) {
    const bf16* PROJ = (const bf16*)(F.ws + WS_PROJ); const float* kmean = (const float*)(F.ws + WS_KMEAN); bf16* YA = (bf16*)(F.ws + WS_YA);
    LAS float* sc = (LAS float*)F.lds + F.wave * 1088; LAS float* qs = sc + 1024;
    const int gw = F.vcu * NWAVES + F.wave, NGW = F.G * NWAVES, lane = lane_now();
    for (int item = gw; item < BATCH * AH * SEQ; item += NGW) {
        const int q = item & (SEQ - 1), bh = item >> 12, b = bh >> 3, h = bh & 7, blk = q >> 8;
        const size_t rb = (size_t)b * SEQ;
        qs[lane] = bf2f(PROJ[(rb + q) * NPROJ + PC_Q + h * AHD + lane]);
        asm volatile("s_waitcnt lgkmcnt(0)" ::: "memory");
        float qr[64];
#pragma unroll
        for (int i = 0; i < 16; ++i) { const f32x4 t = *(const LAS f32x4*)(qs + 4 * i); qr[4 * i] = t[0]; qr[4 * i + 1] = t[1]; qr[4 * i + 2] = t[2]; qr[4 * i + 3] = t[3]; }
        float gv = -INFINITY;
        if (lane < blk) { const float* km = kmean + ((size_t)bh * ANB + lane) * AHD; float a = 0.f;
#pragma unroll
            for (int i = 0; i < 16; ++i) { const f32x4 t = *(const f32x4*)(km + 4 * i); a += qr[4 * i] * t[0] + qr[4 * i + 1] * t[1] + qr[4 * i + 2] * t[2] + qr[4 * i + 3] * t[3]; }
            gv = a; }
        unsigned selmask = 0u;
        for (int s = 0; s < 3 && s < blk; ++s) { const float mx = wave_max(gv, lane); const unsigned long long bal = __ballot(gv == mx && lane < blk); const int idx = __ffsll((long long)bal) - 1;
            selmask |= 1u << idx; if (lane == idx) gv = -INFINITY; }
        int slot = 0;
        for (int n = 0; n < blk; ++n) if ((selmask >> n) & 1u) {
#pragma unroll
            for (int jj = 0; jj < 4; ++jj) { const int key = n * ABLK + lane + 64 * jj; sc[slot * 256 + lane + 64 * jj] = dot64(PROJ + (rb + key) * NPROJ + PC_K + h * AHD, qr); }
            ++slot; }
#pragma unroll
        for (int jj = 0; jj < 4; ++jj) { const int key = blk * ABLK + lane + 64 * jj; const float a = dot64(PROJ + (rb + key) * NPROJ + PC_K + h * AHD, qr); sc[slot * 256 + lane + 64 * jj] = (key > q) ? -INFINITY : a; }
        const int ntot = (slot + 1) * 256;
        asm volatile("s_waitcnt lgkmcnt(0)" ::: "memory");
        float mx = -INFINITY; for (int i = lane; i < ntot; i += 64) mx = fmaxf(mx, sc[i]); mx = wave_max(mx, lane);
        float sum = 0.f; for (int i = lane; i < ntot; i += 64) { const float p = pg8::ex2(sc[i] - mx); sc[i] = p; sum += p; } sum = wave_sum(sum, lane);
        asm volatile("s_waitcnt lgkmcnt(0)" ::: "memory");
        float o = 0.f; slot = 0;
        for (int n = 0; n < blk; ++n) if ((selmask >> n) & 1u) { const bf16* vp = PROJ + (rb + n * ABLK) * NPROJ + PC_V + h * AHD + lane;
            for (int j = 0; j < 256; ++j) o += sc[slot * 256 + j] * bf2f(vp[(size_t)j * NPROJ]);
            ++slot; }
        { const bf16* vp = PROJ + (rb + blk * ABLK) * NPROJ + PC_V + h * AHD + lane; const int je = q - blk * ABLK;
            for (int j = 0; j <= je; ++j) o += sc[slot * 256 + j] * bf2f(vp[(size_t)j * NPROJ]); }
        YA[(rb + q) * 1024 + h * AHD + lane] = (bf16)f2bf(o / sum);
        asm volatile("s_waitcnt lgkmcnt(0)" ::: "memory");
    }
}

__device__ __forceinline__ void phase_mlstm_naive(Frame& F, const Inputs& in, int l) {
    if (blockIdx.x >= BATCH * MH) return;
    const bf16* PROJ = (const bf16*)(F.ws + WS_PROJ); const bf16* QKC = (const bf16*)(F.ws + WS_QKC); const float* ifpre = (const float*)(F.ws + WS_IFPRE); bf16* YB = (bf16*)(F.ws + WS_YB);
    const float* gh = in.p[I_GH] + l * MDK;
    const int bh = blockIdx.x, b = bh >> 2, h = bh & 3, tid = F.wave * 64 + lane_now(), lane = tid & 63, e = tid & 127, g = tid >> 7;
    LAS float* qs = (LAS float*)F.lds; LAS float* ks = qs + 16 * 128; LAS float* vs = ks + 16 * 128; LAS float* red = vs + 16 * 128; LAS float* redd = red + 16 * 4 * 128;
    LAS float* gi = redd + 64; LAS float* gf = gi + 16; LAS float* ms = gf + 16;
    float C[32], nn[32];
#pragma unroll
    for (int i = 0; i < 32; ++i) { C[i] = 0.f; nn[i] = 0.f; }
    float m = 0.f;
    for (int t0 = 0; t0 < SEQ; t0 += 16) {
        for (int i = tid; i < 16 * 128; i += NTHR) { const int st = i >> 7, d = i & 127; const size_t r = (size_t)b * SEQ + t0 + st;
            qs[i] = bf2f(QKC[r * 1024 + h * MDK + d]); ks[i] = bf2f(QKC[r * 1024 + 512 + h * MDK + d]); vs[i] = bf2f(PROJ[r * NPROJ + PC_VM + h * MDK + d]); }
        if (tid < 16) { const size_t r = (size_t)b * SEQ + t0 + tid; gi[tid] = ifpre[r * 8 + h]; const float x = ifpre[r * 8 + 4 + h]; gf[tid] = fminf(x, 0.f) - log1pf(expf(-fabsf(x))); }
        __syncthreads();
        for (int st = 0; st < 16; ++st) {
            const float li = gi[st], lf = gf[st], mn = fmaxf(lf + m, li), wC = expf(lf + m - mn), wS = expf(li - mn); m = mn;
            const float ve = vs[st * 128 + e]; float pn = 0.f, pd = 0.f;
#pragma unroll
            for (int i4 = 0; i4 < 8; ++i4) { const f32x4 k4 = *(const LAS f32x4*)(ks + st * 128 + 32 * g + 4 * i4), q4 = *(const LAS f32x4*)(qs + st * 128 + 32 * g + 4 * i4);
#pragma unroll
                for (int j = 0; j < 4; ++j) { const int i = 4 * i4 + j; const float kd = wS * k4[j]; C[i] = wC * C[i] + kd * ve; nn[i] = wC * nn[i] + kd; pn += q4[j] * C[i]; pd += q4[j] * nn[i]; } }
            red[(st * 4 + g) * 128 + e] = pn; if (e == 0) redd[st * 4 + g] = pd; if (tid == 0) ms[st] = mn;
        }
        __syncthreads();
#pragma unroll
        for (int s2 = 0; s2 < 2; ++s2) { const int st = 2 * F.wave + s2; const float den = (redd[st * 4] + redd[st * 4 + 1]) + (redd[st * 4 + 2] + redd[st * 4 + 3]);
            const float dn = 1.0f / fmaxf(fabsf(den), expf(-ms[st]));
            const float h0 = ((red[(st * 4) * 128 + lane] + red[(st * 4 + 1) * 128 + lane]) + (red[(st * 4 + 2) * 128 + lane] + red[(st * 4 + 3) * 128 + lane])) * dn;
            const float h1 = ((red[(st * 4) * 128 + 64 + lane] + red[(st * 4 + 1) * 128 + 64 + lane]) + (red[(st * 4 + 2) * 128 + 64 + lane] + red[(st * 4 + 3) * 128 + 64 + lane])) * dn;
            const float rr = 1.0f / sqrtf(wave_sum(h0 * h0 + h1 * h1, lane) * (1.0f / MDK) + RMS_EPS);
            const size_t r = (size_t)b * SEQ + t0 + st;
            const float o0 = sigm(bf2f(PROJ[r * NPROJ + PC_OM + h * MDK + lane])), o1 = sigm(bf2f(PROJ[r * NPROJ + PC_OM + h * MDK + 64 + lane]));
            YB[r * 1024 + h * MDK + lane] = (bf16)f2bf(h0 * rr * gh[lane] * o0); YB[r * 1024 + h * MDK + 64 + lane] = (bf16)f2bf(h1 * rr * gh[64 + lane] * o1); }
        __syncthreads();
    }
}
typedef short bf16x8s __attribute__((ext_vector_type(8)));
typedef short s16x4 __attribute__((ext_vector_type(4)));
typedef float f32x16 __attribute__((ext_vector_type(16)));
constexpr size_t ST_DCT = WS_ST, ST_DN = WS_ST + 16 * MiB, ST_NIN = ST_DN + 128 * 1024, ST_MLOC = ST_NIN + 128 * 1024, ST_BL = ST_MLOC + 4096, ST_MIN = ST_BL + 4096;
constexpr size_t ST_CINT = WS_MIXED;
constexpr int SM_OFF = LDSCTL_OFF + 1024;
__device__ __forceinline__ unsigned off_b(unsigned row, unsigned ch) { return 256u * row + 16u * (ch ^ (((row & 3u) << 2) | ((row >> 2) & 3u))); }
__device__ __forceinline__ s16x4 vtr(const LAS unsigned char* p) { return __builtin_bit_cast(s16x4, __builtin_amdgcn_ds_read_tr16_b64_v4i16((LAS s16x4*)p)); }
__device__ __forceinline__ int crow(int r, int hi) { return (r & 3) + 8 * (r >> 2) + 4 * hi; }
__device__ __forceinline__ float shu(float v, int o, int lane) { return __int_as_float(__builtin_amdgcn_ds_bpermute((lane - o) << 2, __float_as_int(v))); }
__device__ __forceinline__ float shl(float v, int src) { return __int_as_float(__builtin_amdgcn_ds_bpermute(src << 2, __float_as_int(v))); }
__device__ __forceinline__ float logsig(float x) { return fminf(x, 0.f) - log1pf(expf(-fabsf(x))); }
__device__ __forceinline__ bf16x8s tr_frag(const LAS unsigned char* img, int lane, int row0, int c) {
    const unsigned h = lane >> 5, blk = (lane >> 4) & 1, q = (lane & 15) >> 2, p = lane & 3;
    const s16x4 lo = vtr(img + off_b(row0 + 8 * h + q, 4 * c + 2 * blk + (p >> 1)) + 8 * (p & 1)), hi = vtr(img + off_b(row0 + 8 * h + 4 + q, 4 * c + 2 * blk + (p >> 1)) + 8 * (p & 1));
    return (bf16x8s){lo[0], lo[1], lo[2], lo[3], hi[0], hi[1], hi[2], hi[3]};
}
__device__ __forceinline__ bf16x8s tr_frag_perm(const LAS unsigned char* img, int lane, int row0, int c) {
    const unsigned h = lane >> 5, blk = (lane >> 4) & 1, q = (lane & 15) >> 2, p = lane & 3;
    const s16x4 lo = vtr(img + off_b(row0 + 4 * h + q, 4 * c + 2 * blk + (p >> 1)) + 8 * (p & 1)), hi = vtr(img + off_b(row0 + 8 + 4 * h + q, 4 * c + 2 * blk + (p >> 1)) + 8 * (p & 1));
    return (bf16x8s){lo[0], lo[1], lo[2], lo[3], hi[0], hi[1], hi[2], hi[3]};
}
__device__ __forceinline__ void chunk_gates(const float* ifpre, size_t row0, int h, int lane, float (&bc)[4], float (&ii)[4], float& bL) {
#pragma unroll
    for (int k = 0; k < 4; ++k) { const size_t r = row0 + 4 * lane + k; ii[k] = ifpre[r * 8 + h]; bc[k] = logsig(ifpre[r * 8 + 4 + h]); }
    bc[1] += bc[0]; bc[2] += bc[1]; bc[3] += bc[2];
    float inc = bc[3];
#pragma unroll
    for (int o = 1; o < 64; o <<= 1) { const float t = shu(inc, o, lane); if (lane >= o) inc += t; }
    const float excl = inc - bc[3];
#pragma unroll
    for (int k = 0; k < 4; ++k) bc[k] += excl;
    bL = shl(inc, 63);
}

__device__ __forceinline__ void phase_mlstm_m1(Frame& F, const Inputs& in, int l) {
    PHASE_LOCALS();
    const bf16* PROJ = (const bf16*)(F.ws + WS_PROJ); bf16* QKC = (bf16*)(F.ws + WS_QKC); const float* ifpre = (const float*)(F.ws + WS_IFPRE);
    float* dCT = (float*)(F.ws + ST_DCT); float* DN = (float*)(F.ws + ST_DN); float* MLOC = (float*)(F.ws + ST_MLOC); float* BL = (float*)(F.ws + ST_BL);
    LAS unsigned char* Kimg = F.lds; LAS unsigned char* Vimg = F.lds + 65536; LAS float* sw = (LAS float*)(F.lds + SM_OFF);
    const int r32 = lane & 31, hi = lane >> 5;
    for (int unit = F.vcu; unit < BATCH * MH * 16; unit += F.G) {
        const int bh = unit >> 4, c = unit & 15, b = bh >> 2, h = bh & 3; const size_t row0 = (size_t)b * SEQ + c * 256;
        { const float* cw = in.p[I_CONVW] + (size_t)l * 4 * 1024; const float* cb = in.p[I_CONVB] + (size_t)l * 1024;
          const int cc = tid & 31, c0 = (cc < 16 ? 0 : 512) + h * MDK + 8 * (cc & 15), run = tid >> 5; const float sc = (cc >= 16) ? 0.08838834764831845f : 1.0f;
          float w[4][8], bia[8];
#pragma unroll
          for (int j = 0; j < 4; ++j) { const f32x4 w0 = *(const f32x4*)(cw + j * 1024 + c0), w1 = *(const f32x4*)(cw + j * 1024 + c0 + 4);
              w[j][0] = w0[0]; w[j][1] = w0[1]; w[j][2] = w0[2]; w[j][3] = w0[3]; w[j][4] = w1[0]; w[j][5] = w1[1]; w[j][6] = w1[2]; w[j][7] = w1[3]; }
          { const f32x4 b0 = *(const f32x4*)(cb + c0), b1 = *(const f32x4*)(cb + c0 + 4); bia[0] = b0[0]; bia[1] = b0[1]; bia[2] = b0[2]; bia[3] = b0[3]; bia[4] = b1[0]; bia[5] = b1[1]; bia[6] = b1[2]; bia[7] = b1[3]; }
          const size_t r0 = row0 + 16 * run; const bool first = (c == 0 && run == 0);
          v4u xin[19];
#pragma unroll
          for (int i = 0; i < 19; ++i) { xin[i] = (v4u){0u, 0u, 0u, 0u}; if (i >= 3 || !first) xin[i] = *(const v4u*)(PROJ + (r0 - 3 + i) * NPROJ + PC_QKM + c0); }
#pragma unroll
          for (int i = 0; i < 16; ++i) { float a[8];
#pragma unroll
              for (int k = 0; k < 8; ++k) a[k] = bia[k];
#pragma unroll
              for (int j = 0; j < 4; ++j) { const v4u x = xin[i + j];
                  a[0] += w[j][0] * bflo(x.x); a[1] += w[j][1] * bfhi(x.x); a[2] += w[j][2] * bflo(x.y); a[3] += w[j][3] * bfhi(x.y); a[4] += w[j][4] * bflo(x.z); a[5] += w[j][5] * bfhi(x.z); a[6] += w[j][6] * bflo(x.w); a[7] += w[j][7] * bfhi(x.w); }
#pragma unroll
              for (int k = 0; k < 8; ++k) a[k] = a[k] * sigm(a[k]) * sc;
              v4u o; o.x = pk2(a[0], a[1]); o.y = pk2(a[2], a[3]); o.z = pk2(a[4], a[5]); o.w = pk2(a[6], a[7]);
              *(v4u*)(QKC + (r0 + i) * 1024 + c0) = o; } }
        if (F.wave == 0) {
            float bc[4], ii[4], bL; chunk_gates(ifpre, row0, h, lane, bc, ii, bL);
            float g[4]; float mx = -INFINITY;
#pragma unroll
            for (int k = 0; k < 4; ++k) { g[k] = bL - bc[k] + ii[k]; mx = fmaxf(mx, g[k]); }
            mx = wave_max(mx, lane);
#pragma unroll
            for (int k = 0; k < 4; ++k) sw[4 * lane + k] = pg8::ex2((g[k] - mx) * 1.4426950408889634f);
            if (lane == 0) { MLOC[unit] = mx; BL[unit] = bL; }
        }
        asm volatile("s_waitcnt vmcnt(0)" ::: "memory");
        __syncthreads();
        for (int i = tid; i < 4096; i += NTHR) { const int s = i >> 4, ch = i & 15; const float w = sw[s];
            const v4u kv = *(const v4u*)(QKC + (row0 + s) * 1024 + 512 + h * MDK + 8 * ch);
            v4u ko; ko.x = pk2(bflo(kv.x) * w, bfhi(kv.x) * w); ko.y = pk2(bflo(kv.y) * w, bfhi(kv.y) * w); ko.z = pk2(bflo(kv.z) * w, bfhi(kv.z) * w); ko.w = pk2(bflo(kv.w) * w, bfhi(kv.w) * w);
            *(LAS v4u*)(Kimg + off_b(s, ch)) = ko;
            *(LAS v4u*)(Vimg + off_b(s, ch)) = *(const v4u*)(PROJ + (row0 + s) * NPROJ + PC_VM + h * MDK + 8 * ch); }
        __syncthreads();
        const int dt = F.wave >> 1, c0 = 2 * (F.wave & 1);
        f32x16 acc0, acc1;
#pragma unroll
        for (int i = 0; i < 16; ++i) { acc0[i] = 0.f; acc1[i] = 0.f; }
#pragma unroll 4
        for (int ks = 0; ks < 16; ++ks) {
            const bf16x8s a = tr_frag(Kimg, lane, 16 * ks, dt), b0 = tr_frag(Vimg, lane, 16 * ks, c0), b1 = tr_frag(Vimg, lane, 16 * ks, c0 + 1);
            acc0 = __builtin_amdgcn_mfma_f32_32x32x16_bf16(a, b0, acc0, 0, 0, 0);
            acc1 = __builtin_amdgcn_mfma_f32_32x32x16_bf16(a, b1, acc1, 0, 0, 0);
        }
#pragma unroll
        for (int g = 0; g < 4; ++g) { const int d = 32 * dt + 8 * g + 4 * hi;
            *(f32x4*)(dCT + ((size_t)unit * 128 + 32 * c0 + r32) * 128 + d) = (f32x4){acc0[4 * g], acc0[4 * g + 1], acc0[4 * g + 2], acc0[4 * g + 3]};
            *(f32x4*)(dCT + ((size_t)unit * 128 + 32 * (c0 + 1) + r32) * 128 + d) = (f32x4){acc1[4 * g], acc1[4 * g + 1], acc1[4 * g + 2], acc1[4 * g + 3]}; }
        { const int d = tid & 127, part = tid >> 7; float s0 = 0.f, s1 = 0.f;
#pragma unroll 8
            for (int t = 0; t < 64; t += 2) { s0 += bf2f(*(const LAS bf16*)(Kimg + off_b(64 * part + t, d >> 3) + 2 * (d & 7))); s1 += bf2f(*(const LAS bf16*)(Kimg + off_b(64 * part + t + 1, d >> 3) + 2 * (d & 7))); }
            sw[256 + tid] = s0 + s1; }
        __syncthreads();
        if (tid < 128) DN[(size_t)unit * 128 + tid] = (sw[256 + tid] + sw[256 + 128 + tid]) + (sw[256 + 256 + tid] + sw[256 + 384 + tid]);
        __syncthreads();
    }
}

__device__ __forceinline__ void phase_mlstm_m2(Frame& F) {
    PHASE_LOCALS();
    const float* dCT = (const float*)(F.ws + ST_DCT); const float* DN = (const float*)(F.ws + ST_DN); const float* MLOC = (const float*)(F.ws + ST_MLOC); const float* BL = (const float*)(F.ws + ST_BL);
    bf16* CinT = (bf16*)(F.ws + ST_CINT); float* NIN = (float*)(F.ws + ST_NIN); float* MIN = (float*)(F.ws + ST_MIN);
    LAS float* al = (LAS float*)(F.lds + SM_OFF); LAS float* be = al + 16;
    for (int item = F.vcu; item < 256; item += F.G) {
        const int bh = item >> 4, sl = item & 15;
        if (tid == 0) { float m = 0.f;
            for (int c = 0; c < 16; ++c) { const int u = bh * 16 + c; const float bl = BL[u], ml = MLOC[u]; if (sl == 0) MIN[u] = m;
                const float mo = fmaxf(bl + m, ml); al[c] = expf(bl + m - mo); be[c] = expf(ml - mo); m = mo; } }
        __syncthreads();
        { const size_t idx = (size_t)sl * 1024 + 2 * tid; float s0 = 0.f, s1 = 0.f;
#pragma unroll
            for (int c = 0; c < 16; ++c) { const size_t u = (size_t)bh * 16 + c; const float2 dc = *(const float2*)(dCT + u * 16384 + idx);
                *(unsigned*)(CinT + u * 16384 + idx) = pk2(s0, s1); s0 = al[c] * s0 + be[c] * dc.x; s1 = al[c] * s1 + be[c] * dc.y; } }
        if (sl == 0 && tid < 128) { float s = 0.f;
#pragma unroll
            for (int c = 0; c < 16; ++c) { const size_t u = (size_t)bh * 16 + c; NIN[u * 128 + tid] = s; s = al[c] * s + be[c] * DN[u * 128 + tid]; } }
        __syncthreads();
    }
}

__device__ __forceinline__ void phase_mlstm_m3(Frame& F, const Inputs& in, int l, int reps = 1) {
    PHASE_LOCALS();
    const bf16* PROJ = (const bf16*)(F.ws + WS_PROJ); const bf16* QKC = (const bf16*)(F.ws + WS_QKC); const float* ifpre = (const float*)(F.ws + WS_IFPRE);
    const float* dCT = (const float*)(F.ws + ST_DCT); const float* DN = (const float*)(F.ws + ST_DN); const float* MLOC = (const float*)(F.ws + ST_MLOC); const float* BLV = (const float*)(F.ws + ST_BL); bf16* YB = (bf16*)(F.ws + WS_YB);
    const float* gh = in.p[I_GH] + l * MDK;
    LAS unsigned char* Vimg = F.lds; LAS unsigned char* Cimg = F.lds + 65536; LAS unsigned char* Kimg = F.lds + 65536;
    LAS float* us = (LAS float*)(F.lds + SM_OFF); LAS float* Mt = us + 256; LAS float* aw = Mt + 256; LAS float* em = aw + 256; LAS float* inv = em + 256; LAS float* nin_s = inv + 256; LAS float* coef = nin_s + 128;
    const int r32 = lane & 31, hi = lane >> 5, wave = F.wave;
    for (int unit = F.vcu; unit < reps * BATCH * MH * 16; unit += F.G) {
        const int unit_ = unit; { const int unit = unit_ & (BATCH * MH * 16 - 1);
        const int bh = unit >> 4, c = unit & 15, b = bh >> 2, h = bh & 3; const size_t row0 = (size_t)b * SEQ + c * 256;
        if (tid < 32) coef[tid] = (tid < 16) ? BLV[bh * 16 + tid] : MLOC[bh * 16 + tid - 16];
        for (int i = tid; i < 4096; i += NTHR) { const int s = i >> 4, ch = i & 15;
            *(LAS v4u*)(Vimg + off_b(s, ch)) = *(const v4u*)(PROJ + (row0 + s) * NPROJ + PC_VM + h * MDK + 8 * ch); }
        __syncthreads();
        if (tid == 0) { float mm = 0.f;
            for (int cc = 0; cc < c; ++cc) { const float bl = coef[cc], ml = coef[16 + cc], mo = fmaxf(bl + mm, ml); coef[cc] = pg8::ex2((bl + mm - mo) * 1.4426950408889634f); coef[16 + cc] = pg8::ex2((ml - mo) * 1.4426950408889634f); mm = mo; }
            coef[32] = mm; }
        __syncthreads();
        { float st[32];
#pragma unroll
            for (int i = 0; i < 32; ++i) st[i] = 0.f;
            f32x4 sa[8], sb[8], sc[8];
            const float* sbase = dCT + ((size_t)(bh * 16)) * 16384 + 32 * tid;
#define M3_LD(buf, cc_) do { const int ci_ = ((cc_) < 15) ? (cc_) : 15;   \
                const f32x4* src_ = (const f32x4*)(sbase + (size_t)ci_ * 16384); _Pragma("unroll") for (int i = 0; i < 8; ++i) buf[i] = src_[i]; __builtin_amdgcn_sched_barrier(0); } while (0)
#define M3_FM(buf, cc_) do { if ((cc_) < c) { const float al = coef[(cc_)], be = coef[16 + (cc_)]; \
                _Pragma("unroll") for (int i = 0; i < 8; ++i) { const f32x4 v = buf[i]; st[4 * i] = al * st[4 * i] + be * v[0]; st[4 * i + 1] = al * st[4 * i + 1] + be * v[1]; st[4 * i + 2] = al * st[4 * i + 2] + be * v[2]; st[4 * i + 3] = al * st[4 * i + 3] + be * v[3]; } } \
                __builtin_amdgcn_sched_barrier(0); } while (0)
            if (c > 0) { M3_LD(sa, 0); M3_LD(sb, 1);
                for (int cc = 0; cc < c; cc += 3) { M3_LD(sc, cc + 2); M3_FM(sa, cc); M3_LD(sa, cc + 3); M3_FM(sb, cc + 1); M3_LD(sb, cc + 4); M3_FM(sc, cc + 2); } }
#undef M3_LD
#undef M3_FM
            LAS unsigned char* dst = Cimg + (tid >> 2) * 272 + (tid & 3) * 64;
#pragma unroll
            for (int i = 0; i < 4; ++i) { v4u o; o.x = pk2(st[8 * i], st[8 * i + 1]); o.y = pk2(st[8 * i + 2], st[8 * i + 3]); o.z = pk2(st[8 * i + 4], st[8 * i + 5]); o.w = pk2(st[8 * i + 6], st[8 * i + 7]); *(LAS v4u*)(dst + 16 * i) = o; }
            if (tid < 128) { float dnv[16];
#pragma unroll
                for (int cc = 0; cc < 16; ++cc) dnv[cc] = DN[((size_t)(bh * 16 + cc)) * 128 + tid];
                float sn = 0.f;
#pragma unroll
                for (int cc = 0; cc < 16; ++cc) if (cc < c) sn = coef[cc] * sn + coef[16 + cc] * dnv[cc];
                nin_s[tid] = sn; } }
        if (wave == 0) {
            float bc[4], ii[4], bL; chunk_gates(ifpre, row0, h, lane, bc, ii, bL);
            float u[4], pm[4];
#pragma unroll
            for (int k = 0; k < 4; ++k) u[k] = ii[k] - bc[k];
            pm[0] = u[0]; pm[1] = fmaxf(pm[0], u[1]); pm[2] = fmaxf(pm[1], u[2]); pm[3] = fmaxf(pm[2], u[3]);
            float inc = pm[3];
#pragma unroll
            for (int o = 1; o < 64; o <<= 1) { const float t = shu(inc, o, lane); if (lane >= o) inc = fmaxf(inc, t); }
            float excl = shu(inc, 1, lane); if (lane == 0) excl = -INFINITY;
            const float m_in = coef[32];
#pragma unroll
            for (int k = 0; k < 4; ++k) { const float Mx = fmaxf(m_in, fmaxf(pm[k], excl)); const int s = 4 * lane + k; us[s] = u[k]; Mt[s] = Mx; aw[s] = pg8::ex2((m_in - Mx) * 1.4426950408889634f); em[s] = pg8::ex2(-(bc[k] + Mx) * 1.4426950408889634f); }
        }
        __syncthreads();
        const int t = 32 * wave + r32;
        bf16x8s qf[8];
#pragma unroll
        for (int ks = 0; ks < 8; ++ks) qf[ks] = *(const bf16x8s*)(QKC + (row0 + t) * 1024 + h * MDK + 16 * ks + 8 * hi);
        float qn = 0.f;
#pragma unroll
        for (int ks = 0; ks < 8; ++ks)
#pragma unroll
            for (int j = 0; j < 8; ++j) qn += bf2f((bf16)qf[ks][j]) * nin_s[16 * ks + 8 * hi + j];
        qn += shx(qn, 32, lane);
        f32x16 acc[4];
#pragma unroll
        for (int cc = 0; cc < 4; ++cc)
#pragma unroll
            for (int i = 0; i < 16; ++i) acc[cc][i] = 0.f;
#pragma unroll
        for (int cc = 0; cc < 4; ++cc)
#pragma unroll
            for (int ks = 0; ks < 8; ++ks) { const bf16x8s bq = *(const LAS bf16x8s*)(Cimg + (32 * cc + r32) * 272 + 2 * (16 * ks + 8 * hi));
                acc[cc] = __builtin_amdgcn_mfma_f32_32x32x16_bf16(qf[ks], bq, acc[cc], 0, 0, 0); }
#pragma unroll
        for (int rg = 0; rg < 16; ++rg) { const float a = aw[32 * wave + crow(rg, hi)];
#pragma unroll
            for (int cc = 0; cc < 4; ++cc) acc[cc][rg] *= a; }
        { v4u kst[8];
#pragma unroll
          for (int i = 0; i < 8; ++i) { const int idx = tid + NTHR * i, s_ = idx >> 4, ch = idx & 15; kst[i] = *(const v4u*)(QKC + (row0 + s_) * 1024 + 512 + h * MDK + 8 * ch); }
          __syncthreads();
#pragma unroll
          for (int i = 0; i < 8; ++i) { const int idx = tid + NTHR * i, s_ = idx >> 4, ch = idx & 15; *(LAS v4u*)(Kimg + off_b(s_, ch)) = kst[i]; }
          __syncthreads(); }
        const float Ml = Mt[t]; float den = 0.f;
        for (int j = 0; j <= wave; ++j) {
            f32x16 X;
#pragma unroll
            for (int i = 0; i < 16; ++i) X[i] = 0.f;
#pragma unroll
            for (int ks = 0; ks < 8; ++ks) { const bf16x8s ka = *(const LAS bf16x8s*)(Kimg + off_b(32 * j + r32, 2 * ks + hi));
                X = __builtin_amdgcn_mfma_f32_32x32x16_bf16(ka, qf[ks], X, 0, 0, 0); }
#pragma unroll
            for (int rg = 0; rg < 16; ++rg) { const int s = 32 * j + crow(rg, hi); float w = pg8::ex2((us[s] - Ml) * 1.4426950408889634f); if (s > t) w = 0.f;     const float pv = X[rg] * w; X[rg] = pv; den += pv; }
            v4u p0, p1;
            p0.x = pk2(X[0], X[1]); p0.y = pk2(X[2], X[3]); p0.z = pk2(X[4], X[5]); p0.w = pk2(X[6], X[7]);
            p1.x = pk2(X[8], X[9]); p1.y = pk2(X[10], X[11]); p1.z = pk2(X[12], X[13]); p1.w = pk2(X[14], X[15]);
            const bf16x8s pa0 = __builtin_bit_cast(bf16x8s, p0), pa1 = __builtin_bit_cast(bf16x8s, p1);
#pragma unroll
            for (int cc = 0; cc < 4; ++cc) {
                acc[cc] = __builtin_amdgcn_mfma_f32_32x32x16_bf16(pa0, tr_frag_perm(Vimg, lane, 32 * j, cc), acc[cc], 0, 0, 0);
                acc[cc] = __builtin_amdgcn_mfma_f32_32x32x16_bf16(pa1, tr_frag_perm(Vimg, lane, 32 * j + 16, cc), acc[cc], 0, 0, 0); }
        }
        den += shx(den, 32, lane);
        { const float dt = aw[t] * qn + den; inv[t] = 1.0f / fmaxf(fabsf(dt), em[t]); }
        asm volatile("s_waitcnt lgkmcnt(0)" ::: "memory");
        float rr[16];
#pragma unroll
        for (int rg = 0; rg < 16; ++rg) { const float f = inv[32 * wave + crow(rg, hi)]; float sq = 0.f;
#pragma unroll
            for (int cc = 0; cc < 4; ++cc) { acc[cc][rg] *= f; sq += acc[cc][rg] * acc[cc][rg]; }
#pragma unroll
            for (int o = 1; o < 32; o <<= 1) sq += shx(sq, o, lane);
            rr[rg] = 1.0f / sqrtf(sq * (1.0f / MDK) + RMS_EPS); }
#pragma unroll
        for (int cc = 0; cc < 4; ++cc) { const int e = 32 * cc + r32; const float ge = gh[e];
#pragma unroll
            for (int rg = 0; rg < 16; ++rg) { const size_t r = row0 + 32 * wave + crow(rg, hi);
                const float o = sigm(bf2f(PROJ[r * NPROJ + PC_OM + h * MDK + e]));
                YB[r * 1024 + h * MDK + e] = (bf16)f2bf(acc[cc][rg] * rr[rg] * ge * o); } }
        __syncthreads();
        }
    }
}
#include <hip/hip_bf16.h>
namespace attn_body {
using bf16=__hip_bfloat16;
using bf16x8=__attribute__((ext_vector_type(8)))short;
using s16x4=__attribute__((ext_vector_type(4)))short;
using f32x16=__attribute__((ext_vector_type(16)))float;
using u32x4=__attribute__((ext_vector_type(4)))unsigned;
using f32x4_t=__attribute__((ext_vector_type(4)))float;
constexpr int BATCH=4,NHEAD=8,SEQ=4096,D=64,DM=3584,DMO=1024;
constexpr float NEGBIG=-200.f;
constexpr int NW=8,QBLK=32,QB=QBLK*NW,KVBLK=64,NQB=SEQ/QB;
constexpr int ATTN_PITCH=DM, ATTN_UNIT_ROWS=QB;
__device__ __forceinline__ int crow(int r,int hi){return (r&3)+8*(r>>2)+4*hi;}
#define SBAR() __builtin_amdgcn_sched_barrier(0)
__device__ __forceinline__ void cmask(f32x16&p0,f32x16&p1,int jb,int qrel,int hi){
  const float NEG=-INFINITY; int kb=64*jb+4*hi;
  #pragma unroll
  for(int r=0;r<16;++r){int kv=kb+(r&3)+8*(r>>2); if(kv>qrel)p0[r]=NEG; if(kv+32>qrel)p1[r]=NEG;}
}

constexpr int NSLOT=3, SLOTB=8192;
constexpr int LDS_K=0, LDS_V=NSLOT*SLOTB, LDS_WS=2*NSLOT*SLOTB, LDS_OST=LDS_WS+NW*64*4, LDS_KMS=LDS_OST+NW*4096  , LDS_BYTES=LDS_KMS+4096;
constexpr float C2=0.125f*1.4426950408889634f;
__device__ __forceinline__ void glds16(const void*gsrc,unsigned lds_dst){unsigned keep;
  asm volatile("s_mov_b32 %0, m0\n\ts_mov_b32 m0, %2\n\ts_nop 0\n\tglobal_load_lds_dwordx4 %1, off\n\ts_mov_b32 m0, %0":"=&s"(keep):"v"(gsrc),"s"(lds_dst):"memory");}
__device__ __forceinline__ float max3f(float a,float b,float c){float r;asm("v_max3_f32 %0, %1, %2, %3":"=v"(r):"v"(a),"v"(b),"v"(c));return r;}
__device__ __forceinline__ float max2f(float a,float b){float r;asm("v_max_f32_e32 %0, %1, %2":"=v"(r):"v"(a),"v"(b));return r;}
__device__ __forceinline__ float fadd_s(float a,float b){float r;asm("v_add_f32_e32 %0, %1, %2":"=v"(r):"v"(a),"v"(b));return r;}
__device__ __forceinline__ float fsub_s(float a,float b){float r;asm("v_sub_f32_e32 %0, %1, %2":"=v"(r):"v"(a),"v"(b));return r;}
typedef float f32x2_t __attribute__((ext_vector_type(2))); typedef __bf16 bf16x2_t __attribute__((ext_vector_type(2)));
__device__ __forceinline__ unsigned cvtpk_s(float lo,float hi){f32x2_t v={lo,hi};bf16x2_t b=__builtin_convertvector(v,bf16x2_t);return __builtin_bit_cast(unsigned,b);}
#define WAIT_BAR(N) asm volatile("s_waitcnt vmcnt(" #N ") lgkmcnt(0)\n\ts_barrier":::"memory")

__device__ __forceinline__ void qkt(f32x16&p0,f32x16&p1,const char*Kslot,const bf16x8*qr,const f32x16&negm,int r32,int hi){
  const char*kb=Kslot+hi*1024+r32*16;
  #pragma unroll
  for(int d0=0;d0<4;++d0){
    const bf16x8 b0=*reinterpret_cast<const bf16x8*>(kb+d0*2048);
    const bf16x8 b1=*reinterpret_cast<const bf16x8*>(kb+d0*2048+512);
    if(d0==0){p0=__builtin_amdgcn_mfma_f32_32x32x16_bf16(b0,qr[0],negm,0,0,0);p1=__builtin_amdgcn_mfma_f32_32x32x16_bf16(b1,qr[0],negm,0,0,0);}
    else{p0=__builtin_amdgcn_mfma_f32_32x32x16_bf16(b0,qr[d0],p0,0,0,0);p1=__builtin_amdgcn_mfma_f32_32x32x16_bf16(b1,qr[d0],p1,0,0,0);}}
}
typedef __attribute__((address_space(3))) const char* lds_cptr;
typedef short v4i16_t __attribute__((ext_vector_type(4)));
__device__ __forceinline__ void kload8(bf16x8*kf,lds_cptr kp){
  kf[0]=*(const __attribute__((address_space(3))) bf16x8*)(kp);      kf[1]=*(const __attribute__((address_space(3))) bf16x8*)(kp+512);
  kf[2]=*(const __attribute__((address_space(3))) bf16x8*)(kp+2048); kf[3]=*(const __attribute__((address_space(3))) bf16x8*)(kp+2560);
  kf[4]=*(const __attribute__((address_space(3))) bf16x8*)(kp+4096); kf[5]=*(const __attribute__((address_space(3))) bf16x8*)(kp+4608);
  kf[6]=*(const __attribute__((address_space(3))) bf16x8*)(kp+6144); kf[7]=*(const __attribute__((address_space(3))) bf16x8*)(kp+6656);
}
__device__ __forceinline__ void kload2(bf16x8*kf,lds_cptr kp,int j){ kf[2*j]=*(const __attribute__((address_space(3))) bf16x8*)(kp+j*2048); kf[2*j+1]=*(const __attribute__((address_space(3))) bf16x8*)(kp+j*2048+512); }
__device__ __forceinline__ s16x4 vtr(lds_cptr p){ return __builtin_bit_cast(s16x4,__builtin_amdgcn_ds_read_tr16_b64_v4i16((__attribute__((address_space(3))) v4i16_t*)p)); }
__device__ __forceinline__ float rowmax(const f32x16&p0,const f32x16&p1){
  float a=max3f(p0[0],p0[1],p1[0]),b=max3f(p0[2],p0[3],p1[1]);a=max3f(a,p1[2],p1[3]);
  #pragma unroll
  for(int r=4;r<16;r+=4){a=max3f(a,p0[r],p0[r+1]);b=max3f(b,p0[r+2],p0[r+3]);a=max3f(a,p1[r],p1[r+1]);b=max3f(b,p1[r+2],p1[r+3]);}
  const float m=max2f(a,b);
  auto rr=__builtin_amdgcn_permlane32_swap(__float_as_uint(m),__float_as_uint(m),false,false);
  return max2f(__uint_as_float(rr[0]),__uint_as_float(rr[1]));
}
__device__ __forceinline__ void pv(f32x16*o,int vb,bf16x8 pa0,bf16x8 pa1,bf16x8 pa2,bf16x8 pa3){
  #pragma unroll
  for(int d0=0;d0<2;++d0){s16x4 lo[4],hi[4];
    #pragma unroll
    for(int ks=0;ks<4;++ks){
      asm volatile("ds_read_b64_tr_b16 %0,%1 offset:%c2":"=&v"(lo[ks]):"v"(vb),"i"(d0*4096+ks*1024):"memory");
      asm volatile("ds_read_b64_tr_b16 %0,%1 offset:%c2":"=&v"(hi[ks]):"v"(vb),"i"(d0*4096+ks*1024+512):"memory");}
    asm volatile("s_waitcnt lgkmcnt(0)":::"memory");SBAR();
    #define PK(k) (bf16x8){lo[k][0],lo[k][1],lo[k][2],lo[k][3],hi[k][0],hi[k][1],hi[k][2],hi[k][3]}
    o[d0]=__builtin_amdgcn_mfma_f32_32x32x16_bf16(pa0,PK(0),o[d0],0,0,0);
    o[d0]=__builtin_amdgcn_mfma_f32_32x32x16_bf16(pa1,PK(1),o[d0],0,0,0);
    o[d0]=__builtin_amdgcn_mfma_f32_32x32x16_bf16(pa2,PK(2),o[d0],0,0,0);
    o[d0]=__builtin_amdgcn_mfma_f32_32x32x16_bf16(pa3,PK(3),o[d0],0,0,0);
    #undef PK
  }
}

#ifndef ATTN_STORE16
#define ATTN_STORE16(p,v) (*(u32x4*)(p)=(v))
#endif
template<int THRL> __device__ __forceinline__ void attn_unit(int b,int h,int qb,const bf16*Q,const bf16*__restrict__ K,const bf16*__restrict__ V,bf16*O,const float*__restrict__ kmean,char*shm,int wave_in){
  int tid_; asm volatile("v_mbcnt_lo_u32_b32 %0, -1, 0\n\tv_mbcnt_hi_u32_b32 %0, -1, %0":"=v"(tid_)); tid_+=64*wave_in; const int tid=tid_,lane=tid&63,r32=lane&31,hi=lane>>5; const int wid=__builtin_amdgcn_readfirstlane(tid>>6);
  const long rowbase=(long)b*SEQ; const int q0=qb*QB;
  const bf16*Qw=Q+(rowbase+q0+wid*QBLK)*DM+h*D;
  const bf16*Kh=K+rowbase*DM+h*D,*Vh=V+rowbase*DM+h*D;
  const unsigned lds0=(unsigned)(uintptr_t)shm;
  float*wsf=(float*)(shm+LDS_WS)+wid*64;
  const bf16*ksrc=Kh+(long)lane*DM+wid*8;
  const bf16*vsrc=Vh+(long)(16*(wid&3)+(lane>>2))*DM+(wid>>2)*32+(lane&3)*8;
  const unsigned kdst=lds0+LDS_K+wid*1024, vdst=lds0+LDS_V+wid*1024;
  #define DMA_K(t,slot) glds16(ksrc+(long)(t)*KVBLK*DM,(unsigned)__builtin_amdgcn_readfirstlane(kdst+(slot)))
  #define DMA_V(t,slot) glds16(vsrc+(long)(t)*KVBLK*DM,(unsigned)__builtin_amdgcn_readfirstlane(vdst+(slot)))
  const int vb0=(int)(lds0+LDS_V)+((lane>>4)&1)*32+(lane&3)*8+(4*hi+((lane&15)>>2))*64;
  const char*Kbase=shm+LDS_K; bf16x8 kf[8];
  const lds_cptr shm3=(lds_cptr)shm; const lds_cptr kp0=shm3+LDS_K+hi*1024+r32*16; const lds_cptr vp0=shm3+LDS_V+((lane>>4)&1)*32+(lane&3)*8+(4*hi+((lane&15)>>2))*64;
  const int NT=(q0+QB)/KVBLK;
  DMA_K(0,0);DMA_V(0,0);DMA_K(1,SLOTB);
  bf16x8 qr[4];
  #pragma unroll
  for(int d0=0;d0<4;++d0)qr[d0]=*reinterpret_cast<const bf16x8*>(&Qw[(long)r32*DM+d0*16+hi*8]);

  unsigned selm=0u;
  if(qb>0){
    typedef __attribute__((address_space(3))) f32x4_t lds_f4;
    if(wid<4){ const int n_=tid>>4,d4_=(tid&15)*4; const f32x4_t s_=*reinterpret_cast<const f32x4_t*>(kmean+n_*128+d4_)+*reinterpret_cast<const f32x4_t*>(kmean+n_*128+64+d4_);
      *(lds_f4*)((lds_cptr)shm+LDS_KMS+(n_*64+d4_)*4)=s_; }
    asm volatile("s_waitcnt lgkmcnt(0)\n\ts_barrier":::"memory");
    float g[16];
    #pragma unroll
    for(int n=0;n<16;++n)g[n]=-INFINITY;
    #pragma unroll
    for(int n=0;n<15;++n) if(n<qb){
      const lds_cptr km=(lds_cptr)shm+LDS_KMS+(n*64+8*hi)*4; float a=0.f;
      #pragma unroll
      for(int d0=0;d0<4;++d0){ const f32x4_t k0=*(const lds_f4*)(km+64*d0),k1=*(const lds_f4*)(km+64*d0+16);
        #pragma unroll
        for(int j=0;j<4;++j){ a+=__uint_as_float((unsigned)(unsigned short)qr[d0][j]<<16)*k0[j]; a+=__uint_as_float((unsigned)(unsigned short)qr[d0][4+j]<<16)*k1[j]; } }
      auto rr=__builtin_amdgcn_permlane32_swap(__float_as_uint(a),__float_as_uint(a),false,false); g[n]=__uint_as_float(rr[0])+__uint_as_float(rr[1]);
    }
    #pragma unroll
    for(int s=0;s<3;++s) if(s<qb){ float best=-INFINITY; int bi=0;
      #pragma unroll
      for(int n=0;n<15;++n) if(g[n]>best){best=g[n];bi=n;}
      selm|=1u<<bi;
      #pragma unroll
      for(int n=0;n<15;++n) if(n==bi)g[n]=-INFINITY; }
  }
  selm|=1u<<qb;
  float mhat=0.f,l_reg=0.f;f32x16 o[2];f32x16 negm; { float z_=0.f; asm volatile("":"+v"(z_));
    _Pragma("unroll") for(int r_=0;r_<16;++r_){o[0][r_]=z_;o[1][r_]=z_;negm[r_]=z_;} } asm volatile("":"+v"(negm));
  const int qrel=wid*QBLK+r32;
  #define NEGSET(blk) do{ const float nv_=((selm>>(blk))&1u)?-mhat:NEGBIG; _Pragma("unroll") for(int r_=0;r_<16;++r_)negm[r_]=nv_; asm volatile("":"+v"(negm)); }while(0)
  NEGSET(0);
  #define CMASK(P0,P1,t) do{int jb_=(t)-(NT-4); if(jb_>=0)cmask(P0,P1,jb_,qrel,hi); }while(0)
  bool resc=false;
  #define START(P0,P1) do{ const float rm=rowmax(P0,P1); resc=false; \
    { const float dl=rm; mhat=fadd_s(mhat,dl); \
      _Pragma("unroll") for(int r=0;r<16;++r){P0[r]=fsub_s(P0[r],dl);P1[r]=fsub_s(P1[r],dl);} \
      NEGSET(0); } \
    _Pragma("unroll") for(int r=0;r<16;++r)P0[r]=__builtin_amdgcn_exp2f(P0[r]); }while(0)
  #define RESC() do{ if(resc){ asm volatile("s_waitcnt lgkmcnt(0)":::"memory"); \
      _Pragma("unroll") for(int d_=0;d_<2;++d_) _Pragma("unroll") for(int r=0;r<16;++r)o[d_][r]*=wsf[crow(r,hi)]; } }while(0)
  f32x16 pA0,pA1,pB0,pB1;
  int sl_prev=0,sl_cur=0,sl_next=SLOTB;
  #define ROT() do{sl_prev=sl_cur;sl_cur=sl_next;sl_next=(sl_next==(NSLOT-1)*SLOTB)?0:sl_next+SLOTB;}while(0)
  DMA_K(2,2*SLOTB);
  WAIT_BAR(3);
  qkt(pA0,pA1,Kbase,qr,negm,r32,hi);asm volatile("s_nop 15\n\ts_nop 7":"+v"(pA0),"+v"(pA1));CMASK(pA0,pA1,0);
  START(pA0,pA1);
  _Pragma("unroll") for(int r=0;r<16;++r)pA1[r]=__builtin_amdgcn_exp2f(pA1[r]);
  WAIT_BAR(0);
  DMA_K(3,0);DMA_V(1,SLOTB);
  ROT();
  kload8(kf,kp0+sl_cur);
  WAIT_BAR(2);
  s16x4 vlo[8],vhi[8]; u32x4 pw0,pw1,pw2,pw3;
  #define PKW(P,B) cvtpk_s(P[B],P[B+1])
  #define PAF(k) __builtin_bit_cast(bf16x8,pw##k)
  #define VFR(i) (bf16x8){vlo[i][0],vlo[i][1],vlo[i][2],vlo[i][3],vhi[i][0],vhi[i][1],vhi[i][2],vhi[i][3]}
  #define PIN(x) asm volatile("":"+v"(x))
  #define MX3(a,b,c) __builtin_fmaxf(__builtin_fmaxf((a),(b)),(c))
  #define GAPA(MF,A0,A1,A2,A3,W0,W1,PW) do{ MF; sacc+=A0; sacc+=A1; sacc+=A2; sacc+=A3; PIN(sacc); W0; W1; PIN(PW); SBAR(); }while(0)
  #define EX(v) __builtin_amdgcn_exp2f(v)
  #define GAPB(MF,X,B) do{ MF; X[B]=EX(X[B]); X[B+1]=EX(X[B+1]); X[B+2]=EX(X[B+2]); X[B+3]=EX(X[B+3]); PIN(X); SBAR(); }while(0)
  #define VRD(i) do{ vlo[i]=vtr(vp_+(((i)>>2)*4096+((i)&3)*1024)); vhi[i]=vtr(vp_+(((i)>>2)*4096+((i)&3)*1024+512)); }while(0)
  #define KRD(G,j) do{ if(G){ kload2(kf,kp0+sl_next,j); SBAR(); } }while(0)
  #define STEP(C0,C1,P0,P1,t,GK,GV,GL) do{ SBAR(); \
    const lds_cptr vp_=vp0+sl_prev; \
    VRD(0); SBAR(); float sacc=(P0[0]+P0[1]); \
    GAPA(C0=__builtin_amdgcn_mfma_f32_32x32x16_bf16(kf[0],qr[0],negm,0,0,0), P0[2],P0[3],P0[4],P0[5],     pw0[0]=PKW(P0,0), pw0[1]=PKW(P0,2), pw0); \
    VRD(4); SBAR(); GAPA(C1=__builtin_amdgcn_mfma_f32_32x32x16_bf16(kf[1],qr[0],negm,0,0,0), P0[6],P0[7],P0[8],P0[9],     pw0[2]=PKW(P0,4), pw0[3]=PKW(P0,6), pw0); \
    VRD(1); SBAR(); GAPA(C0=__builtin_amdgcn_mfma_f32_32x32x16_bf16(kf[2],qr[1],C0,0,0,0),   P0[10],P0[11],P0[12],P0[13], pw1[0]=PKW(P0,8), pw1[1]=PKW(P0,10), pw1); \
    VRD(5); SBAR(); GAPA(C1=__builtin_amdgcn_mfma_f32_32x32x16_bf16(kf[3],qr[1],C1,0,0,0),   P0[14],P0[15],P1[0],P1[1],   pw1[2]=PKW(P0,12),pw1[3]=PKW(P0,14), pw1); \
    VRD(2); SBAR(); GAPA(C0=__builtin_amdgcn_mfma_f32_32x32x16_bf16(kf[4],qr[2],C0,0,0,0),   P1[2],P1[3],P1[4],P1[5],     pw2[0]=PKW(P1,0), pw2[1]=PKW(P1,2), pw2); \
    VRD(6); SBAR(); GAPA(C1=__builtin_amdgcn_mfma_f32_32x32x16_bf16(kf[5],qr[2],C1,0,0,0),   P1[6],P1[7],P1[8],P1[9],     pw2[2]=PKW(P1,4), pw2[3]=PKW(P1,6), pw2); \
    VRD(3); SBAR(); GAPA(C0=__builtin_amdgcn_mfma_f32_32x32x16_bf16(kf[6],qr[3],C0,0,0,0),   P1[10],P1[11],P1[12],P1[13], pw3[0]=PKW(P1,8), pw3[1]=PKW(P1,10), pw3); \
    VRD(7); SBAR(); GAPA(C1=__builtin_amdgcn_mfma_f32_32x32x16_bf16(kf[7],qr[3],C1,0,0,0),   P1[14],P1[15],0.f,0.f,       pw3[2]=PKW(P1,12),pw3[3]=PKW(P1,14), pw3); \
    l_reg+=sacc; \
    if(GK){DMA_K((t)+3,sl_cur);} if(GV){DMA_V((t)+1,sl_next);} \
    CMASK(C0,C1,t); \
    { float a=MX3(C0[0],C0[1],C1[0]),b=MX3(C0[2],C0[3],C1[1]); a=MX3(a,C1[2],C1[3]); \
      _Pragma("unroll") for(int r=4;r<16;r+=4){a=MX3(a,C0[r],C0[r+1]);b=MX3(b,C0[r+2],C0[r+3]);a=MX3(a,C1[r],C1[r+1]);b=MX3(b,C1[r+2],C1[r+3]);} \
      float rm=__builtin_fmaxf(a,b); { auto rr=__builtin_amdgcn_permlane32_swap(__float_as_uint(rm),__float_as_uint(rm),false,false); rm=__builtin_fmaxf(__uint_as_float(rr[0]),__uint_as_float(rr[1])); } \
      resc=false; \
      if(__builtin_expect(__any(rm>(float)THRL),0)){ const float dl=__builtin_fmaxf(rm,0.f); mhat+=dl; \
        _Pragma("unroll") for(int r=0;r<16;++r){C0[r]-=dl;C1[r]-=dl;} \
        NEGSET((t)>>2); \
        const float f=__builtin_amdgcn_exp2f(-dl); l_reg*=f; if(hi==0)wsf[r32]=f; resc=true; } } \
    SBAR(); \
    GAPB(o[0]=__builtin_amdgcn_mfma_f32_32x32x16_bf16(PAF(0),VFR(0),o[0],0,0,0), C0,0); \
    GAPB(o[1]=__builtin_amdgcn_mfma_f32_32x32x16_bf16(PAF(0),VFR(4),o[1],0,0,0), C0,4); \
    KRD(GL,0); GAPB(o[0]=__builtin_amdgcn_mfma_f32_32x32x16_bf16(PAF(1),VFR(1),o[0],0,0,0), C0,8); \
    KRD(GL,1); GAPB(o[1]=__builtin_amdgcn_mfma_f32_32x32x16_bf16(PAF(1),VFR(5),o[1],0,0,0), C0,12); \
    KRD(GL,2); GAPB(o[0]=__builtin_amdgcn_mfma_f32_32x32x16_bf16(PAF(2),VFR(2),o[0],0,0,0), C1,0); \
    KRD(GL,3); GAPB(o[1]=__builtin_amdgcn_mfma_f32_32x32x16_bf16(PAF(2),VFR(6),o[1],0,0,0), C1,4); \
    GAPB(o[0]=__builtin_amdgcn_mfma_f32_32x32x16_bf16(PAF(3),VFR(3),o[0],0,0,0), C1,8); \
    GAPB(o[1]=__builtin_amdgcn_mfma_f32_32x32x16_bf16(PAF(3),VFR(7),o[1],0,0,0), C1,12); \
    }while(0)
  int t=1;
  #undef CMASK
  #define CMASK(P0,P1,t) do{}while(0)
  for(;t+5<NT;t+=2){
    STEP(pB0,pB1,pA0,pA1,t,true,true,true);     WAIT_BAR(2); RESC(); ROT();
    if(((t+1)&3)==0)NEGSET((t+1)>>2);
    STEP(pA0,pA1,pB0,pB1,t+1,true,true,true);   WAIT_BAR(2); RESC(); ROT();
  }
  #undef CMASK
  #define CMASK(P0,P1,t) do{int jb_=(t)-(NT-4); if(jb_>=0)cmask(P0,P1,jb_,qrel,hi); }while(0)
  #define ENDW(tt) do{ if((tt)+3<NT){WAIT_BAR(2);} else if((tt)+2<NT){WAIT_BAR(1);} else {WAIT_BAR(0);} }while(0)
  for(;t+1<NT;t+=2){
    STEP(pB0,pB1,pA0,pA1,t,(t+3<NT),(t+1<NT),(t+1<NT));       ENDW(t);   RESC(); ROT();
    if(((t+1)&3)==0)NEGSET((t+1)>>2);
    STEP(pA0,pA1,pB0,pB1,t+1,(t+4<NT),(t+2<NT),(t+2<NT));     ENDW(t+1); RESC(); ROT();
  }
  STEP(pB0,pB1,pA0,pA1,NT-1,false,false,false); RESC();
  { float sacc=pB0[0]+pB0[1]; _Pragma("unroll") for(int r=2;r<16;++r)sacc+=pB0[r]; _Pragma("unroll") for(int r=0;r<16;++r)sacc+=pB1[r]; l_reg+=sacc;
    pw0=(u32x4){PKW(pB0,0),PKW(pB0,2),PKW(pB0,4),PKW(pB0,6)};pw1=(u32x4){PKW(pB0,8),PKW(pB0,10),PKW(pB0,12),PKW(pB0,14)};pw2=(u32x4){PKW(pB1,0),PKW(pB1,2),PKW(pB1,4),PKW(pB1,6)};pw3=(u32x4){PKW(pB1,8),PKW(pB1,10),PKW(pB1,12),PKW(pB1,14)};
    SBAR(); pv(o,vb0+sl_cur,PAF(0),PAF(1),PAF(2),PAF(3)); }
  #undef PKW
  #undef PAF
  #undef VFR
  #undef PIN
  #undef MX3
  #undef GAPA
  #undef GAPB
  #undef EX
  #undef VRD
  #undef KRD
  #undef STEP
  #undef ENDW
  {auto rr=__builtin_amdgcn_permlane32_swap(__float_as_uint(l_reg),__float_as_uint(l_reg),false,false);l_reg=__uint_as_float(rr[0])+__uint_as_float(rr[1]);}
  if(hi==0)wsf[32+r32]=l_reg;asm volatile("s_waitcnt lgkmcnt(0)":::"memory");
  float rli[16];
  #pragma unroll
  for(int r=0;r<16;++r)rli[r]=__builtin_amdgcn_rcpf(wsf[32+crow(r,hi)]);
  bf16*Ow=O+(rowbase+q0+wid*QBLK)*DMO+h*D;
  { bf16*stg=(bf16*)(shm+LDS_OST)+wid*2048;
    #pragma unroll
    for(int r=0;r<16;++r){const int orow=crow(r,hi);
      #pragma unroll
      for(int d0=0;d0<2;++d0)stg[orow*64+d0*32+r32]=__float2bfloat16(o[d0][r]*rli[r]);}
    asm volatile("s_waitcnt lgkmcnt(0)":::"memory");
    #pragma unroll
    for(int i=0;i<4;++i){const int row=i*8+(lane>>3),ch=lane&7; const u32x4 v=*(const u32x4*)(stg+row*64+ch*8); ATTN_STORE16(Ow+(long)row*DMO+ch*8,v);} }
  asm volatile("s_waitcnt lgkmcnt(0)\n\ts_barrier":::"memory");
  #undef DMA_K
  #undef DMA_V
  #undef CMASK
  #undef NEGSET
  #undef START
  #undef RESC
  #undef ROT
}
constexpr int ATTN_LDS_BYTES=LDS_BYTES;
struct AttnTensors { const bf16* Q; const bf16* K; const bf16* V; bf16* O; const float* kmean; };
struct AttnUnit { int bh; int qb; };
struct StaticOrder {
  int vcu,G;
  __device__ __forceinline__ explicit StaticOrder(int grid,int block):vcu((grid%8==0)?(block%8)*(grid/8)+block/8:block),G(grid){}
  __device__ __forceinline__ bool next(int i,AttnUnit&u)const{ const int idx=(i>>1)*G+vcu; if(idx>=BATCH*NHEAD*8)return false; const int s=idx&7; u.bh=idx>>3; u.qb=(i&1)?15-s:s; return true; }
  __device__ __forceinline__ void a_ready(const AttnUnit&)const{}
  __device__ __forceinline__ void done(const AttnUnit&)const{}
};
template<class Sched,int THRL=8> __device__ __forceinline__ void attn_phase(char*lds,const AttnTensors&T,const Sched&S,int wave_in){
  AttnUnit u;
  for(int i=0;S.next(i,u);++i){ S.a_ready(u); attn_unit<THRL>(u.bh/NHEAD,u.bh%NHEAD,u.qb,T.Q,T.K,T.V,T.O,T.kmean+(size_t)u.bh*16*128,lds,wave_in); S.done(u); }
}
#undef SBAR
#undef WAIT_BAR
}
__device__ __forceinline__ void phase_moe_route(Frame& F) {
    PHASE_LOCALS();
    if ((int)blockIdx.x >= 4 * (M / 256)) return;
    const int j = blockIdx.x >> 2, quarter = blockIdx.x & 3;
    const int* TOPI = (const int*)(F.ws + WS_TOPI); int* DEST = (int*)(F.ws + WS_DEST); int* ROWTOK = (int*)(F.ws + WS_ROWTOK); int* TILEE = (int*)(F.ws + WS_TILEE); int* NTILES = (int*)(F.ws + WS_NTILES);
    LAS int* cnt = (LAS int*)F.lds; LAS int* tot = cnt + 64 * 8; LAS int* basej = tot + 8; LAS int* pstart = basej + 8; LAS int* wcnt = pstart + 16; LAS int* dsts = wcnt + 32;
    for (int i = tid; i < 64 * 8; i += NTHR) cnt[i] = 0;
    __syncthreads();
    for (int m0 = tid; m0 < M; m0 += 8 * NTHR) { int2 e[8];
#pragma unroll
        for (int k = 0; k < 8; ++k) e[k] = *(const int2*)(TOPI + (size_t)(m0 + k * NTHR) * 2);
#pragma unroll
        for (int k = 0; k < 8; ++k) { const int m = m0 + k * NTHR; __hip_atomic_fetch_add(cnt + (m >> 8) * 8 + e[k].x, 1, __ATOMIC_RELAXED, __HIP_MEMORY_SCOPE_WORKGROUP); __hip_atomic_fetch_add(cnt + (m >> 8) * 8 + e[k].y, 1, __ATOMIC_RELAXED, __HIP_MEMORY_SCOPE_WORKGROUP); } }
    __syncthreads();
    if (tid < 8) { int s = 0, bj = 0; for (int jj = 0; jj < 64; ++jj) { if (jj == j) bj = s; s += cnt[jj * 8 + tid]; } tot[tid] = s; basej[tid] = bj; }
    __syncthreads();
    if (tid == 0) { int ps = 0; for (int e = 0; e < 8; ++e) { pstart[e] = ps; ps += (tot[e] + 255) & ~255; } pstart[8] = ps; }
    __syncthreads();
    const int m = 256 * j + tid; int e1 = -1, e2 = -1, rk1 = 0, rk2 = 0;
    if (tid < 256) { const int2 e = *(const int2*)(TOPI + (size_t)m * 2); e1 = e.x; e2 = e.y; }
    if (tid < 256) {
#pragma unroll
        for (int e = 0; e < 8; ++e) { const bool has = (e1 == e) || (e2 == e); const unsigned long long mask = __ballot(has); const int rk = __popcll(mask & ((1ull << lane) - 1ull));
            if (e1 == e) rk1 = rk; if (e2 == e) rk2 = rk; if (lane == 0) wcnt[F.wave * 8 + e] = __popcll(mask); }
    }
    __syncthreads();
    if (tid < 256) {
        int o1 = 0, o2 = 0;
        for (int w = 0; w < F.wave; ++w) { o1 += wcnt[w * 8 + e1]; o2 += wcnt[w * 8 + e2]; }
        const int d1 = pstart[e1] + basej[e1] + o1 + rk1, d2 = pstart[e2] + basej[e2] + o2 + rk2;
        if (quarter == 0) *(int2*)(DEST + (size_t)m * 2) = make_int2(d1, d2);
        dsts[2 * tid] = d1; dsts[2 * tid + 1] = d2;
    }
    __syncthreads();
    { const bf16* __restrict__ HB = (const bf16*)(F.ws + WS_HB); bf16* __restrict__ XG = (bf16*)(F.ws + WS_XG);
      for (int i0 = quarter * 64 * 128 + tid; i0 < (quarter + 1) * 64 * 128; i0 += 8 * NTHR) { v4u val[8];
#pragma unroll
          for (int k = 0; k < 8; ++k) { const int i = i0 + k * NTHR; val[k] = *(const v4u*)(HB + (size_t)(256 * j + (i >> 7)) * D + 8 * (i & 127)); }
#pragma unroll
          for (int k = 0; k < 8; ++k) { const int i = i0 + k * NTHR, t = i >> 7; const v4u w = val[k];
#define C8_(v) __builtin_amdgcn_fmed3f((v), -448.0f, 448.0f)
              int a_ = __builtin_amdgcn_cvt_pk_fp8_f32(C8_(bflo(w.x)), C8_(bfhi(w.x)), 0, false); a_ = __builtin_amdgcn_cvt_pk_fp8_f32(C8_(bflo(w.y)), C8_(bfhi(w.y)), a_, true);
              int b_ = __builtin_amdgcn_cvt_pk_fp8_f32(C8_(bflo(w.z)), C8_(bfhi(w.z)), 0, false); b_ = __builtin_amdgcn_cvt_pk_fp8_f32(C8_(bflo(w.w)), C8_(bfhi(w.w)), b_, true);
#undef C8_
              uint2 o8; o8.x = (unsigned)a_; o8.y = (unsigned)b_;
              *(uint2*)((unsigned char*)XG + (size_t)dsts[2 * t] * D + 8 * (i & 127)) = o8; *(uint2*)((unsigned char*)XG + (size_t)dsts[2 * t + 1] * D + 8 * (i & 127)) = o8; } } }
    if (j == 0 && quarter == 0) {
        const int nt = pstart[8] >> 8;
        for (int i = tid; i < nt; i += NTHR) { int e = 0; for (int k = 1; k < 8; ++k) if (256 * i >= pstart[k]) e = k; TILEE[i] = e; }
        if (tid == 0) NTILES[0] = nt;
    }
    __syncthreads();
}
__device__ __forceinline__ int moe_ntiles(Frame& F) { return __builtin_amdgcn_readfirstlane((int)__hip_atomic_load((const unsigned*)(F.ws + WS_NTILES), RLX_AGENT)); }
__device__ __forceinline__ void phase_moe_gather(Frame& F) {
    PHASE_LOCALS();
    const int nrows = moe_ntiles(F) * 256; const int* __restrict__ ROWTOK = (const int*)(F.ws + WS_ROWTOK); const bf16* __restrict__ HB = (const bf16*)(F.ws + WS_HB); bf16* __restrict__ XG = (bf16*)(F.ws + WS_XG);
    const int total = nrows * 128, stride = F.G * NTHR;
    for (int idx0 = F.vcu * NTHR + tid; idx0 < total; idx0 += 8 * stride) {
        int tok[8]; v4u val[8];
#pragma unroll
        for (int k = 0; k < 8; ++k) { const int idx = idx0 + k * stride; tok[k] = (idx < total) ? ROWTOK[idx >> 7] : 0; }
#pragma unroll
        for (int k = 0; k < 8; ++k) { const int idx = idx0 + k * stride; val[k] = *(const v4u*)(HB + (size_t)tok[k] * D + 8 * (idx & 127)); }
#pragma unroll
        for (int k = 0; k < 8; ++k) { const int idx = idx0 + k * stride; if (idx < total) *(v4u*)(XG + (size_t)(idx >> 7) * D + 8 * (idx & 127)) = val[k]; }
    }
}
constexpr float W2_F8SCALE = 64.0f, GH_F8SCALE = 4.0f;
constexpr float W13_F8SCALE = 32.0f;
constexpr int CW_Q = 2048, CW_DONE = 3072;
constexpr int QN_E13 = 2 * (16 * 14), QN_E2 = 56 * 4;
constexpr int QN0 = NEXP * (QN_E13 + QN_E2), QN3 = (NTILES_T - P0_URGENT) + P_CHUNKS;
__device__ __forceinline__ void conv_item(Frame& F, const Inputs& in, int q, int it, int lane) {
    if (q == 3) { if (it < NTILES_T - P0_URGENT) p0_tile(F, in, P0_URGENT + it, lane); else p_chunk(F, in, it - (NTILES_T - P0_URGENT), F.wave * 64 + lane); return; }
    unsigned char* W13 = F.ws + WS_WE; unsigned char* W2 = W13 + (size_t)NEXP * 2 * DFFE * D;
    const int per = QN_E13 + QN_E2, e = it / per; int r = it % per;
    bool found = false; TrJob jb;
    jb.W = nullptr; jb.ld = 0; jb.K = 64; jb.N = 256; jb.WT = nullptr; jb.rowstep = 128; jb.row_off = 0; jb.gk = nullptr; jb.nrows = 32;
    bf16* W13e = (bf16*)(W13 + (size_t)e * 2 * DFFE * D);
    TTJOBG(in.p[I_WE1] + (size_t)e * D * DFFE, DFFE, D, DFFE, W13e, 256, 0, nullptr)
    TTJOBG(in.p[I_WE3] + (size_t)e * D * DFFE, DFFE, D, DFFE, W13e, 256, 128, nullptr)
    const bool is13 = found;
    TTJOBG(in.p[I_WE2] + (size_t)e * DFFE * D, D, DFFE, D, (bf16*)(W2 + (size_t)e * D * DFFE), 128, 0, nullptr)
    if (found) tr_tile(jb.W, jb.ld, jb.K, jb.N / 256, jb.WT, jb.rowstep, jb.row_off, (LAS float*)(F.lds + RING_OFF), r, F.wave, lane, jb.gk, false, is13 ? W13_F8SCALE : W2_F8SCALE);
}
struct TileJob0 { const float* W; unsigned char* WT; int ld, K, rowstep, row_off, k0, n0; float sc; };
__device__ __forceinline__ TileJob0 tile_job0(Frame& F, const Inputs& in, int it) {
    unsigned char* W13 = F.ws + WS_WE; unsigned char* W2 = W13 + (size_t)NEXP * 2 * DFFE * D;
    const int per = QN_E13 + QN_E2, e = it / per, r = it % per; TileJob0 j;
    if (r < QN_E13) { const int h3 = (r >= QN_E13 / 2) ? 1 : 0, rr = r - h3 * (QN_E13 / 2);
        j.W = in.p[h3 ? I_WE3 : I_WE1] + (size_t)e * D * DFFE; j.ld = DFFE; j.K = D; j.WT = W13 + (size_t)e * 2 * DFFE * D; j.rowstep = 256; j.row_off = 128 * h3; j.k0 = 64 * (rr / 14); j.n0 = 256 * (rr % 14); j.sc = W13_F8SCALE; }
    else { const int rr = r - QN_E13; j.W = in.p[I_WE2] + (size_t)e * DFFE * D; j.ld = D; j.K = DFFE; j.WT = W2 + (size_t)e * D * DFFE; j.rowstep = 128; j.row_off = 0; j.k0 = 64 * (rr / 4); j.n0 = 256 * (rr % 4); j.sc = W2_F8SCALE; }
    return j;
}
__device__ __forceinline__ void conv_queue0(Frame& F, const Inputs& in, int nitems, int stop_site, unsigned n_long) {
    PHASE_LOCALS();
    gu32* head = F.ctl + CW_Q; gu32* done = F.ctl + CW_DONE + 64 * (stop_site < 0 ? 0 : stop_site);
    volatile LAS unsigned* slot = F.MISC + 16; LAS float* scr = (LAS float*)(F.lds + RING_OFF); const int wave = F.wave;
#define Q0_TAKE() do { if (tid == 0) { unsigned b_ = 0xffffffffu; if (!(stop_site >= 0 && __hip_atomic_load(done, RLX_AGENT) >= n_long)) b_ = __hip_atomic_fetch_add(head, 1u, RLX_AGENT); slot[0] = b_; } } while (0)
#define Q0_LOAD(J, V) do { _Pragma("unroll") for (int i = 0; i < 8; ++i) V[i] = *(const f32x4*)(J.W + (size_t)(J.k0 + wave + 8 * i) * J.ld + J.n0 + 4 * lane); } while (0)
    Q0_TAKE();
    __syncthreads();
    unsigned base = slot[0];
    __syncthreads();
    if (base >= (unsigned)nitems) return;
    TileJob0 a = tile_job0(F, in, (int)base); f32x4 v[8], vn[8];
    Q0_LOAD(a, v);
    for (;;) {
        Q0_TAKE();
#pragma unroll
        for (int i = 0; i < 8; ++i) { LAS float* d = scr + (wave + 8 * i) * 257 + 4 * lane; d[0] = v[i][0]; d[1] = v[i][1]; d[2] = v[i][2]; d[3] = v[i][3]; }
        __syncthreads();
        base = slot[0];
        const bool more = base < (unsigned)nitems; TileJob0 b = a;
        if (more) { b = tile_job0(F, in, (int)base); Q0_LOAD(b, vn); }
        { const int c = tid & 7;
#pragma unroll
          for (int jj = 0; jj < 4; ++jj) { const int n = (tid >> 3) + 64 * jj; const LAS float* p = scr + (8 * c) * 257 + n; const float sc = a.sc;
              const int nn = a.n0 + n, drow = (nn >> 7) * a.rowstep + (nn & 127) + a.row_off;
              int a_ = __builtin_amdgcn_cvt_pk_fp8_f32(p[0] * sc, p[257] * sc, 0, false); a_ = __builtin_amdgcn_cvt_pk_fp8_f32(p[2 * 257] * sc, p[3 * 257] * sc, a_, true);
              int b_ = __builtin_amdgcn_cvt_pk_fp8_f32(p[4 * 257] * sc, p[5 * 257] * sc, 0, false); b_ = __builtin_amdgcn_cvt_pk_fp8_f32(p[6 * 257] * sc, p[7 * 257] * sc, b_, true);
              uint2 o8; o8.x = (unsigned)a_; o8.y = (unsigned)b_; *(uint2*)(a.WT + (size_t)drow * a.K + a.k0 + 8 * c) = o8; } }
        __syncthreads();
        if (!more) break;
        a = b;
#pragma unroll
        for (int i = 0; i < 8; ++i) v[i] = vn[i];
    }
#undef Q0_TAKE
#undef Q0_LOAD
}
__device__ __forceinline__ void conv_queue(Frame& F, const Inputs& in, int q, int nitems, int stop_site, unsigned n_long) {
    if (q == 0) { conv_queue0(F, in, nitems, stop_site, n_long); return; }
    PHASE_LOCALS();
    gu32* head = F.ctl + CW_Q + 64 * q; gu32* done = F.ctl + CW_DONE + 64 * (stop_site < 0 ? 0 : stop_site);
    volatile LAS unsigned* slot = F.MISC + 16;
    for (;;) {
        if (tid == 0) { unsigned base = 0xffffffffu;
            if (!(stop_site >= 0 && __hip_atomic_load(done, RLX_AGENT) >= n_long)) base = __hip_atomic_fetch_add(head, 1u, RLX_AGENT);
            slot[0] = base; }
        __syncthreads();
        const unsigned base = slot[0];
        __syncthreads();
        if (base >= (unsigned)nitems) break;
        conv_item(F, in, q, (int)base, lane);
    }
}
__device__ __forceinline__ void conv_fill_tail(Frame& F, const Inputs& in, int q, int nitems, int site, int mine, int maxc, int nlong) {
    if (nlong >= F.G) return;
    if (mine == maxc) { if (F.wave == 0 && lane_now() == 0) __hip_atomic_fetch_add(F.ctl + CW_DONE + 64 * site, 1u, RLX_AGENT); }
    else conv_queue(F, in, q, nitems, site, (unsigned)nlong);
}
__device__ __forceinline__ void conv_fill_all(Frame& F, const Inputs& in, int q, int nitems, int site) {
    __syncthreads();
    if (F.wave == 0 && lane_now() == 0) __hip_atomic_fetch_add(F.ctl + CW_DONE + 64 * site, 1u, RLX_AGENT);
    conv_queue(F, in, q, nitems, site, (unsigned)F.G);
}
__device__ __forceinline__ void conv_fill_tail_rr(Frame& F, const Inputs& in, int q, int nitems, int site, int nunits, int c) {
    const int maxu = (nunits + F.G - 1) / F.G, n_long = nunits - (maxu - 1) * F.G;
    conv_fill_tail(F, in, q, nitems, site, c < n_long ? maxu : maxu - 1, maxu, n_long);
}
__device__ __forceinline__ const LAS unsigned* moe_tile_table(Frame& F, int ntr) {
    LAS unsigned* tab = (LAS unsigned*)(F.lds + SM_OFF); const int tid = F.wave * 64 + lane_now();
    __syncthreads();
    if (tid < ntr) tab[tid] = __hip_atomic_load((const unsigned*)(F.ws + WS_TILEE) + tid, RLX_AGENT);
    __syncthreads();
    return tab;
}
namespace pg8 {
struct MoeOrder {
    static constexpr bool SEGMENTED = true;
    const PG8_LAS unsigned* tile_e; int ntr, nct, bpe, G, c;
    __device__ __forceinline__ bool next(int i, Unit& u) const {
        const int T = ntr * nct; long p;
        if (SEGMENTED && G % 8 == 0) { const int per = G / 8, x = c % 8, s = c / 8, seg = (T + 7) / 8; const long q = (long)i * per + s; if (q >= seg) return false; p = (long)x * seg + q; }
        else p = (long)i * G + c;
        if (p >= T) return false;
        u.pm = (int)(p / nct); u.pn = (int)(p % nct);
        const int e = __builtin_amdgcn_readfirstlane((int)tile_e[u.pm]);
        u.pb = e * bpe + u.pn; return true;
    }
    __device__ __forceinline__ int count_of(int cc) const { const int T = ntr * nct;
        if (SEGMENTED && G % 8 == 0) { const int per = G / 8, x = cc % 8, s = cc / 8, seg = (T + 7) / 8; int sx = T - x * seg; sx = sx < 0 ? 0 : (sx > seg ? seg : sx); return s < sx ? (sx - s + per - 1) / per : 0; }
        return cc < T ? (T - cc + G - 1) / G : 0; }
    __device__ __forceinline__ void tails(int& mine, int& maxc, int& nlong) const { mine = count_of(c); const int T = ntr * nct;
        if (!(SEGMENTED && G % 8 == 0)) { maxc = (T + G - 1) / G; nlong = T - (maxc - 1) * G; return; }
        const int per = G / 8, seg = (T + 7) / 8; maxc = (seg + per - 1) / per; nlong = 0;
        for (int x = 0; x < 8; ++x) { int sx = T - x * seg; sx = sx < 0 ? 0 : (sx > seg ? seg : sx); int k = sx - (maxc - 1) * per; k = k < 0 ? 0 : (k > per ? per : k); nlong += k; } }
    __device__ __forceinline__ void a_ready(const Unit&) const {}
    __device__ __forceinline__ void done(const Unit&) const {}
};
template <bool ACCUM> struct EpiY {
    static constexpr bool PERM = true, AFTER_DRAIN = false, MIDK = false; typedef NoPre::Pre Pre; __device__ __forceinline__ Pre prefetch(const Unit&, int, int) const { return Pre{}; }
    bf16_t* Y; int ldc; float osc;
    __device__ __forceinline__ void operator()(const f32x4 (&acc)[2][2][4][2], const Unit& u, int wr, int wc, int fr, int fq, const Pre&) const {
        const int row0 = u.pm * BM + wr * 64 + fr, col0 = u.pn * BM + wc * 32 + 8 * fq;
#pragma unroll
        for (int ai = 0; ai < 2; ++ai)
#pragma unroll
            for (int m = 0; m < 4; ++m) { bf16_t* rowp = Y + (size_t)(row0 + ai * HALF + m * 16) * ldc + col0;
#pragma unroll
                for (int bj = 0; bj < 2; ++bj) { f32x4 v0 = acc[ai][bj][m][0] * osc, v1 = acc[ai][bj][m][1] * osc;
                    if (ACCUM) { const u32x4 y = *(const u32x4*)(rowp + bj * HALF);
                        v0 += (f32x4){bflo(y.x), bfhi(y.x), bflo(y.y), bfhi(y.y)}; v1 += (f32x4){bflo(y.z), bfhi(y.z), bflo(y.w), bfhi(y.w)}; }
                    u32x4 w; w.x = cvt_pk_bf16(v0[0], v0[1]); w.y = cvt_pk_bf16(v0[2], v0[3]); w.z = cvt_pk_bf16(v1[0], v1[1]); w.w = cvt_pk_bf16(v1[2], v1[3]);
                    *(u32x4*)(rowp + bj * HALF) = w; } }
    }
};
}
struct Args { Inputs in; float* out; unsigned char* ws; int ph_lo, ph_hi, li, pad; };
#ifndef MLSTM_NAIVE
#define MLSTM_NAIVE 0
#endif
#ifndef ATTN_NAIVE
#define ATTN_NAIVE 0
#endif
#ifndef MOE_NAIVE
#define MOE_NAIVE 0
#endif
#ifndef MK_PER_PHASE
#define MK_PER_PHASE 0
#endif
constexpr int MAX_LAUNCH = 64;

__global__ void __launch_bounds__(NTHR, 2) mega_fwd(Args args) {
    extern __shared__ __attribute__((aligned(16))) unsigned char lds[];
    Frame F;
    F.lds = (LAS unsigned char*)lds;
    F.MISC = (volatile LAS unsigned*)(F.lds + MISC_OFF);
    F.wave = __builtin_amdgcn_readfirstlane((int)(threadIdx.x >> 6));
    F.G = gridDim.x; { const int bx = blockIdx.x; F.vcu = (F.G % 8 == 0) ? (bx % 8) * (F.G / 8) + bx / 8 : bx; }
    F.ws = args.ws; F.ctl = (gu32*)(args.ws + WS_CTL);
    const Inputs& in = args.in;
    for (int u = threadIdx.x; u < (LDS_BYTES - LDSCTL_OFF) / 4; u += NTHR) ((LAS unsigned*)(F.lds + LDSCTL_OFF))[u] = 0u;
    __syncthreads();
    XcdBarrier bar = xcd_barrier_post((unsigned*)(F.ctl + CW_BAR) + args.li * XCD_BAR_WORDS, F.MISC + 8, F.wave);
    const int lo = args.ph_lo, hi = args.ph_hi;
    int ph = 0;
__attribute__((unused)) auto phq = [](int p) { asm volatile("" : "+s"(p)); return p; };
#define RUN() (lo <= phq(ph) && phq(ph) < hi)
#define SEAM() do { if (lo <= phq(ph) && phq(ph) + 1 < hi) xcd_barrier(bar); ++ph; } while (0)
    auto wsp = [&]() { unsigned char* p_ = args.ws; asm volatile("" : "+s"(p_)); return p_; };
#define HB ((bf16*)(wsp() + WS_HB))
#define PROJ ((bf16*)(wsp() + WS_PROJ))
#define YA ((bf16*)(wsp() + WS_YA))
#define YB ((bf16*)(wsp() + WS_YB))
#define MIXED ((bf16*)(wsp() + WS_MIXED))
#define TMP ((bf16*)(wsp() + WS_TMP))
#define GH ((bf16*)(wsp() + WS_GH))
#define PP ((bf16*)(wsp() + WS_PP))
#define IFPRE ((float*)(wsp() + WS_IFPRE))
#define GSEL ((float*)(wsp() + WS_GSEL))
#define XB ((bf16*)(wsp() + WS_XB))
#define XB2 ((bf16*)(wsp() + WS_QKC))
#define SSACC ((pg8::ssq_t*)((unsigned*)(wsp() + WS_CTL) + CW_SS))
    float* const X = args.out;


#ifndef SK_P0
        if (RUN()) p0_prologue(F, in);
#endif

    SEAM();
    { constexpr int l = 0;
        const float* xs = (l == 0) ? in.p[I_X] : X;
        if (RUN()) {
            const bf16* A_ = (l == 0) ? XB : XB2; const bf16* W_ = (const bf16*)(F.ws + WS_WIN) + (size_t)l * NPROJX * D; const pg8::ssq_t* ss_ = (l == 0) ? (const pg8::ssq_t*)(F.ws + WS_SS0) : (const pg8::ssq_t*)(SSACC + 2 * M);
            { pg8::Gemm g{A_, W_, M, 1024, D}; pg8::StaticOrder S; S.init(M, 1024, F.G, (int)blockIdx.x);
              pg8::EpiQK E{PROJ, (unsigned)NPROJ, ss_, in.p[I_GQ] + l * AHD, in.p[I_GK] + l * AHD, (float*)(wsp() + WS_KMEAN), C2};
              pg8::gemm_phase<pg8::EpiQK, pg8::StaticOrder, true, true>(F.lds + RING_OFF, g, S, E, F.wave); }
            { pg8::Gemm g{A_, W_ + (size_t)1024 * D, M, NPROJX - 1024, D}; pg8::StaticOrder S; S.init(M, NPROJX - 1024, F.G, (int)blockIdx.x);
              pg8::EpiProj E{PROJ, NPROJ, PC_GA / 256, ss_, NPROJX / 256 - 1, IFPRE, in.p[I_BI] + l * MH, in.p[I_BF] + l * MH, (bf16*)(wsp() + WS_GT), 4};
              pg8::gemm_phase<pg8::EpiProj, pg8::StaticOrder, true, true>(F.lds + RING_OFF, g, S, E, F.wave);
              if (l == 0) conv_fill_tail_rr(F, in, 3, QN3, 0, (M / 256) * ((NPROJX - 1024) / 256), (int)blockIdx.x);
              else conv_fill_tail_rr(F, in, 0, QN0, 2, (M / 256) * ((NPROJX - 1024) / 256), (int)blockIdx.x); }
        }
        SEAM();
        if (RUN()) {
#if !MLSTM_NAIVE
            phase_mlstm_m1(F, in, l);
#endif
#if ATTN_NAIVE
            phase_attn_naive(F);
#else
            { const attn_body::AttnTensors AT{(const attn_body::bf16*)(PROJ + PC_Q), (const attn_body::bf16*)(PROJ + PC_K), (const attn_body::bf16*)(PROJ + PC_V), (attn_body::bf16*)YA, (const float*)(F.ws + WS_KMEAN)};
              const attn_body::StaticOrder S((int)F.G, (int)blockIdx.x);
              attn_body::attn_phase<attn_body::StaticOrder>((char*)lds + RING_OFF, AT, S, F.wave); }
#endif
        }

        SEAM();

#if MLSTM_NAIVE
        if (RUN()) phase_mlstm_naive(F, in, l);
        SEAM();
#else
        if (RUN()) { phase_mlstm_m3(F, in, l);
            if (l == 0) { conv_queue(F, in, 3, QN3, -1, 0u); conv_fill_all(F, in, 0, QN0, 5); } else conv_fill_all(F, in, 0, QN0, 4); }
        SEAM();
#endif


        if (RUN()) { pg8::Gemm g{YA, (const bf16*)(F.ws + WS_WOA) + (size_t)l * D * D, M, D, D}; pg8::StaticOrder S; S.init(M, D, F.G, (int)blockIdx.x);
            pg8::EpiMerge E{(const bf16*)(wsp() + WS_GT), MIXED, D};
            pg8::gemm_phase<pg8::EpiMerge, pg8::StaticOrder, true, true>(F.lds + RING_OFF, g, S, E, F.wave); }
        SEAM();
        if (RUN()) { pg8::Gemm g{MIXED, (const bf16*)(F.ws + WS_WOUT) + (size_t)l * D * D, M, D, D}; pg8::StaticOrder S; S.init(M, D, F.G, (int)blockIdx.x);
            pg8::EpiResid E{xs, X, D, nullptr, 0, (l == 0) ? XB : nullptr, (l == 0) ? SSACC : nullptr};
            pg8::gemm_phase<pg8::EpiResid, pg8::StaticOrder, true, true>(F.lds + RING_OFF, g, S, E, F.wave); }
        SEAM();
        if (l == 0) {
            if (RUN()) { pg8::Gemm g{XB, (const bf16*)(F.ws + WS_WD13), M, 2 * DFF, D}; pg8::StaticOrder S; S.init(M, 2 * DFF, F.G, (int)blockIdx.x);
                pg8::EpiSwiglu E{GH, DFF, SSACC, 1.0f, 0.f};
                pg8::gemm_phase<pg8::EpiSwiglu, pg8::StaticOrder, true, true>(F.lds + RING_OFF, g, S, E, F.wave);
                conv_fill_tail_rr(F, in, 0, QN0, 1, (M / 256) * (2 * DFF / 256), (int)blockIdx.x); }
            SEAM();
            if (RUN()) { pg8::Gemm g{GH, (const bf16*)(F.ws + WS_WD2), M, D, DFF}; pg8::StaticOrder S; S.init(M, D, F.G, (int)blockIdx.x);
                pg8::EpiResid E{X, X, D, nullptr, 0, XB, SSACC + M};
                pg8::gemm_phase<pg8::EpiResid, pg8::StaticOrder, true, true>(F.lds + RING_OFF, g, S, E, F.wave); }
            SEAM();
        } else {
            if (RUN()) phase_norm<2>(F, X, in.p[I_GFFN] + l * D, HB, in.p[I_WR], NEXP, nullptr, nullptr, nullptr, GSEL);
            SEAM();
#if MOE_NAIVE
            for (int e = 0; e < NEXP; ++e) {

#ifndef SK_CONVE
        if (RUN()) p_conv_expert(F, in, e);
#endif

                SEAM();
                if (RUN()) { pg8::Gemm g{HB, (const bf16*)(F.ws + WS_WE), M, 2 * DFFE, D}; pg8::StaticOrder S; S.init(M, 2 * DFFE, F.G, (int)blockIdx.x);
                    pg8::EpiSwiglu E{GH, DFFE, nullptr, 1.0f, 0.f};
                    pg8::gemm_phase<pg8::EpiSwiglu, pg8::StaticOrder, true, true>(F.lds + RING_OFF, g, S, E, F.wave); }
                SEAM();
                if (RUN()) { pg8::Gemm g{GH, (const bf16*)(F.ws + WS_WE) + (size_t)2 * DFFE * D, M, D, DFFE}; pg8::StaticOrder S; S.init(M, D, F.G, (int)blockIdx.x);
                    pg8::EpiResid E{X, X, D, GSEL + e, NEXP, nullptr, nullptr};
                    pg8::gemm_phase<pg8::EpiResid, pg8::StaticOrder, true, true>(F.lds + RING_OFF, g, S, E, F.wave); }
                SEAM();
            }
#else
            if (RUN()) { phase_moe_route(F); conv_queue(F, in, 0, QN0, -1, 0u); }
            SEAM();
            if (RUN()) { pg8::Gemm g{(const bf16*)(F.ws + WS_XG), (const bf16*)(F.ws + WS_WE), MOE_MAXROWS, 2 * DFFE, D / 2};
                const int ntr_ = moe_ntiles(F); pg8::MoeOrder S{moe_tile_table(F, ntr_), ntr_, 2 * DFFE / 256, 2 * DFFE / 256, F.G, (int)blockIdx.x};
                pg8::EpiSwiglu E{(bf16*)(F.ws + WS_GHH), DFFE, nullptr, 1.0f / W13_F8SCALE, GH_F8SCALE};
                pg8::gemm_phase<pg8::EpiSwiglu, pg8::MoeOrder, true, true, true>(F.lds + RING_OFF, g, S, E, F.wave); }
            SEAM();
            if (RUN()) { pg8::Gemm g{(const bf16*)(F.ws + WS_GHH), (const bf16*)(F.ws + WS_WE + (size_t)NEXP * 2 * DFFE * D), MOE_MAXROWS, D, DFFE / 2};
                const int ntr_ = moe_ntiles(F); pg8::MoeOrder S{moe_tile_table(F, ntr_), ntr_, D / 256, D / 256, F.G, (int)blockIdx.x};
                pg8::EpiY<false> E{(bf16*)(F.ws + WS_Y), D, 1.0f / (W2_F8SCALE * GH_F8SCALE)}; pg8::gemm_phase<pg8::EpiY<false>, pg8::MoeOrder, true, true, true>(F.lds + RING_OFF, g, S, E, F.wave); }
            SEAM();
#endif
        }
        if (l == 1) {
            if (RUN()) { if (!MOE_NAIVE) phase_norm<3>(F, X, in.p[I_GPLE] + l * D, HB, nullptr, 0, nullptr, nullptr, nullptr, nullptr);
                else phase_norm<0>(F, X, in.p[I_GPLE] + l * D, HB, nullptr, 0, nullptr, nullptr, nullptr, nullptr); }
            SEAM();
        }
        if (RUN()) {
            { pg8::Gemm g{(const bf16*)(F.ws + WS_PB) + (size_t)l * M * PLE, (const bf16*)(F.ws + WS_WPP) + (size_t)l * D * PLE, M, D, PLE}; pg8::StaticOrder S; S.init(M, D, F.G, (int)blockIdx.x);
              pg8::EpiF32 E{PP, D};
              pg8::gemm_phase<pg8::EpiF32, pg8::StaticOrder, true, true>(F.lds + RING_OFF, g, S, E, F.wave); }
            if constexpr (l == 0) { pg8::Gemm g{XB, (const bf16*)(F.ws + WS_WPG), M, D, D}; pg8::StaticOrder S; S.init(M, D, F.G, (int)blockIdx.x);
              pg8::EpiPle2 E{PP, X, D, (const pg8::ssq_t*)(SSACC + M), XB2, SSACC + 2 * M, 1.0f};
              pg8::gemm_phase<pg8::EpiPle2, pg8::StaticOrder, true, true>(F.lds + RING_OFF, g, S, E, F.wave); }
            else { pg8::Gemm g{HB, (const bf16*)(F.ws + WS_WPG) + (size_t)l * D * D, M, D, D / 2}; pg8::StaticOrder S; S.init(M, D, F.G, (int)blockIdx.x);
              pg8::EpiPle2 E{PP, X, D, nullptr, nullptr, nullptr, 1.0f / (WPG_F8SCALE * HB_F8SCALE)};
              pg8::gemm_phase<pg8::EpiPle2, pg8::StaticOrder, true, true, true>(F.lds + RING_OFF, g, S, E, F.wave); }
        }
        SEAM();
    }
    { constexpr int l = 1;
        const float* xs = (l == 0) ? in.p[I_X] : X;
        if (RUN()) {
            const bf16* A_ = (l == 0) ? XB : XB2; const bf16* W_ = (const bf16*)(F.ws + WS_WIN) + (size_t)l * NPROJX * D; const pg8::ssq_t* ss_ = (l == 0) ? (const pg8::ssq_t*)(F.ws + WS_SS0) : (const pg8::ssq_t*)(SSACC + 2 * M);
            { pg8::Gemm g{A_, W_, M, 1024, D}; pg8::StaticOrder S; S.init(M, 1024, F.G, (int)blockIdx.x);
              pg8::EpiQK E{PROJ, (unsigned)NPROJ, ss_, in.p[I_GQ] + l * AHD, in.p[I_GK] + l * AHD, (float*)(wsp() + WS_KMEAN), C2};
              pg8::gemm_phase<pg8::EpiQK, pg8::StaticOrder, true, true>(F.lds + RING_OFF, g, S, E, F.wave); }
            { pg8::Gemm g{A_, W_ + (size_t)1024 * D, M, NPROJX - 1024, D}; pg8::StaticOrder S; S.init(M, NPROJX - 1024, F.G, (int)blockIdx.x);
              pg8::EpiProj E{PROJ, NPROJ, PC_GA / 256, ss_, NPROJX / 256 - 1, IFPRE, in.p[I_BI] + l * MH, in.p[I_BF] + l * MH, (bf16*)(wsp() + WS_GT), 4};
              pg8::gemm_phase<pg8::EpiProj, pg8::StaticOrder, true, true>(F.lds + RING_OFF, g, S, E, F.wave);
              if (l == 0) conv_fill_tail_rr(F, in, 3, QN3, 0, (M / 256) * ((NPROJX - 1024) / 256), (int)blockIdx.x);
              else conv_fill_tail_rr(F, in, 0, QN0, 2, (M / 256) * ((NPROJX - 1024) / 256), (int)blockIdx.x); }
        }
        SEAM();
        if (RUN()) {
#if !MLSTM_NAIVE
            phase_mlstm_m1(F, in, l);
#endif
#if ATTN_NAIVE
            phase_attn_naive(F);
#else
            { const attn_body::AttnTensors AT{(const attn_body::bf16*)(PROJ + PC_Q), (const attn_body::bf16*)(PROJ + PC_K), (const attn_body::bf16*)(PROJ + PC_V), (attn_body::bf16*)YA, (const float*)(F.ws + WS_KMEAN)};
              const attn_body::StaticOrder S((int)F.G, (int)blockIdx.x);
              attn_body::attn_phase<attn_body::StaticOrder>((char*)lds + RING_OFF, AT, S, F.wave); }
#endif
        }

        SEAM();

#if MLSTM_NAIVE
        if (RUN()) phase_mlstm_naive(F, in, l);
        SEAM();
#else
        if (RUN()) { phase_mlstm_m3(F, in, l);
            if (l == 0) { conv_queue(F, in, 3, QN3, -1, 0u); conv_fill_all(F, in, 0, QN0, 5); } else conv_fill_all(F, in, 0, QN0, 4); }
        SEAM();
#endif


        if (RUN()) { pg8::Gemm g{YA, (const bf16*)(F.ws + WS_WOA) + (size_t)l * D * D, M, D, D}; pg8::StaticOrder S; S.init(M, D, F.G, (int)blockIdx.x);
            pg8::EpiMerge E{(const bf16*)(wsp() + WS_GT), MIXED, D};
            pg8::gemm_phase<pg8::EpiMerge, pg8::StaticOrder, true, true>(F.lds + RING_OFF, g, S, E, F.wave); }
        SEAM();
        if (RUN()) { pg8::Gemm g{MIXED, (const bf16*)(F.ws + WS_WOUT) + (size_t)l * D * D, M, D, D}; pg8::StaticOrder S; S.init(M, D, F.G, (int)blockIdx.x);
            pg8::EpiResid E{xs, X, D, nullptr, 0, (l == 0) ? XB : nullptr, (l == 0) ? SSACC : nullptr};
            pg8::gemm_phase<pg8::EpiResid, pg8::StaticOrder, true, true>(F.lds + RING_OFF, g, S, E, F.wave); }
        SEAM();
        if (l == 0) {
            if (RUN()) { pg8::Gemm g{XB, (const bf16*)(F.ws + WS_WD13), M, 2 * DFF, D}; pg8::StaticOrder S; S.init(M, 2 * DFF, F.G, (int)blockIdx.x);
                pg8::EpiSwiglu E{GH, DFF, SSACC, 1.0f, 0.f};
                pg8::gemm_phase<pg8::EpiSwiglu, pg8::StaticOrder, true, true>(F.lds + RING_OFF, g, S, E, F.wave);
                conv_fill_tail_rr(F, in, 0, QN0, 1, (M / 256) * (2 * DFF / 256), (int)blockIdx.x); }
            SEAM();
            if (RUN()) { pg8::Gemm g{GH, (const bf16*)(F.ws + WS_WD2), M, D, DFF}; pg8::StaticOrder S; S.init(M, D, F.G, (int)blockIdx.x);
                pg8::EpiResid E{X, X, D, nullptr, 0, XB, SSACC + M};
                pg8::gemm_phase<pg8::EpiResid, pg8::StaticOrder, true, true>(F.lds + RING_OFF, g, S, E, F.wave); }
            SEAM();
        } else {
            if (RUN()) phase_norm<2>(F, X, in.p[I_GFFN] + l * D, HB, in.p[I_WR], NEXP, nullptr, nullptr, nullptr, GSEL);
            SEAM();
#if MOE_NAIVE
            for (int e = 0; e < NEXP; ++e) {

#ifndef SK_CONVE
        if (RUN()) p_conv_expert(F, in, e);
#endif

                SEAM();
                if (RUN()) { pg8::Gemm g{HB, (const bf16*)(F.ws + WS_WE), M, 2 * DFFE, D}; pg8::StaticOrder S; S.init(M, 2 * DFFE, F.G, (int)blockIdx.x);
                    pg8::EpiSwiglu E{GH, DFFE, nullptr, 1.0f, 0.f};
                    pg8::gemm_phase<pg8::EpiSwiglu, pg8::StaticOrder, true, true>(F.lds + RING_OFF, g, S, E, F.wave); }
                SEAM();
                if (RUN()) { pg8::Gemm g{GH, (const bf16*)(F.ws + WS_WE) + (size_t)2 * DFFE * D, M, D, DFFE}; pg8::StaticOrder S; S.init(M, D, F.G, (int)blockIdx.x);
                    pg8::EpiResid E{X, X, D, GSEL + e, NEXP, nullptr, nullptr};
                    pg8::gemm_phase<pg8::EpiResid, pg8::StaticOrder, true, true>(F.lds + RING_OFF, g, S, E, F.wave); }
                SEAM();
            }
#else
            if (RUN()) { phase_moe_route(F); conv_queue(F, in, 0, QN0, -1, 0u); }
            SEAM();
            if (RUN()) { pg8::Gemm g{(const bf16*)(F.ws + WS_XG), (const bf16*)(F.ws + WS_WE), MOE_MAXROWS, 2 * DFFE, D / 2};
                const int ntr_ = moe_ntiles(F); pg8::MoeOrder S{moe_tile_table(F, ntr_), ntr_, 2 * DFFE / 256, 2 * DFFE / 256, F.G, (int)blockIdx.x};
                pg8::EpiSwiglu E{(bf16*)(F.ws + WS_GHH), DFFE, nullptr, 1.0f / W13_F8SCALE, GH_F8SCALE};
                pg8::gemm_phase<pg8::EpiSwiglu, pg8::MoeOrder, true, true, true>(F.lds + RING_OFF, g, S, E, F.wave); }
            SEAM();
            if (RUN()) { pg8::Gemm g{(const bf16*)(F.ws + WS_GHH), (const bf16*)(F.ws + WS_WE + (size_t)NEXP * 2 * DFFE * D), MOE_MAXROWS, D, DFFE / 2};
                const int ntr_ = moe_ntiles(F); pg8::MoeOrder S{moe_tile_table(F, ntr_), ntr_, D / 256, D / 256, F.G, (int)blockIdx.x};
                pg8::EpiY<false> E{(bf16*)(F.ws + WS_Y), D, 1.0f / (W2_F8SCALE * GH_F8SCALE)}; pg8::gemm_phase<pg8::EpiY<false>, pg8::MoeOrder, true, true, true>(F.lds + RING_OFF, g, S, E, F.wave); }
            SEAM();
#endif
        }
        if (l == 1) {
            if (RUN()) { if (!MOE_NAIVE) phase_norm<3>(F, X, in.p[I_GPLE] + l * D, HB, nullptr, 0, nullptr, nullptr, nullptr, nullptr);
                else phase_norm<0>(F, X, in.p[I_GPLE] + l * D, HB, nullptr, 0, nullptr, nullptr, nullptr, nullptr); }
            SEAM();
        }
        if (RUN()) {
            { pg8::Gemm g{(const bf16*)(F.ws + WS_PB) + (size_t)l * M * PLE, (const bf16*)(F.ws + WS_WPP) + (size_t)l * D * PLE, M, D, PLE}; pg8::StaticOrder S; S.init(M, D, F.G, (int)blockIdx.x);
              pg8::EpiF32 E{PP, D};
              pg8::gemm_phase<pg8::EpiF32, pg8::StaticOrder, true, true>(F.lds + RING_OFF, g, S, E, F.wave); }
            if constexpr (l == 0) { pg8::Gemm g{XB, (const bf16*)(F.ws + WS_WPG), M, D, D}; pg8::StaticOrder S; S.init(M, D, F.G, (int)blockIdx.x);
              pg8::EpiPle2 E{PP, X, D, (const pg8::ssq_t*)(SSACC + M), XB2, SSACC + 2 * M, 1.0f};
              pg8::gemm_phase<pg8::EpiPle2, pg8::StaticOrder, true, true>(F.lds + RING_OFF, g, S, E, F.wave); }
            else { pg8::Gemm g{HB, (const bf16*)(F.ws + WS_WPG) + (size_t)l * D * D, M, D, D / 2}; pg8::StaticOrder S; S.init(M, D, F.G, (int)blockIdx.x);
              pg8::EpiPle2 E{PP, X, D, nullptr, nullptr, nullptr, 1.0f / (WPG_F8SCALE * HB_F8SCALE)};
              pg8::gemm_phase<pg8::EpiPle2, pg8::StaticOrder, true, true, true>(F.lds + RING_OFF, g, S, E, F.wave); }
        }
        SEAM();
    }
#undef RUN
#undef HB
#undef PROJ
#undef YA
#undef YB
#undef MIXED
#undef TMP
#undef GH
#undef PP
#undef IFPRE
#undef GSEL
#undef XB
#undef XB2
#undef SSACC
#undef SEAM
}
constexpr int N_PHASES = 1 + (5 + 2 + 1) + (5 + 1 + (MOE_NAIVE ? 3 * NEXP : 3) + 2);

extern "C" void kernel_launch(void* const* d_in, const int* in_sizes, int n_in, void* d_out, int out_size, void* d_ws, size_t ws_size, hipStream_t stream) {
    static int grid = 0;
    if (grid == 0) {
        if (n_in != 25 || in_sizes[0] != M * D || out_size != M * D || ws_size < WS_END) { fprintf(stderr, "kernel_launch: unexpected shapes / workspace (n_in %d, ws %zu); nothing launched\n", n_in, ws_size); grid = -1; return; }
        int dev = 0, cus = 0, per_cu = 0;
        if (hipGetDevice(&dev) != hipSuccess || hipDeviceGetAttribute(&cus, hipDeviceAttributeMultiprocessorCount, dev) != hipSuccess) { grid = -1; return; }
        if (hipFuncSetAttribute((const void*)mega_fwd, hipFuncAttributeMaxDynamicSharedMemorySize, LDS_BYTES) != hipSuccess) { grid = -1; return; }
        if (hipOccupancyMaxActiveBlocksPerMultiprocessor(&per_cu, (const void*)mega_fwd, NTHR, LDS_BYTES) != hipSuccess || per_cu < 1) { fprintf(stderr, "kernel_launch: occupancy query reports %d\n", per_cu); }
        (void)hipGetLastError();
        grid = cus;
    }
    if (grid < 0) return;
    if (hipMemsetAsync((char*)d_ws + WS_CTL, 0, CTL_ZERO_BYTES, stream) != hipSuccess) return;
    Args a{};
    for (int i = 0; i < 25; ++i) a.in.p[i] = (const float*)d_in[i];
    a.out = (float*)d_out; a.ws = (unsigned char*)d_ws;
#if MK_PER_PHASE
    for (int li = 0; li < N_PHASES; ++li) { a.ph_lo = li; a.ph_hi = li + 1; a.li = 0; hipLaunchKernelGGL(mega_fwd, dim3(grid), dim3(NTHR), LDS_BYTES, stream, a); }
#else
    a.ph_lo = 0; a.ph_hi = N_PHASES; a.li = 0;
    hipLaunchKernelGGL(mega_fwd, dim3(grid), dim3(NTHR), LDS_BYTES, stream, a);
#endif
}
```

```cpp
#include <hip/hip_runtime.h>
#include <cstdio>
#include <cstdint>
#include <cmath>
namespace pg8 {
#define PG8_LAS __attribute__((address_space(3)))
typedef unsigned short bf16_t;
typedef short bf16x8 __attribute__((ext_vector_type(8)));
typedef float f32x4 __attribute__((ext_vector_type(4)));
typedef unsigned u32x4 __attribute__((ext_vector_type(4)));
typedef int v8i32 __attribute__((ext_vector_type(8)));
typedef int v4i32 __attribute__((ext_vector_type(4)));
constexpr int BM = 256, BK = 64, HALF = 128, HTB = HALF * BK * 2  , STAGE_BYTES = 8 * HTB, NXCD = 8, WGM = 8;

__host__ __device__ __forceinline__ int lds_byte(int r, int c) { const int st = (r >> 4) * 2 + (c >> 5), rr = r & 15, cc = c & 31, ob = rr * 64 + cc * 2; return st * 1024 + (ob ^ (((ob >> 9) & 1) << 5)); }
__host__ __device__ __forceinline__ void stage_rc(int b, int& R, int& C) { const int st = b / 1024, sb = b % 1024, swz = sb ^ (((sb >> 9) & 1) << 5); R = (st >> 1) * 16 + swz / 64; C = (st & 1) * 32 + (swz % 64) / 2; }
__host__ __device__ __forceinline__ int perm32(int rho) { const int n = rho >> 4, i = rho & 15; return 8 * (i >> 2) + 4 * n + (i & 3); }

struct Unit { int pm, pn, pb; };
struct Gemm { const bf16_t* A; const bf16_t* Bt; int M, N, K; };

struct StaticOrder {
    int nM, nN, nwg, G, c;
    __host__ __device__ void init(int M, int N, int G_, int c_) { nM = M / BM; nN = N / BM; nwg = nM * nN; G = G_; c = c_; }
    __host__ __device__ bool next(int i, Unit& u) const {
        const long L = (long)i * G + c; if (L >= nwg) return false;
        int wgid = (int)L; { const int q = nwg / NXCD, r = nwg % NXCD, xcd = wgid % NXCD, off = wgid / NXCD; wgid = (xcd < r ? xcd * (q + 1) : r * (q + 1) + (xcd - r) * q) + off; }
        const int nig = WGM * nN, gid = wgid / nig, fm = gid * WGM, gsz = (nM - fm) < WGM ? (nM - fm) : WGM;
        u.pm = fm + ((wgid % nig) % gsz); u.pn = (wgid % nig) / gsz; u.pb = u.pn; return true;
    }
    __device__ __forceinline__ void a_ready(const Unit&) const {}
    __device__ __forceinline__ void done(const Unit&) const {}
};

__device__ __forceinline__ unsigned cvt_pk_bf16(float lo, float hi) { unsigned r; asm volatile("v_cvt_pk_bf16_f32 %0, %1, %2" : "=v"(r) : "v"(lo), "v"(hi)); return r; }
template <class Epi, class Sched, bool ALIGN_EPI = false, bool SP2 = false, bool F8 = false>
__device__ __forceinline__ void gemm_phase(PG8_LAS unsigned char* lds, const Gemm g, const Sched& S, const Epi& E, int wave_in) {
    int tid_; asm volatile("v_mbcnt_lo_u32_b32 %0, -1, 0\n\tv_mbcnt_hi_u32_b32 %0, -1, %0" : "=v"(tid_)); tid_ += 64 * wave_in;
    const int tid = tid_, wid = __builtin_amdgcn_readfirstlane(tid >> 6), lane = tid & 63, wr = wid >> 2, wc = wid & 3, fr = lane & 15, fq = lane >> 4;
    const int K = g.K, nt = K / BK;
    unsigned voffA[2], voffB[2];
#pragma unroll
    for (int i = 0; i < 2; ++i) { int R, C; stage_rc(tid * 16 + i * 8192, R, C); const int Rb = Epi::PERM ? ((R & ~31) + perm32(R & 31)) : R;
        voffA[i] = (unsigned)(R * K + C) * 2u; voffB[i] = (unsigned)(Rb * K + C) * 2u; }
    const size_t kstep = (size_t)(BK * 2);
    const size_t hstep = (size_t)HALF * K * 2;
    const size_t tstep = 2 * hstep;
    const unsigned ldsw = (unsigned)wid * 1024u;
    const int aoff = lds_byte(wr * 64 + fr, fq * 8), boff = lds_byte(wc * 32 + fr, fq * 8);
    const int aofk0 = F8 ? lds_byte(wr * 64 + fr, 16 * fq) : aoff, aofk1 = F8 ? lds_byte(wr * 64 + fr, 16 * fq + 8) : aoff + 1024, bofk0 = F8 ? lds_byte(wc * 32 + fr, 16 * fq) : boff, bofk1 = F8 ? lds_byte(wc * 32 + fr, 16 * fq + 8) : boff + 1024;
#define PG8_SA(b, h) (((b) * 2 + (h)) * HTB)
#define PG8_SB(b, h) ((4 + (b) * 2 + (h)) * HTB)
#define PG8_STAGE(bufoff, gbase, voff) do { _Pragma("unroll") for (int _i = 0; _i < 2; ++_i) \
        __builtin_amdgcn_global_load_lds((const unsigned*)((const char*)(gbase) + (voff)[_i]), (PG8_LAS unsigned*)(lds + (bufoff) + ldsw + _i * 8192), 16, 0, 0); } while (0)
#define PG8_LDA(dst, b, h) do { if constexpr (F8) { _Pragma("unroll") for (int m = 0; m < 4; ++m) { dst##8[m].lo = *(const PG8_LAS v4i32*)(lds + PG8_SA(b, h) + aofk0 + m * 2048); dst##8[m].hi = *(const PG8_LAS v4i32*)(lds + PG8_SA(b, h) + aofk1 + m * 2048); } } \
        else { _Pragma("unroll") for (int m = 0; m < 4; ++m) _Pragma("unroll") for (int k = 0; k < 2; ++k) dst[m][k] = *(const PG8_LAS bf16x8*)(lds + PG8_SA(b, h) + (k ? aofk1 : aofk0) + m * 2048); } } while (0)
#define PG8_LDB(dst, b, h) do { if constexpr (F8) { _Pragma("unroll") for (int n = 0; n < 2; ++n) { dst##8[n].lo = *(const PG8_LAS v4i32*)(lds + PG8_SB(b, h) + bofk0 + n * 2048); dst##8[n].hi = *(const PG8_LAS v4i32*)(lds + PG8_SB(b, h) + bofk1 + n * 2048); } } \
        else { _Pragma("unroll") for (int n = 0; n < 2; ++n) _Pragma("unroll") for (int k = 0; k < 2; ++k) dst[n][k] = *(const PG8_LAS bf16x8*)(lds + PG8_SB(b, h) + (k ? bofk1 : bofk0) + n * 2048); } } while (0)
#define PG8_MMA(ai, bj, At, Bt) do { __builtin_amdgcn_s_setprio(1); \
        if constexpr (F8) { _Pragma("unroll") for (int m = 0; m < 4; ++m) _Pragma("unroll") for (int n = 0; n < 2; ++n) \
            asm volatile("v_mfma_scale_f32_16x16x128_f8f6f4 %0, %1, %2, %0, %3, %3 op_sel_hi:[0,0,0]" : "+v"(acc[ai][bj][m][n]) : "v"(Bt##8[n]), "v"(At##8[m]), "v"(f8one)); } \
        else { _Pragma("unroll") for (int m = 0; m < 4; ++m) _Pragma("unroll") for (int n = 0; n < 2; ++n) _Pragma("unroll") for (int k = 0; k < 2; ++k) \
            acc[ai][bj][m][n] = __builtin_amdgcn_mfma_f32_16x16x32_bf16(Bt[n][k], At[m][k], acc[ai][bj][m][n], 0, 0, 0); } \
        __builtin_amdgcn_s_setprio(0); } while (0)
#define PG8_WAIT_V(n) asm volatile("s_waitcnt vmcnt(" #n ")" ::: "memory")
#define PG8_WAIT_L(n) asm volatile("s_waitcnt lgkmcnt(" #n ")" ::: "memory")
#define PG8_BAR __builtin_amdgcn_s_barrier()
#define PG8_SCHED __builtin_amdgcn_sched_barrier(0)
    Unit cur, nxt; int ui = 0;
    if (!S.next(0, cur)) return;
    typename Epi::Pre pre = E.prefetch(cur, wr, fr);
    f32x4 acc[2][2][4][2];
#pragma unroll
    for (int a = 0; a < 2; ++a)
#pragma unroll
        for (int b = 0; b < 2; ++b)
#pragma unroll
            for (int m = 0; m < 4; ++m)
#pragma unroll
                for (int n = 0; n < 2; ++n) acc[a][b][m][n] = (f32x4){0.f, 0.f, 0.f, 0.f};
    bf16x8 At[4][2], B0[2][2], B1[2][2];
    int f8one = 0x7f7f7f7f; asm volatile("" : "+v"(f8one));
    v8i32 At8[4], B08[2], B18[2];
    const char* cA = (const char*)g.A + (size_t)cur.pm * tstep; const char* cB = (const char*)g.Bt + (size_t)cur.pb * tstep;
    S.a_ready(cur);
    if constexpr (SP2) {
        PG8_STAGE(PG8_SB(0, 0), cB, voffB); PG8_STAGE(PG8_SB(0, 1), cB + hstep, voffB); PG8_STAGE(PG8_SA(0, 0), cA, voffA); PG8_STAGE(PG8_SA(0, 1), cA + hstep, voffA);
        if (wr == 1) PG8_BAR;
        PG8_WAIT_V(2); PG8_BAR;
        PG8_STAGE(PG8_SB(1, 0), cB + kstep, voffB); PG8_STAGE(PG8_SA(1, 0), cA + kstep, voffA); PG8_STAGE(PG8_SB(1, 1), cB + hstep + kstep, voffB);
        PG8_WAIT_V(6); PG8_BAR;
    } else {
        PG8_STAGE(PG8_SB(0, 0), cB, voffB); PG8_STAGE(PG8_SA(0, 0), cA, voffA); PG8_STAGE(PG8_SB(0, 1), cB + hstep, voffB); PG8_STAGE(PG8_SA(0, 1), cA + hstep, voffA);
        if (wr == 1) PG8_BAR;
        PG8_WAIT_V(4); PG8_BAR;
        PG8_STAGE(PG8_SB(1, 0), cB + kstep, voffB); PG8_STAGE(PG8_SA(1, 0), cA + kstep, voffA); PG8_STAGE(PG8_SB(1, 1), cB + hstep + kstep, voffB);
        PG8_WAIT_V(6); PG8_BAR;
    }
    for (;;) {
        const bool has_next = S.next(ui + 1, nxt);
        const char* nA = has_next ? (const char*)g.A + (size_t)nxt.pm * tstep : cA; const char* nB = has_next ? (const char*)g.Bt + (size_t)nxt.pb * tstep : cB;
        _Pragma("nounroll") for (int t = 0; t < nt; t += 2) {
            const bool last = (t == nt - 2);
            const char* a1 = cA + (size_t)(t + 1) * kstep;
            const char* a2 = last ? nA : cA + (size_t)(t + 2) * kstep; const char* b2 = last ? nB : cB + (size_t)(t + 2) * kstep;
            const char* a3 = a2 + kstep; const char* b3 = b2 + kstep;
            if (last && has_next) S.a_ready(nxt);
            if constexpr (Epi::MIDK) { if (t == Epi::MID_T) E.mid(acc, cur, wr, wc, fr, fq); }
            if constexpr (SP2) {
            PG8_LDB(B0, 0, 0); PG8_LDB(B1, 0, 1); PG8_SCHED; PG8_LDA(At, 0, 0); PG8_STAGE(PG8_SA(1, 1), a1 + hstep, voffA);
            PG8_WAIT_V(8); PG8_WAIT_L(0); PG8_BAR; PG8_MMA(0, 0, At, B0); PG8_MMA(0, 1, At, B1); PG8_BAR; PG8_SCHED;
            PG8_LDA(At, 0, 1); PG8_STAGE(PG8_SB(0, 0), b2, voffB); PG8_STAGE(PG8_SB(0, 1), b2 + hstep, voffB); PG8_STAGE(PG8_SA(0, 0), a2, voffA);
            PG8_WAIT_V(8); PG8_WAIT_L(0); PG8_BAR; PG8_MMA(1, 0, At, B0); PG8_MMA(1, 1, At, B1); PG8_BAR; PG8_SCHED;
            PG8_LDB(B0, 1, 0); PG8_LDB(B1, 1, 1); PG8_SCHED; PG8_LDA(At, 1, 0); PG8_STAGE(PG8_SA(0, 1), a2 + hstep, voffA);
            PG8_WAIT_V(8); PG8_WAIT_L(0); PG8_BAR; PG8_MMA(0, 0, At, B0); PG8_MMA(0, 1, At, B1); PG8_BAR; PG8_SCHED;
            PG8_LDA(At, 1, 1); PG8_STAGE(PG8_SB(1, 0), b3, voffB); PG8_STAGE(PG8_SB(1, 1), b3 + hstep, voffB); PG8_STAGE(PG8_SA(1, 0), a3, voffA);
            PG8_WAIT_V(8); PG8_WAIT_L(0); PG8_BAR; PG8_MMA(1, 0, At, B0); PG8_MMA(1, 1, At, B1); PG8_BAR; PG8_SCHED;
            } else {
            PG8_LDB(B0, 0, 0); PG8_SCHED; PG8_LDA(At, 0, 0); PG8_STAGE(PG8_SA(1, 1), a1 + hstep, voffA);
            PG8_WAIT_L(8); PG8_BAR; PG8_WAIT_L(0); PG8_MMA(0, 0, At, B0); PG8_BAR; PG8_SCHED;
            PG8_LDB(B1, 0, 1); PG8_STAGE(PG8_SB(0, 0), b2, voffB);
            PG8_BAR; PG8_WAIT_L(0); PG8_MMA(0, 1, At, B1); PG8_BAR;
            PG8_LDA(At, 0, 1); PG8_STAGE(PG8_SA(0, 0), a2, voffA);
            PG8_BAR; PG8_WAIT_L(0); PG8_MMA(1, 0, At, B0); PG8_BAR; PG8_SCHED;
            PG8_STAGE(PG8_SB(0, 1), b2 + hstep, voffB);
            PG8_WAIT_V(6); PG8_BAR; PG8_MMA(1, 1, At, B1); PG8_BAR;
            PG8_LDB(B0, 1, 0); PG8_SCHED; PG8_LDA(At, 1, 0); PG8_STAGE(PG8_SA(0, 1), a2 + hstep, voffA);
            PG8_WAIT_L(8); PG8_BAR; PG8_WAIT_L(0); PG8_MMA(0, 0, At, B0); PG8_BAR; PG8_SCHED;
            PG8_LDB(B1, 1, 1); PG8_STAGE(PG8_SB(1, 0), b3, voffB);
            PG8_BAR; PG8_WAIT_L(0); PG8_MMA(0, 1, At, B1); PG8_BAR;
            PG8_LDA(At, 1, 1); PG8_STAGE(PG8_SA(1, 0), a3, voffA);
            PG8_BAR; PG8_WAIT_L(0); PG8_MMA(1, 0, At, B0); PG8_BAR; PG8_SCHED;
            PG8_STAGE(PG8_SB(1, 1), b3 + hstep, voffB);
            PG8_WAIT_V(6); PG8_BAR; PG8_MMA(1, 1, At, B1); PG8_BAR;
            }
        }
        if constexpr (ALIGN_EPI) { if (wr == 0) PG8_BAR; }
        if constexpr (F8) asm volatile("s_nop 15\n\ts_nop 15" ::: "memory");
        if constexpr (!Epi::AFTER_DRAIN) { E(acc, cur, wr, wc, fr, fq, pre); S.done(cur); }
        if (!has_next) break;
#pragma unroll
        for (int a = 0; a < 2; ++a)
#pragma unroll
            for (int b = 0; b < 2; ++b)
#pragma unroll
                for (int m = 0; m < 4; ++m)
#pragma unroll
                    for (int n = 0; n < 2; ++n) acc[a][b][m][n] = (f32x4){0.f, 0.f, 0.f, 0.f};
        cur = nxt; cA = nA; cB = nB; ++ui; pre = E.prefetch(cur, wr, fr);
        if constexpr (ALIGN_EPI) { if (wr == 1) PG8_BAR; }
    }
    PG8_WAIT_V(0);
    if constexpr (!ALIGN_EPI) { if (wr == 0) PG8_BAR; }
    PG8_BAR;
    if constexpr (Epi::AFTER_DRAIN) { E.fused(acc, cur, wr, wc, fr, fq, lds, wid, lane); S.done(cur); }
#undef PG8_SA
#undef PG8_SB
#undef PG8_STAGE
#undef PG8_LDA
#undef PG8_LDB
#undef PG8_MMA
#undef PG8_WAIT_V
#undef PG8_WAIT_L
#undef PG8_BAR
#undef PG8_SCHED
}
}
namespace pg8 {
#define PG8_GAS __attribute__((address_space(1)))
typedef unsigned u32x2 __attribute__((ext_vector_type(2)));
__device__ __forceinline__ float ex2(float x) { return __builtin_amdgcn_exp2f(x); }
__device__ __forceinline__ float sigm(float x) { return __builtin_amdgcn_rcpf(1.0f + ex2(-1.4426950408889634f * x)); }
__device__ __forceinline__ float bflo(unsigned w) { return __uint_as_float(w << 16); }
__device__ __forceinline__ float bfhi(unsigned w) { return __uint_as_float(w & 0xffff0000u); }

typedef unsigned ssq_t;
__device__ __forceinline__ ssq_t ss_fix(float v) { return (ssq_t)(v * 1024.0f); }
__device__ __forceinline__ float rstd_fix(ssq_t s) { return __builtin_amdgcn_rsqf((float)s * (1.0f / (1024.0f * 1024.0f)) + 1e-6f); }
struct NoPre { struct Pre {}; __device__ __forceinline__ Pre prefetch(const Unit&, int, int) const { return Pre{}; } };
struct SsPre { struct Pre { ssq_t s[8]; };
    __device__ __forceinline__ static Pre load(const ssq_t* ss, const Unit& u, int wr, int fr) { Pre p;
#pragma unroll
        for (int i = 0; i < 8; ++i) p.s[i] = ss ? ss[u.pm * BM + wr * 64 + fr + (i >> 2) * HALF + (i & 3) * 16] : 0u;
        return p; } };
__device__ __forceinline__ float quad_sum(float v, int fr, int fq) {
    const int lane = fr + 16 * fq;
    v += __int_as_float(__builtin_amdgcn_ds_bpermute((lane ^ 16) << 2, __float_as_int(v)));
    v += __int_as_float(__builtin_amdgcn_ds_bpermute((lane ^ 32) << 2, __float_as_int(v)));
    return v;
}
struct EpiQK {
    static constexpr bool PERM = true, AFTER_DRAIN = false, MIDK = false; typedef SsPre::Pre Pre;
    bf16_t* O; unsigned ldc; const ssq_t* ss; const float* g_q; const float* g_k; float* kmp; float qscale;
    __device__ __forceinline__ Pre prefetch(const Unit& u, int wr, int fr) const { return SsPre::load(ss, u, wr, fr); }
    __device__ __forceinline__ void operator()(const f32x4 (&acc)[2][2][4][2], const Unit& u, int wr, int wc, int fr_, int fq_, const Pre& pre) const {
        int fr = fr_, fq = fq_; asm volatile("" : "+v"(fr), "+v"(fq));
        const bool isq = u.pn < 2; const float* gg = (isq ? g_q : g_k) + 8 * fq; const float osc = isq ? qscale : 1.0f;
        f32x4 gn[2][2], cs[2][2];
#pragma unroll
        for (int bj = 0; bj < 2; ++bj)
#pragma unroll
            for (int n = 0; n < 2; ++n) { gn[bj][n] = *(const f32x4*)(gg + 32 * bj + 4 * n); cs[bj][n] = (f32x4){0.f, 0.f, 0.f, 0.f}; }
        const unsigned obase = (unsigned)(u.pm * BM + wr * 64 + fr) * ldc + (unsigned)(u.pn * BM + wc * 64 + 8 * fq);
#pragma unroll
        for (int ai = 0; ai < 2; ++ai)
#pragma unroll
            for (int m = 0; m < 4; ++m) { const float rs = rstd_fix(pre.s[ai * 4 + m]);
                float q2 = 0.f;
#pragma unroll
                for (int bj = 0; bj < 2; ++bj)
#pragma unroll
                    for (int n = 0; n < 2; ++n) { const f32x4 a = acc[ai][bj][m][n]; q2 += (a[0] * a[0] + a[1] * a[1]) + (a[2] * a[2] + a[3] * a[3]); }
                q2 = quad_sum(q2, fr, fq);
                const float rr = rs * __builtin_amdgcn_rsqf(rs * rs * q2 * (1.0f / 64.0f) + 1e-6f) * osc;
                const unsigned off = obase + (unsigned)(ai * HALF + m * 16) * ldc;
#pragma unroll
                for (int bj = 0; bj < 2; ++bj) { const f32x4 o0 = acc[ai][bj][m][0] * (gn[bj][0] * rr), o1 = acc[ai][bj][m][1] * (gn[bj][1] * rr); cs[bj][0] += o0; cs[bj][1] += o1;
                    u32x4 w; w.x = cvt_pk_bf16(o0[0], o0[1]); w.y = cvt_pk_bf16(o0[2], o0[3]); w.z = cvt_pk_bf16(o1[0], o1[1]); w.w = cvt_pk_bf16(o1[2], o1[3]);
                    *(u32x4*)(O + off + 32 * bj) = w; }
                asm volatile("" : "+v"(cs[0][0]), "+v"(cs[0][1]), "+v"(cs[1][0]), "+v"(cs[1][1]));
                __builtin_amdgcn_sched_barrier(0); }
        if (!isq) {
            const int lane = fr + 16 * fq;
#pragma unroll
            for (int o = 1; o < 16; o <<= 1)
#pragma unroll
                for (int bj = 0; bj < 2; ++bj)
#pragma unroll
                    for (int n = 0; n < 2; ++n)
#pragma unroll
                        for (int j = 0; j < 4; ++j) cs[bj][n][j] += __int_as_float(__builtin_amdgcn_ds_bpermute((lane ^ o) << 2, __float_as_int(cs[bj][n][j])));
            if (fr == 0) { float* kp = kmp + ((((unsigned)(u.pm >> 4) * 8 + (u.pn & 1) * 4 + wc) * 16 + (u.pm & 15)) * 2 + wr) * 64 + 8 * fq;
#pragma unroll
                for (int bj = 0; bj < 2; ++bj) { *(f32x4*)(kp + 32 * bj) = cs[bj][0]; *(f32x4*)(kp + 32 * bj + 4) = cs[bj][1]; } }
        }
    }
};
struct EpiProj {
    static constexpr bool PERM = true, AFTER_DRAIN = false, MIDK = false; typedef SsPre::Pre Pre;
    bf16_t* O; int ldc; int sig_from; const ssq_t* ss; int gate_tile; float* ifpre; const float* b_i; const float* b_f; bf16_t* GT; int pn0;
    __device__ __forceinline__ Pre prefetch(const Unit& u, int wr, int fr) const { return SsPre::load(ss, u, wr, fr); }
    __device__ __forceinline__ void operator()(const f32x4 (&acc)[2][2][4][2], const Unit& u_, int wr, int wc, int fr, int fq, const Pre& pre) const {
        Unit u = u_; u.pn += pn0;
        const int row0 = u.pm * BM + wr * 64 + fr, col0 = u.pn * BM + wc * 32 + 8 * fq; const bool sg = u.pn >= sig_from;
        if (u.pn == gate_tile) {
            if (wc == 0 && fq == 0) { const f32x4 bi = *(const f32x4*)b_i, bf = *(const f32x4*)b_f;
#pragma unroll
                for (int ai = 0; ai < 2; ++ai)
#pragma unroll
                    for (int m = 0; m < 4; ++m) { const int r = row0 + ai * HALF + m * 16; const float rs = rstd_fix(pre.s[ai * 4 + m]);
                        *(f32x4*)(ifpre + (size_t)r * 8) = acc[ai][0][m][0] * rs + bi; *(f32x4*)(ifpre + (size_t)r * 8 + 4) = acc[ai][0][m][1] * rs + bf; } }
            return; }
#pragma unroll
        for (int ai = 0; ai < 2; ++ai)
#pragma unroll
            for (int m = 0; m < 4; ++m) { const int r = row0 + ai * HALF + m * 16; bf16_t* rowp = O + (size_t)r * ldc + col0; const float rs = rstd_fix(pre.s[ai * 4 + m]);
#pragma unroll
                for (int bj = 0; bj < 2; ++bj) { f32x4 v0 = acc[ai][bj][m][0] * rs, v1 = acc[ai][bj][m][1] * rs;
                    if (sg) {
#pragma unroll
                        for (int j = 0; j < 4; ++j) { v0[j] = sigm(v0[j]); v1[j] = sigm(v1[j]); } }
                    u32x4 w; w.x = cvt_pk_bf16(v0[0], v0[1]); w.y = cvt_pk_bf16(v0[2], v0[3]); w.z = cvt_pk_bf16(v1[0], v1[1]); w.w = cvt_pk_bf16(v1[2], v1[3]);
                    if (sg) *(u32x4*)(GT + ((((size_t)u.pm * 8 + (u.pn - sig_from)) * 16 + (ai * 8 + m * 2 + bj)) * 8 + (wr * 4 + wc)) * 512 + (fr + 16 * fq) * 8) = w;
                    else *(u32x4*)(rowp + bj * HALF) = w; } }
    }
};
struct EpiSwiglu {
    static constexpr bool PERM = true, AFTER_DRAIN = false, MIDK = false; typedef SsPre::Pre Pre;
    bf16_t* O; int ldc; const ssq_t* ss; float osc; float f8out;
    __device__ __forceinline__ Pre prefetch(const Unit& u, int wr, int fr) const { return SsPre::load(ss, u, wr, fr); }
    __device__ __forceinline__ void operator()(const f32x4 (&acc)[2][2][4][2], const Unit& u, int wr, int wc, int fr_, int fq_, const Pre& pre) const {
        int fr = fr_, fq = fq_; asm volatile("" : "+v"(fr), "+v"(fq));
        const unsigned obase = (unsigned)(u.pm * BM + wr * 64 + fr) * (unsigned)ldc + (unsigned)(u.pn * HALF + wc * 32 + 8 * fq);
#pragma unroll
        for (int ai = 0; ai < 2; ++ai)
#pragma unroll
            for (int m = 0; m < 4; ++m) { bf16_t* rowp = O + (obase + (unsigned)(ai * HALF + m * 16) * (unsigned)ldc); const float rs = (ss ? rstd_fix(pre.s[ai * 4 + m]) : 1.0f) * osc;
                const float nl = -1.4426950408889634f * rs, ic = __builtin_amdgcn_rcpf(rs * rs * (f8out != 0.f ? f8out : 1.0f));
                f32x4 v0, v1;
#pragma unroll
                for (int j = 0; j < 4; ++j) { const float g0 = acc[ai][0][m][0][j], g1 = acc[ai][0][m][1][j];
                    v0[j] = (g0 * acc[ai][1][m][0][j]) * __builtin_amdgcn_rcpf(fmaf(ex2(g0 * nl), ic, ic)); v1[j] = (g1 * acc[ai][1][m][1][j]) * __builtin_amdgcn_rcpf(fmaf(ex2(g1 * nl), ic, ic)); }
                if (f8out != 0.f) {
#pragma unroll
                    for (int j = 0; j < 4; ++j) { v0[j] = __builtin_amdgcn_fmed3f(v0[j], -448.0f, 448.0f); v1[j] = __builtin_amdgcn_fmed3f(v1[j], -448.0f, 448.0f); }
                    int a_ = __builtin_amdgcn_cvt_pk_fp8_f32(v0[0], v0[1], 0, false); a_ = __builtin_amdgcn_cvt_pk_fp8_f32(v0[2], v0[3], a_, true);
                    int b_ = __builtin_amdgcn_cvt_pk_fp8_f32(v1[0], v1[1], 0, false); b_ = __builtin_amdgcn_cvt_pk_fp8_f32(v1[2], v1[3], b_, true);
                    u32x2 w8; w8.x = (unsigned)a_; w8.y = (unsigned)b_; *(u32x2*)((unsigned char*)O + (obase + (unsigned)(ai * HALF + m * 16) * (unsigned)ldc)) = w8; }
                else { u32x4 w; w.x = cvt_pk_bf16(v0[0], v0[1]); w.y = cvt_pk_bf16(v0[2], v0[3]); w.z = cvt_pk_bf16(v1[0], v1[1]); w.w = cvt_pk_bf16(v1[2], v1[3]);
                    *(u32x4*)rowp = w; } }
    }
};
struct EpiResid {
    static constexpr bool PERM = true, AFTER_DRAIN = false, MIDK = false; typedef NoPre::Pre Pre; __device__ __forceinline__ Pre prefetch(const Unit&, int, int) const { return Pre{}; }
    const float* base; float* out; int ldc; const float* rowscale; int rs_ld; bf16_t* xb; ssq_t* ssacc;
    __device__ __forceinline__ void operator()(const f32x4 (&acc)[2][2][4][2], const Unit& u, int wr, int wc, int fr_, int fq_, const Pre&) const {
        int fr = fr_, fq = fq_; asm volatile("" : "+v"(fr), "+v"(fq));
        const int row0 = u.pm * BM + wr * 64 + fr, col0 = u.pn * BM + wc * 32 + 8 * fq;
        const PG8_GAS float* gb_ = (const PG8_GAS float*)base;
        f32x4 bv[2][4][2][2];
#define PG8_RESID_LOAD(ai) do { _Pragma("unroll") for (int m = 0; m < 4; ++m) _Pragma("unroll") for (int bj = 0; bj < 2; ++bj) { const size_t off = (size_t)(row0 + (ai) * HALF + m * 16) * ldc + col0 + bj * HALF; \
            bv[ai][m][bj][0] = *(const PG8_GAS f32x4*)(gb_ + off); bv[ai][m][bj][1] = *(const PG8_GAS f32x4*)(gb_ + off + 4); } __builtin_amdgcn_sched_barrier(0); } while (0)
#define PG8_RESID_STEP(ai, m) do { const int r = row0 + (ai) * HALF + (m) * 16; const float s = rowscale ? rowscale[(size_t)r * rs_ld] : 1.0f; float part = 0.f; \
            _Pragma("unroll") for (int bj = 0; bj < 2; ++bj) { const size_t off = (size_t)r * ldc + col0 + bj * HALF; \
                const f32x4 v0 = bv[ai][m][bj][0] + acc[ai][bj][m][0] * s, v1 = bv[ai][m][bj][1] + acc[ai][bj][m][1] * s; \
                *(PG8_GAS f32x4*)((PG8_GAS float*)out + off) = v0; *(PG8_GAS f32x4*)((PG8_GAS float*)out + off + 4) = v1; \
                if (xb) { u32x4 w; w.x = cvt_pk_bf16(v0[0], v0[1]); w.y = cvt_pk_bf16(v0[2], v0[3]); w.z = cvt_pk_bf16(v1[0], v1[1]); w.w = cvt_pk_bf16(v1[2], v1[3]); *(PG8_GAS u32x4*)((PG8_GAS bf16_t*)xb + off) = w; } \
                part += (v0[0] * v0[0] + v0[1] * v0[1]) + (v0[2] * v0[2] + v0[3] * v0[3]) + (v1[0] * v1[0] + v1[1] * v1[1]) + (v1[2] * v1[2] + v1[3] * v1[3]); } \
            if (ssacc) { part = quad_sum(part, fr, fq); if (fq == 0) __hip_atomic_fetch_add((PG8_GAS ssq_t*)ssacc + r, ss_fix(part), __ATOMIC_RELAXED, __HIP_MEMORY_SCOPE_AGENT); } } while (0)
        PG8_RESID_LOAD(0);
        PG8_RESID_STEP(0, 0); PG8_RESID_STEP(0, 1); __builtin_amdgcn_sched_barrier(0);
        PG8_RESID_LOAD(1);
        PG8_RESID_STEP(0, 2); PG8_RESID_STEP(0, 3); PG8_RESID_STEP(1, 0); PG8_RESID_STEP(1, 1); PG8_RESID_STEP(1, 2); PG8_RESID_STEP(1, 3);
#undef PG8_RESID_LOAD
#undef PG8_RESID_STEP
    }
};
template <bool B16> struct EpiResid16 {
    static constexpr bool PERM = true, AFTER_DRAIN = false, MIDK = false; typedef NoPre::Pre Pre; __device__ __forceinline__ Pre prefetch(const Unit&, int, int) const { return Pre{}; }
    const float* base32; const bf16_t* base16; int ldc; bf16_t* xb; ssq_t* ssacc; float osc = 1.0f;
    __device__ __forceinline__ void operator()(const f32x4 (&acc)[2][2][4][2], const Unit& u, int wr, int wc, int fr_, int fq_, const Pre&) const {
        int fr = fr_, fq = fq_; asm volatile("" : "+v"(fr), "+v"(fq));
        const int row0 = u.pm * BM + wr * 64 + fr, col0 = u.pn * BM + wc * 32 + 8 * fq;
        f32x4 bv[2][4][2][B16 ? 1 : 2]; u32x4 br[2][4][2];
#define PG8_R16_LOAD(ai) do { _Pragma("unroll") for (int m = 0; m < 4; ++m) _Pragma("unroll") for (int bj = 0; bj < 2; ++bj) { const size_t off = (size_t)(row0 + (ai) * HALF + m * 16) * ldc + col0 + bj * HALF; \
            if constexpr (B16) br[ai][m][bj] = *(const PG8_GAS u32x4*)((const PG8_GAS bf16_t*)base16 + off); \
            else { bv[ai][m][bj][0] = *(const PG8_GAS f32x4*)((const PG8_GAS float*)base32 + off); bv[ai][m][bj][B16 ? 0 : 1] = *(const PG8_GAS f32x4*)((const PG8_GAS float*)base32 + off + 4); } } __builtin_amdgcn_sched_barrier(0); } while (0)
#define PG8_R16_STEP(ai, m) do { const int r = row0 + (ai) * HALF + (m) * 16; float part = 0.f; \
            _Pragma("unroll") for (int bj = 0; bj < 2; ++bj) { const size_t off = (size_t)r * ldc + col0 + bj * HALF; f32x4 b0, b1; \
                if constexpr (B16) { const u32x4 t = br[ai][m][bj]; b0 = (f32x4){bflo(t.x), bfhi(t.x), bflo(t.y), bfhi(t.y)}; b1 = (f32x4){bflo(t.z), bfhi(t.z), bflo(t.w), bfhi(t.w)}; } \
                else { b0 = bv[ai][m][bj][0]; b1 = bv[ai][m][bj][B16 ? 0 : 1]; } \
                const f32x4 v0 = b0 + acc[ai][bj][m][0] * osc, v1 = b1 + acc[ai][bj][m][1] * osc; \
                { u32x4 w; w.x = cvt_pk_bf16(v0[0], v0[1]); w.y = cvt_pk_bf16(v0[2], v0[3]); w.z = cvt_pk_bf16(v1[0], v1[1]); w.w = cvt_pk_bf16(v1[2], v1[3]); *(PG8_GAS u32x4*)((PG8_GAS bf16_t*)xb + off) = w; } \
                part += (v0[0] * v0[0] + v0[1] * v0[1]) + (v0[2] * v0[2] + v0[3] * v0[3]) + (v1[0] * v1[0] + v1[1] * v1[1]) + (v1[2] * v1[2] + v1[3] * v1[3]); } \
            if (ssacc) { part = quad_sum(part, fr, fq); if (fq == 0) __hip_atomic_fetch_add((PG8_GAS ssq_t*)ssacc + r, ss_fix(part), __ATOMIC_RELAXED, __HIP_MEMORY_SCOPE_AGENT); } } while (0)
        PG8_R16_LOAD(0);
        PG8_R16_STEP(0, 0); PG8_R16_STEP(0, 1); __builtin_amdgcn_sched_barrier(0);
        PG8_R16_LOAD(1);
        PG8_R16_STEP(0, 2); PG8_R16_STEP(0, 3); PG8_R16_STEP(1, 0); PG8_R16_STEP(1, 1); PG8_R16_STEP(1, 2); PG8_R16_STEP(1, 3);
#undef PG8_R16_LOAD
#undef PG8_R16_STEP
    }
};
struct EpiMerge {
    static constexpr bool PERM = true, AFTER_DRAIN = false, MIDK = true; static constexpr int MID_T = 8; typedef NoPre::Pre Pre; __device__ __forceinline__ Pre prefetch(const Unit&, int, int) const { return Pre{}; }
    const bf16_t* GT; bf16_t* O; int ldc;
    __device__ __forceinline__ void mid(f32x4 (&acc)[2][2][4][2], const Unit& u, int wr, int wc, int fr_, int fq_) const {
        int fr = fr_, fq = fq_; asm volatile("" : "+v"(fr), "+v"(fq));
        const PG8_GAS bf16_t* ga_ = (const PG8_GAS bf16_t*)GT + ((size_t)u.pm * 8 + u.pn) * 65536 + (size_t)(wr * 4 + wc) * 512 + (fr + 16 * fq) * 8;
#pragma unroll
        for (int ai = 0; ai < 2; ++ai) { u32x4 ga[4][2], gb[4][2];
#pragma unroll
            for (int m = 0; m < 4; ++m)
#pragma unroll
                for (int bj = 0; bj < 2; ++bj) { const size_t fo = (size_t)(ai * 8 + m * 2 + bj) * 4096; ga[m][bj] = *(const PG8_GAS u32x4*)(ga_ + fo); gb[m][bj] = *(const PG8_GAS u32x4*)(ga_ + 4 * 65536 + fo); }
            __builtin_amdgcn_sched_barrier(0);
#pragma unroll
            for (int m = 0; m < 4; ++m)
#pragma unroll
                for (int bj = 0; bj < 2; ++bj) { const u32x4 a = ga[m][bj], b = gb[m][bj];
                    const f32x4 a0 = {bflo(a.x), bfhi(a.x), bflo(a.y), bfhi(a.y)}, a1 = {bflo(a.z), bfhi(a.z), bflo(a.w), bfhi(a.w)}, b0 = {bflo(b.x), bfhi(b.x), bflo(b.y), bfhi(b.y)}, b1 = {bflo(b.z), bfhi(b.z), bflo(b.w), bfhi(b.w)};
#pragma unroll
                    for (int j = 0; j < 4; ++j) { acc[ai][bj][m][0][j] *= a0[j] * __builtin_amdgcn_rcpf(fmaxf(b0[j], 1e-30f)); acc[ai][bj][m][1][j] *= a1[j] * __builtin_amdgcn_rcpf(fmaxf(b1[j], 1e-30f)); } }
            __builtin_amdgcn_sched_barrier(0); }
    }
    __device__ __forceinline__ void operator()(const f32x4 (&acc)[2][2][4][2], const Unit& u, int wr, int wc, int fr_, int fq_, const Pre&) const {
        int fr = fr_, fq = fq_; asm volatile("" : "+v"(fr), "+v"(fq));
        const int row0 = u.pm * BM + wr * 64 + fr, col0 = u.pn * BM + wc * 32 + 8 * fq;
        const PG8_GAS bf16_t* gb_ = (const PG8_GAS bf16_t*)GT + ((size_t)u.pm * 8 + 4 + u.pn) * 65536 + (size_t)(wr * 4 + wc) * 512 + (fr + 16 * fq) * 8;
        u32x4 gb[2][4][2];
#pragma unroll
        for (int ai = 0; ai < 2; ++ai)
#pragma unroll
            for (int m = 0; m < 4; ++m)
#pragma unroll
                for (int bj = 0; bj < 2; ++bj) gb[ai][m][bj] = *(const PG8_GAS u32x4*)(gb_ + (size_t)(ai * 8 + m * 2 + bj) * 4096);
        __builtin_amdgcn_sched_barrier(0);
#pragma unroll
        for (int ai = 0; ai < 2; ++ai)
#pragma unroll
            for (int m = 0; m < 4; ++m) { const size_t r = (size_t)(row0 + ai * HALF + m * 16);
#pragma unroll
                for (int bj = 0; bj < 2; ++bj) { const u32x4 b = gb[ai][m][bj];
                    const f32x4 b0 = {bflo(b.x), bfhi(b.x), bflo(b.y), bfhi(b.y)}, b1 = {bflo(b.z), bfhi(b.z), bflo(b.w), bfhi(b.w)};
                    const f32x4 v0 = acc[ai][bj][m][0] * b0, v1 = acc[ai][bj][m][1] * b1;
                    u32x4 w; w.x = cvt_pk_bf16(v0[0], v0[1]); w.y = cvt_pk_bf16(v0[2], v0[3]); w.z = cvt_pk_bf16(v1[0], v1[1]); w.w = cvt_pk_bf16(v1[2], v1[3]);
                    *(PG8_GAS u32x4*)((PG8_GAS bf16_t*)O + r * ldc + col0 + bj * HALF) = w; } }
    }
};
struct EpiGate1 {
    static constexpr bool PERM = true, AFTER_DRAIN = false, MIDK = false; typedef NoPre::Pre Pre; __device__ __forceinline__ Pre prefetch(const Unit&, int, int) const { return Pre{}; }
    const bf16_t* G; int ldg; bf16_t* T; int ldc;
    __device__ __forceinline__ void operator()(const f32x4 (&acc)[2][2][4][2], const Unit& u, int wr, int wc, int fr, int fq, const Pre&) const {
        const int row0 = u.pm * BM + wr * 64 + fr, col0 = u.pn * BM + wc * 32 + 8 * fq;
#pragma unroll
        for (int ai = 0; ai < 2; ++ai)
#pragma unroll
            for (int m = 0; m < 4; ++m) { const size_t r = (size_t)(row0 + ai * HALF + m * 16);
#pragma unroll
                for (int bj = 0; bj < 2; ++bj) { const u32x4 g = *(const u32x4*)(G + r * ldg + col0 + bj * HALF);
                    f32x4 g0 = {bflo(g.x), bfhi(g.x), bflo(g.y), bfhi(g.y)}, g1 = {bflo(g.z), bfhi(g.z), bflo(g.w), bfhi(g.w)};
                    const f32x4 t0 = g0 * acc[ai][bj][m][0], t1 = g1 * acc[ai][bj][m][1];
                    u32x4 w; w.x = cvt_pk_bf16(t0[0], t0[1]); w.y = cvt_pk_bf16(t0[2], t0[3]); w.z = cvt_pk_bf16(t1[0], t1[1]); w.w = cvt_pk_bf16(t1[2], t1[3]);
                    *(u32x4*)(T + r * ldc + col0 + bj * HALF) = w; } }
    }
};
struct EpiGate2 {
    static constexpr bool PERM = true, AFTER_DRAIN = false, MIDK = false; typedef NoPre::Pre Pre; __device__ __forceinline__ Pre prefetch(const Unit&, int, int) const { return Pre{}; }
    const bf16_t* G; int ldg; const bf16_t* T; bf16_t* O; int ldc;
    __device__ __forceinline__ void operator()(const f32x4 (&acc)[2][2][4][2], const Unit& u, int wr, int wc, int fr, int fq, const Pre&) const {
        const int row0 = u.pm * BM + wr * 64 + fr, col0 = u.pn * BM + wc * 32 + 8 * fq;
#pragma unroll
        for (int ai = 0; ai < 2; ++ai)
#pragma unroll
            for (int m = 0; m < 4; ++m) { const size_t r = (size_t)(row0 + ai * HALF + m * 16);
#pragma unroll
                for (int bj = 0; bj < 2; ++bj) { const u32x4 g = *(const u32x4*)(G + r * ldg + col0 + bj * HALF);
                    f32x4 g0 = {bflo(g.x), bfhi(g.x), bflo(g.y), bfhi(g.y)}, g1 = {bflo(g.z), bfhi(g.z), bflo(g.w), bfhi(g.w)};
                    const u32x4 tt = *(const u32x4*)(T + r * ldc + col0 + bj * HALF);
                    const f32x4 v0 = (f32x4){bflo(tt.x), bfhi(tt.x), bflo(tt.y), bfhi(tt.y)} + g0 * acc[ai][bj][m][0], v1 = (f32x4){bflo(tt.z), bfhi(tt.z), bflo(tt.w), bfhi(tt.w)} + g1 * acc[ai][bj][m][1];
                    u32x4 w; w.x = cvt_pk_bf16(v0[0], v0[1]); w.y = cvt_pk_bf16(v0[2], v0[3]); w.z = cvt_pk_bf16(v1[0], v1[1]); w.w = cvt_pk_bf16(v1[2], v1[3]);
                    *(u32x4*)(O + r * ldc + col0 + bj * HALF) = w; } }
    }
};
struct EpiF32 {
    static constexpr bool PERM = true, AFTER_DRAIN = false, MIDK = false; typedef NoPre::Pre Pre; __device__ __forceinline__ Pre prefetch(const Unit&, int, int) const { return Pre{}; }
    bf16_t* O; int ldc;
    __device__ __forceinline__ void operator()(const f32x4 (&acc)[2][2][4][2], const Unit& u, int wr, int wc, int fr, int fq, const Pre&) const {
        const int row0 = u.pm * BM + wr * 64 + fr, col0 = u.pn * BM + wc * 32 + 8 * fq;
#pragma unroll
        for (int ai = 0; ai < 2; ++ai)
#pragma unroll
            for (int m = 0; m < 4; ++m)
#pragma unroll
                for (int bj = 0; bj < 2; ++bj) { const f32x4 v0 = acc[ai][bj][m][0], v1 = acc[ai][bj][m][1]; u32x4 w; w.x = cvt_pk_bf16(v0[0], v0[1]); w.y = cvt_pk_bf16(v0[2], v0[3]); w.z = cvt_pk_bf16(v1[0], v1[1]); w.w = cvt_pk_bf16(v1[2], v1[3]);
                    *(u32x4*)(O + (size_t)(row0 + ai * HALF + m * 16) * ldc + col0 + bj * HALF) = w; }
    }
};
struct EpiPle2 {
    static constexpr bool PERM = true, AFTER_DRAIN = false, MIDK = false; typedef NoPre::Pre Pre; __device__ __forceinline__ Pre prefetch(const Unit&, int, int) const { return Pre{}; }
    const bf16_t* PP; float* x; int ldc; const ssq_t* ss_in; bf16_t* xb; ssq_t* ssacc; float osc; const bf16_t* x16;
    __device__ __forceinline__ void operator()(const f32x4 (&acc)[2][2][4][2], const Unit& u, int wr, int wc, int fr_, int fq_, const Pre&) const {
        int fr = fr_, fq = fq_; asm volatile("" : "+v"(fr), "+v"(fq));
        const int row0 = u.pm * BM + wr * 64 + fr, col0 = u.pn * BM + wc * 32 + 8 * fq;
        const PG8_GAS float* gx_ = (const PG8_GAS float*)x; const PG8_GAS bf16_t* gp_ = (const PG8_GAS bf16_t*)PP;
        f32x4 xv[4][2][2][2]; u32x4 pv[4][2][2], xr[4][2][2]; ssq_t sv[4][2];
#define PG8_PLE_LOAD(q) do { _Pragma("unroll") for (int mm = 0; mm < 2; ++mm) { sv[q][mm] = ss_in ? ((const PG8_GAS ssq_t*)ss_in)[row0 + ((q) >> 1) * HALF + (((q) & 1) * 2 + mm) * 16] : 0u; _Pragma("unroll") for (int bj = 0; bj < 2; ++bj) { const size_t off = (size_t)(row0 + ((q) >> 1) * HALF + (((q) & 1) * 2 + mm) * 16) * ldc + col0 + bj * HALF; \
            pv[q][mm][bj] = *(const PG8_GAS u32x4*)(gp_ + off); if (x16) xr[q][mm][bj] = *(const PG8_GAS u32x4*)((const PG8_GAS bf16_t*)x16 + off); else { xv[q][mm][bj][0] = *(const PG8_GAS f32x4*)(gx_ + off); xv[q][mm][bj][1] = *(const PG8_GAS f32x4*)(gx_ + off + 4); } } } __builtin_amdgcn_sched_barrier(0); } while (0)
#define PG8_PLE_STEP(q, mm) do { constexpr int ai = (q) >> 1, m = ((q) & 1) * 2 + (mm); const int r = row0 + ai * HALF + m * 16; ssq_t sq_ = sv[q][mm]; asm volatile("" : "+v"(sq_));   const float rs = (ss_in ? rstd_fix(sq_) : 1.0f) * osc; float part = 0.f; \
            _Pragma("unroll") for (int bj = 0; bj < 2; ++bj) { const size_t off = (size_t)r * ldc + col0 + bj * HALF; \
                f32x4 a0 = acc[ai][bj][m][0] * rs, a1 = acc[ai][bj][m][1] * rs; \
                _Pragma("unroll") for (int j = 0; j < 4; ++j) { a0[j] = sigm(a0[j]); a1[j] = sigm(a1[j]); } \
                const u32x4 pw = pv[q][mm][bj]; \
                f32x4 x0_, x1_; if (x16) { const u32x4 t = xr[q][mm][bj]; x0_ = (f32x4){bflo(t.x), bfhi(t.x), bflo(t.y), bfhi(t.y)}; x1_ = (f32x4){bflo(t.z), bfhi(t.z), bflo(t.w), bfhi(t.w)}; } else { x0_ = xv[q][mm][bj][0]; x1_ = xv[q][mm][bj][1]; } \
                const f32x4 v0 = x0_ + a0 * (f32x4){bflo(pw.x), bfhi(pw.x), bflo(pw.y), bfhi(pw.y)}, v1 = x1_ + a1 * (f32x4){bflo(pw.z), bfhi(pw.z), bflo(pw.w), bfhi(pw.w)}; \
                if (x) { *(PG8_GAS f32x4*)((PG8_GAS float*)x + off) = v0; *(PG8_GAS f32x4*)((PG8_GAS float*)x + off + 4) = v1; } \
                if (xb) { u32x4 w; w.x = cvt_pk_bf16(v0[0], v0[1]); w.y = cvt_pk_bf16(v0[2], v0[3]); w.z = cvt_pk_bf16(v1[0], v1[1]); w.w = cvt_pk_bf16(v1[2], v1[3]); *(PG8_GAS u32x4*)((PG8_GAS bf16_t*)xb + off) = w; } \
                part += (v0[0] * v0[0] + v0[1] * v0[1]) + (v0[2] * v0[2] + v0[3] * v0[3]) + (v1[0] * v1[0] + v1[1] * v1[1]) + (v1[2] * v1[2] + v1[3] * v1[3]); } \
            if (ssacc) { part = quad_sum(part, fr, fq); if (fq == 0) __hip_atomic_fetch_add((PG8_GAS ssq_t*)ssacc + r, ss_fix(part), __ATOMIC_RELAXED, __HIP_MEMORY_SCOPE_AGENT); } } while (0)
        PG8_PLE_LOAD(0);
        PG8_PLE_STEP(0, 0); __builtin_amdgcn_sched_barrier(0);
        PG8_PLE_LOAD(1);
        PG8_PLE_STEP(0, 1); PG8_PLE_STEP(1, 0); __builtin_amdgcn_sched_barrier(0);
        PG8_PLE_LOAD(2);
        PG8_PLE_STEP(1, 1); PG8_PLE_STEP(2, 0); __builtin_amdgcn_sched_barrier(0);
        PG8_PLE_LOAD(3);
        PG8_PLE_STEP(2, 1); PG8_PLE_STEP(3, 0); PG8_PLE_STEP(3, 1);
#undef PG8_PLE_LOAD
#undef PG8_PLE_STEP
    }
};
}
#define GAS __attribute__((address_space(1)))
#define LAS __attribute__((address_space(3)))
typedef unsigned short bf16;
typedef unsigned v4u __attribute__((ext_vector_type(4)));
typedef float f32x4 __attribute__((ext_vector_type(4)));
typedef short bf16x8 __attribute__((ext_vector_type(8)));
typedef GAS unsigned gu32;
typedef GAS unsigned long long gu64;
#define RLX_AGENT __ATOMIC_RELAXED, __HIP_MEMORY_SCOPE_AGENT
#define LDS_WAIT() asm volatile("s_waitcnt lgkmcnt(0)" ::: "memory")
#define VM_WAIT() asm volatile("s_waitcnt vmcnt(0)" ::: "memory")
__device__ __forceinline__ unsigned long long rt() { return __builtin_amdgcn_s_memrealtime(); }
__device__ __forceinline__ unsigned f2bf(float f) { unsigned u = __builtin_bit_cast(unsigned, f); return (u + 0x7fffu + ((u >> 16) & 1u)) >> 16; }
__device__ __forceinline__ unsigned pk2(float lo, float hi) { return f2bf(lo) | (f2bf(hi) << 16); }

#define XB_TMO      128
#define XB_XCNT(j)  (256  + 64 * (j))
#define XB_XSUB(j)  (1280 + 64 * (j))
#define XB_XGEN(j)  (2304 + 64 * (j))
#define XB_TOP      3328
#define XB_TOPGEN   3392
#define XCD_BAR_WORDS 3456
#define XB_SPIN_CAP (1u << 18)

__device__ __forceinline__ unsigned xb_ld(unsigned* p)              { return __hip_atomic_load(p, __ATOMIC_RELAXED, __HIP_MEMORY_SCOPE_AGENT); }
__device__ __forceinline__ unsigned xb_add(unsigned* p, unsigned v) { return __hip_atomic_fetch_add(p, v, __ATOMIC_RELAXED, __HIP_MEMORY_SCOPE_AGENT); }
__device__ __forceinline__ unsigned xb_xcc_id() { return (unsigned)__builtin_amdgcn_s_getreg((3 << 11) | 20) & 0xFu; }
#define XB_SPIN(cond, bar) do { unsigned _sp = 0; while (cond) { __builtin_amdgcn_s_sleep(1); \
    if ((++_sp & 255u) == 0u) { if (xb_ld(&(bar)[XB_TMO])) break; if (_sp > XB_SPIN_CAP) { atomicAdd(&(bar)[XB_TMO], 1u); break; } } } } while (0)

__device__ __forceinline__ int lane_now() { int l; asm volatile("v_mbcnt_lo_u32_b32 %0, -1, 0\n\tv_mbcnt_hi_u32_b32 %0, -1, %0" : "=v"(l)); return l; }
struct XcdBarrier {
    unsigned* bar; unsigned x; int wave;
    volatile LAS unsigned* st;
};

__device__ __forceinline__ XcdBarrier xcd_barrier_post(unsigned* bar, volatile LAS unsigned* st, int wave) {
    XcdBarrier b; b.bar = bar; b.x = xb_xcc_id(); b.st = st; b.wave = wave;
    if (wave == 0 && lane_now() == 0) (void)xb_add(&bar[XB_XCNT(b.x)], 1u);
    return b;
}
__device__ __forceinline__ void xcd_barrier_complete(unsigned* bar, unsigned x, unsigned& nloc, unsigned& nx) {
    const unsigned G = gridDim.x * gridDim.y * gridDim.z;
    unsigned sum, cnt, mine, sp = 0u;
    for (;;) {
        sum = 0u; cnt = 0u; mine = 0u;
#pragma unroll
        for (unsigned j = 0; j < 16; ++j) { const unsigned c = xb_ld(&bar[XB_XCNT(j)]); sum += c; cnt += (c > 0u) ? 1u : 0u; mine = (j == x) ? c : mine; }
        if (sum == G) break;
        __builtin_amdgcn_s_sleep(1);
        if ((++sp & 255u) == 0u) { if (xb_ld(&bar[XB_TMO])) break; if (sp > XB_SPIN_CAP) { atomicAdd(&bar[XB_TMO], 1u); break; } }
    }
    nloc = mine > 0u ? mine : 1u; nx = cnt > 0u ? cnt : 1u;
}

__device__ __forceinline__ void xcd_barrier(const XcdBarrier& b) {
    asm volatile("s_waitcnt vmcnt(0)" ::: "memory");
    __syncthreads();
    if (b.wave == 0 && lane_now() == 0) {
        unsigned* bar = b.bar;
        __builtin_amdgcn_s_waitcnt(0);
        unsigned nloc = b.st[0], nx = b.st[1];
        if (nloc == 0u) { xcd_barrier_complete(bar, b.x, nloc, nx); b.st[0] = nloc; b.st[1] = nx; }
        const unsigned old = xb_add(&bar[XB_XSUB(b.x)], 1u);
        const unsigned gen = old / nloc;
        if (old + 1u == (gen + 1u) * nloc) {
            __builtin_amdgcn_fence(__ATOMIC_RELEASE, "agent");
            asm volatile("s_waitcnt vmcnt(0)" ::: "memory");
            const unsigned og = xb_add(&bar[XB_TOP], 1u);
            const unsigned tg = og / nx;
            if (og + 1u == (tg + 1u) * nx) xb_add(&bar[XB_TOPGEN], 1u);
            else XB_SPIN(xb_ld(&bar[XB_TOPGEN]) == tg, bar);
            __builtin_amdgcn_fence(__ATOMIC_ACQUIRE, "agent");
            xb_add(&bar[XB_XGEN(b.x)], 1u);
            asm volatile("s_waitcnt vmcnt(0)" ::: "memory");
        } else {
            XB_SPIN(xb_ld(&bar[XB_XGEN(b.x)]) == gen, bar);
            __builtin_amdgcn_fence(__ATOMIC_ACQUIRE, "agent");
            asm volatile("s_waitcnt vmcnt(0)" ::: "memory");
        }
    }
    __syncthreads();
}
constexpr int NWAVES = 8, NTHR = NWAVES * 64;
constexpr int BATCH = 4, SEQ = 4096, D = 1024, M = BATCH * SEQ, NIN = 5640, NPROJ = 3584, PLE = 256;
constexpr int DFF = 2816, NEXP = 8, DFFE = 3584, NLAYER = 2;
constexpr int AH = 8, AHD = 64, ABLK = 256, ANB = SEQ / ABLK;
constexpr int MH = 4, MDK = 128;
constexpr float RMS_EPS = 1e-6f;
constexpr float C2 = 0.125f * 1.4426950408889634f;
constexpr int PC_Q = 0, PC_K = 512, PC_V = 1024, PC_QKM = 1536, PC_VM = 2560, PC_OM = 3072, PC_GA = 3584, PC_GB = 4608;

constexpr size_t MiB = 1u << 20;
constexpr size_t WS_CTL = 0, CTL_ZERO_BYTES = 1 * MiB;
constexpr int NPROJX = 5888;
constexpr size_t WS_WIN = 1 * MiB, WS_WOA = 24 * MiB, WS_WOB = 26 * MiB, WS_WOUT = 28 * MiB, WS_WD13 = 32 * MiB, WS_WD2 = 43 * MiB, WS_WPG = 49 * MiB, WS_WPP = 53 * MiB, WS_PB = 54 * MiB;
constexpr size_t WS_WE = 70 * MiB;
constexpr size_t WS_SMALL = 154 * MiB;
constexpr size_t WS_XB = 161 * MiB;
constexpr size_t WS_SS0 = WS_SMALL + 5 * MiB;
constexpr size_t WS_IFPRE = WS_SMALL, WS_KMEAN = WS_SMALL + 1 * MiB, WS_GSEL = WS_SMALL + 4 * MiB;
constexpr size_t WS_HB = 161 * MiB, WS_QKC = 193 * MiB, WS_YA = 225 * MiB, WS_YB = 225 * MiB + 1024  , WS_MIXED = 257 * MiB, WS_ST = 289 * MiB, WS_PROJ = 309 * MiB, WS_XR1 = 485 * MiB  , WS_END = 517 * MiB;
constexpr size_t WS_TOPI = WS_SMALL + 2 * MiB, WS_TOPG = WS_TOPI + 256 * 1024, WS_DEST = WS_TOPG + 256 * 1024, WS_ROWTOK = WS_SMALL + 3 * MiB, WS_TILEE = WS_ROWTOK + 512 * 1024, WS_NTILES = WS_TILEE + 4096;
constexpr int MOE_MAXROWS = 2 * M + NEXP * 256;
constexpr size_t WS_WE2B = 448 * MiB;
constexpr size_t WS_XG = 193 * MiB, WS_Y = 261 * MiB, WS_GHH = 329 * MiB;
static_assert(WS_XG + (size_t)MOE_MAXROWS * D * 2 <= WS_Y && WS_Y + (size_t)MOE_MAXROWS * D * 2 <= WS_GHH && WS_GHH + (size_t)MOE_MAXROWS * DFFE <= WS_END, "MoE buffers");
constexpr size_t WS_GT = WS_PROJ + (size_t)M * NPROJ * 2;
static_assert(WS_GT + (size_t)64 * MiB <= WS_END, "gate tiles inside the old proj region");
constexpr size_t WS_TMP = WS_HB;
constexpr size_t WS_GH = WS_PROJ, WS_PP = WS_PROJ;
constexpr int CW_TMO = 0, CW_CODE = 1, CW_BAR = 4096;
constexpr int CW_SS = 65536;
static_assert((CW_SS + 3 * M) * 4 <= (int)CTL_ZERO_BYTES, "SS accumulators inside the zeroed region");

constexpr int RING_OFF = 0, RING_BYTES = 131072;
constexpr int LDSCTL_OFF = RING_BYTES, MISC_OFF = LDSCTL_OFF + 320;
constexpr int LDS_BYTES = 147456;
struct Frame {
    LAS unsigned char* lds;
    volatile LAS unsigned* MISC;
    gu32* ctl;
    int wave;
    int vcu, G;
    unsigned char* ws;
};
__device__ __forceinline__ int opaque(int v) { asm volatile("" : "+v"(v)); return v; }
#define PHASE_LOCALS() const int tid = F.wave * 64 + lane_now(), lane = tid & 63; (void)lane
__device__ __forceinline__ float shx(float v, int o, int lane) { return __int_as_float(__builtin_amdgcn_ds_bpermute((lane ^ o) << 2, __float_as_int(v))); }
__device__ __forceinline__ float wave_sum(float v, int lane) {
#pragma unroll
    for (int o = 1; o < 64; o <<= 1) v += shx(v, o, lane);
    return v;
}
__device__ __forceinline__ float wave_max(float v, int lane) {
#pragma unroll
    for (int o = 1; o < 64; o <<= 1) v = fmaxf(v, shx(v, o, lane));
    return v;
}
__device__ __forceinline__ float bf2f(bf16 u) { return __uint_as_float((unsigned)u << 16); }
__device__ __forceinline__ float bflo(unsigned w) { return __uint_as_float(w << 16); }
__device__ __forceinline__ float bfhi(unsigned w) { return __uint_as_float(w & 0xffff0000u); }
__device__ __forceinline__ float sigm(float x) { return pg8::sigm(x); }

__device__ __forceinline__ void tr_item(const float* W, int ld, int K, int N, bf16* WT, int rowstep, int row_off, LAS float* scr, int item, int lane, const float* gk = nullptr, int nrows = 32) {
    const int nblk = N / 32, kb = item / nblk, nb = item % nblk, k0 = 64 * kb, n0 = 32 * nb;
#pragma unroll 32
    for (int i = 0; i < 32; ++i) { const int kk = 2 * i + (lane >> 5); scr[kk * 33 + (lane & 31)] = W[(size_t)(k0 + kk) * ld + n0 + (lane & 31)] * (gk ? gk[k0 + kk] : 1.0f); }
    LDS_WAIT(); asm volatile("" ::: "memory");
    const int c = lane & 7;
#pragma unroll
    for (int j = 0; j < 4; ++j) { const int n = (lane >> 3) + 8 * j; const LAS float* s = scr + (8 * c) * 33 + n;
        v4u o; o.x = pk2(s[0 * 33], s[1 * 33]); o.y = pk2(s[2 * 33], s[3 * 33]); o.z = pk2(s[4 * 33], s[5 * 33]); o.w = pk2(s[6 * 33], s[7 * 33]);
        const int nn = n0 + n, drow = (nn >> 7) * rowstep + (nn & 127) + row_off;
        if (n < nrows) *(GAS v4u*)(WT + (size_t)drow * K + k0 + 8 * c) = o; }
    LDS_WAIT(); asm volatile("" ::: "memory");
}
__device__ __forceinline__ void tr_tile(const float* W, int ld, int K, int ntn, bf16* WT, int rowstep, int row_off, LAS float* scr, int tile, int wave, int lane, const float* gk, bool permqk, float f8scale = 0.f) {
    const int kb = tile / ntn, nb = tile % ntn, k0 = 64 * kb, n0 = 256 * nb;
    f32x4 v[8];
#pragma unroll
    for (int i = 0; i < 8; ++i) v[i] = *(const f32x4*)(W + (size_t)(k0 + wave + 8 * i) * ld + n0 + 4 * lane);
#pragma unroll
    for (int i = 0; i < 8; ++i) { const int k = wave + 8 * i; const float g = gk ? gk[k0 + k] : 1.0f; LAS float* d = scr + k * 257 + 4 * lane; d[0] = v[i][0] * g; d[1] = v[i][1] * g; d[2] = v[i][2] * g; d[3] = v[i][3] * g; }
    __syncthreads();
    const int tid = wave * 64 + lane, c = tid & 7;
#pragma unroll
    for (int j = 0; j < 4; ++j) { const int n = (tid >> 3) + 64 * j; const LAS float* p = scr + (8 * c) * 257 + n;
        v4u o; o.x = pk2(p[0], p[257]); o.y = pk2(p[2 * 257], p[3 * 257]); o.z = pk2(p[4 * 257], p[5 * 257]); o.w = pk2(p[6 * 257], p[7 * 257]);
        const int nn = n0 + n, drow = permqk ? (nn & ~255) + (((nn >> 5) & 1) << 7) + (((nn >> 6) & 3) << 5) + (nn & 31) + row_off : (nn >> 7) * rowstep + (nn & 127) + row_off;
        if (f8scale != 0.f) { uint2 o8; int a_ = __builtin_amdgcn_cvt_pk_fp8_f32(p[0] * f8scale, p[257] * f8scale, 0, false); a_ = __builtin_amdgcn_cvt_pk_fp8_f32(p[2 * 257] * f8scale, p[3 * 257] * f8scale, a_, true);
            int b_ = __builtin_amdgcn_cvt_pk_fp8_f32(p[4 * 257] * f8scale, p[5 * 257] * f8scale, 0, false); b_ = __builtin_amdgcn_cvt_pk_fp8_f32(p[6 * 257] * f8scale, p[7 * 257] * f8scale, b_, true);
            o8.x = (unsigned)a_; o8.y = (unsigned)b_; *(uint2*)((unsigned char*)WT + (size_t)drow * K + k0 + 8 * c) = o8; }
        else *(GAS v4u*)(WT + (size_t)drow * K + k0 + 8 * c) = o; }
    __syncthreads();
}
#define TTJOBG(W_, ld_, K_, N_, WT_, rs_, ro_, gk_) if (!found) { const int I_ = ((K_) / 64) * ((N_) / 256); if (r < I_) { jb.W = (W_); jb.ld = (ld_); jb.K = (K_); jb.N = (N_); jb.WT = (WT_); jb.rowstep = (rs_); jb.row_off = (ro_); jb.gk = (gk_); jb.nrows = 32; found = true; } else r -= I_; }
struct TrJob { const float* W; int ld, K, N; bf16* WT; int rowstep, row_off; const float* gk; int nrows; };
#define TRJOBG256(W_, ld_, K_, N_, WT_, rs_, ro_, gk_, nr_) if (!found) { const int I_ = ((K_) / 64) * ((N_) / 256); if (r < I_) { jb.W = (W_); jb.ld = (ld_); jb.K = (K_); jb.N = (N_); jb.WT = (WT_); jb.rowstep = (rs_); jb.row_off = (ro_); jb.gk = (gk_); jb.nrows = (nr_); found = true; } else r -= I_; }
constexpr float WPG_F8SCALE = 32.0f, HB_F8SCALE = 16.0f;
#define TRJOBG(W_, ld_, K_, N_, WT_, rs_, ro_, gk_, nr_) if (!found) { const int I_ = ((K_) / 64) * ((N_) / 32); if (r < I_) { jb.W = (W_); jb.ld = (ld_); jb.K = (K_); jb.N = (N_); jb.WT = (WT_); jb.rowstep = (rs_); jb.row_off = (ro_); jb.gk = (gk_); jb.nrows = (nr_); found = true; } else r -= I_; }
#define TRJOB(W_, ld_, K_, N_, WT_, rs_, ro_) TRJOBG(W_, ld_, K_, N_, WT_, rs_, ro_, nullptr, 32)

struct Inputs { const float* p[25]; };
enum { I_X = 0, I_P, I_GMIX, I_WIN, I_GQ, I_GK, I_CONVW, I_CONVB, I_BI, I_BF, I_GH, I_WOA, I_WOB, I_WOUT, I_GFFN, I_WD1, I_WD3, I_WD2, I_WR, I_WE1, I_WE3, I_WE2, I_GPLE, I_WPG, I_WPP };

constexpr int PER_LAYER_T = 16 * 4 + 16 * 10 + 16 * 8 + 2 * (8 * 4) + 2 * (16 * 4) + 4 * 4, NTILES_T = 2 * PER_LAYER_T + 2 * (16 * 11) + 44 * 4, P0_URGENT = 16 * 4 + 16 * 10 + 16 * 8;
__device__ __forceinline__ bool p0_job(Frame& F, const Inputs& in, int r_in, TrJob& jb, int& r_out) {
    int r = r_in; bool found = false;
            jb.W = nullptr; jb.ld = 0; jb.K = 64; jb.N = 256; jb.WT = nullptr; jb.rowstep = 128; jb.row_off = 0; jb.gk = nullptr; jb.nrows = 32;
#pragma unroll
            for (int l = 0; l < 2; ++l) {
                if (!found) { const int I_ = 16 * 4; if (r < I_) { jb.W = in.p[I_WIN] + (size_t)l * D * NIN; jb.ld = NIN; jb.K = D; jb.N = 1024; jb.WT = (bf16*)(F.ws + WS_WIN) + (size_t)l * NPROJX * D; jb.rowstep = 128; jb.row_off = 0; jb.gk = in.p[I_GMIX] + l * D; jb.nrows = 33; found = true; } else r -= I_; }
                TTJOBG(in.p[I_WIN] + (size_t)l * D * NIN + 1024, NIN, D, 2560, (bf16*)(F.ws + WS_WIN) + (size_t)l * NPROJX * D, 128, 1024, in.p[I_GMIX] + l * D)
                TTJOBG(in.p[I_WIN] + (size_t)l * D * NIN + 3592, NIN, D, 2048, (bf16*)(F.ws + WS_WIN) + (size_t)l * NPROJX * D, 128, 3584, in.p[I_GMIX] + l * D)
                if (!found) { const int I_ = 8 * 4; if (r < I_) { jb.W = in.p[I_WOA] + (size_t)l * 512 * D; jb.ld = D; jb.K = D; jb.N = D; jb.WT = (bf16*)(F.ws + WS_WOA) + (size_t)l * D * D; jb.rowstep = 128; jb.row_off = 0; jb.gk = nullptr; found = true; } else r -= I_; }
                if (!found) { const int I_ = 8 * 4; if (r < I_) { jb.W = in.p[I_WOB] + (size_t)l * 512 * D; jb.ld = D; jb.K = D; jb.N = D; jb.WT = (bf16*)(F.ws + WS_WOA) + (size_t)l * D * D + 512; jb.rowstep = 128; jb.row_off = 0; jb.gk = nullptr; found = true; } else r -= I_; }
                TTJOBG(in.p[I_WOUT] + (size_t)l * D * D, D, D, D, (bf16*)(F.ws + WS_WOUT) + (size_t)l * D * D, 128, 0, nullptr)
                TRJOBG256(in.p[I_WPG] + (size_t)l * D * D, D, D, D, (bf16*)(F.ws + WS_WPG) + (size_t)l * D * D, 128, 0, (l == 0) ? in.p[I_GPLE] : nullptr, (l == 0) ? 32 : 34)
                TTJOBG(in.p[I_WPP] + (size_t)l * PLE * D, D, PLE, D, (bf16*)(F.ws + WS_WPP) + (size_t)l * D * PLE, 128, 0, nullptr)
            }
            TTJOBG(in.p[I_WD1], DFF, D, DFF, (bf16*)(F.ws + WS_WD13), 256, 0, in.p[I_GFFN])
            TTJOBG(in.p[I_WD3], DFF, D, DFF, (bf16*)(F.ws + WS_WD13), 256, 128, in.p[I_GFFN])
            TRJOBG256(in.p[I_WD2], D, DFF, D, (bf16*)(F.ws + WS_WD2), 128, 0, nullptr, 34)
    r_out = r; return found;
}
__device__ __forceinline__ void p0_tile(Frame& F, const Inputs& in, int r_in, int lane) {
    TrJob jb; int r;
    if (p0_job(F, in, r_in, jb, r)) tr_tile(jb.W, jb.ld, jb.K, jb.N / 256, jb.WT, jb.rowstep, jb.row_off, (LAS float*)(F.lds + RING_OFF), r, F.wave, lane, jb.gk, jb.nrows == 33, jb.nrows == 34 ? WPG_F8SCALE : 0.f);
}
constexpr int P_CHUNKS = 64;
__device__ __forceinline__ void p_chunk(Frame& F, const Inputs& in, int c, int tid) {
    const size_t n8 = (size_t)2 * M * PLE / 8, per = n8 / P_CHUNKS;
    for (size_t i = (size_t)c * per + tid; i < (size_t)(c + 1) * per; i += NTHR) {
        const f32x4 a = *(const f32x4*)(in.p[I_P] + i * 8), b = *(const f32x4*)(in.p[I_P] + i * 8 + 4);
        v4u o; o.x = pk2(a[0], a[1]); o.y = pk2(a[2], a[3]); o.z = pk2(b[0], b[1]); o.w = pk2(b[2], b[3]);
        *(v4u*)((bf16*)(F.ws + WS_PB) + i * 8) = o; }
}
__device__ __forceinline__ void p0_prologue(Frame& F, const Inputs& in, int parts = 7) {
    PHASE_LOCALS();
    LAS float* scr = (LAS float*)(F.lds + RING_OFF + F.wave * 16384);
    const int gw = F.vcu * NWAVES + F.wave, NGW = F.G * NWAVES;
    if (parts & 1) {
        for (int it = F.vcu; it < P0_URGENT; it += F.G) p0_tile(F, in, it, lane);
        for (int it = gw; it < 32; it += NGW) { const int l = it >> 4;
            tr_item(in.p[I_WIN] + (size_t)l * D * NIN + 3584, NIN, D, 32, (bf16*)(F.ws + WS_WIN) + (size_t)l * NPROJX * D, 128, 5632, scr, it & 15, lane, in.p[I_GMIX] + l * D, 8); }
    }
    if (parts & 2) { GAS pg8::ssq_t* SS0 = (GAS pg8::ssq_t*)(F.ws + WS_SS0); GAS bf16* XB = (GAS bf16*)(F.ws + WS_XB); const GAS float* xg = (const GAS float*)in.p[I_X];
      f32x4 vn[4];
#pragma unroll
      for (int j = 0; j < 4; ++j) vn[j] = (gw < M) ? ((const GAS f32x4*)(xg + (size_t)gw * D) + lane)[64 * j] : (f32x4){0.f, 0.f, 0.f, 0.f};
      for (int m = gw; m < M; m += NGW) { f32x4 v[4]; float ss = 0.f;
#pragma unroll
          for (int j = 0; j < 4; ++j) v[j] = vn[j];
          if (m + NGW < M) {
#pragma unroll
              for (int j = 0; j < 4; ++j) vn[j] = ((const GAS f32x4*)(xg + (size_t)(m + NGW) * D) + lane)[64 * j]; }
          GAS unsigned long long* o8 = (GAS unsigned long long*)(XB + (size_t)m * D) + lane;
#pragma unroll
          for (int j = 0; j < 4; ++j) { ss += (v[j][0] * v[j][0] + v[j][1] * v[j][1]) + (v[j][2] * v[j][2] + v[j][3] * v[j][3]); o8[64 * j] = (unsigned long long)pk2(v[j][0], v[j][1]) | ((unsigned long long)pk2(v[j][2], v[j][3]) << 32); }
          ss = wave_sum(ss, lane); if (lane == 0) SS0[m] = pg8::ss_fix(ss); } }
}
__device__ __forceinline__ void p_conv_expert(Frame& F, const Inputs& in, int e) {
    PHASE_LOCALS();
    LAS float* scr = (LAS float*)(F.lds + RING_OFF + F.wave * 16384);
    const int gw = F.vcu * NWAVES + F.wave, NGW = F.G * NWAVES;
    constexpr int NITEMS = 2 * (16 * 112) + 56 * 32;
    bf16* W13 = (bf16*)(F.ws + WS_WE); bf16* W2 = W13 + (size_t)2 * DFFE * D;
    for (int it = gw; it < NITEMS; it += NGW) {
        int r = it; bool found = false; TrJob jb;
        jb.W = nullptr; jb.ld = 0; jb.K = 64; jb.N = 32; jb.WT = nullptr; jb.rowstep = 128; jb.row_off = 0; jb.gk = nullptr; jb.nrows = 32;
        TRJOB(in.p[I_WE1] + (size_t)e * D * DFFE, DFFE, D, DFFE, W13, 256, 0)
        TRJOB(in.p[I_WE3] + (size_t)e * D * DFFE, DFFE, D, DFFE, W13, 256, 128)
        TRJOB(in.p[I_WE2] + (size_t)e * DFFE * D, D, DFFE, D, W2, 128, 0)
        if (found) tr_item(jb.W, jb.ld, jb.K, jb.N, jb.WT, jb.rowstep, jb.row_off, scr, r, lane, jb.gk, jb.nrows);
    }
}

typedef unsigned v2u_ __attribute__((ext_vector_type(2))); typedef float v2f_ __attribute__((ext_vector_type(2))); typedef int v2i_ __attribute__((ext_vector_type(2)));
template <int MODE>
__device__ __forceinline__ void phase_norm(Frame& F, const float* xsrc, const float* g, bf16* hb, const float* wx, int ldw, const float* b_i, const float* b_f, float* ifpre, float* gsel, bf16* x16 = nullptr) {
    PHASE_LOCALS();
    LAS float* wl = (LAS float*)F.lds;
    if (MODE == 1 || MODE == 2) {
        for (int i = tid; i < 1024 * 2; i += NTHR) { const int c = i >> 1, hlf = i & 1; *(LAS f32x4*)(wl + c * 8 + 4 * hlf) = *(const f32x4*)(wx + (size_t)c * ldw + 4 * hlf); }
        __syncthreads();
    }
    const int gw = F.vcu * NWAVES + F.wave, NGW = F.G * NWAVES;
    f32x4 gv[4];
#pragma unroll
    for (int j = 0; j < 4; ++j) gv[j] = ((const GAS f32x4*)g)[lane + 64 * j];
    f32x4 vn[4]; v2u_ vnr[4]; uint2 yan[4], ybn[4]; float2 tgn = make_float2(0.f, 0.f), tgc = tgn; int2 tdn = make_int2(0, 0);
#pragma unroll
    for (int j = 0; j < 4; ++j) { vn[j] = (f32x4){0.f, 0.f, 0.f, 0.f}; vnr[j] = (v2u_){0u, 0u}; yan[j] = make_uint2(0u, 0u); ybn[j] = make_uint2(0u, 0u); }
    if (gw < M) {
        if (MODE == 3) { { const v2f_ t_ = *(const GAS v2f_*)((const GAS float*)(F.ws + WS_TOPG) + (size_t)gw * 2); tgc = make_float2(t_.x, t_.y); } const v2i_ td0 = *(const GAS v2i_*)((const GAS int*)(F.ws + WS_DEST) + (size_t)gw * 2);
            const GAS bf16* y1 = (const GAS bf16*)(F.ws + WS_Y) + (size_t)td0.x * D; const GAS bf16* y2 = (const GAS bf16*)(F.ws + WS_Y) + (size_t)td0.y * D;
#pragma unroll
            for (int j = 0; j < 4; ++j) { { const v2u_ a_ = *(const GAS v2u_*)(y1 + 4 * lane + 256 * j), b_ = *(const GAS v2u_*)(y2 + 4 * lane + 256 * j); yan[j] = make_uint2(a_.x, a_.y); ybn[j] = make_uint2(b_.x, b_.y); } }
            if (gw + NGW < M) { { const v2f_ t_ = *(const GAS v2f_*)((const GAS float*)(F.ws + WS_TOPG) + (size_t)(gw + NGW) * 2); tgn = make_float2(t_.x, t_.y); const v2i_ d_ = *(const GAS v2i_*)((const GAS int*)(F.ws + WS_DEST) + (size_t)(gw + NGW) * 2); tdn = make_int2(d_.x, d_.y); } } }
#pragma unroll
        for (int j = 0; j < 4; ++j) { if (x16) vnr[j] = *(const GAS v2u_*)((const GAS bf16*)x16 + (size_t)gw * D + 4 * lane + 256 * j); else vn[j] = ((const GAS f32x4*)((const GAS float*)xsrc + (size_t)gw * D) + lane)[64 * j]; }
    }
    for (int m = gw; m < M; m += NGW) {
        f32x4 v[4]; uint2 ya[4], yb[4]; float s = 0.f; const float2 tg = tgc;
#pragma unroll
        for (int j = 0; j < 4; ++j) { if (x16) { const v2u_ t_ = vnr[j]; v[j] = (f32x4){bflo(t_.x), bfhi(t_.x), bflo(t_.y), bfhi(t_.y)}; } else v[j] = vn[j]; ya[j] = yan[j]; yb[j] = ybn[j]; }
        if (m + NGW < M) {
            const int mn = m + NGW;
            if (MODE == 3) { tgc = tgn; const GAS bf16* y1 = (const GAS bf16*)(F.ws + WS_Y) + (size_t)tdn.x * D; const GAS bf16* y2 = (const GAS bf16*)(F.ws + WS_Y) + (size_t)tdn.y * D;
#pragma unroll
                for (int j = 0; j < 4; ++j) { { const v2u_ a_ = *(const GAS v2u_*)(y1 + 4 * lane + 256 * j), b_ = *(const GAS v2u_*)(y2 + 4 * lane + 256 * j); yan[j] = make_uint2(a_.x, a_.y); ybn[j] = make_uint2(b_.x, b_.y); } }
                if (mn + NGW < M) { { const v2f_ t_ = *(const GAS v2f_*)((const GAS float*)(F.ws + WS_TOPG) + (size_t)(mn + NGW) * 2); tgn = make_float2(t_.x, t_.y); const v2i_ d_ = *(const GAS v2i_*)((const GAS int*)(F.ws + WS_DEST) + (size_t)(mn + NGW) * 2); tdn = make_int2(d_.x, d_.y); } } }
#pragma unroll
            for (int j = 0; j < 4; ++j) { if (x16) vnr[j] = *(const GAS v2u_*)((const GAS bf16*)x16 + (size_t)mn * D + 4 * lane + 256 * j); else vn[j] = ((const GAS f32x4*)((const GAS float*)xsrc + (size_t)mn * D) + lane)[64 * j]; }
        }
        if (MODE == 3) {
#pragma unroll
            for (int j = 0; j < 4; ++j) { const uint2 a = ya[j], b = yb[j];
                v[j][0] += tg.x * bflo(a.x) + tg.y * bflo(b.x); v[j][1] += tg.x * bfhi(a.x) + tg.y * bfhi(b.x); v[j][2] += tg.x * bflo(a.y) + tg.y * bflo(b.y); v[j][3] += tg.x * bfhi(a.y) + tg.y * bfhi(b.y);
                if (x16) *(GAS v2u_*)((GAS bf16*)x16 + (size_t)m * D + 4 * lane + 256 * j) = (v2u_){pk2(v[j][0], v[j][1]), pk2(v[j][2], v[j][3])};
                else ((GAS f32x4*)((GAS float*)const_cast<float*>(xsrc) + (size_t)m * D))[lane + 64 * j] = v[j]; }
        }
#pragma unroll
        for (int j = 0; j < 4; ++j) s += (v[j][0] * v[j][0] + v[j][1] * v[j][1]) + (v[j][2] * v[j][2] + v[j][3] * v[j][3]);
        const float rstd = 1.0f / sqrtf(wave_sum(s, lane) * (1.0f / D) + RMS_EPS);
        GAS unsigned long long* o8 = (GAS unsigned long long*)((GAS bf16*)hb + (size_t)m * D) + lane;
#pragma unroll
        for (int j = 0; j < 4; ++j) { v[j] = v[j] * rstd * gv[j];
            if (MODE == 3) {
                int a_ = __builtin_amdgcn_cvt_pk_fp8_f32(__builtin_amdgcn_fmed3f(v[j][0] * HB_F8SCALE, -448.0f, 448.0f), __builtin_amdgcn_fmed3f(v[j][1] * HB_F8SCALE, -448.0f, 448.0f), 0, false);
                a_ = __builtin_amdgcn_cvt_pk_fp8_f32(__builtin_amdgcn_fmed3f(v[j][2] * HB_F8SCALE, -448.0f, 448.0f), __builtin_amdgcn_fmed3f(v[j][3] * HB_F8SCALE, -448.0f, 448.0f), a_, true);
                ((GAS unsigned*)((GAS unsigned char*)hb + (size_t)m * D))[lane + 64 * j] = (unsigned)a_; }
            else if (MODE == 2) {
                int a_ = __builtin_amdgcn_cvt_pk_fp8_f32(__builtin_amdgcn_fmed3f(v[j][0], -448.0f, 448.0f), __builtin_amdgcn_fmed3f(v[j][1], -448.0f, 448.0f), 0, false);
                a_ = __builtin_amdgcn_cvt_pk_fp8_f32(__builtin_amdgcn_fmed3f(v[j][2], -448.0f, 448.0f), __builtin_amdgcn_fmed3f(v[j][3], -448.0f, 448.0f), a_, true);
                ((GAS unsigned*)((GAS unsigned char*)hb + (size_t)m * D))[lane + 64 * j] = (unsigned)a_; }
            else o8[64 * j] = (unsigned long long)pk2(v[j][0], v[j][1]) | ((unsigned long long)pk2(v[j][2], v[j][3]) << 32); }
        if (MODE == 1 || MODE == 2) {
            float a[8];
#pragma unroll
            for (int k = 0; k < 8; ++k) a[k] = 0.f;
#pragma unroll
            for (int j = 0; j < 4; ++j)
#pragma unroll
                for (int q = 0; q < 4; ++q) { const int c = 4 * lane + 256 * j + q; const f32x4 w0 = *(const LAS f32x4*)(wl + c * 8), w1 = *(const LAS f32x4*)(wl + c * 8 + 4); const float y = v[j][q];
                    a[0] += y * w0[0]; a[1] += y * w0[1]; a[2] += y * w0[2]; a[3] += y * w0[3]; a[4] += y * w1[0]; a[5] += y * w1[1]; a[6] += y * w1[2]; a[7] += y * w1[3]; }
#pragma unroll
            for (int k = 0; k < 8; ++k) a[k] = wave_sum(a[k], lane);
            if (MODE == 1) {
                if (lane == 0) {
                    f32x4 o0 = {a[0] + b_i[0], a[1] + b_i[1], a[2] + b_i[2], a[3] + b_i[3]}, o1 = {a[4] + b_f[0], a[5] + b_f[1], a[6] + b_f[2], a[7] + b_f[3]};
                    *(f32x4*)(ifpre + (size_t)m * 8) = o0; *(f32x4*)(ifpre + (size_t)m * 8 + 4) = o1; }
            } else {
                int i1 = 0; float v1 = a[0];
#pragma unroll
                for (int k = 1; k < 8; ++k) if (a[k] > v1) { v1 = a[k]; i1 = k; }
                int i2 = -1; float v2 = -INFINITY;
#pragma unroll
                for (int k = 0; k < 8; ++k) if (k != i1 && a[k] > v2) { v2 = a[k]; i2 = k; }
                const float g1 = 1.0f / (1.0f + expf(v2 - v1)), g2 = 1.0f - g1;
                if (lane < 8) ((GAS float*)gsel)[(size_t)m * 8 + lane] = (lane == i1) ? g1 : (lane == i2) ? g2 : 0.f;
                if (lane == 0) { *(GAS v2i_*)((GAS int*)(F.ws + WS_TOPI) + (size_t)m * 2) = (v2i_){i1, i2}; *(GAS v2f_*)((GAS float*)(F.ws + WS_TOPG) + (size_t)m * 2) = (v2f_){g1, g2}; }
            }
        }
    }
    if (MODE == 1 || MODE == 2) __syncthreads();
}

__device__ __forceinline__ void phase_prep(Frame& F, const Inputs& in, int l, int parts = 3) {
    PHASE_LOCALS();
    bf16* PROJ = (bf16*)(F.ws + WS_PROJ); float* kmean = (float*)(F.ws + WS_KMEAN); bf16* QKC = (bf16*)(F.ws + WS_QKC);
    const float* gq = in.p[I_GQ] + l * AHD; const float* gk = in.p[I_GK] + l * AHD;
    LAS float* kt = (LAS float*)F.lds; LAS float* part = kt + 256 * 65;
    if (parts & 1) for (int u = F.vcu; u < (M / 256) * AH; u += F.G) {
        const int pm = u >> 3, h = u & 7, row = tid >> 1, hf = tid & 1; const size_t grow = (size_t)pm * 256 + row;
#pragma unroll
        for (int which = 0; which < 2; ++which) {
            bf16* ptr = PROJ + grow * NPROJ + (which ? PC_K : PC_Q) + h * AHD + hf * 32; const float* gg = (which ? gk : gq) + hf * 32;
            bf16* optr = (parts & 4) ? (bf16*)(F.ws + WS_MIXED) + (grow & 255) * NPROJ + (which ? PC_K : PC_Q) + h * AHD + hf * 32 : ptr;
            float v[32]; float ss = 0.f;
#pragma unroll
            for (int i = 0; i < 4; ++i) { const v4u w = *(const v4u*)(ptr + 8 * i);
                v[8 * i + 0] = bflo(w.x); v[8 * i + 1] = bfhi(w.x); v[8 * i + 2] = bflo(w.y); v[8 * i + 3] = bfhi(w.y); v[8 * i + 4] = bflo(w.z); v[8 * i + 5] = bfhi(w.z); v[8 * i + 6] = bflo(w.w); v[8 * i + 7] = bfhi(w.w); }
#pragma unroll
            for (int i = 0; i < 32; ++i) ss += v[i] * v[i];
            ss += shx(ss, 1, lane);
            const float r = (1.0f / sqrtf(ss * (1.0f / AHD) + RMS_EPS)) * (which ? 1.0f : C2);
#pragma unroll
            for (int i = 0; i < 32; ++i) v[i] = v[i] * r * gg[i];
            if (which) {
#pragma unroll
                for (int i = 0; i < 32; ++i) kt[row * 65 + hf * 32 + i] = v[i]; }
#pragma unroll
            for (int i = 0; i < 4; ++i) { v4u o; o.x = pk2(v[8 * i], v[8 * i + 1]); o.y = pk2(v[8 * i + 2], v[8 * i + 3]); o.z = pk2(v[8 * i + 4], v[8 * i + 5]); o.w = pk2(v[8 * i + 6], v[8 * i + 7]); *(v4u*)(optr + 8 * i) = o; }
        }
        __syncthreads();
        { const int c = tid & 63, pt = tid >> 6; float s = 0.f;
            for (int i = 0; i < 32; ++i) s += kt[(pt * 32 + i) * 65 + c];
            part[pt * 64 + c] = s; }
        __syncthreads();
        if (tid < 64) { float tot = 0.f;
#pragma unroll
            for (int pt = 0; pt < 8; ++pt) tot += part[pt * 64 + tid];
            const int b = pm >> 4, n = pm & 15;
            ((parts & 4) ? (float*)(F.ws + WS_MIXED) + 4 * 1024 * 1024 : kmean)[(((size_t)(b * AH + h)) * ANB + n) * AHD + tid] = tot * (1.0f / ABLK); }
        __syncthreads();
    }
    if (parts & 2) {
        const float* cw = in.p[I_CONVW] + (size_t)l * 4 * 1024; const float* cb = in.p[I_CONVB] + (size_t)l * 1024;
        const int ch = tid & 127, c0 = ch * 8; const float sc = (c0 >= 512) ? 0.08838834764831845f : 1.0f;
        float w[4][8], bia[8];
#pragma unroll
        for (int j = 0; j < 4; ++j) { const f32x4 w0 = *(const f32x4*)(cw + j * 1024 + c0), w1 = *(const f32x4*)(cw + j * 1024 + c0 + 4);
            w[j][0] = w0[0]; w[j][1] = w0[1]; w[j][2] = w0[2]; w[j][3] = w0[3]; w[j][4] = w1[0]; w[j][5] = w1[1]; w[j][6] = w1[2]; w[j][7] = w1[3]; }
        { const f32x4 b0 = *(const f32x4*)(cb + c0), b1 = *(const f32x4*)(cb + c0 + 4); bia[0] = b0[0]; bia[1] = b0[1]; bia[2] = b0[2]; bia[3] = b0[3]; bia[4] = b1[0]; bia[5] = b1[1]; bia[6] = b1[2]; bia[7] = b1[3]; }
        for (int run = F.vcu * 4 + (tid >> 7); run < M / 16; run += F.G * 4) {
            const int r0 = run * 16, t0 = r0 & (SEQ - 1);
            v4u xin[19];
#pragma unroll
            for (int i = 0; i < 19; ++i) { xin[i] = (v4u){0u, 0u, 0u, 0u}; if (i >= 3 || t0 > 0) xin[i] = *(const v4u*)(PROJ + (size_t)(r0 - 3 + i) * NPROJ + PC_QKM + c0); }
#pragma unroll
            for (int i = 0; i < 16; ++i) { float a[8];
#pragma unroll
                for (int k = 0; k < 8; ++k) a[k] = bia[k];
#pragma unroll
                for (int j = 0; j < 4; ++j) { const v4u x = xin[i + j];
                    a[0] += w[j][0] * bflo(x.x); a[1] += w[j][1] * bfhi(x.x); a[2] += w[j][2] * bflo(x.y); a[3] += w[j][3] * bfhi(x.y); a[4] += w[j][4] * bflo(x.z); a[5] += w[j][5] * bfhi(x.z); a[6] += w[j][6] * bflo(x.w); a[7] += w[j][7] * bfhi(x.w); }
#pragma unroll
                for (int k = 0; k < 8; ++k) a[k] = a[k] * sigm(a[k]) * sc;
                v4u o; o.x = pk2(a[0], a[1]); o.y = pk2(a[2], a[3]); o.z = pk2(a[4], a[5]); o.w = pk2(a[6], a[7]);
                *(v4u*)(QKC + (size_t)(r0 + i) * 1024 + c0) = o; }
        }
    }
}

__device__ __forceinline__ float dot64(const bf16* kr, const float (&q)[64]) {
    float a = 0.f;
#pragma unroll
    for (int i = 0; i < 8; ++i) { const v4u w = *(const v4u*)(kr + 8 * i);
        a += q[8 * i] * bflo(w.x) + q[8 * i + 1] * bfhi(w.x) + q[8 * i + 2] * bflo(w.y) + q[8 * i + 3] * bfhi(w.y) + q[8 * i + 4] * bflo(w.z) + q[8 * i + 5] * bfhi(w.z) + q[8 * i + 6] * bflo(w.w) + q[8 * i + 7] * bfhi(w.w); }
    return a;
}
__device__ __forceinline__ void phase_attn_naive(Frame& F) {
    const bf16* PROJ = (const bf16*)(F.ws + WS_PROJ); const float* kmean = (const float*)(F.ws + WS_KMEAN); bf16* YA = (bf16*)(F.ws + WS_YA);
    LAS float* sc = (LAS float*)F.lds + F.wave * 1088; LAS float* qs = sc + 1024;
    const int gw = F.vcu * NWAVES + F.wave, NGW = F.G * NWAVES, lane = lane_now();
    for (int item = gw; item < BATCH * AH * SEQ; item += NGW) {
        const int q = item & (SEQ - 1), bh = item >> 12, b = bh >> 3, h = bh & 7, blk = q >> 8;
        const size_t rb = (size_t)b * SEQ;
        qs[lane] = bf2f(PROJ[(rb + q) * NPROJ + PC_Q + h * AHD + lane]);
        asm volatile("s_waitcnt lgkmcnt(0)" ::: "memory");
        float qr[64];
#pragma unroll
        for (int i = 0; i < 16; ++i) { const f32x4 t = *(const LAS f32x4*)(qs + 4 * i); qr[4 * i] = t[0]; qr[4 * i + 1] = t[1]; qr[4 * i + 2] = t[2]; qr[4 * i + 3] = t[3]; }
        float gv = -INFINITY;
        if (lane < blk) { const float* km = kmean + ((size_t)bh * ANB + lane) * AHD; float a = 0.f;
#pragma unroll
            for (int i = 0; i < 16; ++i) { const f32x4 t = *(const f32x4*)(km + 4 * i); a += qr[4 * i] * t[0] + qr[4 * i + 1] * t[1] + qr[4 * i + 2] * t[2] + qr[4 * i + 3] * t[3]; }
            gv = a; }
        unsigned selmask = 0u;
        for (int s = 0; s < 3 && s < blk; ++s) { const float mx = wave_max(gv, lane); const unsigned long long bal = __ballot(gv == mx && lane < blk); const int idx = __ffsll((long long)bal) - 1;
            selmask |= 1u << idx; if (lane == idx) gv = -INFINITY; }
        int slot = 0;
        for (int n = 0; n < blk; ++n) if ((selmask >> n) & 1u) {
#pragma unroll
            for (int jj = 0; jj < 4; ++jj) { const int key = n * ABLK + lane + 64 * jj; sc[slot * 256 + lane + 64 * jj] = dot64(PROJ + (rb + key) * NPROJ + PC_K + h * AHD, qr); }
            ++slot; }
#pragma unroll
        for (int jj = 0; jj < 4; ++jj) { const int key = blk * ABLK + lane + 64 * jj; const float a = dot64(PROJ + (rb + key) * NPROJ + PC_K + h * AHD, qr); sc[slot * 256 + lane + 64 * jj] = (key > q) ? -INFINITY : a; }
        const int ntot = (slot + 1) * 256;
        asm volatile("s_waitcnt lgkmcnt(0)" ::: "memory");
        float mx = -INFINITY; for (int i = lane; i < ntot; i += 64) mx = fmaxf(mx, sc[i]); mx = wave_max(mx, lane);
        float sum = 0.f; for (int i = lane; i < ntot; i += 64) { const float p = pg8::ex2(sc[i] - mx); sc[i] = p; sum += p; } sum = wave_sum(sum, lane);
        asm volatile("s_waitcnt lgkmcnt(0)" ::: "memory");
        float o = 0.f; slot = 0;
        for (int n = 0; n < blk; ++n) if ((selmask >> n) & 1u) { const bf16* vp = PROJ + (rb + n * ABLK) * NPROJ + PC_V + h * AHD + lane;
            for (int j = 0; j < 256; ++j) o += sc[slot * 256 + j] * bf2f(vp[(size_t)j * NPROJ]);
            ++slot; }
        { const bf16* vp = PROJ + (rb + blk * ABLK) * NPROJ + PC_V + h * AHD + lane; const int je = q - blk * ABLK;
            for (int j = 0; j <= je; ++j) o += sc[slot * 256 + j] * bf2f(vp[(size_t)j * NPROJ]); }
        YA[(rb + q) * 1024 + h * AHD + lane] = (bf16)f2bf(o / sum);
        asm volatile("s_waitcnt lgkmcnt(0)" ::: "memory");
    }
}

__device__ __forceinline__ void phase_mlstm_naive(Frame& F, const Inputs& in, int l) {
    if (blockIdx.x >= BATCH * MH) return;
    const bf16* PROJ = (const bf16*)(F.ws + WS_PROJ); const bf16* QKC = (const bf16*)(F.ws + WS_QKC); const float* ifpre = (const float*)(F.ws + WS_IFPRE); bf16* YB = (bf16*)(F.ws + WS_YB);
    const float* gh = in.p[I_GH] + l * MDK;
    const int bh = blockIdx.x, b = bh >> 2, h = bh & 3, tid = F.wave * 64 + lane_now(), lane = tid & 63, e = tid & 127, g = tid >> 7;
    LAS float* qs = (LAS float*)F.lds; LAS float* ks = qs + 16 * 128; LAS float* vs = ks + 16 * 128; LAS float* red = vs + 16 * 128; LAS float* redd = red + 16 * 4 * 128;
    LAS float* gi = redd + 64; LAS float* gf = gi + 16; LAS float* ms = gf + 16;
    float C[32], nn[32];
#pragma unroll
    for (int i = 0; i < 32; ++i) { C[i] = 0.f; nn[i] = 0.f; }
    float m = 0.f;
    for (int t0 = 0; t0 < SEQ; t0 += 16) {
        for (int i = tid; i < 16 * 128; i += NTHR) { const int st = i >> 7, d = i & 127; const size_t r = (size_t)b * SEQ + t0 + st;
            qs[i] = bf2f(QKC[r * 1024 + h * MDK + d]); ks[i] = bf2f(QKC[r * 1024 + 512 + h * MDK + d]); vs[i] = bf2f(PROJ[r * NPROJ + PC_VM + h * MDK + d]); }
        if (tid < 16) { const size_t r = (size_t)b * SEQ + t0 + tid; gi[tid] = ifpre[r * 8 + h]; const float x = ifpre[r * 8 + 4 + h]; gf[tid] = fminf(x, 0.f) - log1pf(expf(-fabsf(x))); }
        __syncthreads();
        for (int st = 0; st < 16; ++st) {
            const float li = gi[st], lf = gf[st], mn = fmaxf(lf + m, li), wC = expf(lf + m - mn), wS = expf(li - mn); m = mn;
            const float ve = vs[st * 128 + e]; float pn = 0.f, pd = 0.f;
#pragma unroll
            for (int i4 = 0; i4 < 8; ++i4) { const f32x4 k4 = *(const LAS f32x4*)(ks + st * 128 + 32 * g + 4 * i4), q4 = *(const LAS f32x4*)(qs + st * 128 + 32 * g + 4 * i4);
#pragma unroll
                for (int j = 0; j < 4; ++j) { const int i = 4 * i4 + j; const float kd = wS * k4[j]; C[i] = wC * C[i] + kd * ve; nn[i] = wC * nn[i] + kd; pn += q4[j] * C[i]; pd += q4[j] * nn[i]; } }
            red[(st * 4 + g) * 128 + e] = pn; if (e == 0) redd[st * 4 + g] = pd; if (tid == 0) ms[st] = mn;
        }
        __syncthreads();
#pragma unroll
        for (int s2 = 0; s2 < 2; ++s2) { const int st = 2 * F.wave + s2; const float den = (redd[st * 4] + redd[st * 4 + 1]) + (redd[st * 4 + 2] + redd[st * 4 + 3]);
            const float dn = 1.0f / fmaxf(fabsf(den), expf(-ms[st]));
            const float h0 = ((red[(st * 4) * 128 + lane] + red[(st * 4 + 1) * 128 + lane]) + (red[(st * 4 + 2) * 128 + lane] + red[(st * 4 + 3) * 128 + lane])) * dn;
            const float h1 = ((red[(st * 4) * 128 + 64 + lane] + red[(st * 4 + 1) * 128 + 64 + lane]) + (red[(st * 4 + 2) * 128 + 64 + lane] + red[(st * 4 + 3) * 128 + 64 + lane])) * dn;
            const float rr = 1.0f / sqrtf(wave_sum(h0 * h0 + h1 * h1, lane) * (1.0f / MDK) + RMS_EPS);
            const size_t r = (size_t)b * SEQ + t0 + st;
            const float o0 = sigm(bf2f(PROJ[r * NPROJ + PC_OM + h * MDK + lane])), o1 = sigm(bf2f(PROJ[r * NPROJ + PC_OM + h * MDK + 64 + lane]));
            YB[r * 1024 + h * MDK + lane] = (bf16)f2bf(h0 * rr * gh[lane] * o0); YB[r * 1024 + h * MDK + 64 + lane] = (bf16)f2bf(h1 * rr * gh[64 + lane] * o1); }
        __syncthreads();
    }
}
typedef short bf16x8s __attribute__((ext_vector_type(8)));
typedef short s16x4 __attribute__((ext_vector_type(4)));
typedef float f32x16 __attribute__((ext_vector_type(16)));
constexpr size_t ST_DCT = WS_ST, ST_DN = WS_ST + 16 * MiB, ST_NIN = ST_DN + 128 * 1024, ST_MLOC = ST_NIN + 128 * 1024, ST_BL = ST_MLOC + 4096, ST_MIN = ST_BL + 4096;
constexpr size_t ST_CINT = WS_MIXED;
constexpr int SM_OFF = LDSCTL_OFF + 1024;
__device__ __forceinline__ unsigned off_b(unsigned row, unsigned ch) { return 256u * row + 16u * (ch ^ (((row & 3u) << 2) | ((row >> 2) & 3u))); }
__device__ __forceinline__ s16x4 vtr(const LAS unsigned char* p) { return __builtin_bit_cast(s16x4, __builtin_amdgcn_ds_read_tr16_b64_v4i16((LAS s16x4*)p)); }
__device__ __forceinline__ int crow(int r, int hi) { return (r & 3) + 8 * (r >> 2) + 4 * hi; }
__device__ __forceinline__ float shu(float v, int o, int lane) { return __int_as_float(__builtin_amdgcn_ds_bpermute((lane - o) << 2, __float_as_int(v))); }
__device__ __forceinline__ float shl(float v, int src) { return __int_as_float(__builtin_amdgcn_ds_bpermute(src << 2, __float_as_int(v))); }
__device__ __forceinline__ float logsig(float x) { return fminf(x, 0.f) - log1pf(expf(-fabsf(x))); }
__device__ __forceinline__ bf16x8s tr_frag(const LAS unsigned char* img, int lane, int row0, int c) {
    const unsigned h = lane >> 5, blk = (lane >> 4) & 1, q = (lane & 15) >> 2, p = lane & 3;
    const s16x4 lo = vtr(img + off_b(row0 + 8 * h + q, 4 * c + 2 * blk + (p >> 1)) + 8 * (p & 1)), hi = vtr(img + off_b(row0 + 8 * h + 4 + q, 4 * c + 2 * blk + (p >> 1)) + 8 * (p & 1));
    return (bf16x8s){lo[0], lo[1], lo[2], lo[3], hi[0], hi[1], hi[2], hi[3]};
}
__device__ __forceinline__ bf16x8s tr_frag_perm(const LAS unsigned char* img, int lane, int row0, int c) {
    const unsigned h = lane >> 5, blk = (lane >> 4) & 1, q = (lane & 15) >> 2, p = lane & 3;
    const s16x4 lo = vtr(img + off_b(row0 + 4 * h + q, 4 * c + 2 * blk + (p >> 1)) + 8 * (p & 1)), hi = vtr(img + off_b(row0 + 8 + 4 * h + q, 4 * c + 2 * blk + (p >> 1)) + 8 * (p & 1));
    return (bf16x8s){lo[0], lo[1], lo[2], lo[3], hi[0], hi[1], hi[2], hi[3]};
}
__device__ __forceinline__ void chunk_gates(const float* ifpre, size_t row0, int h, int lane, float (&bc)[4], float (&ii)[4], float& bL) {
#pragma unroll
    for (int k = 0; k < 4; ++k) { const size_t r = row0 + 4 * lane + k; ii[k] = ((const GAS float*)ifpre)[r * 8 + h]; bc[k] = ((const GAS float*)ifpre)[r * 8 + 4 + h]; }
    __builtin_amdgcn_sched_barrier(0);
#pragma unroll
    for (int k = 0; k < 4; ++k) bc[k] = logsig(bc[k]);
    bc[1] += bc[0]; bc[2] += bc[1]; bc[3] += bc[2];
    float inc = bc[3];
#pragma unroll
    for (int o = 1; o < 64; o <<= 1) { const float t = shu(inc, o, lane); if (lane >= o) inc += t; }
    const float excl = inc - bc[3];
#pragma unroll
    for (int k = 0; k < 4; ++k) bc[k] += excl;
    bL = shl(inc, 63);
}

__device__ __forceinline__ void phase_mlstm_m1(Frame& F, const Inputs& in, int l) {
    PHASE_LOCALS();
    const bf16* PROJ = (const bf16*)(F.ws + WS_PROJ); bf16* QKC = (bf16*)(F.ws + WS_QKC); const float* ifpre = (const float*)(F.ws + WS_IFPRE);
    float* dCT = (float*)(F.ws + ST_DCT); float* DN = (float*)(F.ws + ST_DN); float* MLOC = (float*)(F.ws + ST_MLOC); float* BL = (float*)(F.ws + ST_BL);
    LAS unsigned char* Kimg = F.lds; LAS unsigned char* Vimg = F.lds + 65536; LAS float* sw = (LAS float*)(F.lds + SM_OFF);
    const int r32 = lane & 31, hi = lane >> 5;
    for (int unit = F.vcu; unit < BATCH * MH * 16; unit += F.G) {
        const int bh = unit >> 4, c = unit & 15, b = bh >> 2, h = bh & 3; const size_t row0 = (size_t)b * SEQ + c * 256;
        { const float* cw = in.p[I_CONVW] + (size_t)l * 4 * 1024; const float* cb = in.p[I_CONVB] + (size_t)l * 1024;
          const int cc = tid & 31, c0 = (cc < 16 ? 0 : 512) + h * MDK + 8 * (cc & 15), run = tid >> 5; const float sc = (cc >= 16) ? 0.08838834764831845f : 1.0f;
          float w[4][8], bia[8];
#pragma unroll
          for (int j = 0; j < 4; ++j) { const f32x4 w0 = *(const f32x4*)(cw + j * 1024 + c0), w1 = *(const f32x4*)(cw + j * 1024 + c0 + 4);
              w[j][0] = w0[0]; w[j][1] = w0[1]; w[j][2] = w0[2]; w[j][3] = w0[3]; w[j][4] = w1[0]; w[j][5] = w1[1]; w[j][6] = w1[2]; w[j][7] = w1[3]; }
          { const f32x4 b0 = *(const f32x4*)(cb + c0), b1 = *(const f32x4*)(cb + c0 + 4); bia[0] = b0[0]; bia[1] = b0[1]; bia[2] = b0[2]; bia[3] = b0[3]; bia[4] = b1[0]; bia[5] = b1[1]; bia[6] = b1[2]; bia[7] = b1[3]; }
          const size_t r0 = row0 + 16 * run; const bool first = (c == 0 && run == 0);
          v4u xin[19];
#pragma unroll
          for (int i = 0; i < 19; ++i) { xin[i] = (v4u){0u, 0u, 0u, 0u}; if (i >= 3 || !first) xin[i] = *(const v4u*)(PROJ + (r0 - 3 + i) * NPROJ + PC_QKM + c0); }
#pragma unroll
          for (int i = 0; i < 16; ++i) { float a[8];
#pragma unroll
              for (int k = 0; k < 8; ++k) a[k] = bia[k];
#pragma unroll
              for (int j = 0; j < 4; ++j) { const v4u x = xin[i + j];
                  a[0] += w[j][0] * bflo(x.x); a[1] += w[j][1] * bfhi(x.x); a[2] += w[j][2] * bflo(x.y); a[3] += w[j][3] * bfhi(x.y); a[4] += w[j][4] * bflo(x.z); a[5] += w[j][5] * bfhi(x.z); a[6] += w[j][6] * bflo(x.w); a[7] += w[j][7] * bfhi(x.w); }
#pragma unroll
              for (int k = 0; k < 8; ++k) a[k] = a[k] * sigm(a[k]) * sc;
              v4u o; o.x = pk2(a[0], a[1]); o.y = pk2(a[2], a[3]); o.z = pk2(a[4], a[5]); o.w = pk2(a[6], a[7]);
              *(v4u*)(QKC + (r0 + i) * 1024 + c0) = o; } }
        if (F.wave == 0) {
            float bc[4], ii[4], bL; chunk_gates(ifpre, row0, h, lane, bc, ii, bL);
            float g[4]; float mx = -INFINITY;
#pragma unroll
            for (int k = 0; k < 4; ++k) { g[k] = bL - bc[k] + ii[k]; mx = fmaxf(mx, g[k]); }
            mx = wave_max(mx, lane);
#pragma unroll
            for (int k = 0; k < 4; ++k) sw[4 * lane + k] = pg8::ex2((g[k] - mx) * 1.4426950408889634f);
            if (lane == 0) { MLOC[unit] = mx; BL[unit] = bL; }
        }
        asm volatile("s_waitcnt vmcnt(0)" ::: "memory");
        __syncthreads();
        { v4u kvv[8], vvv[8];
#pragma unroll
          for (int i = 0; i < 8; ++i) { const int idx = tid + NTHR * i, s = idx >> 4, ch = idx & 15;
              kvv[i] = *(const GAS v4u*)((const GAS bf16*)QKC + (row0 + s) * 1024 + 512 + h * MDK + 8 * ch); vvv[i] = *(const GAS v4u*)((const GAS bf16*)PROJ + (row0 + s) * NPROJ + PC_VM + h * MDK + 8 * ch); }
#pragma unroll
          for (int i = 0; i < 8; ++i) { const int idx = tid + NTHR * i, s = idx >> 4, ch = idx & 15; const float w = sw[s]; const v4u kv = kvv[i];
              v4u ko; ko.x = pk2(bflo(kv.x) * w, bfhi(kv.x) * w); ko.y = pk2(bflo(kv.y) * w, bfhi(kv.y) * w); ko.z = pk2(bflo(kv.z) * w, bfhi(kv.z) * w); ko.w = pk2(bflo(kv.w) * w, bfhi(kv.w) * w);
              *(LAS v4u*)(Kimg + off_b(s, ch)) = ko;
              *(LAS v4u*)(Vimg + off_b(s, ch)) = vvv[i]; } }
        __syncthreads();
        const int dt = F.wave >> 1, c0 = 2 * (F.wave & 1);
        f32x16 acc0, acc1;
#pragma unroll
        for (int i = 0; i < 16; ++i) { acc0[i] = 0.f; acc1[i] = 0.f; }
#pragma unroll 4
        for (int ks = 0; ks < 16; ++ks) {
            const bf16x8s a = tr_frag(Kimg, lane, 16 * ks, dt), b0 = tr_frag(Vimg, lane, 16 * ks, c0), b1 = tr_frag(Vimg, lane, 16 * ks, c0 + 1);
            acc0 = __builtin_amdgcn_mfma_f32_32x32x16_bf16(a, b0, acc0, 0, 0, 0);
            acc1 = __builtin_amdgcn_mfma_f32_32x32x16_bf16(a, b1, acc1, 0, 0, 0);
        }
#pragma unroll
        for (int g = 0; g < 4; ++g) { const int d = 32 * dt + 8 * g + 4 * hi;
            typedef unsigned u2_ __attribute__((ext_vector_type(2)));
            *(GAS u2_*)((GAS bf16*)dCT + ((size_t)unit * 128 + 32 * c0 + r32) * 128 + d) = (u2_){pk2(acc0[4 * g], acc0[4 * g + 1]), pk2(acc0[4 * g + 2], acc0[4 * g + 3])};
            *(GAS u2_*)((GAS bf16*)dCT + ((size_t)unit * 128 + 32 * (c0 + 1) + r32) * 128 + d) = (u2_){pk2(acc1[4 * g], acc1[4 * g + 1]), pk2(acc1[4 * g + 2], acc1[4 * g + 3])}; }
        { const int d = tid & 127, part = tid >> 7; float s0 = 0.f, s1 = 0.f;
#pragma unroll 8
            for (int t = 0; t < 64; t += 2) { s0 += bf2f(*(const LAS bf16*)(Kimg + off_b(64 * part + t, d >> 3) + 2 * (d & 7))); s1 += bf2f(*(const LAS bf16*)(Kimg + off_b(64 * part + t + 1, d >> 3) + 2 * (d & 7))); }
            sw[256 + tid] = s0 + s1; }
        __syncthreads();
        if (tid < 128) DN[(size_t)unit * 128 + tid] = (sw[256 + tid] + sw[256 + 128 + tid]) + (sw[256 + 256 + tid] + sw[256 + 384 + tid]);
        __syncthreads();
    }
}

__device__ __forceinline__ void phase_mlstm_m2(Frame& F) {
    PHASE_LOCALS();
    const float* dCT = (const float*)(F.ws + ST_DCT); const float* DN = (const float*)(F.ws + ST_DN); const float* MLOC = (const float*)(F.ws + ST_MLOC); const float* BL = (const float*)(F.ws + ST_BL);
    bf16* CinT = (bf16*)(F.ws + ST_CINT); float* NIN = (float*)(F.ws + ST_NIN); float* MIN = (float*)(F.ws + ST_MIN);
    LAS float* al = (LAS float*)(F.lds + SM_OFF); LAS float* be = al + 16;
    for (int item = F.vcu; item < 256; item += F.G) {
        const int bh = item >> 4, sl = item & 15;
        if (tid == 0) { float m = 0.f;
            for (int c = 0; c < 16; ++c) { const int u = bh * 16 + c; const float bl = BL[u], ml = MLOC[u]; if (sl == 0) MIN[u] = m;
                const float mo = fmaxf(bl + m, ml); al[c] = expf(bl + m - mo); be[c] = expf(ml - mo); m = mo; } }
        __syncthreads();
        { const size_t idx = (size_t)sl * 1024 + 2 * tid; float s0 = 0.f, s1 = 0.f;
#pragma unroll
            for (int c = 0; c < 16; ++c) { const size_t u = (size_t)bh * 16 + c; const float2 dc = *(const float2*)(dCT + u * 16384 + idx);
                *(unsigned*)(CinT + u * 16384 + idx) = pk2(s0, s1); s0 = al[c] * s0 + be[c] * dc.x; s1 = al[c] * s1 + be[c] * dc.y; } }
        if (sl == 0 && tid < 128) { float s = 0.f;
#pragma unroll
            for (int c = 0; c < 16; ++c) { const size_t u = (size_t)bh * 16 + c; NIN[u * 128 + tid] = s; s = al[c] * s + be[c] * DN[u * 128 + tid]; } }
        __syncthreads();
    }
}

__device__ __forceinline__ void phase_mlstm_m3(Frame& F, const Inputs& in, int l, int reps = 1) {
    PHASE_LOCALS();
    const bf16* PROJ = (const bf16*)(F.ws + WS_PROJ); const bf16* QKC = (const bf16*)(F.ws + WS_QKC); const float* ifpre = (const float*)(F.ws + WS_IFPRE);
    const float* dCT = (const float*)(F.ws + ST_DCT); const float* DN = (const float*)(F.ws + ST_DN); const float* MLOC = (const float*)(F.ws + ST_MLOC); const float* BLV = (const float*)(F.ws + ST_BL); bf16* YB = (bf16*)(F.ws + WS_YB);
    const float* gh = in.p[I_GH] + l * MDK;
    LAS unsigned char* Vimg = F.lds; LAS unsigned char* Cimg = F.lds + 65536; LAS unsigned char* Kimg = F.lds + 65536;
    LAS float* us = (LAS float*)(F.lds + SM_OFF); LAS float* Mt = us + 256; LAS float* aw = Mt + 256; LAS float* em = aw + 256; LAS float* inv = em + 256; LAS float* nin_s = inv + 256; LAS float* coef = nin_s + 128;
    const int r32 = lane & 31, hi = lane >> 5, wave = F.wave;
    for (int unit = F.vcu; unit < reps * BATCH * MH * 16; unit += F.G) {
        const int unit_ = unit; { const int unit = unit_ & (BATCH * MH * 16 - 1);
        const int bh = unit >> 4, c = unit & 15, b = bh >> 2, h = bh & 3; const size_t row0 = (size_t)b * SEQ + c * 256;
        if (tid < 32) coef[tid] = (tid < 16) ? BLV[bh * 16 + tid] : MLOC[bh * 16 + tid - 16];
        { v4u vvv[8];
#pragma unroll
          for (int i = 0; i < 8; ++i) { const int idx = tid + NTHR * i, s = idx >> 4, ch = idx & 15; vvv[i] = *(const GAS v4u*)((const GAS bf16*)PROJ + (row0 + s) * NPROJ + PC_VM + h * MDK + 8 * ch); }
#pragma unroll
          for (int i = 0; i < 8; ++i) { const int idx = tid + NTHR * i, s = idx >> 4, ch = idx & 15; *(LAS v4u*)(Vimg + off_b(s, ch)) = vvv[i]; } }
        __syncthreads();
        if (tid == 0) { float mm = 0.f;
            for (int cc = 0; cc < c; ++cc) { const float bl = coef[cc], ml = coef[16 + cc], mo = fmaxf(bl + mm, ml); coef[cc] = pg8::ex2((bl + mm - mo) * 1.4426950408889634f); coef[16 + cc] = pg8::ex2((ml - mo) * 1.4426950408889634f); mm = mo; }
            coef[32] = mm; }
        __syncthreads();
        { float st[32];
#pragma unroll
            for (int i = 0; i < 32; ++i) st[i] = 0.f;
            v4u sa[4], sb[4], sc[4];
            const GAS bf16* sbase = (const GAS bf16*)dCT + ((size_t)(bh * 16)) * 16384 + 32 * tid;
#define M3_LD(buf, cc_) do { const int ci_ = ((cc_) < 15) ? (cc_) : 15;   \
                const GAS v4u* src_ = (const GAS v4u*)(sbase + (size_t)ci_ * 16384); _Pragma("unroll") for (int i = 0; i < 4; ++i) buf[i] = src_[i]; __builtin_amdgcn_sched_barrier(0); } while (0)
#define M3_FM(buf, cc_) do { if ((cc_) < c) { const float al = coef[(cc_)], be = coef[16 + (cc_)]; \
                _Pragma("unroll") for (int i = 0; i < 4; ++i) { const v4u v = buf[i]; \
                    st[8 * i] = al * st[8 * i] + be * bflo(v.x); st[8 * i + 1] = al * st[8 * i + 1] + be * bfhi(v.x); st[8 * i + 2] = al * st[8 * i + 2] + be * bflo(v.y); st[8 * i + 3] = al * st[8 * i + 3] + be * bfhi(v.y); \
                    st[8 * i + 4] = al * st[8 * i + 4] + be * bflo(v.z); st[8 * i + 5] = al * st[8 * i + 5] + be * bfhi(v.z); st[8 * i + 6] = al * st[8 * i + 6] + be * bflo(v.w); st[8 * i + 7] = al * st[8 * i + 7] + be * bfhi(v.w); } } \
                __builtin_amdgcn_sched_barrier(0); } while (0)
            if (c > 0) { M3_LD(sa, 0); M3_LD(sb, 1);
                for (int cc = 0; cc < c; cc += 3) { M3_LD(sc, cc + 2); M3_FM(sa, cc); M3_LD(sa, cc + 3); M3_FM(sb, cc + 1); M3_LD(sb, cc + 4); M3_FM(sc, cc + 2); } }
#undef M3_LD
#undef M3_FM
            LAS unsigned char* dst = Cimg + (tid >> 2) * 272 + (tid & 3) * 64;
#pragma unroll
            for (int i = 0; i < 4; ++i) { v4u o; o.x = pk2(st[8 * i], st[8 * i + 1]); o.y = pk2(st[8 * i + 2], st[8 * i + 3]); o.z = pk2(st[8 * i + 4], st[8 * i + 5]); o.w = pk2(st[8 * i + 6], st[8 * i + 7]); *(LAS v4u*)(dst + 16 * i) = o; }
            if (tid < 128) { float dnv[16];
#pragma unroll
                for (int cc = 0; cc < 16; ++cc) dnv[cc] = DN[((size_t)(bh * 16 + cc)) * 128 + tid];
                float sn = 0.f;
#pragma unroll
                for (int cc = 0; cc < 16; ++cc) if (cc < c) sn = coef[cc] * sn + coef[16 + cc] * dnv[cc];
                nin_s[tid] = sn; } }
        if (wave == 0) {
            float bc[4], ii[4], bL; chunk_gates(ifpre, row0, h, lane, bc, ii, bL);
            float u[4], pm[4];
#pragma unroll
            for (int k = 0; k < 4; ++k) u[k] = ii[k] - bc[k];
            pm[0] = u[0]; pm[1] = fmaxf(pm[0], u[1]); pm[2] = fmaxf(pm[1], u[2]); pm[3] = fmaxf(pm[2], u[3]);
            float inc = pm[3];
#pragma unroll
            for (int o = 1; o < 64; o <<= 1) { const float t = shu(inc, o, lane); if (lane >= o) inc = fmaxf(inc, t); }
            float excl = shu(inc, 1, lane); if (lane == 0) excl = -INFINITY;
            const float m_in = coef[32];
#pragma unroll
            for (int k = 0; k < 4; ++k) { const float Mx = fmaxf(m_in, fmaxf(pm[k], excl)); const int s = 4 * lane + k; us[s] = u[k]; Mt[s] = Mx; aw[s] = pg8::ex2((m_in - Mx) * 1.4426950408889634f); em[s] = pg8::ex2(-(bc[k] + Mx) * 1.4426950408889634f); }
        }
        __syncthreads();
        const int t = 32 * wave + r32;
        bf16x8s qf[8];
#pragma unroll
        for (int ks = 0; ks < 8; ++ks) qf[ks] = *(const bf16x8s*)(QKC + (row0 + t) * 1024 + h * MDK + 16 * ks + 8 * hi);
        float qn = 0.f;
#pragma unroll
        for (int ks = 0; ks < 8; ++ks)
#pragma unroll
            for (int j = 0; j < 8; ++j) qn += bf2f((bf16)qf[ks][j]) * nin_s[16 * ks + 8 * hi + j];
        qn += shx(qn, 32, lane);
        f32x16 acc[4];
#pragma unroll
        for (int cc = 0; cc < 4; ++cc)
#pragma unroll
            for (int i = 0; i < 16; ++i) acc[cc][i] = 0.f;
#pragma unroll
        for (int cc = 0; cc < 4; ++cc)
#pragma unroll
            for (int ks = 0; ks < 8; ++ks) { const bf16x8s bq = *(const LAS bf16x8s*)(Cimg + (32 * cc + r32) * 272 + 2 * (16 * ks + 8 * hi));
                acc[cc] = __builtin_amdgcn_mfma_f32_32x32x16_bf16(qf[ks], bq, acc[cc], 0, 0, 0); }
#pragma unroll
        for (int rg = 0; rg < 16; ++rg) { const float a = aw[32 * wave + crow(rg, hi)];
#pragma unroll
            for (int cc = 0; cc < 4; ++cc) acc[cc][rg] *= a; }
        { v4u kst[8];
#pragma unroll
          for (int i = 0; i < 8; ++i) { const int idx = tid + NTHR * i, s_ = idx >> 4, ch = idx & 15; kst[i] = *(const v4u*)(QKC + (row0 + s_) * 1024 + 512 + h * MDK + 8 * ch); }
          __syncthreads();
#pragma unroll
          for (int i = 0; i < 8; ++i) { const int idx = tid + NTHR * i, s_ = idx >> 4, ch = idx & 15; *(LAS v4u*)(Kimg + off_b(s_, ch)) = kst[i]; }
          __syncthreads(); }
        const float Ml = Mt[t]; float den = 0.f;
        for (int j = 0; j <= wave; ++j) {
            f32x16 X;
#pragma unroll
            for (int i = 0; i < 16; ++i) X[i] = 0.f;
#pragma unroll
            for (int ks = 0; ks < 8; ++ks) { const bf16x8s ka = *(const LAS bf16x8s*)(Kimg + off_b(32 * j + r32, 2 * ks + hi));
                X = __builtin_amdgcn_mfma_f32_32x32x16_bf16(ka, qf[ks], X, 0, 0, 0); }
#pragma unroll
            for (int rg = 0; rg < 16; ++rg) { const int s = 32 * j + crow(rg, hi); float w = pg8::ex2((us[s] - Ml) * 1.4426950408889634f); if (s > t) w = 0.f;     const float pv = X[rg] * w; X[rg] = pv; den += pv; }
            v4u p0, p1;
            p0.x = pk2(X[0], X[1]); p0.y = pk2(X[2], X[3]); p0.z = pk2(X[4], X[5]); p0.w = pk2(X[6], X[7]);
            p1.x = pk2(X[8], X[9]); p1.y = pk2(X[10], X[11]); p1.z = pk2(X[12], X[13]); p1.w = pk2(X[14], X[15]);
            const bf16x8s pa0 = __builtin_bit_cast(bf16x8s, p0), pa1 = __builtin_bit_cast(bf16x8s, p1);
#pragma unroll
            for (int cc = 0; cc < 4; ++cc) {
                acc[cc] = __builtin_amdgcn_mfma_f32_32x32x16_bf16(pa0, tr_frag_perm(Vimg, lane, 32 * j, cc), acc[cc], 0, 0, 0);
                acc[cc] = __builtin_amdgcn_mfma_f32_32x32x16_bf16(pa1, tr_frag_perm(Vimg, lane, 32 * j + 16, cc), acc[cc], 0, 0, 0); }
        }
        den += shx(den, 32, lane);
        { const float dt = aw[t] * qn + den; inv[t] = 1.0f / fmaxf(fabsf(dt), em[t]); }
        asm volatile("s_waitcnt lgkmcnt(0)" ::: "memory");
        float rr[16];
#pragma unroll
        for (int rg = 0; rg < 16; ++rg) { const float f = inv[32 * wave + crow(rg, hi)]; float sq = 0.f;
#pragma unroll
            for (int cc = 0; cc < 4; ++cc) { acc[cc][rg] *= f; sq += acc[cc][rg] * acc[cc][rg]; }
#pragma unroll
            for (int o = 1; o < 32; o <<= 1) sq += shx(sq, o, lane);
            rr[rg] = 1.0f / sqrtf(sq * (1.0f / MDK) + RMS_EPS); }
        { int r32o = r32, hio = hi; asm volatile("" : "+v"(r32o), "+v"(hio));
          const GAS unsigned short* og = (const GAS unsigned short*)PROJ + (row0 + 32 * wave) * NPROJ + PC_OM + h * MDK + r32o; GAS unsigned short* yo = (GAS unsigned short*)YB + (row0 + 32 * wave) * 1024 + h * MDK + r32o;
#pragma unroll
          for (int cc = 0; cc < 4; ++cc) { const int e = 32 * cc + r32; const float ge = gh[e];
#pragma unroll
              for (int hb = 0; hb < 2; ++hb) { unsigned short ov[8];
#pragma unroll
                  for (int q = 0; q < 8; ++q) ov[q] = og[(size_t)crow(8 * hb + q, hio) * NPROJ + 32 * cc];
                  __builtin_amdgcn_sched_barrier(0);
#pragma unroll
                  for (int q = 0; q < 8; ++q) { const int rg = 8 * hb + q; const float o = sigm(__uint_as_float((unsigned)ov[q] << 16));
                      yo[(size_t)crow(rg, hio) * 1024 + 32 * cc] = f2bf(acc[cc][rg] * rr[rg] * ge * o); }
                  __builtin_amdgcn_sched_barrier(0); } } }
        __syncthreads();
        }
    }
}
#include <hip/hip_bf16.h>
namespace attn_body {
using bf16=__hip_bfloat16;
using bf16x8=__attribute__((ext_vector_type(8)))short;
using s16x4=__attribute__((ext_vector_type(4)))short;
using f32x16=__attribute__((ext_vector_type(16)))float;
using u32x4=__attribute__((ext_vector_type(4)))unsigned;
using f32x4_t=__attribute__((ext_vector_type(4)))float;
constexpr int BATCH=4,NHEAD=8,SEQ=4096,D=64,DM=3584,DMO=1024;
constexpr float NEGBIG=-200.f;
constexpr int NW=8,QBLK=32,QB=QBLK*NW,KVBLK=64,NQB=SEQ/QB;
constexpr int ATTN_PITCH=DM, ATTN_UNIT_ROWS=QB;
__device__ __forceinline__ int crow(int r,int hi){return (r&3)+8*(r>>2)+4*hi;}
#define SBAR() __builtin_amdgcn_sched_barrier(0)
__device__ __forceinline__ void cmask(f32x16&p0,f32x16&p1,int jb,int qrel,int hi){
  const float NEG=-INFINITY; int kb=64*jb+4*hi;
  #pragma unroll
  for(int r=0;r<16;++r){int kv=kb+(r&3)+8*(r>>2); if(kv>qrel)p0[r]=NEG; if(kv+32>qrel)p1[r]=NEG;}
}

constexpr int NSLOT=3, SLOTB=8192;
constexpr int LDS_K=0, LDS_V=NSLOT*SLOTB, LDS_WS=2*NSLOT*SLOTB, LDS_OST=LDS_WS+NW*64*4, LDS_KMS=LDS_OST+NW*4096  , LDS_BYTES=LDS_KMS+4096;
constexpr float C2=0.125f*1.4426950408889634f;
__device__ __forceinline__ void glds16(const void*gsrc,unsigned lds_dst){unsigned keep;
  asm volatile("s_mov_b32 %0, m0\n\ts_mov_b32 m0, %2\n\ts_nop 0\n\tglobal_load_lds_dwordx4 %1, off\n\ts_mov_b32 m0, %0":"=&s"(keep):"v"(gsrc),"s"(lds_dst):"memory");}
__device__ __forceinline__ float max3f(float a,float b,float c){float r;asm("v_max3_f32 %0, %1, %2, %3":"=v"(r):"v"(a),"v"(b),"v"(c));return r;}
__device__ __forceinline__ float max2f(float a,float b){float r;asm("v_max_f32_e32 %0, %1, %2":"=v"(r):"v"(a),"v"(b));return r;}
__device__ __forceinline__ float fadd_s(float a,float b){float r;asm("v_add_f32_e32 %0, %1, %2":"=v"(r):"v"(a),"v"(b));return r;}
__device__ __forceinline__ float fsub_s(float a,float b){float r;asm("v_sub_f32_e32 %0, %1, %2":"=v"(r):"v"(a),"v"(b));return r;}
typedef float f32x2_t __attribute__((ext_vector_type(2))); typedef __bf16 bf16x2_t __attribute__((ext_vector_type(2)));
__device__ __forceinline__ unsigned cvtpk_s(float lo,float hi){f32x2_t v={lo,hi};bf16x2_t b=__builtin_convertvector(v,bf16x2_t);return __builtin_bit_cast(unsigned,b);}
#define WAIT_BAR(N) asm volatile("s_waitcnt vmcnt(" #N ") lgkmcnt(0)\n\ts_barrier":::"memory")

__device__ __forceinline__ void qkt(f32x16&p0,f32x16&p1,const char*Kslot,const bf16x8*qr,const f32x16&negm,int r32,int hi){
  const char*kb=Kslot+hi*1024+r32*16;
  #pragma unroll
  for(int d0=0;d0<4;++d0){
    const bf16x8 b0=*reinterpret_cast<const bf16x8*>(kb+d0*2048);
    const bf16x8 b1=*reinterpret_cast<const bf16x8*>(kb+d0*2048+512);
    if(d0==0){p0=__builtin_amdgcn_mfma_f32_32x32x16_bf16(b0,qr[0],negm,0,0,0);p1=__builtin_amdgcn_mfma_f32_32x32x16_bf16(b1,qr[0],negm,0,0,0);}
    else{p0=__builtin_amdgcn_mfma_f32_32x32x16_bf16(b0,qr[d0],p0,0,0,0);p1=__builtin_amdgcn_mfma_f32_32x32x16_bf16(b1,qr[d0],p1,0,0,0);}}
}
typedef __attribute__((address_space(3))) const char* lds_cptr;
typedef short v4i16_t __attribute__((ext_vector_type(4)));
__device__ __forceinline__ void kload8(bf16x8*kf,lds_cptr kp){
  kf[0]=*(const __attribute__((address_space(3))) bf16x8*)(kp);      kf[1]=*(const __attribute__((address_space(3))) bf16x8*)(kp+512);
  kf[2]=*(const __attribute__((address_space(3))) bf16x8*)(kp+2048); kf[3]=*(const __attribute__((address_space(3))) bf16x8*)(kp+2560);
  kf[4]=*(const __attribute__((address_space(3))) bf16x8*)(kp+4096); kf[5]=*(const __attribute__((address_space(3))) bf16x8*)(kp+4608);
  kf[6]=*(const __attribute__((address_space(3))) bf16x8*)(kp+6144); kf[7]=*(const __attribute__((address_space(3))) bf16x8*)(kp+6656);
}
__device__ __forceinline__ void kload2(bf16x8*kf,lds_cptr kp,int j){ kf[2*j]=*(const __attribute__((address_space(3))) bf16x8*)(kp+j*2048); kf[2*j+1]=*(const __attribute__((address_space(3))) bf16x8*)(kp+j*2048+512); }
__device__ __forceinline__ s16x4 vtr(lds_cptr p){ return __builtin_bit_cast(s16x4,__builtin_amdgcn_ds_read_tr16_b64_v4i16((__attribute__((address_space(3))) v4i16_t*)p)); }
__device__ __forceinline__ float rowmax(const f32x16&p0,const f32x16&p1){
  float a=max3f(p0[0],p0[1],p1[0]),b=max3f(p0[2],p0[3],p1[1]);a=max3f(a,p1[2],p1[3]);
  #pragma unroll
  for(int r=4;r<16;r+=4){a=max3f(a,p0[r],p0[r+1]);b=max3f(b,p0[r+2],p0[r+3]);a=max3f(a,p1[r],p1[r+1]);b=max3f(b,p1[r+2],p1[r+3]);}
  const float m=max2f(a,b);
  auto rr=__builtin_amdgcn_permlane32_swap(__float_as_uint(m),__float_as_uint(m),false,false);
  return max2f(__uint_as_float(rr[0]),__uint_as_float(rr[1]));
}
__device__ __forceinline__ void pv(f32x16*o,int vb,bf16x8 pa0,bf16x8 pa1,bf16x8 pa2,bf16x8 pa3){
  #pragma unroll
  for(int d0=0;d0<2;++d0){s16x4 lo[4],hi[4];
    #pragma unroll
    for(int ks=0;ks<4;++ks){
      asm volatile("ds_read_b64_tr_b16 %0,%1 offset:%c2":"=&v"(lo[ks]):"v"(vb),"i"(d0*4096+ks*1024):"memory");
      asm volatile("ds_read_b64_tr_b16 %0,%1 offset:%c2":"=&v"(hi[ks]):"v"(vb),"i"(d0*4096+ks*1024+512):"memory");}
    asm volatile("s_waitcnt lgkmcnt(0)":::"memory");SBAR();
    #define PK(k) (bf16x8){lo[k][0],lo[k][1],lo[k][2],lo[k][3],hi[k][0],hi[k][1],hi[k][2],hi[k][3]}
    o[d0]=__builtin_amdgcn_mfma_f32_32x32x16_bf16(pa0,PK(0),o[d0],0,0,0);
    o[d0]=__builtin_amdgcn_mfma_f32_32x32x16_bf16(pa1,PK(1),o[d0],0,0,0);
    o[d0]=__builtin_amdgcn_mfma_f32_32x32x16_bf16(pa2,PK(2),o[d0],0,0,0);
    o[d0]=__builtin_amdgcn_mfma_f32_32x32x16_bf16(pa3,PK(3),o[d0],0,0,0);
    #undef PK
  }
}

#ifndef ATTN_STORE16
#define ATTN_STORE16(p,v) (*(u32x4*)(p)=(v))
#endif
template<int THRL> __device__ __forceinline__ void attn_unit(int b,int h,int qb,const bf16*Q,const bf16*__restrict__ K,const bf16*__restrict__ V,bf16*O,const float*__restrict__ kmean,char*shm,int wave_in){
  int tid_; asm volatile("v_mbcnt_lo_u32_b32 %0, -1, 0\n\tv_mbcnt_hi_u32_b32 %0, -1, %0":"=v"(tid_)); tid_+=64*wave_in; const int tid=tid_,lane=tid&63,r32=lane&31,hi=lane>>5; const int wid=__builtin_amdgcn_readfirstlane(tid>>6);
  const long rowbase=(long)b*SEQ; const int q0=qb*QB;
  const bf16*Qw=Q+(rowbase+q0+wid*QBLK)*DM+h*D;
  const bf16*Kh=K+rowbase*DM+h*D,*Vh=V+rowbase*DM+h*D;
  const unsigned lds0=(unsigned)(uintptr_t)shm;
  float*wsf=(float*)(shm+LDS_WS)+wid*64;
  const bf16*ksrc=Kh+(long)lane*DM+wid*8;
  const bf16*vsrc=Vh+(long)(16*(wid&3)+(lane>>2))*DM+(wid>>2)*32+(lane&3)*8;
  const unsigned kdst=lds0+LDS_K+wid*1024, vdst=lds0+LDS_V+wid*1024;
  #define DMA_K(t,slot) glds16(ksrc+(long)(t)*KVBLK*DM,(unsigned)__builtin_amdgcn_readfirstlane(kdst+(slot)))
  #define DMA_V(t,slot) glds16(vsrc+(long)(t)*KVBLK*DM,(unsigned)__builtin_amdgcn_readfirstlane(vdst+(slot)))
  const int vb0=(int)(lds0+LDS_V)+((lane>>4)&1)*32+(lane&3)*8+(4*hi+((lane&15)>>2))*64;
  const char*Kbase=shm+LDS_K; bf16x8 kf[8];
  const lds_cptr shm3=(lds_cptr)shm; const lds_cptr kp0=shm3+LDS_K+hi*1024+r32*16; const lds_cptr vp0=shm3+LDS_V+((lane>>4)&1)*32+(lane&3)*8+(4*hi+((lane&15)>>2))*64;
  const int NT=(q0+QB)/KVBLK;
  DMA_K(0,0);DMA_V(0,0);DMA_K(1,SLOTB);
  bf16x8 qr[4];
  #pragma unroll
  for(int d0=0;d0<4;++d0)qr[d0]=*reinterpret_cast<const bf16x8*>(&Qw[(long)r32*DM+d0*16+hi*8]);

  unsigned selm=0u;
  if(qb>0){
    typedef __attribute__((address_space(3))) f32x4_t lds_f4;
    if(wid<4){ const int n_=tid>>4,d4_=(tid&15)*4; const f32x4_t s_=*reinterpret_cast<const f32x4_t*>(kmean+n_*128+d4_)+*reinterpret_cast<const f32x4_t*>(kmean+n_*128+64+d4_);
      *(lds_f4*)((lds_cptr)shm+LDS_KMS+(n_*64+d4_)*4)=s_; }
    asm volatile("s_waitcnt lgkmcnt(0)\n\ts_barrier":::"memory");
    float g[16];
    #pragma unroll
    for(int n=0;n<16;++n)g[n]=-INFINITY;
    #pragma unroll
    for(int n=0;n<15;++n) if(n<qb){
      const lds_cptr km=(lds_cptr)shm+LDS_KMS+(n*64+8*hi)*4; float a=0.f;
      #pragma unroll
      for(int d0=0;d0<4;++d0){ const f32x4_t k0=*(const lds_f4*)(km+64*d0),k1=*(const lds_f4*)(km+64*d0+16);
        #pragma unroll
        for(int j=0;j<4;++j){ a+=__uint_as_float((unsigned)(unsigned short)qr[d0][j]<<16)*k0[j]; a+=__uint_as_float((unsigned)(unsigned short)qr[d0][4+j]<<16)*k1[j]; } }
      auto rr=__builtin_amdgcn_permlane32_swap(__float_as_uint(a),__float_as_uint(a),false,false); g[n]=__uint_as_float(rr[0])+__uint_as_float(rr[1]);
    }
    #pragma unroll
    for(int s=0;s<3;++s) if(s<qb){ float best=-INFINITY; int bi=0;
      #pragma unroll
      for(int n=0;n<15;++n) if(g[n]>best){best=g[n];bi=n;}
      selm|=1u<<bi;
      #pragma unroll
      for(int n=0;n<15;++n) if(n==bi)g[n]=-INFINITY; }
  }
  selm|=1u<<qb;
  float mhat=0.f,l_reg=0.f;f32x16 o[2];f32x16 negm; { float z_=0.f; asm volatile("":"+v"(z_));
    _Pragma("unroll") for(int r_=0;r_<16;++r_){o[0][r_]=z_;o[1][r_]=z_;negm[r_]=z_;} } asm volatile("":"+v"(negm));
  const int qrel=wid*QBLK+r32;
  #define NEGSET(blk) do{ const float nv_=((selm>>(blk))&1u)?-mhat:NEGBIG; _Pragma("unroll") for(int r_=0;r_<16;++r_)negm[r_]=nv_; asm volatile("":"+v"(negm)); }while(0)
  NEGSET(0);
  #define CMASK(P0,P1,t) do{int jb_=(t)-(NT-4); if(jb_>=0)cmask(P0,P1,jb_,qrel,hi); }while(0)
  bool resc=false;
  #define START(P0,P1) do{ const float rm=rowmax(P0,P1); resc=false; \
    { const float dl=rm; mhat=fadd_s(mhat,dl); \
      _Pragma("unroll") for(int r=0;r<16;++r){P0[r]=fsub_s(P0[r],dl);P1[r]=fsub_s(P1[r],dl);} \
      NEGSET(0); } \
    _Pragma("unroll") for(int r=0;r<16;++r)P0[r]=__builtin_amdgcn_exp2f(P0[r]); }while(0)
  #define RESC() do{ if(resc){ asm volatile("s_waitcnt lgkmcnt(0)":::"memory"); \
      _Pragma("unroll") for(int d_=0;d_<2;++d_) _Pragma("unroll") for(int r=0;r<16;++r)o[d_][r]*=wsf[crow(r,hi)]; } }while(0)
  f32x16 pA0,pA1,pB0,pB1;
  int sl_prev=0,sl_cur=0,sl_next=SLOTB;
  #define ROT() do{sl_prev=sl_cur;sl_cur=sl_next;sl_next=(sl_next==(NSLOT-1)*SLOTB)?0:sl_next+SLOTB;}while(0)
  DMA_K(2,2*SLOTB);
  WAIT_BAR(3);
  qkt(pA0,pA1,Kbase,qr,negm,r32,hi);asm volatile("s_nop 15\n\ts_nop 7":"+v"(pA0),"+v"(pA1));CMASK(pA0,pA1,0);
  START(pA0,pA1);
  _Pragma("unroll") for(int r=0;r<16;++r)pA1[r]=__builtin_amdgcn_exp2f(pA1[r]);
  WAIT_BAR(0);
  DMA_K(3,0);DMA_V(1,SLOTB);
  ROT();
  kload8(kf,kp0+sl_cur);
  WAIT_BAR(2);
  s16x4 vlo[8],vhi[8]; u32x4 pw0,pw1,pw2,pw3;
  #define PKW(P,B) cvtpk_s(P[B],P[B+1])
  #define PAF(k) __builtin_bit_cast(bf16x8,pw##k)
  #define VFR(i) (bf16x8){vlo[i][0],vlo[i][1],vlo[i][2],vlo[i][3],vhi[i][0],vhi[i][1],vhi[i][2],vhi[i][3]}
  #define PIN(x) asm volatile("":"+v"(x))
  #define MX3(a,b,c) __builtin_fmaxf(__builtin_fmaxf((a),(b)),(c))
  #define GAPA(MF,A0,A1,A2,A3,W0,W1,PW) do{ MF; sacc+=A0; sacc+=A1; sacc+=A2; sacc+=A3; PIN(sacc); W0; W1; PIN(PW); SBAR(); }while(0)
  #define EX(v) __builtin_amdgcn_exp2f(v)
  #define GAPB(MF,X,B) do{ MF; X[B]=EX(X[B]); X[B+1]=EX(X[B+1]); X[B+2]=EX(X[B+2]); X[B+3]=EX(X[B+3]); PIN(X); SBAR(); }while(0)
  #define VRD(i) do{ vlo[i]=vtr(vp_+(((i)>>2)*4096+((i)&3)*1024)); vhi[i]=vtr(vp_+(((i)>>2)*4096+((i)&3)*1024+512)); }while(0)
  #define KRD(G,j) do{ if(G){ kload2(kf,kp0+sl_next,j); SBAR(); } }while(0)
  #define STEP(C0,C1,P0,P1,t,GK,GV,GL) do{ SBAR(); \
    const lds_cptr vp_=vp0+sl_prev; \
    VRD(0); SBAR(); float sacc=(P0[0]+P0[1]); \
    GAPA(C0=__builtin_amdgcn_mfma_f32_32x32x16_bf16(kf[0],qr[0],negm,0,0,0), P0[2],P0[3],P0[4],P0[5],     pw0[0]=PKW(P0,0), pw0[1]=PKW(P0,2), pw0); \
    VRD(4); SBAR(); GAPA(C1=__builtin_amdgcn_mfma_f32_32x32x16_bf16(kf[1],qr[0],negm,0,0,0), P0[6],P0[7],P0[8],P0[9],     pw0[2]=PKW(P0,4), pw0[3]=PKW(P0,6), pw0); \
    VRD(1); SBAR(); GAPA(C0=__builtin_amdgcn_mfma_f32_32x32x16_bf16(kf[2],qr[1],C0,0,0,0),   P0[10],P0[11],P0[12],P0[13], pw1[0]=PKW(P0,8), pw1[1]=PKW(P0,10), pw1); \
    VRD(5); SBAR(); GAPA(C1=__builtin_amdgcn_mfma_f32_32x32x16_bf16(kf[3],qr[1],C1,0,0,0),   P0[14],P0[15],P1[0],P1[1],   pw1[2]=PKW(P0,12),pw1[3]=PKW(P0,14), pw1); \
    VRD(2); SBAR(); GAPA(C0=__builtin_amdgcn_mfma_f32_32x32x16_bf16(kf[4],qr[2],C0,0,0,0),   P1[2],P1[3],P1[4],P1[5],     pw2[0]=PKW(P1,0), pw2[1]=PKW(P1,2), pw2); \
    VRD(6); SBAR(); GAPA(C1=__builtin_amdgcn_mfma_f32_32x32x16_bf16(kf[5],qr[2],C1,0,0,0),   P1[6],P1[7],P1[8],P1[9],     pw2[2]=PKW(P1,4), pw2[3]=PKW(P1,6), pw2); \
    VRD(3); SBAR(); GAPA(C0=__builtin_amdgcn_mfma_f32_32x32x16_bf16(kf[6],qr[3],C0,0,0,0),   P1[10],P1[11],P1[12],P1[13], pw3[0]=PKW(P1,8), pw3[1]=PKW(P1,10), pw3); \
    VRD(7); SBAR(); GAPA(C1=__builtin_amdgcn_mfma_f32_32x32x16_bf16(kf[7],qr[3],C1,0,0,0),   P1[14],P1[15],0.f,0.f,       pw3[2]=PKW(P1,12),pw3[3]=PKW(P1,14), pw3); \
    l_reg+=sacc; \
    if(GK){DMA_K((t)+3,sl_cur);} if(GV){DMA_V((t)+1,sl_next);} \
    CMASK(C0,C1,t); \
    { float a=MX3(C0[0],C0[1],C1[0]),b=MX3(C0[2],C0[3],C1[1]); a=MX3(a,C1[2],C1[3]); \
      _Pragma("unroll") for(int r=4;r<16;r+=4){a=MX3(a,C0[r],C0[r+1]);b=MX3(b,C0[r+2],C0[r+3]);a=MX3(a,C1[r],C1[r+1]);b=MX3(b,C1[r+2],C1[r+3]);} \
      float rm=__builtin_fmaxf(a,b); { auto rr=__builtin_amdgcn_permlane32_swap(__float_as_uint(rm),__float_as_uint(rm),false,false); rm=__builtin_fmaxf(__uint_as_float(rr[0]),__uint_as_float(rr[1])); } \
      resc=false; \
      if(__builtin_expect(__any(rm>(float)THRL),0)){ const float dl=__builtin_fmaxf(rm,0.f); mhat+=dl; \
        _Pragma("unroll") for(int r=0;r<16;++r){C0[r]-=dl;C1[r]-=dl;} \
        NEGSET((t)>>2); \
        const float f=__builtin_amdgcn_exp2f(-dl); l_reg*=f; if(hi==0)wsf[r32]=f; resc=true; } } \
    SBAR(); \
    GAPB(o[0]=__builtin_amdgcn_mfma_f32_32x32x16_bf16(PAF(0),VFR(0),o[0],0,0,0), C0,0); \
    GAPB(o[1]=__builtin_amdgcn_mfma_f32_32x32x16_bf16(PAF(0),VFR(4),o[1],0,0,0), C0,4); \
    KRD(GL,0); GAPB(o[0]=__builtin_amdgcn_mfma_f32_32x32x16_bf16(PAF(1),VFR(1),o[0],0,0,0), C0,8); \
    KRD(GL,1); GAPB(o[1]=__builtin_amdgcn_mfma_f32_32x32x16_bf16(PAF(1),VFR(5),o[1],0,0,0), C0,12); \
    KRD(GL,2); GAPB(o[0]=__builtin_amdgcn_mfma_f32_32x32x16_bf16(PAF(2),VFR(2),o[0],0,0,0), C1,0); \
    KRD(GL,3); GAPB(o[1]=__builtin_amdgcn_mfma_f32_32x32x16_bf16(PAF(2),VFR(6),o[1],0,0,0), C1,4); \
    GAPB(o[0]=__builtin_amdgcn_mfma_f32_32x32x16_bf16(PAF(3),VFR(3),o[0],0,0,0), C1,8); \
    GAPB(o[1]=__builtin_amdgcn_mfma_f32_32x32x16_bf16(PAF(3),VFR(7),o[1],0,0,0), C1,12); \
    }while(0)
  int t=1;
  #undef CMASK
  #define CMASK(P0,P1,t) do{}while(0)
  for(;t+5<NT;t+=2){
    STEP(pB0,pB1,pA0,pA1,t,true,true,true);     WAIT_BAR(2); RESC(); ROT();
    if(((t+1)&3)==0)NEGSET((t+1)>>2);
    STEP(pA0,pA1,pB0,pB1,t+1,true,true,true);   WAIT_BAR(2); RESC(); ROT();
  }
  #undef CMASK
  #define CMASK(P0,P1,t) do{int jb_=(t)-(NT-4); if(jb_>=0)cmask(P0,P1,jb_,qrel,hi); }while(0)
  #define ENDW(tt) do{ if((tt)+3<NT){WAIT_BAR(2);} else if((tt)+2<NT){WAIT_BAR(1);} else {WAIT_BAR(0);} }while(0)
  for(;t+1<NT;t+=2){
    STEP(pB0,pB1,pA0,pA1,t,(t+3<NT),(t+1<NT),(t+1<NT));       ENDW(t);   RESC(); ROT();
    if(((t+1)&3)==0)NEGSET((t+1)>>2);
    STEP(pA0,pA1,pB0,pB1,t+1,(t+4<NT),(t+2<NT),(t+2<NT));     ENDW(t+1); RESC(); ROT();
  }
  STEP(pB0,pB1,pA0,pA1,NT-1,false,false,false); RESC();
  { float sacc=pB0[0]+pB0[1]; _Pragma("unroll") for(int r=2;r<16;++r)sacc+=pB0[r]; _Pragma("unroll") for(int r=0;r<16;++r)sacc+=pB1[r]; l_reg+=sacc;
    pw0=(u32x4){PKW(pB0,0),PKW(pB0,2),PKW(pB0,4),PKW(pB0,6)};pw1=(u32x4){PKW(pB0,8),PKW(pB0,10),PKW(pB0,12),PKW(pB0,14)};pw2=(u32x4){PKW(pB1,0),PKW(pB1,2),PKW(pB1,4),PKW(pB1,6)};pw3=(u32x4){PKW(pB1,8),PKW(pB1,10),PKW(pB1,12),PKW(pB1,14)};
    SBAR(); pv(o,vb0+sl_cur,PAF(0),PAF(1),PAF(2),PAF(3)); }
  #undef PKW
  #undef PAF
  #undef VFR
  #undef PIN
  #undef MX3
  #undef GAPA
  #undef GAPB
  #undef EX
  #undef VRD
  #undef KRD
  #undef STEP
  #undef ENDW
  {auto rr=__builtin_amdgcn_permlane32_swap(__float_as_uint(l_reg),__float_as_uint(l_reg),false,false);l_reg=__uint_as_float(rr[0])+__uint_as_float(rr[1]);}
  if(hi==0)wsf[32+r32]=l_reg;asm volatile("s_waitcnt lgkmcnt(0)":::"memory");
  float rli[16];
  #pragma unroll
  for(int r=0;r<16;++r)rli[r]=__builtin_amdgcn_rcpf(wsf[32+crow(r,hi)]);
  bf16*Ow=O+(rowbase+q0+wid*QBLK)*DMO+h*D;
  { bf16*stg=(bf16*)(shm+LDS_OST)+wid*2048;
    #pragma unroll
    for(int r=0;r<16;++r){const int orow=crow(r,hi);
      #pragma unroll
      for(int d0=0;d0<2;++d0)stg[orow*64+d0*32+r32]=__float2bfloat16(o[d0][r]*rli[r]);}
    asm volatile("s_waitcnt lgkmcnt(0)":::"memory");
    #pragma unroll
    for(int i=0;i<4;++i){const int row=i*8+(lane>>3),ch=lane&7; const u32x4 v=*(const u32x4*)(stg+row*64+ch*8); ATTN_STORE16(Ow+(long)row*DMO+ch*8,v);} }
  asm volatile("s_waitcnt lgkmcnt(0)\n\ts_barrier":::"memory");
  #undef DMA_K
  #undef DMA_V
  #undef CMASK
  #undef NEGSET
  #undef START
  #undef RESC
  #undef ROT
}
constexpr int ATTN_LDS_BYTES=LDS_BYTES;
struct AttnTensors { const bf16* Q; const bf16* K; const bf16* V; bf16* O; const float* kmean; };
struct AttnUnit { int bh; int qb; };
struct StaticOrder {
  int vcu,G;
  __device__ __forceinline__ explicit StaticOrder(int grid,int block):vcu((grid%8==0)?(block%8)*(grid/8)+block/8:block),G(grid){}
  __device__ __forceinline__ bool next(int i,AttnUnit&u)const{ const int idx=(i>>1)*G+vcu; if(idx>=BATCH*NHEAD*8)return false; const int s=idx&7; u.bh=idx>>3; u.qb=(i&1)?15-s:s; return true; }
  __device__ __forceinline__ void a_ready(const AttnUnit&)const{}
  __device__ __forceinline__ void done(const AttnUnit&)const{}
};
template<class Sched,int THRL=8> __device__ __forceinline__ void attn_phase(char*lds,const AttnTensors&T,const Sched&S,int wave_in){
  AttnUnit u;
  for(int i=0;S.next(i,u);++i){ S.a_ready(u); attn_unit<THRL>(u.bh/NHEAD,u.bh%NHEAD,u.qb,T.Q,T.K,T.V,T.O,T.kmean+(size_t)u.bh*16*128,lds,wave_in); S.done(u); }
}
#undef SBAR
#undef WAIT_BAR
}
__device__ __forceinline__ void phase_moe_route(Frame& F) {
    PHASE_LOCALS();
    if ((int)blockIdx.x >= 4 * (M / 256)) return;
    const int j = blockIdx.x >> 2, quarter = blockIdx.x & 3;
    const int* TOPI = (const int*)(F.ws + WS_TOPI); int* DEST = (int*)(F.ws + WS_DEST); int* ROWTOK = (int*)(F.ws + WS_ROWTOK); int* TILEE = (int*)(F.ws + WS_TILEE); int* NTILES = (int*)(F.ws + WS_NTILES);
    LAS int* cnt = (LAS int*)F.lds; LAS int* tot = cnt + 64 * 8; LAS int* basej = tot + 8; LAS int* pstart = basej + 8; LAS int* wcnt = pstart + 16; LAS int* dsts = wcnt + 32;
    for (int i = tid; i < 64 * 8; i += NTHR) cnt[i] = 0;
    __syncthreads();
    for (int m0 = tid; m0 < M; m0 += 8 * NTHR) { int2 e[8];
#pragma unroll
        for (int k = 0; k < 8; ++k) e[k] = *(const int2*)(TOPI + (size_t)(m0 + k * NTHR) * 2);
#pragma unroll
        for (int k = 0; k < 8; ++k) { const int m = m0 + k * NTHR; __hip_atomic_fetch_add(cnt + (m >> 8) * 8 + e[k].x, 1, __ATOMIC_RELAXED, __HIP_MEMORY_SCOPE_WORKGROUP); __hip_atomic_fetch_add(cnt + (m >> 8) * 8 + e[k].y, 1, __ATOMIC_RELAXED, __HIP_MEMORY_SCOPE_WORKGROUP); } }
    __syncthreads();
    if (tid < 8) { int s = 0, bj = 0; for (int jj = 0; jj < 64; ++jj) { if (jj == j) bj = s; s += cnt[jj * 8 + tid]; } tot[tid] = s; basej[tid] = bj; }
    __syncthreads();
    if (tid == 0) { int ps = 0; for (int e = 0; e < 8; ++e) { pstart[e] = ps; ps += (tot[e] + 255) & ~255; } pstart[8] = ps; }
    __syncthreads();
    const int m = 256 * j + tid; int e1 = -1, e2 = -1, rk1 = 0, rk2 = 0;
    if (tid < 256) { const int2 e = *(const int2*)(TOPI + (size_t)m * 2); e1 = e.x; e2 = e.y; }
    if (tid < 256) {
#pragma unroll
        for (int e = 0; e < 8; ++e) { const bool has = (e1 == e) || (e2 == e); const unsigned long long mask = __ballot(has); const int rk = __popcll(mask & ((1ull << lane) - 1ull));
            if (e1 == e) rk1 = rk; if (e2 == e) rk2 = rk; if (lane == 0) wcnt[F.wave * 8 + e] = __popcll(mask); }
    }
    __syncthreads();
    if (tid < 256) {
        int o1 = 0, o2 = 0;
        for (int w = 0; w < F.wave; ++w) { o1 += wcnt[w * 8 + e1]; o2 += wcnt[w * 8 + e2]; }
        const int d1 = pstart[e1] + basej[e1] + o1 + rk1, d2 = pstart[e2] + basej[e2] + o2 + rk2;
        if (quarter == 0) *(int2*)(DEST + (size_t)m * 2) = make_int2(d1, d2);
        dsts[2 * tid] = d1; dsts[2 * tid + 1] = d2;
    }
    __syncthreads();
    { const unsigned char* __restrict__ HB8 = (const unsigned char*)(F.ws + WS_HB); unsigned char* __restrict__ XG = (unsigned char*)(F.ws + WS_XG);
      for (int i0 = quarter * 64 * 64 + tid; i0 < (quarter + 1) * 64 * 64; i0 += 8 * NTHR) { v4u val[8];
#pragma unroll
          for (int k = 0; k < 8; ++k) { const int i = i0 + k * NTHR; val[k] = *(const GAS v4u*)(HB8 + (size_t)(256 * j + (i >> 6)) * D + 16 * (i & 63)); }
#pragma unroll
          for (int k = 0; k < 8; ++k) { const int i = i0 + k * NTHR, t = i >> 6;
              *(GAS v4u*)(XG + (size_t)dsts[2 * t] * D + 16 * (i & 63)) = val[k]; *(GAS v4u*)(XG + (size_t)dsts[2 * t + 1] * D + 16 * (i & 63)) = val[k]; } } }
    if (j == 0 && quarter == 0) {
        const int nt = pstart[8] >> 8;
        for (int i = tid; i < nt; i += NTHR) { int e = 0; for (int k = 1; k < 8; ++k) if (256 * i >= pstart[k]) e = k; TILEE[i] = e; }
        if (tid == 0) NTILES[0] = nt;
    }
    __syncthreads();
}
__device__ __forceinline__ int moe_ntiles(Frame& F) { return __builtin_amdgcn_readfirstlane((int)__hip_atomic_load((const unsigned*)(F.ws + WS_NTILES), RLX_AGENT)); }
__device__ __forceinline__ void phase_moe_gather(Frame& F) {
    PHASE_LOCALS();
    const int nrows = moe_ntiles(F) * 256; const int* __restrict__ ROWTOK = (const int*)(F.ws + WS_ROWTOK); const bf16* __restrict__ HB = (const bf16*)(F.ws + WS_HB); bf16* __restrict__ XG = (bf16*)(F.ws + WS_XG);
    const int total = nrows * 128, stride = F.G * NTHR;
    for (int idx0 = F.vcu * NTHR + tid; idx0 < total; idx0 += 8 * stride) {
        int tok[8]; v4u val[8];
#pragma unroll
        for (int k = 0; k < 8; ++k) { const int idx = idx0 + k * stride; tok[k] = (idx < total) ? ROWTOK[idx >> 7] : 0; }
#pragma unroll
        for (int k = 0; k < 8; ++k) { const int idx = idx0 + k * stride; val[k] = *(const v4u*)(HB + (size_t)tok[k] * D + 8 * (idx & 127)); }
#pragma unroll
        for (int k = 0; k < 8; ++k) { const int idx = idx0 + k * stride; if (idx < total) *(v4u*)(XG + (size_t)(idx >> 7) * D + 8 * (idx & 127)) = val[k]; }
    }
}
constexpr float W2_F8SCALE = 64.0f, GH_F8SCALE = 4.0f;
constexpr float W13_F8SCALE = 32.0f;
constexpr int CW_Q = 2048, CW_DONE = 3072;
constexpr int QN_E13 = 2 * (16 * 14), QN_E2 = 56 * 4;
constexpr int QN0 = NEXP * (QN_E13 + QN_E2), QN3 = (NTILES_T - P0_URGENT) + P_CHUNKS;
__device__ __forceinline__ void conv_item(Frame& F, const Inputs& in, int q, int it, int lane) {
    if (q == 3) { if (it < NTILES_T - P0_URGENT) p0_tile(F, in, P0_URGENT + it, lane); else p_chunk(F, in, it - (NTILES_T - P0_URGENT), F.wave * 64 + lane); return; }
    unsigned char* W13 = F.ws + WS_WE; unsigned char* W2 = W13 + (size_t)NEXP * 2 * DFFE * D;
    const int per = QN_E13 + QN_E2, e = it / per; int r = it % per;
    bool found = false; TrJob jb;
    jb.W = nullptr; jb.ld = 0; jb.K = 64; jb.N = 256; jb.WT = nullptr; jb.rowstep = 128; jb.row_off = 0; jb.gk = nullptr; jb.nrows = 32;
    bf16* W13e = (bf16*)(W13 + (size_t)e * 2 * DFFE * D);
    TTJOBG(in.p[I_WE1] + (size_t)e * D * DFFE, DFFE, D, DFFE, W13e, 256, 0, nullptr)
    TTJOBG(in.p[I_WE3] + (size_t)e * D * DFFE, DFFE, D, DFFE, W13e, 256, 128, nullptr)
    const bool is13 = found;
    TTJOBG(in.p[I_WE2] + (size_t)e * DFFE * D, D, DFFE, D, (bf16*)(W2 + (size_t)e * D * DFFE), 128, 0, nullptr)
    if (found) tr_tile(jb.W, jb.ld, jb.K, jb.N / 256, jb.WT, jb.rowstep, jb.row_off, (LAS float*)(F.lds + RING_OFF), r, F.wave, lane, jb.gk, false, is13 ? W13_F8SCALE : W2_F8SCALE);
}
struct TileJob0 { const float* W; unsigned char* WT; int ld, K, rowstep, row_off, k0, n0; float sc; };
__device__ __forceinline__ TileJob0 tile_job0(Frame& F, const Inputs& in, int it) {
    unsigned char* W13 = F.ws + WS_WE; unsigned char* W2 = W13 + (size_t)NEXP * 2 * DFFE * D;
    const int per = QN_E13 + QN_E2, e = it / per, r = it % per; TileJob0 j;
    if (r < QN_E13) { const int h3 = (r >= QN_E13 / 2) ? 1 : 0, rr = r - h3 * (QN_E13 / 2);
        j.W = in.p[h3 ? I_WE3 : I_WE1] + (size_t)e * D * DFFE; j.ld = DFFE; j.K = D; j.WT = W13 + (size_t)e * 2 * DFFE * D; j.rowstep = 256; j.row_off = 128 * h3; j.k0 = 64 * (rr / 14); j.n0 = 256 * (rr % 14); j.sc = W13_F8SCALE; }
    else { const int rr = r - QN_E13; j.W = in.p[I_WE2] + (size_t)e * DFFE * D; j.ld = D; j.K = DFFE; j.WT = W2 + (size_t)e * D * DFFE; j.rowstep = 128; j.row_off = 0; j.k0 = 64 * (rr / 4); j.n0 = 256 * (rr % 4); j.sc = W2_F8SCALE; }
    return j;
}
__device__ __forceinline__ void conv_queue0(Frame& F, const Inputs& in, int nitems, int stop_site, unsigned n_long) {
    PHASE_LOCALS();
    gu32* head = F.ctl + CW_Q; gu32* done = F.ctl + CW_DONE + 64 * (stop_site < 0 ? 0 : stop_site);
    volatile LAS unsigned* slot = F.MISC + 16; LAS float* scr = (LAS float*)(F.lds + RING_OFF); const int wave = F.wave;
#define Q0_TAKE() do { if (tid == 0) { unsigned b_ = 0xffffffffu; if (!(stop_site >= 0 && __hip_atomic_load(done, RLX_AGENT) >= n_long)) b_ = __hip_atomic_fetch_add(head, 1u, RLX_AGENT); slot[0] = b_; } } while (0)
#define Q0_LOAD(J, V) do { _Pragma("unroll") for (int i = 0; i < 8; ++i) V[i] = *(const f32x4*)(J.W + (size_t)(J.k0 + wave + 8 * i) * J.ld + J.n0 + 4 * lane); } while (0)
    Q0_TAKE();
    __syncthreads();
    unsigned base = slot[0];
    __syncthreads();
    if (base >= (unsigned)nitems) return;
    TileJob0 a = tile_job0(F, in, (int)base); f32x4 v[8], vn[8];
    Q0_LOAD(a, v);
    for (;;) {
        Q0_TAKE();
#pragma unroll
        for (int i = 0; i < 8; ++i) { LAS float* d = scr + (wave + 8 * i) * 257 + 4 * lane; d[0] = v[i][0]; d[1] = v[i][1]; d[2] = v[i][2]; d[3] = v[i][3]; }
        __syncthreads();
        base = slot[0];
        const bool more = base < (unsigned)nitems; TileJob0 b = a;
        if (more) { b = tile_job0(F, in, (int)base); Q0_LOAD(b, vn); }
        { const int c = tid & 7;
#pragma unroll
          for (int jj = 0; jj < 4; ++jj) { const int n = (tid >> 3) + 64 * jj; const LAS float* p = scr + (8 * c) * 257 + n; const float sc = a.sc;
              const int nn = a.n0 + n, drow = (nn >> 7) * a.rowstep + (nn & 127) + a.row_off;
              int a_ = __builtin_amdgcn_cvt_pk_fp8_f32(p[0] * sc, p[257] * sc, 0, false); a_ = __builtin_amdgcn_cvt_pk_fp8_f32(p[2 * 257] * sc, p[3 * 257] * sc, a_, true);
              int b_ = __builtin_amdgcn_cvt_pk_fp8_f32(p[4 * 257] * sc, p[5 * 257] * sc, 0, false); b_ = __builtin_amdgcn_cvt_pk_fp8_f32(p[6 * 257] * sc, p[7 * 257] * sc, b_, true);
              uint2 o8; o8.x = (unsigned)a_; o8.y = (unsigned)b_; *(uint2*)(a.WT + (size_t)drow * a.K + a.k0 + 8 * c) = o8; } }
        __syncthreads();
        if (!more) break;
        a = b;
#pragma unroll
        for (int i = 0; i < 8; ++i) v[i] = vn[i];
    }
#undef Q0_TAKE
#undef Q0_LOAD
}
__device__ __forceinline__ void conv_queue3(Frame& F, const Inputs& in, int nitems, int stop_site, unsigned n_long) {
    PHASE_LOCALS();
    gu32* head = F.ctl + CW_Q + 64 * 3; gu32* done = F.ctl + CW_DONE + 64 * (stop_site < 0 ? 0 : stop_site);
    volatile LAS unsigned* slot = F.MISC + 16; LAS float* scr = (LAS float*)(F.lds + RING_OFF); const int wave = F.wave; constexpr int NT3 = NTILES_T - P0_URGENT;
#define Q3_TAKE() do { if (tid == 0) { unsigned b_ = 0xffffffffu; if (!(stop_site >= 0 && __hip_atomic_load(done, RLX_AGENT) >= n_long)) b_ = __hip_atomic_fetch_add(head, 1u, RLX_AGENT); slot[0] = b_; } } while (0)
#define Q3_LOAD(J, R, V, GV) do { const int ntn_ = J.N / 256, k0_ = 64 * ((R) / ntn_), n0_ = 256 * ((R) % ntn_); _Pragma("unroll") for (int i = 0; i < 8; ++i) { V[i] = *(const f32x4*)(J.W + (size_t)(k0_ + wave + 8 * i) * J.ld + n0_ + 4 * lane); GV[i] = J.gk ? J.gk[k0_ + wave + 8 * i] : 1.0f; } } while (0)
    Q3_TAKE();
    __syncthreads();
    unsigned base = slot[0];
    __syncthreads();
    while (base < (unsigned)nitems) {
        if ((int)base >= NT3) { p_chunk(F, in, (int)base - NT3, tid); Q3_TAKE(); __syncthreads(); base = slot[0]; __syncthreads(); continue; }
        TrJob a; int ra; p0_job(F, in, P0_URGENT + (int)base, a, ra); f32x4 v[8], vn[8]; float gv[8], gn[8];
        Q3_LOAD(a, ra, v, gv);
        for (;;) {
            Q3_TAKE();
#pragma unroll
            for (int i = 0; i < 8; ++i) { LAS float* d = scr + (wave + 8 * i) * 257 + 4 * lane; const float g = gv[i]; d[0] = v[i][0] * g; d[1] = v[i][1] * g; d[2] = v[i][2] * g; d[3] = v[i][3] * g; }
            __syncthreads();
            base = slot[0];
            const bool more = base < (unsigned)nitems && (int)base < NT3; TrJob b = a; int rb = ra;
            if (more) { p0_job(F, in, P0_URGENT + (int)base, b, rb); Q3_LOAD(b, rb, vn, gn); }
            { const int c = tid & 7, ntn = a.N / 256, k0 = 64 * (ra / ntn), n0 = 256 * (ra % ntn); const bool permqk = a.nrows == 33; const float f8scale = a.nrows == 34 ? WPG_F8SCALE : 0.f;
#pragma unroll
              for (int j = 0; j < 4; ++j) { const int n = (tid >> 3) + 64 * j; const LAS float* p = scr + (8 * c) * 257 + n;
                  const int nn = n0 + n, drow = permqk ? (nn & ~255) + (((nn >> 5) & 1) << 7) + (((nn >> 6) & 3) << 5) + (nn & 31) + a.row_off : (nn >> 7) * a.rowstep + (nn & 127) + a.row_off;
                  if (f8scale != 0.f) { uint2 o8; int a_ = __builtin_amdgcn_cvt_pk_fp8_f32(p[0] * f8scale, p[257] * f8scale, 0, false); a_ = __builtin_amdgcn_cvt_pk_fp8_f32(p[2 * 257] * f8scale, p[3 * 257] * f8scale, a_, true);
                      int b_ = __builtin_amdgcn_cvt_pk_fp8_f32(p[4 * 257] * f8scale, p[5 * 257] * f8scale, 0, false); b_ = __builtin_amdgcn_cvt_pk_fp8_f32(p[6 * 257] * f8scale, p[7 * 257] * f8scale, b_, true);
                      o8.x = (unsigned)a_; o8.y = (unsigned)b_; *(uint2*)((unsigned char*)a.WT + (size_t)drow * a.K + k0 + 8 * c) = o8; }
                  else { v4u o; o.x = pk2(p[0], p[257]); o.y = pk2(p[2 * 257], p[3 * 257]); o.z = pk2(p[4 * 257], p[5 * 257]); o.w = pk2(p[6 * 257], p[7 * 257]); *(GAS v4u*)(a.WT + (size_t)drow * a.K + k0 + 8 * c) = o; } } }
            __syncthreads();
            if (!more) break;
            a = b; ra = rb;
#pragma unroll
            for (int i = 0; i < 8; ++i) { v[i] = vn[i]; gv[i] = gn[i]; }
        }
    }
#undef Q3_TAKE
#undef Q3_LOAD
}
__device__ __forceinline__ void conv_queue(Frame& F, const Inputs& in, int q, int nitems, int stop_site, unsigned n_long) {
    if (q == 0) { conv_queue0(F, in, nitems, stop_site, n_long); return; }
    if (q == 3) { conv_queue3(F, in, nitems, stop_site, n_long); return; }
    PHASE_LOCALS();
    gu32* head = F.ctl + CW_Q + 64 * q; gu32* done = F.ctl + CW_DONE + 64 * (stop_site < 0 ? 0 : stop_site);
    volatile LAS unsigned* slot = F.MISC + 16;
    for (;;) {
        if (tid == 0) { unsigned base = 0xffffffffu;
            if (!(stop_site >= 0 && __hip_atomic_load(done, RLX_AGENT) >= n_long)) base = __hip_atomic_fetch_add(head, 1u, RLX_AGENT);
            slot[0] = base; }
        __syncthreads();
        const unsigned base = slot[0];
        __syncthreads();
        if (base >= (unsigned)nitems) break;
        conv_item(F, in, q, (int)base, lane);
    }
}
__device__ __forceinline__ void conv_fill_tail(Frame& F, const Inputs& in, int q, int nitems, int site, int mine, int maxc, int nlong) {
    if (nlong >= F.G) return;
    if (mine == maxc) { if (F.wave == 0 && lane_now() == 0) __hip_atomic_fetch_add(F.ctl + CW_DONE + 64 * site, 1u, RLX_AGENT); }
    else conv_queue(F, in, q, nitems, site, (unsigned)nlong);
}
__device__ __forceinline__ void conv_fill_all(Frame& F, const Inputs& in, int q, int nitems, int site) {
    __syncthreads();
    if (F.wave == 0 && lane_now() == 0) __hip_atomic_fetch_add(F.ctl + CW_DONE + 64 * site, 1u, RLX_AGENT);
    conv_queue(F, in, q, nitems, site, (unsigned)F.G);
}
__device__ __forceinline__ void conv_fill_tail_rr(Frame& F, const Inputs& in, int q, int nitems, int site, int nunits, int c) {
    const int maxu = (nunits + F.G - 1) / F.G, n_long = nunits - (maxu - 1) * F.G;
    conv_fill_tail(F, in, q, nitems, site, c < n_long ? maxu : maxu - 1, maxu, n_long);
}
__device__ __forceinline__ const LAS unsigned* moe_tile_table(Frame& F, int ntr) {
    LAS unsigned* tab = (LAS unsigned*)(F.lds + SM_OFF); const int tid = F.wave * 64 + lane_now();
    __syncthreads();
    if (tid < ntr) tab[tid] = __hip_atomic_load((const unsigned*)(F.ws + WS_TILEE) + tid, RLX_AGENT);
    __syncthreads();
    return tab;
}
namespace pg8 {
struct MoeOrder {
    static constexpr bool SEGMENTED = false;
    const PG8_LAS unsigned* tile_e; int ntr, nct, bpe, G, c;
    __device__ __forceinline__ bool next(int i, Unit& u) const {
        const int T = ntr * nct; long p;
        if (SEGMENTED && G % 8 == 0) { const int per = G / 8, x = c % 8, s = c / 8, seg = (T + 7) / 8; const long q = (long)i * per + s; if (q >= seg) return false; p = (long)x * seg + q; }
        else p = (long)i * G + c;
        if (p >= T) return false;
        u.pm = (int)(p / nct); u.pn = (int)(p % nct);
        const int e = __builtin_amdgcn_readfirstlane((int)tile_e[u.pm]);
        u.pb = e * bpe + u.pn; return true;
    }
    __device__ __forceinline__ int count_of(int cc) const { const int T = ntr * nct;
        if (SEGMENTED && G % 8 == 0) { const int per = G / 8, x = cc % 8, s = cc / 8, seg = (T + 7) / 8; int sx = T - x * seg; sx = sx < 0 ? 0 : (sx > seg ? seg : sx); return s < sx ? (sx - s + per - 1) / per : 0; }
        return cc < T ? (T - cc + G - 1) / G : 0; }
    __device__ __forceinline__ void tails(int& mine, int& maxc, int& nlong) const { mine = count_of(c); const int T = ntr * nct;
        if (!(SEGMENTED && G % 8 == 0)) { maxc = (T + G - 1) / G; nlong = T - (maxc - 1) * G; return; }
        const int per = G / 8, seg = (T + 7) / 8; maxc = (seg + per - 1) / per; nlong = 0;
        for (int x = 0; x < 8; ++x) { int sx = T - x * seg; sx = sx < 0 ? 0 : (sx > seg ? seg : sx); int k = sx - (maxc - 1) * per; k = k < 0 ? 0 : (k > per ? per : k); nlong += k; } }
    __device__ __forceinline__ void a_ready(const Unit&) const {}
    __device__ __forceinline__ void done(const Unit&) const {}
};
template <bool ACCUM> struct EpiY {
    static constexpr bool PERM = true, AFTER_DRAIN = false, MIDK = false; typedef NoPre::Pre Pre; __device__ __forceinline__ Pre prefetch(const Unit&, int, int) const { return Pre{}; }
    bf16_t* Y; int ldc; float osc;
    __device__ __forceinline__ void operator()(const f32x4 (&acc)[2][2][4][2], const Unit& u, int wr, int wc, int fr, int fq, const Pre&) const {
        const int row0 = u.pm * BM + wr * 64 + fr, col0 = u.pn * BM + wc * 32 + 8 * fq;
#pragma unroll
        for (int ai = 0; ai < 2; ++ai)
#pragma unroll
            for (int m = 0; m < 4; ++m) { bf16_t* rowp = Y + (size_t)(row0 + ai * HALF + m * 16) * ldc + col0;
#pragma unroll
                for (int bj = 0; bj < 2; ++bj) { f32x4 v0 = acc[ai][bj][m][0] * osc, v1 = acc[ai][bj][m][1] * osc;
                    if (ACCUM) { const u32x4 y = *(const u32x4*)(rowp + bj * HALF);
                        v0 += (f32x4){bflo(y.x), bfhi(y.x), bflo(y.y), bfhi(y.y)}; v1 += (f32x4){bflo(y.z), bfhi(y.z), bflo(y.w), bfhi(y.w)}; }
                    u32x4 w; w.x = cvt_pk_bf16(v0[0], v0[1]); w.y = cvt_pk_bf16(v0[2], v0[3]); w.z = cvt_pk_bf16(v1[0], v1[1]); w.w = cvt_pk_bf16(v1[2], v1[3]);
                    *(u32x4*)(rowp + bj * HALF) = w; } }
    }
};
}
struct Args { Inputs in; float* out; unsigned char* ws; int ph_lo, ph_hi, li, pad; };
#ifndef MLSTM_NAIVE
#define MLSTM_NAIVE 0
#endif
#ifndef ATTN_NAIVE
#define ATTN_NAIVE 0
#endif
#ifndef MOE_NAIVE
#define MOE_NAIVE 0
#endif
#ifndef MK_PER_PHASE
#define MK_PER_PHASE 0
#endif
constexpr int MAX_LAUNCH = 64;

__global__ void __launch_bounds__(NTHR, 2) mega_fwd(Args args) {
    extern __shared__ __attribute__((aligned(16))) unsigned char lds[];
    Frame F;
    F.lds = (LAS unsigned char*)lds;
    F.MISC = (volatile LAS unsigned*)(F.lds + MISC_OFF);
    F.wave = __builtin_amdgcn_readfirstlane((int)(threadIdx.x >> 6));
    F.G = gridDim.x; { const int bx = blockIdx.x; F.vcu = (F.G % 8 == 0) ? (bx % 8) * (F.G / 8) + bx / 8 : bx; }
    F.ws = args.ws; F.ctl = (gu32*)(args.ws + WS_CTL);
    const Inputs& in = args.in;
    for (int u = threadIdx.x; u < (LDS_BYTES - LDSCTL_OFF) / 4; u += NTHR) ((LAS unsigned*)(F.lds + LDSCTL_OFF))[u] = 0u;
    __syncthreads();
    XcdBarrier bar = xcd_barrier_post((unsigned*)(F.ctl + CW_BAR) + args.li * XCD_BAR_WORDS, F.MISC + 8, F.wave);
    const int lo = args.ph_lo, hi = args.ph_hi;
    int ph = 0;
__attribute__((unused)) auto phq = [](int p) { asm volatile("" : "+s"(p)); return p; };
#define RUN() (lo <= phq(ph) && phq(ph) < hi)
#define SEAM() do { if (lo <= phq(ph) && phq(ph) + 1 < hi) xcd_barrier(bar); ++ph; } while (0)
    auto wsp = [&]() { unsigned char* p_ = args.ws; asm volatile("" : "+s"(p_)); return p_; };
#define HB ((bf16*)(wsp() + WS_HB))
#define PROJ ((bf16*)(wsp() + WS_PROJ))
#define YA ((bf16*)(wsp() + WS_YA))
#define YB ((bf16*)(wsp() + WS_YB))
#define MIXED ((bf16*)(wsp() + WS_MIXED))
#define TMP ((bf16*)(wsp() + WS_TMP))
#define GH ((bf16*)(wsp() + WS_GH))
#define PP ((bf16*)(wsp() + WS_PP))
#define IFPRE ((float*)(wsp() + WS_IFPRE))
#define GSEL ((float*)(wsp() + WS_GSEL))
#define XB ((bf16*)(wsp() + WS_XB))
#define XB2 ((bf16*)(wsp() + WS_QKC))
#define SSACC ((pg8::ssq_t*)((unsigned*)(wsp() + WS_CTL) + CW_SS))
    float* const X = args.out;


#ifndef SK_P0
        if (RUN()) p0_prologue(F, in);
#endif

    SEAM();
    { constexpr int l = 0;
        const float* xs = (l == 0) ? in.p[I_X] : X;
        if (RUN()) {
            const bf16* A_ = (l == 0) ? XB : (const bf16*)(wsp() + WS_XR1); const bf16* W_ = (const bf16*)(F.ws + WS_WIN) + (size_t)l * NPROJX * D; const pg8::ssq_t* ss_ = (l == 0) ? (const pg8::ssq_t*)(F.ws + WS_SS0) : (const pg8::ssq_t*)(SSACC + 2 * M);
            { pg8::Gemm g{A_, W_, M, 1024, D}; pg8::StaticOrder S; S.init(M, 1024, F.G, (int)blockIdx.x);
              pg8::EpiQK E{PROJ, (unsigned)NPROJ, ss_, in.p[I_GQ] + l * AHD, in.p[I_GK] + l * AHD, (float*)(wsp() + WS_KMEAN), C2};
              pg8::gemm_phase<pg8::EpiQK, pg8::StaticOrder, true, true>(F.lds + RING_OFF, g, S, E, F.wave); }
            { pg8::Gemm g{A_, W_ + (size_t)1024 * D, M, NPROJX - 1024, D}; pg8::StaticOrder S; S.init(M, NPROJX - 1024, F.G, (int)blockIdx.x);
              pg8::EpiProj E{PROJ, NPROJ, PC_GA / 256, ss_, NPROJX / 256 - 1, IFPRE, in.p[I_BI] + l * MH, in.p[I_BF] + l * MH, (bf16*)(wsp() + WS_GT), 4};
              pg8::gemm_phase<pg8::EpiProj, pg8::StaticOrder, true, true>(F.lds + RING_OFF, g, S, E, F.wave);
              if (l == 0) conv_fill_tail_rr(F, in, 3, QN3, 0, (M / 256) * ((NPROJX - 1024) / 256), (int)blockIdx.x);
              else conv_fill_tail_rr(F, in, 0, QN0, 2, (M / 256) * ((NPROJX - 1024) / 256), (int)blockIdx.x); }
        }
        SEAM();
        if (RUN()) {
#if !MLSTM_NAIVE
            phase_mlstm_m1(F, in, l);
#endif
#if ATTN_NAIVE
            phase_attn_naive(F);
#else
            { const attn_body::AttnTensors AT{(const attn_body::bf16*)(PROJ + PC_Q), (const attn_body::bf16*)(PROJ + PC_K), (const attn_body::bf16*)(PROJ + PC_V), (attn_body::bf16*)YA, (const float*)(F.ws + WS_KMEAN)};
              const attn_body::StaticOrder S((int)F.G, (int)blockIdx.x);
              attn_body::attn_phase<attn_body::StaticOrder>((char*)lds + RING_OFF, AT, S, F.wave); }
#endif
        }

        SEAM();

#if MLSTM_NAIVE
        if (RUN()) phase_mlstm_naive(F, in, l);
        SEAM();
#else
        if (RUN()) { phase_mlstm_m3(F, in, l);
            if (l == 0) { conv_queue(F, in, 3, QN3, -1, 0u); conv_fill_all(F, in, 0, QN0, 5); } else conv_fill_all(F, in, 0, QN0, 4); }
        SEAM();
#endif


        if (RUN()) { pg8::Gemm g{YA, (const bf16*)(F.ws + WS_WOA) + (size_t)l * D * D, M, D, D}; pg8::StaticOrder S; S.init(M, D, F.G, (int)blockIdx.x);
            pg8::EpiMerge E{(const bf16*)(wsp() + WS_GT), MIXED, D};
            pg8::gemm_phase<pg8::EpiMerge, pg8::StaticOrder, true, true>(F.lds + RING_OFF, g, S, E, F.wave); }
        SEAM();
        if (RUN()) { pg8::Gemm g{MIXED, (const bf16*)(F.ws + WS_WOUT) + (size_t)l * D * D, M, D, D}; pg8::StaticOrder S; S.init(M, D, F.G, (int)blockIdx.x);
            if constexpr (l == 0) { pg8::EpiResid16<false> E{xs, nullptr, D, XB, SSACC};
                pg8::gemm_phase<pg8::EpiResid16<false>, pg8::StaticOrder, true, true>(F.lds + RING_OFF, g, S, E, F.wave); }
            else { pg8::EpiResid16<true> E{nullptr, (const bf16*)(wsp() + WS_XR1), D, (bf16*)(wsp() + WS_XR1), nullptr};
                pg8::gemm_phase<pg8::EpiResid16<true>, pg8::StaticOrder, true, true>(F.lds + RING_OFF, g, S, E, F.wave); } }
        SEAM();
        if (l == 0) {
            if (RUN()) { pg8::Gemm g{XB, (const bf16*)(F.ws + WS_WD13), M, 2 * DFF, D}; pg8::StaticOrder S; S.init(M, 2 * DFF, F.G, (int)blockIdx.x);
                pg8::EpiSwiglu E{GH, DFF, SSACC, 1.0f, GH_F8SCALE};
                pg8::gemm_phase<pg8::EpiSwiglu, pg8::StaticOrder, true, true>(F.lds + RING_OFF, g, S, E, F.wave);
                conv_fill_tail_rr(F, in, 0, QN0, 1, (M / 256) * (2 * DFF / 256), (int)blockIdx.x); }
            SEAM();
            if (RUN()) { pg8::Gemm g{GH, (const bf16*)(F.ws + WS_WD2), M, D, DFF / 2}; pg8::StaticOrder S; S.init(M, D, F.G, (int)blockIdx.x);
                pg8::EpiResid16<true> E{nullptr, XB, D, XB, SSACC + M, 1.0f / (WPG_F8SCALE * GH_F8SCALE)};
                pg8::gemm_phase<pg8::EpiResid16<true>, pg8::StaticOrder, true, true, true>(F.lds + RING_OFF, g, S, E, F.wave); }
            SEAM();
        } else {
            if (RUN()) phase_norm<2>(F, X, in.p[I_GFFN] + l * D, HB, in.p[I_WR], NEXP, nullptr, nullptr, nullptr, GSEL, (bf16*)(wsp() + WS_XR1));
            SEAM();
#if MOE_NAIVE
            for (int e = 0; e < NEXP; ++e) {

#ifndef SK_CONVE
        if (RUN()) p_conv_expert(F, in, e);
#endif

                SEAM();
                if (RUN()) { pg8::Gemm g{HB, (const bf16*)(F.ws + WS_WE), M, 2 * DFFE, D}; pg8::StaticOrder S; S.init(M, 2 * DFFE, F.G, (int)blockIdx.x);
                    pg8::EpiSwiglu E{GH, DFFE, nullptr, 1.0f, 0.f};
                    pg8::gemm_phase<pg8::EpiSwiglu, pg8::StaticOrder, true, true>(F.lds + RING_OFF, g, S, E, F.wave); }
                SEAM();
                if (RUN()) { pg8::Gemm g{GH, (const bf16*)(F.ws + WS_WE) + (size_t)2 * DFFE * D, M, D, DFFE}; pg8::StaticOrder S; S.init(M, D, F.G, (int)blockIdx.x);
                    pg8::EpiResid E{X, X, D, GSEL + e, NEXP, nullptr, nullptr};
                    pg8::gemm_phase<pg8::EpiResid, pg8::StaticOrder, true, true>(F.lds + RING_OFF, g, S, E, F.wave); }
                SEAM();
            }
#else
            if (RUN()) { phase_moe_route(F); conv_queue(F, in, 0, QN0, -1, 0u); }
            SEAM();
            if (RUN()) { pg8::Gemm g{(const bf16*)(F.ws + WS_XG), (const bf16*)(F.ws + WS_WE), MOE_MAXROWS, 2 * DFFE, D / 2};
                const int ntr_ = moe_ntiles(F); pg8::MoeOrder S{moe_tile_table(F, ntr_), ntr_, 2 * DFFE / 256, 2 * DFFE / 256, F.G, (int)blockIdx.x};
                pg8::EpiSwiglu E{(bf16*)(F.ws + WS_GHH), DFFE, nullptr, 1.0f / W13_F8SCALE, GH_F8SCALE};
                pg8::gemm_phase<pg8::EpiSwiglu, pg8::MoeOrder, true, true, true>(F.lds + RING_OFF, g, S, E, F.wave); }
            SEAM();
            if (RUN()) { pg8::Gemm g{(const bf16*)(F.ws + WS_GHH), (const bf16*)(F.ws + WS_WE + (size_t)NEXP * 2 * DFFE * D), MOE_MAXROWS, D, DFFE / 2};
                const int ntr_ = moe_ntiles(F); pg8::MoeOrder S{moe_tile_table(F, ntr_), ntr_, D / 256, D / 256, F.G, (int)blockIdx.x};
                pg8::EpiY<false> E{(bf16*)(F.ws + WS_Y), D, 1.0f / (W2_F8SCALE * GH_F8SCALE)}; pg8::gemm_phase<pg8::EpiY<false>, pg8::MoeOrder, true, true, true>(F.lds + RING_OFF, g, S, E, F.wave); }
            SEAM();
#endif
        }
        if (l == 1) {
            if (RUN()) { if (!MOE_NAIVE) phase_norm<3>(F, X, in.p[I_GPLE] + l * D, HB, nullptr, 0, nullptr, nullptr, nullptr, nullptr, (bf16*)(wsp() + WS_XR1));
                else phase_norm<0>(F, X, in.p[I_GPLE] + l * D, HB, nullptr, 0, nullptr, nullptr, nullptr, nullptr); }
            SEAM();
        }
        if (RUN()) {
            { pg8::Gemm g{(const bf16*)(F.ws + WS_PB) + (size_t)l * M * PLE, (const bf16*)(F.ws + WS_WPP) + (size_t)l * D * PLE, M, D, PLE}; pg8::StaticOrder S; S.init(M, D, F.G, (int)blockIdx.x);
              pg8::EpiF32 E{PP, D};
              pg8::gemm_phase<pg8::EpiF32, pg8::StaticOrder, true, true>(F.lds + RING_OFF, g, S, E, F.wave); }
            if constexpr (l == 0) { pg8::Gemm g{XB, (const bf16*)(F.ws + WS_WPG), M, D, D}; pg8::StaticOrder S; S.init(M, D, F.G, (int)blockIdx.x);
              pg8::EpiPle2 E{PP, nullptr, D, (const pg8::ssq_t*)(SSACC + M), (bf16*)(wsp() + WS_XR1), SSACC + 2 * M, 1.0f, XB};
              pg8::gemm_phase<pg8::EpiPle2, pg8::StaticOrder, true, true>(F.lds + RING_OFF, g, S, E, F.wave); }
            else { pg8::Gemm g{HB, (const bf16*)(F.ws + WS_WPG) + (size_t)l * D * D, M, D, D / 2}; pg8::StaticOrder S; S.init(M, D, F.G, (int)blockIdx.x);
              pg8::EpiPle2 E{PP, X, D, nullptr, nullptr, nullptr, 1.0f / (WPG_F8SCALE * HB_F8SCALE), (const bf16*)(wsp() + WS_XR1)};
              pg8::gemm_phase<pg8::EpiPle2, pg8::StaticOrder, true, true, true>(F.lds + RING_OFF, g, S, E, F.wave); }
        }
        SEAM();
    }
    { constexpr int l = 1;
        const float* xs = (l == 0) ? in.p[I_X] : X;
        if (RUN()) {
            const bf16* A_ = (l == 0) ? XB : (const bf16*)(wsp() + WS_XR1); const bf16* W_ = (const bf16*)(F.ws + WS_WIN) + (size_t)l * NPROJX * D; const pg8::ssq_t* ss_ = (l == 0) ? (const pg8::ssq_t*)(F.ws + WS_SS0) : (const pg8::ssq_t*)(SSACC + 2 * M);
            { pg8::Gemm g{A_, W_, M, 1024, D}; pg8::StaticOrder S; S.init(M, 1024, F.G, (int)blockIdx.x);
              pg8::EpiQK E{PROJ, (unsigned)NPROJ, ss_, in.p[I_GQ] + l * AHD, in.p[I_GK] + l * AHD, (float*)(wsp() + WS_KMEAN), C2};
              pg8::gemm_phase<pg8::EpiQK, pg8::StaticOrder, true, true>(F.lds + RING_OFF, g, S, E, F.wave); }
            { pg8::Gemm g{A_, W_ + (size_t)1024 * D, M, NPROJX - 1024, D}; pg8::StaticOrder S; S.init(M, NPROJX - 1024, F.G, (int)blockIdx.x);
              pg8::EpiProj E{PROJ, NPROJ, PC_GA / 256, ss_, NPROJX / 256 - 1, IFPRE, in.p[I_BI] + l * MH, in.p[I_BF] + l * MH, (bf16*)(wsp() + WS_GT), 4};
              pg8::gemm_phase<pg8::EpiProj, pg8::StaticOrder, true, true>(F.lds + RING_OFF, g, S, E, F.wave);
              if (l == 0) conv_fill_tail_rr(F, in, 3, QN3, 0, (M / 256) * ((NPROJX - 1024) / 256), (int)blockIdx.x);
              else conv_fill_tail_rr(F, in, 0, QN0, 2, (M / 256) * ((NPROJX - 1024) / 256), (int)blockIdx.x); }
        }
        SEAM();
        if (RUN()) {
#if !MLSTM_NAIVE
            phase_mlstm_m1(F, in, l);
#endif
#if ATTN_NAIVE
            phase_attn_naive(F);
#else
            { const attn_body::AttnTensors AT{(const attn_body::bf16*)(PROJ + PC_Q), (const attn_body::bf16*)(PROJ + PC_K), (const attn_body::bf16*)(PROJ + PC_V), (attn_body::bf16*)YA, (const float*)(F.ws + WS_KMEAN)};
              const attn_body::StaticOrder S((int)F.G, (int)blockIdx.x);
              attn_body::attn_phase<attn_body::StaticOrder>((char*)lds + RING_OFF, AT, S, F.wave); }
#endif
        }

        SEAM();

#if MLSTM_NAIVE
        if (RUN()) phase_mlstm_naive(F, in, l);
        SEAM();
#else
        if (RUN()) { phase_mlstm_m3(F, in, l);
            if (l == 0) { conv_queue(F, in, 3, QN3, -1, 0u); conv_fill_all(F, in, 0, QN0, 5); } else conv_fill_all(F, in, 0, QN0, 4); }
        SEAM();
#endif


        if (RUN()) { pg8::Gemm g{YA, (const bf16*)(F.ws + WS_WOA) + (size_t)l * D * D, M, D, D}; pg8::StaticOrder S; S.init(M, D, F.G, (int)blockIdx.x);
            pg8::EpiMerge E{(const bf16*)(wsp() + WS_GT), MIXED, D};
            pg8::gemm_phase<pg8::EpiMerge, pg8::StaticOrder, true, true>(F.lds + RING_OFF, g, S, E, F.wave); }
        SEAM();
        if (RUN()) { pg8::Gemm g{MIXED, (const bf16*)(F.ws + WS_WOUT) + (size_t)l * D * D, M, D, D}; pg8::StaticOrder S; S.init(M, D, F.G, (int)blockIdx.x);
            if constexpr (l == 0) { pg8::EpiResid16<false> E{xs, nullptr, D, XB, SSACC};
                pg8::gemm_phase<pg8::EpiResid16<false>, pg8::StaticOrder, true, true>(F.lds + RING_OFF, g, S, E, F.wave); }
            else { pg8::EpiResid16<true> E{nullptr, (const bf16*)(wsp() + WS_XR1), D, (bf16*)(wsp() + WS_XR1), nullptr};
                pg8::gemm_phase<pg8::EpiResid16<true>, pg8::StaticOrder, true, true>(F.lds + RING_OFF, g, S, E, F.wave); } }
        SEAM();
        if (l == 0) {
            if (RUN()) { pg8::Gemm g{XB, (const bf16*)(F.ws + WS_WD13), M, 2 * DFF, D}; pg8::StaticOrder S; S.init(M, 2 * DFF, F.G, (int)blockIdx.x);
                pg8::EpiSwiglu E{GH, DFF, SSACC, 1.0f, GH_F8SCALE};
                pg8::gemm_phase<pg8::EpiSwiglu, pg8::StaticOrder, true, true>(F.lds + RING_OFF, g, S, E, F.wave);
                conv_fill_tail_rr(F, in, 0, QN0, 1, (M / 256) * (2 * DFF / 256), (int)blockIdx.x); }
            SEAM();
            if (RUN()) { pg8::Gemm g{GH, (const bf16*)(F.ws + WS_WD2), M, D, DFF / 2}; pg8::StaticOrder S; S.init(M, D, F.G, (int)blockIdx.x);
                pg8::EpiResid16<true> E{nullptr, XB, D, XB, SSACC + M, 1.0f / (WPG_F8SCALE * GH_F8SCALE)};
                pg8::gemm_phase<pg8::EpiResid16<true>, pg8::StaticOrder, true, true, true>(F.lds + RING_OFF, g, S, E, F.wave); }
            SEAM();
        } else {
            if (RUN()) phase_norm<2>(F, X, in.p[I_GFFN] + l * D, HB, in.p[I_WR], NEXP, nullptr, nullptr, nullptr, GSEL, (bf16*)(wsp() + WS_XR1));
            SEAM();
#if MOE_NAIVE
            for (int e = 0; e < NEXP; ++e) {

#ifndef SK_CONVE
        if (RUN()) p_conv_expert(F, in, e);
#endif

                SEAM();
                if (RUN()) { pg8::Gemm g{HB, (const bf16*)(F.ws + WS_WE), M, 2 * DFFE, D}; pg8::StaticOrder S; S.init(M, 2 * DFFE, F.G, (int)blockIdx.x);
                    pg8::EpiSwiglu E{GH, DFFE, nullptr, 1.0f, 0.f};
                    pg8::gemm_phase<pg8::EpiSwiglu, pg8::StaticOrder, true, true>(F.lds + RING_OFF, g, S, E, F.wave); }
                SEAM();
                if (RUN()) { pg8::Gemm g{GH, (const bf16*)(F.ws + WS_WE) + (size_t)2 * DFFE * D, M, D, DFFE}; pg8::StaticOrder S; S.init(M, D, F.G, (int)blockIdx.x);
                    pg8::EpiResid E{X, X, D, GSEL + e, NEXP, nullptr, nullptr};
                    pg8::gemm_phase<pg8::EpiResid, pg8::StaticOrder, true, true>(F.lds + RING_OFF, g, S, E, F.wave); }
                SEAM();
            }
#else
            if (RUN()) { phase_moe_route(F); conv_queue(F, in, 0, QN0, -1, 0u); }
            SEAM();
            if (RUN()) { pg8::Gemm g{(const bf16*)(F.ws + WS_XG), (const bf16*)(F.ws + WS_WE), MOE_MAXROWS, 2 * DFFE, D / 2};
                const int ntr_ = moe_ntiles(F); pg8::MoeOrder S{moe_tile_table(F, ntr_), ntr_, 2 * DFFE / 256, 2 * DFFE / 256, F.G, (int)blockIdx.x};
                pg8::EpiSwiglu E{(bf16*)(F.ws + WS_GHH), DFFE, nullptr, 1.0f / W13_F8SCALE, GH_F8SCALE};
                pg8::gemm_phase<pg8::EpiSwiglu, pg8::MoeOrder, true, true, true>(F.lds + RING_OFF, g, S, E, F.wave); }
            SEAM();
            if (RUN()) { pg8::Gemm g{(const bf16*)(F.ws + WS_GHH), (const bf16*)(F.ws + WS_WE + (size_t)NEXP * 2 * DFFE * D), MOE_MAXROWS, D, DFFE / 2};
                const int ntr_ = moe_ntiles(F); pg8::MoeOrder S{moe_tile_table(F, ntr_), ntr_, D / 256, D / 256, F.G, (int)blockIdx.x};
                pg8::EpiY<false> E{(bf16*)(F.ws + WS_Y), D, 1.0f / (W2_F8SCALE * GH_F8SCALE)}; pg8::gemm_phase<pg8::EpiY<false>, pg8::MoeOrder, true, true, true>(F.lds + RING_OFF, g, S, E, F.wave); }
            SEAM();
#endif
        }
        if (l == 1) {
            if (RUN()) { if (!MOE_NAIVE) phase_norm<3>(F, X, in.p[I_GPLE] + l * D, HB, nullptr, 0, nullptr, nullptr, nullptr, nullptr, (bf16*)(wsp() + WS_XR1));
                else phase_norm<0>(F, X, in.p[I_GPLE] + l * D, HB, nullptr, 0, nullptr, nullptr, nullptr, nullptr); }
            SEAM();
        }
        if (RUN()) {
            { pg8::Gemm g{(const bf16*)(F.ws + WS_PB) + (size_t)l * M * PLE, (const bf16*)(F.ws + WS_WPP) + (size_t)l * D * PLE, M, D, PLE}; pg8::StaticOrder S; S.init(M, D, F.G, (int)blockIdx.x);
              pg8::EpiF32 E{PP, D};
              pg8::gemm_phase<pg8::EpiF32, pg8::StaticOrder, true, true>(F.lds + RING_OFF, g, S, E, F.wave); }
            if constexpr (l == 0) { pg8::Gemm g{XB, (const bf16*)(F.ws + WS_WPG), M, D, D}; pg8::StaticOrder S; S.init(M, D, F.G, (int)blockIdx.x);
              pg8::EpiPle2 E{PP, nullptr, D, (const pg8::ssq_t*)(SSACC + M), (bf16*)(wsp() + WS_XR1), SSACC + 2 * M, 1.0f, XB};
              pg8::gemm_phase<pg8::EpiPle2, pg8::StaticOrder, true, true>(F.lds + RING_OFF, g, S, E, F.wave); }
            else { pg8::Gemm g{HB, (const bf16*)(F.ws + WS_WPG) + (size_t)l * D * D, M, D, D / 2}; pg8::StaticOrder S; S.init(M, D, F.G, (int)blockIdx.x);
              pg8::EpiPle2 E{PP, X, D, nullptr, nullptr, nullptr, 1.0f / (WPG_F8SCALE * HB_F8SCALE), (const bf16*)(wsp() + WS_XR1)};
              pg8::gemm_phase<pg8::EpiPle2, pg8::StaticOrder, true, true, true>(F.lds + RING_OFF, g, S, E, F.wave); }
        }
        SEAM();
    }
#undef RUN
#undef HB
#undef PROJ
#undef YA
#undef YB
#undef MIXED
#undef TMP
#undef GH
#undef PP
#undef IFPRE
#undef GSEL
#undef XB
#undef XB2
#undef SSACC
#undef SEAM
}
constexpr int N_PHASES = 1 + (5 + 2 + 1) + (5 + 1 + (MOE_NAIVE ? 3 * NEXP : 3) + 2);

extern "C" void kernel_launch(void* const* d_in, const int* in_sizes, int n_in, void* d_out, int out_size, void* d_ws, size_t ws_size, hipStream_t stream) {
    static int grid = 0;
    if (grid == 0) {
        if (n_in != 25 || in_sizes[0] != M * D || out_size != M * D || ws_size < WS_END) { fprintf(stderr, "kernel_launch: unexpected shapes / workspace (n_in %d, ws %zu); nothing launched\n", n_in, ws_size); grid = -1; return; }
        int dev = 0, cus = 0, per_cu = 0;
        if (hipGetDevice(&dev) != hipSuccess || hipDeviceGetAttribute(&cus, hipDeviceAttributeMultiprocessorCount, dev) != hipSuccess) { grid = -1; return; }
        if (hipFuncSetAttribute((const void*)mega_fwd, hipFuncAttributeMaxDynamicSharedMemorySize, LDS_BYTES) != hipSuccess) { grid = -1; return; }
        if (hipOccupancyMaxActiveBlocksPerMultiprocessor(&per_cu, (const void*)mega_fwd, NTHR, LDS_BYTES) != hipSuccess || per_cu < 1) { fprintf(stderr, "kernel_launch: occupancy query reports %d\n", per_cu); }
        (void)hipGetLastError();
        grid = cus;
    }
    if (grid < 0) return;
    if (hipMemsetAsync((char*)d_ws + WS_CTL, 0, CTL_ZERO_BYTES, stream) != hipSuccess) return;
    Args a{};
    for (int i = 0; i < 25; ++i) a.in.p[i] = (const float*)d_in[i];
    a.out = (float*)d_out; a.ws = (unsigned char*)d_ws;
#if MK_PER_PHASE
    for (int li = 0; li < N_PHASES; ++li) { a.ph_lo = li; a.ph_hi = li + 1; a.li = 0; hipLaunchKernelGGL(mega_fwd, dim3(grid), dim3(NTHR), LDS_BYTES, stream, a); }
#else
    a.ph_lo = 0; a.ph_hi = N_PHASES; a.li = 0;
    hipLaunchKernelGGL(mega_fwd, dim3(grid), dim3(NTHR), LDS_BYTES, stream, a);
#endif
}
```
